# Optimizing an MI355X kernel written in HIP

```python
import jax, jax.numpy as jnp
from jax import lax
import numpy as np

D_MODEL = 2048
BATCH = 2
SEQ = 16384
DEPTH = 4

N_EVEN = (DEPTH + 1) // 2
N_ODD = DEPTH // 2
N_VRES = max(N_EVEN - 1, 0)
NORM_EPS = 1e-6
FFN_DIM = 5632
MIX_WIDTH = D_MODEL
A_WIDTH = MIX_WIDTH // 2
A_HEAD_DIM = 64
A_HEADS = A_WIDTH // A_HEAD_DIM
A_DECAY_RANK = 64
A_ICLR_RANK = 64
A_GATE_RANK = 160
A_VRES_RANK = 32
A_GN_EPS = 64e-5
A_COLS = 3 * A_WIDTH + A_DECAY_RANK + A_ICLR_RANK + A_GATE_RANK
B_HEAD_DIM = 64
B_HEADS = (MIX_WIDTH - A_WIDTH) // B_HEAD_DIM
B_KV_HEADS = 4
B_GROUP = B_HEADS // B_KV_HEADS
B_COLS = (B_HEADS + 2 * B_KV_HEADS) * B_HEAD_DIM
WINDOW = 128
BLOCK = 128
E_IN_COLS = A_COLS + B_COLS
C_WIDTH = D_MODEL
C_GROUPS = 16
C_CHUNK = 128

kernel_name = 'hybrid_rwkv7_swa_gmlp_macaron'


def rms_norm(x, g):
    xf = x.astype(jnp.float32)
    y = xf * lax.rsqrt(jnp.mean(xf * xf, axis=-1, keepdims=True) + NORM_EPS)
    return (y * g.astype(jnp.float32)).astype(x.dtype)


def swiglu(h, wg, wu, wd):
    return (jax.nn.silu(h @ wg) * (h @ wu)) @ wd


def token_shift(z):
    return jnp.pad(z, ((0, 0), (1, 0), (0, 0)))[:, :-1]


def alibi_slopes(n):
    return 2.0 ** (-8.0 * jnp.arange(1, n + 1, dtype=jnp.float32) / n)


def rwkv7_scan(r, w, k, v, a_vec, b_vec):
    B, T, H, N = r.shape

    def step(S, inp):
        r_t, w_t, k_t, v_t, a_t, b_t = inp
        sa = jnp.einsum('bhvk,bhk->bhv', S, a_t)
        S = S * w_t[:, :, None, :] + sa[..., None] * b_t[:, :, None, :] + v_t[..., None] * k_t[:, :, None, :]
        return S, jnp.einsum('bhvk,bhk->bhv', S, r_t)

    xs = tuple(jnp.moveaxis(t, 1, 0) for t in (r, w, k, v, a_vec, b_vec))
    _, y = lax.scan(step, jnp.zeros((B, H, N, N), jnp.float32), xs)
    return jnp.moveaxis(y, 0, 1)


def rwkv7_mixer(z, mu, w0, w2, a0, a2, g2, k_k, k_a, r_k, gn_g, gn_b, v_first, vres):
    B, T, _ = z.shape
    z = z + (token_shift(z) - z) * mu
    idx = [A_WIDTH, 2 * A_WIDTH, 3 * A_WIDTH, 3 * A_WIDTH + A_DECAY_RANK,
           3 * A_WIDTH + A_DECAY_RANK + A_ICLR_RANK]
    r, k, v, xw, xa, xg = jnp.split(z, idx, axis=-1)
    if vres is not None:
        v0, v1, v2 = vres
        v = v + (v_first - v) * jax.nn.sigmoid(v0 + (v @ v1) @ v2)
    w_log = -jax.nn.softplus(-(w0 + jnp.tanh(xw) @ w2).astype(jnp.float32)) - 0.5
    decay = jnp.exp(-jnp.exp(w_log))
    a = jax.nn.sigmoid(a0 + xa @ a2)
    g = jax.nn.sigmoid(xg) @ g2
    hs = (A_HEADS, A_HEAD_DIM)
    heads = lambda t: t.reshape(B, T, A_HEADS, A_HEAD_DIM).astype(jnp.float32)
    r_h, k_h, v_h, a_h, w_h = heads(r), heads(k), heads(v), heads(a), heads(decay)
    kk = k_h * k_k.reshape(hs).astype(jnp.float32)
    kk = kk / jnp.maximum(jnp.linalg.norm(kk, axis=-1, keepdims=True), 1e-12)
    k_h = k_h * (1.0 + (a_h - 1.0) * k_a.reshape(hs).astype(jnp.float32))
    y = rwkv7_scan(r_h, w_h, k_h, v_h, -kk, kk * a_h)
    mean = jnp.mean(y, axis=-1, keepdims=True)
    var = jnp.mean(jnp.square(y - mean), axis=-1, keepdims=True)
    y = (y - mean) * lax.rsqrt(var + A_GN_EPS) * gn_g.reshape(hs).astype(jnp.float32) + gn_b.reshape(hs).astype(jnp.float32)
    y = y + jnp.sum(r_h * k_h * r_k.astype(jnp.float32), axis=-1, keepdims=True) * v_h
    out = y.reshape(B, T, A_WIDTH).astype(z.dtype) * g
    return out, v


def sliding_window_attention(q, k, v, sinks):
    B, T = q.shape[0], q.shape[1]
    nb = T // BLOCK
    qb = q.reshape(B, nb, BLOCK, B_KV_HEADS, B_GROUP, B_HEAD_DIM)

    def band(t):
        tb = t.reshape(B, nb, BLOCK, B_KV_HEADS, B_HEAD_DIM)
        prev = jnp.pad(tb, ((0, 0), (1, 0), (0, 0), (0, 0), (0, 0)))[:, :-1]
        return jnp.concatenate([prev, tb], axis=2)

    kb, vb = band(k), band(v)
    s = jnp.einsum('bnqhgd,bnkhd->bnhgqk', qb, kb).astype(jnp.float32) * (B_HEAD_DIM ** -0.5)
    dist = jnp.arange(BLOCK)[:, None] + BLOCK - jnp.arange(2 * BLOCK)[None, :]
    slopes = alibi_slopes(B_HEADS).reshape(B_KV_HEADS, B_GROUP)
    s = s - slopes[:, :, None, None] * dist.astype(jnp.float32)
    key_pos = jnp.arange(nb)[:, None] * BLOCK - BLOCK + jnp.arange(2 * BLOCK)[None, :]
    valid = ((dist >= 0) & (dist < WINDOW))[None] & (key_pos >= 0)[:, None, :]
    s = jnp.where(valid[None, :, None, None], s, -jnp.inf)
    sink = sinks.reshape(B_KV_HEADS, B_GROUP)[:, :, None, None].astype(jnp.float32)
    m = jnp.maximum(jnp.max(s, axis=-1, keepdims=True), sink)
    p = jnp.exp(s - m)
    p = p / (jnp.sum(p, axis=-1, keepdims=True) + jnp.exp(sink - m))
    o = jnp.einsum('bnhgqk,bnkhd->bnqhgd', p.astype(vb.dtype), vb)
    return o.reshape(B, T, B_HEADS * B_HEAD_DIM)


def even_mixer(h, w_in, b_qkv, mu, w0, w2, a0, a2, g2, k_k, k_a, r_k, gn_g, gn_b, sinks, w_out, v_first, vres):
    B, T, _ = h.shape
    z = h @ w_in
    z_a, z_b = z[..., :A_COLS], z[..., A_COLS:] + b_qkv
    o_a, v_a = rwkv7_mixer(z_a, mu, w0, w2, a0, a2, g2, k_k, k_a, r_k, gn_g, gn_b, v_first, vres)
    nq, nkv = B_HEADS * B_HEAD_DIM, B_KV_HEADS * B_HEAD_DIM
    q = z_b[..., :nq].reshape(B, T, B_HEADS, B_HEAD_DIM)
    k = z_b[..., nq:nq + nkv].reshape(B, T, B_KV_HEADS, B_HEAD_DIM)
    v = z_b[..., nq + nkv:].reshape(B, T, B_KV_HEADS, B_HEAD_DIM)
    o_b = sliding_window_attention(q, k, v, sinks)
    return jnp.concatenate([o_a, o_b], axis=-1) @ w_out, v_a


def odd_mixer(h, w_in, vn_g, w_s, b_s, w_out):
    B, T, _ = h.shape
    z = jax.nn.gelu(h @ w_in, approximate=False)
    u, v = z[..., :C_WIDTH], z[..., C_WIDTH:]
    v = rms_norm(v, vn_g)
    nc = T // C_CHUNK
    vc = v.reshape(B, nc, C_CHUNK, C_GROUPS, C_WIDTH // C_GROUPS)
    ws = jnp.tril(w_s)
    vm = jnp.einsum('gij,bnjgc->bnigc', ws, vc) + b_s.T[:, :, None]
    return (u * vm.reshape(B, T, C_WIDTH)) @ w_out


def setup_inputs(seed: int = 0) -> dict:
    key = jax.random.key(seed)
    ks = iter(jax.random.split(key, 40))
    nrm = lambda shape, scale: jax.random.normal(next(ks), shape, jnp.float32) * scale
    uni = lambda shape, lo, hi: jax.random.uniform(next(ks), shape, jnp.float32, lo, hi)
    D, F = D_MODEL, FFN_DIM
    return {
        'x': nrm((BATCH, SEQ, D), 1.0),
        'norm_g': 1.0 + nrm((DEPTH, 3, D), 0.05),
        'ffn_wg': nrm((DEPTH, 2, D, F), D ** -0.5),
        'ffn_wu': nrm((DEPTH, 2, D, F), D ** -0.5),
        'ffn_wd': nrm((DEPTH, 2, F, D), F ** -0.5),
        'e_w_in': nrm((N_EVEN, D, E_IN_COLS), D ** -0.5),
        'e_b_qkv': nrm((N_EVEN, B_COLS), 0.02),
        'e_mu': uni((N_EVEN, A_COLS), 0.0, 1.0),
        'e_w0': uni((N_EVEN, A_WIDTH), -6.0, -1.0),
        'e_w2': nrm((N_EVEN, A_DECAY_RANK, A_WIDTH), 0.5 * A_DECAY_RANK ** -0.5),
        'e_a0': nrm((N_EVEN, A_WIDTH), 0.1),
        'e_a2': nrm((N_EVEN, A_ICLR_RANK, A_WIDTH), 0.5 * A_ICLR_RANK ** -0.5),
        'e_g2': nrm((N_EVEN, A_GATE_RANK, A_WIDTH), A_GATE_RANK ** -0.5),
        'e_k_k': 0.85 + nrm((N_EVEN, A_WIDTH), 0.05),
        'e_k_a': 1.0 + nrm((N_EVEN, A_WIDTH), 0.05),
        'e_r_k': nrm((N_EVEN, A_HEADS, A_HEAD_DIM), 0.1),
        'e_gn_g': 1.0 + nrm((N_EVEN, A_WIDTH), 0.1),
        'e_gn_b': nrm((N_EVEN, A_WIDTH), 0.02),
        'e_sinks': nrm((N_EVEN, B_HEADS), 0.5),
        'e_w_out': nrm((N_EVEN, MIX_WIDTH, D), MIX_WIDTH ** -0.5),
        'vres_v0': 1.0 + nrm((N_VRES, A_WIDTH), 0.1),
        'vres_v1': nrm((N_VRES, A_WIDTH, A_VRES_RANK), A_WIDTH ** -0.5),
        'vres_v2': nrm((N_VRES, A_VRES_RANK, A_WIDTH), 0.5 * A_VRES_RANK ** -0.5),
        'o_w_in': nrm((N_ODD, D, 2 * C_WIDTH), D ** -0.5),
        'o_vn_g': 1.0 + nrm((N_ODD, C_WIDTH), 0.05),
        'o_w_s': nrm((N_ODD, C_GROUPS, C_CHUNK, C_CHUNK), C_CHUNK ** -0.5),
        'o_b_s': 1.0 + nrm((N_ODD, C_GROUPS, C_CHUNK), 0.1),
        'o_w_out': nrm((N_ODD, C_WIDTH, D), C_WIDTH ** -0.5),
        'final_g': 1.0 + nrm((D,), 0.05),
    }


def reference(x, norm_g, ffn_wg, ffn_wu, ffn_wd, e_w_in, e_b_qkv, e_mu, e_w0, e_w2, e_a0, e_a2,
              e_g2, e_k_k, e_k_a, e_r_k, e_gn_g, e_gn_b, e_sinks, e_w_out, vres_v0, vres_v1, vres_v2,
              o_w_in, o_vn_g, o_w_s, o_b_s, o_w_out, final_g):
    v_first = None
    for layer in range(DEPTH):
        x = x + 0.5 * swiglu(rms_norm(x, norm_g[layer, 0]), ffn_wg[layer, 0], ffn_wu[layer, 0], ffn_wd[layer, 0])
        h = rms_norm(x, norm_g[layer, 1])
        if layer % 2 == 0:
            i = layer // 2
            vres = None if i == 0 else (vres_v0[i - 1], vres_v1[i - 1], vres_v2[i - 1])
            y, v_a = even_mixer(h, e_w_in[i], e_b_qkv[i], e_mu[i], e_w0[i], e_w2[i], e_a0[i], e_a2[i],
                                e_g2[i], e_k_k[i], e_k_a[i], e_r_k[i], e_gn_g[i], e_gn_b[i], e_sinks[i],
                                e_w_out[i], v_first, vres)
            if i == 0:
                v_first = v_a
        else:
            j = layer // 2
            y = odd_mixer(h, o_w_in[j], o_vn_g[j], o_w_s[j], o_b_s[j], o_w_out[j])
        x = x + y
        x = x + 0.5 * swiglu(rms_norm(x, norm_g[layer, 2]), ffn_wg[layer, 1], ffn_wu[layer, 1], ffn_wd[layer, 1])
    return rms_norm(x, final_g)
```

```cpp
#include <hip/hip_runtime.h>
#include <cstdio>
#include <cstdint>
namespace pg8 {
#define PG8_LAS __attribute__((address_space(3)))
typedef unsigned short bf16_t;
typedef short bf16x8 __attribute__((ext_vector_type(8)));
typedef float f32x4 __attribute__((ext_vector_type(4)));
typedef unsigned u32x4 __attribute__((ext_vector_type(4)));
constexpr int BM = 256, BK = 64, HALF = 128, HTB = HALF * BK * 2  , STAGE_BYTES = 8 * HTB, NXCD = 8, WGM = 8;

__host__ __device__ __forceinline__ int lds_byte(int r, int c) { const int st = (r >> 4) * 2 + (c >> 5), rr = r & 15, cc = c & 31, ob = rr * 64 + cc * 2; return st * 1024 + (ob ^ (((ob >> 9) & 1) << 5)); }
__host__ __device__ __forceinline__ void stage_rc(int b, int& R, int& C) { const int st = b / 1024, sb = b % 1024, swz = sb ^ (((sb >> 9) & 1) << 5); R = (st >> 1) * 16 + swz / 64; C = (st & 1) * 32 + (swz % 64) / 2; }
__host__ __device__ __forceinline__ int perm32(int rho) { const int n = rho >> 4, i = rho & 15; return 8 * (i >> 2) + 4 * n + (i & 3); }

struct Unit { int pm, pn; };
struct Gemm { const bf16_t* A; const bf16_t* Bt; int M, N, K; };

struct StaticOrder {
    int nM, nN, nwg, G, c;
    __host__ __device__ void init(int M, int N, int G_, int c_) { nM = M / BM; nN = N / BM; nwg = nM * nN; G = G_; c = c_; }
    __host__ __device__ bool next(int i, Unit& u) const {
        const long L = (long)i * G + c; if (L >= nwg) return false;
        int wgid = (int)L; { const int q = nwg / NXCD, r = nwg % NXCD, xcd = wgid % NXCD, off = wgid / NXCD; wgid = (xcd < r ? xcd * (q + 1) : r * (q + 1) + (xcd - r) * q) + off; }
        const int nig = WGM * nN, gid = wgid / nig, fm = gid * WGM, gsz = (nM - fm) < WGM ? (nM - fm) : WGM;
        u.pm = fm + ((wgid % nig) % gsz); u.pn = (wgid % nig) / gsz; return true;
    }
    __device__ __forceinline__ void a_ready(const Unit&) const {}
    __device__ __forceinline__ void done(const Unit&) const {}
};
__device__ __forceinline__ unsigned cvt_pk_bf16(float lo, float hi) { unsigned r; asm volatile("v_cvt_pk_bf16_f32 %0, %1, %2" : "=v"(r) : "v"(lo), "v"(hi)); return r; }
typedef float f32x2 __attribute__((ext_vector_type(2)));
__device__ __forceinline__ f32x2 gelu_pk(f32x2 v) {
    const f32x2 av = __builtin_elementwise_abs(v), d = av * 0.2316418882f + 1.0f;
    f32x2 t; t.x = __builtin_amdgcn_rcpf(d.x); t.y = __builtin_amdgcn_rcpf(d.y);
    f32x2 q = t * 0.5307027145f + (-0.7265760135f); q = q * t + 0.7107068705f; q = q * t + (-0.142248368f); q = q * t + 0.127414796f; q = q * t;
    const f32x2 s = (v * v) * (-0.72134752044f);
    f32x2 e; e.x = __builtin_amdgcn_exp2f(s.x); e.y = __builtin_amdgcn_exp2f(s.y);
    const f32x2 m = v * (q * e), r = v - m;
    f32x2 o; o.x = v.x < 0.f ? m.x : r.x; o.y = v.y < 0.f ? m.y : r.y; return o;
}

constexpr int SS_M = 32768;
__device__ __forceinline__ float row_rs(const float* P, int row) {
    const float s = ((P[row] + P[SS_M + row]) + (P[2 * SS_M + row] + P[3 * SS_M + row])) + ((P[4 * SS_M + row] + P[5 * SS_M + row]) + (P[6 * SS_M + row] + P[7 * SS_M + row]));
    return rsqrtf(s * (1.0f / 2048.0f) + 1e-6f);
}
struct EpiSwiGLU {
    static constexpr bool PERM = true, AFTER_DRAIN = false;
    bf16_t* O; int ldc; const float* ss;
    __device__ __forceinline__ void operator()(const f32x4 (&acc)[2][2][4][2], const Unit& u, int wr, int wc, int fr, int fq) const {
        const int row0 = u.pm * BM + wr * 64 + fr, col0 = u.pn * HALF + wc * 32 + 8 * fq;
#pragma unroll
        for (int ai = 0; ai < 2; ++ai)
#pragma unroll
            for (int m = 0; m < 4; ++m) {
                const int row = row0 + ai * HALF + m * 16;
                const float rs = row_rs(ss, row);
                float o[8];
#pragma unroll
                for (int n = 0; n < 2; ++n)
#pragma unroll
                    for (int j = 0; j < 4; ++j) { const float g = acc[ai][0][m][n][j] * rs, up = acc[ai][1][m][n][j] * rs; o[4 * n + j] = g * __builtin_amdgcn_rcpf(1.0f + __expf(-g)) * up; }
                u32x4 w; w.x = cvt_pk_bf16(o[0], o[1]); w.y = cvt_pk_bf16(o[2], o[3]); w.z = cvt_pk_bf16(o[4], o[5]); w.w = cvt_pk_bf16(o[6], o[7]);
                *(u32x4*)(O + (size_t)row * ldc + col0) = w;
                asm volatile("" ::: "memory");
            }
    }
};
struct EpiResid {
    static constexpr bool PERM = false, AFTER_DRAIN = false;
    const float* base; float* out; bf16_t* xb; float* ssn; float scale; PG8_LAS float* sp;
    __device__ __forceinline__ void operator()(const f32x4 (&acc)[2][2][4][2], const Unit& u, int wr, int wc, int fr, int fq) const {
        const int row0 = u.pm * BM + wr * 64 + fr, col0 = u.pn * BM + wc * 32 + 4 * fq;
        typedef unsigned u32x2v __attribute__((ext_vector_type(2)));
#pragma unroll
        for (int ai = 0; ai < 2; ++ai)
#pragma unroll
            for (int m = 0; m < 4; ++m) {
                const int row = row0 + ai * HALF + m * 16; const size_t off = (size_t)row * 2048 + col0; float s = 0.f;
#pragma unroll
                for (int bj = 0; bj < 2; ++bj)
#pragma unroll
                    for (int n = 0; n < 2; ++n) {
                        const f32x4 bs = *(const f32x4*)(base + off + bj * HALF + n * 16);
                        const f32x4 o = bs + acc[ai][bj][m][n] * scale;
                        *(f32x4*)(out + off + bj * HALF + n * 16) = o;
                        u32x2v w; w.x = cvt_pk_bf16(o[0], o[1]); w.y = cvt_pk_bf16(o[2], o[3]);
                        *(u32x2v*)(xb + off + bj * HALF + n * 16) = w;
                        s += (o[0] * o[0] + o[1] * o[1]) + (o[2] * o[2] + o[3] * o[3]);
                    }
                s += __shfl_xor(s, 16); s += __shfl_xor(s, 32);
                if (fq == 0) sp[(ai * HALF + wr * 64 + m * 16 + fr) * 4 + wc] = s;
                asm volatile("" ::: "memory");
            }
        asm volatile("s_waitcnt lgkmcnt(0)" ::: "memory"); __builtin_amdgcn_s_barrier(); asm volatile("" ::: "memory");
        const int t = (wr * 4 + wc) * 64 + fq * 16 + fr;
        if (t < BM) { const f32x4 p = *(const PG8_LAS f32x4*)(sp + t * 4); ssn[(size_t)u.pn * SS_M + u.pm * BM + t] = (p[0] + p[1]) + (p[2] + p[3]); }
    }
};
struct EpiZ {
    static constexpr bool PERM = true, AFTER_DRAIN = false;
    bf16_t* O; int ldc; const float* ss; const float* bias;
    __device__ __forceinline__ void operator()(const f32x4 (&acc)[2][2][4][2], const Unit& u, int wr, int wc, int fr, int fq) const {
        const int row0 = u.pm * BM + wr * 64 + fr, col0 = u.pn * BM + wc * 32 + 8 * fq;
        const bool hb = u.pn < 6;
        f32x4 bv[2][2];
#pragma unroll
        for (int bj = 0; bj < 2; ++bj)
#pragma unroll
            for (int n = 0; n < 2; ++n) bv[bj][n] = hb ? *(const f32x4*)(bias + col0 + bj * HALF + 4 * n) : (f32x4){0.f, 0.f, 0.f, 0.f};
#pragma unroll
        for (int ai = 0; ai < 2; ++ai)
#pragma unroll
            for (int m = 0; m < 4; ++m) {
                const int row = row0 + ai * HALF + m * 16;
                const float rs = row_rs(ss, row);
                bf16_t* rowp = O + (size_t)row * ldc + col0;
#pragma unroll
                for (int bj = 0; bj < 2; ++bj) {
                    const f32x4 v0 = acc[ai][bj][m][0] * rs + bv[bj][0], v1 = acc[ai][bj][m][1] * rs + bv[bj][1];
                    u32x4 w; w.x = cvt_pk_bf16(v0[0], v0[1]); w.y = cvt_pk_bf16(v0[2], v0[3]); w.z = cvt_pk_bf16(v1[0], v1[1]); w.w = cvt_pk_bf16(v1[2], v1[3]);
                    *(u32x4*)(rowp + bj * HALF) = w;
                }
                asm volatile("" ::: "memory");
            }
    }
};
struct EpiGeluV {
    static constexpr bool PERM = true, AFTER_DRAIN = false;
    bf16_t* O; int ldc; const float* ss; float* ssv; PG8_LAS float* sp;
    __device__ __forceinline__ void operator()(const f32x4 (&acc)[2][2][4][2], const Unit& u, int wr, int wc, int fr, int fq) const {
        const int row0 = u.pm * BM + wr * 64 + fr, col0 = u.pn * BM + wc * 32 + 8 * fq;
        const bool isv = u.pn >= 8;
#pragma unroll
        for (int ai = 0; ai < 2; ++ai)
#pragma unroll
            for (int m = 0; m < 4; ++m) {
                const int row = row0 + ai * HALF + m * 16;
                const float rs = row_rs(ss, row);
                bf16_t* rowp = O + (size_t)row * ldc + col0; float s = 0.f;
#pragma unroll
                for (int bj = 0; bj < 2; ++bj) {
                    f32x4 v0 = acc[ai][bj][m][0] * rs, v1 = acc[ai][bj][m][1] * rs;
                    const f32x2 a = gelu_pk((f32x2){v0[0], v0[1]}), b = gelu_pk((f32x2){v0[2], v0[3]}), c = gelu_pk((f32x2){v1[0], v1[1]}), d = gelu_pk((f32x2){v1[2], v1[3]});
                    s += (a.x * a.x + a.y * a.y) + (b.x * b.x + b.y * b.y) + (c.x * c.x + c.y * c.y) + (d.x * d.x + d.y * d.y);
                    u32x4 w; w.x = cvt_pk_bf16(a.x, a.y); w.y = cvt_pk_bf16(b.x, b.y); w.z = cvt_pk_bf16(c.x, c.y); w.w = cvt_pk_bf16(d.x, d.y);
                    *(u32x4*)(rowp + bj * HALF) = w;
                }
                if (isv) { s += __shfl_xor(s, 16); s += __shfl_xor(s, 32); if (fq == 0) sp[(ai * HALF + wr * 64 + m * 16 + fr) * 4 + wc] = s; }
                asm volatile("" ::: "memory");
            }
        if (isv) {
            asm volatile("s_waitcnt lgkmcnt(0)" ::: "memory"); __builtin_amdgcn_s_barrier(); asm volatile("" ::: "memory");
            const int t = (wr * 4 + wc) * 64 + fq * 16 + fr;
            if (t < BM) { const f32x4 p = *(const PG8_LAS f32x4*)(sp + t * 4); ssv[(size_t)(u.pn - 8) * SS_M + u.pm * BM + t] = (p[0] + p[1]) + (p[2] + p[3]); }
        }
    }
};
template <class Epi, class Sched, bool ALIGN_EPI = false, bool SP2 = false>
__device__ __forceinline__ void gemm_phase(PG8_LAS unsigned char* lds, const Gemm g, const Sched& S, const Epi& E) {
    int tid_ = threadIdx.x; asm volatile("" : "+v"(tid_));
    const int tid = tid_, wid = __builtin_amdgcn_readfirstlane(tid >> 6), lane = tid & 63, wr = wid >> 2, wc = wid & 3, fr = lane & 15, fq = lane >> 4;
    const int K = g.K, nt = K / BK;
    unsigned voffA[2], voffB[2];
#pragma unroll
    for (int i = 0; i < 2; ++i) { int R, C; stage_rc(tid * 16 + i * 8192, R, C); const int Rb = Epi::PERM ? ((R & ~31) + perm32(R & 31)) : R;
        voffA[i] = (unsigned)(R * K + C) * 2u; voffB[i] = (unsigned)(Rb * K + C) * 2u; }
    const size_t kstep = (size_t)(BK * 2);
    const size_t hstep = (size_t)HALF * K * 2;
    const size_t tstep = 2 * hstep;
    const unsigned ldsw = (unsigned)wid * 1024u;
    const int aoff = lds_byte(wr * 64 + fr, fq * 8), boff = lds_byte(wc * 32 + fr, fq * 8);
#define PG8_SA(b, h) (((b) * 2 + (h)) * HTB)
#define PG8_SB(b, h) ((4 + (b) * 2 + (h)) * HTB)
#define PG8_STAGE(bufoff, gbase, voff) do { _Pragma("unroll") for (int _i = 0; _i < 2; ++_i) \
        __builtin_amdgcn_global_load_lds((const unsigned*)((const char*)(gbase) + (voff)[_i]), (PG8_LAS unsigned*)(lds + (bufoff) + ldsw + _i * 8192), 16, 0, 0); } while (0)
#define PG8_LDA(dst, b, h) do { _Pragma("unroll") for (int m = 0; m < 4; ++m) _Pragma("unroll") for (int k = 0; k < 2; ++k) dst[m][k] = *(const PG8_LAS bf16x8*)(lds + PG8_SA(b, h) + aoff + m * 2048 + k * 1024); } while (0)
#define PG8_LDB(dst, b, h) do { _Pragma("unroll") for (int n = 0; n < 2; ++n) _Pragma("unroll") for (int k = 0; k < 2; ++k) dst[n][k] = *(const PG8_LAS bf16x8*)(lds + PG8_SB(b, h) + boff + n * 2048 + k * 1024); } while (0)
#define PG8_MMA(ai, bj, At, Bt) do { __builtin_amdgcn_s_setprio(1); _Pragma("unroll") for (int m = 0; m < 4; ++m) _Pragma("unroll") for (int n = 0; n < 2; ++n) _Pragma("unroll") for (int k = 0; k < 2; ++k) \
        acc[ai][bj][m][n] = __builtin_amdgcn_mfma_f32_16x16x32_bf16(Bt[n][k], At[m][k], acc[ai][bj][m][n], 0, 0, 0); __builtin_amdgcn_s_setprio(0); } while (0)
#define PG8_WAIT_V(n) asm volatile("s_waitcnt vmcnt(" #n ")" ::: "memory")
#define PG8_WAIT_L(n) asm volatile("s_waitcnt lgkmcnt(" #n ")" ::: "memory")
#define PG8_BAR __builtin_amdgcn_s_barrier()
#define PG8_SCHED __builtin_amdgcn_sched_barrier(0)
    Unit cur, nxt; int ui = 0;
    if (!S.next(0, cur)) return;
    f32x4 acc[2][2][4][2];
#pragma unroll
    for (int a = 0; a < 2; ++a)
#pragma unroll
        for (int b = 0; b < 2; ++b)
#pragma unroll
            for (int m = 0; m < 4; ++m)
#pragma unroll
                for (int n = 0; n < 2; ++n) acc[a][b][m][n] = (f32x4){0.f, 0.f, 0.f, 0.f};
    bf16x8 At[4][2], B0[2][2], B1[2][2];
    const char* cA = (const char*)g.A + (size_t)cur.pm * tstep; const char* cB = (const char*)g.Bt + (size_t)cur.pn * tstep;
    S.a_ready(cur);
    if constexpr (SP2) {
        PG8_STAGE(PG8_SB(0, 0), cB, voffB); PG8_STAGE(PG8_SB(0, 1), cB + hstep, voffB); PG8_STAGE(PG8_SA(0, 0), cA, voffA); PG8_STAGE(PG8_SA(0, 1), cA + hstep, voffA);
        if (wr == 1) PG8_BAR;
        PG8_WAIT_V(2); PG8_BAR;
        PG8_STAGE(PG8_SB(1, 0), cB + kstep, voffB); PG8_STAGE(PG8_SA(1, 0), cA + kstep, voffA); PG8_STAGE(PG8_SB(1, 1), cB + hstep + kstep, voffB);
        PG8_WAIT_V(6); PG8_BAR;
    } else {
        PG8_STAGE(PG8_SB(0, 0), cB, voffB); PG8_STAGE(PG8_SA(0, 0), cA, voffA); PG8_STAGE(PG8_SB(0, 1), cB + hstep, voffB); PG8_STAGE(PG8_SA(0, 1), cA + hstep, voffA);
        if (wr == 1) PG8_BAR;
        PG8_WAIT_V(4); PG8_BAR;
        PG8_STAGE(PG8_SB(1, 0), cB + kstep, voffB); PG8_STAGE(PG8_SA(1, 0), cA + kstep, voffA); PG8_STAGE(PG8_SB(1, 1), cB + hstep + kstep, voffB);
        PG8_WAIT_V(6); PG8_BAR;
    }
    for (;;) {
        const bool has_next = S.next(ui + 1, nxt);
        const char* nA = has_next ? (const char*)g.A + (size_t)nxt.pm * tstep : cA; const char* nB = has_next ? (const char*)g.Bt + (size_t)nxt.pn * tstep : cB;
        for (int t = 0; t < nt; t += 2) {
            const bool last = (t == nt - 2);
            const char* a1 = cA + (size_t)(t + 1) * kstep;
            const char* a2 = last ? nA : cA + (size_t)(t + 2) * kstep; const char* b2 = last ? nB : cB + (size_t)(t + 2) * kstep;
            const char* a3 = a2 + kstep; const char* b3 = b2 + kstep;
            if (last && has_next) S.a_ready(nxt);
            if constexpr (SP2) {
            PG8_LDB(B0, 0, 0); PG8_LDB(B1, 0, 1); PG8_SCHED; PG8_LDA(At, 0, 0); PG8_STAGE(PG8_SA(1, 1), a1 + hstep, voffA);
            PG8_WAIT_V(8); PG8_WAIT_L(0); PG8_BAR; PG8_MMA(0, 0, At, B0); PG8_MMA(0, 1, At, B1); PG8_BAR; PG8_SCHED;
            PG8_LDA(At, 0, 1); PG8_STAGE(PG8_SB(0, 0), b2, voffB); PG8_STAGE(PG8_SB(0, 1), b2 + hstep, voffB); PG8_STAGE(PG8_SA(0, 0), a2, voffA);
            PG8_WAIT_V(8); PG8_WAIT_L(0); PG8_BAR; PG8_MMA(1, 0, At, B0); PG8_MMA(1, 1, At, B1); PG8_BAR; PG8_SCHED;
            PG8_LDB(B0, 1, 0); PG8_LDB(B1, 1, 1); PG8_SCHED; PG8_LDA(At, 1, 0); PG8_STAGE(PG8_SA(0, 1), a2 + hstep, voffA);
            PG8_WAIT_V(8); PG8_WAIT_L(0); PG8_BAR; PG8_MMA(0, 0, At, B0); PG8_MMA(0, 1, At, B1); PG8_BAR; PG8_SCHED;
            PG8_LDA(At, 1, 1); PG8_STAGE(PG8_SB(1, 0), b3, voffB); PG8_STAGE(PG8_SB(1, 1), b3 + hstep, voffB); PG8_STAGE(PG8_SA(1, 0), a3, voffA);
            PG8_WAIT_V(8); PG8_WAIT_L(0); PG8_BAR; PG8_MMA(1, 0, At, B0); PG8_MMA(1, 1, At, B1); PG8_BAR; PG8_SCHED;
            } else {
            PG8_LDB(B0, 0, 0); PG8_SCHED; PG8_LDA(At, 0, 0); PG8_STAGE(PG8_SA(1, 1), a1 + hstep, voffA);
            PG8_WAIT_L(8); PG8_BAR; PG8_WAIT_L(0); PG8_MMA(0, 0, At, B0); PG8_BAR; PG8_SCHED;
            PG8_LDB(B1, 0, 1); PG8_STAGE(PG8_SB(0, 0), b2, voffB);
            PG8_BAR; PG8_WAIT_L(0); PG8_MMA(0, 1, At, B1); PG8_BAR;
            PG8_LDA(At, 0, 1); PG8_STAGE(PG8_SA(0, 0), a2, voffA);
            PG8_BAR; PG8_WAIT_L(0); PG8_MMA(1, 0, At, B0); PG8_BAR; PG8_SCHED;
            PG8_STAGE(PG8_SB(0, 1), b2 + hstep, voffB);
            PG8_WAIT_V(6); PG8_BAR; PG8_MMA(1, 1, At, B1); PG8_BAR;
            PG8_LDB(B0, 1, 0); PG8_SCHED; PG8_LDA(At, 1, 0); PG8_STAGE(PG8_SA(0, 1), a2 + hstep, voffA);
            PG8_WAIT_L(8); PG8_BAR; PG8_WAIT_L(0); PG8_MMA(0, 0, At, B0); PG8_BAR; PG8_SCHED;
            PG8_LDB(B1, 1, 1); PG8_STAGE(PG8_SB(1, 0), b3, voffB);
            PG8_BAR; PG8_WAIT_L(0); PG8_MMA(0, 1, At, B1); PG8_BAR;
            PG8_LDA(At, 1, 1); PG8_STAGE(PG8_SA(1, 0), a3, voffA);
            PG8_BAR; PG8_WAIT_L(0); PG8_MMA(1, 0, At, B0); PG8_BAR; PG8_SCHED;
            PG8_STAGE(PG8_SB(1, 1), b3 + hstep, voffB);
            PG8_WAIT_V(6); PG8_BAR; PG8_MMA(1, 1, At, B1); PG8_BAR;
            }
        }
        if constexpr (ALIGN_EPI) { if (wr == 0) PG8_BAR; }
        if constexpr (!Epi::AFTER_DRAIN) { E(acc, cur, wr, wc, fr, fq); S.done(cur); }
        if (!has_next) break;
#pragma unroll
        for (int a = 0; a < 2; ++a)
#pragma unroll
            for (int b = 0; b < 2; ++b)
#pragma unroll
                for (int m = 0; m < 4; ++m)
#pragma unroll
                    for (int n = 0; n < 2; ++n) acc[a][b][m][n] = (f32x4){0.f, 0.f, 0.f, 0.f};
        cur = nxt; cA = nA; cB = nB; ++ui;
        if constexpr (ALIGN_EPI) { if (wr == 1) PG8_BAR; }
    }
    PG8_WAIT_V(0);
    if constexpr (!ALIGN_EPI) { if (wr == 0) PG8_BAR; }
    PG8_BAR;
    if constexpr (Epi::AFTER_DRAIN) { E.fused(acc, cur, wr, wc, fr, fq, lds, wid, lane); S.done(cur); }
#undef PG8_SA
#undef PG8_SB
#undef PG8_STAGE
#undef PG8_LDA
#undef PG8_LDB
#undef PG8_MMA
#undef PG8_WAIT_V
#undef PG8_WAIT_L
#undef PG8_BAR
#undef PG8_SCHED
}
}
#define LAS_BAR __attribute__((address_space(3)))
#define XB_TMO      128
#define XB_XCNT(j)  (256  + 64 * (j))
#define XB_XSUB(j)  (1280 + 64 * (j))
#define XB_XGEN(j)  (2304 + 64 * (j))
#define XB_TOP      3328
#define XB_TOPGEN   3392
#define XCD_BAR_WORDS 3456
#define XB_SPIN_CAP (1u << 18)

__device__ __forceinline__ unsigned xb_ld(unsigned* p)              { return __hip_atomic_load(p, __ATOMIC_RELAXED, __HIP_MEMORY_SCOPE_AGENT); }
__device__ __forceinline__ unsigned xb_add(unsigned* p, unsigned v) { return __hip_atomic_fetch_add(p, v, __ATOMIC_RELAXED, __HIP_MEMORY_SCOPE_AGENT); }
__device__ __forceinline__ unsigned xb_xcc_id() { return (unsigned)__builtin_amdgcn_s_getreg((3 << 11) | 20) & 0xFu; }
#define XB_SPIN(cond, bar) do { unsigned _sp = 0; while (cond) { __builtin_amdgcn_s_sleep(1); \
    if ((++_sp & 255u) == 0u) { if (xb_ld(&(bar)[XB_TMO])) break; if (_sp > XB_SPIN_CAP) { atomicAdd(&(bar)[XB_TMO], 1u); break; } } } } while (0)

struct XcdBarrier {
    unsigned* bar; unsigned x;
    volatile LAS_BAR unsigned* st;
};

__device__ __forceinline__ XcdBarrier xcd_barrier_post(unsigned* bar, volatile LAS_BAR unsigned* st) {
    XcdBarrier b; b.bar = bar; b.x = xb_xcc_id(); b.st = st;
    if (threadIdx.x == 0) (void)xb_add(&bar[XB_XCNT(b.x)], 1u);
    return b;
}
__device__ __forceinline__ void xcd_barrier_complete(unsigned* bar, unsigned x, unsigned& nloc, unsigned& nx) {
    const unsigned G = gridDim.x * gridDim.y * gridDim.z;
    unsigned sum, cnt, mine, sp = 0u;
    for (;;) {
        sum = 0u; cnt = 0u; mine = 0u;
#pragma unroll
        for (unsigned j = 0; j < 16; ++j) { const unsigned c = xb_ld(&bar[XB_XCNT(j)]); sum += c; cnt += (c > 0u) ? 1u : 0u; mine = (j == x) ? c : mine; }
        if (sum == G) break;
        __builtin_amdgcn_s_sleep(1);
        if ((++sp & 255u) == 0u) { if (xb_ld(&bar[XB_TMO])) break; if (sp > XB_SPIN_CAP) { atomicAdd(&bar[XB_TMO], 1u); break; } }
    }
    nloc = mine > 0u ? mine : 1u; nx = cnt > 0u ? cnt : 1u;
}

__device__ __forceinline__ void xcd_barrier(const XcdBarrier& b) {
    asm volatile("s_waitcnt vmcnt(0)" ::: "memory");
    __syncthreads();
    if (threadIdx.x == 0) {
        unsigned* bar = b.bar;
        __builtin_amdgcn_s_waitcnt(0);
        unsigned nloc = b.st[0], nx = b.st[1];
        if (nloc == 0u) { xcd_barrier_complete(bar, b.x, nloc, nx); b.st[0] = nloc; b.st[1] = nx; }
        const unsigned old = xb_add(&bar[XB_XSUB(b.x)], 1u);
        const unsigned gen = old / nloc;
        if (old + 1u == (gen + 1u) * nloc) {
            __builtin_amdgcn_fence(__ATOMIC_RELEASE, "agent");
            asm volatile("s_waitcnt vmcnt(0)" ::: "memory");
            const unsigned og = xb_add(&bar[XB_TOP], 1u);
            const unsigned tg = og / nx;
            if (og + 1u == (tg + 1u) * nx) xb_add(&bar[XB_TOPGEN], 1u);
            else XB_SPIN(xb_ld(&bar[XB_TOPGEN]) == tg, bar);
            __builtin_amdgcn_fence(__ATOMIC_ACQUIRE, "agent");
            xb_add(&bar[XB_XGEN(b.x)], 1u);
            asm volatile("s_waitcnt vmcnt(0)" ::: "memory");
        } else {
            XB_SPIN(xb_ld(&bar[XB_XGEN(b.x)]) == gen, bar);
            __builtin_amdgcn_fence(__ATOMIC_ACQUIRE, "agent");
            asm volatile("s_waitcnt vmcnt(0)" ::: "memory");
        }
    }
    __syncthreads();
}

constexpr int NWAVES = 8, NTHR = 512;
constexpr int BATCH = 2, T = 16384, D = 2048, FF = 5632, M = BATCH * T;
constexpr int ZN = 5120;
constexpr int ZA = 1536;
constexpr int A_COLS = 3360, E_IN = 4896;
constexpr int ZO = 4096;
constexpr int NSUB = 12;
#ifndef MK_ONE_LAUNCH
#define MK_ONE_LAUNCH 0
#endif

constexpr size_t MiB = 1u << 20;
constexpr size_t WS_CTL = 0, CTL_ZERO_BYTES = 1 * MiB;
constexpr size_t WS_SS = 1 * MiB;
constexpr size_t SS_REC = 8 * (size_t)M;
constexpr size_t WS_WT = 16 * MiB;
constexpr size_t WT_GU1 = WS_WT, WT_D1 = WT_GU1 + 44 * MiB, WT_GU2 = WT_D1 + 22 * MiB, WT_D2 = WT_GU2 + 44 * MiB, WT_IN = WT_D2 + 22 * MiB, WT_OUT = WT_IN + 20 * MiB;
constexpr size_t WS_XB = WT_OUT + 8 * MiB;
constexpr size_t WS_ACT = WS_XB + 128 * MiB;
constexpr size_t WS_SC = WS_ACT + 352 * MiB;
constexpr size_t SC_R = WS_SC, SC_K2 = SC_R + 64 * MiB, SC_KK = SC_K2 + 64 * MiB, SC_BB = SC_KK + 64 * MiB, SC_LW = SC_BB + 64 * MiB, SC_GG = SC_LW + 64 * MiB;
constexpr size_t WS_VF = SC_GG + 64 * MiB;
constexpr size_t WS_V2 = WS_VF + 64 * MiB;
constexpr size_t WS_O = WS_V2 + 64 * MiB;
constexpr size_t WS_END = WS_O + 128 * MiB;
static_assert(WT_OUT + 8 * MiB == 176 * MiB && WS_SS + 15 * MiB <= WS_WT, "weight map");
constexpr int CW_TMO = 0, CW_CODE = 1, CW_BAR = 4096;

constexpr int LDS_BYTES = 147456, LDSCTL_OFF = LDS_BYTES - 512;

#define GAS __attribute__((address_space(1)))
#define LAS __attribute__((address_space(3)))
typedef unsigned short bf16;
typedef unsigned v4u __attribute__((ext_vector_type(4)));
typedef unsigned v2u __attribute__((ext_vector_type(2)));
typedef float f32x4 __attribute__((ext_vector_type(4)));
typedef float f32x2 __attribute__((ext_vector_type(2)));
typedef GAS unsigned gu32;
#define RLX_AGENT __ATOMIC_RELAXED, __HIP_MEMORY_SCOPE_AGENT
#define LDS_WAIT() asm volatile("s_waitcnt lgkmcnt(0)" ::: "memory")
__device__ __forceinline__ unsigned f2bf(float f) { unsigned u = __builtin_bit_cast(unsigned, f); return (u + 0x7fffu + ((u >> 16) & 1u)) >> 16; }
__device__ __forceinline__ unsigned pk2(float lo, float hi) { return f2bf(lo) | (f2bf(hi) << 16); }
__device__ __forceinline__ float bf2f(bf16 b) { return __builtin_bit_cast(float, (unsigned)b << 16); }
__device__ __forceinline__ float bflo(unsigned w) { return __builtin_bit_cast(float, w << 16); }
__device__ __forceinline__ float bfhi(unsigned w) { return __builtin_bit_cast(float, w & 0xffff0000u); }
__device__ __forceinline__ float wave_sum(float v) {
#pragma unroll
    for (int o = 1; o < 64; o <<= 1) v += __shfl_xor(v, o);
    return v;
}
template <int CTRL> __device__ __forceinline__ float dpp_mov(float v) { return __builtin_bit_cast(float, __builtin_amdgcn_update_dpp(0, __builtin_bit_cast(int, v), CTRL, 0xf, 0xf, true)); }
__device__ __forceinline__ float row16_sum(float v) { v += dpp_mov<0xB1>(v); v += dpp_mov<0x4E>(v); v += dpp_mov<0x141>(v); v += dpp_mov<0x140>(v); return v; }
__device__ __forceinline__ float sigmoidf_(float x) { return 1.0f / (1.0f + __expf(-x)); }

__device__ __forceinline__ int opaque(int v) { asm volatile("" : "+v"(v)); return v; }
struct Args { const float* in[29]; float* out; unsigned char* ws; int ph_lo, ph_hi; };
static_assert(sizeof(Args) == 29 * 8 + 8 + 8 + 8, "Args has no padding");
enum { I_X = 0, I_NG, I_WG, I_WU, I_WD, I_EWIN, I_EBQKV, I_EMU, I_EW0, I_EW2, I_EA0, I_EA2, I_EG2, I_EKK, I_EKA, I_ERK, I_EGNG, I_EGNB, I_ESINK, I_EWOUT, I_V0, I_V1, I_V2, I_OWIN, I_OVNG, I_OWS, I_OBS, I_OWOUT, I_FG };

__device__ __forceinline__ void tr_item(const float* W, int ldw, int k0, int c0, const float* gk, bf16* WT, int K, int drow0, LAS float* scr, int lane, bool zero) {
    if (!zero) {
#pragma unroll 8
        for (int i = 0; i < 32; ++i) { const int kk = 2 * i + (lane >> 5); float v = W[(size_t)(k0 + kk) * ldw + c0 + (lane & 31)]; if (gk) v *= gk[k0 + kk]; scr[kk * 33 + (lane & 31)] = v; }
    } else {
#pragma unroll 8
        for (int i = 0; i < 32; ++i) { const int kk = 2 * i + (lane >> 5); scr[kk * 33 + (lane & 31)] = 0.f; }
    }
    LDS_WAIT(); asm volatile("" ::: "memory");
    const int c = lane & 7;
#pragma unroll
    for (int j = 0; j < 4; ++j) { const int n = (lane >> 3) + 8 * j; const LAS float* s = scr + (8 * c) * 33 + n;
        v4u o; o.x = pk2(s[0 * 33], s[1 * 33]); o.y = pk2(s[2 * 33], s[3 * 33]); o.z = pk2(s[4 * 33], s[5 * 33]); o.w = pk2(s[6 * 33], s[7 * 33]);
        *(GAS v4u*)(WT + (size_t)(drow0 + n) * K + k0 + 8 * c) = o; }
    LDS_WAIT(); asm volatile("" ::: "memory");
}
__device__ __forceinline__ void prep_phase(const Args& a, int L, LAS unsigned char* lds, int vcu, int G, int wave, int lane) {
    LAS float* scr = (LAS float*)(lds + wave * 16384);
    const int gw = vcu * NWAVES + wave, NGW = G * NWAVES;
    unsigned char* ws = a.ws;
    const bool even = !(L & 1); const int li = L >> 1;
    constexpr int nGU = 32 * 352, nD = 88 * 64, nOUT = 32 * 64;
    const int nIN = 32 * (even ? 160 : 128);
    const int total = 2 * nGU + 2 * nD + nIN + nOUT;
    for (int it = gw; it < total; it += NGW) {
        int r = it;
        if (r < 2 * nGU) { const int f = r / nGU; r -= f * nGU; const int kb = r / 352, rb = r % 352, tj = rb >> 3, sub = rb & 7;
            const float* W = (sub < 4 ? a.in[I_WG] : a.in[I_WU]) + (size_t)(L * 2 + f) * D * FF;
            tr_item(W, FF, 64 * kb, 128 * tj + 32 * (sub & 3), a.in[I_NG] + (L * 3 + (f ? 2 : 0)) * D, (bf16*)(ws + (f ? WT_GU2 : WT_GU1)), D, 32 * rb, scr, lane, false); continue; }
        r -= 2 * nGU;
        if (r < 2 * nD) { const int f = r / nD; r -= f * nD; const int kb = r / 64, nb = r % 64;
            tr_item(a.in[I_WD] + (size_t)(L * 2 + f) * FF * D, D, 64 * kb, 32 * nb, nullptr, (bf16*)(ws + (f ? WT_D2 : WT_D1)), FF, 32 * nb, scr, lane, false); continue; }
        r -= 2 * nD;
        if (r < nIN) {
            if (even) { const int kb = r / 160, rb = r % 160, d = 32 * rb; const bool zero = d >= E_IN; const int c0 = d < ZA ? A_COLS + d : d - ZA;
                tr_item(a.in[I_EWIN] + (size_t)li * D * E_IN, E_IN, 64 * kb, zero ? 0 : c0, a.in[I_NG] + (L * 3 + 1) * D, (bf16*)(ws + WT_IN), D, d, scr, lane, zero); }
            else { const int kb = r / 128, rb = r % 128;
                tr_item(a.in[I_OWIN] + (size_t)li * D * ZO, ZO, 64 * kb, 32 * rb, a.in[I_NG] + (L * 3 + 1) * D, (bf16*)(ws + WT_IN), D, 32 * rb, scr, lane, false); }
            continue; }
        r -= nIN;
        { const int kb = r / 64, nb = r % 64;
          tr_item((even ? a.in[I_EWOUT] : a.in[I_OWOUT]) + (size_t)li * D * D, D, 64 * kb, 32 * nb, nullptr, (bf16*)(ws + WT_OUT), D, 32 * nb, scr, lane, false); }
    }
    if (L == 0) {
        float* ss0 = (float*)(ws + WS_SS); bf16* XB = (bf16*)(ws + WS_XB);
        for (int m = gw; m < M; m += NGW) {
            const GAS f32x4* xr = (const GAS f32x4*)(a.in[I_X] + (size_t)m * D) + lane; GAS v2u* o = (GAS v2u*)(XB + (size_t)m * D) + lane; float s = 0.f;
#pragma unroll
            for (int j = 0; j < 8; ++j) { const f32x4 v = xr[64 * j]; s += (v.x * v.x + v.y * v.y) + (v.z * v.z + v.w * v.w); v2u w; w.x = pk2(v.x, v.y); w.y = pk2(v.z, v.w); o[64 * j] = w; }
            s = wave_sum(s); if (lane < 8) ss0[(size_t)lane * M + m] = lane ? 0.f : s;
        }
    }
}

__device__ __forceinline__ void e1_phase(const Args& a, int li, LAS unsigned char* ldsb, int vcu, int G, int tid) {
    LAS float* Aw = (LAS float*)ldsb; LAS float* Aa = Aw + 16 * 64; LAS float* Ag = Aa + 16 * 64; LAS float* Vp = Ag + 16 * 160; LAS float* Pb = Vp + 16 * 1024;
    unsigned char* ws = a.ws;
    const bf16* Z = (const bf16*)(ws + WS_ACT);
    bf16* R = (bf16*)(ws + SC_R); bf16* K2 = (bf16*)(ws + SC_K2); bf16* KK = (bf16*)(ws + SC_KK); bf16* BB = (bf16*)(ws + SC_BB); bf16* LW = (bf16*)(ws + SC_LW); bf16* GG = (bf16*)(ws + SC_GG);
    bf16* VO = (bf16*)(ws + (li ? WS_V2 : WS_VF)); const bf16* VF = (const bf16*)(ws + WS_VF);
    const float* mu = a.in[I_EMU] + li * A_COLS;
    const float* w0 = a.in[I_EW0] + li * 1024; const float* w2 = a.in[I_EW2] + (size_t)li * 64 * 1024;
    const float* a0 = a.in[I_EA0] + li * 1024; const float* a2 = a.in[I_EA2] + (size_t)li * 64 * 1024;
    const float* g2 = a.in[I_EG2] + (size_t)li * 160 * 1024;
    const float* kkw = a.in[I_EKK] + li * 1024; const float* kaw = a.in[I_EKA] + li * 1024;
    const float* v0w = a.in[I_V0]; const float* v1w = a.in[I_V1]; const float* v2w = a.in[I_V2];
    for (int unit = vcu; unit < M / 16; unit += G) {
        const int m0 = unit * 16;
        for (int e = tid; e < 16 * 288; e += NTHR) { const int r = e / 288, j = e % 288, m = m0 + r; const bool first = (m & (T - 1)) == 0;
            const float zc = bf2f(Z[(size_t)m * ZN + ZA + 3072 + j]); const float zp = first ? 0.f : bf2f(Z[(size_t)(m - 1) * ZN + ZA + 3072 + j]);
            const float x = zc + (zp - zc) * mu[3072 + j];
            if (j < 64) Aw[r * 64 + j] = tanhf(x); else if (j < 128) Aa[r * 64 + j - 64] = x; else Ag[r * 160 + j - 128] = sigmoidf_(x); }
        if (li > 0) {
            for (int e = tid; e < 16 * 1024; e += NTHR) { const int r = e >> 10, c = e & 1023, m = m0 + r; const bool first = (m & (T - 1)) == 0;
                const float zc = bf2f(Z[(size_t)m * ZN + ZA + 2048 + c]); const float zp = first ? 0.f : bf2f(Z[(size_t)(m - 1) * ZN + ZA + 2048 + c]);
                Vp[e] = zc + (zp - zc) * mu[2048 + c]; }
        }
        __syncthreads();
        if (li > 0) { const int r = tid >> 5, j = tid & 31; float acc = 0.f;
            for (int c = 0; c < 1024; ++c) acc += Vp[r * 1024 + c] * v1w[c * 32 + j];
            Pb[r * 32 + j] = acc; __syncthreads(); }
        for (int pass = 0; pass < 2; ++pass) {
            const int c = tid + NTHR * pass;
            float wa[16], aa[16], ga[16];
#pragma unroll
            for (int r = 0; r < 16; ++r) { wa[r] = 0.f; aa[r] = 0.f; ga[r] = 0.f; }
            for (int k = 0; k < 64; k += 4) {
                const float w_0 = w2[(k + 0) * 1024 + c], w_1 = w2[(k + 1) * 1024 + c], w_2 = w2[(k + 2) * 1024 + c], w_3 = w2[(k + 3) * 1024 + c];
                const float a_0 = a2[(k + 0) * 1024 + c], a_1 = a2[(k + 1) * 1024 + c], a_2 = a2[(k + 2) * 1024 + c], a_3 = a2[(k + 3) * 1024 + c];
#pragma unroll
                for (int r = 0; r < 16; ++r) { const f32x4 xw = *(const LAS f32x4*)(Aw + r * 64 + k), xa = *(const LAS f32x4*)(Aa + r * 64 + k);
                    wa[r] += (xw.x * w_0 + xw.y * w_1) + (xw.z * w_2 + xw.w * w_3); aa[r] += (xa.x * a_0 + xa.y * a_1) + (xa.z * a_2 + xa.w * a_3); }
            }
            for (int k = 0; k < 160; k += 4) {
                const float g_0 = g2[(k + 0) * 1024 + c], g_1 = g2[(k + 1) * 1024 + c], g_2 = g2[(k + 2) * 1024 + c], g_3 = g2[(k + 3) * 1024 + c];
#pragma unroll
                for (int r = 0; r < 16; ++r) { const f32x4 xg = *(const LAS f32x4*)(Ag + r * 160 + k); ga[r] += (xg.x * g_0 + xg.y * g_1) + (xg.z * g_2 + xg.w * g_3); }
            }
            const float w0c = w0[c], a0c = a0[c], kkc = kkw[c], kac = kaw[c], mur = mu[c], muk = mu[1024 + c], muv = mu[2048 + c];
            const float v0c = li ? v0w[c] : 0.f;
#pragma unroll
            for (int r = 0; r < 16; ++r) {
                const int m = m0 + r; const bool first = (m & (T - 1)) == 0; const size_t zo = (size_t)m * ZN + ZA + c, zq = zo - ZN;
                const float rc = bf2f(Z[zo]), kc = bf2f(Z[zo + 1024]), vc = bf2f(Z[zo + 2048]);
                const float rp = first ? 0.f : bf2f(Z[zq]), kp = first ? 0.f : bf2f(Z[zq + 1024]), vp = first ? 0.f : bf2f(Z[zq + 2048]);
                const float rr = rc + (rp - rc) * mur, k1 = kc + (kp - kc) * muk; float vv = vc + (vp - vc) * muv;
                if (li > 0) { float gt = v0c;
#pragma unroll 8
                    for (int j = 0; j < 32; ++j) gt += Pb[r * 32 + j] * v2w[j * 1024 + c];
                    vv = vv + (bf2f(VF[(size_t)m * 1024 + c]) - vv) * sigmoidf_(gt); }
                const float av = sigmoidf_(a0c + aa[r]);
                const float wv = w0c + wa[r]; const float y = -wv; const float sp = fmaxf(y, 0.f) + log1pf(__expf(-fabsf(y)));
                const float lw = -__expf(-sp - 0.5f);
                const float kk0 = k1 * kkc; const float nrm = sqrtf(wave_sum(kk0 * kk0)); const float kk = kk0 / fmaxf(nrm, 1e-12f);
                const float k2 = k1 * (1.0f + (av - 1.0f) * kac);
                const size_t o = (size_t)m * 1024 + c;
                R[o] = (bf16)f2bf(rr); K2[o] = (bf16)f2bf(k2); VO[o] = (bf16)f2bf(vv); KK[o] = (bf16)f2bf(kk); BB[o] = (bf16)f2bf(kk * av); LW[o] = (bf16)f2bf(lw); GG[o] = (bf16)f2bf(ga[r]);
            }
        }
        __syncthreads();
    }
}

constexpr int SCH = 32;
__device__ __forceinline__ void scan_fill(LAS float* vecb, LAS float* vvb, const bf16* LW, const bf16* K2, const bf16* R, const bf16* KK, const bf16* BB, const bf16* V, size_t rowbase, int colh, int q, int ft, int nft) {
    for (int e = ft; e < 5 * SCH * 8; e += nft) { const int i = e / (SCH * 8), rem = e % (SCH * 8), tt = rem >> 3, j = rem & 7;
        const bf16* src = (i == 0 ? LW : i == 1 ? K2 : i == 2 ? R : i == 3 ? KK : BB) + (rowbase + tt) * 1024 + colh + 8 * j;
        const v4u w = *(const GAS v4u*)src; f32x4 lo, hi;
        lo.x = bflo(w.x); lo.y = bfhi(w.x); lo.z = bflo(w.y); lo.w = bfhi(w.y); hi.x = bflo(w.z); hi.y = bfhi(w.z); hi.z = bflo(w.w); hi.w = bfhi(w.w);
        if (i == 0) { lo.x = __expf(lo.x); lo.y = __expf(lo.y); lo.z = __expf(lo.z); lo.w = __expf(lo.w); hi.x = __expf(hi.x); hi.y = __expf(hi.y); hi.z = __expf(hi.z); hi.w = __expf(hi.w); }
        if (i == 3) { lo = -lo; hi = -hi; }
        LAS f32x4* d = (LAS f32x4*)(vecb + (i * SCH + tt) * 64 + 8 * j); d[0] = lo; d[1] = hi; }
    for (int e = ft; e < SCH * 2; e += nft) { const int tt = e >> 1, hf = e & 1;
        const v4u w = *(const GAS v4u*)(V + (rowbase + tt) * 1024 + colh + 16 * q + 8 * hf); f32x4 lo, hi;
        lo.x = bflo(w.x); lo.y = bfhi(w.x); lo.z = bflo(w.y); lo.w = bfhi(w.y); hi.x = bflo(w.z); hi.y = bfhi(w.z); hi.z = bflo(w.w); hi.w = bfhi(w.w);
        LAS f32x4* d = (LAS f32x4*)(vvb + tt * 16 + 8 * hf); d[0] = lo; d[1] = hi; }
}
__device__ __forceinline__ void scan_unit(const Args& a, int li, int su, LAS unsigned char* ldsb, int tid) {
    unsigned char* ws = a.ws;
    const bf16* R = (const bf16*)(ws + SC_R); const bf16* K2 = (const bf16*)(ws + SC_K2); const bf16* KK = (const bf16*)(ws + SC_KK); const bf16* BB = (const bf16*)(ws + SC_BB); const bf16* LW = (const bf16*)(ws + SC_LW);
    const bf16* V = (const bf16*)(ws + (li ? WS_V2 : WS_VF)); float* Y = (float*)(ws + WS_XB);
    const int bh = su >> 2, q = su & 3, b = bh >> 4, h = bh & 15, colh = h * 64; const size_t row0 = (size_t)b * T;
    LAS float* vec = (LAS float*)ldsb;
    LAS float* vvl = vec + 2 * 5 * SCH * 64;
    LAS float* ybl = vvl + 2 * SCH * 16;
    const int lane = tid & 63, cw = tid >> 6, rp = lane >> 4, kg = lane & 15, lr0 = 8 * cw + 2 * rp;
    f32x4 S0 = {0.f, 0.f, 0.f, 0.f}, S1 = {0.f, 0.f, 0.f, 0.f};
    scan_fill(vec, vvl, LW, K2, R, KK, BB, V, row0, colh, q, tid, NTHR);
    constexpr int NCH = T / SCH;
    for (int c = 0; c < NCH; ++c) {
        __syncthreads();
        const int buf = c & 1;
        if (tid < 128) {
            const LAS float* vb = vec + buf * 5 * SCH * 64 + 4 * kg; const LAS float* vvb = vvl + buf * SCH * 16 + lr0; LAS float* yb = ybl + buf * SCH * 16 + lr0;
#pragma unroll 4
            for (int t = 0; t < SCH; ++t) {
                const f32x4 wv = *(const LAS f32x4*)(vb + t * 64), kv = *(const LAS f32x4*)(vb + (SCH + t) * 64), rv = *(const LAS f32x4*)(vb + (2 * SCH + t) * 64),
                            av = *(const LAS f32x4*)(vb + (3 * SCH + t) * 64), bv = *(const LAS f32x4*)(vb + (4 * SCH + t) * 64);
                const f32x2 v2 = *(const LAS f32x2*)(vvb + t * 16);
                float sa0 = (S0.x * av.x + S0.y * av.y) + (S0.z * av.z + S0.w * av.w), sa1 = (S1.x * av.x + S1.y * av.y) + (S1.z * av.z + S1.w * av.w);
                sa0 = row16_sum(sa0); sa1 = row16_sum(sa1);
                S0 = S0 * wv + (bv * sa0 + kv * v2.x); S1 = S1 * wv + (bv * sa1 + kv * v2.y);
                float y0 = (S0.x * rv.x + S0.y * rv.y) + (S0.z * rv.z + S0.w * rv.w), y1 = (S1.x * rv.x + S1.y * rv.y) + (S1.z * rv.z + S1.w * rv.w);
                y0 = row16_sum(y0); y1 = row16_sum(y1);
                if (kg == 0) *(LAS f32x2*)(yb + t * 16) = (f32x2){y0, y1};
            }
        } else {
            const int ft = tid - 128;
            if (c + 1 < NCH) scan_fill(vec + (buf ^ 1) * 5 * SCH * 64, vvl + (buf ^ 1) * SCH * 16, LW, K2, R, KK, BB, V, row0 + (size_t)(c + 1) * SCH, colh, q, ft, NTHR - 128);
            if (c > 0 && ft < 128) { const int tt = ft >> 2, part = ft & 3;
                *(GAS f32x4*)(Y + (row0 + (size_t)(c - 1) * SCH + tt) * 1024 + colh + 16 * q + 4 * part) = *(const LAS f32x4*)(ybl + (buf ^ 1) * SCH * 16 + tt * 16 + 4 * part); }
        }
    }
    __syncthreads();
    if (tid < 128) { const int tt = tid >> 2, part = tid & 3;
        *(GAS f32x4*)(Y + (row0 + (size_t)(NCH - 1) * SCH + tt) * 1024 + colh + 16 * q + 4 * part) = *(const LAS f32x4*)(ybl + ((NCH - 1) & 1) * SCH * 16 + tt * 16 + 4 * part); }
    __syncthreads();
}

__device__ __forceinline__ void attn_unit(const Args& a, int li, int au, LAS unsigned char* ldsb, int tid) {
    unsigned char* ws = a.ws; const bf16* Z = (const bf16*)(ws + WS_ACT); bf16* O = (bf16*)(ws + WS_O);
    const int n = au & 127, kvh = (au >> 7) & 3, b = au >> 9;
    LAS float* Ks = (LAS float*)ldsb; LAS float* Vs = Ks + 256 * 68;
    const size_t rblk = (size_t)b * T + (size_t)n * 128;
    for (int e = tid; e < 256 * 8 * 2; e += NTHR) { const int which = e >> 11, rem = e & 2047, j = rem >> 3, c8 = rem & 7; const bool valid = (n > 0) || (j >= 128);
        f32x4 lo = {0.f, 0.f, 0.f, 0.f}, hi = lo;
        if (valid) { const v4u w = *(const GAS v4u*)(Z + (rblk + j - 128) * ZN + 1024 + which * 256 + kvh * 64 + 8 * c8);
            lo.x = bflo(w.x); lo.y = bfhi(w.x); lo.z = bflo(w.y); lo.w = bfhi(w.y); hi.x = bflo(w.z); hi.y = bfhi(w.z); hi.z = bflo(w.w); hi.w = bfhi(w.w); }
        LAS f32x4* d = (LAS f32x4*)((which ? Vs : Ks) + j * 68 + 8 * c8); d[0] = lo; d[1] = hi; }
    __syncthreads();
    const int g = tid >> 7, i = tid & 127, hq = kvh * 4 + g; const size_t row = rblk + i;
    float qv[64];
    { const GAS v4u* qp = (const GAS v4u*)(Z + row * ZN + hq * 64);
#pragma unroll
      for (int c = 0; c < 8; ++c) { const v4u w = qp[c]; qv[8 * c + 0] = bflo(w.x) * 0.125f; qv[8 * c + 1] = bfhi(w.x) * 0.125f; qv[8 * c + 2] = bflo(w.y) * 0.125f; qv[8 * c + 3] = bfhi(w.y) * 0.125f;
          qv[8 * c + 4] = bflo(w.z) * 0.125f; qv[8 * c + 5] = bfhi(w.z) * 0.125f; qv[8 * c + 6] = bflo(w.w) * 0.125f; qv[8 * c + 7] = bfhi(w.w) * 0.125f; } }
    const float slope = exp2f(-0.5f * (float)(hq + 1)); const float sink = a.in[I_ESINK][li * 16 + hq];
    float mx = sink, l = 1.0f; float acc[64];
#pragma unroll
    for (int d = 0; d < 64; ++d) acc[d] = 0.f;
    for (int jj = 0; jj < 128; ++jj) { const int j = i + 1 + jj; const bool valid = (n > 0) || (j >= 128);
        const LAS f32x4* kr = (const LAS f32x4*)(Ks + j * 68); float s0 = 0.f, s1 = 0.f;
#pragma unroll
        for (int c = 0; c < 16; c += 2) { const f32x4 k0 = kr[c], k1 = kr[c + 1];
            s0 += (qv[4 * c] * k0.x + qv[4 * c + 1] * k0.y) + (qv[4 * c + 2] * k0.z + qv[4 * c + 3] * k0.w); s1 += (qv[4 * c + 4] * k1.x + qv[4 * c + 5] * k1.y) + (qv[4 * c + 6] * k1.z + qv[4 * c + 7] * k1.w); }
        float s = (s0 + s1) - slope * (float)(127 - jj);
        if (!valid) s = -INFINITY;
        if (s > mx) { const float sc = __expf(mx - s); l *= sc;
#pragma unroll
            for (int d = 0; d < 64; ++d) acc[d] *= sc;
            mx = s; }
        const float p = __expf(s - mx); l += p;
        const LAS f32x4* vr = (const LAS f32x4*)(Vs + j * 68);
#pragma unroll
        for (int c = 0; c < 16; ++c) { const f32x4 v = vr[c]; acc[4 * c] += p * v.x; acc[4 * c + 1] += p * v.y; acc[4 * c + 2] += p * v.z; acc[4 * c + 3] += p * v.w; }
    }
    const float inv = 1.0f / l;
    { GAS v4u* op = (GAS v4u*)(O + row * D + 1024 + hq * 64);
#pragma unroll
      for (int c = 0; c < 8; ++c) { v4u w; w.x = pk2(acc[8 * c] * inv, acc[8 * c + 1] * inv); w.y = pk2(acc[8 * c + 2] * inv, acc[8 * c + 3] * inv); w.z = pk2(acc[8 * c + 4] * inv, acc[8 * c + 5] * inv); w.w = pk2(acc[8 * c + 6] * inv, acc[8 * c + 7] * inv); op[c] = w; } }
    __syncthreads();
}

__device__ __forceinline__ void e3_phase(const Args& a, int li, int vcu, int G, int tid) {
    unsigned char* ws = a.ws; const float* Y = (const float*)(ws + WS_XB);
    const bf16* R = (const bf16*)(ws + SC_R); const bf16* K2 = (const bf16*)(ws + SC_K2); const bf16* GG = (const bf16*)(ws + SC_GG); const bf16* V = (const bf16*)(ws + (li ? WS_V2 : WS_VF));
    bf16* O = (bf16*)(ws + WS_O);
    const float* rk = a.in[I_ERK] + li * 1024; const float* gng = a.in[I_EGNG] + li * 1024; const float* gnb = a.in[I_EGNB] + li * 1024;
    for (size_t e = (size_t)vcu * NTHR + tid; e < (size_t)M * 1024; e += (size_t)G * NTHR) {
        const size_t row = e >> 10; const int c = (int)(e & 1023);
        const float y = Y[e]; const float mean = wave_sum(y) * (1.0f / 64.0f); const float dv = y - mean; const float var = wave_sum(dv * dv) * (1.0f / 64.0f);
        const float r = bf2f(R[e]), k = bf2f(K2[e]), v = bf2f(V[e]), g = bf2f(GG[e]);
        const float yn = dv * rsqrtf(var + 64e-5f) * gng[c] + gnb[c];
        const float bonus = wave_sum(r * k * rk[c]);
        O[row * D + c] = (bf16)f2bf((yn + bonus * v) * g);
    }
}

#define SGU_SYNC() __syncthreads()
__device__ __forceinline__ void sgu_phase(const Args& a, int li, LAS unsigned char* ldsb, int vcu, int G, int tid) {
    unsigned char* ws = a.ws; const bf16* Z = (const bf16*)(ws + WS_ACT); bf16* O = (bf16*)(ws + WS_O);
    const float* ssv = (const float*)(ws + WS_SS) + (size_t)(13 + li) * SS_REC;
    LAS float* vs = (LAS float*)ldsb;
#ifndef WTS
#define WTS 132
#endif
    LAS float* wt = vs + 128 * 128;
    const float* wsg = a.in[I_OWS] + (size_t)li * 16 * 128 * 128; const float* bs = a.in[I_OBS] + li * 16 * 128; const float* vng = a.in[I_OVNG] + li * D;
    int gcur = -1;
    for (int u = vcu; u < 4096; u += G) {
        const int g = u & 15, bn = u >> 4; const size_t m0 = (size_t)bn * 128;
        __syncthreads();
        if (g != gcur) { gcur = g;
            for (int e = tid; e < 128 * 128; e += NTHR) { const int i = e >> 7, j = e & 127; wt[j * WTS + i] = (j <= i) ? wsg[((size_t)g * 128 + i) * 128 + j] : 0.f; } }
        for (int e = tid; e < 128 * 16; e += NTHR) { const int j = e >> 4, c8 = e & 15; const float rs = pg8::row_rs(ssv, (int)(m0 + j));
            const v4u w = *(const GAS v4u*)(Z + (m0 + j) * ZO + 2048 + g * 128 + 8 * c8); f32x4 lo, hi;
            lo.x = bflo(w.x) * rs; lo.y = bfhi(w.x) * rs; lo.z = bflo(w.y) * rs; lo.w = bfhi(w.y) * rs; hi.x = bflo(w.z) * rs; hi.y = bfhi(w.z) * rs; hi.z = bflo(w.w) * rs; hi.w = bfhi(w.w) * rs;
            LAS f32x4* d = (LAS f32x4*)(vs + j * 128 + 8 * c8); d[0] = lo; d[1] = hi; }
        __syncthreads();
        const int c = tid & 127, ib = tid >> 7; const float vg = vng[g * 128 + c];
        for (int ig = 0; ig < 4; ++ig) { const int i0 = 32 * ib + 8 * ig; float acc[8];
#pragma unroll
            for (int r = 0; r < 8; ++r) acc[r] = 0.f;
            for (int j = 0; j < i0 + 8; ++j) { const float vv = vs[j * 128 + c]; const f32x4 w0 = *(const LAS f32x4*)(wt + j * WTS + i0), w1 = *(const LAS f32x4*)(wt + j * WTS + i0 + 4);
                acc[0] += w0.x * vv; acc[1] += w0.y * vv; acc[2] += w0.z * vv; acc[3] += w0.w * vv; acc[4] += w1.x * vv; acc[5] += w1.y * vv; acc[6] += w1.z * vv; acc[7] += w1.w * vv; }
#pragma unroll
            for (int r = 0; r < 8; ++r) { const int i = i0 + r; const float uu = bf2f(Z[(m0 + i) * ZO + g * 128 + c]);
                O[(m0 + i) * D + g * 128 + c] = (bf16)f2bf(uu * (vg * acc[r] + bs[g * 128 + i])); }
        }
    }
    __syncthreads();
}

__device__ __forceinline__ void final_phase(const Args& a, int vcu, int G, int wave, int lane) {
    const int gw = vcu * NWAVES + wave, NGW = G * NWAVES; const float* ss = (const float*)(a.ws + WS_SS) + (size_t)12 * SS_REC; const float* fg = a.in[I_FG];
    for (int m = gw; m < M; m += NGW) { const float rs = pg8::row_rs(ss, m);
        GAS f32x4* xr = (GAS f32x4*)(a.out + (size_t)m * D) + lane; const GAS f32x4* gr = (const GAS f32x4*)fg + lane;
#pragma unroll
        for (int j = 0; j < 8; ++j) { const f32x4 v = xr[64 * j], gg = gr[64 * j]; xr[64 * j] = v * rs * gg; } }
}

__global__ void __launch_bounds__(NTHR, 2) mk_fwd(Args args) {
    extern __shared__ __attribute__((aligned(16))) unsigned char lds_raw[];
    LAS unsigned char* lds = (LAS unsigned char*)lds_raw;
    const int tid = threadIdx.x, lane = tid & 63, wave = __builtin_amdgcn_readfirstlane(tid >> 6);
    const int G = gridDim.x, bx = blockIdx.x; const int vcu = (G % 8 == 0) ? (bx % 8) * (G / 8) + bx / 8 : bx;
    unsigned char* ws = args.ws; gu32* ctl = (gu32*)(ws + WS_CTL);
    for (int u = tid; u < (LDS_BYTES - LDSCTL_OFF) / 4; u += NTHR) ((LAS unsigned*)(lds + LDSCTL_OFF))[u] = 0u;
    __syncthreads();
    const int lo = args.ph_lo, hi = args.ph_hi;
    const bool multi = (hi - lo) > 1;
    XcdBarrier bar; bar.bar = (unsigned*)(ctl + CW_BAR); bar.x = 0; bar.st = nullptr;
    if (multi) bar = xcd_barrier_post((unsigned*)(ctl + CW_BAR), (volatile LAS unsigned*)(lds + LDSCTL_OFF));
#define IN(k) (lo <= (k) && (k) < hi)
#define SEAM(k) do { if ((k) + 1 < hi) xcd_barrier(bar); } while (0)
    float* ssb = (float*)(ws + WS_SS);
    bf16* XB = (bf16*)(ws + WS_XB); bf16* ACT = (bf16*)(ws + WS_ACT); bf16* OB = (bf16*)(ws + WS_O);

    for (int s = 0; s < NSUB; ++s) {
        const int pb = s * 8, L = s / 3, kind = s % 3, li = L >> 1; const bool even = !(L & 1);
        #ifndef NO_PREP
        if (kind == 0 && IN(pb + 0)) { { const int t_ = opaque(tid); prep_phase(args, L, lds, vcu, G, __builtin_amdgcn_readfirstlane(t_ >> 6), t_ & 63); } SEAM(pb + 0); }
#endif
        if (IN(pb + 1)) {
            const float* ss = ssb + (size_t)s * SS_REC;
            if (kind != 1) {
                pg8::Gemm g{XB, (const bf16*)(ws + (kind == 0 ? WT_GU1 : WT_GU2)), M, 2 * FF, D}; pg8::StaticOrder S; S.init(M, 2 * FF, G, bx);
                pg8::EpiSwiGLU E{ACT, FF, ss};
#ifndef NO_G1
                pg8::gemm_phase<pg8::EpiSwiGLU, pg8::StaticOrder, true, true>(lds, g, S, E);
#endif
            } else if (even) {
                pg8::Gemm g{XB, (const bf16*)(ws + WT_IN), M, ZN, D}; pg8::StaticOrder S; S.init(M, ZN, G, bx);
                pg8::EpiZ E{ACT, ZN, ss, args.in[I_EBQKV] + li * 1536};
#ifndef NO_GZ
                pg8::gemm_phase<pg8::EpiZ, pg8::StaticOrder, true, true>(lds, g, S, E);
#endif
            } else {
                pg8::Gemm g{XB, (const bf16*)(ws + WT_IN), M, ZO, D}; pg8::StaticOrder S; S.init(M, ZO, G, bx);
                pg8::EpiGeluV E{ACT, ZO, ss, ssb + (size_t)(13 + li) * SS_REC, (LAS float*)(lds + 131072)};
#ifndef NO_GG
                pg8::gemm_phase<pg8::EpiGeluV, pg8::StaticOrder, true, true>(lds, g, S, E);
#endif
            }
            SEAM(pb + 1);
        }
        if (kind == 1) {
            if (IN(pb + 2)) {
#ifndef NO_E1
                if (even) e1_phase(args, li, lds, vcu, G, opaque(tid));
#endif
#ifndef NO_SGU
                if (!even) sgu_phase(args, li, lds, vcu, G, opaque(tid));
#endif
                SEAM(pb + 2); }
            if (even && IN(pb + 3)) {
                const int xcd = bx & 7, slot = bx >> 3; const bool split = (G == 256);
                const int s0 = split ? (slot < 16 ? xcd * 16 + slot : 128) : vcu, sstr = split ? 128 : G;
#ifndef NO_SCAN
                for (int su = s0; su < 128; su += sstr) scan_unit(args, li, su, lds, opaque(tid));
#endif
                const int a0 = split ? (slot >= 16 ? xcd * 16 + slot - 16 : 1024) : vcu, astr = split ? 128 : G;
#ifndef NO_ATTN
                for (int au = a0; au < 1024; au += astr) attn_unit(args, li, au, lds, opaque(tid));
#endif
                SEAM(pb + 3);
            }
#ifndef NO_E3
            if (even && IN(pb + 4)) { e3_phase(args, li, vcu, G, opaque(tid)); SEAM(pb + 4); }
#endif
        }
        if (IN(pb + 5)) {
            const bf16* A = (kind == 1) ? OB : ACT; const int K = (kind == 1) ? D : FF;
            const bf16* Bt = (const bf16*)(ws + (kind == 0 ? WT_D1 : kind == 1 ? WT_OUT : WT_D2));
            pg8::Gemm g{A, Bt, M, D, K}; pg8::StaticOrder S; S.init(M, D, G, bx);
            pg8::EpiResid E{s == 0 ? args.in[I_X] : args.out, args.out, XB, ssb + (size_t)(s + 1) * SS_REC, kind == 1 ? 1.0f : 0.5f, (LAS float*)(lds + 131072)};
#ifndef NO_GR
            pg8::gemm_phase<pg8::EpiResid, pg8::StaticOrder, true, true>(lds, g, S, E);
#endif
            SEAM(pb + 5);
        }
    }
    if (IN(NSUB * 8)) { const int t_ = opaque(tid); final_phase(args, vcu, G, __builtin_amdgcn_readfirstlane(t_ >> 6), t_ & 63); }
#undef IN
#undef SEAM
}

extern "C" void kernel_launch(void* const* d_in, const int* in_sizes, int n_in, void* d_out, int out_size, void* d_ws, size_t ws_size, hipStream_t stream) {
    static int grid = 0;
    if (grid == 0) {
        if (n_in != 29 || out_size != M * D || ws_size < WS_END) { fprintf(stderr, "kernel_launch: unexpected shapes (n_in %d, out %d, ws %zu < %zu); nothing launched\n", n_in, out_size, ws_size, (size_t)WS_END); grid = -1; return; }
        int dev = 0, cus = 0;
        if (hipGetDevice(&dev) != hipSuccess || hipDeviceGetAttribute(&cus, hipDeviceAttributeMultiprocessorCount, dev) != hipSuccess) { grid = -1; return; }
        if (hipFuncSetAttribute((const void*)mk_fwd, hipFuncAttributeMaxDynamicSharedMemorySize, LDS_BYTES) != hipSuccess) { fprintf(stderr, "kernel_launch: hipFuncSetAttribute failed\n"); grid = -1; return; }
        int per_cu = 0;
        if (hipOccupancyMaxActiveBlocksPerMultiprocessor(&per_cu, (const void*)mk_fwd, NTHR, LDS_BYTES) != hipSuccess || per_cu < 1) fprintf(stderr, "kernel_launch: occupancy query says %d\n", per_cu);
        (void)hipGetLastError();
        grid = cus;
    }
    if (grid < 0) return;
    (void)hipMemsetAsync((char*)d_ws + WS_CTL, 0, CTL_ZERO_BYTES, stream);
    Args a{};
    for (int i = 0; i < 29; ++i) a.in[i] = (const float*)d_in[i];
    a.out = (float*)d_out; a.ws = (unsigned char*)d_ws;
#if MK_ONE_LAUNCH
    a.ph_lo = 0; a.ph_hi = NSUB * 8 + 1;
    hipLaunchKernelGGL(mk_fwd, dim3(grid), dim3(NTHR), LDS_BYTES, stream, a);
#else
    for (int s = 0; s <= NSUB; ++s) {
        for (int k = 0; k < (s == NSUB ? 1 : 8); ++k) {
            const int L = s / 3, kind = s % 3; const bool even = !(L & 1);
            bool live;
            if (s == NSUB) live = true;
            else if (k == 0) live = (kind == 0);
            else if (k == 1 || k == 5) live = true;
            else if (k == 2) live = (kind == 1);
            else if (k == 3 || k == 4) live = (kind == 1) && even;
            else live = false;
            if (!live) continue;
            a.ph_lo = s * 8 + k; a.ph_hi = a.ph_lo + 1;
            hipLaunchKernelGGL(mk_fwd, dim3(grid), dim3(NTHR), LDS_BYTES, stream, a);
        }
    }
#endif
}
```

```cpp
#include <hip/hip_runtime.h>
#include <cstdio>
#include <cstdint>
#define MK_ONE_LAUNCH 1
namespace pg8 {
#define PG8_LAS __attribute__((address_space(3)))
typedef unsigned short bf16_t;
typedef short bf16x8 __attribute__((ext_vector_type(8)));
typedef float f32x4 __attribute__((ext_vector_type(4)));
typedef unsigned u32x4 __attribute__((ext_vector_type(4)));
constexpr int BM = 256, BK = 64, HALF = 128, HTB = HALF * BK * 2  , STAGE_BYTES = 8 * HTB, NXCD = 8, WGM = 8;

__host__ __device__ __forceinline__ int lds_byte(int r, int c) { const int st = (r >> 4) * 2 + (c >> 5), rr = r & 15, cc = c & 31, ob = rr * 64 + cc * 2; return st * 1024 + (ob ^ (((ob >> 9) & 1) << 5)); }
__host__ __device__ __forceinline__ void stage_rc(int b, int& R, int& C) { const int st = b / 1024, sb = b % 1024, swz = sb ^ (((sb >> 9) & 1) << 5); R = (st >> 1) * 16 + swz / 64; C = (st & 1) * 32 + (swz % 64) / 2; }
__host__ __device__ __forceinline__ int perm32(int rho) { const int n = rho >> 4, i = rho & 15; return 8 * (i >> 2) + 4 * n + (i & 3); }

struct Unit { int pm, pn; };
struct Gemm { const bf16_t* A; const bf16_t* Bt; int M, N, K; };

struct StaticOrder {
    int nM, nN, nwg, G, c;
    __host__ __device__ void init(int M, int N, int G_, int c_) { nM = M / BM; nN = N / BM; nwg = nM * nN; G = G_; c = c_; }
    __host__ __device__ bool next(int i, Unit& u) const {
        const long L = (long)i * G + c; if (L >= nwg) return false;
        int wgid = (int)L; { const int q = nwg / NXCD, r = nwg % NXCD, xcd = wgid % NXCD, off = wgid / NXCD; wgid = (xcd < r ? xcd * (q + 1) : r * (q + 1) + (xcd - r) * q) + off; }
        const int nig = WGM * nN, gid = wgid / nig, fm = gid * WGM, gsz = (nM - fm) < WGM ? (nM - fm) : WGM;
        u.pm = fm + ((wgid % nig) % gsz); u.pn = (wgid % nig) / gsz; return true;
    }
    __device__ __forceinline__ void a_ready(const Unit&) const {}
    __device__ __forceinline__ void done(const Unit&) const {}
};
__device__ __forceinline__ unsigned cvt_pk_bf16(float lo, float hi) { unsigned r; asm volatile("v_cvt_pk_bf16_f32 %0, %1, %2" : "=v"(r) : "v"(lo), "v"(hi)); return r; }
typedef float f32x2 __attribute__((ext_vector_type(2)));
__device__ __forceinline__ f32x2 gelu_pk(f32x2 v) {
    const f32x2 av = __builtin_elementwise_abs(v), d = av * 0.2316418882f + 1.0f;
    f32x2 t; t.x = __builtin_amdgcn_rcpf(d.x); t.y = __builtin_amdgcn_rcpf(d.y);
    f32x2 q = t * 0.5307027145f + (-0.7265760135f); q = q * t + 0.7107068705f; q = q * t + (-0.142248368f); q = q * t + 0.127414796f; q = q * t;
    const f32x2 s = (v * v) * (-0.72134752044f);
    f32x2 e; e.x = __builtin_amdgcn_exp2f(s.x); e.y = __builtin_amdgcn_exp2f(s.y);
    const f32x2 m = v * (q * e), r = v - m;
    f32x2 o; o.x = v.x < 0.f ? m.x : r.x; o.y = v.y < 0.f ? m.y : r.y; return o;
}

constexpr int SS_M = 32768;
__device__ __forceinline__ float row_rs(const float* P, int row) {
    const float s = ((P[row] + P[SS_M + row]) + (P[2 * SS_M + row] + P[3 * SS_M + row])) + ((P[4 * SS_M + row] + P[5 * SS_M + row]) + (P[6 * SS_M + row] + P[7 * SS_M + row]));
    return rsqrtf(s * (1.0f / 2048.0f) + 1e-6f);
}
struct EpiSwiGLU {
    static constexpr bool PERM = true, AFTER_DRAIN = false;
    bf16_t* O; int ldc; const float* ss;
    __device__ __forceinline__ void operator()(const f32x4 (&acc)[2][2][4][2], const Unit& u, int wr, int wc, int fr, int fq) const {
        const int row0 = u.pm * BM + wr * 64 + fr, col0 = u.pn * HALF + wc * 32 + 8 * fq;
#pragma unroll
        for (int ai = 0; ai < 2; ++ai)
#pragma unroll
            for (int m = 0; m < 4; ++m) {
                const int row = row0 + ai * HALF + m * 16;
                const float rs = row_rs(ss, row);
                float o[8];
#pragma unroll
                for (int n = 0; n < 2; ++n)
#pragma unroll
                    for (int j = 0; j < 4; ++j) { const float g = acc[ai][0][m][n][j] * rs, up = acc[ai][1][m][n][j] * rs; o[4 * n + j] = g * __builtin_amdgcn_rcpf(1.0f + __expf(-g)) * up; }
                u32x4 w; w.x = cvt_pk_bf16(o[0], o[1]); w.y = cvt_pk_bf16(o[2], o[3]); w.z = cvt_pk_bf16(o[4], o[5]); w.w = cvt_pk_bf16(o[6], o[7]);
                *(u32x4*)(O + (size_t)row * ldc + col0) = w;
                asm volatile("" ::: "memory");
            }
    }
};
struct EpiResid {
    static constexpr bool PERM = false, AFTER_DRAIN = false;
    const float* base; float* out; bf16_t* xb; float* ssn; float scale; PG8_LAS float* sp;
    __device__ __forceinline__ void operator()(const f32x4 (&acc)[2][2][4][2], const Unit& u, int wr, int wc, int fr, int fq) const {
        const int row0 = u.pm * BM + wr * 64 + fr, col0 = u.pn * BM + wc * 32 + 4 * fq;
        typedef unsigned u32x2v __attribute__((ext_vector_type(2)));
#pragma unroll
        for (int ai = 0; ai < 2; ++ai)
#pragma unroll
            for (int m = 0; m < 4; ++m) {
                const int row = row0 + ai * HALF + m * 16; const size_t off = (size_t)row * 2048 + col0; float s = 0.f;
#pragma unroll
                for (int bj = 0; bj < 2; ++bj)
#pragma unroll
                    for (int n = 0; n < 2; ++n) {
                        const f32x4 bs = *(const f32x4*)(base + off + bj * HALF + n * 16);
                        const f32x4 o = bs + acc[ai][bj][m][n] * scale;
                        *(f32x4*)(out + off + bj * HALF + n * 16) = o;
                        u32x2v w; w.x = cvt_pk_bf16(o[0], o[1]); w.y = cvt_pk_bf16(o[2], o[3]);
                        *(u32x2v*)(xb + off + bj * HALF + n * 16) = w;
                        s += (o[0] * o[0] + o[1] * o[1]) + (o[2] * o[2] + o[3] * o[3]);
                    }
                s += __shfl_xor(s, 16); s += __shfl_xor(s, 32);
                if (fq == 0) sp[(ai * HALF + wr * 64 + m * 16 + fr) * 4 + wc] = s;
                asm volatile("" ::: "memory");
            }
        asm volatile("s_waitcnt lgkmcnt(0)" ::: "memory"); __builtin_amdgcn_s_barrier(); asm volatile("" ::: "memory");
        const int t = (wr * 4 + wc) * 64 + fq * 16 + fr;
        if (t < BM) { const f32x4 p = *(const PG8_LAS f32x4*)(sp + t * 4); ssn[(size_t)u.pn * SS_M + u.pm * BM + t] = (p[0] + p[1]) + (p[2] + p[3]); }
    }
};
struct EpiZ {
    static constexpr bool PERM = true, AFTER_DRAIN = false;
    bf16_t* O; int ldc; const float* ss; const float* bias;
    __device__ __forceinline__ void operator()(const f32x4 (&acc)[2][2][4][2], const Unit& u, int wr, int wc, int fr, int fq) const {
        const int row0 = u.pm * BM + wr * 64 + fr, col0 = u.pn * BM + wc * 32 + 8 * fq;
        const bool hb = u.pn < 6;
        f32x4 bv[2][2];
#pragma unroll
        for (int bj = 0; bj < 2; ++bj)
#pragma unroll
            for (int n = 0; n < 2; ++n) bv[bj][n] = hb ? *(const f32x4*)(bias + col0 + bj * HALF + 4 * n) : (f32x4){0.f, 0.f, 0.f, 0.f};
#pragma unroll
        for (int ai = 0; ai < 2; ++ai)
#pragma unroll
            for (int m = 0; m < 4; ++m) {
                const int row = row0 + ai * HALF + m * 16;
                const float rs = row_rs(ss, row);
                bf16_t* rowp = O + (size_t)row * ldc + col0;
#pragma unroll
                for (int bj = 0; bj < 2; ++bj) {
                    const f32x4 v0 = acc[ai][bj][m][0] * rs + bv[bj][0], v1 = acc[ai][bj][m][1] * rs + bv[bj][1];
                    u32x4 w; w.x = cvt_pk_bf16(v0[0], v0[1]); w.y = cvt_pk_bf16(v0[2], v0[3]); w.z = cvt_pk_bf16(v1[0], v1[1]); w.w = cvt_pk_bf16(v1[2], v1[3]);
                    *(u32x4*)(rowp + bj * HALF) = w;
                }
                asm volatile("" ::: "memory");
            }
    }
};
struct EpiGeluV {
    static constexpr bool PERM = true, AFTER_DRAIN = false;
    bf16_t* O; int ldc; const float* ss; float* ssv; PG8_LAS float* sp;
    __device__ __forceinline__ void operator()(const f32x4 (&acc)[2][2][4][2], const Unit& u, int wr, int wc, int fr, int fq) const {
        const int row0 = u.pm * BM + wr * 64 + fr, col0 = u.pn * BM + wc * 32 + 8 * fq;
        const bool isv = u.pn >= 8;
#pragma unroll
        for (int ai = 0; ai < 2; ++ai)
#pragma unroll
            for (int m = 0; m < 4; ++m) {
                const int row = row0 + ai * HALF + m * 16;
                const float rs = row_rs(ss, row);
                bf16_t* rowp = O + (size_t)row * ldc + col0; float s = 0.f;
#pragma unroll
                for (int bj = 0; bj < 2; ++bj) {
                    f32x4 v0 = acc[ai][bj][m][0] * rs, v1 = acc[ai][bj][m][1] * rs;
                    const f32x2 a = gelu_pk((f32x2){v0[0], v0[1]}), b = gelu_pk((f32x2){v0[2], v0[3]}), c = gelu_pk((f32x2){v1[0], v1[1]}), d = gelu_pk((f32x2){v1[2], v1[3]});
                    s += (a.x * a.x + a.y * a.y) + (b.x * b.x + b.y * b.y) + (c.x * c.x + c.y * c.y) + (d.x * d.x + d.y * d.y);
                    u32x4 w; w.x = cvt_pk_bf16(a.x, a.y); w.y = cvt_pk_bf16(b.x, b.y); w.z = cvt_pk_bf16(c.x, c.y); w.w = cvt_pk_bf16(d.x, d.y);
                    *(u32x4*)(rowp + bj * HALF) = w;
                }
                if (isv) { s += __shfl_xor(s, 16); s += __shfl_xor(s, 32); if (fq == 0) sp[(ai * HALF + wr * 64 + m * 16 + fr) * 4 + wc] = s; }
                asm volatile("" ::: "memory");
            }
        if (isv) {
            asm volatile("s_waitcnt lgkmcnt(0)" ::: "memory"); __builtin_amdgcn_s_barrier(); asm volatile("" ::: "memory");
            const int t = (wr * 4 + wc) * 64 + fq * 16 + fr;
            if (t < BM) { const f32x4 p = *(const PG8_LAS f32x4*)(sp + t * 4); ssv[(size_t)(u.pn - 8) * SS_M + u.pm * BM + t] = (p[0] + p[1]) + (p[2] + p[3]); }
        }
    }
};
template <class Epi, class Sched, bool ALIGN_EPI = false, bool SP2 = false>
__device__ __forceinline__ void gemm_phase(PG8_LAS unsigned char* lds, const Gemm g, const Sched& S, const Epi& E) {
    int tid_ = threadIdx.x; asm volatile("" : "+v"(tid_));
    const int tid = tid_, wid = __builtin_amdgcn_readfirstlane(tid >> 6), lane = tid & 63, wr = wid >> 2, wc = wid & 3, fr = lane & 15, fq = lane >> 4;
    const int K = g.K, nt = K / BK;
    unsigned voffA[2], voffB[2];
#pragma unroll
    for (int i = 0; i < 2; ++i) { int R, C; stage_rc(tid * 16 + i * 8192, R, C); const int Rb = Epi::PERM ? ((R & ~31) + perm32(R & 31)) : R;
        voffA[i] = (unsigned)(R * K + C) * 2u; voffB[i] = (unsigned)(Rb * K + C) * 2u; }
    const size_t kstep = (size_t)(BK * 2);
    const size_t hstep = (size_t)HALF * K * 2;
    const size_t tstep = 2 * hstep;
    const unsigned ldsw = (unsigned)wid * 1024u;
    const int aoff = lds_byte(wr * 64 + fr, fq * 8), boff = lds_byte(wc * 32 + fr, fq * 8);
#define PG8_SA(b, h) (((b) * 2 + (h)) * HTB)
#define PG8_SB(b, h) ((4 + (b) * 2 + (h)) * HTB)
#define PG8_STAGE(bufoff, gbase, voff) do { _Pragma("unroll") for (int _i = 0; _i < 2; ++_i) \
        __builtin_amdgcn_global_load_lds((const unsigned*)((const char*)(gbase) + (voff)[_i]), (PG8_LAS unsigned*)(lds + (bufoff) + ldsw + _i * 8192), 16, 0, 0); } while (0)
#define PG8_LDA(dst, b, h) do { _Pragma("unroll") for (int m = 0; m < 4; ++m) _Pragma("unroll") for (int k = 0; k < 2; ++k) dst[m][k] = *(const PG8_LAS bf16x8*)(lds + PG8_SA(b, h) + aoff + m * 2048 + k * 1024); } while (0)
#define PG8_LDB(dst, b, h) do { _Pragma("unroll") for (int n = 0; n < 2; ++n) _Pragma("unroll") for (int k = 0; k < 2; ++k) dst[n][k] = *(const PG8_LAS bf16x8*)(lds + PG8_SB(b, h) + boff + n * 2048 + k * 1024); } while (0)
#define PG8_MMA(ai, bj, At, Bt) do { __builtin_amdgcn_s_setprio(1); _Pragma("unroll") for (int m = 0; m < 4; ++m) _Pragma("unroll") for (int n = 0; n < 2; ++n) _Pragma("unroll") for (int k = 0; k < 2; ++k) \
        acc[ai][bj][m][n] = __builtin_amdgcn_mfma_f32_16x16x32_bf16(Bt[n][k], At[m][k], acc[ai][bj][m][n], 0, 0, 0); __builtin_amdgcn_s_setprio(0); } while (0)
#define PG8_WAIT_V(n) asm volatile("s_waitcnt vmcnt(" #n ")" ::: "memory")
#define PG8_WAIT_L(n) asm volatile("s_waitcnt lgkmcnt(" #n ")" ::: "memory")
#define PG8_BAR __builtin_amdgcn_s_barrier()
#define PG8_SCHED __builtin_amdgcn_sched_barrier(0)
    Unit cur, nxt; int ui = 0;
    if (!S.next(0, cur)) return;
    f32x4 acc[2][2][4][2];
#pragma unroll
    for (int a = 0; a < 2; ++a)
#pragma unroll
        for (int b = 0; b < 2; ++b)
#pragma unroll
            for (int m = 0; m < 4; ++m)
#pragma unroll
                for (int n = 0; n < 2; ++n) acc[a][b][m][n] = (f32x4){0.f, 0.f, 0.f, 0.f};
    bf16x8 At[4][2], B0[2][2], B1[2][2];
    const char* cA = (const char*)g.A + (size_t)cur.pm * tstep; const char* cB = (const char*)g.Bt + (size_t)cur.pn * tstep;
    S.a_ready(cur);
    if constexpr (SP2) {
        PG8_STAGE(PG8_SB(0, 0), cB, voffB); PG8_STAGE(PG8_SB(0, 1), cB + hstep, voffB); PG8_STAGE(PG8_SA(0, 0), cA, voffA); PG8_STAGE(PG8_SA(0, 1), cA + hstep, voffA);
        if (wr == 1) PG8_BAR;
        PG8_WAIT_V(2); PG8_BAR;
        PG8_STAGE(PG8_SB(1, 0), cB + kstep, voffB); PG8_STAGE(PG8_SA(1, 0), cA + kstep, voffA); PG8_STAGE(PG8_SB(1, 1), cB + hstep + kstep, voffB);
        PG8_WAIT_V(6); PG8_BAR;
    } else {
        PG8_STAGE(PG8_SB(0, 0), cB, voffB); PG8_STAGE(PG8_SA(0, 0), cA, voffA); PG8_STAGE(PG8_SB(0, 1), cB + hstep, voffB); PG8_STAGE(PG8_SA(0, 1), cA + hstep, voffA);
        if (wr == 1) PG8_BAR;
        PG8_WAIT_V(4); PG8_BAR;
        PG8_STAGE(PG8_SB(1, 0), cB + kstep, voffB); PG8_STAGE(PG8_SA(1, 0), cA + kstep, voffA); PG8_STAGE(PG8_SB(1, 1), cB + hstep + kstep, voffB);
        PG8_WAIT_V(6); PG8_BAR;
    }
    for (;;) {
        const bool has_next = S.next(ui + 1, nxt);
        const char* nA = has_next ? (const char*)g.A + (size_t)nxt.pm * tstep : cA; const char* nB = has_next ? (const char*)g.Bt + (size_t)nxt.pn * tstep : cB;
        for (int t = 0; t < nt; t += 2) {
            const bool last = (t == nt - 2);
            const char* a1 = cA + (size_t)(t + 1) * kstep;
            const char* a2 = last ? nA : cA + (size_t)(t + 2) * kstep; const char* b2 = last ? nB : cB + (size_t)(t + 2) * kstep;
            const char* a3 = a2 + kstep; const char* b3 = b2 + kstep;
            if (last && has_next) S.a_ready(nxt);
            if constexpr (SP2) {
            PG8_LDB(B0, 0, 0); PG8_LDB(B1, 0, 1); PG8_SCHED; PG8_LDA(At, 0, 0); PG8_STAGE(PG8_SA(1, 1), a1 + hstep, voffA);
            PG8_WAIT_V(8); PG8_WAIT_L(0); PG8_BAR; PG8_MMA(0, 0, At, B0); PG8_MMA(0, 1, At, B1); PG8_BAR; PG8_SCHED;
            PG8_LDA(At, 0, 1); PG8_STAGE(PG8_SB(0, 0), b2, voffB); PG8_STAGE(PG8_SB(0, 1), b2 + hstep, voffB); PG8_STAGE(PG8_SA(0, 0), a2, voffA);
            PG8_WAIT_V(8); PG8_WAIT_L(0); PG8_BAR; PG8_MMA(1, 0, At, B0); PG8_MMA(1, 1, At, B1); PG8_BAR; PG8_SCHED;
            PG8_LDB(B0, 1, 0); PG8_LDB(B1, 1, 1); PG8_SCHED; PG8_LDA(At, 1, 0); PG8_STAGE(PG8_SA(0, 1), a2 + hstep, voffA);
            PG8_WAIT_V(8); PG8_WAIT_L(0); PG8_BAR; PG8_MMA(0, 0, At, B0); PG8_MMA(0, 1, At, B1); PG8_BAR; PG8_SCHED;
            PG8_LDA(At, 1, 1); PG8_STAGE(PG8_SB(1, 0), b3, voffB); PG8_STAGE(PG8_SB(1, 1), b3 + hstep, voffB); PG8_STAGE(PG8_SA(1, 0), a3, voffA);
            PG8_WAIT_V(8); PG8_WAIT_L(0); PG8_BAR; PG8_MMA(1, 0, At, B0); PG8_MMA(1, 1, At, B1); PG8_BAR; PG8_SCHED;
            } else {
            PG8_LDB(B0, 0, 0); PG8_SCHED; PG8_LDA(At, 0, 0); PG8_STAGE(PG8_SA(1, 1), a1 + hstep, voffA);
            PG8_WAIT_L(8); PG8_BAR; PG8_WAIT_L(0); PG8_MMA(0, 0, At, B0); PG8_BAR; PG8_SCHED;
            PG8_LDB(B1, 0, 1); PG8_STAGE(PG8_SB(0, 0), b2, voffB);
            PG8_BAR; PG8_WAIT_L(0); PG8_MMA(0, 1, At, B1); PG8_BAR;
            PG8_LDA(At, 0, 1); PG8_STAGE(PG8_SA(0, 0), a2, voffA);
            PG8_BAR; PG8_WAIT_L(0); PG8_MMA(1, 0, At, B0); PG8_BAR; PG8_SCHED;
            PG8_STAGE(PG8_SB(0, 1), b2 + hstep, voffB);
            PG8_WAIT_V(6); PG8_BAR; PG8_MMA(1, 1, At, B1); PG8_BAR;
            PG8_LDB(B0, 1, 0); PG8_SCHED; PG8_LDA(At, 1, 0); PG8_STAGE(PG8_SA(0, 1), a2 + hstep, voffA);
            PG8_WAIT_L(8); PG8_BAR; PG8_WAIT_L(0); PG8_MMA(0, 0, At, B0); PG8_BAR; PG8_SCHED;
            PG8_LDB(B1, 1, 1); PG8_STAGE(PG8_SB(1, 0), b3, voffB);
            PG8_BAR; PG8_WAIT_L(0); PG8_MMA(0, 1, At, B1); PG8_BAR;
            PG8_LDA(At, 1, 1); PG8_STAGE(PG8_SA(1, 0), a3, voffA);
            PG8_BAR; PG8_WAIT_L(0); PG8_MMA(1, 0, At, B0); PG8_BAR; PG8_SCHED;
            PG8_STAGE(PG8_SB(1, 1), b3 + hstep, voffB);
            PG8_WAIT_V(6); PG8_BAR; PG8_MMA(1, 1, At, B1); PG8_BAR;
            }
        }
        if constexpr (ALIGN_EPI) { if (wr == 0) PG8_BAR; }
        if constexpr (!Epi::AFTER_DRAIN) { E(acc, cur, wr, wc, fr, fq); S.done(cur); }
        if (!has_next) break;
#pragma unroll
        for (int a = 0; a < 2; ++a)
#pragma unroll
            for (int b = 0; b < 2; ++b)
#pragma unroll
                for (int m = 0; m < 4; ++m)
#pragma unroll
                    for (int n = 0; n < 2; ++n) acc[a][b][m][n] = (f32x4){0.f, 0.f, 0.f, 0.f};
        cur = nxt; cA = nA; cB = nB; ++ui;
        if constexpr (ALIGN_EPI) { if (wr == 1) PG8_BAR; }
    }
    PG8_WAIT_V(0);
    if constexpr (!ALIGN_EPI) { if (wr == 0) PG8_BAR; }
    PG8_BAR;
    if constexpr (Epi::AFTER_DRAIN) { E.fused(acc, cur, wr, wc, fr, fq, lds, wid, lane); S.done(cur); }
#undef PG8_SA
#undef PG8_SB
#undef PG8_STAGE
#undef PG8_LDA
#undef PG8_LDB
#undef PG8_MMA
#undef PG8_WAIT_V
#undef PG8_WAIT_L
#undef PG8_BAR
#undef PG8_SCHED
}
}
#define LAS_BAR __attribute__((address_space(3)))
#define XB_TMO      128
#define XB_XCNT(j)  (256  + 64 * (j))
#define XB_XSUB(j)  (1280 + 64 * (j))
#define XB_XGEN(j)  (2304 + 64 * (j))
#define XB_TOP      3328
#define XB_TOPGEN   3392
#define XCD_BAR_WORDS 3456
#define XB_SPIN_CAP (1u << 22)

__device__ __forceinline__ unsigned xb_ld(unsigned* p)              { return __hip_atomic_load(p, __ATOMIC_RELAXED, __HIP_MEMORY_SCOPE_AGENT); }
__device__ __forceinline__ unsigned xb_add(unsigned* p, unsigned v) { return __hip_atomic_fetch_add(p, v, __ATOMIC_RELAXED, __HIP_MEMORY_SCOPE_AGENT); }
__device__ __forceinline__ unsigned xb_xcc_id() { return (unsigned)__builtin_amdgcn_s_getreg((3 << 11) | 20) & 0xFu; }
#define XB_SPIN(cond, bar) do { unsigned _sp = 0; while (cond) { __builtin_amdgcn_s_sleep(1); \
    if ((++_sp & 255u) == 0u) { if (xb_ld(&(bar)[XB_TMO])) break; if (_sp > XB_SPIN_CAP) { atomicAdd(&(bar)[XB_TMO], 1u); break; } } } } while (0)

struct XcdBarrier {
    unsigned* bar; unsigned x;
    volatile LAS_BAR unsigned* st;
};

__device__ __forceinline__ XcdBarrier xcd_barrier_post(unsigned* bar, volatile LAS_BAR unsigned* st) {
    XcdBarrier b; b.bar = bar; b.x = xb_xcc_id(); b.st = st;
    if (threadIdx.x == 0) (void)xb_add(&bar[XB_XCNT(b.x)], 1u);
    return b;
}
__device__ __forceinline__ void xcd_barrier_complete(unsigned* bar, unsigned x, unsigned& nloc, unsigned& nx) {
    const unsigned G = gridDim.x * gridDim.y * gridDim.z;
    unsigned sum, cnt, mine, sp = 0u;
    for (;;) {
        sum = 0u; cnt = 0u; mine = 0u;
#pragma unroll
        for (unsigned j = 0; j < 16; ++j) { const unsigned c = xb_ld(&bar[XB_XCNT(j)]); sum += c; cnt += (c > 0u) ? 1u : 0u; mine = (j == x) ? c : mine; }
        if (sum == G) break;
        __builtin_amdgcn_s_sleep(1);
        if ((++sp & 255u) == 0u) { if (xb_ld(&bar[XB_TMO])) break; if (sp > XB_SPIN_CAP) { atomicAdd(&bar[XB_TMO], 1u); break; } }
    }
    nloc = mine > 0u ? mine : 1u; nx = cnt > 0u ? cnt : 1u;
}

__device__ __forceinline__ void xcd_barrier(const XcdBarrier& b) {
    asm volatile("s_waitcnt vmcnt(0)" ::: "memory");
    __syncthreads();
    if (threadIdx.x == 0) {
        unsigned* bar = b.bar;
        __builtin_amdgcn_s_waitcnt(0);
        unsigned nloc = b.st[0], nx = b.st[1];
        if (nloc == 0u) { xcd_barrier_complete(bar, b.x, nloc, nx); b.st[0] = nloc; b.st[1] = nx; }
        const unsigned old = xb_add(&bar[XB_XSUB(b.x)], 1u);
        const unsigned gen = old / nloc;
        if (old + 1u == (gen + 1u) * nloc) {
            __builtin_amdgcn_fence(__ATOMIC_RELEASE, "agent");
            asm volatile("s_waitcnt vmcnt(0)" ::: "memory");
            const unsigned og = xb_add(&bar[XB_TOP], 1u);
            const unsigned tg = og / nx;
            if (og + 1u == (tg + 1u) * nx) xb_add(&bar[XB_TOPGEN], 1u);
            else XB_SPIN(xb_ld(&bar[XB_TOPGEN]) == tg, bar);
            __builtin_amdgcn_fence(__ATOMIC_ACQUIRE, "agent");
            xb_add(&bar[XB_XGEN(b.x)], 1u);
            asm volatile("s_waitcnt vmcnt(0)" ::: "memory");
        } else {
            XB_SPIN(xb_ld(&bar[XB_XGEN(b.x)]) == gen, bar);
            __builtin_amdgcn_fence(__ATOMIC_ACQUIRE, "agent");
            asm volatile("s_waitcnt vmcnt(0)" ::: "memory");
        }
    }
    __syncthreads();
}

constexpr int NWAVES = 8, NTHR = 512;
constexpr int BATCH = 2, T = 16384, D = 2048, FF = 5632, M = BATCH * T;
constexpr int ZN = 5120;
constexpr int ZA = 1536;
constexpr int A_COLS = 3360, E_IN = 4896;
constexpr int ZO = 4096;
constexpr int NSUB = 12;
#ifndef MK_ONE_LAUNCH
#define MK_ONE_LAUNCH 0
#endif

constexpr size_t MiB = 1u << 20;
constexpr size_t WS_CTL = 0, CTL_ZERO_BYTES = 1 * MiB;
constexpr size_t WS_SS = 1 * MiB;
constexpr size_t SS_REC = 8 * (size_t)M;
constexpr size_t WS_WT = 16 * MiB;
constexpr size_t WT_GU1 = WS_WT, WT_D1 = WT_GU1 + 44 * MiB, WT_GU2 = WT_D1 + 22 * MiB, WT_D2 = WT_GU2 + 44 * MiB, WT_IN = WT_D2 + 22 * MiB, WT_OUT = WT_IN + 20 * MiB;
constexpr size_t WS_XB = WT_OUT + 8 * MiB;
constexpr size_t WS_ACT = WS_XB + 128 * MiB;
constexpr size_t WS_SC = WS_ACT + 352 * MiB;
constexpr size_t SC_R = WS_SC, SC_K2 = SC_R + 64 * MiB, SC_KK = SC_K2 + 64 * MiB, SC_BB = SC_KK + 64 * MiB, SC_LW = SC_BB + 64 * MiB, SC_GG = SC_LW + 64 * MiB;
constexpr size_t WS_VF = SC_GG + 64 * MiB;
constexpr size_t WS_V2 = WS_VF + 64 * MiB;
constexpr size_t WS_O = WS_V2 + 64 * MiB;
constexpr size_t WS_END = WS_O + 128 * MiB;
static_assert(WT_OUT + 8 * MiB == 176 * MiB && WS_SS + 15 * MiB <= WS_WT, "weight map");
constexpr int CW_TMO = 0, CW_CODE = 1, CW_BAR = 4096;

constexpr int LDS_BYTES = 147456, LDSCTL_OFF = LDS_BYTES - 512;

#define GAS __attribute__((address_space(1)))
#define LAS __attribute__((address_space(3)))
typedef unsigned short bf16;
typedef unsigned v4u __attribute__((ext_vector_type(4)));
typedef unsigned v2u __attribute__((ext_vector_type(2)));
typedef float f32x4 __attribute__((ext_vector_type(4)));
typedef float f32x2 __attribute__((ext_vector_type(2)));
typedef GAS unsigned gu32;
#define RLX_AGENT __ATOMIC_RELAXED, __HIP_MEMORY_SCOPE_AGENT
#define LDS_WAIT() asm volatile("s_waitcnt lgkmcnt(0)" ::: "memory")
__device__ __forceinline__ unsigned f2bf(float f) { unsigned u = __builtin_bit_cast(unsigned, f); return (u + 0x7fffu + ((u >> 16) & 1u)) >> 16; }
__device__ __forceinline__ unsigned pk2(float lo, float hi) { return f2bf(lo) | (f2bf(hi) << 16); }
__device__ __forceinline__ float bf2f(bf16 b) { return __builtin_bit_cast(float, (unsigned)b << 16); }
__device__ __forceinline__ float bflo(unsigned w) { return __builtin_bit_cast(float, w << 16); }
__device__ __forceinline__ float bfhi(unsigned w) { return __builtin_bit_cast(float, w & 0xffff0000u); }
__device__ __forceinline__ float wave_sum(float v) {
#pragma unroll
    for (int o = 1; o < 64; o <<= 1) v += __shfl_xor(v, o);
    return v;
}
template <int CTRL> __device__ __forceinline__ float dpp_mov(float v) { return __builtin_bit_cast(float, __builtin_amdgcn_update_dpp(0, __builtin_bit_cast(int, v), CTRL, 0xf, 0xf, true)); }
__device__ __forceinline__ float row16_sum(float v) { v += dpp_mov<0xB1>(v); v += dpp_mov<0x4E>(v); v += dpp_mov<0x141>(v); v += dpp_mov<0x140>(v); return v; }
__device__ __forceinline__ float sigmoidf_(float x) { return 1.0f / (1.0f + __expf(-x)); }

__device__ __forceinline__ int opaque(int v) { asm volatile("" : "+v"(v)); return v; }
struct Args { const float* in[29]; float* out; unsigned char* ws; int ph_lo, ph_hi; };
static_assert(sizeof(Args) == 29 * 8 + 8 + 8 + 8, "Args has no padding");
enum { I_X = 0, I_NG, I_WG, I_WU, I_WD, I_EWIN, I_EBQKV, I_EMU, I_EW0, I_EW2, I_EA0, I_EA2, I_EG2, I_EKK, I_EKA, I_ERK, I_EGNG, I_EGNB, I_ESINK, I_EWOUT, I_V0, I_V1, I_V2, I_OWIN, I_OVNG, I_OWS, I_OBS, I_OWOUT, I_FG };

__device__ __forceinline__ void tr_item(const float* W, int ldw, int k0, int c0, const float* gk, bf16* WT, int K, int drow0, LAS float* scr, int lane, bool zero) {
    if (!zero) {
#pragma unroll 8
        for (int i = 0; i < 32; ++i) { const int kk = 2 * i + (lane >> 5); float v = W[(size_t)(k0 + kk) * ldw + c0 + (lane & 31)]; if (gk) v *= gk[k0 + kk]; scr[kk * 33 + (lane & 31)] = v; }
    } else {
#pragma unroll 8
        for (int i = 0; i < 32; ++i) { const int kk = 2 * i + (lane >> 5); scr[kk * 33 + (lane & 31)] = 0.f; }
    }
    LDS_WAIT(); asm volatile("" ::: "memory");
    const int c = lane & 7;
#pragma unroll
    for (int j = 0; j < 4; ++j) { const int n = (lane >> 3) + 8 * j; const LAS float* s = scr + (8 * c) * 33 + n;
        v4u o; o.x = pk2(s[0 * 33], s[1 * 33]); o.y = pk2(s[2 * 33], s[3 * 33]); o.z = pk2(s[4 * 33], s[5 * 33]); o.w = pk2(s[6 * 33], s[7 * 33]);
        *(GAS v4u*)(WT + (size_t)(drow0 + n) * K + k0 + 8 * c) = o; }
    LDS_WAIT(); asm volatile("" ::: "memory");
}
__device__ __forceinline__ void prep_phase(const Args& a, int L, LAS unsigned char* lds, int vcu, int G, int wave, int lane) {
    LAS float* scr = (LAS float*)(lds + wave * 16384);
    const int gw = vcu * NWAVES + wave, NGW = G * NWAVES;
    unsigned char* ws = a.ws;
    const bool even = !(L & 1); const int li = L >> 1;
    constexpr int nGU = 32 * 352, nD = 88 * 64, nOUT = 32 * 64;
    const int nIN = 32 * (even ? 160 : 128);
    const int total = 2 * nGU + 2 * nD + nIN + nOUT;
    for (int it = gw; it < total; it += NGW) {
        int r = it;
        if (r < 2 * nGU) { const int f = r / nGU; r -= f * nGU; const int kb = r / 352, rb = r % 352, tj = rb >> 3, sub = rb & 7;
            const float* W = (sub < 4 ? a.in[I_WG] : a.in[I_WU]) + (size_t)(L * 2 + f) * D * FF;
            tr_item(W, FF, 64 * kb, 128 * tj + 32 * (sub & 3), a.in[I_NG] + (L * 3 + (f ? 2 : 0)) * D, (bf16*)(ws + (f ? WT_GU2 : WT_GU1)), D, 32 * rb, scr, lane, false); continue; }
        r -= 2 * nGU;
        if (r < 2 * nD) { const int f = r / nD; r -= f * nD; const int kb = r / 64, nb = r % 64;
            tr_item(a.in[I_WD] + (size_t)(L * 2 + f) * FF * D, D, 64 * kb, 32 * nb, nullptr, (bf16*)(ws + (f ? WT_D2 : WT_D1)), FF, 32 * nb, scr, lane, false); continue; }
        r -= 2 * nD;
        if (r < nIN) {
            if (even) { const int kb = r / 160, rb = r % 160, d = 32 * rb; const bool zero = d >= E_IN; const int c0 = d < ZA ? A_COLS + d : d - ZA;
                tr_item(a.in[I_EWIN] + (size_t)li * D * E_IN, E_IN, 64 * kb, zero ? 0 : c0, a.in[I_NG] + (L * 3 + 1) * D, (bf16*)(ws + WT_IN), D, d, scr, lane, zero); }
            else { const int kb = r / 128, rb = r % 128;
                tr_item(a.in[I_OWIN] + (size_t)li * D * ZO, ZO, 64 * kb, 32 * rb, a.in[I_NG] + (L * 3 + 1) * D, (bf16*)(ws + WT_IN), D, 32 * rb, scr, lane, false); }
            continue; }
        r -= nIN;
        { const int kb = r / 64, nb = r % 64;
          tr_item((even ? a.in[I_EWOUT] : a.in[I_OWOUT]) + (size_t)li * D * D, D, 64 * kb, 32 * nb, nullptr, (bf16*)(ws + WT_OUT), D, 32 * nb, scr, lane, false); }
    }
    if (L == 0) {
        float* ss0 = (float*)(ws + WS_SS); bf16* XB = (bf16*)(ws + WS_XB);
        for (int m = gw; m < M; m += NGW) {
            const GAS f32x4* xr = (const GAS f32x4*)(a.in[I_X] + (size_t)m * D) + lane; GAS v2u* o = (GAS v2u*)(XB + (size_t)m * D) + lane; float s = 0.f;
#pragma unroll
            for (int j = 0; j < 8; ++j) { const f32x4 v = xr[64 * j]; s += (v.x * v.x + v.y * v.y) + (v.z * v.z + v.w * v.w); v2u w; w.x = pk2(v.x, v.y); w.y = pk2(v.z, v.w); o[64 * j] = w; }
            s = wave_sum(s); if (lane < 8) ss0[(size_t)lane * M + m] = lane ? 0.f : s;
        }
    }
}

__device__ __forceinline__ void e1_phase(const Args& a, int li, LAS unsigned char* ldsb, int vcu, int G, int tid) {
    LAS float* Aw = (LAS float*)ldsb; LAS float* Aa = Aw + 16 * 64; LAS float* Ag = Aa + 16 * 64; LAS float* Vp = Ag + 16 * 160; LAS float* Pb = Vp + 16 * 1024;
    unsigned char* ws = a.ws;
    const bf16* Z = (const bf16*)(ws + WS_ACT);
    bf16* R = (bf16*)(ws + SC_R); bf16* K2 = (bf16*)(ws + SC_K2); bf16* KK = (bf16*)(ws + SC_KK); bf16* BB = (bf16*)(ws + SC_BB); bf16* LW = (bf16*)(ws + SC_LW); bf16* GG = (bf16*)(ws + SC_GG);
    bf16* VO = (bf16*)(ws + (li ? WS_V2 : WS_VF)); const bf16* VF = (const bf16*)(ws + WS_VF);
    const float* mu = a.in[I_EMU] + li * A_COLS;
    const float* w0 = a.in[I_EW0] + li * 1024; const float* w2 = a.in[I_EW2] + (size_t)li * 64 * 1024;
    const float* a0 = a.in[I_EA0] + li * 1024; const float* a2 = a.in[I_EA2] + (size_t)li * 64 * 1024;
    const float* g2 = a.in[I_EG2] + (size_t)li * 160 * 1024;
    const float* kkw = a.in[I_EKK] + li * 1024; const float* kaw = a.in[I_EKA] + li * 1024;
    const float* v0w = a.in[I_V0]; const float* v1w = a.in[I_V1]; const float* v2w = a.in[I_V2];
    for (int unit = vcu; unit < M / 16; unit += G) {
        const int m0 = unit * 16;
        for (int e = tid; e < 16 * 288; e += NTHR) { const int r = e / 288, j = e % 288, m = m0 + r; const bool first = (m & (T - 1)) == 0;
            const float zc = bf2f(Z[(size_t)m * ZN + ZA + 3072 + j]); const float zp = first ? 0.f : bf2f(Z[(size_t)(m - 1) * ZN + ZA + 3072 + j]);
            const float x = zc + (zp - zc) * mu[3072 + j];
            if (j < 64) Aw[r * 64 + j] = tanhf(x); else if (j < 128) Aa[r * 64 + j - 64] = x; else Ag[r * 160 + j - 128] = sigmoidf_(x); }
        if (li > 0) {
            for (int e = tid; e < 16 * 1024; e += NTHR) { const int r = e >> 10, c = e & 1023, m = m0 + r; const bool first = (m & (T - 1)) == 0;
                const float zc = bf2f(Z[(size_t)m * ZN + ZA + 2048 + c]); const float zp = first ? 0.f : bf2f(Z[(size_t)(m - 1) * ZN + ZA + 2048 + c]);
                Vp[e] = zc + (zp - zc) * mu[2048 + c]; }
        }
        __syncthreads();
        if (li > 0) { const int r = tid >> 5, j = tid & 31; float acc = 0.f;
            for (int c = 0; c < 1024; ++c) acc += Vp[r * 1024 + c] * v1w[c * 32 + j];
            Pb[r * 32 + j] = acc; __syncthreads(); }
        for (int pass = 0; pass < 2; ++pass) {
            const int c = tid + NTHR * pass;
            float wa[16], aa[16], ga[16];
#pragma unroll
            for (int r = 0; r < 16; ++r) { wa[r] = 0.f; aa[r] = 0.f; ga[r] = 0.f; }
            for (int k = 0; k < 64; k += 4) {
                const float w_0 = w2[(k + 0) * 1024 + c], w_1 = w2[(k + 1) * 1024 + c], w_2 = w2[(k + 2) * 1024 + c], w_3 = w2[(k + 3) * 1024 + c];
                const float a_0 = a2[(k + 0) * 1024 + c], a_1 = a2[(k + 1) * 1024 + c], a_2 = a2[(k + 2) * 1024 + c], a_3 = a2[(k + 3) * 1024 + c];
#pragma unroll
                for (int r = 0; r < 16; ++r) { const f32x4 xw = *(const LAS f32x4*)(Aw + r * 64 + k), xa = *(const LAS f32x4*)(Aa + r * 64 + k);
                    wa[r] += (xw.x * w_0 + xw.y * w_1) + (xw.z * w_2 + xw.w * w_3); aa[r] += (xa.x * a_0 + xa.y * a_1) + (xa.z * a_2 + xa.w * a_3); }
            }
            for (int k = 0; k < 160; k += 4) {
                const float g_0 = g2[(k + 0) * 1024 + c], g_1 = g2[(k + 1) * 1024 + c], g_2 = g2[(k + 2) * 1024 + c], g_3 = g2[(k + 3) * 1024 + c];
#pragma unroll
                for (int r = 0; r < 16; ++r) { const f32x4 xg = *(const LAS f32x4*)(Ag + r * 160 + k); ga[r] += (xg.x * g_0 + xg.y * g_1) + (xg.z * g_2 + xg.w * g_3); }
            }
            const float w0c = w0[c], a0c = a0[c], kkc = kkw[c], kac = kaw[c], mur = mu[c], muk = mu[1024 + c], muv = mu[2048 + c];
            const float v0c = li ? v0w[c] : 0.f;
#pragma unroll
            for (int r = 0; r < 16; ++r) {
                const int m = m0 + r; const bool first = (m & (T - 1)) == 0; const size_t zo = (size_t)m * ZN + ZA + c, zq = zo - ZN;
                const float rc = bf2f(Z[zo]), kc = bf2f(Z[zo + 1024]), vc = bf2f(Z[zo + 2048]);
                const float rp = first ? 0.f : bf2f(Z[zq]), kp = first ? 0.f : bf2f(Z[zq + 1024]), vp = first ? 0.f : bf2f(Z[zq + 2048]);
                const float rr = rc + (rp - rc) * mur, k1 = kc + (kp - kc) * muk; float vv = vc + (vp - vc) * muv;
                if (li > 0) { float gt = v0c;
#pragma unroll 8
                    for (int j = 0; j < 32; ++j) gt += Pb[r * 32 + j] * v2w[j * 1024 + c];
                    vv = vv + (bf2f(VF[(size_t)m * 1024 + c]) - vv) * sigmoidf_(gt); }
                const float av = sigmoidf_(a0c + aa[r]);
                const float wv = w0c + wa[r]; const float y = -wv; const float sp = fmaxf(y, 0.f) + log1pf(__expf(-fabsf(y)));
                const float lw = -__expf(-sp - 0.5f);
                const float kk0 = k1 * kkc; const float nrm = sqrtf(wave_sum(kk0 * kk0)); const float kk = kk0 / fmaxf(nrm, 1e-12f);
                const float k2 = k1 * (1.0f + (av - 1.0f) * kac);
                const size_t o = (size_t)m * 1024 + c;
                R[o] = (bf16)f2bf(rr); K2[o] = (bf16)f2bf(k2); VO[o] = (bf16)f2bf(vv); KK[o] = (bf16)f2bf(kk); BB[o] = (bf16)f2bf(kk * av); LW[o] = (bf16)f2bf(lw); GG[o] = (bf16)f2bf(ga[r]);
            }
        }
        __syncthreads();
    }
}

constexpr int SCH = 32;
__device__ __forceinline__ void scan_fill(LAS float* vecb, LAS float* vvb, const bf16* LW, const bf16* K2, const bf16* R, const bf16* KK, const bf16* BB, const bf16* V, size_t rowbase, int colh, int q, int ft, int nft) {
    for (int e = ft; e < 5 * SCH * 8; e += nft) { const int i = e / (SCH * 8), rem = e % (SCH * 8), tt = rem >> 3, j = rem & 7;
        const bf16* src = (i == 0 ? LW : i == 1 ? K2 : i == 2 ? R : i == 3 ? KK : BB) + (rowbase + tt) * 1024 + colh + 8 * j;
        const v4u w = *(const GAS v4u*)src; f32x4 lo, hi;
        lo.x = bflo(w.x); lo.y = bfhi(w.x); lo.z = bflo(w.y); lo.w = bfhi(w.y); hi.x = bflo(w.z); hi.y = bfhi(w.z); hi.z = bflo(w.w); hi.w = bfhi(w.w);
        if (i == 0) { lo.x = __expf(lo.x); lo.y = __expf(lo.y); lo.z = __expf(lo.z); lo.w = __expf(lo.w); hi.x = __expf(hi.x); hi.y = __expf(hi.y); hi.z = __expf(hi.z); hi.w = __expf(hi.w); }
        if (i == 3) { lo = -lo; hi = -hi; }
        LAS f32x4* d = (LAS f32x4*)(vecb + (i * SCH + tt) * 64 + 8 * j); d[0] = lo; d[1] = hi; }
    for (int e = ft; e < SCH * 2; e += nft) { const int tt = e >> 1, hf = e & 1;
        const v4u w = *(const GAS v4u*)(V + (rowbase + tt) * 1024 + colh + 16 * q + 8 * hf); f32x4 lo, hi;
        lo.x = bflo(w.x); lo.y = bfhi(w.x); lo.z = bflo(w.y); lo.w = bfhi(w.y); hi.x = bflo(w.z); hi.y = bfhi(w.z); hi.z = bflo(w.w); hi.w = bfhi(w.w);
        LAS f32x4* d = (LAS f32x4*)(vvb + tt * 16 + 8 * hf); d[0] = lo; d[1] = hi; }
}
__device__ __forceinline__ void scan_unit(const Args& a, int li, int su, LAS unsigned char* ldsb, int tid) {
    unsigned char* ws = a.ws;
    const bf16* R = (const bf16*)(ws + SC_R); const bf16* K2 = (const bf16*)(ws + SC_K2); const bf16* KK = (const bf16*)(ws + SC_KK); const bf16* BB = (const bf16*)(ws + SC_BB); const bf16* LW = (const bf16*)(ws + SC_LW);
    const bf16* V = (const bf16*)(ws + (li ? WS_V2 : WS_VF)); float* Y = (float*)(ws + WS_XB);
    const int bh = su >> 2, q = su & 3, b = bh >> 4, h = bh & 15, colh = h * 64; const size_t row0 = (size_t)b * T;
    LAS float* vec = (LAS float*)ldsb;
    LAS float* vvl = vec + 2 * 5 * SCH * 64;
    LAS float* ybl = vvl + 2 * SCH * 16;
    const int lane = tid & 63, cw = tid >> 6, rp = lane >> 4, kg = lane & 15, lr0 = 8 * cw + 2 * rp;
    f32x4 S0 = {0.f, 0.f, 0.f, 0.f}, S1 = {0.f, 0.f, 0.f, 0.f};
    scan_fill(vec, vvl, LW, K2, R, KK, BB, V, row0, colh, q, tid, NTHR);
    constexpr int NCH = T / SCH;
    for (int c = 0; c < NCH; ++c) {
        __syncthreads();
        const int buf = c & 1;
        if (tid < 128) {
            const LAS float* vb = vec + buf * 5 * SCH * 64 + 4 * kg; const LAS float* vvb = vvl + buf * SCH * 16 + lr0; LAS float* yb = ybl + buf * SCH * 16 + lr0;
#pragma unroll 4
            for (int t = 0; t < SCH; ++t) {
                const f32x4 wv = *(const LAS f32x4*)(vb + t * 64), kv = *(const LAS f32x4*)(vb + (SCH + t) * 64), rv = *(const LAS f32x4*)(vb + (2 * SCH + t) * 64),
                            av = *(const LAS f32x4*)(vb + (3 * SCH + t) * 64), bv = *(const LAS f32x4*)(vb + (4 * SCH + t) * 64);
                const f32x2 v2 = *(const LAS f32x2*)(vvb + t * 16);
                float sa0 = (S0.x * av.x + S0.y * av.y) + (S0.z * av.z + S0.w * av.w), sa1 = (S1.x * av.x + S1.y * av.y) + (S1.z * av.z + S1.w * av.w);
                sa0 = row16_sum(sa0); sa1 = row16_sum(sa1);
                S0 = S0 * wv + (bv * sa0 + kv * v2.x); S1 = S1 * wv + (bv * sa1 + kv * v2.y);
                float y0 = (S0.x * rv.x + S0.y * rv.y) + (S0.z * rv.z + S0.w * rv.w), y1 = (S1.x * rv.x + S1.y * rv.y) + (S1.z * rv.z + S1.w * rv.w);
                y0 = row16_sum(y0); y1 = row16_sum(y1);
                if (kg == 0) *(LAS f32x2*)(yb + t * 16) = (f32x2){y0, y1};
            }
        } else {
            const int ft = tid - 128;
            if (c + 1 < NCH) scan_fill(vec + (buf ^ 1) * 5 * SCH * 64, vvl + (buf ^ 1) * SCH * 16, LW, K2, R, KK, BB, V, row0 + (size_t)(c + 1) * SCH, colh, q, ft, NTHR - 128);
            if (c > 0 && ft < 128) { const int tt = ft >> 2, part = ft & 3;
                *(GAS f32x4*)(Y + (row0 + (size_t)(c - 1) * SCH + tt) * 1024 + colh + 16 * q + 4 * part) = *(const LAS f32x4*)(ybl + (buf ^ 1) * SCH * 16 + tt * 16 + 4 * part); }
        }
    }
    __syncthreads();
    if (tid < 128) { const int tt = tid >> 2, part = tid & 3;
        *(GAS f32x4*)(Y + (row0 + (size_t)(NCH - 1) * SCH + tt) * 1024 + colh + 16 * q + 4 * part) = *(const LAS f32x4*)(ybl + ((NCH - 1) & 1) * SCH * 16 + tt * 16 + 4 * part); }
    __syncthreads();
}

__device__ __forceinline__ void attn_unit(const Args& a, int li, int au, LAS unsigned char* ldsb, int tid) {
    unsigned char* ws = a.ws; const bf16* Z = (const bf16*)(ws + WS_ACT); bf16* O = (bf16*)(ws + WS_O);
    const int n = au & 127, kvh = (au >> 7) & 3, b = au >> 9;
    LAS float* Ks = (LAS float*)ldsb; LAS float* Vs = Ks + 256 * 68;
    const size_t rblk = (size_t)b * T + (size_t)n * 128;
    for (int e = tid; e < 256 * 8 * 2; e += NTHR) { const int which = e >> 11, rem = e & 2047, j = rem >> 3, c8 = rem & 7; const bool valid = (n > 0) || (j >= 128);
        f32x4 lo = {0.f, 0.f, 0.f, 0.f}, hi = lo;
        if (valid) { const v4u w = *(const GAS v4u*)(Z + (rblk + j - 128) * ZN + 1024 + which * 256 + kvh * 64 + 8 * c8);
            lo.x = bflo(w.x); lo.y = bfhi(w.x); lo.z = bflo(w.y); lo.w = bfhi(w.y); hi.x = bflo(w.z); hi.y = bfhi(w.z); hi.z = bflo(w.w); hi.w = bfhi(w.w); }
        LAS f32x4* d = (LAS f32x4*)((which ? Vs : Ks) + j * 68 + 8 * c8); d[0] = lo; d[1] = hi; }
    __syncthreads();
    const int g = tid >> 7, i = tid & 127, hq = kvh * 4 + g; const size_t row = rblk + i;
    float qv[64];
    { const GAS v4u* qp = (const GAS v4u*)(Z + row * ZN + hq * 64);
#pragma unroll
      for (int c = 0; c < 8; ++c) { const v4u w = qp[c]; qv[8 * c + 0] = bflo(w.x) * 0.125f; qv[8 * c + 1] = bfhi(w.x) * 0.125f; qv[8 * c + 2] = bflo(w.y) * 0.125f; qv[8 * c + 3] = bfhi(w.y) * 0.125f;
          qv[8 * c + 4] = bflo(w.z) * 0.125f; qv[8 * c + 5] = bfhi(w.z) * 0.125f; qv[8 * c + 6] = bflo(w.w) * 0.125f; qv[8 * c + 7] = bfhi(w.w) * 0.125f; } }
    const float slope = exp2f(-0.5f * (float)(hq + 1)); const float sink = a.in[I_ESINK][li * 16 + hq];
    float mx = sink, l = 1.0f; float acc[64];
#pragma unroll
    for (int d = 0; d < 64; ++d) acc[d] = 0.f;
    for (int jj = 0; jj < 128; ++jj) { const int j = i + 1 + jj; const bool valid = (n > 0) || (j >= 128);
        const LAS f32x4* kr = (const LAS f32x4*)(Ks + j * 68); float s0 = 0.f, s1 = 0.f;
#pragma unroll
        for (int c = 0; c < 16; c += 2) { const f32x4 k0 = kr[c], k1 = kr[c + 1];
            s0 += (qv[4 * c] * k0.x + qv[4 * c + 1] * k0.y) + (qv[4 * c + 2] * k0.z + qv[4 * c + 3] * k0.w); s1 += (qv[4 * c + 4] * k1.x + qv[4 * c + 5] * k1.y) + (qv[4 * c + 6] * k1.z + qv[4 * c + 7] * k1.w); }
        float s = (s0 + s1) - slope * (float)(127 - jj);
        if (!valid) s = -INFINITY;
        if (s > mx) { const float sc = __expf(mx - s); l *= sc;
#pragma unroll
            for (int d = 0; d < 64; ++d) acc[d] *= sc;
            mx = s; }
        const float p = __expf(s - mx); l += p;
        const LAS f32x4* vr = (const LAS f32x4*)(Vs + j * 68);
#pragma unroll
        for (int c = 0; c < 16; ++c) { const f32x4 v = vr[c]; acc[4 * c] += p * v.x; acc[4 * c + 1] += p * v.y; acc[4 * c + 2] += p * v.z; acc[4 * c + 3] += p * v.w; }
    }
    const float inv = 1.0f / l;
    { GAS v4u* op = (GAS v4u*)(O + row * D + 1024 + hq * 64);
#pragma unroll
      for (int c = 0; c < 8; ++c) { v4u w; w.x = pk2(acc[8 * c] * inv, acc[8 * c + 1] * inv); w.y = pk2(acc[8 * c + 2] * inv, acc[8 * c + 3] * inv); w.z = pk2(acc[8 * c + 4] * inv, acc[8 * c + 5] * inv); w.w = pk2(acc[8 * c + 6] * inv, acc[8 * c + 7] * inv); op[c] = w; } }
    __syncthreads();
}

__device__ __forceinline__ void e3_phase(const Args& a, int li, int vcu, int G, int tid) {
    unsigned char* ws = a.ws; const float* Y = (const float*)(ws + WS_XB);
    const bf16* R = (const bf16*)(ws + SC_R); const bf16* K2 = (const bf16*)(ws + SC_K2); const bf16* GG = (const bf16*)(ws + SC_GG); const bf16* V = (const bf16*)(ws + (li ? WS_V2 : WS_VF));
    bf16* O = (bf16*)(ws + WS_O);
    const float* rk = a.in[I_ERK] + li * 1024; const float* gng = a.in[I_EGNG] + li * 1024; const float* gnb = a.in[I_EGNB] + li * 1024;
    for (size_t e = (size_t)vcu * NTHR + tid; e < (size_t)M * 1024; e += (size_t)G * NTHR) {
        const size_t row = e >> 10; const int c = (int)(e & 1023);
        const float y = Y[e]; const float mean = wave_sum(y) * (1.0f / 64.0f); const float dv = y - mean; const float var = wave_sum(dv * dv) * (1.0f / 64.0f);
        const float r = bf2f(R[e]), k = bf2f(K2[e]), v = bf2f(V[e]), g = bf2f(GG[e]);
        const float yn = dv * rsqrtf(var + 64e-5f) * gng[c] + gnb[c];
        const float bonus = wave_sum(r * k * rk[c]);
        O[row * D + c] = (bf16)f2bf((yn + bonus * v) * g);
    }
}

#define SGU_SYNC() __syncthreads()
__device__ __forceinline__ void sgu_phase(const Args& a, int li, LAS unsigned char* ldsb, int vcu, int G, int tid) {
    unsigned char* ws = a.ws; const bf16* Z = (const bf16*)(ws + WS_ACT); bf16* O = (bf16*)(ws + WS_O);
    const float* ssv = (const float*)(ws + WS_SS) + (size_t)(13 + li) * SS_REC;
    LAS float* vs = (LAS float*)ldsb;
#ifndef WTS
#define WTS 132
#endif
    LAS float* wt = vs + 128 * 128;
    const float* wsg = a.in[I_OWS] + (size_t)li * 16 * 128 * 128; const float* bs = a.in[I_OBS] + li * 16 * 128; const float* vng = a.in[I_OVNG] + li * D;
    int gcur = -1;
    for (int u = vcu; u < 4096; u += G) {
        const int g = u & 15, bn = u >> 4; const size_t m0 = (size_t)bn * 128;
        __syncthreads();
        if (g != gcur) { gcur = g;
            for (int e = tid; e < 128 * 128; e += NTHR) { const int i = e >> 7, j = e & 127; wt[j * WTS + i] = (j <= i) ? wsg[((size_t)g * 128 + i) * 128 + j] : 0.f; } }
        for (int e = tid; e < 128 * 16; e += NTHR) { const int j = e >> 4, c8 = e & 15; const float rs = pg8::row_rs(ssv, (int)(m0 + j));
            const v4u w = *(const GAS v4u*)(Z + (m0 + j) * ZO + 2048 + g * 128 + 8 * c8); f32x4 lo, hi;
            lo.x = bflo(w.x) * rs; lo.y = bfhi(w.x) * rs; lo.z = bflo(w.y) * rs; lo.w = bfhi(w.y) * rs; hi.x = bflo(w.z) * rs; hi.y = bfhi(w.z) * rs; hi.z = bflo(w.w) * rs; hi.w = bfhi(w.w) * rs;
            LAS f32x4* d = (LAS f32x4*)(vs + j * 128 + 8 * c8); d[0] = lo; d[1] = hi; }
        __syncthreads();
        const int c = tid & 127, ib = tid >> 7; const float vg = vng[g * 128 + c];
        for (int ig = 0; ig < 4; ++ig) { const int i0 = 32 * ib + 8 * ig; float acc[8];
#pragma unroll
            for (int r = 0; r < 8; ++r) acc[r] = 0.f;
            for (int j = 0; j < i0 + 8; ++j) { const float vv = vs[j * 128 + c]; const f32x4 w0 = *(const LAS f32x4*)(wt + j * WTS + i0), w1 = *(const LAS f32x4*)(wt + j * WTS + i0 + 4);
                acc[0] += w0.x * vv; acc[1] += w0.y * vv; acc[2] += w0.z * vv; acc[3] += w0.w * vv; acc[4] += w1.x * vv; acc[5] += w1.y * vv; acc[6] += w1.z * vv; acc[7] += w1.w * vv; }
#pragma unroll
            for (int r = 0; r < 8; ++r) { const int i = i0 + r; const float uu = bf2f(Z[(m0 + i) * ZO + g * 128 + c]);
                O[(m0 + i) * D + g * 128 + c] = (bf16)f2bf(uu * (vg * acc[r] + bs[g * 128 + i])); }
        }
    }
    __syncthreads();
}

__device__ __forceinline__ void final_phase(const Args& a, int vcu, int G, int wave, int lane) {
    const int gw = vcu * NWAVES + wave, NGW = G * NWAVES; const float* ss = (const float*)(a.ws + WS_SS) + (size_t)12 * SS_REC; const float* fg = a.in[I_FG];
    for (int m = gw; m < M; m += NGW) { const float rs = pg8::row_rs(ss, m);
        GAS f32x4* xr = (GAS f32x4*)(a.out + (size_t)m * D) + lane; const GAS f32x4* gr = (const GAS f32x4*)fg + lane;
#pragma unroll
        for (int j = 0; j < 8; ++j) { const f32x4 v = xr[64 * j], gg = gr[64 * j]; xr[64 * j] = v * rs * gg; } }
}

__global__ void __launch_bounds__(NTHR, 2) mk_fwd(Args args) {
    extern __shared__ __attribute__((aligned(16))) unsigned char lds_raw[];
    LAS unsigned char* lds = (LAS unsigned char*)lds_raw;
    const int tid = threadIdx.x, lane = tid & 63, wave = __builtin_amdgcn_readfirstlane(tid >> 6);
    const int G = gridDim.x, bx = blockIdx.x; const int vcu = (G % 8 == 0) ? (bx % 8) * (G / 8) + bx / 8 : bx;
    unsigned char* ws = args.ws; gu32* ctl = (gu32*)(ws + WS_CTL);
    for (int u = tid; u < (LDS_BYTES - LDSCTL_OFF) / 4; u += NTHR) ((LAS unsigned*)(lds + LDSCTL_OFF))[u] = 0u;
    __syncthreads();
    const int lo = args.ph_lo, hi = args.ph_hi;
    const bool multi = (hi - lo) > 1;
    XcdBarrier bar; bar.bar = (unsigned*)(ctl + CW_BAR); bar.x = 0; bar.st = nullptr;
    if (multi) bar = xcd_barrier_post((unsigned*)(ctl + CW_BAR), (volatile LAS unsigned*)(lds + LDSCTL_OFF));
#define IN(k) (lo <= (k) && (k) < hi)
#define SEAM(k) do { if ((k) + 1 < hi) xcd_barrier(bar); } while (0)
    float* ssb = (float*)(ws + WS_SS);
    bf16* XB = (bf16*)(ws + WS_XB); bf16* ACT = (bf16*)(ws + WS_ACT); bf16* OB = (bf16*)(ws + WS_O);

    for (int s = 0; s < NSUB; ++s) {
        const int pb = s * 8, L = s / 3, kind = s % 3, li = L >> 1; const bool even = !(L & 1);
        #ifndef NO_PREP
        if (kind == 0 && IN(pb + 0)) { { const int t_ = opaque(tid); prep_phase(args, L, lds, vcu, G, __builtin_amdgcn_readfirstlane(t_ >> 6), t_ & 63); } SEAM(pb + 0); }
#endif
        if (IN(pb + 1)) {
            const float* ss = ssb + (size_t)s * SS_REC;
            if (kind != 1) {
                pg8::Gemm g{XB, (const bf16*)(ws + (kind == 0 ? WT_GU1 : WT_GU2)), M, 2 * FF, D}; pg8::StaticOrder S; S.init(M, 2 * FF, G, bx);
                pg8::EpiSwiGLU E{ACT, FF, ss};
#ifndef NO_G1
                pg8::gemm_phase<pg8::EpiSwiGLU, pg8::StaticOrder, true, true>(lds, g, S, E);
#endif
            } else if (even) {
                pg8::Gemm g{XB, (const bf16*)(ws + WT_IN), M, ZN, D}; pg8::StaticOrder S; S.init(M, ZN, G, bx);
                pg8::EpiZ E{ACT, ZN, ss, args.in[I_EBQKV] + li * 1536};
#ifndef NO_GZ
                pg8::gemm_phase<pg8::EpiZ, pg8::StaticOrder, true, true>(lds, g, S, E);
#endif
            } else {
                pg8::Gemm g{XB, (const bf16*)(ws + WT_IN), M, ZO, D}; pg8::StaticOrder S; S.init(M, ZO, G, bx);
                pg8::EpiGeluV E{ACT, ZO, ss, ssb + (size_t)(13 + li) * SS_REC, (LAS float*)(lds + 131072)};
#ifndef NO_GG
                pg8::gemm_phase<pg8::EpiGeluV, pg8::StaticOrder, true, true>(lds, g, S, E);
#endif
            }
            SEAM(pb + 1);
        }
        if (kind == 1) {
            if (IN(pb + 2)) {
#ifndef NO_E1
                if (even) e1_phase(args, li, lds, vcu, G, opaque(tid));
#endif
#ifndef NO_SGU
                if (!even) sgu_phase(args, li, lds, vcu, G, opaque(tid));
#endif
                SEAM(pb + 2); }
            if (even && IN(pb + 3)) {
                const int xcd = bx & 7, slot = bx >> 3; const bool split = (G == 256);
                const int s0 = split ? (slot < 16 ? xcd * 16 + slot : 128) : vcu, sstr = split ? 128 : G;
#ifndef NO_SCAN
                for (int su = s0; su < 128; su += sstr) scan_unit(args, li, su, lds, opaque(tid));
#endif
                const int a0 = split ? (slot >= 16 ? xcd * 16 + slot - 16 : 1024) : vcu, astr = split ? 128 : G;
#ifndef NO_ATTN
                for (int au = a0; au < 1024; au += astr) attn_unit(args, li, au, lds, opaque(tid));
#endif
                SEAM(pb + 3);
            }
#ifndef NO_E3
            if (even && IN(pb + 4)) { e3_phase(args, li, vcu, G, opaque(tid)); SEAM(pb + 4); }
#endif
        }
        if (IN(pb + 5)) {
            const bf16* A = (kind == 1) ? OB : ACT; const int K = (kind == 1) ? D : FF;
            const bf16* Bt = (const bf16*)(ws + (kind == 0 ? WT_D1 : kind == 1 ? WT_OUT : WT_D2));
            pg8::Gemm g{A, Bt, M, D, K}; pg8::StaticOrder S; S.init(M, D, G, bx);
            pg8::EpiResid E{s == 0 ? args.in[I_X] : args.out, args.out, XB, ssb + (size_t)(s + 1) * SS_REC, kind == 1 ? 1.0f : 0.5f, (LAS float*)(lds + 131072)};
#ifndef NO_GR
            pg8::gemm_phase<pg8::EpiResid, pg8::StaticOrder, true, true>(lds, g, S, E);
#endif
            SEAM(pb + 5);
        }
    }
    if (IN(NSUB * 8)) { const int t_ = opaque(tid); final_phase(args, vcu, G, __builtin_amdgcn_readfirstlane(t_ >> 6), t_ & 63); }
#undef IN
#undef SEAM
}

extern "C" void kernel_launch(void* const* d_in, const int* in_sizes, int n_in, void* d_out, int out_size, void* d_ws, size_t ws_size, hipStream_t stream) {
    static int grid = 0;
    if (grid == 0) {
        if (n_in != 29 || out_size != M * D || ws_size < WS_END) { fprintf(stderr, "kernel_launch: unexpected shapes (n_in %d, out %d, ws %zu < %zu); nothing launched\n", n_in, out_size, ws_size, (size_t)WS_END); grid = -1; return; }
        int dev = 0, cus = 0;
        if (hipGetDevice(&dev) != hipSuccess || hipDeviceGetAttribute(&cus, hipDeviceAttributeMultiprocessorCount, dev) != hipSuccess) { grid = -1; return; }
        if (hipFuncSetAttribute((const void*)mk_fwd, hipFuncAttributeMaxDynamicSharedMemorySize, LDS_BYTES) != hipSuccess) { fprintf(stderr, "kernel_launch: hipFuncSetAttribute failed\n"); grid = -1; return; }
        int per_cu = 0;
        if (hipOccupancyMaxActiveBlocksPerMultiprocessor(&per_cu, (const void*)mk_fwd, NTHR, LDS_BYTES) != hipSuccess || per_cu < 1) fprintf(stderr, "kernel_launch: occupancy query says %d\n", per_cu);
        (void)hipGetLastError();
        grid = cus;
    }
    if (grid < 0) return;
    (void)hipMemsetAsync((char*)d_ws + WS_CTL, 0, CTL_ZERO_BYTES, stream);
    Args a{};
    for (int i = 0; i < 29; ++i) a.in[i] = (const float*)d_in[i];
    a.out = (float*)d_out; a.ws = (unsigned char*)d_ws;
#if MK_ONE_LAUNCH
    a.ph_lo = 0; a.ph_hi = NSUB * 8 + 1;
    hipLaunchKernelGGL(mk_fwd, dim3(grid), dim3(NTHR), LDS_BYTES, stream, a);
#else
    for (int s = 0; s <= NSUB; ++s) {
        for (int k = 0; k < (s == NSUB ? 1 : 8); ++k) {
            const int L = s / 3, kind = s % 3; const bool even = !(L & 1);
            bool live;
            if (s == NSUB) live = true;
            else if (k == 0) live = (kind == 0);
            else if (k == 1 || k == 5) live = true;
            else if (k == 2) live = (kind == 1);
            else if (k == 3 || k == 4) live = (kind == 1) && even;
            else live = false;
            if (!live) continue;
            a.ph_lo = s * 8 + k; a.ph_hi = a.ph_lo + 1;
            hipLaunchKernelGGL(mk_fwd, dim3(grid), dim3(NTHR), LDS_BYTES, stream, a);
        }
    }
#endif
}
```

```cpp
#include <hip/hip_runtime.h>
#include <cstdio>
#include <cstdint>
#define MK_ONE_LAUNCH 1
namespace pg8 {
#define PG8_LAS __attribute__((address_space(3)))
typedef unsigned short bf16_t;
typedef short bf16x8 __attribute__((ext_vector_type(8)));
typedef float f32x4 __attribute__((ext_vector_type(4)));
typedef unsigned u32x4 __attribute__((ext_vector_type(4)));
constexpr int BM = 256, BK = 64, HALF = 128, HTB = HALF * BK * 2  , STAGE_BYTES = 8 * HTB, NXCD = 8, WGM = 8;

__host__ __device__ __forceinline__ int lds_byte(int r, int c) { const int st = (r >> 4) * 2 + (c >> 5), rr = r & 15, cc = c & 31, ob = rr * 64 + cc * 2; return st * 1024 + (ob ^ (((ob >> 9) & 1) << 5)); }
__host__ __device__ __forceinline__ void stage_rc(int b, int& R, int& C) { const int st = b / 1024, sb = b % 1024, swz = sb ^ (((sb >> 9) & 1) << 5); R = (st >> 1) * 16 + swz / 64; C = (st & 1) * 32 + (swz % 64) / 2; }
__host__ __device__ __forceinline__ int perm32(int rho) { const int n = rho >> 4, i = rho & 15; return 8 * (i >> 2) + 4 * n + (i & 3); }

struct Unit { int pm, pn; };
struct Gemm { const bf16_t* A; const bf16_t* Bt; int M, N, K; };

struct StaticOrder {
    int nM, nN, nwg, G, c;
    __host__ __device__ void init(int M, int N, int G_, int c_) { nM = M / BM; nN = N / BM; nwg = nM * nN; G = G_; c = c_; }
    __host__ __device__ bool next(int i, Unit& u) const {
        const long L = (long)i * G + c; if (L >= nwg) return false;
        int wgid = (int)L; { const int q = nwg / NXCD, r = nwg % NXCD, xcd = wgid % NXCD, off = wgid / NXCD; wgid = (xcd < r ? xcd * (q + 1) : r * (q + 1) + (xcd - r) * q) + off; }
        const int nig = WGM * nN, gid = wgid / nig, fm = gid * WGM, gsz = (nM - fm) < WGM ? (nM - fm) : WGM;
        u.pm = fm + ((wgid % nig) % gsz); u.pn = (wgid % nig) / gsz; return true;
    }
    __device__ __forceinline__ void a_ready(const Unit&) const {}
    __device__ __forceinline__ void done(const Unit&) const {}
};
__device__ __forceinline__ unsigned cvt_pk_bf16(float lo, float hi) { unsigned r; asm volatile("v_cvt_pk_bf16_f32 %0, %1, %2" : "=v"(r) : "v"(lo), "v"(hi)); return r; }
typedef float f32x2 __attribute__((ext_vector_type(2)));
__device__ __forceinline__ f32x2 gelu_pk(f32x2 v) {
    const f32x2 av = __builtin_elementwise_abs(v), d = av * 0.2316418882f + 1.0f;
    f32x2 t; t.x = __builtin_amdgcn_rcpf(d.x); t.y = __builtin_amdgcn_rcpf(d.y);
    f32x2 q = t * 0.5307027145f + (-0.7265760135f); q = q * t + 0.7107068705f; q = q * t + (-0.142248368f); q = q * t + 0.127414796f; q = q * t;
    const f32x2 s = (v * v) * (-0.72134752044f);
    f32x2 e; e.x = __builtin_amdgcn_exp2f(s.x); e.y = __builtin_amdgcn_exp2f(s.y);
    const f32x2 m = v * (q * e), r = v - m;
    f32x2 o; o.x = v.x < 0.f ? m.x : r.x; o.y = v.y < 0.f ? m.y : r.y; return o;
}

constexpr int SS_M = 32768;
__device__ __forceinline__ float row_rs(const float* P, int row) {
    const float s = ((P[row] + P[SS_M + row]) + (P[2 * SS_M + row] + P[3 * SS_M + row])) + ((P[4 * SS_M + row] + P[5 * SS_M + row]) + (P[6 * SS_M + row] + P[7 * SS_M + row]));
    return rsqrtf(s * (1.0f / 2048.0f) + 1e-6f);
}
struct EpiSwiGLU {
    static constexpr bool PERM = true, AFTER_DRAIN = false;
    bf16_t* O; int ldc; const float* ss;
    __device__ __forceinline__ void operator()(const f32x4 (&acc)[2][2][4][2], const Unit& u, int wr, int wc, int fr, int fq) const {
        const int row0 = u.pm * BM + wr * 64 + fr, col0 = u.pn * HALF + wc * 32 + 8 * fq;
#pragma unroll
        for (int ai = 0; ai < 2; ++ai)
#pragma unroll
            for (int m = 0; m < 4; ++m) {
                const int row = row0 + ai * HALF + m * 16;
                const float rs = row_rs(ss, row);
                float o[8];
#pragma unroll
                for (int n = 0; n < 2; ++n)
#pragma unroll
                    for (int j = 0; j < 4; ++j) { const float g = acc[ai][0][m][n][j] * rs, up = acc[ai][1][m][n][j] * rs; o[4 * n + j] = g * __builtin_amdgcn_rcpf(1.0f + __expf(-g)) * up; }
                u32x4 w; w.x = cvt_pk_bf16(o[0], o[1]); w.y = cvt_pk_bf16(o[2], o[3]); w.z = cvt_pk_bf16(o[4], o[5]); w.w = cvt_pk_bf16(o[6], o[7]);
                *(u32x4*)(O + (size_t)row * ldc + col0) = w;
                asm volatile("" ::: "memory");
            }
    }
};
struct EpiResid {
    static constexpr bool PERM = false, AFTER_DRAIN = false;
    const float* base; float* out; bf16_t* xb; float* ssn; float scale; PG8_LAS float* sp;
    __device__ __forceinline__ void operator()(const f32x4 (&acc)[2][2][4][2], const Unit& u, int wr, int wc, int fr, int fq) const {
        const int row0 = u.pm * BM + wr * 64 + fr, col0 = u.pn * BM + wc * 32 + 4 * fq;
        typedef unsigned u32x2v __attribute__((ext_vector_type(2)));
#pragma unroll
        for (int ai = 0; ai < 2; ++ai)
#pragma unroll
            for (int m = 0; m < 4; ++m) {
                const int row = row0 + ai * HALF + m * 16; const size_t off = (size_t)row * 2048 + col0; float s = 0.f;
#pragma unroll
                for (int bj = 0; bj < 2; ++bj)
#pragma unroll
                    for (int n = 0; n < 2; ++n) {
                        const f32x4 bs = *(const f32x4*)(base + off + bj * HALF + n * 16);
                        const f32x4 o = bs + acc[ai][bj][m][n] * scale;
                        *(f32x4*)(out + off + bj * HALF + n * 16) = o;
                        u32x2v w; w.x = cvt_pk_bf16(o[0], o[1]); w.y = cvt_pk_bf16(o[2], o[3]);
                        *(u32x2v*)(xb + off + bj * HALF + n * 16) = w;
                        s += (o[0] * o[0] + o[1] * o[1]) + (o[2] * o[2] + o[3] * o[3]);
                    }
                s += __shfl_xor(s, 16); s += __shfl_xor(s, 32);
                if (fq == 0) sp[(ai * HALF + wr * 64 + m * 16 + fr) * 4 + wc] = s;
                asm volatile("" ::: "memory");
            }
        asm volatile("s_waitcnt lgkmcnt(0)" ::: "memory"); __builtin_amdgcn_s_barrier(); asm volatile("" ::: "memory");
        const int t = (wr * 4 + wc) * 64 + fq * 16 + fr;
        if (t < BM) { const f32x4 p = *(const PG8_LAS f32x4*)(sp + t * 4); ssn[(size_t)u.pn * SS_M + u.pm * BM + t] = (p[0] + p[1]) + (p[2] + p[3]); }
    }
};
struct EpiZ {
    static constexpr bool PERM = true, AFTER_DRAIN = false;
    bf16_t* O; int ldc; const float* ss; const float* bias;
    __device__ __forceinline__ void operator()(const f32x4 (&acc)[2][2][4][2], const Unit& u, int wr, int wc, int fr, int fq) const {
        const int row0 = u.pm * BM + wr * 64 + fr, col0 = u.pn * BM + wc * 32 + 8 * fq;
        const bool hb = u.pn < 6;
        f32x4 bv[2][2];
#pragma unroll
        for (int bj = 0; bj < 2; ++bj)
#pragma unroll
            for (int n = 0; n < 2; ++n) bv[bj][n] = hb ? *(const f32x4*)(bias + col0 + bj * HALF + 4 * n) : (f32x4){0.f, 0.f, 0.f, 0.f};
#pragma unroll
        for (int ai = 0; ai < 2; ++ai)
#pragma unroll
            for (int m = 0; m < 4; ++m) {
                const int row = row0 + ai * HALF + m * 16;
                const float rs = row_rs(ss, row);
                bf16_t* rowp = O + (size_t)row * ldc + col0;
#pragma unroll
                for (int bj = 0; bj < 2; ++bj) {
                    const f32x4 v0 = acc[ai][bj][m][0] * rs + bv[bj][0], v1 = acc[ai][bj][m][1] * rs + bv[bj][1];
                    u32x4 w; w.x = cvt_pk_bf16(v0[0], v0[1]); w.y = cvt_pk_bf16(v0[2], v0[3]); w.z = cvt_pk_bf16(v1[0], v1[1]); w.w = cvt_pk_bf16(v1[2], v1[3]);
                    *(u32x4*)(rowp + bj * HALF) = w;
                }
                asm volatile("" ::: "memory");
            }
    }
};
struct EpiGeluV {
    static constexpr bool PERM = true, AFTER_DRAIN = false;
    bf16_t* O; int ldc; const float* ss; float* ssv; PG8_LAS float* sp;
    __device__ __forceinline__ void operator()(const f32x4 (&acc)[2][2][4][2], const Unit& u, int wr, int wc, int fr, int fq) const {
        const int row0 = u.pm * BM + wr * 64 + fr, col0 = u.pn * BM + wc * 32 + 8 * fq;
        const bool isv = u.pn >= 8;
#pragma unroll
        for (int ai = 0; ai < 2; ++ai)
#pragma unroll
            for (int m = 0; m < 4; ++m) {
                const int row = row0 + ai * HALF + m * 16;
                const float rs = row_rs(ss, row);
                bf16_t* rowp = O + (size_t)row * ldc + col0; float s = 0.f;
#pragma unroll
                for (int bj = 0; bj < 2; ++bj) {
                    f32x4 v0 = acc[ai][bj][m][0] * rs, v1 = acc[ai][bj][m][1] * rs;
                    const f32x2 a = gelu_pk((f32x2){v0[0], v0[1]}), b = gelu_pk((f32x2){v0[2], v0[3]}), c = gelu_pk((f32x2){v1[0], v1[1]}), d = gelu_pk((f32x2){v1[2], v1[3]});
                    s += (a.x * a.x + a.y * a.y) + (b.x * b.x + b.y * b.y) + (c.x * c.x + c.y * c.y) + (d.x * d.x + d.y * d.y);
                    u32x4 w; w.x = cvt_pk_bf16(a.x, a.y); w.y = cvt_pk_bf16(b.x, b.y); w.z = cvt_pk_bf16(c.x, c.y); w.w = cvt_pk_bf16(d.x, d.y);
                    *(u32x4*)(rowp + bj * HALF) = w;
                }
                if (isv) { s += __shfl_xor(s, 16); s += __shfl_xor(s, 32); if (fq == 0) sp[(ai * HALF + wr * 64 + m * 16 + fr) * 4 + wc] = s; }
                asm volatile("" ::: "memory");
            }
        if (isv) {
            asm volatile("s_waitcnt lgkmcnt(0)" ::: "memory"); __builtin_amdgcn_s_barrier(); asm volatile("" ::: "memory");
            const int t = (wr * 4 + wc) * 64 + fq * 16 + fr;
            if (t < BM) { const f32x4 p = *(const PG8_LAS f32x4*)(sp + t * 4); ssv[(size_t)(u.pn - 8) * SS_M + u.pm * BM + t] = (p[0] + p[1]) + (p[2] + p[3]); }
        }
    }
};
template <class Epi, class Sched, bool ALIGN_EPI = false, bool SP2 = false>
__device__ __forceinline__ void gemm_phase(PG8_LAS unsigned char* lds, const Gemm g, const Sched& S, const Epi& E) {
    int tid_ = threadIdx.x; asm volatile("" : "+v"(tid_));
    const int tid = tid_, wid = __builtin_amdgcn_readfirstlane(tid >> 6), lane = tid & 63, wr = wid >> 2, wc = wid & 3, fr = lane & 15, fq = lane >> 4;
    const int K = g.K, nt = K / BK;
    unsigned voffA[2], voffB[2];
#pragma unroll
    for (int i = 0; i < 2; ++i) { int R, C; stage_rc(tid * 16 + i * 8192, R, C); const int Rb = Epi::PERM ? ((R & ~31) + perm32(R & 31)) : R;
        voffA[i] = (unsigned)(R * K + C) * 2u; voffB[i] = (unsigned)(Rb * K + C) * 2u; }
    const size_t kstep = (size_t)(BK * 2);
    const size_t hstep = (size_t)HALF * K * 2;
    const size_t tstep = 2 * hstep;
    const unsigned ldsw = (unsigned)wid * 1024u;
    const int aoff = lds_byte(wr * 64 + fr, fq * 8), boff = lds_byte(wc * 32 + fr, fq * 8);
#define PG8_SA(b, h) (((b) * 2 + (h)) * HTB)
#define PG8_SB(b, h) ((4 + (b) * 2 + (h)) * HTB)
#define PG8_STAGE(bufoff, gbase, voff) do { _Pragma("unroll") for (int _i = 0; _i < 2; ++_i) \
        __builtin_amdgcn_global_load_lds((const unsigned*)((const char*)(gbase) + (voff)[_i]), (PG8_LAS unsigned*)(lds + (bufoff) + ldsw + _i * 8192), 16, 0, 0); } while (0)
#define PG8_LDA(dst, b, h) do { _Pragma("unroll") for (int m = 0; m < 4; ++m) _Pragma("unroll") for (int k = 0; k < 2; ++k) dst[m][k] = *(const PG8_LAS bf16x8*)(lds + PG8_SA(b, h) + aoff + m * 2048 + k * 1024); } while (0)
#define PG8_LDB(dst, b, h) do { _Pragma("unroll") for (int n = 0; n < 2; ++n) _Pragma("unroll") for (int k = 0; k < 2; ++k) dst[n][k] = *(const PG8_LAS bf16x8*)(lds + PG8_SB(b, h) + boff + n * 2048 + k * 1024); } while (0)
#define PG8_MMA(ai, bj, At, Bt) do { __builtin_amdgcn_s_setprio(1); _Pragma("unroll") for (int m = 0; m < 4; ++m) _Pragma("unroll") for (int n = 0; n < 2; ++n) _Pragma("unroll") for (int k = 0; k < 2; ++k) \
        acc[ai][bj][m][n] = __builtin_amdgcn_mfma_f32_16x16x32_bf16(Bt[n][k], At[m][k], acc[ai][bj][m][n], 0, 0, 0); __builtin_amdgcn_s_setprio(0); } while (0)
#define PG8_WAIT_V(n) asm volatile("s_waitcnt vmcnt(" #n ")" ::: "memory")
#define PG8_WAIT_L(n) asm volatile("s_waitcnt lgkmcnt(" #n ")" ::: "memory")
#define PG8_BAR __builtin_amdgcn_s_barrier()
#define PG8_SCHED __builtin_amdgcn_sched_barrier(0)
    Unit cur, nxt; int ui = 0;
    if (!S.next(0, cur)) return;
    f32x4 acc[2][2][4][2];
#pragma unroll
    for (int a = 0; a < 2; ++a)
#pragma unroll
        for (int b = 0; b < 2; ++b)
#pragma unroll
            for (int m = 0; m < 4; ++m)
#pragma unroll
                for (int n = 0; n < 2; ++n) acc[a][b][m][n] = (f32x4){0.f, 0.f, 0.f, 0.f};
    bf16x8 At[4][2], B0[2][2], B1[2][2];
    const char* cA = (const char*)g.A + (size_t)cur.pm * tstep; const char* cB = (const char*)g.Bt + (size_t)cur.pn * tstep;
    S.a_ready(cur);
    if constexpr (SP2) {
        PG8_STAGE(PG8_SB(0, 0), cB, voffB); PG8_STAGE(PG8_SB(0, 1), cB + hstep, voffB); PG8_STAGE(PG8_SA(0, 0), cA, voffA); PG8_STAGE(PG8_SA(0, 1), cA + hstep, voffA);
        if (wr == 1) PG8_BAR;
        PG8_WAIT_V(2); PG8_BAR;
        PG8_STAGE(PG8_SB(1, 0), cB + kstep, voffB); PG8_STAGE(PG8_SA(1, 0), cA + kstep, voffA); PG8_STAGE(PG8_SB(1, 1), cB + hstep + kstep, voffB);
        PG8_WAIT_V(6); PG8_BAR;
    } else {
        PG8_STAGE(PG8_SB(0, 0), cB, voffB); PG8_STAGE(PG8_SA(0, 0), cA, voffA); PG8_STAGE(PG8_SB(0, 1), cB + hstep, voffB); PG8_STAGE(PG8_SA(0, 1), cA + hstep, voffA);
        if (wr == 1) PG8_BAR;
        PG8_WAIT_V(4); PG8_BAR;
        PG8_STAGE(PG8_SB(1, 0), cB + kstep, voffB); PG8_STAGE(PG8_SA(1, 0), cA + kstep, voffA); PG8_STAGE(PG8_SB(1, 1), cB + hstep + kstep, voffB);
        PG8_WAIT_V(6); PG8_BAR;
    }
    for (;;) {
        const bool has_next = S.next(ui + 1, nxt);
        const char* nA = has_next ? (const char*)g.A + (size_t)nxt.pm * tstep : cA; const char* nB = has_next ? (const char*)g.Bt + (size_t)nxt.pn * tstep : cB;
        for (int t = 0; t < nt; t += 2) {
            const bool last = (t == nt - 2);
            const char* a1 = cA + (size_t)(t + 1) * kstep;
            const char* a2 = last ? nA : cA + (size_t)(t + 2) * kstep; const char* b2 = last ? nB : cB + (size_t)(t + 2) * kstep;
            const char* a3 = a2 + kstep; const char* b3 = b2 + kstep;
            if (last && has_next) S.a_ready(nxt);
            if constexpr (SP2) {
            PG8_LDB(B0, 0, 0); PG8_LDB(B1, 0, 1); PG8_SCHED; PG8_LDA(At, 0, 0); PG8_STAGE(PG8_SA(1, 1), a1 + hstep, voffA);
            PG8_WAIT_V(8); PG8_WAIT_L(0); PG8_BAR; PG8_MMA(0, 0, At, B0); PG8_MMA(0, 1, At, B1); PG8_BAR; PG8_SCHED;
            PG8_LDA(At, 0, 1); PG8_STAGE(PG8_SB(0, 0), b2, voffB); PG8_STAGE(PG8_SB(0, 1), b2 + hstep, voffB); PG8_STAGE(PG8_SA(0, 0), a2, voffA);
            PG8_WAIT_V(8); PG8_WAIT_L(0); PG8_BAR; PG8_MMA(1, 0, At, B0); PG8_MMA(1, 1, At, B1); PG8_BAR; PG8_SCHED;
            PG8_LDB(B0, 1, 0); PG8_LDB(B1, 1, 1); PG8_SCHED; PG8_LDA(At, 1, 0); PG8_STAGE(PG8_SA(0, 1), a2 + hstep, voffA);
            PG8_WAIT_V(8); PG8_WAIT_L(0); PG8_BAR; PG8_MMA(0, 0, At, B0); PG8_MMA(0, 1, At, B1); PG8_BAR; PG8_SCHED;
            PG8_LDA(At, 1, 1); PG8_STAGE(PG8_SB(1, 0), b3, voffB); PG8_STAGE(PG8_SB(1, 1), b3 + hstep, voffB); PG8_STAGE(PG8_SA(1, 0), a3, voffA);
            PG8_WAIT_V(8); PG8_WAIT_L(0); PG8_BAR; PG8_MMA(1, 0, At, B0); PG8_MMA(1, 1, At, B1); PG8_BAR; PG8_SCHED;
            } else {
            PG8_LDB(B0, 0, 0); PG8_SCHED; PG8_LDA(At, 0, 0); PG8_STAGE(PG8_SA(1, 1), a1 + hstep, voffA);
            PG8_WAIT_L(8); PG8_BAR; PG8_WAIT_L(0); PG8_MMA(0, 0, At, B0); PG8_BAR; PG8_SCHED;
            PG8_LDB(B1, 0, 1); PG8_STAGE(PG8_SB(0, 0), b2, voffB);
            PG8_BAR; PG8_WAIT_L(0); PG8_MMA(0, 1, At, B1); PG8_BAR;
            PG8_LDA(At, 0, 1); PG8_STAGE(PG8_SA(0, 0), a2, voffA);
            PG8_BAR; PG8_WAIT_L(0); PG8_MMA(1, 0, At, B0); PG8_BAR; PG8_SCHED;
            PG8_STAGE(PG8_SB(0, 1), b2 + hstep, voffB);
            PG8_WAIT_V(6); PG8_BAR; PG8_MMA(1, 1, At, B1); PG8_BAR;
            PG8_LDB(B0, 1, 0); PG8_SCHED; PG8_LDA(At, 1, 0); PG8_STAGE(PG8_SA(0, 1), a2 + hstep, voffA);
            PG8_WAIT_L(8); PG8_BAR; PG8_WAIT_L(0); PG8_MMA(0, 0, At, B0); PG8_BAR; PG8_SCHED;
            PG8_LDB(B1, 1, 1); PG8_STAGE(PG8_SB(1, 0), b3, voffB);
            PG8_BAR; PG8_WAIT_L(0); PG8_MMA(0, 1, At, B1); PG8_BAR;
            PG8_LDA(At, 1, 1); PG8_STAGE(PG8_SA(1, 0), a3, voffA);
            PG8_BAR; PG8_WAIT_L(0); PG8_MMA(1, 0, At, B0); PG8_BAR; PG8_SCHED;
            PG8_STAGE(PG8_SB(1, 1), b3 + hstep, voffB);
            PG8_WAIT_V(6); PG8_BAR; PG8_MMA(1, 1, At, B1); PG8_BAR;
            }
        }
        if constexpr (ALIGN_EPI) { if (wr == 0) PG8_BAR; }
        if constexpr (!Epi::AFTER_DRAIN) { E(acc, cur, wr, wc, fr, fq); S.done(cur); }
        if (!has_next) break;
#pragma unroll
        for (int a = 0; a < 2; ++a)
#pragma unroll
            for (int b = 0; b < 2; ++b)
#pragma unroll
                for (int m = 0; m < 4; ++m)
#pragma unroll
                    for (int n = 0; n < 2; ++n) acc[a][b][m][n] = (f32x4){0.f, 0.f, 0.f, 0.f};
        cur = nxt; cA = nA; cB = nB; ++ui;
        if constexpr (ALIGN_EPI) { if (wr == 1) PG8_BAR; }
    }
    PG8_WAIT_V(0);
    if constexpr (!ALIGN_EPI) { if (wr == 0) PG8_BAR; }
    PG8_BAR;
    if constexpr (Epi::AFTER_DRAIN) { E.fused(acc, cur, wr, wc, fr, fq, lds, wid, lane); S.done(cur); }
#undef PG8_SA
#undef PG8_SB
#undef PG8_STAGE
#undef PG8_LDA
#undef PG8_LDB
#undef PG8_MMA
#undef PG8_WAIT_V
#undef PG8_WAIT_L
#undef PG8_BAR
#undef PG8_SCHED
}
}
#define LAS_BAR __attribute__((address_space(3)))
#define XB_TMO      128
#define XB_XCNT(j)  (256  + 64 * (j))
#define XB_XSUB(j)  (1280 + 64 * (j))
#define XB_XGEN(j)  (2304 + 64 * (j))
#define XB_TOP      3328
#define XB_TOPGEN   3392
#define XCD_BAR_WORDS 3456
#define XB_SPIN_CAP (1u << 22)

__device__ __forceinline__ unsigned xb_ld(unsigned* p)              { return __hip_atomic_load(p, __ATOMIC_RELAXED, __HIP_MEMORY_SCOPE_AGENT); }
__device__ __forceinline__ unsigned xb_add(unsigned* p, unsigned v) { return __hip_atomic_fetch_add(p, v, __ATOMIC_RELAXED, __HIP_MEMORY_SCOPE_AGENT); }
__device__ __forceinline__ unsigned xb_xcc_id() { return (unsigned)__builtin_amdgcn_s_getreg((3 << 11) | 20) & 0xFu; }
#define XB_SPIN(cond, bar) do { unsigned _sp = 0; while (cond) { __builtin_amdgcn_s_sleep(1); \
    if ((++_sp & 255u) == 0u) { if (xb_ld(&(bar)[XB_TMO])) break; if (_sp > XB_SPIN_CAP) { atomicAdd(&(bar)[XB_TMO], 1u); break; } } } } while (0)

struct XcdBarrier {
    unsigned* bar; unsigned x;
    volatile LAS_BAR unsigned* st;
};

__device__ __forceinline__ XcdBarrier xcd_barrier_post(unsigned* bar, volatile LAS_BAR unsigned* st) {
    XcdBarrier b; b.bar = bar; b.x = xb_xcc_id(); b.st = st;
    if (threadIdx.x == 0) (void)xb_add(&bar[XB_XCNT(b.x)], 1u);
    return b;
}
__device__ __forceinline__ void xcd_barrier_complete(unsigned* bar, unsigned x, unsigned& nloc, unsigned& nx) {
    const unsigned G = gridDim.x * gridDim.y * gridDim.z;
    unsigned sum, cnt, mine, sp = 0u;
    for (;;) {
        sum = 0u; cnt = 0u; mine = 0u;
#pragma unroll
        for (unsigned j = 0; j < 16; ++j) { const unsigned c = xb_ld(&bar[XB_XCNT(j)]); sum += c; cnt += (c > 0u) ? 1u : 0u; mine = (j == x) ? c : mine; }
        if (sum == G) break;
        __builtin_amdgcn_s_sleep(1);
        if ((++sp & 255u) == 0u) { if (xb_ld(&bar[XB_TMO])) break; if (sp > XB_SPIN_CAP) { atomicAdd(&bar[XB_TMO], 1u); break; } }
    }
    nloc = mine > 0u ? mine : 1u; nx = cnt > 0u ? cnt : 1u;
}

__device__ __forceinline__ void xcd_barrier(const XcdBarrier& b) {
    asm volatile("s_waitcnt vmcnt(0)" ::: "memory");
    __syncthreads();
    if (threadIdx.x == 0) {
        unsigned* bar = b.bar;
        __builtin_amdgcn_s_waitcnt(0);
        unsigned nloc = b.st[0], nx = b.st[1];
        if (nloc == 0u) { xcd_barrier_complete(bar, b.x, nloc, nx); b.st[0] = nloc; b.st[1] = nx; }
        const unsigned old = xb_add(&bar[XB_XSUB(b.x)], 1u);
        const unsigned gen = old / nloc;
        if (old + 1u == (gen + 1u) * nloc) {
            __builtin_amdgcn_fence(__ATOMIC_RELEASE, "agent");
            asm volatile("s_waitcnt vmcnt(0)" ::: "memory");
            const unsigned og = xb_add(&bar[XB_TOP], 1u);
            const unsigned tg = og / nx;
            if (og + 1u == (tg + 1u) * nx) xb_add(&bar[XB_TOPGEN], 1u);
            else XB_SPIN(xb_ld(&bar[XB_TOPGEN]) == tg, bar);
            __builtin_amdgcn_fence(__ATOMIC_ACQUIRE, "agent");
            xb_add(&bar[XB_XGEN(b.x)], 1u);
            asm volatile("s_waitcnt vmcnt(0)" ::: "memory");
        } else {
            XB_SPIN(xb_ld(&bar[XB_XGEN(b.x)]) == gen, bar);
            __builtin_amdgcn_fence(__ATOMIC_ACQUIRE, "agent");
            asm volatile("s_waitcnt vmcnt(0)" ::: "memory");
        }
    }
    __syncthreads();
}

constexpr int NWAVES = 8, NTHR = 512;
constexpr int BATCH = 2, T = 16384, D = 2048, FF = 5632, M = BATCH * T;
constexpr int ZN = 5120;
constexpr int ZA = 1536;
constexpr int A_COLS = 3360, E_IN = 4896;
constexpr int ZO = 4096;
constexpr int NSUB = 12;
#ifndef MK_ONE_LAUNCH
#define MK_ONE_LAUNCH 0
#endif

constexpr size_t MiB = 1u << 20;
constexpr size_t WS_CTL = 0, CTL_ZERO_BYTES = 1 * MiB;
constexpr size_t WS_SS = 1 * MiB;
constexpr size_t SS_REC = 8 * (size_t)M;
constexpr size_t WS_WT = 16 * MiB;
constexpr size_t WT_GU1 = WS_WT, WT_D1 = WT_GU1 + 44 * MiB, WT_GU2 = WT_D1 + 22 * MiB, WT_D2 = WT_GU2 + 44 * MiB, WT_IN = WT_D2 + 22 * MiB, WT_OUT = WT_IN + 20 * MiB;
constexpr size_t WS_XB = WT_OUT + 8 * MiB;
constexpr size_t WS_ACT = WS_XB + 128 * MiB;
constexpr size_t WS_SC = WS_ACT + 352 * MiB;
constexpr size_t SC_R = WS_SC, SC_K2 = SC_R + 64 * MiB, SC_KK = SC_K2 + 64 * MiB, SC_BB = SC_KK + 64 * MiB, SC_LW = SC_BB + 64 * MiB, SC_GG = SC_LW + 64 * MiB;
constexpr size_t WS_VF = SC_GG + 64 * MiB;
constexpr size_t WS_V2 = WS_VF + 64 * MiB;
constexpr size_t WS_O = WS_V2 + 64 * MiB;
constexpr size_t WS_SM = WS_O + 128 * MiB;
constexpr size_t SM_W2T = WS_SM, SM_A2T = SM_W2T + 131072, SM_G2T = SM_A2T + 131072, SM_V1T = SM_G2T + 327680, SM_V2T = SM_V1T + 65536, SM_WSB = SM_V2T + 65536;
constexpr size_t WS_END = WS_SM + 2 * MiB;
static_assert(SM_WSB + 524288 <= WS_END, "small-weight map");
static_assert(WT_OUT + 8 * MiB == 176 * MiB && WS_SS + 15 * MiB <= WS_WT, "weight map");
constexpr int CW_TMO = 0, CW_CODE = 1, CW_BAR = 4096;

constexpr int LDS_BYTES = 147456, LDSCTL_OFF = LDS_BYTES - 512;

#define GAS __attribute__((address_space(1)))
#define LAS __attribute__((address_space(3)))
typedef unsigned short bf16;
typedef unsigned v4u __attribute__((ext_vector_type(4)));
typedef unsigned v2u __attribute__((ext_vector_type(2)));
typedef float f32x4 __attribute__((ext_vector_type(4)));
typedef float f32x2 __attribute__((ext_vector_type(2)));
typedef GAS unsigned gu32;
#define RLX_AGENT __ATOMIC_RELAXED, __HIP_MEMORY_SCOPE_AGENT
#define LDS_WAIT() asm volatile("s_waitcnt lgkmcnt(0)" ::: "memory")
__device__ __forceinline__ unsigned f2bf(float f) { unsigned u = __builtin_bit_cast(unsigned, f); return (u + 0x7fffu + ((u >> 16) & 1u)) >> 16; }
__device__ __forceinline__ unsigned pk2(float lo, float hi) { return f2bf(lo) | (f2bf(hi) << 16); }
__device__ __forceinline__ float bf2f(bf16 b) { return __builtin_bit_cast(float, (unsigned)b << 16); }
__device__ __forceinline__ float bflo(unsigned w) { return __builtin_bit_cast(float, w << 16); }
__device__ __forceinline__ float bfhi(unsigned w) { return __builtin_bit_cast(float, w & 0xffff0000u); }
__device__ __forceinline__ float wave_sum(float v) {
#pragma unroll
    for (int o = 1; o < 64; o <<= 1) v += __shfl_xor(v, o);
    return v;
}
template <int CTRL> __device__ __forceinline__ float dpp_mov(float v) { return __builtin_bit_cast(float, __builtin_amdgcn_update_dpp(0, __builtin_bit_cast(int, v), CTRL, 0xf, 0xf, true)); }
__device__ __forceinline__ float row16_sum(float v) { v += dpp_mov<0xB1>(v); v += dpp_mov<0x4E>(v); v += dpp_mov<0x141>(v); v += dpp_mov<0x140>(v); return v; }
__device__ __forceinline__ float sigmoidf_(float x) { return 1.0f / (1.0f + __expf(-x)); }

__device__ __forceinline__ int opaque(int v) { asm volatile("" : "+v"(v)); return v; }
struct Args { const float* in[29]; float* out; unsigned char* ws; int ph_lo, ph_hi; };
static_assert(sizeof(Args) == 29 * 8 + 8 + 8 + 8, "Args has no padding");
enum { I_X = 0, I_NG, I_WG, I_WU, I_WD, I_EWIN, I_EBQKV, I_EMU, I_EW0, I_EW2, I_EA0, I_EA2, I_EG2, I_EKK, I_EKA, I_ERK, I_EGNG, I_EGNB, I_ESINK, I_EWOUT, I_V0, I_V1, I_V2, I_OWIN, I_OVNG, I_OWS, I_OBS, I_OWOUT, I_FG };

__device__ __forceinline__ void tr_item(const float* W, int ldw, int k0, int c0, const float* gk, bf16* WT, int K, int drow0, LAS float* scr, int lane, bool zero) {
    if (!zero) {
#pragma unroll 8
        for (int i = 0; i < 32; ++i) { const int kk = 2 * i + (lane >> 5); float v = W[(size_t)(k0 + kk) * ldw + c0 + (lane & 31)]; if (gk) v *= gk[k0 + kk]; scr[kk * 33 + (lane & 31)] = v; }
    } else {
#pragma unroll 8
        for (int i = 0; i < 32; ++i) { const int kk = 2 * i + (lane >> 5); scr[kk * 33 + (lane & 31)] = 0.f; }
    }
    LDS_WAIT(); asm volatile("" ::: "memory");
    const int c = lane & 7;
#pragma unroll
    for (int j = 0; j < 4; ++j) { const int n = (lane >> 3) + 8 * j; const LAS float* s = scr + (8 * c) * 33 + n;
        v4u o; o.x = pk2(s[0 * 33], s[1 * 33]); o.y = pk2(s[2 * 33], s[3 * 33]); o.z = pk2(s[4 * 33], s[5 * 33]); o.w = pk2(s[6 * 33], s[7 * 33]);
        *(GAS v4u*)(WT + (size_t)(drow0 + n) * K + k0 + 8 * c) = o; }
    LDS_WAIT(); asm volatile("" ::: "memory");
}
__device__ __forceinline__ void prep_phase(const Args& a, int L, LAS unsigned char* lds, int vcu, int G, int wave, int lane) {
    LAS float* scr = (LAS float*)(lds + wave * 16384);
    const int gw = vcu * NWAVES + wave, NGW = G * NWAVES;
    unsigned char* ws = a.ws;
    const bool even = !(L & 1); const int li = L >> 1;
    constexpr int nGU = 32 * 352, nD = 88 * 64, nOUT = 32 * 64;
    const int nIN = 32 * (even ? 160 : 128);
    const int total = 2 * nGU + 2 * nD + nIN + nOUT;
    for (int it = gw; it < total; it += NGW) {
        int r = it;
        if (r < 2 * nGU) { const int f = r / nGU; r -= f * nGU; const int kb = r / 352, rb = r % 352, tj = rb >> 3, sub = rb & 7;
            const float* W = (sub < 4 ? a.in[I_WG] : a.in[I_WU]) + (size_t)(L * 2 + f) * D * FF;
            tr_item(W, FF, 64 * kb, 128 * tj + 32 * (sub & 3), a.in[I_NG] + (L * 3 + (f ? 2 : 0)) * D, (bf16*)(ws + (f ? WT_GU2 : WT_GU1)), D, 32 * rb, scr, lane, false); continue; }
        r -= 2 * nGU;
        if (r < 2 * nD) { const int f = r / nD; r -= f * nD; const int kb = r / 64, nb = r % 64;
            tr_item(a.in[I_WD] + (size_t)(L * 2 + f) * FF * D, D, 64 * kb, 32 * nb, nullptr, (bf16*)(ws + (f ? WT_D2 : WT_D1)), FF, 32 * nb, scr, lane, false); continue; }
        r -= 2 * nD;
        if (r < nIN) {
            if (even) { const int kb = r / 160, rb = r % 160, d = 32 * rb; const bool zero = d >= E_IN; const int c0 = d < ZA ? A_COLS + d : d - ZA;
                tr_item(a.in[I_EWIN] + (size_t)li * D * E_IN, E_IN, 64 * kb, zero ? 0 : c0, a.in[I_NG] + (L * 3 + 1) * D, (bf16*)(ws + WT_IN), D, d, scr, lane, zero); }
            else { const int kb = r / 128, rb = r % 128;
                tr_item(a.in[I_OWIN] + (size_t)li * D * ZO, ZO, 64 * kb, 32 * rb, a.in[I_NG] + (L * 3 + 1) * D, (bf16*)(ws + WT_IN), D, 32 * rb, scr, lane, false); }
            continue; }
        r -= nIN;
        { const int kb = r / 64, nb = r % 64;
          tr_item((even ? a.in[I_EWOUT] : a.in[I_OWOUT]) + (size_t)li * D * D, D, 64 * kb, 32 * nb, nullptr, (bf16*)(ws + WT_OUT), D, 32 * nb, scr, lane, false); }
    }
    {
        const int gt = gw * 64 + lane, NGT = NGW * 64;
        if (even) {
            const float* w2 = a.in[I_EW2] + (size_t)li * 64 * 1024; const float* a2 = a.in[I_EA2] + (size_t)li * 64 * 1024; const float* g2 = a.in[I_EG2] + (size_t)li * 160 * 1024;
            bf16* W2T = (bf16*)(ws + SM_W2T); bf16* A2T = (bf16*)(ws + SM_A2T); bf16* G2T = (bf16*)(ws + SM_G2T);
            for (int e = gt; e < 1024 * 64; e += NGT) { const int k = e >> 10, c = e & 1023; W2T[c * 64 + k] = (bf16)f2bf(w2[e]); A2T[c * 64 + k] = (bf16)f2bf(a2[e]); }
            for (int e = gt; e < 1024 * 160; e += NGT) { const int k = e >> 10, c = e & 1023; G2T[c * 160 + k] = (bf16)f2bf(g2[e]); }
            if (li > 0) { bf16* V1T = (bf16*)(ws + SM_V1T); bf16* V2T = (bf16*)(ws + SM_V2T);
                for (int e = gt; e < 1024 * 32; e += NGT) { const int c = e >> 5, j = e & 31; V1T[j * 1024 + c] = (bf16)f2bf(a.in[I_V1][e]); }
                for (int e = gt; e < 32 * 1024; e += NGT) { const int j = e >> 10, c = e & 1023; V2T[c * 32 + j] = (bf16)f2bf(a.in[I_V2][e]); } }
        } else {
            const float* wsg = a.in[I_OWS] + (size_t)li * 16 * 128 * 128; bf16* WSB = (bf16*)(ws + SM_WSB);
            for (int e = gt; e < 16 * 128 * 128; e += NGT) { const int i = (e >> 7) & 127, j = e & 127; WSB[e] = (bf16)f2bf(j <= i ? wsg[e] : 0.f); }
        }
    }
    if (L == 0) {
        float* ss0 = (float*)(ws + WS_SS); bf16* XB = (bf16*)(ws + WS_XB);
        for (int m = gw; m < M; m += NGW) {
            const GAS f32x4* xr = (const GAS f32x4*)(a.in[I_X] + (size_t)m * D) + lane; GAS v2u* o = (GAS v2u*)(XB + (size_t)m * D) + lane; float s = 0.f;
#pragma unroll
            for (int j = 0; j < 8; ++j) { const f32x4 v = xr[64 * j]; s += (v.x * v.x + v.y * v.y) + (v.z * v.z + v.w * v.w); v2u w; w.x = pk2(v.x, v.y); w.y = pk2(v.z, v.w); o[64 * j] = w; }
            s = wave_sum(s); if (lane < 8) ss0[(size_t)lane * M + m] = lane ? 0.f : s;
        }
    }
}

typedef short bf16x8_t __attribute__((ext_vector_type(8)));
__device__ __forceinline__ float fast_tanh(float x) { const float e = __expf(2.0f * x); return 1.0f - 2.0f / (1.0f + e); }
__device__ __forceinline__ void lerp8(const v4u c, const v4u p, const float* mu, float (&o)[8]) {
    const f32x4 m0 = *(const f32x4*)mu, m1 = *(const f32x4*)(mu + 4);
    const float c0 = bflo(c.x), c1 = bfhi(c.x), c2 = bflo(c.y), c3 = bfhi(c.y), c4 = bflo(c.z), c5 = bfhi(c.z), c6 = bflo(c.w), c7 = bfhi(c.w);
    o[0] = c0 + (bflo(p.x) - c0) * m0.x; o[1] = c1 + (bfhi(p.x) - c1) * m0.y; o[2] = c2 + (bflo(p.y) - c2) * m0.z; o[3] = c3 + (bfhi(p.y) - c3) * m0.w;
    o[4] = c4 + (bflo(p.z) - c4) * m1.x; o[5] = c5 + (bfhi(p.z) - c5) * m1.y; o[6] = c6 + (bflo(p.w) - c6) * m1.z; o[7] = c7 + (bfhi(p.w) - c7) * m1.w;
}
__device__ __forceinline__ void lerp4(const v2u c, const v2u p, const f32x4 m, float (&o)[4]) {
    const float c0 = bflo(c.x), c1 = bfhi(c.x), c2 = bflo(c.y), c3 = bfhi(c.y);
    o[0] = c0 + (bflo(p.x) - c0) * m.x; o[1] = c1 + (bfhi(p.x) - c1) * m.y; o[2] = c2 + (bflo(p.y) - c2) * m.z; o[3] = c3 + (bfhi(p.y) - c3) * m.w;
}
__device__ __forceinline__ v2u pack4(float a, float b, float c, float d) { v2u w; w.x = pk2(a, b); w.y = pk2(c, d); return w; }
constexpr int E1_AW = 0, E1_AA = 9216, E1_AG = 18432, E1_PP = 40960, E1_PB = 106496;
__device__ __forceinline__ void e1_phase(const Args& a, int li, LAS unsigned char* ldsb, int vcu, int G, int tid) {
    unsigned char* ws = a.ws;
    const bf16* Z = (const bf16*)(ws + WS_ACT);
    bf16* R = (bf16*)(ws + SC_R); bf16* K2 = (bf16*)(ws + SC_K2); bf16* KK = (bf16*)(ws + SC_KK); bf16* BB = (bf16*)(ws + SC_BB); bf16* LW = (bf16*)(ws + SC_LW); bf16* GG = (bf16*)(ws + SC_GG);
    bf16* VO = (bf16*)(ws + (li ? WS_V2 : WS_VF)); const bf16* VF = (const bf16*)(ws + WS_VF);
    const bf16* W2T = (const bf16*)(ws + SM_W2T); const bf16* A2T = (const bf16*)(ws + SM_A2T); const bf16* G2T = (const bf16*)(ws + SM_G2T);
    const bf16* V1T = (const bf16*)(ws + SM_V1T); const bf16* V2T = (const bf16*)(ws + SM_V2T);
    const float* mu = a.in[I_EMU] + li * A_COLS;
    const float* w0 = a.in[I_EW0] + li * 1024; const float* a0 = a.in[I_EA0] + li * 1024;
    const float* kkw = a.in[I_EKK] + li * 1024; const float* kaw = a.in[I_EKA] + li * 1024; const float* v0w = a.in[I_V0];
    const int lane = tid & 63, wave = tid >> 6, fr = lane & 15, fq = lane >> 4;
    for (int unit = vcu; unit < M / 64; unit += G) {
        const int m0 = unit * 64;
        for (int e = tid; e < 64 * 36; e += NTHR) { const int r = e / 36, ch = e % 36, j0 = 8 * ch, m = m0 + r; const bool first = (m & (T - 1)) == 0;
            const v4u cur = *(const GAS v4u*)(Z + (size_t)m * ZN + ZA + 3072 + j0); v4u prv = {0u, 0u, 0u, 0u}; if (!first) prv = *(const GAS v4u*)(Z + (size_t)(m - 1) * ZN + ZA + 3072 + j0);
            float x[8]; lerp8(cur, prv, mu + 3072 + j0, x);
            if (j0 < 64) {
#pragma unroll
                for (int i = 0; i < 8; ++i) x[i] = fast_tanh(x[i]);
            } else if (j0 >= 128) {
#pragma unroll
                for (int i = 0; i < 8; ++i) x[i] = sigmoidf_(x[i]);
            }
            v4u o; o.x = pk2(x[0], x[1]); o.y = pk2(x[2], x[3]); o.z = pk2(x[4], x[5]); o.w = pk2(x[6], x[7]);
            LAS unsigned char* dst = j0 < 64 ? ldsb + E1_AW + r * 144 + j0 * 2 : j0 < 128 ? ldsb + E1_AA + r * 144 + (j0 - 64) * 2 : ldsb + E1_AG + r * 336 + (j0 - 128) * 2;
            *(LAS v4u*)dst = o; }
        if (li > 0) {
            f32x4 pacc[4][2];
#pragma unroll
            for (int mt = 0; mt < 4; ++mt) { pacc[mt][0] = (f32x4){0.f, 0.f, 0.f, 0.f}; pacc[mt][1] = pacc[mt][0]; }
            for (int ks = 0; ks < 4; ++ks) { const int c = 128 * wave + 32 * ks + 8 * fq;
                const bf16x8_t w0f = *(const GAS bf16x8_t*)(V1T + (size_t)fr * 1024 + c), w1f = *(const GAS bf16x8_t*)(V1T + (size_t)(16 + fr) * 1024 + c);
#pragma unroll
                for (int mt = 0; mt < 4; ++mt) { const int m = m0 + 16 * mt + fr; const bool first = (m & (T - 1)) == 0;
                    const v4u cur = *(const GAS v4u*)(Z + (size_t)m * ZN + ZA + 2048 + c); v4u prv = {0u, 0u, 0u, 0u}; if (!first) prv = *(const GAS v4u*)(Z + (size_t)(m - 1) * ZN + ZA + 2048 + c);
                    float x[8]; lerp8(cur, prv, mu + 2048 + c, x);
                    v4u o; o.x = pk2(x[0], x[1]); o.y = pk2(x[2], x[3]); o.z = pk2(x[4], x[5]); o.w = pk2(x[6], x[7]);
                    const bf16x8_t af = __builtin_bit_cast(bf16x8_t, o);
                    pacc[mt][0] = __builtin_amdgcn_mfma_f32_16x16x32_bf16(w0f, af, pacc[mt][0], 0, 0, 0); pacc[mt][1] = __builtin_amdgcn_mfma_f32_16x16x32_bf16(w1f, af, pacc[mt][1], 0, 0, 0); } }
#pragma unroll
            for (int mt = 0; mt < 4; ++mt)
#pragma unroll
                for (int nt = 0; nt < 2; ++nt) *(LAS f32x4*)(ldsb + E1_PP + ((wave * 64 + 16 * mt + fr) * 32 + 16 * nt + 4 * fq) * 4) = pacc[mt][nt];
        }
        __syncthreads();
        if (li > 0) {
            for (int e = tid; e < 64 * 32; e += NTHR) { float sum = 0.f;
#pragma unroll
                for (int w = 0; w < 8; ++w) sum += *(const LAS float*)(ldsb + E1_PP + (w * 2048 + e) * 4);
                *(LAS bf16*)(ldsb + E1_PB + (e >> 5) * 80 + (e & 31) * 2) = (bf16)f2bf(sum); }
            __syncthreads();
        }
#pragma unroll 1
        for (int hm = 0; hm < 8; ++hm) {
            const int hh = hm >> 2, mt = hm & 3;
            const int cb = 128 * wave + 64 * hh;
            const int m = m0 + 16 * mt + fr; const bool first = (m & (T - 1)) == 0;
            f32x4 aa[4], aw[4], ag[4], avr[4];
#pragma unroll
            for (int nt = 0; nt < 4; ++nt) { aa[nt] = (f32x4){0.f, 0.f, 0.f, 0.f}; aw[nt] = aa[nt]; ag[nt] = aa[nt]; avr[nt] = aa[nt]; }
#pragma unroll
            for (int ks = 0; ks < 2; ++ks) {
                const bf16x8_t fa = *(const LAS bf16x8_t*)(ldsb + E1_AA + (16 * mt + fr) * 144 + (32 * ks + 8 * fq) * 2), fw = *(const LAS bf16x8_t*)(ldsb + E1_AW + (16 * mt + fr) * 144 + (32 * ks + 8 * fq) * 2);
#pragma unroll
                for (int nt = 0; nt < 4; ++nt) { const size_t wo = (size_t)(cb + 16 * nt + fr) * 64 + 32 * ks + 8 * fq;
                    aa[nt] = __builtin_amdgcn_mfma_f32_16x16x32_bf16(*(const GAS bf16x8_t*)(A2T + wo), fa, aa[nt], 0, 0, 0);
                    aw[nt] = __builtin_amdgcn_mfma_f32_16x16x32_bf16(*(const GAS bf16x8_t*)(W2T + wo), fw, aw[nt], 0, 0, 0); } }
#pragma unroll
            for (int ks = 0; ks < 5; ++ks) { const bf16x8_t fg = *(const LAS bf16x8_t*)(ldsb + E1_AG + (16 * mt + fr) * 336 + (32 * ks + 8 * fq) * 2);
#pragma unroll
                for (int nt = 0; nt < 4; ++nt) ag[nt] = __builtin_amdgcn_mfma_f32_16x16x32_bf16(*(const GAS bf16x8_t*)(G2T + (size_t)(cb + 16 * nt + fr) * 160 + 32 * ks + 8 * fq), fg, ag[nt], 0, 0, 0); }
            if (li > 0) { const bf16x8_t fp = *(const LAS bf16x8_t*)(ldsb + E1_PB + (16 * mt + fr) * 80 + (8 * fq) * 2);
#pragma unroll
                for (int nt = 0; nt < 4; ++nt) avr[nt] = __builtin_amdgcn_mfma_f32_16x16x32_bf16(*(const GAS bf16x8_t*)(V2T + (size_t)(cb + 16 * nt + fr) * 32 + 8 * fq), fp, avr[nt], 0, 0, 0); }
            const size_t zo = (size_t)m * ZN + ZA + cb + 4 * fq;
            float k1[4][4], av[4][4], kk0[4][4]; float n2 = 0.f;
#pragma unroll
            for (int nt = 0; nt < 4; ++nt) { const int c = cb + 16 * nt + 4 * fq;
                const v2u cur = *(const GAS v2u*)(Z + zo + 1024 + 16 * nt); v2u prv = {0u, 0u}; if (!first) prv = *(const GAS v2u*)(Z + zo - ZN + 1024 + 16 * nt);
                lerp4(cur, prv, *(const f32x4*)(mu + 1024 + c), k1[nt]);
                const f32x4 a0v = *(const f32x4*)(a0 + c), kkv = *(const f32x4*)(kkw + c);
#pragma unroll
                for (int j = 0; j < 4; ++j) { av[nt][j] = sigmoidf_(a0v[j] + aa[nt][j]); kk0[nt][j] = k1[nt][j] * kkv[j]; n2 += kk0[nt][j] * kk0[nt][j]; } }
            n2 += __shfl_xor(n2, 16); n2 += __shfl_xor(n2, 32);
            const float inv = 1.0f / fmaxf(sqrtf(n2), 1e-12f);
#pragma unroll
            for (int nt = 0; nt < 4; ++nt) { const int c = cb + 16 * nt + 4 * fq; const size_t o = (size_t)m * 1024 + c; const f32x4 kav = *(const f32x4*)(kaw + c), w0v = *(const f32x4*)(w0 + c);
                float kk[4], k2[4], bb[4], lw[4];
#pragma unroll
                for (int j = 0; j < 4; ++j) { kk[j] = kk0[nt][j] * inv; k2[j] = k1[nt][j] * (1.0f + (av[nt][j] - 1.0f) * kav[j]); bb[j] = kk[j] * av[nt][j];
                    const float y = -(w0v[j] + aw[nt][j]); const float sp = fmaxf(y, 0.f) + __logf(1.0f + __expf(-fabsf(y))); lw[j] = -__expf(-sp - 0.5f); }
                *(GAS v2u*)(KK + o) = pack4(kk[0], kk[1], kk[2], kk[3]); *(GAS v2u*)(K2 + o) = pack4(k2[0], k2[1], k2[2], k2[3]); *(GAS v2u*)(BB + o) = pack4(bb[0], bb[1], bb[2], bb[3]);
                *(GAS v2u*)(LW + o) = pack4(lw[0], lw[1], lw[2], lw[3]); *(GAS v2u*)(GG + o) = pack4(ag[nt][0], ag[nt][1], ag[nt][2], ag[nt][3]);
                const v2u rc = *(const GAS v2u*)(Z + zo + 16 * nt), vc = *(const GAS v2u*)(Z + zo + 2048 + 16 * nt); v2u rp = {0u, 0u}, vp = {0u, 0u};
                if (!first) { rp = *(const GAS v2u*)(Z + zo - ZN + 16 * nt); vp = *(const GAS v2u*)(Z + zo - ZN + 2048 + 16 * nt); }
                float rr[4], vv[4]; lerp4(rc, rp, *(const f32x4*)(mu + c), rr); lerp4(vc, vp, *(const f32x4*)(mu + 2048 + c), vv);
                if (li > 0) { const f32x4 v0v = *(const f32x4*)(v0w + c); const v2u vf = *(const GAS v2u*)(VF + o); const float f0 = bflo(vf.x), f1 = bfhi(vf.x), f2 = bflo(vf.y), f3 = bfhi(vf.y);
                    vv[0] += (f0 - vv[0]) * sigmoidf_(v0v[0] + avr[nt][0]); vv[1] += (f1 - vv[1]) * sigmoidf_(v0v[1] + avr[nt][1]);
                    vv[2] += (f2 - vv[2]) * sigmoidf_(v0v[2] + avr[nt][2]); vv[3] += (f3 - vv[3]) * sigmoidf_(v0v[3] + avr[nt][3]); }
                *(GAS v2u*)(R + o) = pack4(rr[0], rr[1], rr[2], rr[3]); *(GAS v2u*)(VO + o) = pack4(vv[0], vv[1], vv[2], vv[3]); }
        }
        __syncthreads();
    }
}

constexpr int SCH = 32;
__device__ __forceinline__ void scan_fill(LAS float* vecb, LAS float* vvb, const bf16* LW, const bf16* K2, const bf16* R, const bf16* KK, const bf16* BB, const bf16* V, size_t rowbase, int colh, int q, int ft, int nft) {
    for (int e = ft; e < 5 * SCH * 8; e += nft) { const int i = e / (SCH * 8), rem = e % (SCH * 8), tt = rem >> 3, j = rem & 7;
        const bf16* src = (i == 0 ? LW : i == 1 ? K2 : i == 2 ? R : i == 3 ? KK : BB) + (rowbase + tt) * 1024 + colh + 8 * j;
        const v4u w = *(const GAS v4u*)src; f32x4 lo, hi;
        lo.x = bflo(w.x); lo.y = bfhi(w.x); lo.z = bflo(w.y); lo.w = bfhi(w.y); hi.x = bflo(w.z); hi.y = bfhi(w.z); hi.z = bflo(w.w); hi.w = bfhi(w.w);
        if (i == 0) { lo.x = __expf(lo.x); lo.y = __expf(lo.y); lo.z = __expf(lo.z); lo.w = __expf(lo.w); hi.x = __expf(hi.x); hi.y = __expf(hi.y); hi.z = __expf(hi.z); hi.w = __expf(hi.w); }
        if (i == 3) { lo = -lo; hi = -hi; }
        LAS f32x4* d = (LAS f32x4*)(vecb + (i * SCH + tt) * 64 + 8 * j); d[0] = lo; d[1] = hi; }
    for (int e = ft; e < SCH * 2; e += nft) { const int tt = e >> 1, hf = e & 1;
        const v4u w = *(const GAS v4u*)(V + (rowbase + tt) * 1024 + colh + 16 * q + 8 * hf); f32x4 lo, hi;
        lo.x = bflo(w.x); lo.y = bfhi(w.x); lo.z = bflo(w.y); lo.w = bfhi(w.y); hi.x = bflo(w.z); hi.y = bfhi(w.z); hi.z = bflo(w.w); hi.w = bfhi(w.w);
        LAS f32x4* d = (LAS f32x4*)(vvb + tt * 16 + 8 * hf); d[0] = lo; d[1] = hi; }
}
__device__ __forceinline__ void scan_unit(const Args& a, int li, int su, LAS unsigned char* ldsb, int tid) {
    unsigned char* ws = a.ws;
    const bf16* R = (const bf16*)(ws + SC_R); const bf16* K2 = (const bf16*)(ws + SC_K2); const bf16* KK = (const bf16*)(ws + SC_KK); const bf16* BB = (const bf16*)(ws + SC_BB); const bf16* LW = (const bf16*)(ws + SC_LW);
    const bf16* V = (const bf16*)(ws + (li ? WS_V2 : WS_VF)); float* Y = (float*)(ws + WS_XB);
    const int bh = su >> 2, q = su & 3, b = bh >> 4, h = bh & 15, colh = h * 64; const size_t row0 = (size_t)b * T;
    LAS float* vec = (LAS float*)ldsb;
    LAS float* vvl = vec + 2 * 5 * SCH * 64;
    LAS float* ybl = vvl + 2 * SCH * 16;
    const int lane = tid & 63, cw = tid >> 6, rp = lane >> 4, kg = lane & 15, lr0 = 8 * cw + 2 * rp;
    f32x4 S0 = {0.f, 0.f, 0.f, 0.f}, S1 = {0.f, 0.f, 0.f, 0.f};
    scan_fill(vec, vvl, LW, K2, R, KK, BB, V, row0, colh, q, tid, NTHR);
    constexpr int NCH = T / SCH;
    for (int c = 0; c < NCH; ++c) {
        __syncthreads();
        const int buf = c & 1;
        if (tid < 128) {
            const LAS float* vb = vec + buf * 5 * SCH * 64 + 4 * kg; const LAS float* vvb = vvl + buf * SCH * 16 + lr0;
            LAS float* yb = (kg == 0) ? ybl + buf * SCH * 16 + lr0 : ybl + 2 * SCH * 16 + tid * 2;
            const int ystep = (kg == 0) ? 16 : 0;
            f32x4 wv = *(const LAS f32x4*)(vb), kv = *(const LAS f32x4*)(vb + SCH * 64), rv = *(const LAS f32x4*)(vb + 2 * SCH * 64), av = *(const LAS f32x4*)(vb + 3 * SCH * 64), bv = *(const LAS f32x4*)(vb + 4 * SCH * 64);
            f32x2 v2 = *(const LAS f32x2*)(vvb);
#pragma unroll 2
            for (int t = 0; t < SCH; ++t) {
                const int tn = (t + 1 < SCH) ? t + 1 : t;
                const f32x4 wn = *(const LAS f32x4*)(vb + tn * 64), kn = *(const LAS f32x4*)(vb + (SCH + tn) * 64), rn = *(const LAS f32x4*)(vb + (2 * SCH + tn) * 64),
                            an = *(const LAS f32x4*)(vb + (3 * SCH + tn) * 64), bn = *(const LAS f32x4*)(vb + (4 * SCH + tn) * 64);
                const f32x2 vn = *(const LAS f32x2*)(vvb + tn * 16);
                float sa0 = (S0.x * av.x + S0.y * av.y) + (S0.z * av.z + S0.w * av.w), sa1 = (S1.x * av.x + S1.y * av.y) + (S1.z * av.z + S1.w * av.w);
                sa0 = row16_sum(sa0); sa1 = row16_sum(sa1);
                S0 = S0 * wv + (bv * sa0 + kv * v2.x); S1 = S1 * wv + (bv * sa1 + kv * v2.y);
                float y0 = (S0.x * rv.x + S0.y * rv.y) + (S0.z * rv.z + S0.w * rv.w), y1 = (S1.x * rv.x + S1.y * rv.y) + (S1.z * rv.z + S1.w * rv.w);
                y0 = row16_sum(y0); y1 = row16_sum(y1);
                *(LAS f32x2*)(yb + t * ystep) = (f32x2){y0, y1};
                wv = wn; kv = kn; rv = rn; av = an; bv = bn; v2 = vn;
            }
        } else {
            const int ft = tid - 128;
            if (c + 1 < NCH) scan_fill(vec + (buf ^ 1) * 5 * SCH * 64, vvl + (buf ^ 1) * SCH * 16, LW, K2, R, KK, BB, V, row0 + (size_t)(c + 1) * SCH, colh, q, ft, NTHR - 128);
            if (c > 0 && ft < 128) { const int tt = ft >> 2, part = ft & 3;
                *(GAS f32x4*)(Y + (row0 + (size_t)(c - 1) * SCH + tt) * 1024 + colh + 16 * q + 4 * part) = *(const LAS f32x4*)(ybl + (buf ^ 1) * SCH * 16 + tt * 16 + 4 * part); }
        }
    }
    __syncthreads();
    if (tid < 128) { const int tt = tid >> 2, part = tid & 3;
        *(GAS f32x4*)(Y + (row0 + (size_t)(NCH - 1) * SCH + tt) * 1024 + colh + 16 * q + 4 * part) = *(const LAS f32x4*)(ybl + ((NCH - 1) & 1) * SCH * 16 + tt * 16 + 4 * part); }
    __syncthreads();
}

__device__ __forceinline__ void attn_unit(const Args& a, int li, int au, LAS unsigned char* ldsb, int tid) {
    unsigned char* ws = a.ws; const bf16* Z = (const bf16*)(ws + WS_ACT); bf16* O = (bf16*)(ws + WS_O);
    const int n = au & 127, kvh = (au >> 7) & 3, b = au >> 9;
    LAS float* Ks = (LAS float*)ldsb; LAS float* Vs = Ks + 256 * 68;
    const size_t rblk = (size_t)b * T + (size_t)n * 128;
    for (int e = tid; e < 256 * 8 * 2; e += NTHR) { const int which = e >> 11, rem = e & 2047, j = rem >> 3, c8 = rem & 7; const bool valid = (n > 0) || (j >= 128);
        f32x4 lo = {0.f, 0.f, 0.f, 0.f}, hi = lo;
        if (valid) { const v4u w = *(const GAS v4u*)(Z + (rblk + j - 128) * ZN + 1024 + which * 256 + kvh * 64 + 8 * c8);
            lo.x = bflo(w.x); lo.y = bfhi(w.x); lo.z = bflo(w.y); lo.w = bfhi(w.y); hi.x = bflo(w.z); hi.y = bfhi(w.z); hi.z = bflo(w.w); hi.w = bfhi(w.w); }
        LAS f32x4* d = (LAS f32x4*)((which ? Vs : Ks) + j * 68 + 8 * c8); d[0] = lo; d[1] = hi; }
    __syncthreads();
    const int g = tid >> 7, i = tid & 127, hq = kvh * 4 + g; const size_t row = rblk + i;
    float qv[64];
    { const GAS v4u* qp = (const GAS v4u*)(Z + row * ZN + hq * 64);
#pragma unroll
      for (int c = 0; c < 8; ++c) { const v4u w = qp[c]; qv[8 * c + 0] = bflo(w.x) * 0.125f; qv[8 * c + 1] = bfhi(w.x) * 0.125f; qv[8 * c + 2] = bflo(w.y) * 0.125f; qv[8 * c + 3] = bfhi(w.y) * 0.125f;
          qv[8 * c + 4] = bflo(w.z) * 0.125f; qv[8 * c + 5] = bfhi(w.z) * 0.125f; qv[8 * c + 6] = bflo(w.w) * 0.125f; qv[8 * c + 7] = bfhi(w.w) * 0.125f; } }
    const float slope = exp2f(-0.5f * (float)(hq + 1)); const float sink = a.in[I_ESINK][li * 16 + hq];
    float mx = sink, l = 1.0f; float acc[64];
#pragma unroll
    for (int d = 0; d < 64; ++d) acc[d] = 0.f;
    for (int jj = 0; jj < 128; ++jj) { const int j = i + 1 + jj; const bool valid = (n > 0) || (j >= 128);
        const LAS f32x4* kr = (const LAS f32x4*)(Ks + j * 68); float s0 = 0.f, s1 = 0.f;
#pragma unroll
        for (int c = 0; c < 16; c += 2) { const f32x4 k0 = kr[c], k1 = kr[c + 1];
            s0 += (qv[4 * c] * k0.x + qv[4 * c + 1] * k0.y) + (qv[4 * c + 2] * k0.z + qv[4 * c + 3] * k0.w); s1 += (qv[4 * c + 4] * k1.x + qv[4 * c + 5] * k1.y) + (qv[4 * c + 6] * k1.z + qv[4 * c + 7] * k1.w); }
        float s = (s0 + s1) - slope * (float)(127 - jj);
        if (!valid) s = -INFINITY;
        if (s > mx) { const float sc = __expf(mx - s); l *= sc;
#pragma unroll
            for (int d = 0; d < 64; ++d) acc[d] *= sc;
            mx = s; }
        const float p = __expf(s - mx); l += p;
        const LAS f32x4* vr = (const LAS f32x4*)(Vs + j * 68);
#pragma unroll
        for (int c = 0; c < 16; ++c) { const f32x4 v = vr[c]; acc[4 * c] += p * v.x; acc[4 * c + 1] += p * v.y; acc[4 * c + 2] += p * v.z; acc[4 * c + 3] += p * v.w; }
    }
    const float inv = 1.0f / l;
    { GAS v4u* op = (GAS v4u*)(O + row * D + 1024 + hq * 64);
#pragma unroll
      for (int c = 0; c < 8; ++c) { v4u w; w.x = pk2(acc[8 * c] * inv, acc[8 * c + 1] * inv); w.y = pk2(acc[8 * c + 2] * inv, acc[8 * c + 3] * inv); w.z = pk2(acc[8 * c + 4] * inv, acc[8 * c + 5] * inv); w.w = pk2(acc[8 * c + 6] * inv, acc[8 * c + 7] * inv); op[c] = w; } }
    __syncthreads();
}

__device__ __forceinline__ void e3_phase(const Args& a, int li, int vcu, int G, int tid) {
    unsigned char* ws = a.ws; const float* Y = (const float*)(ws + WS_XB);
    const bf16* R = (const bf16*)(ws + SC_R); const bf16* K2 = (const bf16*)(ws + SC_K2); const bf16* GG = (const bf16*)(ws + SC_GG); const bf16* V = (const bf16*)(ws + (li ? WS_V2 : WS_VF));
    bf16* O = (bf16*)(ws + WS_O);
    const float* rk = a.in[I_ERK] + li * 1024; const float* gng = a.in[I_EGNG] + li * 1024; const float* gnb = a.in[I_EGNB] + li * 1024;
    for (size_t e = (size_t)vcu * NTHR + tid; e < (size_t)M * 1024; e += (size_t)G * NTHR) {
        const size_t row = e >> 10; const int c = (int)(e & 1023);
        const float y = Y[e]; const float mean = wave_sum(y) * (1.0f / 64.0f); const float dv = y - mean; const float var = wave_sum(dv * dv) * (1.0f / 64.0f);
        const float r = bf2f(R[e]), k = bf2f(K2[e]), v = bf2f(V[e]), g = bf2f(GG[e]);
        const float yn = dv * rsqrtf(var + 64e-5f) * gng[c] + gnb[c];
        const float bonus = wave_sum(r * k * rk[c]);
        O[row * D + c] = (bf16)f2bf((yn + bonus * v) * g);
    }
}

#define SGU_SYNC() __syncthreads()
__device__ __forceinline__ void sgu_phase(const Args& a, int li, LAS unsigned char* ldsb, int vcu, int G, int tid) {
    unsigned char* ws = a.ws; const bf16* Z = (const bf16*)(ws + WS_ACT); bf16* O = (bf16*)(ws + WS_O);
    const float* ssv = (const float*)(ws + WS_SS) + (size_t)(13 + li) * SS_REC;
    LAS float* vs = (LAS float*)ldsb;
#ifndef WTS
#define WTS 132
#endif
    LAS float* wt = vs + 128 * 128;
    const float* wsg = a.in[I_OWS] + (size_t)li * 16 * 128 * 128; const float* bs = a.in[I_OBS] + li * 16 * 128; const float* vng = a.in[I_OVNG] + li * D;
    int gcur = -1;
    for (int u = vcu; u < 4096; u += G) {
        const int g = u & 15, bn = u >> 4; const size_t m0 = (size_t)bn * 128;
        __syncthreads();
        if (g != gcur) { gcur = g;
            for (int e = tid; e < 128 * 128; e += NTHR) { const int i = e >> 7, j = e & 127; wt[j * WTS + i] = (j <= i) ? wsg[((size_t)g * 128 + i) * 128 + j] : 0.f; } }
        for (int e = tid; e < 128 * 16; e += NTHR) { const int j = e >> 4, c8 = e & 15; const float rs = pg8::row_rs(ssv, (int)(m0 + j));
            const v4u w = *(const GAS v4u*)(Z + (m0 + j) * ZO + 2048 + g * 128 + 8 * c8); f32x4 lo, hi;
            lo.x = bflo(w.x) * rs; lo.y = bfhi(w.x) * rs; lo.z = bflo(w.y) * rs; lo.w = bfhi(w.y) * rs; hi.x = bflo(w.z) * rs; hi.y = bfhi(w.z) * rs; hi.z = bflo(w.w) * rs; hi.w = bfhi(w.w) * rs;
            LAS f32x4* d = (LAS f32x4*)(vs + j * 128 + 8 * c8); d[0] = lo; d[1] = hi; }
        __syncthreads();
        const int c = tid & 127, ib = tid >> 7; const float vg = vng[g * 128 + c];
        for (int ig = 0; ig < 4; ++ig) { const int i0 = 32 * ib + 8 * ig; float acc[8];
#pragma unroll
            for (int r = 0; r < 8; ++r) acc[r] = 0.f;
            for (int j = 0; j < i0 + 8; ++j) { const float vv = vs[j * 128 + c]; const f32x4 w0 = *(const LAS f32x4*)(wt + j * WTS + i0), w1 = *(const LAS f32x4*)(wt + j * WTS + i0 + 4);
                acc[0] += w0.x * vv; acc[1] += w0.y * vv; acc[2] += w0.z * vv; acc[3] += w0.w * vv; acc[4] += w1.x * vv; acc[5] += w1.y * vv; acc[6] += w1.z * vv; acc[7] += w1.w * vv; }
#pragma unroll
            for (int r = 0; r < 8; ++r) { const int i = i0 + r; const float uu = bf2f(Z[(m0 + i) * ZO + g * 128 + c]);
                O[(m0 + i) * D + g * 128 + c] = (bf16)f2bf(uu * (vg * acc[r] + bs[g * 128 + i])); }
        }
    }
    __syncthreads();
}

__device__ __forceinline__ void final_phase(const Args& a, int vcu, int G, int wave, int lane) {
    const int gw = vcu * NWAVES + wave, NGW = G * NWAVES; const float* ss = (const float*)(a.ws + WS_SS) + (size_t)12 * SS_REC; const float* fg = a.in[I_FG];
    for (int m = gw; m < M; m += NGW) { const float rs = pg8::row_rs(ss, m);
        GAS f32x4* xr = (GAS f32x4*)(a.out + (size_t)m * D) + lane; const GAS f32x4* gr = (const GAS f32x4*)fg + lane;
#pragma unroll
        for (int j = 0; j < 8; ++j) { const f32x4 v = xr[64 * j], gg = gr[64 * j]; xr[64 * j] = v * rs * gg; } }
}

__global__ void __launch_bounds__(NTHR, 2) mk_fwd(Args args) {
    extern __shared__ __attribute__((aligned(16))) unsigned char lds_raw[];
    LAS unsigned char* lds = (LAS unsigned char*)lds_raw;
    const int tid = threadIdx.x, lane = tid & 63, wave = __builtin_amdgcn_readfirstlane(tid >> 6);
    const int G = gridDim.x, bx = blockIdx.x; const int vcu = (G % 8 == 0) ? (bx % 8) * (G / 8) + bx / 8 : bx;
    unsigned char* ws = args.ws; gu32* ctl = (gu32*)(ws + WS_CTL);
    for (int u = tid; u < (LDS_BYTES - LDSCTL_OFF) / 4; u += NTHR) ((LAS unsigned*)(lds + LDSCTL_OFF))[u] = 0u;
    __syncthreads();
    const int lo = args.ph_lo, hi = args.ph_hi;
    const bool multi = (hi - lo) > 1;
    XcdBarrier bar; bar.bar = (unsigned*)(ctl + CW_BAR); bar.x = 0; bar.st = nullptr;
    if (multi) bar = xcd_barrier_post((unsigned*)(ctl + CW_BAR), (volatile LAS unsigned*)(lds + LDSCTL_OFF));
#define IN(k) (lo <= (k) && (k) < hi)
#define SEAM(k) do { if ((k) + 1 < hi) xcd_barrier(bar); } while (0)
#ifndef DUP_G
#define DUP_G 1
#endif
#ifndef DUP_T
#define DUP_T 1
#endif
#ifndef DUP_PREP
#define DUP_PREP DUP_T
#endif
#ifndef DUP_E1
#define DUP_E1 DUP_T
#endif
#ifndef DUP_SGU
#define DUP_SGU DUP_T
#endif
#ifndef DUP_E3
#define DUP_E3 DUP_T
#endif
#define REPN(n) for (int rep_ = 0; rep_ < (n); ++rep_)
#ifndef DUP_S
#define DUP_S 1
#endif
#define REPG for (int rep_ = 0; rep_ < DUP_G; ++rep_)
#define REPT for (int rep_ = 0; rep_ < DUP_T; ++rep_)
#define REPS for (int rep_ = 0; rep_ < DUP_S; ++rep_)
#define RSEAM(n) do { if (rep_ + 1 < (n)) xcd_barrier(bar); } while (0)
    float* ssb = (float*)(ws + WS_SS);
    bf16* XB = (bf16*)(ws + WS_XB); bf16* ACT = (bf16*)(ws + WS_ACT); bf16* OB = (bf16*)(ws + WS_O);

    for (int s = 0; s < NSUB; ++s) {
        const int pb = s * 8, L = s / 3, kind = s % 3, li = L >> 1; const bool even = !(L & 1);
        #ifndef NO_PREP
        if (kind == 0 && IN(pb + 0)) { REPN(DUP_PREP) { const int t_ = opaque(tid); prep_phase(args, L, lds, vcu, G, __builtin_amdgcn_readfirstlane(t_ >> 6), t_ & 63); RSEAM(DUP_PREP); } SEAM(pb + 0); }
#endif
        if (IN(pb + 1)) {
            const float* ss = ssb + (size_t)s * SS_REC;
            if (kind != 1) {
                pg8::Gemm g{XB, (const bf16*)(ws + (kind == 0 ? WT_GU1 : WT_GU2)), M, 2 * FF, D}; pg8::StaticOrder S; S.init(M, 2 * FF, G, bx);
                pg8::EpiSwiGLU E{ACT, FF, ss};
#ifndef NO_G1
                REPG { pg8::gemm_phase<pg8::EpiSwiGLU, pg8::StaticOrder, true, true>(lds, g, S, E); RSEAM(DUP_G); }
#endif
            } else if (even) {
                pg8::Gemm g{XB, (const bf16*)(ws + WT_IN), M, ZN, D}; pg8::StaticOrder S; S.init(M, ZN, G, bx);
                pg8::EpiZ E{ACT, ZN, ss, args.in[I_EBQKV] + li * 1536};
#ifndef NO_GZ
                REPG { pg8::gemm_phase<pg8::EpiZ, pg8::StaticOrder, true, true>(lds, g, S, E); RSEAM(DUP_G); }
#endif
            } else {
                pg8::Gemm g{XB, (const bf16*)(ws + WT_IN), M, ZO, D}; pg8::StaticOrder S; S.init(M, ZO, G, bx);
                pg8::EpiGeluV E{ACT, ZO, ss, ssb + (size_t)(13 + li) * SS_REC, (LAS float*)(lds + 131072)};
#ifndef NO_GG
                REPG { pg8::gemm_phase<pg8::EpiGeluV, pg8::StaticOrder, true, true>(lds, g, S, E); RSEAM(DUP_G); }
#endif
            }
            SEAM(pb + 1);
        }
        if (kind == 1) {
            if (IN(pb + 2)) {
#ifndef NO_E1
                if (even) REPN(DUP_E1) { e1_phase(args, li, lds, vcu, G, opaque(tid)); RSEAM(DUP_E1); }
#endif
#ifndef NO_SGU
                if (!even) REPN(DUP_SGU) { sgu_phase(args, li, lds, vcu, G, opaque(tid)); RSEAM(DUP_SGU); }
#endif
                SEAM(pb + 2); }
            if (even && IN(pb + 3)) { REPS {
                const int xcd = bx & 7, slot = bx >> 3; const bool split = (G == 256);
                const int s0 = split ? (slot < 16 ? xcd * 16 + slot : 128) : vcu, sstr = split ? 128 : G;
#ifndef NO_SCAN
                for (int su = s0; su < 128; su += sstr) scan_unit(args, li, su, lds, opaque(tid));
#endif
                const int a0 = split ? (slot >= 16 ? xcd * 16 + slot - 16 : 1024) : vcu, astr = split ? 128 : G;
#ifndef NO_ATTN
                for (int au = a0; au < 1024; au += astr) attn_unit(args, li, au, lds, opaque(tid));
#endif
                RSEAM(DUP_S); }
                SEAM(pb + 3);
            }
#ifndef NO_E3
            if (even && IN(pb + 4)) { REPN(DUP_E3) { e3_phase(args, li, vcu, G, opaque(tid)); RSEAM(DUP_E3); } SEAM(pb + 4); }
#endif
        }
        if (IN(pb + 5)) {
            const bf16* A = (kind == 1) ? OB : ACT; const int K = (kind == 1) ? D : FF;
            const bf16* Bt = (const bf16*)(ws + (kind == 0 ? WT_D1 : kind == 1 ? WT_OUT : WT_D2));
            pg8::Gemm g{A, Bt, M, D, K}; pg8::StaticOrder S; S.init(M, D, G, bx);
            pg8::EpiResid E{s == 0 ? args.in[I_X] : args.out, args.out, XB, ssb + (size_t)(s + 1) * SS_REC, kind == 1 ? 1.0f : 0.5f, (LAS float*)(lds + 131072)};
#ifndef NO_GR
            REPG { if (rep_) { E.base = args.out; E.scale = 0.f; } pg8::gemm_phase<pg8::EpiResid, pg8::StaticOrder, true, true>(lds, g, S, E); RSEAM(DUP_G); }
#endif
            SEAM(pb + 5);
        }
    }
    if (IN(NSUB * 8)) { const int t_ = opaque(tid); final_phase(args, vcu, G, __builtin_amdgcn_readfirstlane(t_ >> 6), t_ & 63); }
#undef IN
#undef SEAM
}

extern "C" void kernel_launch(void* const* d_in, const int* in_sizes, int n_in, void* d_out, int out_size, void* d_ws, size_t ws_size, hipStream_t stream) {
    static int grid = 0;
    if (grid == 0) {
        if (n_in != 29 || out_size != M * D || ws_size < WS_END) { fprintf(stderr, "kernel_launch: unexpected shapes (n_in %d, out %d, ws %zu < %zu); nothing launched\n", n_in, out_size, ws_size, (size_t)WS_END); grid = -1; return; }
        int dev = 0, cus = 0;
        if (hipGetDevice(&dev) != hipSuccess || hipDeviceGetAttribute(&cus, hipDeviceAttributeMultiprocessorCount, dev) != hipSuccess) { grid = -1; return; }
        if (hipFuncSetAttribute((const void*)mk_fwd, hipFuncAttributeMaxDynamicSharedMemorySize, LDS_BYTES) != hipSuccess) { fprintf(stderr, "kernel_launch: hipFuncSetAttribute failed\n"); grid = -1; return; }
        int per_cu = 0;
        if (hipOccupancyMaxActiveBlocksPerMultiprocessor(&per_cu, (const void*)mk_fwd, NTHR, LDS_BYTES) != hipSuccess || per_cu < 1) fprintf(stderr, "kernel_launch: occupancy query says %d\n", per_cu);
        (void)hipGetLastError();
        grid = cus;
    }
    if (grid < 0) return;
    (void)hipMemsetAsync((char*)d_ws + WS_CTL, 0, CTL_ZERO_BYTES, stream);
    Args a{};
    for (int i = 0; i < 29; ++i) a.in[i] = (const float*)d_in[i];
    a.out = (float*)d_out; a.ws = (unsigned char*)d_ws;
#if MK_ONE_LAUNCH
    a.ph_lo = 0; a.ph_hi = NSUB * 8 + 1;
    hipLaunchKernelGGL(mk_fwd, dim3(grid), dim3(NTHR), LDS_BYTES, stream, a);
#else
    for (int s = 0; s <= NSUB; ++s) {
        for (int k = 0; k < (s == NSUB ? 1 : 8); ++k) {
            const int L = s / 3, kind = s % 3; const bool even = !(L & 1);
            bool live;
            if (s == NSUB) live = true;
            else if (k == 0) live = (kind == 0);
            else if (k == 1 || k == 5) live = true;
            else if (k == 2) live = (kind == 1);
            else if (k == 3 || k == 4) live = (kind == 1) && even;
            else live = false;
            if (!live) continue;
            a.ph_lo = s * 8 + k; a.ph_hi = a.ph_lo + 1;
            hipLaunchKernelGGL(mk_fwd, dim3(grid), dim3(NTHR), LDS_BYTES, stream, a);
        }
    }
#endif
}
```

```cpp
#include <hip/hip_runtime.h>
#include <cstdio>
#include <cstdint>
#define MK_ONE_LAUNCH 1
namespace pg8 {
#define PG8_LAS __attribute__((address_space(3)))
typedef unsigned short bf16_t;
typedef short bf16x8 __attribute__((ext_vector_type(8)));
typedef float f32x4 __attribute__((ext_vector_type(4)));
typedef unsigned u32x4 __attribute__((ext_vector_type(4)));
constexpr int BM = 256, BK = 64, HALF = 128, HTB = HALF * BK * 2  , STAGE_BYTES = 8 * HTB, NXCD = 8, WGM = 8;

__host__ __device__ __forceinline__ int lds_byte(int r, int c) { const int st = (r >> 4) * 2 + (c >> 5), rr = r & 15, cc = c & 31, ob = rr * 64 + cc * 2; return st * 1024 + (ob ^ (((ob >> 9) & 1) << 5)); }
__host__ __device__ __forceinline__ void stage_rc(int b, int& R, int& C) { const int st = b / 1024, sb = b % 1024, swz = sb ^ (((sb >> 9) & 1) << 5); R = (st >> 1) * 16 + swz / 64; C = (st & 1) * 32 + (swz % 64) / 2; }
__host__ __device__ __forceinline__ int perm32(int rho) { const int n = rho >> 4, i = rho & 15; return 8 * (i >> 2) + 4 * n + (i & 3); }

struct Unit { int pm, pn; };
struct Gemm { const bf16_t* A; const bf16_t* Bt; int M, N, K; };

struct StaticOrder {
    int nM, nN, nwg, G, c;
    __host__ __device__ void init(int M, int N, int G_, int c_) { nM = M / BM; nN = N / BM; nwg = nM * nN; G = G_; c = c_; }
    __host__ __device__ bool next(int i, Unit& u) const {
        const long L = (long)i * G + c; if (L >= nwg) return false;
        int wgid = (int)L; { const int q = nwg / NXCD, r = nwg % NXCD, xcd = wgid % NXCD, off = wgid / NXCD; wgid = (xcd < r ? xcd * (q + 1) : r * (q + 1) + (xcd - r) * q) + off; }
        const int nig = WGM * nN, gid = wgid / nig, fm = gid * WGM, gsz = (nM - fm) < WGM ? (nM - fm) : WGM;
        u.pm = fm + ((wgid % nig) % gsz); u.pn = (wgid % nig) / gsz; return true;
    }
    __device__ __forceinline__ void a_ready(const Unit&) const {}
    __device__ __forceinline__ void done(const Unit&) const {}
};
__device__ __forceinline__ unsigned cvt_pk_bf16(float lo, float hi) { unsigned r; asm volatile("v_cvt_pk_bf16_f32 %0, %1, %2" : "=v"(r) : "v"(lo), "v"(hi)); return r; }
typedef float f32x2 __attribute__((ext_vector_type(2)));
__device__ __forceinline__ f32x2 gelu_pk(f32x2 v) {
    const f32x2 av = __builtin_elementwise_abs(v), d = av * 0.2316418882f + 1.0f;
    f32x2 t; t.x = __builtin_amdgcn_rcpf(d.x); t.y = __builtin_amdgcn_rcpf(d.y);
    f32x2 q = t * 0.5307027145f + (-0.7265760135f); q = q * t + 0.7107068705f; q = q * t + (-0.142248368f); q = q * t + 0.127414796f; q = q * t;
    const f32x2 s = (v * v) * (-0.72134752044f);
    f32x2 e; e.x = __builtin_amdgcn_exp2f(s.x); e.y = __builtin_amdgcn_exp2f(s.y);
    const f32x2 m = v * (q * e), r = v - m;
    f32x2 o; o.x = v.x < 0.f ? m.x : r.x; o.y = v.y < 0.f ? m.y : r.y; return o;
}

constexpr int SS_M = 32768;
__device__ __forceinline__ float row_rs(const float* P, int row) {
    const float s = ((P[row] + P[SS_M + row]) + (P[2 * SS_M + row] + P[3 * SS_M + row])) + ((P[4 * SS_M + row] + P[5 * SS_M + row]) + (P[6 * SS_M + row] + P[7 * SS_M + row]));
    return rsqrtf(s * (1.0f / 2048.0f) + 1e-6f);
}
struct EpiSwiGLU {
    static constexpr bool PERM = true, AFTER_DRAIN = false;
    bf16_t* O; int ldc; const float* ss;
    __device__ __forceinline__ void operator()(const f32x4 (&acc)[2][2][4][2], const Unit& u, int wr, int wc, int fr, int fq) const {
        const int row0 = u.pm * BM + wr * 64 + fr, col0 = u.pn * HALF + wc * 32 + 8 * fq;
#pragma unroll
        for (int ai = 0; ai < 2; ++ai)
#pragma unroll
            for (int m = 0; m < 4; ++m) {
                const int row = row0 + ai * HALF + m * 16;
                const float rs = row_rs(ss, row);
                float o[8];
#pragma unroll
                for (int n = 0; n < 2; ++n)
#pragma unroll
                    for (int j = 0; j < 4; ++j) { const float g = acc[ai][0][m][n][j] * rs, up = acc[ai][1][m][n][j] * rs; o[4 * n + j] = g * __builtin_amdgcn_rcpf(1.0f + __expf(-g)) * up; }
                u32x4 w; w.x = cvt_pk_bf16(o[0], o[1]); w.y = cvt_pk_bf16(o[2], o[3]); w.z = cvt_pk_bf16(o[4], o[5]); w.w = cvt_pk_bf16(o[6], o[7]);
                *(u32x4*)(O + (size_t)row * ldc + col0) = w;
                asm volatile("" ::: "memory");
            }
    }
};
struct EpiResid {
    static constexpr bool PERM = false, AFTER_DRAIN = false;
    const float* base; float* out; bf16_t* xb; float* ssn; float scale; PG8_LAS float* sp;
    __device__ __forceinline__ void operator()(const f32x4 (&acc)[2][2][4][2], const Unit& u, int wr, int wc, int fr, int fq) const {
        const int row0 = u.pm * BM + wr * 64 + fr, col0 = u.pn * BM + wc * 32 + 4 * fq;
        typedef unsigned u32x2v __attribute__((ext_vector_type(2)));
#pragma unroll
        for (int ai = 0; ai < 2; ++ai)
#pragma unroll
            for (int m = 0; m < 4; ++m) {
                const int row = row0 + ai * HALF + m * 16; const size_t off = (size_t)row * 2048 + col0; float s = 0.f;
#pragma unroll
                for (int bj = 0; bj < 2; ++bj)
#pragma unroll
                    for (int n = 0; n < 2; ++n) {
                        const f32x4 bs = *(const f32x4*)(base + off + bj * HALF + n * 16);
                        const f32x4 o = bs + acc[ai][bj][m][n] * scale;
                        *(f32x4*)(out + off + bj * HALF + n * 16) = o;
                        u32x2v w; w.x = cvt_pk_bf16(o[0], o[1]); w.y = cvt_pk_bf16(o[2], o[3]);
                        *(u32x2v*)(xb + off + bj * HALF + n * 16) = w;
                        s += (o[0] * o[0] + o[1] * o[1]) + (o[2] * o[2] + o[3] * o[3]);
                    }
                s += __shfl_xor(s, 16); s += __shfl_xor(s, 32);
                if (fq == 0) sp[(ai * HALF + wr * 64 + m * 16 + fr) * 4 + wc] = s;
                asm volatile("" ::: "memory");
            }
        asm volatile("s_waitcnt lgkmcnt(0)" ::: "memory"); __builtin_amdgcn_s_barrier(); asm volatile("" ::: "memory");
        const int t = (wr * 4 + wc) * 64 + fq * 16 + fr;
        if (t < BM) { const f32x4 p = *(const PG8_LAS f32x4*)(sp + t * 4); ssn[(size_t)u.pn * SS_M + u.pm * BM + t] = (p[0] + p[1]) + (p[2] + p[3]); }
    }
};
struct EpiZ {
    static constexpr bool PERM = true, AFTER_DRAIN = false;
    bf16_t* O; int ldc; const float* ss; const float* bias;
    __device__ __forceinline__ void operator()(const f32x4 (&acc)[2][2][4][2], const Unit& u, int wr, int wc, int fr, int fq) const {
        const int row0 = u.pm * BM + wr * 64 + fr, col0 = u.pn * BM + wc * 32 + 8 * fq;
        const bool hb = u.pn < 6;
        f32x4 bv[2][2];
#pragma unroll
        for (int bj = 0; bj < 2; ++bj)
#pragma unroll
            for (int n = 0; n < 2; ++n) bv[bj][n] = hb ? *(const f32x4*)(bias + col0 + bj * HALF + 4 * n) : (f32x4){0.f, 0.f, 0.f, 0.f};
#pragma unroll
        for (int ai = 0; ai < 2; ++ai)
#pragma unroll
            for (int m = 0; m < 4; ++m) {
                const int row = row0 + ai * HALF + m * 16;
                const float rs = row_rs(ss, row);
                bf16_t* rowp = O + (size_t)row * ldc + col0;
#pragma unroll
                for (int bj = 0; bj < 2; ++bj) {
                    const f32x4 v0 = acc[ai][bj][m][0] * rs + bv[bj][0], v1 = acc[ai][bj][m][1] * rs + bv[bj][1];
                    u32x4 w; w.x = cvt_pk_bf16(v0[0], v0[1]); w.y = cvt_pk_bf16(v0[2], v0[3]); w.z = cvt_pk_bf16(v1[0], v1[1]); w.w = cvt_pk_bf16(v1[2], v1[3]);
                    *(u32x4*)(rowp + bj * HALF) = w;
                }
                asm volatile("" ::: "memory");
            }
    }
};
struct EpiGeluV {
    static constexpr bool PERM = true, AFTER_DRAIN = false;
    bf16_t* O; int ldc; const float* ss; float* ssv; PG8_LAS float* sp;
    __device__ __forceinline__ void operator()(const f32x4 (&acc)[2][2][4][2], const Unit& u, int wr, int wc, int fr, int fq) const {
        const int row0 = u.pm * BM + wr * 64 + fr, col0 = u.pn * BM + wc * 32 + 8 * fq;
        const bool isv = u.pn >= 8;
#pragma unroll
        for (int ai = 0; ai < 2; ++ai)
#pragma unroll
            for (int m = 0; m < 4; ++m) {
                const int row = row0 + ai * HALF + m * 16;
                const float rs = row_rs(ss, row);
                bf16_t* rowp = O + (size_t)row * ldc + col0; float s = 0.f;
#pragma unroll
                for (int bj = 0; bj < 2; ++bj) {
                    f32x4 v0 = acc[ai][bj][m][0] * rs, v1 = acc[ai][bj][m][1] * rs;
                    const f32x2 a = gelu_pk((f32x2){v0[0], v0[1]}), b = gelu_pk((f32x2){v0[2], v0[3]}), c = gelu_pk((f32x2){v1[0], v1[1]}), d = gelu_pk((f32x2){v1[2], v1[3]});
                    s += (a.x * a.x + a.y * a.y) + (b.x * b.x + b.y * b.y) + (c.x * c.x + c.y * c.y) + (d.x * d.x + d.y * d.y);
                    u32x4 w; w.x = cvt_pk_bf16(a.x, a.y); w.y = cvt_pk_bf16(b.x, b.y); w.z = cvt_pk_bf16(c.x, c.y); w.w = cvt_pk_bf16(d.x, d.y);
                    *(u32x4*)(rowp + bj * HALF) = w;
                }
                if (isv) { s += __shfl_xor(s, 16); s += __shfl_xor(s, 32); if (fq == 0) sp[(ai * HALF + wr * 64 + m * 16 + fr) * 4 + wc] = s; }
                asm volatile("" ::: "memory");
            }
        if (isv) {
            asm volatile("s_waitcnt lgkmcnt(0)" ::: "memory"); __builtin_amdgcn_s_barrier(); asm volatile("" ::: "memory");
            const int t = (wr * 4 + wc) * 64 + fq * 16 + fr;
            if (t < BM) { const f32x4 p = *(const PG8_LAS f32x4*)(sp + t * 4); ssv[(size_t)(u.pn - 8) * SS_M + u.pm * BM + t] = (p[0] + p[1]) + (p[2] + p[3]); }
        }
    }
};
template <class Epi, class Sched, bool ALIGN_EPI = false, bool SP2 = false>
__device__ __forceinline__ void gemm_phase(PG8_LAS unsigned char* lds, const Gemm g, const Sched& S, const Epi& E) {
    int tid_ = threadIdx.x; asm volatile("" : "+v"(tid_));
    const int tid = tid_, wid = __builtin_amdgcn_readfirstlane(tid >> 6), lane = tid & 63, wr = wid >> 2, wc = wid & 3, fr = lane & 15, fq = lane >> 4;
    const int K = g.K, nt = K / BK;
    unsigned voffA[2], voffB[2];
#pragma unroll
    for (int i = 0; i < 2; ++i) { int R, C; stage_rc(tid * 16 + i * 8192, R, C); const int Rb = Epi::PERM ? ((R & ~31) + perm32(R & 31)) : R;
        voffA[i] = (unsigned)(R * K + C) * 2u; voffB[i] = (unsigned)(Rb * K + C) * 2u; }
    const size_t kstep = (size_t)(BK * 2);
    const size_t hstep = (size_t)HALF * K * 2;
    const size_t tstep = 2 * hstep;
    const unsigned ldsw = (unsigned)wid * 1024u;
    const int aoff = lds_byte(wr * 64 + fr, fq * 8), boff = lds_byte(wc * 32 + fr, fq * 8);
#define PG8_SA(b, h) (((b) * 2 + (h)) * HTB)
#define PG8_SB(b, h) ((4 + (b) * 2 + (h)) * HTB)
#define PG8_STAGE(bufoff, gbase, voff) do { _Pragma("unroll") for (int _i = 0; _i < 2; ++_i) \
        __builtin_amdgcn_global_load_lds((const unsigned*)((const char*)(gbase) + (voff)[_i]), (PG8_LAS unsigned*)(lds + (bufoff) + ldsw + _i * 8192), 16, 0, 0); } while (0)
#define PG8_LDA(dst, b, h) do { _Pragma("unroll") for (int m = 0; m < 4; ++m) _Pragma("unroll") for (int k = 0; k < 2; ++k) dst[m][k] = *(const PG8_LAS bf16x8*)(lds + PG8_SA(b, h) + aoff + m * 2048 + k * 1024); } while (0)
#define PG8_LDB(dst, b, h) do { _Pragma("unroll") for (int n = 0; n < 2; ++n) _Pragma("unroll") for (int k = 0; k < 2; ++k) dst[n][k] = *(const PG8_LAS bf16x8*)(lds + PG8_SB(b, h) + boff + n * 2048 + k * 1024); } while (0)
#define PG8_MMA(ai, bj, At, Bt) do { __builtin_amdgcn_s_setprio(1); _Pragma("unroll") for (int m = 0; m < 4; ++m) _Pragma("unroll") for (int n = 0; n < 2; ++n) _Pragma("unroll") for (int k = 0; k < 2; ++k) \
        acc[ai][bj][m][n] = __builtin_amdgcn_mfma_f32_16x16x32_bf16(Bt[n][k], At[m][k], acc[ai][bj][m][n], 0, 0, 0); __builtin_amdgcn_s_setprio(0); } while (0)
#define PG8_WAIT_V(n) asm volatile("s_waitcnt vmcnt(" #n ")" ::: "memory")
#define PG8_WAIT_L(n) asm volatile("s_waitcnt lgkmcnt(" #n ")" ::: "memory")
#define PG8_BAR __builtin_amdgcn_s_barrier()
#define PG8_SCHED __builtin_amdgcn_sched_barrier(0)
    Unit cur, nxt; int ui = 0;
    if (!S.next(0, cur)) return;
    f32x4 acc[2][2][4][2];
#pragma unroll
    for (int a = 0; a < 2; ++a)
#pragma unroll
        for (int b = 0; b < 2; ++b)
#pragma unroll
            for (int m = 0; m < 4; ++m)
#pragma unroll
                for (int n = 0; n < 2; ++n) acc[a][b][m][n] = (f32x4){0.f, 0.f, 0.f, 0.f};
    bf16x8 At[4][2], B0[2][2], B1[2][2];
    const char* cA = (const char*)g.A + (size_t)cur.pm * tstep; const char* cB = (const char*)g.Bt + (size_t)cur.pn * tstep;
    S.a_ready(cur);
    if constexpr (SP2) {
        PG8_STAGE(PG8_SB(0, 0), cB, voffB); PG8_STAGE(PG8_SB(0, 1), cB + hstep, voffB); PG8_STAGE(PG8_SA(0, 0), cA, voffA); PG8_STAGE(PG8_SA(0, 1), cA + hstep, voffA);
        if (wr == 1) PG8_BAR;
        PG8_WAIT_V(2); PG8_BAR;
        PG8_STAGE(PG8_SB(1, 0), cB + kstep, voffB); PG8_STAGE(PG8_SA(1, 0), cA + kstep, voffA); PG8_STAGE(PG8_SB(1, 1), cB + hstep + kstep, voffB);
        PG8_WAIT_V(6); PG8_BAR;
    } else {
        PG8_STAGE(PG8_SB(0, 0), cB, voffB); PG8_STAGE(PG8_SA(0, 0), cA, voffA); PG8_STAGE(PG8_SB(0, 1), cB + hstep, voffB); PG8_STAGE(PG8_SA(0, 1), cA + hstep, voffA);
        if (wr == 1) PG8_BAR;
        PG8_WAIT_V(4); PG8_BAR;
        PG8_STAGE(PG8_SB(1, 0), cB + kstep, voffB); PG8_STAGE(PG8_SA(1, 0), cA + kstep, voffA); PG8_STAGE(PG8_SB(1, 1), cB + hstep + kstep, voffB);
        PG8_WAIT_V(6); PG8_BAR;
    }
    for (;;) {
        const bool has_next = S.next(ui + 1, nxt);
        const char* nA = has_next ? (const char*)g.A + (size_t)nxt.pm * tstep : cA; const char* nB = has_next ? (const char*)g.Bt + (size_t)nxt.pn * tstep : cB;
        for (int t = 0; t < nt; t += 2) {
            const bool last = (t == nt - 2);
            const char* a1 = cA + (size_t)(t + 1) * kstep;
            const char* a2 = last ? nA : cA + (size_t)(t + 2) * kstep; const char* b2 = last ? nB : cB + (size_t)(t + 2) * kstep;
            const char* a3 = a2 + kstep; const char* b3 = b2 + kstep;
            if (last && has_next) S.a_ready(nxt);
            if constexpr (SP2) {
            PG8_LDB(B0, 0, 0); PG8_LDB(B1, 0, 1); PG8_SCHED; PG8_LDA(At, 0, 0); PG8_STAGE(PG8_SA(1, 1), a1 + hstep, voffA);
            PG8_WAIT_V(8); PG8_WAIT_L(0); PG8_BAR; PG8_MMA(0, 0, At, B0); PG8_MMA(0, 1, At, B1); PG8_BAR; PG8_SCHED;
            PG8_LDA(At, 0, 1); PG8_STAGE(PG8_SB(0, 0), b2, voffB); PG8_STAGE(PG8_SB(0, 1), b2 + hstep, voffB); PG8_STAGE(PG8_SA(0, 0), a2, voffA);
            PG8_WAIT_V(8); PG8_WAIT_L(0); PG8_BAR; PG8_MMA(1, 0, At, B0); PG8_MMA(1, 1, At, B1); PG8_BAR; PG8_SCHED;
            PG8_LDB(B0, 1, 0); PG8_LDB(B1, 1, 1); PG8_SCHED; PG8_LDA(At, 1, 0); PG8_STAGE(PG8_SA(0, 1), a2 + hstep, voffA);
            PG8_WAIT_V(8); PG8_WAIT_L(0); PG8_BAR; PG8_MMA(0, 0, At, B0); PG8_MMA(0, 1, At, B1); PG8_BAR; PG8_SCHED;
            PG8_LDA(At, 1, 1); PG8_STAGE(PG8_SB(1, 0), b3, voffB); PG8_STAGE(PG8_SB(1, 1), b3 + hstep, voffB); PG8_STAGE(PG8_SA(1, 0), a3, voffA);
            PG8_WAIT_V(8); PG8_WAIT_L(0); PG8_BAR; PG8_MMA(1, 0, At, B0); PG8_MMA(1, 1, At, B1); PG8_BAR; PG8_SCHED;
            } else {
            PG8_LDB(B0, 0, 0); PG8_SCHED; PG8_LDA(At, 0, 0); PG8_STAGE(PG8_SA(1, 1), a1 + hstep, voffA);
            PG8_WAIT_L(8); PG8_BAR; PG8_WAIT_L(0); PG8_MMA(0, 0, At, B0); PG8_BAR; PG8_SCHED;
            PG8_LDB(B1, 0, 1); PG8_STAGE(PG8_SB(0, 0), b2, voffB);
            PG8_BAR; PG8_WAIT_L(0); PG8_MMA(0, 1, At, B1); PG8_BAR;
            PG8_LDA(At, 0, 1); PG8_STAGE(PG8_SA(0, 0), a2, voffA);
            PG8_BAR; PG8_WAIT_L(0); PG8_MMA(1, 0, At, B0); PG8_BAR; PG8_SCHED;
            PG8_STAGE(PG8_SB(0, 1), b2 + hstep, voffB);
            PG8_WAIT_V(6); PG8_BAR; PG8_MMA(1, 1, At, B1); PG8_BAR;
            PG8_LDB(B0, 1, 0); PG8_SCHED; PG8_LDA(At, 1, 0); PG8_STAGE(PG8_SA(0, 1), a2 + hstep, voffA);
            PG8_WAIT_L(8); PG8_BAR; PG8_WAIT_L(0); PG8_MMA(0, 0, At, B0); PG8_BAR; PG8_SCHED;
            PG8_LDB(B1, 1, 1); PG8_STAGE(PG8_SB(1, 0), b3, voffB);
            PG8_BAR; PG8_WAIT_L(0); PG8_MMA(0, 1, At, B1); PG8_BAR;
            PG8_LDA(At, 1, 1); PG8_STAGE(PG8_SA(1, 0), a3, voffA);
            PG8_BAR; PG8_WAIT_L(0); PG8_MMA(1, 0, At, B0); PG8_BAR; PG8_SCHED;
            PG8_STAGE(PG8_SB(1, 1), b3 + hstep, voffB);
            PG8_WAIT_V(6); PG8_BAR; PG8_MMA(1, 1, At, B1); PG8_BAR;
            }
        }
        if constexpr (ALIGN_EPI) { if (wr == 0) PG8_BAR; }
        if constexpr (!Epi::AFTER_DRAIN) { E(acc, cur, wr, wc, fr, fq); S.done(cur); }
        if (!has_next) break;
#pragma unroll
        for (int a = 0; a < 2; ++a)
#pragma unroll
            for (int b = 0; b < 2; ++b)
#pragma unroll
                for (int m = 0; m < 4; ++m)
#pragma unroll
                    for (int n = 0; n < 2; ++n) acc[a][b][m][n] = (f32x4){0.f, 0.f, 0.f, 0.f};
        cur = nxt; cA = nA; cB = nB; ++ui;
        if constexpr (ALIGN_EPI) { if (wr == 1) PG8_BAR; }
    }
    PG8_WAIT_V(0);
    if constexpr (!ALIGN_EPI) { if (wr == 0) PG8_BAR; }
    PG8_BAR;
    if constexpr (Epi::AFTER_DRAIN) { E.fused(acc, cur, wr, wc, fr, fq, lds, wid, lane); S.done(cur); }
#undef PG8_SA
#undef PG8_SB
#undef PG8_STAGE
#undef PG8_LDA
#undef PG8_LDB
#undef PG8_MMA
#undef PG8_WAIT_V
#undef PG8_WAIT_L
#undef PG8_BAR
#undef PG8_SCHED
}
}
#define LAS_BAR __attribute__((address_space(3)))
#define XB_TMO      128
#define XB_XCNT(j)  (256  + 64 * (j))
#define XB_XSUB(j)  (1280 + 64 * (j))
#define XB_XGEN(j)  (2304 + 64 * (j))
#define XB_TOP      3328
#define XB_TOPGEN   3392
#define XCD_BAR_WORDS 3456
#define XB_SPIN_CAP (1u << 22)

__device__ __forceinline__ unsigned xb_ld(unsigned* p)              { return __hip_atomic_load(p, __ATOMIC_RELAXED, __HIP_MEMORY_SCOPE_AGENT); }
__device__ __forceinline__ unsigned xb_add(unsigned* p, unsigned v) { return __hip_atomic_fetch_add(p, v, __ATOMIC_RELAXED, __HIP_MEMORY_SCOPE_AGENT); }
__device__ __forceinline__ unsigned xb_xcc_id() { return (unsigned)__builtin_amdgcn_s_getreg((3 << 11) | 20) & 0xFu; }
#define XB_SPIN(cond, bar) do { unsigned _sp = 0; while (cond) { __builtin_amdgcn_s_sleep(1); \
    if ((++_sp & 255u) == 0u) { if (xb_ld(&(bar)[XB_TMO])) break; if (_sp > XB_SPIN_CAP) { atomicAdd(&(bar)[XB_TMO], 1u); break; } } } } while (0)

struct XcdBarrier {
    unsigned* bar; unsigned x;
    volatile LAS_BAR unsigned* st;
};

__device__ __forceinline__ XcdBarrier xcd_barrier_post(unsigned* bar, volatile LAS_BAR unsigned* st) {
    XcdBarrier b; b.bar = bar; b.x = xb_xcc_id(); b.st = st;
    if (threadIdx.x == 0) (void)xb_add(&bar[XB_XCNT(b.x)], 1u);
    return b;
}
__device__ __forceinline__ void xcd_barrier_complete(unsigned* bar, unsigned x, unsigned& nloc, unsigned& nx) {
    const unsigned G = gridDim.x * gridDim.y * gridDim.z;
    unsigned sum, cnt, mine, sp = 0u;
    for (;;) {
        sum = 0u; cnt = 0u; mine = 0u;
#pragma unroll
        for (unsigned j = 0; j < 16; ++j) { const unsigned c = xb_ld(&bar[XB_XCNT(j)]); sum += c; cnt += (c > 0u) ? 1u : 0u; mine = (j == x) ? c : mine; }
        if (sum == G) break;
        __builtin_amdgcn_s_sleep(1);
        if ((++sp & 255u) == 0u) { if (xb_ld(&bar[XB_TMO])) break; if (sp > XB_SPIN_CAP) { atomicAdd(&bar[XB_TMO], 1u); break; } }
    }
    nloc = mine > 0u ? mine : 1u; nx = cnt > 0u ? cnt : 1u;
}

__device__ __forceinline__ void xcd_barrier(const XcdBarrier& b) {
    asm volatile("s_waitcnt vmcnt(0)" ::: "memory");
    __syncthreads();
    if (threadIdx.x == 0) {
        unsigned* bar = b.bar;
        __builtin_amdgcn_s_waitcnt(0);
        unsigned nloc = b.st[0], nx = b.st[1];
        if (nloc == 0u) { xcd_barrier_complete(bar, b.x, nloc, nx); b.st[0] = nloc; b.st[1] = nx; }
        const unsigned old = xb_add(&bar[XB_XSUB(b.x)], 1u);
        const unsigned gen = old / nloc;
        if (old + 1u == (gen + 1u) * nloc) {
            __builtin_amdgcn_fence(__ATOMIC_RELEASE, "agent");
            asm volatile("s_waitcnt vmcnt(0)" ::: "memory");
            const unsigned og = xb_add(&bar[XB_TOP], 1u);
            const unsigned tg = og / nx;
            if (og + 1u == (tg + 1u) * nx) xb_add(&bar[XB_TOPGEN], 1u);
            else XB_SPIN(xb_ld(&bar[XB_TOPGEN]) == tg, bar);
            __builtin_amdgcn_fence(__ATOMIC_ACQUIRE, "agent");
            xb_add(&bar[XB_XGEN(b.x)], 1u);
            asm volatile("s_waitcnt vmcnt(0)" ::: "memory");
        } else {
            XB_SPIN(xb_ld(&bar[XB_XGEN(b.x)]) == gen, bar);
            __builtin_amdgcn_fence(__ATOMIC_ACQUIRE, "agent");
            asm volatile("s_waitcnt vmcnt(0)" ::: "memory");
        }
    }
    __syncthreads();
}

constexpr int NWAVES = 8, NTHR = 512;
constexpr int BATCH = 2, T = 16384, D = 2048, FF = 5632, M = BATCH * T;
constexpr int ZN = 5120;
constexpr int ZA = 1536;
constexpr int A_COLS = 3360, E_IN = 4896;
constexpr int ZO = 4096;
constexpr int NSUB = 12;
#ifndef MK_ONE_LAUNCH
#define MK_ONE_LAUNCH 0
#endif

constexpr size_t MiB = 1u << 20;
constexpr size_t WS_CTL = 0, CTL_ZERO_BYTES = 1 * MiB;
constexpr size_t WS_SS = 1 * MiB;
constexpr size_t SS_REC = 8 * (size_t)M;
constexpr size_t WS_WT = 16 * MiB;
constexpr size_t WT_GU1 = WS_WT, WT_D1 = WT_GU1 + 44 * MiB, WT_GU2 = WT_D1 + 22 * MiB, WT_D2 = WT_GU2 + 44 * MiB, WT_IN = WT_D2 + 22 * MiB, WT_OUT = WT_IN + 20 * MiB;
constexpr size_t WS_XB = WT_OUT + 8 * MiB;
constexpr size_t WS_ACT = WS_XB + 128 * MiB;
constexpr size_t WS_SC = WS_ACT + 352 * MiB;
constexpr size_t SC_R = WS_SC, SC_K2 = SC_R + 64 * MiB, SC_KK = SC_K2 + 64 * MiB, SC_BB = SC_KK + 64 * MiB, SC_LW = SC_BB + 64 * MiB, SC_GG = SC_LW + 64 * MiB;
constexpr size_t WS_VF = SC_GG + 64 * MiB;
constexpr size_t WS_V2 = WS_VF + 64 * MiB;
constexpr size_t WS_O = WS_V2 + 64 * MiB;
constexpr size_t WS_SM = WS_O + 128 * MiB;
constexpr size_t SM_W2T = WS_SM, SM_A2T = SM_W2T + 131072, SM_G2T = SM_A2T + 131072, SM_V1T = SM_G2T + 327680, SM_V2T = SM_V1T + 65536, SM_WSB = SM_V2T + 65536;
constexpr size_t WS_U0 = WS_SM + 2 * MiB;
constexpr size_t WS_END = WS_U0 + 64 * MiB;
static_assert(SM_WSB + 524288 <= WS_END, "small-weight map");
static_assert(WT_OUT + 8 * MiB == 176 * MiB && WS_SS + 15 * MiB <= WS_WT, "weight map");
constexpr int CW_TMO = 0, CW_CODE = 1, CW_BAR = 4096;

constexpr int LDS_BYTES = 147456, LDSCTL_OFF = LDS_BYTES - 512;

#define GAS __attribute__((address_space(1)))
#define LAS __attribute__((address_space(3)))
typedef unsigned short bf16;
typedef unsigned v4u __attribute__((ext_vector_type(4)));
typedef unsigned v2u __attribute__((ext_vector_type(2)));
typedef float f32x4 __attribute__((ext_vector_type(4)));
typedef float f32x2 __attribute__((ext_vector_type(2)));
typedef GAS unsigned gu32;
#define RLX_AGENT __ATOMIC_RELAXED, __HIP_MEMORY_SCOPE_AGENT
#define LDS_WAIT() asm volatile("s_waitcnt lgkmcnt(0)" ::: "memory")
__device__ __forceinline__ unsigned f2bf(float f) { unsigned u = __builtin_bit_cast(unsigned, f); return (u + 0x7fffu + ((u >> 16) & 1u)) >> 16; }
__device__ __forceinline__ unsigned pk2(float lo, float hi) { return f2bf(lo) | (f2bf(hi) << 16); }
__device__ __forceinline__ float bf2f(bf16 b) { return __builtin_bit_cast(float, (unsigned)b << 16); }
__device__ __forceinline__ float bflo(unsigned w) { return __builtin_bit_cast(float, w << 16); }
__device__ __forceinline__ float bfhi(unsigned w) { return __builtin_bit_cast(float, w & 0xffff0000u); }
__device__ __forceinline__ float wave_sum(float v) {
#pragma unroll
    for (int o = 1; o < 64; o <<= 1) v += __shfl_xor(v, o);
    return v;
}
template <int CTRL> __device__ __forceinline__ float dpp_mov(float v) { return __builtin_bit_cast(float, __builtin_amdgcn_update_dpp(0, __builtin_bit_cast(int, v), CTRL, 0xf, 0xf, true)); }
__device__ __forceinline__ float row16_sum(float v) { v += dpp_mov<0xB1>(v); v += dpp_mov<0x4E>(v); v += dpp_mov<0x141>(v); v += dpp_mov<0x140>(v); return v; }
__device__ __forceinline__ float sigmoidf_(float x) { return 1.0f / (1.0f + __expf(-x)); }

__device__ __forceinline__ int opaque(int v) { asm volatile("" : "+v"(v)); return v; }
struct Args { const float* in[29]; float* out; unsigned char* ws; int ph_lo, ph_hi; };
static_assert(sizeof(Args) == 29 * 8 + 8 + 8 + 8, "Args has no padding");
enum { I_X = 0, I_NG, I_WG, I_WU, I_WD, I_EWIN, I_EBQKV, I_EMU, I_EW0, I_EW2, I_EA0, I_EA2, I_EG2, I_EKK, I_EKA, I_ERK, I_EGNG, I_EGNB, I_ESINK, I_EWOUT, I_V0, I_V1, I_V2, I_OWIN, I_OVNG, I_OWS, I_OBS, I_OWOUT, I_FG };

__device__ __forceinline__ void tr_item(const float* W, int ldw, int k0, int c0, const float* gk, bf16* WT, int K, int drow0, LAS float* scr, int lane, bool zero) {
    if (!zero) {
#pragma unroll 8
        for (int i = 0; i < 32; ++i) { const int kk = 2 * i + (lane >> 5); float v = W[(size_t)(k0 + kk) * ldw + c0 + (lane & 31)]; if (gk) v *= gk[k0 + kk]; scr[kk * 33 + (lane & 31)] = v; }
    } else {
#pragma unroll 8
        for (int i = 0; i < 32; ++i) { const int kk = 2 * i + (lane >> 5); scr[kk * 33 + (lane & 31)] = 0.f; }
    }
    LDS_WAIT(); asm volatile("" ::: "memory");
    const int c = lane & 7;
#pragma unroll
    for (int j = 0; j < 4; ++j) { const int n = (lane >> 3) + 8 * j; const LAS float* s = scr + (8 * c) * 33 + n;
        v4u o; o.x = pk2(s[0 * 33], s[1 * 33]); o.y = pk2(s[2 * 33], s[3 * 33]); o.z = pk2(s[4 * 33], s[5 * 33]); o.w = pk2(s[6 * 33], s[7 * 33]);
        *(GAS v4u*)(WT + (size_t)(drow0 + n) * K + k0 + 8 * c) = o; }
    LDS_WAIT(); asm volatile("" ::: "memory");
}
__device__ __forceinline__ void prep_phase(const Args& a, int L, LAS unsigned char* lds, int vcu, int G, int wave, int lane) {
    asm volatile("" : "+s"(G));
    LAS float* scr = (LAS float*)(lds + wave * 16384);
    const int gw = vcu * NWAVES + wave, NGW = G * NWAVES;
    unsigned char* ws = a.ws;
    const bool even = !(L & 1); const int li = L >> 1;
    constexpr int nGU = 32 * 352, nD = 88 * 64, nOUT = 32 * 64;
    const int nIN = 32 * (even ? 160 : 128);
    const int total = 2 * nGU + 2 * nD + nIN + nOUT;
    for (int it = gw; it < total; it += NGW) {
        int r = it;
        if (r < 2 * nGU) { const int f = r / nGU; r -= f * nGU; const int kb = r / 352, rb = r % 352, tj = rb >> 3, sub = rb & 7;
            const float* W = (sub < 4 ? a.in[I_WG] : a.in[I_WU]) + (size_t)(L * 2 + f) * D * FF;
            tr_item(W, FF, 64 * kb, 128 * tj + 32 * (sub & 3), a.in[I_NG] + (L * 3 + (f ? 2 : 0)) * D, (bf16*)(ws + (f ? WT_GU2 : WT_GU1)), D, 32 * rb, scr, lane, false); continue; }
        r -= 2 * nGU;
        if (r < 2 * nD) { const int f = r / nD; r -= f * nD; const int kb = r / 64, nb = r % 64;
            tr_item(a.in[I_WD] + (size_t)(L * 2 + f) * FF * D, D, 64 * kb, 32 * nb, nullptr, (bf16*)(ws + (f ? WT_D2 : WT_D1)), FF, 32 * nb, scr, lane, false); continue; }
        r -= 2 * nD;
        if (r < nIN) {
            if (even) { const int kb = r / 160, rb = r % 160, d = 32 * rb; const bool zero = d >= E_IN; const int c0 = d < ZA ? A_COLS + d : d - ZA;
                tr_item(a.in[I_EWIN] + (size_t)li * D * E_IN, E_IN, 64 * kb, zero ? 0 : c0, a.in[I_NG] + (L * 3 + 1) * D, (bf16*)(ws + WT_IN), D, d, scr, lane, zero); }
            else { const int kb = r / 128, rb = r % 128;
                tr_item(a.in[I_OWIN] + (size_t)li * D * ZO, ZO, 64 * kb, 32 * rb, a.in[I_NG] + (L * 3 + 1) * D, (bf16*)(ws + WT_IN), D, 32 * rb, scr, lane, false); }
            continue; }
        r -= nIN;
        { const int kb = r / 64, nb = r % 64;
          tr_item((even ? a.in[I_EWOUT] : a.in[I_OWOUT]) + (size_t)li * D * D, D, 64 * kb, 32 * nb, nullptr, (bf16*)(ws + WT_OUT), D, 32 * nb, scr, lane, false); }
    }
    {
        const int gt = gw * 64 + lane, NGT = NGW * 64;
        if (even) {
            const float* w2 = a.in[I_EW2] + (size_t)li * 64 * 1024; const float* a2 = a.in[I_EA2] + (size_t)li * 64 * 1024; const float* g2 = a.in[I_EG2] + (size_t)li * 160 * 1024;
            bf16* W2T = (bf16*)(ws + SM_W2T); bf16* A2T = (bf16*)(ws + SM_A2T); bf16* G2T = (bf16*)(ws + SM_G2T);
            for (int e = gt; e < 1024 * 64; e += NGT) { const int k = e >> 10, c = e & 1023; W2T[c * 64 + k] = (bf16)f2bf(w2[e]); A2T[c * 64 + k] = (bf16)f2bf(a2[e]); }
            for (int e = gt; e < 1024 * 160; e += NGT) { const int k = e >> 10, c = e & 1023; G2T[c * 160 + k] = (bf16)f2bf(g2[e]); }
            if (li > 0) { bf16* V1T = (bf16*)(ws + SM_V1T); bf16* V2T = (bf16*)(ws + SM_V2T);
                for (int e = gt; e < 1024 * 32; e += NGT) { const int c = e >> 5, j = e & 31; V1T[j * 1024 + c] = (bf16)f2bf(a.in[I_V1][e]); }
                for (int e = gt; e < 32 * 1024; e += NGT) { const int j = e >> 10, c = e & 1023; V2T[c * 32 + j] = (bf16)f2bf(a.in[I_V2][e]); } }
        } else {
            const float* wsg = a.in[I_OWS] + (size_t)li * 16 * 128 * 128; bf16* WSB = (bf16*)(ws + SM_WSB);
            for (int e = gt; e < 16 * 128 * 128; e += NGT) { const int i = (e >> 7) & 127, j = e & 127; WSB[e] = (bf16)f2bf(j <= i ? wsg[e] : 0.f); }
        }
    }
    if (L == 0) {
        float* ss0 = (float*)(ws + WS_SS); bf16* XB = (bf16*)(ws + WS_XB);
        for (int m = gw; m < M; m += NGW) {
            const GAS f32x4* xr = (const GAS f32x4*)(a.in[I_X] + (size_t)m * D) + lane; GAS v2u* o = (GAS v2u*)(XB + (size_t)m * D) + lane; float s = 0.f;
#pragma unroll
            for (int j = 0; j < 8; ++j) { const f32x4 v = xr[64 * j]; s += (v.x * v.x + v.y * v.y) + (v.z * v.z + v.w * v.w); v2u w; w.x = pk2(v.x, v.y); w.y = pk2(v.z, v.w); o[64 * j] = w; }
            s = wave_sum(s); if (lane < 8) ss0[(size_t)lane * M + m] = lane ? 0.f : s;
        }
    }
}

typedef short bf16x8_t __attribute__((ext_vector_type(8)));
__device__ __forceinline__ float fast_tanh(float x) { const float e = __expf(2.0f * x); return 1.0f - 2.0f / (1.0f + e); }
__device__ __forceinline__ void lerp8(const v4u c, const v4u p, const float* mu, float (&o)[8]) {
    const f32x4 m0 = *(const f32x4*)mu, m1 = *(const f32x4*)(mu + 4);
    const float c0 = bflo(c.x), c1 = bfhi(c.x), c2 = bflo(c.y), c3 = bfhi(c.y), c4 = bflo(c.z), c5 = bfhi(c.z), c6 = bflo(c.w), c7 = bfhi(c.w);
    o[0] = c0 + (bflo(p.x) - c0) * m0.x; o[1] = c1 + (bfhi(p.x) - c1) * m0.y; o[2] = c2 + (bflo(p.y) - c2) * m0.z; o[3] = c3 + (bfhi(p.y) - c3) * m0.w;
    o[4] = c4 + (bflo(p.z) - c4) * m1.x; o[5] = c5 + (bfhi(p.z) - c5) * m1.y; o[6] = c6 + (bflo(p.w) - c6) * m1.z; o[7] = c7 + (bfhi(p.w) - c7) * m1.w;
}
__device__ __forceinline__ void lerp4(const v2u c, const v2u p, const f32x4 m, float (&o)[4]) {
    const float c0 = bflo(c.x), c1 = bfhi(c.x), c2 = bflo(c.y), c3 = bfhi(c.y);
    o[0] = c0 + (bflo(p.x) - c0) * m.x; o[1] = c1 + (bfhi(p.x) - c1) * m.y; o[2] = c2 + (bflo(p.y) - c2) * m.z; o[3] = c3 + (bfhi(p.y) - c3) * m.w;
}
__device__ __forceinline__ v2u pack4(float a, float b, float c, float d) { v2u w; w.x = pk2(a, b); w.y = pk2(c, d); return w; }
constexpr int E1_AW = 0, E1_AA = 9216, E1_AG = 18432, E1_PP = 40960, E1_PB = 106496;
__device__ __forceinline__ void e1_phase(const Args& a, int li, LAS unsigned char* ldsb, int vcu, int G, int tid) {
    unsigned char* ws = a.ws;
    const bf16* Z = (const bf16*)(ws + WS_ACT);
    bf16* R = (bf16*)(ws + SC_R); bf16* K2 = (bf16*)(ws + SC_K2); bf16* KK = (bf16*)(ws + SC_KK); bf16* BB = (bf16*)(ws + SC_BB); bf16* LW = (bf16*)(ws + SC_LW); bf16* GG = (bf16*)(ws + SC_GG);
    bf16* VO = (bf16*)(ws + (li ? WS_V2 : WS_VF)); const bf16* VF = (const bf16*)(ws + WS_VF);
    const bf16* W2T = (const bf16*)(ws + SM_W2T); const bf16* A2T = (const bf16*)(ws + SM_A2T); const bf16* G2T = (const bf16*)(ws + SM_G2T);
    const bf16* V1T = (const bf16*)(ws + SM_V1T); const bf16* V2T = (const bf16*)(ws + SM_V2T);
    const float* mu = a.in[I_EMU] + li * A_COLS;
    const float* w0 = a.in[I_EW0] + li * 1024; const float* a0 = a.in[I_EA0] + li * 1024;
    const float* kkw = a.in[I_EKK] + li * 1024; const float* kaw = a.in[I_EKA] + li * 1024; const float* v0w = a.in[I_V0];
    const int lane = tid & 63, wave = tid >> 6, fr = lane & 15, fq = lane >> 4;
    for (int unit = vcu; unit < M / 64; unit += G) {
        const int m0 = unit * 64;
        for (int e = tid; e < 64 * 36; e += NTHR) { const int r = e / 36, ch = e % 36, j0 = 8 * ch, m = m0 + r; const bool first = (m & (T - 1)) == 0;
            const v4u cur = *(const GAS v4u*)(Z + (size_t)m * ZN + ZA + 3072 + j0); v4u prv = {0u, 0u, 0u, 0u}; if (!first) prv = *(const GAS v4u*)(Z + (size_t)(m - 1) * ZN + ZA + 3072 + j0);
            float x[8]; lerp8(cur, prv, mu + 3072 + j0, x);
            if (j0 < 64) {
#pragma unroll
                for (int i = 0; i < 8; ++i) x[i] = fast_tanh(x[i]);
            } else if (j0 >= 128) {
#pragma unroll
                for (int i = 0; i < 8; ++i) x[i] = sigmoidf_(x[i]);
            }
            v4u o; o.x = pk2(x[0], x[1]); o.y = pk2(x[2], x[3]); o.z = pk2(x[4], x[5]); o.w = pk2(x[6], x[7]);
            LAS unsigned char* dst = j0 < 64 ? ldsb + E1_AW + r * 144 + j0 * 2 : j0 < 128 ? ldsb + E1_AA + r * 144 + (j0 - 64) * 2 : ldsb + E1_AG + r * 336 + (j0 - 128) * 2;
            *(LAS v4u*)dst = o; }
        if (li > 0) {
            f32x4 pacc[4][2];
#pragma unroll
            for (int mt = 0; mt < 4; ++mt) { pacc[mt][0] = (f32x4){0.f, 0.f, 0.f, 0.f}; pacc[mt][1] = pacc[mt][0]; }
            for (int ks = 0; ks < 4; ++ks) { const int c = 128 * wave + 32 * ks + 8 * fq;
                const bf16x8_t w0f = *(const GAS bf16x8_t*)(V1T + (size_t)fr * 1024 + c), w1f = *(const GAS bf16x8_t*)(V1T + (size_t)(16 + fr) * 1024 + c);
#pragma unroll
                for (int mt = 0; mt < 4; ++mt) { const int m = m0 + 16 * mt + fr; const bool first = (m & (T - 1)) == 0;
                    const v4u cur = *(const GAS v4u*)(Z + (size_t)m * ZN + ZA + 2048 + c); v4u prv = {0u, 0u, 0u, 0u}; if (!first) prv = *(const GAS v4u*)(Z + (size_t)(m - 1) * ZN + ZA + 2048 + c);
                    float x[8]; lerp8(cur, prv, mu + 2048 + c, x);
                    v4u o; o.x = pk2(x[0], x[1]); o.y = pk2(x[2], x[3]); o.z = pk2(x[4], x[5]); o.w = pk2(x[6], x[7]);
                    const bf16x8_t af = __builtin_bit_cast(bf16x8_t, o);
                    pacc[mt][0] = __builtin_amdgcn_mfma_f32_16x16x32_bf16(w0f, af, pacc[mt][0], 0, 0, 0); pacc[mt][1] = __builtin_amdgcn_mfma_f32_16x16x32_bf16(w1f, af, pacc[mt][1], 0, 0, 0); } }
#pragma unroll
            for (int mt = 0; mt < 4; ++mt)
#pragma unroll
                for (int nt = 0; nt < 2; ++nt) *(LAS f32x4*)(ldsb + E1_PP + ((wave * 64 + 16 * mt + fr) * 32 + 16 * nt + 4 * fq) * 4) = pacc[mt][nt];
        }
        __syncthreads();
        if (li > 0) {
            for (int e = tid; e < 64 * 32; e += NTHR) { float sum = 0.f;
#pragma unroll
                for (int w = 0; w < 8; ++w) sum += *(const LAS float*)(ldsb + E1_PP + (w * 2048 + e) * 4);
                *(LAS bf16*)(ldsb + E1_PB + (e >> 5) * 80 + (e & 31) * 2) = (bf16)f2bf(sum); }
            __syncthreads();
        }
#pragma unroll 1
        for (int hm = 0; hm < 8; ++hm) {
            const int hh = hm >> 2, mt = hm & 3;
            const int cb = 128 * wave + 64 * hh;
            const int m = m0 + 16 * mt + fr; const bool first = (m & (T - 1)) == 0;
            f32x4 aa[4], aw[4], ag[4], avr[4];
#pragma unroll
            for (int nt = 0; nt < 4; ++nt) { aa[nt] = (f32x4){0.f, 0.f, 0.f, 0.f}; aw[nt] = aa[nt]; ag[nt] = aa[nt]; avr[nt] = aa[nt]; }
#pragma unroll
            for (int ks = 0; ks < 2; ++ks) {
                const bf16x8_t fa = *(const LAS bf16x8_t*)(ldsb + E1_AA + (16 * mt + fr) * 144 + (32 * ks + 8 * fq) * 2), fw = *(const LAS bf16x8_t*)(ldsb + E1_AW + (16 * mt + fr) * 144 + (32 * ks + 8 * fq) * 2);
#pragma unroll
                for (int nt = 0; nt < 4; ++nt) { const size_t wo = (size_t)(cb + 16 * nt + fr) * 64 + 32 * ks + 8 * fq;
                    aa[nt] = __builtin_amdgcn_mfma_f32_16x16x32_bf16(*(const GAS bf16x8_t*)(A2T + wo), fa, aa[nt], 0, 0, 0);
                    aw[nt] = __builtin_amdgcn_mfma_f32_16x16x32_bf16(*(const GAS bf16x8_t*)(W2T + wo), fw, aw[nt], 0, 0, 0); } }
#pragma unroll
            for (int ks = 0; ks < 5; ++ks) { const bf16x8_t fg = *(const LAS bf16x8_t*)(ldsb + E1_AG + (16 * mt + fr) * 336 + (32 * ks + 8 * fq) * 2);
#pragma unroll
                for (int nt = 0; nt < 4; ++nt) ag[nt] = __builtin_amdgcn_mfma_f32_16x16x32_bf16(*(const GAS bf16x8_t*)(G2T + (size_t)(cb + 16 * nt + fr) * 160 + 32 * ks + 8 * fq), fg, ag[nt], 0, 0, 0); }
            if (li > 0) { const bf16x8_t fp = *(const LAS bf16x8_t*)(ldsb + E1_PB + (16 * mt + fr) * 80 + (8 * fq) * 2);
#pragma unroll
                for (int nt = 0; nt < 4; ++nt) avr[nt] = __builtin_amdgcn_mfma_f32_16x16x32_bf16(*(const GAS bf16x8_t*)(V2T + (size_t)(cb + 16 * nt + fr) * 32 + 8 * fq), fp, avr[nt], 0, 0, 0); }
            const size_t zo = (size_t)m * ZN + ZA + cb + 4 * fq;
            float k1[4][4], av[4][4], kk0[4][4]; float n2 = 0.f;
#pragma unroll
            for (int nt = 0; nt < 4; ++nt) { const int c = cb + 16 * nt + 4 * fq;
                const v2u cur = *(const GAS v2u*)(Z + zo + 1024 + 16 * nt); v2u prv = {0u, 0u}; if (!first) prv = *(const GAS v2u*)(Z + zo - ZN + 1024 + 16 * nt);
                lerp4(cur, prv, *(const f32x4*)(mu + 1024 + c), k1[nt]);
                const f32x4 a0v = *(const f32x4*)(a0 + c), kkv = *(const f32x4*)(kkw + c);
#pragma unroll
                for (int j = 0; j < 4; ++j) { av[nt][j] = sigmoidf_(a0v[j] + aa[nt][j]); kk0[nt][j] = k1[nt][j] * kkv[j]; n2 += kk0[nt][j] * kk0[nt][j]; } }
            n2 += __shfl_xor(n2, 16); n2 += __shfl_xor(n2, 32);
            const float inv = 1.0f / fmaxf(sqrtf(n2), 1e-12f);
#pragma unroll
            for (int nt = 0; nt < 4; ++nt) { const int c = cb + 16 * nt + 4 * fq; const size_t o = (size_t)m * 1024 + c; const f32x4 kav = *(const f32x4*)(kaw + c), w0v = *(const f32x4*)(w0 + c);
                float kk[4], k2[4], bb[4], lw[4];
#pragma unroll
                for (int j = 0; j < 4; ++j) { kk[j] = kk0[nt][j] * inv; k2[j] = k1[nt][j] * (1.0f + (av[nt][j] - 1.0f) * kav[j]); bb[j] = kk[j] * av[nt][j];
                    const float y = -(w0v[j] + aw[nt][j]); const float sp = fmaxf(y, 0.f) + __logf(1.0f + __expf(-fabsf(y))); lw[j] = -__expf(-sp - 0.5f); }
                *(GAS v2u*)(KK + o) = pack4(kk[0], kk[1], kk[2], kk[3]); *(GAS v2u*)(K2 + o) = pack4(k2[0], k2[1], k2[2], k2[3]); *(GAS v2u*)(BB + o) = pack4(bb[0], bb[1], bb[2], bb[3]);
                *(GAS v2u*)(LW + o) = pack4(lw[0], lw[1], lw[2], lw[3]); *(GAS v2u*)(GG + o) = pack4(ag[nt][0], ag[nt][1], ag[nt][2], ag[nt][3]);
                const v2u rc = *(const GAS v2u*)(Z + zo + 16 * nt), vc = *(const GAS v2u*)(Z + zo + 2048 + 16 * nt); v2u rp = {0u, 0u}, vp = {0u, 0u};
                if (!first) { rp = *(const GAS v2u*)(Z + zo - ZN + 16 * nt); vp = *(const GAS v2u*)(Z + zo - ZN + 2048 + 16 * nt); }
                float rr[4], vv[4]; lerp4(rc, rp, *(const f32x4*)(mu + c), rr); lerp4(vc, vp, *(const f32x4*)(mu + 2048 + c), vv);
                if (li > 0) { const f32x4 v0v = *(const f32x4*)(v0w + c); const v2u vf = *(const GAS v2u*)(VF + o); const float f0 = bflo(vf.x), f1 = bfhi(vf.x), f2 = bflo(vf.y), f3 = bfhi(vf.y);
                    vv[0] += (f0 - vv[0]) * sigmoidf_(v0v[0] + avr[nt][0]); vv[1] += (f1 - vv[1]) * sigmoidf_(v0v[1] + avr[nt][1]);
                    vv[2] += (f2 - vv[2]) * sigmoidf_(v0v[2] + avr[nt][2]); vv[3] += (f3 - vv[3]) * sigmoidf_(v0v[3] + avr[nt][3]); }
                *(GAS v2u*)(R + o) = pack4(rr[0], rr[1], rr[2], rr[3]); *(GAS v2u*)(VO + o) = pack4(vv[0], vv[1], vv[2], vv[3]); }
        }
        __syncthreads();
    }
}

constexpr int SCH = 32;
constexpr int SC_NCHK = 5 * SCH * 8 + SCH;
struct ScanSrc { const bf16 *LW, *K2, *R, *KK, *BB, *V; };
__device__ __forceinline__ v4u scan_ld(const ScanSrc& p, int e, size_t rowbase, int colh, int q) {
    if (e < 5 * SCH * 8) { const int i = e / (SCH * 8), rem = e % (SCH * 8), tt = rem >> 3, j = rem & 7;
        const bf16* src = (i == 0 ? p.LW : i == 1 ? p.K2 : i == 2 ? p.R : i == 3 ? p.KK : p.BB) + (rowbase + tt) * 1024 + colh + 8 * j; return *(const GAS v4u*)src; }
    return *(const GAS v4u*)(p.V + (rowbase + (e - 5 * SCH * 8)) * 1024 + colh + 8 * q);
}
__device__ __forceinline__ void scan_st(LAS float* vecb, LAS float* vvb, int e, const v4u w) {
    f32x4 lo, hi; lo.x = bflo(w.x); lo.y = bfhi(w.x); lo.z = bflo(w.y); lo.w = bfhi(w.y); hi.x = bflo(w.z); hi.y = bfhi(w.z); hi.z = bflo(w.w); hi.w = bfhi(w.w);
    if (e < 5 * SCH * 8) { const int i = e / (SCH * 8), rem = e % (SCH * 8), tt = rem >> 3, j = rem & 7;
        if (i == 0) { lo.x = __expf(lo.x); lo.y = __expf(lo.y); lo.z = __expf(lo.z); lo.w = __expf(lo.w); hi.x = __expf(hi.x); hi.y = __expf(hi.y); hi.z = __expf(hi.z); hi.w = __expf(hi.w); }
        if (i == 3) { lo = -lo; hi = -hi; }
        LAS f32x4* d = (LAS f32x4*)(vecb + (i * SCH + tt) * 64 + 8 * j); d[0] = lo; d[1] = hi; }
    else { LAS f32x4* d = (LAS f32x4*)(vvb + (e - 5 * SCH * 8) * 8); d[0] = lo; d[1] = hi; }
}
__device__ __forceinline__ void scan_unit(const Args& a, int li, int su, LAS unsigned char* ldsb, int tid) {
    unsigned char* ws = a.ws;
    const ScanSrc src{(const bf16*)(ws + SC_LW), (const bf16*)(ws + SC_K2), (const bf16*)(ws + SC_R), (const bf16*)(ws + SC_KK), (const bf16*)(ws + SC_BB), (const bf16*)(ws + (li ? WS_V2 : WS_VF))};
    float* Y = (float*)(ws + WS_XB);
    const int bh = su >> 3, q = su & 7, b = bh >> 4, h = bh & 15, colh = h * 64; const size_t row0 = (size_t)b * T;
    LAS float* vec = (LAS float*)ldsb;
    LAS float* vvl = vec + 2 * 5 * SCH * 64;
    LAS float* ybl = vvl + 2 * SCH * 8;
    const int lane = tid & 63, cw = tid >> 6, rp = lane >> 4, kg = lane & 15, lr = 4 * cw + rp;
    f32x4 S0 = {0.f, 0.f, 0.f, 0.f};
    for (int e = tid; e < SC_NCHK; e += NTHR) scan_st(vec, vvl, e, scan_ld(src, e, row0, colh, q));
    const int ft = tid - 128; v4u pre[4];
#pragma unroll
    for (int k = 0; k < 4; ++k) { pre[k] = (v4u){0u, 0u, 0u, 0u}; const int e = ft + 384 * k; if (tid >= 128 && e < SC_NCHK) pre[k] = scan_ld(src, e, row0 + SCH, colh, q); }
    constexpr int NCH = T / SCH;
    for (int c = 0; c < NCH; ++c) {
        __syncthreads();
        const int buf = c & 1;
        if (tid < 128) {
            const LAS float* vb = vec + buf * 5 * SCH * 64 + 4 * kg; const LAS float* vvb = vvl + buf * SCH * 8 + lr;
            LAS float* yb = (kg == 0) ? ybl + buf * SCH * 8 + lr : ybl + 2 * SCH * 8 + tid;
            const int ystep = (kg == 0) ? 8 : 0;
            f32x4 wv = *(const LAS f32x4*)(vb), kv = *(const LAS f32x4*)(vb + SCH * 64), rv = *(const LAS f32x4*)(vb + 2 * SCH * 64), av = *(const LAS f32x4*)(vb + 3 * SCH * 64), bv = *(const LAS f32x4*)(vb + 4 * SCH * 64);
            float v1 = *vvb;
            f32x4 wn = *(const LAS f32x4*)(vb + 64), kn = *(const LAS f32x4*)(vb + (SCH + 1) * 64), rn = *(const LAS f32x4*)(vb + (2 * SCH + 1) * 64), an = *(const LAS f32x4*)(vb + (3 * SCH + 1) * 64), bn = *(const LAS f32x4*)(vb + (4 * SCH + 1) * 64);
            float vn = vvb[8];
#pragma unroll 4
            for (int t = 0; t < SCH; ++t) {
                const int t2 = (t + 2 < SCH) ? t + 2 : SCH - 1;
                const f32x4 w2 = *(const LAS f32x4*)(vb + t2 * 64), k2 = *(const LAS f32x4*)(vb + (SCH + t2) * 64), r2 = *(const LAS f32x4*)(vb + (2 * SCH + t2) * 64),
                            a2 = *(const LAS f32x4*)(vb + (3 * SCH + t2) * 64), b2 = *(const LAS f32x4*)(vb + (4 * SCH + t2) * 64);
                const float v2n = vvb[t2 * 8];
                const f32x4 P = S0 * wv + kv * v1;
                f32x2 d2 = (f32x2){S0.x, S0.y} * (f32x2){av.x, av.y}; d2 = (f32x2){S0.z, S0.w} * (f32x2){av.z, av.w} + d2;
                const float sa0 = row16_sum(d2.x + d2.y);
                S0 = bv * sa0 + P;
                f32x2 e2 = (f32x2){S0.x, S0.y} * (f32x2){rv.x, rv.y}; e2 = (f32x2){S0.z, S0.w} * (f32x2){rv.z, rv.w} + e2;
                yb[t * ystep] = row16_sum(e2.x + e2.y);
                wv = wn; kv = kn; rv = rn; av = an; bv = bn; v1 = vn;
                wn = w2; kn = k2; rn = r2; an = a2; bn = b2; vn = v2n;
            }
        } else {
            if (c + 1 < NCH) {
#pragma unroll
                for (int k = 0; k < 4; ++k) { const int e = ft + 384 * k; if (e < SC_NCHK) scan_st(vec + (buf ^ 1) * 5 * SCH * 64, vvl + (buf ^ 1) * SCH * 8, e, pre[k]); } }
            if (c + 2 < NCH) {
#pragma unroll
                for (int k = 0; k < 4; ++k) { const int e = ft + 384 * k; if (e < SC_NCHK) pre[k] = scan_ld(src, e, row0 + (size_t)(c + 2) * SCH, colh, q); } }
            if (c > 0 && ft < 64) { const int tt = ft >> 1, part = ft & 1;
                *(GAS f32x4*)(Y + (row0 + (size_t)(c - 1) * SCH + tt) * 1024 + colh + 8 * q + 4 * part) = *(const LAS f32x4*)(ybl + (buf ^ 1) * SCH * 8 + tt * 8 + 4 * part); }
        }
    }
    __syncthreads();
    if (tid < 64) { const int tt = tid >> 1, part = tid & 1;
        *(GAS f32x4*)(Y + (row0 + (size_t)(NCH - 1) * SCH + tt) * 1024 + colh + 8 * q + 4 * part) = *(const LAS f32x4*)(ybl + ((NCH - 1) & 1) * SCH * 8 + tt * 8 + 4 * part); }
    __syncthreads();
}

constexpr size_t CS_AR = WS_ACT, CS_BK = WS_ACT + 128 * MiB, CS_Y0 = WS_ACT + 256 * MiB, CS_GL = WS_ACT + 320 * MiB;
__device__ __forceinline__ int cs_perm(int k) { return (k & 32) + 8 * ((k >> 2) & 3) + 4 * ((k >> 4) & 1) + (k & 3); }
__device__ __forceinline__ f32x4 mm16_ll(const LAS float* A, const LAS float* B, f32x4 c, int fr, int fq) {
    const f32x4 a4 = *(const LAS f32x4*)(A + fr * 16 + 4 * fq);
#pragma unroll
    for (int s = 0; s < 4; ++s) c = __builtin_amdgcn_mfma_f32_16x16x4f32(a4[s], B[(4 * fq + s) * 16 + fr], c, 0, 0, 0);
    return c;
}
__device__ __forceinline__ f32x4 mm16_la(const LAS float* A, const f32x4 b, f32x4 c, int fr, int fq) {
    const f32x4 a4 = *(const LAS f32x4*)(A + fr * 16 + 4 * fq);
#pragma unroll
    for (int s = 0; s < 4; ++s) c = __builtin_amdgcn_mfma_f32_16x16x4f32(a4[s], b[s], c, 0, 0, 0);
    return c;
}
__device__ __forceinline__ void st16(LAS float* Mx, const f32x4 c, int fr, int fq) {
#pragma unroll
    for (int r = 0; r < 4; ++r) Mx[(4 * fq + r) * 16 + fr] = c[r];
}
__device__ __forceinline__ void scanpre_phase(const Args& a, int li, LAS unsigned char* ldsb, int vcu, int G, int tid) {
    unsigned char* ws = a.ws;
    const bf16* Rr = (const bf16*)(ws + SC_R); const bf16* K2 = (const bf16*)(ws + SC_K2); const bf16* KK = (const bf16*)(ws + SC_KK); const bf16* BB = (const bf16*)(ws + SC_BB); const bf16* LW = (const bf16*)(ws + SC_LW);
    const bf16* V = (const bf16*)(ws + (li ? WS_V2 : WS_VF));
    bf16* ARo = (bf16*)(ws + CS_AR); bf16* BKo = (bf16*)(ws + CS_BK); bf16* Y0o = (bf16*)(ws + CS_Y0); float* GLo = (float*)(ws + CS_GL); bf16* U0o = (bf16*)(ws + WS_U0);
    const int lane = tid & 63, wave = tid >> 6, fr = lane & 15, fq = lane >> 4;
    LAS unsigned char* wl = ldsb + wave * 17408;
    LAS bf16* LAR = (LAS bf16*)wl; LAS bf16* LBK = (LAS bf16*)(wl + 4608); LAS float* LM = (LAS float*)(wl + 9216); LAS float* LX = (LAS float*)(wl + 13312);
    const LAS float* Mab = LM, *Mak = LM + 256, *Mrb = LM + 512, *Mrk = LM + 768;
    LAS float* Tm = LX, *Na = LX + 256, *Nb = LX + 512;
    for (int ch = vcu * NWAVES + wave; ch < 32 * 1024; ch += G * NWAVES) {
        const int bh = ch >> 10, ci = ch & 1023, b = bh >> 4, h = bh & 15; const size_t row0 = (size_t)b * T + 16 * ci;
        f32x4 At[4], Rt[4], vv[4]; float glane;
#pragma unroll
        for (int nt = 0; nt < 4; ++nt) { f32x4 lw, kk, bb, k2, rr;
#pragma unroll
            for (int s = 0; s < 4; ++s) { const size_t o = (row0 + 4 * fq + s) * 1024 + h * 64 + 16 * nt + fr;
                lw[s] = bf2f(LW[o]); kk[s] = bf2f(KK[o]); bb[s] = bf2f(BB[o]); k2[s] = bf2f(K2[o]); rr[s] = bf2f(Rr[o]); vv[nt][s] = bf2f(V[o]); }
            f32x4 cum; cum[0] = lw[0]; cum[1] = cum[0] + lw[1]; cum[2] = cum[1] + lw[2]; cum[3] = cum[2] + lw[3];
            float x = cum[3]; { const float y = __shfl_up(x, 16); if (fq >= 1) x += y; } { const float y = __shfl_up(x, 32); if (fq >= 2) x += y; }
            const float excl = x - cum[3]; const float cl = __shfl(x, 48 + fr);
            bf16* bo = BKo + (size_t)ch * 2048 + (16 * nt + fr) * 32 + 8 * fq; f32x4 bh4, kh4;
#pragma unroll
            for (int s = 0; s < 4; ++s) { const float c = excl + cum[s]; const float g = __expf(c), gp = __expf(c - lw[s]), gi = __expf(-c), e = __expf(cl - c);
                At[nt][s] = -kk[s] * gp; Rt[nt][s] = rr[s] * g; bh4[s] = bb[s] * e; kh4[s] = k2[s] * e;
                const int t = 4 * fq + s, cc = 16 * nt + fr;
                LAR[t * 72 + cc] = (bf16)f2bf(At[nt][s]); LAR[(16 + t) * 72 + cc] = (bf16)f2bf(Rt[nt][s]); LBK[t * 72 + cc] = (bf16)f2bf(bb[s] * gi); LBK[(16 + t) * 72 + cc] = (bf16)f2bf(k2[s] * gi); }
            *(GAS v4u*)bo = (v4u){pk2(bh4[0], bh4[1]), pk2(bh4[2], bh4[3]), pk2(kh4[0], kh4[1]), pk2(kh4[2], kh4[3])};
            if (fq == 0) GLo[(size_t)ch * 64 + 16 * nt + fr] = __expf(cl);
            glane = cl; }
        (void)glane;
        LDS_WAIT(); asm volatile("" ::: "memory");
#pragma unroll
        for (int mt = 0; mt < 2; ++mt)
#pragma unroll
            for (int nt = 0; nt < 2; ++nt) { f32x4 m = {0.f, 0.f, 0.f, 0.f};
#pragma unroll
                for (int ks = 0; ks < 2; ++ks) { const bf16x8_t af = *(const LAS bf16x8_t*)(LAR + (16 * mt + fr) * 72 + 32 * ks + 8 * fq), bfr = *(const LAS bf16x8_t*)(LBK + (16 * nt + fr) * 72 + 32 * ks + 8 * fq);
                    m = __builtin_amdgcn_mfma_f32_16x16x32_bf16(af, bfr, m, 0, 0, 0); }
#pragma unroll
                for (int r = 0; r < 4; ++r) { const int t = 4 * fq + r; const bool keep = mt ? (fr <= t) : (fr < t); LM[((mt * 2 + nt) * 16 + t) * 16 + fr] = keep ? m[r] : 0.f; } }
        LDS_WAIT(); asm volatile("" ::: "memory");
        { const f32x4 z = {0.f, 0.f, 0.f, 0.f};
          f32x4 t1;
#pragma unroll
          for (int r = 0; r < 4; ++r) t1[r] = Mab[(4 * fq + r) * 16 + fr] + ((4 * fq + r) == fr ? 1.0f : 0.f);
          st16(Tm, t1, fr, fq);
          f32x4 n2 = mm16_ll(Mab, Mab, z, fr, fq); st16(Na, n2, fr, fq);
          LDS_WAIT(); asm volatile("" ::: "memory");
          f32x4 t2 = mm16_ll(Tm, Na, t1, fr, fq);
          f32x4 n4 = mm16_ll(Na, Na, z, fr, fq);
          LDS_WAIT(); asm volatile("" ::: "memory");
          st16(Tm, t2, fr, fq); st16(Nb, n4, fr, fq);
          LDS_WAIT(); asm volatile("" ::: "memory");
          f32x4 t3 = mm16_ll(Tm, Nb, t2, fr, fq);
          f32x4 n8 = mm16_ll(Nb, Nb, z, fr, fq);
          LDS_WAIT(); asm volatile("" ::: "memory");
          st16(Tm, t3, fr, fq); st16(Na, n8, fr, fq);
          LDS_WAIT(); asm volatile("" ::: "memory");
          f32x4 t4 = mm16_ll(Tm, Na, t3, fr, fq);
          LDS_WAIT(); asm volatile("" ::: "memory");
          st16(Tm, t4, fr, fq);
          LDS_WAIT(); asm volatile("" ::: "memory"); }
#pragma unroll
        for (int nt = 0; nt < 4; ++nt) { const f32x4 z = {0.f, 0.f, 0.f, 0.f};
            const f32x4 w1 = mm16_la(Mak, vv[nt], z, fr, fq);
            const f32x4 u0 = mm16_la(Tm, w1, z, fr, fq);
            const f32x4 ah = mm16_la(Tm, At[nt], z, fr, fq);
            const f32x4 rh = mm16_la(Mrb, ah, Rt[nt], fr, fq);
            f32x4 y0 = mm16_la(Mrb, u0, z, fr, fq); y0 = mm16_la(Mrk, vv[nt], y0, fr, fq);
            const int k = 16 * nt + fr; bf16* arp = ARo + (size_t)ch * 2048 + cs_perm(k);
#pragma unroll
            for (int s = 0; s < 4; ++s) { arp[(4 * fq + s) * 64] = (bf16)f2bf(ah[s]); arp[(16 + 4 * fq + s) * 64] = (bf16)f2bf(rh[s]); }
            *(GAS v2u*)(Y0o + (size_t)ch * 1024 + k * 16 + 4 * fq) = pack4(y0[0], y0[1], y0[2], y0[3]);
            *(GAS v2u*)(U0o + (size_t)ch * 1024 + k * 16 + 4 * fq) = pack4(u0[0], u0[1], u0[2], u0[3]); }
        LDS_WAIT(); asm volatile("" ::: "memory");
    }
}
constexpr int CQ_NS = 13, CQ_SLOT = 10240, CQ_FULL = CQ_NS * CQ_SLOT, CQ_DONE = CQ_FULL + 64, CQ_DEPTH = 5;
#define CQ_GLDS(src, dst) __builtin_amdgcn_global_load_lds((const unsigned*)(src), (LAS unsigned*)(dst), 16, 0, 0)
__device__ __forceinline__ void scanseq_phase(const Args& a, int li, LAS unsigned char* ldsb, int vcu, int tid) {
    volatile LAS unsigned* FULL = (volatile LAS unsigned*)(ldsb + CQ_FULL); volatile LAS unsigned* DONE = (volatile LAS unsigned*)(ldsb + CQ_DONE);
    if (tid < 32) ((LAS unsigned*)(ldsb + CQ_FULL))[tid] = 0u;
    __syncthreads();
    const int wave = __builtin_amdgcn_readfirstlane(tid >> 6), lane = tid & 63;
    if (vcu < 128 && wave < 3) {
        unsigned char* ws = a.ws;
        const int bh = vcu >> 2, vb = vcu & 3, b = bh >> 4, h = bh & 15; const size_t row0 = (size_t)b * T; const size_t ch0 = (size_t)bh * 1024;
        if (wave > 0) {
            const unsigned char* ARo = ws + CS_AR; const unsigned char* BKo = ws + CS_BK; const unsigned char* Y0o = ws + CS_Y0; const unsigned char* GLo = ws + CS_GL; const unsigned char* U0o = ws + WS_U0;
            const unsigned char* V = ws + (li ? WS_V2 : WS_VF);
            const unsigned oAR = (unsigned)((lane >> 3) * 128 + 16 * ((lane & 7) ^ ((lane >> 3) & 7)));
            unsigned oBK[4];
#pragma unroll
            for (int i = 0; i < 4; ++i) { const int k = 16 * i + (lane >> 2); oBK[i] = (unsigned)(k * 64 + 16 * ((lane & 3) ^ ((k >> 2) & 3))); }
            const unsigned oUY = (unsigned)((16 * vb + ((lane & 31) >> 1)) * 32 + 16 * (lane & 1));
            const size_t oV = ((size_t)(lane >> 1) * 1024 + h * 64 + 16 * vb) * 2 + 16 * (lane & 1);
            const unsigned oG = (unsigned)(16 * (lane & 15));
            int pub = wave - 1; unsigned spins = 0;
            for (int c = wave - 1; c < 1024; c += 2) {
                const int s = c % CQ_NS;
                if (c >= CQ_NS) { while ((int)DONE[0] < c - CQ_NS + 1) { __builtin_amdgcn_s_sleep(1); if (++spins > (1u << 24)) break; } }
                LAS unsigned char* sl = ldsb + s * CQ_SLOT; const size_t ch = ch0 + c;
                const unsigned char* ar = ARo + ch * 4096; const unsigned char* bk = BKo + ch * 4096;
#pragma unroll
                for (int i = 0; i < 4; ++i) CQ_GLDS(ar + i * 1024 + oAR, sl + i * 1024);
#pragma unroll
                for (int i = 0; i < 4; ++i) CQ_GLDS(bk + oBK[i], sl + 4096 + i * 1024);
                CQ_GLDS((lane < 32 ? U0o : Y0o) + ch * 2048 + oUY, sl + 8192);
                CQ_GLDS(lane < 32 ? V + (row0 + 16 * (size_t)c) * 2048 + oV : GLo + ch * 256 + oG, sl + 9216);
                asm volatile("s_waitcnt vmcnt(50)" ::: "memory");
                for (; pub <= c - 2 * CQ_DEPTH; pub += 2) FULL[pub % CQ_NS] = (unsigned)(pub + 1);
            }
            asm volatile("s_waitcnt vmcnt(0)" ::: "memory");
            for (; pub < 1024; pub += 2) FULL[pub % CQ_NS] = (unsigned)(pub + 1);
        } else {
            float* Y = (float*)(ws + WS_XB);
            const int fr = lane & 15, fq = lane >> 4; const int colv = h * 64 + 16 * vb + fr;
            f32x4 St[4];
#pragma unroll
            for (int kt = 0; kt < 4; ++kt) St[kt] = (f32x4){0.f, 0.f, 0.f, 0.f};
            unsigned spins = 0;
            for (int c = 0; c < 1024; ++c) {
                const int s = c % CQ_NS; LAS unsigned char* sl = ldsb + s * CQ_SLOT;
                while (FULL[s] != (unsigned)(c + 1)) { if (++spins > (1u << 26)) break; }
                __builtin_amdgcn_fence(__ATOMIC_ACQUIRE, "workgroup");
                bf16x8_t ar[2][2], bk[4]; f32x4 gl[4];
#pragma unroll
                for (int mt = 0; mt < 2; ++mt)
#pragma unroll
                    for (int ks = 0; ks < 2; ++ks) { const int r = 16 * mt + fr; ar[mt][ks] = *(const LAS bf16x8_t*)(sl + r * 128 + 16 * ((4 * ks + fq) ^ (r & 7))); }
#pragma unroll
                for (int kt = 0; kt < 4; ++kt) { const int k = 16 * kt + fr; bk[kt] = *(const LAS bf16x8_t*)(sl + 4096 + k * 64 + 16 * (fq ^ ((k >> 2) & 3))); gl[kt] = *(const LAS f32x4*)(sl + 9728 + (16 * kt + 4 * fq) * 4); }
                const v2u u0 = *(const LAS v2u*)(sl + 8192 + fr * 32 + 8 * fq), y0 = *(const LAS v2u*)(sl + 8704 + fr * 32 + 8 * fq);
                unsigned vs[4];
#pragma unroll
                for (int j = 0; j < 4; ++j) vs[j] = *(const LAS unsigned short*)(sl + 9216 + (4 * fq + j) * 32 + 2 * fr);
                bf16x8_t sb[2];
#pragma unroll
                for (int ks = 0; ks < 2; ++ks) { v4u w; w.x = pk2(St[2 * ks][0], St[2 * ks][1]); w.y = pk2(St[2 * ks][2], St[2 * ks][3]); w.z = pk2(St[2 * ks + 1][0], St[2 * ks + 1][1]); w.w = pk2(St[2 * ks + 1][2], St[2 * ks + 1][3]); sb[ks] = __builtin_bit_cast(bf16x8_t, w); }
                f32x4 au = {0.f, 0.f, 0.f, 0.f}, ay = {0.f, 0.f, 0.f, 0.f};
#pragma unroll
                for (int ks = 0; ks < 2; ++ks) { au = __builtin_amdgcn_mfma_f32_16x16x32_bf16(ar[0][ks], sb[ks], au, 0, 0, 0); ay = __builtin_amdgcn_mfma_f32_16x16x32_bf16(ar[1][ks], sb[ks], ay, 0, 0, 0); }
                { const size_t yr = (row0 + 16 * (size_t)c + 4 * fq) * 1024 + colv;
                  Y[yr] = ay[0] + bflo(y0.x); Y[yr + 1024] = ay[1] + bfhi(y0.x); Y[yr + 2048] = ay[2] + bflo(y0.y); Y[yr + 3072] = ay[3] + bfhi(y0.y); }
                v4u uw; uw.x = pk2(au[0] + bflo(u0.x), au[1] + bfhi(u0.x)); uw.y = pk2(au[2] + bflo(u0.y), au[3] + bfhi(u0.y)); uw.z = vs[0] | (vs[1] << 16); uw.w = vs[2] | (vs[3] << 16);
                const bf16x8_t uv = __builtin_bit_cast(bf16x8_t, uw);
#pragma unroll
                for (int kt = 0; kt < 4; ++kt) St[kt] = __builtin_amdgcn_mfma_f32_16x16x32_bf16(bk[kt], uv, St[kt] * gl[kt], 0, 0, 0);
                asm volatile("s_waitcnt lgkmcnt(0)" ::: "memory");
                if (lane == 0) DONE[0] = (unsigned)(c + 1);
            }
        }
    }
    __syncthreads();
}

typedef float f32x16 __attribute__((ext_vector_type(16)));
constexpr int AT_K = 0, AT_V = 36864;
__device__ __forceinline__ bf16x8_t tr_frag(unsigned addr) {
    v2u lo, hi; asm volatile("ds_read_b64_tr_b16 %0, %2\n\tds_read_b64_tr_b16 %1, %2 offset:1536\n\ts_waitcnt lgkmcnt(0)" : "=&v"(lo), "=&v"(hi) : "v"(addr) : "memory");
    v4u w; w.x = lo.x; w.y = lo.y; w.z = hi.x; w.w = hi.y; return __builtin_bit_cast(bf16x8_t, w);
}
__device__ __forceinline__ void attn_unit(const Args& a, int li, int au, LAS unsigned char* ldsb, int tid) {
    unsigned char* ws = a.ws; const bf16* Z = (const bf16*)(ws + WS_ACT); bf16* O = (bf16*)(ws + WS_O);
    const int n = au & 127, kvh = (au >> 7) & 3, b = au >> 9;
    const size_t rblk = (size_t)b * T + (size_t)n * 128;
    for (int e = tid; e < 256 * 8 * 2; e += NTHR) { const int which = e >> 11, rem = e & 2047, j = rem >> 3, c8 = rem & 7; const bool valid = (n > 0) || (j >= 128);
        v4u w = {0u, 0u, 0u, 0u}; if (valid) w = *(const GAS v4u*)(Z + (rblk + j - 128) * ZN + 1024 + which * 256 + kvh * 64 + 8 * c8);
        *(LAS v4u*)(ldsb + (which ? AT_V + j * 192 : AT_K + j * 144) + c8 * 16) = w; }
    __syncthreads();
    const int lane = tid & 63, wave = tid >> 6, l31 = lane & 31, h = lane >> 5;
    const unsigned ldsbase = (unsigned)(size_t)ldsb;
#pragma unroll 1
    for (int it = 0; it < 2; ++it) {
        const int tt = 2 * wave + it, g = tt >> 2, qi = tt & 3, hq = kvh * 4 + g; const size_t qrow = rblk + 32 * qi + l31;
        bf16x8_t qf[4];
#pragma unroll
        for (int ks = 0; ks < 4; ++ks) qf[ks] = *(const GAS bf16x8_t*)(Z + qrow * ZN + hq * 64 + 16 * ks + 8 * h);
        f32x16 st[5];
#pragma unroll
        for (int kt = 0; kt < 5; ++kt) {
#pragma unroll
            for (int r = 0; r < 16; ++r) st[kt][r] = 0.f;
#pragma unroll
            for (int ks = 0; ks < 4; ++ks) { const bf16x8_t kf = *(const LAS bf16x8_t*)(ldsb + AT_K + (32 * (qi + kt) + l31) * 144 + (16 * ks + 8 * h) * 2);
                st[kt] = __builtin_amdgcn_mfma_f32_32x32x16_bf16(kf, qf[ks], st[kt], 0, 0, 0); } }
        const float slope = exp2f(-0.5f * (float)(hq + 1)); const float sink = a.in[I_ESINK][li * 16 + hq];
        float mx = sink;
#pragma unroll
        for (int kt = 0; kt < 5; ++kt)
#pragma unroll
            for (int r = 0; r < 16; ++r) { const int j = 32 * (qi + kt) + (r & 3) + 8 * (r >> 2) + 4 * h; const int dist = 32 * qi + l31 + 128 - j;
                const bool ok = (dist >= 0) && (dist < 128) && ((n > 0) || (j >= 128));
                const float s = ok ? st[kt][r] * 0.125f - slope * (float)dist : -INFINITY; st[kt][r] = s; mx = fmaxf(mx, s); }
        mx = fmaxf(mx, __shfl_xor(mx, 32));
        float l = 0.f;
#pragma unroll
        for (int kt = 0; kt < 5; ++kt)
#pragma unroll
            for (int r = 0; r < 16; ++r) { const float p = __expf(st[kt][r] - mx); st[kt][r] = p; l += p; }
        l += __shfl_xor(l, 32); l += __expf(sink - mx);
        f32x16 ot[2];
#pragma unroll
        for (int r = 0; r < 16; ++r) { ot[0][r] = 0.f; ot[1][r] = 0.f; }
#pragma unroll
        for (int kt = 0; kt < 5; ++kt)
#pragma unroll
            for (int s2 = 0; s2 < 2; ++s2) {
                v4u pw; pw.x = pk2(st[kt][8 * s2 + 0], st[kt][8 * s2 + 1]); pw.y = pk2(st[kt][8 * s2 + 2], st[kt][8 * s2 + 3]); pw.z = pk2(st[kt][8 * s2 + 4], st[kt][8 * s2 + 5]); pw.w = pk2(st[kt][8 * s2 + 6], st[kt][8 * s2 + 7]);
                const bf16x8_t pf = __builtin_bit_cast(bf16x8_t, pw);
#pragma unroll
                for (int db = 0; db < 2; ++db) {
                    const unsigned va = ldsbase + AT_V + (unsigned)(32 * (qi + kt) + 16 * s2 + 4 * h + ((lane & 15) >> 2)) * 192u + (unsigned)(32 * db + 16 * ((lane >> 4) & 1) + 4 * (lane & 3)) * 2u;
                    const bf16x8_t vf = tr_frag(va);
                    ot[db] = __builtin_amdgcn_mfma_f32_32x32x16_bf16(vf, pf, ot[db], 0, 0, 0); } }
        const float inv = 1.0f / l;
#pragma unroll
        for (int db = 0; db < 2; ++db)
#pragma unroll
            for (int g4 = 0; g4 < 4; ++g4)
                *(GAS v2u*)(O + qrow * D + 1024 + hq * 64 + 32 * db + 8 * g4 + 4 * h) = pack4(ot[db][4 * g4] * inv, ot[db][4 * g4 + 1] * inv, ot[db][4 * g4 + 2] * inv, ot[db][4 * g4 + 3] * inv);
    }
    __syncthreads();
}

__device__ __forceinline__ void e3_phase(const Args& a, int li, int vcu, int G, int tid) {
    unsigned char* ws = a.ws; const float* Y = (const float*)(ws + WS_XB);
    const bf16* R = (const bf16*)(ws + SC_R); const bf16* K2 = (const bf16*)(ws + SC_K2); const bf16* GG = (const bf16*)(ws + SC_GG); const bf16* V = (const bf16*)(ws + (li ? WS_V2 : WS_VF));
    bf16* O = (bf16*)(ws + WS_O);
    const float* rk = a.in[I_ERK] + li * 1024; const float* gng = a.in[I_EGNG] + li * 1024; const float* gnb = a.in[I_EGNB] + li * 1024;
    for (size_t e4 = (size_t)vcu * NTHR + tid; e4 < (size_t)M * 256; e4 += (size_t)G * NTHR) {
        const size_t row = e4 >> 8; const int c = (int)(e4 & 255) * 4; const size_t e = row * 1024 + c;
        const f32x4 y = *(const GAS f32x4*)(Y + e);
        const v2u rw = *(const GAS v2u*)(R + e), kw = *(const GAS v2u*)(K2 + e), vw = *(const GAS v2u*)(V + e), gw = *(const GAS v2u*)(GG + e);
        const f32x4 rkv = *(const f32x4*)(rk + c), ggv = *(const f32x4*)(gng + c), gbv = *(const f32x4*)(gnb + c);
        const float mean = row16_sum((y.x + y.y) + (y.z + y.w)) * (1.0f / 64.0f);
        const f32x4 d = y - mean;
        const float var = row16_sum((d.x * d.x + d.y * d.y) + (d.z * d.z + d.w * d.w)) * (1.0f / 64.0f);
        const float rs = rsqrtf(var + 64e-5f);
        const float r0 = bflo(rw.x), r1 = bfhi(rw.x), r2 = bflo(rw.y), r3 = bfhi(rw.y), k0 = bflo(kw.x), k1 = bfhi(kw.x), k2 = bflo(kw.y), k3 = bfhi(kw.y);
        const float bonus = row16_sum((r0 * k0 * rkv.x + r1 * k1 * rkv.y) + (r2 * k2 * rkv.z + r3 * k3 * rkv.w));
        const float o0 = (d.x * rs * ggv.x + gbv.x + bonus * bflo(vw.x)) * bflo(gw.x), o1 = (d.y * rs * ggv.y + gbv.y + bonus * bfhi(vw.x)) * bfhi(gw.x);
        const float o2 = (d.z * rs * ggv.z + gbv.z + bonus * bflo(vw.y)) * bflo(gw.y), o3 = (d.w * rs * ggv.w + gbv.w + bonus * bfhi(vw.y)) * bfhi(gw.y);
        *(GAS v2u*)(O + row * D + c) = pack4(o0, o1, o2, o3);
    }
}

constexpr int SG_W = 0, SG_V = 34816;
__device__ __forceinline__ unsigned sg_off(unsigned row, unsigned ch) { return 256u * row + 16u * (ch ^ (((row & 3u) << 2) | ((row >> 2) & 3u))); }
__device__ __forceinline__ bf16x8_t tr_frag2(unsigned a0, unsigned a1) {
    v2u lo, hi; asm volatile("ds_read_b64_tr_b16 %0, %2\n\tds_read_b64_tr_b16 %1, %3\n\ts_waitcnt lgkmcnt(0)" : "=&v"(lo), "=&v"(hi) : "v"(a0), "v"(a1) : "memory");
    v4u w; w.x = lo.x; w.y = lo.y; w.z = hi.x; w.w = hi.y; return __builtin_bit_cast(bf16x8_t, w);
}
__device__ __forceinline__ void sgu_phase(const Args& a, int li, LAS unsigned char* ldsb, int vcu, int G, int tid) {
    unsigned char* ws = a.ws; const bf16* Z = (const bf16*)(ws + WS_ACT); bf16* O = (bf16*)(ws + WS_O);
    const float* ssv = (const float*)(ws + WS_SS) + (size_t)(13 + li) * SS_REC;
    const bf16* WSB = (const bf16*)(ws + SM_WSB); const float* bs = a.in[I_OBS] + li * 16 * 128; const float* vng = a.in[I_OVNG] + li * D;
    const int lane = tid & 63, wave = tid >> 6, fr = lane & 15, fq = lane >> 4;
    const unsigned ldsbase = (unsigned)(size_t)ldsb;
    int gcur = -1;
    for (int u = vcu; u < 4096; u += G) {
        const int g = u & 15, bn = u >> 4; const size_t m0 = (size_t)bn * 128;
        __syncthreads();
        if (g != gcur) { gcur = g;
            for (int e = tid; e < 128 * 16; e += NTHR) { const int i = e >> 4, ch = e & 15; *(LAS v4u*)(ldsb + SG_W + i * 272 + ch * 16) = *(const GAS v4u*)(WSB + ((size_t)g * 128 + i) * 128 + 8 * ch); } }
        for (int e = tid; e < 128 * 16; e += NTHR) { const int j = e >> 4, ch = e & 15; const float rs = pg8::row_rs(ssv, (int)(m0 + j));
            const v4u w = *(const GAS v4u*)(Z + (m0 + j) * ZO + 2048 + g * 128 + 8 * ch); v4u o;
            o.x = pk2(bflo(w.x) * rs, bfhi(w.x) * rs); o.y = pk2(bflo(w.y) * rs, bfhi(w.y) * rs); o.z = pk2(bflo(w.z) * rs, bfhi(w.z) * rs); o.w = pk2(bflo(w.w) * rs, bfhi(w.w) * rs);
            *(LAS v4u*)(ldsb + SG_V + sg_off((unsigned)j, (unsigned)ch)) = o; }
        __syncthreads();
        bf16x8_t vf[4];
        { const unsigned q = (unsigned)(lane & 15) >> 2, p = (unsigned)lane & 3u;
#pragma unroll
          for (int ks = 0; ks < 4; ++ks) { const unsigned r0 = 32u * ks + 8u * fq + q;
              vf[ks] = tr_frag2(ldsbase + SG_V + sg_off(r0, 2u * wave + (p >> 1)) + 8u * (p & 1u), ldsbase + SG_V + sg_off(r0 + 4u, 2u * wave + (p >> 1)) + 8u * (p & 1u)); } }
        const int cc = g * 128 + 16 * wave + 4 * fq; const f32x4 vg = *(const f32x4*)(vng + cc);
#pragma unroll
        for (int mt = 0; mt < 8; ++mt) {
            f32x4 acc = {0.f, 0.f, 0.f, 0.f};
#pragma unroll
            for (int ks = 0; ks <= (mt >> 1); ++ks) { const bf16x8_t wf = *(const LAS bf16x8_t*)(ldsb + SG_W + (16 * mt + fr) * 272 + (32 * ks + 8 * fq) * 2);
                acc = __builtin_amdgcn_mfma_f32_16x16x32_bf16(vf[ks], wf, acc, 0, 0, 0); }
            const int i = 16 * mt + fr; const float bi = bs[g * 128 + i];
            const v2u uw = *(const GAS v2u*)(Z + (m0 + i) * ZO + cc);
            *(GAS v2u*)(O + (m0 + i) * D + cc) = pack4(bflo(uw.x) * (vg.x * acc[0] + bi), bfhi(uw.x) * (vg.y * acc[1] + bi), bflo(uw.y) * (vg.z * acc[2] + bi), bfhi(uw.y) * (vg.w * acc[3] + bi));
        }
    }
    __syncthreads();
}

__device__ __forceinline__ void final_phase(const Args& a, int vcu, int G, int wave, int lane) {
    const int gw = vcu * NWAVES + wave, NGW = G * NWAVES; const float* ss = (const float*)(a.ws + WS_SS) + (size_t)12 * SS_REC; const float* fg = a.in[I_FG];
    for (int m = gw; m < M; m += NGW) { const float rs = pg8::row_rs(ss, m);
        GAS f32x4* xr = (GAS f32x4*)(a.out + (size_t)m * D) + lane; const GAS f32x4* gr = (const GAS f32x4*)fg + lane;
#pragma unroll
        for (int j = 0; j < 8; ++j) { const f32x4 v = xr[64 * j], gg = gr[64 * j]; xr[64 * j] = v * rs * gg; } }
}

__global__ void __launch_bounds__(NTHR, 2) mk_fwd(Args args) {
    extern __shared__ __attribute__((aligned(16))) unsigned char lds_raw[];
    LAS unsigned char* lds = (LAS unsigned char*)lds_raw;
    const int tid = threadIdx.x, lane = tid & 63, wave = __builtin_amdgcn_readfirstlane(tid >> 6);
    const int G = gridDim.x, bx = blockIdx.x; const int vcu = (G % 8 == 0) ? (bx % 8) * (G / 8) + bx / 8 : bx;
    unsigned char* ws = args.ws; gu32* ctl = (gu32*)(ws + WS_CTL);
    for (int u = tid; u < (LDS_BYTES - LDSCTL_OFF) / 4; u += NTHR) ((LAS unsigned*)(lds + LDSCTL_OFF))[u] = 0u;
    __syncthreads();
    const int lo = args.ph_lo, hi = args.ph_hi;
    const bool multi = (hi - lo) > 1;
    XcdBarrier bar; bar.bar = (unsigned*)(ctl + CW_BAR); bar.x = 0; bar.st = nullptr;
    if (multi) bar = xcd_barrier_post((unsigned*)(ctl + CW_BAR), (volatile LAS unsigned*)(lds + LDSCTL_OFF));
#define IN(k) (lo <= (k) && (k) < hi)
#define SEAM(k) do { if ((k) + 1 < hi) xcd_barrier(bar); } while (0)
#ifndef DUP_G
#define DUP_G 1
#endif
#ifndef DUP_T
#define DUP_T 1
#endif
#ifndef DUP_PREP
#define DUP_PREP DUP_T
#endif
#ifndef DUP_E1
#define DUP_E1 DUP_T
#endif
#ifndef DUP_SGU
#define DUP_SGU DUP_T
#endif
#ifndef DUP_E3
#define DUP_E3 DUP_T
#endif
#define REPN(n) for (int rep_ = 0; rep_ < (n); ++rep_)
#ifndef DUP_S
#define DUP_S 1
#endif
#define REPG for (int rep_ = 0; rep_ < DUP_G; ++rep_)
#define REPT for (int rep_ = 0; rep_ < DUP_T; ++rep_)
#define REPS for (int rep_ = 0; rep_ < DUP_S; ++rep_)
#define RSEAM(n) do { if (rep_ + 1 < (n)) xcd_barrier(bar); } while (0)
    float* ssb = (float*)(ws + WS_SS);
    bf16* XB = (bf16*)(ws + WS_XB); bf16* ACT = (bf16*)(ws + WS_ACT); bf16* OB = (bf16*)(ws + WS_O);

    for (int s = 0; s < NSUB; ++s) {
        const int pb = s * 8, L = s / 3, kind = s % 3, li = L >> 1; const bool even = !(L & 1);
        #ifndef NO_PREP
        if (kind == 0 && IN(pb + 0)) { REPN(DUP_PREP) { const int t_ = opaque(tid); prep_phase(args, L, lds, vcu, G, __builtin_amdgcn_readfirstlane(t_ >> 6), t_ & 63); RSEAM(DUP_PREP); } SEAM(pb + 0); }
#endif
        if (IN(pb + 1)) {
            const float* ss = ssb + (size_t)s * SS_REC;
            if (kind != 1) {
                pg8::Gemm g{XB, (const bf16*)(ws + (kind == 0 ? WT_GU1 : WT_GU2)), M, 2 * FF, D}; pg8::StaticOrder S; S.init(M, 2 * FF, G, bx);
                pg8::EpiSwiGLU E{ACT, FF, ss};
#ifndef NO_G1
                REPG { pg8::gemm_phase<pg8::EpiSwiGLU, pg8::StaticOrder, true, true>(lds, g, S, E); RSEAM(DUP_G); }
#endif
            } else if (even) {
                pg8::Gemm g{XB, (const bf16*)(ws + WT_IN), M, ZN, D}; pg8::StaticOrder S; S.init(M, ZN, G, bx);
                pg8::EpiZ E{ACT, ZN, ss, args.in[I_EBQKV] + li * 1536};
#ifndef NO_GZ
                REPG { pg8::gemm_phase<pg8::EpiZ, pg8::StaticOrder, true, true>(lds, g, S, E); RSEAM(DUP_G); }
#endif
            } else {
                pg8::Gemm g{XB, (const bf16*)(ws + WT_IN), M, ZO, D}; pg8::StaticOrder S; S.init(M, ZO, G, bx);
                pg8::EpiGeluV E{ACT, ZO, ss, ssb + (size_t)(13 + li) * SS_REC, (LAS float*)(lds + 131072)};
#ifndef NO_GG
                REPG { pg8::gemm_phase<pg8::EpiGeluV, pg8::StaticOrder, true, true>(lds, g, S, E); RSEAM(DUP_G); }
#endif
            }
            SEAM(pb + 1);
        }
        if (kind == 1) {
            if (IN(pb + 2)) {
#ifndef NO_E1
                if (even) REPN(DUP_E1) { e1_phase(args, li, lds, vcu, G, opaque(tid)); RSEAM(DUP_E1); }
#endif
#ifndef NO_ATTN
                if (even) for (int au = vcu; au < 1024; au += G) attn_unit(args, li, au, lds, opaque(tid));
#endif
#ifndef NO_SGU
                if (!even) REPN(DUP_SGU) { sgu_phase(args, li, lds, vcu, G, opaque(tid)); RSEAM(DUP_SGU); }
#endif
                SEAM(pb + 2); }
#ifndef NO_SPRE
            if (even && IN(pb + 3)) { REPS { scanpre_phase(args, li, lds, vcu, G, opaque(tid)); RSEAM(DUP_S); } SEAM(pb + 3); }
#endif
#ifndef NO_SSEQ
            if (even && IN(pb + 4)) { REPS { scanseq_phase(args, li, lds, vcu, opaque(tid)); RSEAM(DUP_S); } SEAM(pb + 4); }
#endif
#ifndef NO_E3
            if (even && IN(pb + 5)) { REPN(DUP_E3) { e3_phase(args, li, vcu, G, opaque(tid)); RSEAM(DUP_E3); } SEAM(pb + 5); }
#endif
        }
        if (IN(pb + 6)) {
            const bf16* A = (kind == 1) ? OB : ACT; const int K = (kind == 1) ? D : FF;
            const bf16* Bt = (const bf16*)(ws + (kind == 0 ? WT_D1 : kind == 1 ? WT_OUT : WT_D2));
            pg8::Gemm g{A, Bt, M, D, K}; pg8::StaticOrder S; S.init(M, D, G, bx);
            pg8::EpiResid E{s == 0 ? args.in[I_X] : args.out, args.out, XB, ssb + (size_t)(s + 1) * SS_REC, kind == 1 ? 1.0f : 0.5f, (LAS float*)(lds + 131072)};
#ifndef NO_GR
            REPG { if (rep_) { E.base = args.out; E.scale = 0.f; } pg8::gemm_phase<pg8::EpiResid, pg8::StaticOrder, true, true>(lds, g, S, E); RSEAM(DUP_G); }
#endif
            SEAM(pb + 6);
        }
    }
    if (IN(NSUB * 8)) { const int t_ = opaque(tid); final_phase(args, vcu, G, __builtin_amdgcn_readfirstlane(t_ >> 6), t_ & 63); }
#undef IN
#undef SEAM
}

extern "C" void kernel_launch(void* const* d_in, const int* in_sizes, int n_in, void* d_out, int out_size, void* d_ws, size_t ws_size, hipStream_t stream) {
    static int grid = 0;
    if (grid == 0) {
        if (n_in != 29 || out_size != M * D || ws_size < WS_END) { fprintf(stderr, "kernel_launch: unexpected shapes (n_in %d, out %d, ws %zu < %zu); nothing launched\n", n_in, out_size, ws_size, (size_t)WS_END); grid = -1; return; }
        int dev = 0, cus = 0;
        if (hipGetDevice(&dev) != hipSuccess || hipDeviceGetAttribute(&cus, hipDeviceAttributeMultiprocessorCount, dev) != hipSuccess) { grid = -1; return; }
        if (hipFuncSetAttribute((const void*)mk_fwd, hipFuncAttributeMaxDynamicSharedMemorySize, LDS_BYTES) != hipSuccess) { fprintf(stderr, "kernel_launch: hipFuncSetAttribute failed\n"); grid = -1; return; }
        int per_cu = 0;
        if (hipOccupancyMaxActiveBlocksPerMultiprocessor(&per_cu, (const void*)mk_fwd, NTHR, LDS_BYTES) != hipSuccess || per_cu < 1) fprintf(stderr, "kernel_launch: occupancy query says %d\n", per_cu);
        (void)hipGetLastError();
        grid = cus;
    }
    if (grid < 0) return;
    (void)hipMemsetAsync((char*)d_ws + WS_CTL, 0, CTL_ZERO_BYTES, stream);
    Args a{};
    for (int i = 0; i < 29; ++i) a.in[i] = (const float*)d_in[i];
    a.out = (float*)d_out; a.ws = (unsigned char*)d_ws;
#if MK_ONE_LAUNCH
    a.ph_lo = 0; a.ph_hi = NSUB * 8 + 1;
    hipLaunchKernelGGL(mk_fwd, dim3(grid), dim3(NTHR), LDS_BYTES, stream, a);
#else
    for (int s = 0; s <= NSUB; ++s) {
        for (int k = 0; k < (s == NSUB ? 1 : 8); ++k) {
            const int L = s / 3, kind = s % 3; const bool even = !(L & 1);
            bool live;
            if (s == NSUB) live = true;
            else if (k == 0) live = (kind == 0);
            else if (k == 1 || k == 6) live = true;
            else if (k == 2) live = (kind == 1);
            else if (k == 3 || k == 4 || k == 5) live = (kind == 1) && even;
            else live = false;
            if (!live) continue;
            a.ph_lo = s * 8 + k; a.ph_hi = a.ph_lo + 1;
            hipLaunchKernelGGL(mk_fwd, dim3(grid), dim3(NTHR), LDS_BYTES, stream, a);
        }
    }
#endif
}
```

```cpp
#include <hip/hip_runtime.h>
#include <cstdio>
#include <cstdint>
#define MK_ONE_LAUNCH 1
namespace pg8 {
#define PG8_LAS __attribute__((address_space(3)))
typedef unsigned short bf16_t;
typedef short bf16x8 __attribute__((ext_vector_type(8)));
typedef float f32x4 __attribute__((ext_vector_type(4)));
typedef unsigned u32x4 __attribute__((ext_vector_type(4)));
constexpr int BM = 256, BK = 64, HALF = 128, HTB = HALF * BK * 2  , STAGE_BYTES = 8 * HTB, NXCD = 8, WGM = 8;

__host__ __device__ __forceinline__ int lds_byte(int r, int c) { const int st = (r >> 4) * 2 + (c >> 5), rr = r & 15, cc = c & 31, ob = rr * 64 + cc * 2; return st * 1024 + (ob ^ (((ob >> 9) & 1) << 5)); }
__host__ __device__ __forceinline__ void stage_rc(int b, int& R, int& C) { const int st = b / 1024, sb = b % 1024, swz = sb ^ (((sb >> 9) & 1) << 5); R = (st >> 1) * 16 + swz / 64; C = (st & 1) * 32 + (swz % 64) / 2; }
__host__ __device__ __forceinline__ int perm32(int rho) { const int n = rho >> 4, i = rho & 15; return 8 * (i >> 2) + 4 * n + (i & 3); }

struct Unit { int pm, pn; };
struct Gemm { const bf16_t* A; const bf16_t* Bt; int M, N, K; };

struct StaticOrder {
    int nM, nN, nwg, G, c;
    __host__ __device__ void init(int M, int N, int G_, int c_) { nM = M / BM; nN = N / BM; nwg = nM * nN; G = G_; c = c_; }
    __host__ __device__ bool next(int i, Unit& u) const {
        const long L = (long)i * G + c; if (L >= nwg) return false;
        int wgid = (int)L; { const int q = nwg / NXCD, r = nwg % NXCD, xcd = wgid % NXCD, off = wgid / NXCD; wgid = (xcd < r ? xcd * (q + 1) : r * (q + 1) + (xcd - r) * q) + off; }
        const int nig = WGM * nN, gid = wgid / nig, fm = gid * WGM, gsz = (nM - fm) < WGM ? (nM - fm) : WGM;
        u.pm = fm + ((wgid % nig) % gsz); u.pn = (wgid % nig) / gsz; return true;
    }
    __device__ __forceinline__ void a_ready(const Unit&) const {}
    __device__ __forceinline__ void done(const Unit&) const {}
};
__device__ __forceinline__ unsigned cvt_pk_bf16(float lo, float hi) { unsigned r; asm volatile("v_cvt_pk_bf16_f32 %0, %1, %2" : "=v"(r) : "v"(lo), "v"(hi)); return r; }
typedef float f32x2 __attribute__((ext_vector_type(2)));
__device__ __forceinline__ f32x2 gelu_pk(f32x2 v) {
    const f32x2 av = __builtin_elementwise_abs(v), d = av * 0.2316418882f + 1.0f;
    f32x2 t; t.x = __builtin_amdgcn_rcpf(d.x); t.y = __builtin_amdgcn_rcpf(d.y);
    f32x2 q = t * 0.5307027145f + (-0.7265760135f); q = q * t + 0.7107068705f; q = q * t + (-0.142248368f); q = q * t + 0.127414796f; q = q * t;
    const f32x2 s = (v * v) * (-0.72134752044f);
    f32x2 e; e.x = __builtin_amdgcn_exp2f(s.x); e.y = __builtin_amdgcn_exp2f(s.y);
    const f32x2 m = v * (q * e), r = v - m;
    f32x2 o; o.x = v.x < 0.f ? m.x : r.x; o.y = v.y < 0.f ? m.y : r.y; return o;
}

constexpr int SS_M = 32768;
__device__ __forceinline__ float row_rs(const float* P, int row) {
    const float s = ((P[row] + P[SS_M + row]) + (P[2 * SS_M + row] + P[3 * SS_M + row])) + ((P[4 * SS_M + row] + P[5 * SS_M + row]) + (P[6 * SS_M + row] + P[7 * SS_M + row]));
    return rsqrtf(s * (1.0f / 2048.0f) + 1e-6f);
}
struct EpiSwiGLU {
    static constexpr bool PERM = true, AFTER_DRAIN = false;
    bf16_t* O; int ldc; const float* ss;
    __device__ __forceinline__ void operator()(const f32x4 (&acc)[2][2][4][2], const Unit& u, int wr, int wc, int fr, int fq) const {
        const int row0 = u.pm * BM + wr * 64 + fr, col0 = u.pn * HALF + wc * 32 + 8 * fq;
#pragma unroll
        for (int ai = 0; ai < 2; ++ai)
#pragma unroll
            for (int m = 0; m < 4; ++m) {
                const int row = row0 + ai * HALF + m * 16;
                const float rs = row_rs(ss, row);
                float o[8];
#pragma unroll
                for (int n = 0; n < 2; ++n)
#pragma unroll
                    for (int j = 0; j < 4; ++j) { const float g = acc[ai][0][m][n][j] * rs, up = acc[ai][1][m][n][j] * rs; o[4 * n + j] = g * __builtin_amdgcn_rcpf(1.0f + __expf(-g)) * up; }
                u32x4 w; w.x = cvt_pk_bf16(o[0], o[1]); w.y = cvt_pk_bf16(o[2], o[3]); w.z = cvt_pk_bf16(o[4], o[5]); w.w = cvt_pk_bf16(o[6], o[7]);
                *(u32x4*)(O + (size_t)row * ldc + col0) = w;
                asm volatile("" ::: "memory");
            }
    }
};
struct EpiResid {
    static constexpr bool PERM = false, AFTER_DRAIN = false;
    const float* base; float* out; bf16_t* xb; float* ssn; float scale; PG8_LAS float* sp;
    __device__ __forceinline__ void operator()(const f32x4 (&acc)[2][2][4][2], const Unit& u, int wr, int wc, int fr, int fq) const {
        const int row0 = u.pm * BM + wr * 64 + fr, col0 = u.pn * BM + wc * 32 + 4 * fq;
        typedef unsigned u32x2v __attribute__((ext_vector_type(2)));
#pragma unroll
        for (int ai = 0; ai < 2; ++ai)
#pragma unroll
            for (int m = 0; m < 4; ++m) {
                const int row = row0 + ai * HALF + m * 16; const size_t off = (size_t)row * 2048 + col0; float s = 0.f;
#pragma unroll
                for (int bj = 0; bj < 2; ++bj)
#pragma unroll
                    for (int n = 0; n < 2; ++n) {
                        const f32x4 bs = *(const f32x4*)(base + off + bj * HALF + n * 16);
                        const f32x4 o = bs + acc[ai][bj][m][n] * scale;
                        *(f32x4*)(out + off + bj * HALF + n * 16) = o;
                        u32x2v w; w.x = cvt_pk_bf16(o[0], o[1]); w.y = cvt_pk_bf16(o[2], o[3]);
                        *(u32x2v*)(xb + off + bj * HALF + n * 16) = w;
                        s += (o[0] * o[0] + o[1] * o[1]) + (o[2] * o[2] + o[3] * o[3]);
                    }
                s += __shfl_xor(s, 16); s += __shfl_xor(s, 32);
                if (fq == 0) sp[(ai * HALF + wr * 64 + m * 16 + fr) * 4 + wc] = s;
                asm volatile("" ::: "memory");
            }
        asm volatile("s_waitcnt lgkmcnt(0)" ::: "memory"); __builtin_amdgcn_s_barrier(); asm volatile("" ::: "memory");
        const int t = (wr * 4 + wc) * 64 + fq * 16 + fr;
        if (t < BM) { const f32x4 p = *(const PG8_LAS f32x4*)(sp + t * 4); ssn[(size_t)u.pn * SS_M + u.pm * BM + t] = (p[0] + p[1]) + (p[2] + p[3]); }
    }
};
struct EpiZ {
    static constexpr bool PERM = true, AFTER_DRAIN = false;
    bf16_t* O; int ldc; const float* ss; const float* bias;
    __device__ __forceinline__ void operator()(const f32x4 (&acc)[2][2][4][2], const Unit& u, int wr, int wc, int fr, int fq) const {
        const int row0 = u.pm * BM + wr * 64 + fr, col0 = u.pn * BM + wc * 32 + 8 * fq;
        const bool hb = u.pn < 6;
        f32x4 bv[2][2];
#pragma unroll
        for (int bj = 0; bj < 2; ++bj)
#pragma unroll
            for (int n = 0; n < 2; ++n) bv[bj][n] = hb ? *(const f32x4*)(bias + col0 + bj * HALF + 4 * n) : (f32x4){0.f, 0.f, 0.f, 0.f};
#pragma unroll
        for (int ai = 0; ai < 2; ++ai)
#pragma unroll
            for (int m = 0; m < 4; ++m) {
                const int row = row0 + ai * HALF + m * 16;
                const float rs = row_rs(ss, row);
                bf16_t* rowp = O + (size_t)row * ldc + col0;
#pragma unroll
                for (int bj = 0; bj < 2; ++bj) {
                    const f32x4 v0 = acc[ai][bj][m][0] * rs + bv[bj][0], v1 = acc[ai][bj][m][1] * rs + bv[bj][1];
                    u32x4 w; w.x = cvt_pk_bf16(v0[0], v0[1]); w.y = cvt_pk_bf16(v0[2], v0[3]); w.z = cvt_pk_bf16(v1[0], v1[1]); w.w = cvt_pk_bf16(v1[2], v1[3]);
                    *(u32x4*)(rowp + bj * HALF) = w;
                }
                asm volatile("" ::: "memory");
            }
    }
};
struct EpiGeluV {
    static constexpr bool PERM = true, AFTER_DRAIN = false;
    bf16_t* O; int ldc; const float* ss; float* ssv; PG8_LAS float* sp;
    __device__ __forceinline__ void operator()(const f32x4 (&acc)[2][2][4][2], const Unit& u, int wr, int wc, int fr, int fq) const {
        const int row0 = u.pm * BM + wr * 64 + fr, col0 = u.pn * BM + wc * 32 + 8 * fq;
        const bool isv = u.pn >= 8;
#pragma unroll
        for (int ai = 0; ai < 2; ++ai)
#pragma unroll
            for (int m = 0; m < 4; ++m) {
                const int row = row0 + ai * HALF + m * 16;
                const float rs = row_rs(ss, row);
                bf16_t* rowp = O + (size_t)row * ldc + col0; float s = 0.f;
#pragma unroll
                for (int bj = 0; bj < 2; ++bj) {
                    f32x4 v0 = acc[ai][bj][m][0] * rs, v1 = acc[ai][bj][m][1] * rs;
                    const f32x2 a = gelu_pk((f32x2){v0[0], v0[1]}), b = gelu_pk((f32x2){v0[2], v0[3]}), c = gelu_pk((f32x2){v1[0], v1[1]}), d = gelu_pk((f32x2){v1[2], v1[3]});
                    s += (a.x * a.x + a.y * a.y) + (b.x * b.x + b.y * b.y) + (c.x * c.x + c.y * c.y) + (d.x * d.x + d.y * d.y);
                    u32x4 w; w.x = cvt_pk_bf16(a.x, a.y); w.y = cvt_pk_bf16(b.x, b.y); w.z = cvt_pk_bf16(c.x, c.y); w.w = cvt_pk_bf16(d.x, d.y);
                    *(u32x4*)(rowp + bj * HALF) = w;
                }
                if (isv) { s += __shfl_xor(s, 16); s += __shfl_xor(s, 32); if (fq == 0) sp[(ai * HALF + wr * 64 + m * 16 + fr) * 4 + wc] = s; }
                asm volatile("" ::: "memory");
            }
        if (isv) {
            asm volatile("s_waitcnt lgkmcnt(0)" ::: "memory"); __builtin_amdgcn_s_barrier(); asm volatile("" ::: "memory");
            const int t = (wr * 4 + wc) * 64 + fq * 16 + fr;
            if (t < BM) { const f32x4 p = *(const PG8_LAS f32x4*)(sp + t * 4); ssv[(size_t)(u.pn - 8) * SS_M + u.pm * BM + t] = (p[0] + p[1]) + (p[2] + p[3]); }
        }
    }
};
template <class Epi, class Sched, bool ALIGN_EPI = false, bool SP2 = false>
__device__ __forceinline__ void gemm_phase(PG8_LAS unsigned char* lds, const Gemm g, const Sched& S, const Epi& E) {
    int tid_ = threadIdx.x; asm volatile("" : "+v"(tid_));
    const int tid = tid_, wid = __builtin_amdgcn_readfirstlane(tid >> 6), lane = tid & 63, wr = wid >> 2, wc = wid & 3, fr = lane & 15, fq = lane >> 4;
    const int K = g.K, nt = K / BK;
    unsigned voffA[2], voffB[2];
#pragma unroll
    for (int i = 0; i < 2; ++i) { int R, C; stage_rc(tid * 16 + i * 8192, R, C); const int Rb = Epi::PERM ? ((R & ~31) + perm32(R & 31)) : R;
        voffA[i] = (unsigned)(R * K + C) * 2u; voffB[i] = (unsigned)(Rb * K + C) * 2u; }
    const size_t kstep = (size_t)(BK * 2);
    const size_t hstep = (size_t)HALF * K * 2;
    const size_t tstep = 2 * hstep;
    const unsigned ldsw = (unsigned)wid * 1024u;
    const int aoff = lds_byte(wr * 64 + fr, fq * 8), boff = lds_byte(wc * 32 + fr, fq * 8);
#define PG8_SA(b, h) (((b) * 2 + (h)) * HTB)
#define PG8_SB(b, h) ((4 + (b) * 2 + (h)) * HTB)
#define PG8_STAGE(bufoff, gbase, voff) do { _Pragma("unroll") for (int _i = 0; _i < 2; ++_i) \
        __builtin_amdgcn_global_load_lds((const unsigned*)((const char*)(gbase) + (voff)[_i]), (PG8_LAS unsigned*)(lds + (bufoff) + ldsw + _i * 8192), 16, 0, 0); } while (0)
#define PG8_LDA(dst, b, h) do { _Pragma("unroll") for (int m = 0; m < 4; ++m) _Pragma("unroll") for (int k = 0; k < 2; ++k) dst[m][k] = *(const PG8_LAS bf16x8*)(lds + PG8_SA(b, h) + aoff + m * 2048 + k * 1024); } while (0)
#define PG8_LDB(dst, b, h) do { _Pragma("unroll") for (int n = 0; n < 2; ++n) _Pragma("unroll") for (int k = 0; k < 2; ++k) dst[n][k] = *(const PG8_LAS bf16x8*)(lds + PG8_SB(b, h) + boff + n * 2048 + k * 1024); } while (0)
#define PG8_MMA(ai, bj, At, Bt) do { __builtin_amdgcn_s_setprio(1); _Pragma("unroll") for (int m = 0; m < 4; ++m) _Pragma("unroll") for (int n = 0; n < 2; ++n) _Pragma("unroll") for (int k = 0; k < 2; ++k) \
        acc[ai][bj][m][n] = __builtin_amdgcn_mfma_f32_16x16x32_bf16(Bt[n][k], At[m][k], acc[ai][bj][m][n], 0, 0, 0); __builtin_amdgcn_s_setprio(0); } while (0)
#define PG8_WAIT_V(n) asm volatile("s_waitcnt vmcnt(" #n ")" ::: "memory")
#define PG8_WAIT_L(n) asm volatile("s_waitcnt lgkmcnt(" #n ")" ::: "memory")
#define PG8_BAR __builtin_amdgcn_s_barrier()
#define PG8_SCHED __builtin_amdgcn_sched_barrier(0)
    Unit cur, nxt; int ui = 0;
    if (!S.next(0, cur)) return;
    f32x4 acc[2][2][4][2];
#pragma unroll
    for (int a = 0; a < 2; ++a)
#pragma unroll
        for (int b = 0; b < 2; ++b)
#pragma unroll
            for (int m = 0; m < 4; ++m)
#pragma unroll
                for (int n = 0; n < 2; ++n) acc[a][b][m][n] = (f32x4){0.f, 0.f, 0.f, 0.f};
    bf16x8 At[4][2], B0[2][2], B1[2][2];
    const char* cA = (const char*)g.A + (size_t)cur.pm * tstep; const char* cB = (const char*)g.Bt + (size_t)cur.pn * tstep;
    S.a_ready(cur);
    if constexpr (SP2) {
        PG8_STAGE(PG8_SB(0, 0), cB, voffB); PG8_STAGE(PG8_SB(0, 1), cB + hstep, voffB); PG8_STAGE(PG8_SA(0, 0), cA, voffA); PG8_STAGE(PG8_SA(0, 1), cA + hstep, voffA);
        if (wr == 1) PG8_BAR;
        PG8_WAIT_V(2); PG8_BAR;
        PG8_STAGE(PG8_SB(1, 0), cB + kstep, voffB); PG8_STAGE(PG8_SA(1, 0), cA + kstep, voffA); PG8_STAGE(PG8_SB(1, 1), cB + hstep + kstep, voffB);
        PG8_WAIT_V(6); PG8_BAR;
    } else {
        PG8_STAGE(PG8_SB(0, 0), cB, voffB); PG8_STAGE(PG8_SA(0, 0), cA, voffA); PG8_STAGE(PG8_SB(0, 1), cB + hstep, voffB); PG8_STAGE(PG8_SA(0, 1), cA + hstep, voffA);
        if (wr == 1) PG8_BAR;
        PG8_WAIT_V(4); PG8_BAR;
        PG8_STAGE(PG8_SB(1, 0), cB + kstep, voffB); PG8_STAGE(PG8_SA(1, 0), cA + kstep, voffA); PG8_STAGE(PG8_SB(1, 1), cB + hstep + kstep, voffB);
        PG8_WAIT_V(6); PG8_BAR;
    }
    for (;;) {
        const bool has_next = S.next(ui + 1, nxt);
        const char* nA = has_next ? (const char*)g.A + (size_t)nxt.pm * tstep : cA; const char* nB = has_next ? (const char*)g.Bt + (size_t)nxt.pn * tstep : cB;
        for (int t = 0; t < nt; t += 2) {
            const bool last = (t == nt - 2);
            const char* a1 = cA + (size_t)(t + 1) * kstep;
            const char* a2 = last ? nA : cA + (size_t)(t + 2) * kstep; const char* b2 = last ? nB : cB + (size_t)(t + 2) * kstep;
            const char* a3 = a2 + kstep; const char* b3 = b2 + kstep;
            if (last && has_next) S.a_ready(nxt);
            if constexpr (SP2) {
            PG8_LDB(B0, 0, 0); PG8_LDB(B1, 0, 1); PG8_SCHED; PG8_LDA(At, 0, 0); PG8_STAGE(PG8_SA(1, 1), a1 + hstep, voffA);
            PG8_WAIT_V(8); PG8_WAIT_L(0); PG8_BAR; PG8_MMA(0, 0, At, B0); PG8_MMA(0, 1, At, B1); PG8_BAR; PG8_SCHED;
            PG8_LDA(At, 0, 1); PG8_STAGE(PG8_SB(0, 0), b2, voffB); PG8_STAGE(PG8_SB(0, 1), b2 + hstep, voffB); PG8_STAGE(PG8_SA(0, 0), a2, voffA);
            PG8_WAIT_V(8); PG8_WAIT_L(0); PG8_BAR; PG8_MMA(1, 0, At, B0); PG8_MMA(1, 1, At, B1); PG8_BAR; PG8_SCHED;
            PG8_LDB(B0, 1, 0); PG8_LDB(B1, 1, 1); PG8_SCHED; PG8_LDA(At, 1, 0); PG8_STAGE(PG8_SA(0, 1), a2 + hstep, voffA);
            PG8_WAIT_V(8); PG8_WAIT_L(0); PG8_BAR; PG8_MMA(0, 0, At, B0); PG8_MMA(0, 1, At, B1); PG8_BAR; PG8_SCHED;
            PG8_LDA(At, 1, 1); PG8_STAGE(PG8_SB(1, 0), b3, voffB); PG8_STAGE(PG8_SB(1, 1), b3 + hstep, voffB); PG8_STAGE(PG8_SA(1, 0), a3, voffA);
            PG8_WAIT_V(8); PG8_WAIT_L(0); PG8_BAR; PG8_MMA(1, 0, At, B0); PG8_MMA(1, 1, At, B1); PG8_BAR; PG8_SCHED;
            } else {
            PG8_LDB(B0, 0, 0); PG8_SCHED; PG8_LDA(At, 0, 0); PG8_STAGE(PG8_SA(1, 1), a1 + hstep, voffA);
            PG8_WAIT_L(8); PG8_BAR; PG8_WAIT_L(0); PG8_MMA(0, 0, At, B0); PG8_BAR; PG8_SCHED;
            PG8_LDB(B1, 0, 1); PG8_STAGE(PG8_SB(0, 0), b2, voffB);
            PG8_BAR; PG8_WAIT_L(0); PG8_MMA(0, 1, At, B1); PG8_BAR;
            PG8_LDA(At, 0, 1); PG8_STAGE(PG8_SA(0, 0), a2, voffA);
            PG8_BAR; PG8_WAIT_L(0); PG8_MMA(1, 0, At, B0); PG8_BAR; PG8_SCHED;
            PG8_STAGE(PG8_SB(0, 1), b2 + hstep, voffB);
            PG8_WAIT_V(6); PG8_BAR; PG8_MMA(1, 1, At, B1); PG8_BAR;
            PG8_LDB(B0, 1, 0); PG8_SCHED; PG8_LDA(At, 1, 0); PG8_STAGE(PG8_SA(0, 1), a2 + hstep, voffA);
            PG8_WAIT_L(8); PG8_BAR; PG8_WAIT_L(0); PG8_MMA(0, 0, At, B0); PG8_BAR; PG8_SCHED;
            PG8_LDB(B1, 1, 1); PG8_STAGE(PG8_SB(1, 0), b3, voffB);
            PG8_BAR; PG8_WAIT_L(0); PG8_MMA(0, 1, At, B1); PG8_BAR;
            PG8_LDA(At, 1, 1); PG8_STAGE(PG8_SA(1, 0), a3, voffA);
            PG8_BAR; PG8_WAIT_L(0); PG8_MMA(1, 0, At, B0); PG8_BAR; PG8_SCHED;
            PG8_STAGE(PG8_SB(1, 1), b3 + hstep, voffB);
            PG8_WAIT_V(6); PG8_BAR; PG8_MMA(1, 1, At, B1); PG8_BAR;
            }
        }
        if constexpr (ALIGN_EPI) { if (wr == 0) PG8_BAR; }
        if constexpr (!Epi::AFTER_DRAIN) { E(acc, cur, wr, wc, fr, fq); S.done(cur); }
        if (!has_next) break;
#pragma unroll
        for (int a = 0; a < 2; ++a)
#pragma unroll
            for (int b = 0; b < 2; ++b)
#pragma unroll
                for (int m = 0; m < 4; ++m)
#pragma unroll
                    for (int n = 0; n < 2; ++n) acc[a][b][m][n] = (f32x4){0.f, 0.f, 0.f, 0.f};
        cur = nxt; cA = nA; cB = nB; ++ui;
        if constexpr (ALIGN_EPI) { if (wr == 1) PG8_BAR; }
    }
    PG8_WAIT_V(0);
    if constexpr (!ALIGN_EPI) { if (wr == 0) PG8_BAR; }
    PG8_BAR;
    if constexpr (Epi::AFTER_DRAIN) { E.fused(acc, cur, wr, wc, fr, fq, lds, wid, lane); S.done(cur); }
#undef PG8_SA
#undef PG8_SB
#undef PG8_STAGE
#undef PG8_LDA
#undef PG8_LDB
#undef PG8_MMA
#undef PG8_WAIT_V
#undef PG8_WAIT_L
#undef PG8_BAR
#undef PG8_SCHED
}
}
#define LAS_BAR __attribute__((address_space(3)))
#define XB_TMO      128
#define XB_XCNT(j)  (256  + 64 * (j))
#define XB_XSUB(j)  (1280 + 64 * (j))
#define XB_XGEN(j)  (2304 + 64 * (j))
#define XB_TOP      3328
#define XB_TOPGEN   3392
#define XCD_BAR_WORDS 3456
#define XB_SPIN_CAP (1u << 22)

__device__ __forceinline__ unsigned xb_ld(unsigned* p)              { return __hip_atomic_load(p, __ATOMIC_RELAXED, __HIP_MEMORY_SCOPE_AGENT); }
__device__ __forceinline__ unsigned xb_add(unsigned* p, unsigned v) { return __hip_atomic_fetch_add(p, v, __ATOMIC_RELAXED, __HIP_MEMORY_SCOPE_AGENT); }
__device__ __forceinline__ unsigned xb_xcc_id() { return (unsigned)__builtin_amdgcn_s_getreg((3 << 11) | 20) & 0xFu; }
#define XB_SPIN(cond, bar) do { unsigned _sp = 0; while (cond) { __builtin_amdgcn_s_sleep(1); \
    if ((++_sp & 255u) == 0u) { if (xb_ld(&(bar)[XB_TMO])) break; if (_sp > XB_SPIN_CAP) { atomicAdd(&(bar)[XB_TMO], 1u); break; } } } } while (0)

struct XcdBarrier {
    unsigned* bar; unsigned x;
    volatile LAS_BAR unsigned* st;
};

__device__ __forceinline__ XcdBarrier xcd_barrier_post(unsigned* bar, volatile LAS_BAR unsigned* st) {
    XcdBarrier b; b.bar = bar; b.x = xb_xcc_id(); b.st = st;
    if (threadIdx.x == 0) (void)xb_add(&bar[XB_XCNT(b.x)], 1u);
    return b;
}
__device__ __forceinline__ void xcd_barrier_complete(unsigned* bar, unsigned x, unsigned& nloc, unsigned& nx) {
    const unsigned G = gridDim.x * gridDim.y * gridDim.z;
    unsigned sum, cnt, mine, sp = 0u;
    for (;;) {
        sum = 0u; cnt = 0u; mine = 0u;
#pragma unroll
        for (unsigned j = 0; j < 16; ++j) { const unsigned c = xb_ld(&bar[XB_XCNT(j)]); sum += c; cnt += (c > 0u) ? 1u : 0u; mine = (j == x) ? c : mine; }
        if (sum == G) break;
        __builtin_amdgcn_s_sleep(1);
        if ((++sp & 255u) == 0u) { if (xb_ld(&bar[XB_TMO])) break; if (sp > XB_SPIN_CAP) { atomicAdd(&bar[XB_TMO], 1u); break; } }
    }
    nloc = mine > 0u ? mine : 1u; nx = cnt > 0u ? cnt : 1u;
}

__device__ __forceinline__ void xcd_barrier(const XcdBarrier& b) {
    asm volatile("s_waitcnt vmcnt(0)" ::: "memory");
    __syncthreads();
    if (threadIdx.x == 0) {
        unsigned* bar = b.bar;
        __builtin_amdgcn_s_waitcnt(0);
        unsigned nloc = b.st[0], nx = b.st[1];
        if (nloc == 0u) { xcd_barrier_complete(bar, b.x, nloc, nx); b.st[0] = nloc; b.st[1] = nx; }
        const unsigned old = xb_add(&bar[XB_XSUB(b.x)], 1u);
        const unsigned gen = old / nloc;
        if (old + 1u == (gen + 1u) * nloc) {
            __builtin_amdgcn_fence(__ATOMIC_RELEASE, "agent");
            asm volatile("s_waitcnt vmcnt(0)" ::: "memory");
            const unsigned og = xb_add(&bar[XB_TOP], 1u);
            const unsigned tg = og / nx;
            if (og + 1u == (tg + 1u) * nx) xb_add(&bar[XB_TOPGEN], 1u);
            else XB_SPIN(xb_ld(&bar[XB_TOPGEN]) == tg, bar);
            __builtin_amdgcn_fence(__ATOMIC_ACQUIRE, "agent");
            xb_add(&bar[XB_XGEN(b.x)], 1u);
            asm volatile("s_waitcnt vmcnt(0)" ::: "memory");
        } else {
            XB_SPIN(xb_ld(&bar[XB_XGEN(b.x)]) == gen, bar);
            __builtin_amdgcn_fence(__ATOMIC_ACQUIRE, "agent");
            asm volatile("s_waitcnt vmcnt(0)" ::: "memory");
        }
    }
    __syncthreads();
}

constexpr int NWAVES = 8, NTHR = 512;
constexpr int BATCH = 2, T = 16384, D = 2048, FF = 5632, M = BATCH * T;
constexpr int ZN = 5120;
constexpr int ZA = 1536;
constexpr int A_COLS = 3360, E_IN = 4896;
constexpr int ZO = 4096;
constexpr int NSUB = 12;
#ifndef MK_ONE_LAUNCH
#define MK_ONE_LAUNCH 0
#endif

constexpr size_t MiB = 1u << 20;
constexpr size_t WS_CTL = 0, CTL_ZERO_BYTES = 1 * MiB;
constexpr size_t WS_SS = 1 * MiB;
constexpr size_t SS_REC = 8 * (size_t)M;
constexpr size_t WS_WT = 16 * MiB;
constexpr size_t WT_GU1 = WS_WT, WT_D1 = WT_GU1 + 44 * MiB, WT_GU2 = WT_D1 + 22 * MiB, WT_D2 = WT_GU2 + 44 * MiB, WT_IN = WT_D2 + 22 * MiB, WT_OUT = WT_IN + 20 * MiB;
constexpr size_t WS_XB = WT_OUT + 8 * MiB;
constexpr size_t WS_ACT = WS_XB + 128 * MiB;
constexpr size_t WS_SC = WS_ACT + 352 * MiB;
constexpr size_t SC_R = WS_SC, SC_K2 = SC_R + 64 * MiB, SC_KK = SC_K2 + 64 * MiB, SC_BB = SC_KK + 64 * MiB, SC_LW = SC_BB + 64 * MiB, SC_GG = SC_LW + 64 * MiB;
constexpr size_t WS_VF = SC_GG + 64 * MiB;
constexpr size_t WS_V2 = WS_VF + 64 * MiB;
constexpr size_t WS_O = WS_V2 + 64 * MiB;
constexpr size_t WS_SM = WS_O + 128 * MiB;
constexpr size_t SM_W2T = WS_SM, SM_A2T = SM_W2T + 131072, SM_G2T = SM_A2T + 131072, SM_V1T = SM_G2T + 327680, SM_V2T = SM_V1T + 65536, SM_WSB = SM_V2T + 65536;
constexpr size_t WS_U0 = WS_SM + 2 * MiB;
constexpr size_t WS_END = WS_U0 + 64 * MiB;
static_assert(SM_WSB + 524288 <= WS_END, "small-weight map");
static_assert(WT_OUT + 8 * MiB == 176 * MiB && WS_SS + 15 * MiB <= WS_WT, "weight map");
constexpr int CW_TMO = 0, CW_CODE = 1, CW_BAR = 4096;

constexpr int LDS_BYTES = 147456, LDSCTL_OFF = LDS_BYTES - 512;

#define GAS __attribute__((address_space(1)))
#define LAS __attribute__((address_space(3)))
typedef unsigned short bf16;
typedef unsigned v4u __attribute__((ext_vector_type(4)));
typedef unsigned v2u __attribute__((ext_vector_type(2)));
typedef float f32x4 __attribute__((ext_vector_type(4)));
typedef float f32x2 __attribute__((ext_vector_type(2)));
typedef GAS unsigned gu32;
#define RLX_AGENT __ATOMIC_RELAXED, __HIP_MEMORY_SCOPE_AGENT
#define LDS_WAIT() asm volatile("s_waitcnt lgkmcnt(0)" ::: "memory")
__device__ __forceinline__ unsigned f2bf(float f) { unsigned u = __builtin_bit_cast(unsigned, f); return (u + 0x7fffu + ((u >> 16) & 1u)) >> 16; }
typedef __bf16 bf16x2_hw __attribute__((ext_vector_type(2)));
__device__ __forceinline__ unsigned pk2(float lo, float hi) { const bf16x2_hw b = __builtin_convertvector((f32x2){lo, hi}, bf16x2_hw); return __builtin_bit_cast(unsigned, b); }
__device__ __forceinline__ float bf2f(bf16 b) { return __builtin_bit_cast(float, (unsigned)b << 16); }
__device__ __forceinline__ float bflo(unsigned w) { return __builtin_bit_cast(float, w << 16); }
__device__ __forceinline__ float bfhi(unsigned w) { return __builtin_bit_cast(float, w & 0xffff0000u); }
__device__ __forceinline__ float wave_sum(float v) {
#pragma unroll
    for (int o = 1; o < 64; o <<= 1) v += __shfl_xor(v, o);
    return v;
}
template <int CTRL> __device__ __forceinline__ float dpp_mov(float v) { return __builtin_bit_cast(float, __builtin_amdgcn_update_dpp(0, __builtin_bit_cast(int, v), CTRL, 0xf, 0xf, true)); }
__device__ __forceinline__ float row16_sum(float v) { v += dpp_mov<0xB1>(v); v += dpp_mov<0x4E>(v); v += dpp_mov<0x141>(v); v += dpp_mov<0x140>(v); return v; }
__device__ __forceinline__ float sigmoidf_(float x) { return 1.0f / (1.0f + __expf(-x)); }

__device__ __forceinline__ int opaque(int v) { asm volatile("" : "+v"(v)); return v; }
struct Args { const float* in[29]; float* out; unsigned char* ws; int ph_lo, ph_hi; };
static_assert(sizeof(Args) == 29 * 8 + 8 + 8 + 8, "Args has no padding");
enum { I_X = 0, I_NG, I_WG, I_WU, I_WD, I_EWIN, I_EBQKV, I_EMU, I_EW0, I_EW2, I_EA0, I_EA2, I_EG2, I_EKK, I_EKA, I_ERK, I_EGNG, I_EGNB, I_ESINK, I_EWOUT, I_V0, I_V1, I_V2, I_OWIN, I_OVNG, I_OWS, I_OBS, I_OWOUT, I_FG };

struct TrDesc { const float* W; const float* gk; bf16* WT; int ldw, k0, c0, K, drow0; bool zero; };
__device__ __forceinline__ void tr_load(const TrDesc& d, float (&v)[32], int lane) {
#pragma unroll
    for (int i = 0; i < 32; ++i) { const int kk = 2 * i + (lane >> 5); v[i] = d.zero ? 0.f : d.W[(size_t)(d.k0 + kk) * d.ldw + d.c0 + (lane & 31)]; }
}
__device__ __forceinline__ void tr_store(const TrDesc& d, const float (&v)[32], LAS float* scr, int lane) {
#pragma unroll
    for (int i = 0; i < 32; ++i) { const int kk = 2 * i + (lane >> 5); float x = v[i]; if (d.gk) x *= d.gk[d.k0 + kk]; scr[kk * 33 + (lane & 31)] = x; }
    LDS_WAIT(); asm volatile("" ::: "memory");
    const int c = lane & 7;
#pragma unroll
    for (int j = 0; j < 4; ++j) { const int n = (lane >> 3) + 8 * j; const LAS float* s = scr + (8 * c) * 33 + n;
        v4u o; o.x = pk2(s[0 * 33], s[1 * 33]); o.y = pk2(s[2 * 33], s[3 * 33]); o.z = pk2(s[4 * 33], s[5 * 33]); o.w = pk2(s[6 * 33], s[7 * 33]);
        *(GAS v4u*)(d.WT + (size_t)(d.drow0 + n) * d.K + d.k0 + 8 * c) = o; }
    LDS_WAIT(); asm volatile("" ::: "memory");
}
__device__ __forceinline__ TrDesc tr_desc(const Args& a, int L, int it) {
    unsigned char* ws = a.ws; const bool even = !(L & 1); const int li = L >> 1;
    constexpr int nGU = 32 * 352, nD = 88 * 64; const int nIN = 32 * (even ? 160 : 128);
    TrDesc d; d.zero = false; int r = it;
    if (r < 2 * nGU) { const int f = r / nGU; r -= f * nGU; const int kb = r / 352, rb = r % 352, tj = rb >> 3, sub = rb & 7;
        d.W = (sub < 4 ? a.in[I_WG] : a.in[I_WU]) + (size_t)(L * 2 + f) * D * FF; d.ldw = FF; d.k0 = 64 * kb; d.c0 = 128 * tj + 32 * (sub & 3); d.gk = a.in[I_NG] + (L * 3 + (f ? 2 : 0)) * D;
        d.WT = (bf16*)(ws + (f ? WT_GU2 : WT_GU1)); d.K = D; d.drow0 = 32 * rb; return d; }
    r -= 2 * nGU;
    if (r < 2 * nD) { const int f = r / nD; r -= f * nD; const int kb = r / 64, nb = r % 64;
        d.W = a.in[I_WD] + (size_t)(L * 2 + f) * FF * D; d.ldw = D; d.k0 = 64 * kb; d.c0 = 32 * nb; d.gk = nullptr; d.WT = (bf16*)(ws + (f ? WT_D2 : WT_D1)); d.K = FF; d.drow0 = 32 * nb; return d; }
    r -= 2 * nD;
    if (r < nIN) {
        d.gk = a.in[I_NG] + (L * 3 + 1) * D; d.WT = (bf16*)(ws + WT_IN); d.K = D;
        if (even) { const int kb = r / 160, rb = r % 160, dd = 32 * rb; d.zero = dd >= E_IN; d.W = a.in[I_EWIN] + (size_t)li * D * E_IN; d.ldw = E_IN; d.k0 = 64 * kb; d.c0 = d.zero ? 0 : (dd < ZA ? A_COLS + dd : dd - ZA); d.drow0 = dd; }
        else { const int kb = r / 128, rb = r % 128; d.W = a.in[I_OWIN] + (size_t)li * D * ZO; d.ldw = ZO; d.k0 = 64 * kb; d.c0 = 32 * rb; d.drow0 = 32 * rb; }
        return d; }
    r -= nIN;
    { const int kb = r / 64, nb = r % 64; d.W = (even ? a.in[I_EWOUT] : a.in[I_OWOUT]) + (size_t)li * D * D; d.ldw = D; d.k0 = 64 * kb; d.c0 = 32 * nb; d.gk = nullptr; d.WT = (bf16*)(ws + WT_OUT); d.K = D; d.drow0 = 32 * nb; }
    return d;
}
__device__ __forceinline__ void prep_phase(const Args& a, int L, LAS unsigned char* lds, int vcu, int G, int wave, int lane) {
    asm volatile("" : "+s"(G));
    LAS float* scr = (LAS float*)(lds + wave * 16384);
    const int gw = vcu * NWAVES + wave, NGW = G * NWAVES;
    unsigned char* ws = a.ws;
    const bool even = !(L & 1); const int li = L >> 1;
    const int total = 2 * (32 * 352) + 2 * (88 * 64) + 32 * (even ? 160 : 128) + 32 * 64;
    if (gw < total) {
        TrDesc d0 = tr_desc(a, L, gw); float v0[32]; tr_load(d0, v0, lane);
        for (int it = gw; it < total; it += NGW) {
            const int itn = it + NGW; const bool hasn = itn < total;
            TrDesc d1 = tr_desc(a, L, hasn ? itn : it); float v1[32];
            if (hasn) tr_load(d1, v1, lane);
            tr_store(d0, v0, scr, lane);
            d0 = d1;
#pragma unroll
            for (int i = 0; i < 32; ++i) v0[i] = v1[i];
        }
    }
    {
        const int gt = gw * 64 + lane, NGT = NGW * 64;
        if (even) {
            const float* w2 = a.in[I_EW2] + (size_t)li * 64 * 1024; const float* a2 = a.in[I_EA2] + (size_t)li * 64 * 1024; const float* g2 = a.in[I_EG2] + (size_t)li * 160 * 1024;
            bf16* W2T = (bf16*)(ws + SM_W2T); bf16* A2T = (bf16*)(ws + SM_A2T); bf16* G2T = (bf16*)(ws + SM_G2T);
            for (int e = gt; e < 1024 * 64; e += NGT) { const int k = e >> 10, c = e & 1023; W2T[c * 64 + k] = (bf16)f2bf(w2[e]); A2T[c * 64 + k] = (bf16)f2bf(a2[e]); }
            for (int e = gt; e < 1024 * 160; e += NGT) { const int k = e >> 10, c = e & 1023; G2T[c * 160 + k] = (bf16)f2bf(g2[e]); }
            if (li > 0) { bf16* V1T = (bf16*)(ws + SM_V1T); bf16* V2T = (bf16*)(ws + SM_V2T);
                for (int e = gt; e < 1024 * 32; e += NGT) { const int c = e >> 5, j = e & 31; V1T[j * 1024 + c] = (bf16)f2bf(a.in[I_V1][e]); }
                for (int e = gt; e < 32 * 1024; e += NGT) { const int j = e >> 10, c = e & 1023; V2T[c * 32 + j] = (bf16)f2bf(a.in[I_V2][e]); } }
        } else {
            const float* wsg = a.in[I_OWS] + (size_t)li * 16 * 128 * 128; bf16* WSB = (bf16*)(ws + SM_WSB);
            for (int e = gt; e < 16 * 128 * 128; e += NGT) { const int i = (e >> 7) & 127, j = e & 127; WSB[e] = (bf16)f2bf(j <= i ? wsg[e] : 0.f); }
        }
    }
    if (L == 0) {
        float* ss0 = (float*)(ws + WS_SS); bf16* XB = (bf16*)(ws + WS_XB);
        for (int m = gw; m < M; m += NGW) {
            const GAS f32x4* xr = (const GAS f32x4*)(a.in[I_X] + (size_t)m * D) + lane; GAS v2u* o = (GAS v2u*)(XB + (size_t)m * D) + lane; float s = 0.f;
#pragma unroll
            for (int j = 0; j < 8; ++j) { const f32x4 v = xr[64 * j]; s += (v.x * v.x + v.y * v.y) + (v.z * v.z + v.w * v.w); v2u w; w.x = pk2(v.x, v.y); w.y = pk2(v.z, v.w); o[64 * j] = w; }
            s = wave_sum(s); if (lane < 8) ss0[(size_t)lane * M + m] = lane ? 0.f : s;
        }
    }
}

typedef short bf16x8_t __attribute__((ext_vector_type(8)));
__device__ __forceinline__ float fast_tanh(float x) { const float e = __expf(2.0f * x); return 1.0f - 2.0f / (1.0f + e); }
__device__ __forceinline__ void lerp8(const v4u c, const v4u p, const float* mu, float (&o)[8]) {
    const f32x4 m0 = *(const f32x4*)mu, m1 = *(const f32x4*)(mu + 4);
    const float c0 = bflo(c.x), c1 = bfhi(c.x), c2 = bflo(c.y), c3 = bfhi(c.y), c4 = bflo(c.z), c5 = bfhi(c.z), c6 = bflo(c.w), c7 = bfhi(c.w);
    o[0] = c0 + (bflo(p.x) - c0) * m0.x; o[1] = c1 + (bfhi(p.x) - c1) * m0.y; o[2] = c2 + (bflo(p.y) - c2) * m0.z; o[3] = c3 + (bfhi(p.y) - c3) * m0.w;
    o[4] = c4 + (bflo(p.z) - c4) * m1.x; o[5] = c5 + (bfhi(p.z) - c5) * m1.y; o[6] = c6 + (bflo(p.w) - c6) * m1.z; o[7] = c7 + (bfhi(p.w) - c7) * m1.w;
}
__device__ __forceinline__ void lerp4(const v2u c, const v2u p, const f32x4 m, float (&o)[4]) {
    const float c0 = bflo(c.x), c1 = bfhi(c.x), c2 = bflo(c.y), c3 = bfhi(c.y);
    o[0] = c0 + (bflo(p.x) - c0) * m.x; o[1] = c1 + (bfhi(p.x) - c1) * m.y; o[2] = c2 + (bflo(p.y) - c2) * m.z; o[3] = c3 + (bfhi(p.y) - c3) * m.w;
}
__device__ __forceinline__ v2u pack4(float a, float b, float c, float d) { v2u w; w.x = pk2(a, b); w.y = pk2(c, d); return w; }
constexpr int E1_AW = 0, E1_AA = 9216, E1_AG = 18432, E1_PP = 40960, E1_PB = 106496;
__device__ __forceinline__ void e1_phase(const Args& a, int li, LAS unsigned char* ldsb, int vcu, int G, int tid) {
    unsigned char* ws = a.ws;
    const bf16* Z = (const bf16*)(ws + WS_ACT);
    bf16* R = (bf16*)(ws + SC_R); bf16* K2 = (bf16*)(ws + SC_K2); bf16* KK = (bf16*)(ws + SC_KK); bf16* BB = (bf16*)(ws + SC_BB); bf16* LW = (bf16*)(ws + SC_LW); bf16* GG = (bf16*)(ws + SC_GG);
    bf16* VO = (bf16*)(ws + (li ? WS_V2 : WS_VF)); const bf16* VF = (const bf16*)(ws + WS_VF);
    const bf16* W2T = (const bf16*)(ws + SM_W2T); const bf16* A2T = (const bf16*)(ws + SM_A2T); const bf16* G2T = (const bf16*)(ws + SM_G2T);
    const bf16* V1T = (const bf16*)(ws + SM_V1T); const bf16* V2T = (const bf16*)(ws + SM_V2T);
    const float* mu = a.in[I_EMU] + li * A_COLS;
    const float* w0 = a.in[I_EW0] + li * 1024; const float* a0 = a.in[I_EA0] + li * 1024;
    const float* kkw = a.in[I_EKK] + li * 1024; const float* kaw = a.in[I_EKA] + li * 1024; const float* v0w = a.in[I_V0];
    const int lane = tid & 63, wave = tid >> 6, fr = lane & 15, fq = lane >> 4;
    for (int unit = vcu; unit < M / 64; unit += G) {
        const int m0 = unit * 64;
        for (int e = tid; e < 64 * 36; e += NTHR) { const int r = e / 36, ch = e % 36, j0 = 8 * ch, m = m0 + r; const bool first = (m & (T - 1)) == 0;
            const v4u cur = *(const GAS v4u*)(Z + (size_t)m * ZN + ZA + 3072 + j0); v4u prv = {0u, 0u, 0u, 0u}; if (!first) prv = *(const GAS v4u*)(Z + (size_t)(m - 1) * ZN + ZA + 3072 + j0);
            float x[8]; lerp8(cur, prv, mu + 3072 + j0, x);
            if (j0 < 64) {
#pragma unroll
                for (int i = 0; i < 8; ++i) x[i] = fast_tanh(x[i]);
            } else if (j0 >= 128) {
#pragma unroll
                for (int i = 0; i < 8; ++i) x[i] = sigmoidf_(x[i]);
            }
            v4u o; o.x = pk2(x[0], x[1]); o.y = pk2(x[2], x[3]); o.z = pk2(x[4], x[5]); o.w = pk2(x[6], x[7]);
            LAS unsigned char* dst = j0 < 64 ? ldsb + E1_AW + r * 144 + j0 * 2 : j0 < 128 ? ldsb + E1_AA + r * 144 + (j0 - 64) * 2 : ldsb + E1_AG + r * 336 + (j0 - 128) * 2;
            *(LAS v4u*)dst = o; }
        if (li > 0) {
            f32x4 pacc[4][2];
#pragma unroll
            for (int mt = 0; mt < 4; ++mt) { pacc[mt][0] = (f32x4){0.f, 0.f, 0.f, 0.f}; pacc[mt][1] = pacc[mt][0]; }
            for (int ks = 0; ks < 4; ++ks) { const int c = 128 * wave + 32 * ks + 8 * fq;
                const bf16x8_t w0f = *(const GAS bf16x8_t*)(V1T + (size_t)fr * 1024 + c), w1f = *(const GAS bf16x8_t*)(V1T + (size_t)(16 + fr) * 1024 + c);
#pragma unroll
                for (int mt = 0; mt < 4; ++mt) { const int m = m0 + 16 * mt + fr; const bool first = (m & (T - 1)) == 0;
                    const v4u cur = *(const GAS v4u*)(Z + (size_t)m * ZN + ZA + 2048 + c); v4u prv = {0u, 0u, 0u, 0u}; if (!first) prv = *(const GAS v4u*)(Z + (size_t)(m - 1) * ZN + ZA + 2048 + c);
                    float x[8]; lerp8(cur, prv, mu + 2048 + c, x);
                    v4u o; o.x = pk2(x[0], x[1]); o.y = pk2(x[2], x[3]); o.z = pk2(x[4], x[5]); o.w = pk2(x[6], x[7]);
                    const bf16x8_t af = __builtin_bit_cast(bf16x8_t, o);
                    pacc[mt][0] = __builtin_amdgcn_mfma_f32_16x16x32_bf16(w0f, af, pacc[mt][0], 0, 0, 0); pacc[mt][1] = __builtin_amdgcn_mfma_f32_16x16x32_bf16(w1f, af, pacc[mt][1], 0, 0, 0); } }
#pragma unroll
            for (int mt = 0; mt < 4; ++mt)
#pragma unroll
                for (int nt = 0; nt < 2; ++nt) *(LAS f32x4*)(ldsb + E1_PP + ((wave * 64 + 16 * mt + fr) * 32 + 16 * nt + 4 * fq) * 4) = pacc[mt][nt];
        }
        __syncthreads();
        if (li > 0) {
            for (int e = tid; e < 64 * 32; e += NTHR) { float sum = 0.f;
#pragma unroll
                for (int w = 0; w < 8; ++w) sum += *(const LAS float*)(ldsb + E1_PP + (w * 2048 + e) * 4);
                *(LAS bf16*)(ldsb + E1_PB + (e >> 5) * 80 + (e & 31) * 2) = (bf16)f2bf(sum); }
            __syncthreads();
        }
#pragma unroll 1
        for (int hh = 0; hh < 2; ++hh) {
            const int cb = 128 * wave + 64 * hh;
            {
                bf16x8_t wa[4][2];
#pragma unroll
                for (int nt = 0; nt < 4; ++nt)
#pragma unroll
                    for (int ks = 0; ks < 2; ++ks) wa[nt][ks] = *(const GAS bf16x8_t*)(A2T + (size_t)(cb + 16 * nt + fr) * 64 + 32 * ks + 8 * fq);
#pragma unroll 1
                for (int mt = 0; mt < 4; ++mt) {
                    const int m = m0 + 16 * mt + fr; const bool first = (m & (T - 1)) == 0;
                    f32x4 aa[4];
#pragma unroll
                    for (int nt = 0; nt < 4; ++nt) aa[nt] = (f32x4){0.f, 0.f, 0.f, 0.f};
#pragma unroll
                    for (int ks = 0; ks < 2; ++ks) { const bf16x8_t fa = *(const LAS bf16x8_t*)(ldsb + E1_AA + (16 * mt + fr) * 144 + (32 * ks + 8 * fq) * 2);
#pragma unroll
                        for (int nt = 0; nt < 4; ++nt) aa[nt] = __builtin_amdgcn_mfma_f32_16x16x32_bf16(wa[nt][ks], fa, aa[nt], 0, 0, 0); }
                    const size_t zo = (size_t)m * ZN + ZA + cb + 4 * fq;
                    float k1[4][4], av[4][4], kk0[4][4]; float n2 = 0.f;
#pragma unroll
                    for (int nt = 0; nt < 4; ++nt) { const int c = cb + 16 * nt + 4 * fq;
                        const v2u cur = *(const GAS v2u*)(Z + zo + 1024 + 16 * nt); v2u prv = {0u, 0u}; if (!first) prv = *(const GAS v2u*)(Z + zo - ZN + 1024 + 16 * nt);
                        lerp4(cur, prv, *(const f32x4*)(mu + 1024 + c), k1[nt]);
                        const f32x4 a0v = *(const f32x4*)(a0 + c), kkv = *(const f32x4*)(kkw + c);
#pragma unroll
                        for (int j = 0; j < 4; ++j) { av[nt][j] = sigmoidf_(a0v[j] + aa[nt][j]); kk0[nt][j] = k1[nt][j] * kkv[j]; n2 += kk0[nt][j] * kk0[nt][j]; } }
                    n2 += __shfl_xor(n2, 16); n2 += __shfl_xor(n2, 32);
                    const float inv = 1.0f / fmaxf(sqrtf(n2), 1e-12f);
#pragma unroll
                    for (int nt = 0; nt < 4; ++nt) { const int c = cb + 16 * nt + 4 * fq; const size_t o = (size_t)m * 1024 + c; const f32x4 kav = *(const f32x4*)(kaw + c);
                        float kk[4], k2[4], bb[4];
#pragma unroll
                        for (int j = 0; j < 4; ++j) { kk[j] = kk0[nt][j] * inv; k2[j] = k1[nt][j] * (1.0f + (av[nt][j] - 1.0f) * kav[j]); bb[j] = kk[j] * av[nt][j]; }
                        *(GAS v2u*)(KK + o) = pack4(kk[0], kk[1], kk[2], kk[3]); *(GAS v2u*)(K2 + o) = pack4(k2[0], k2[1], k2[2], k2[3]); *(GAS v2u*)(BB + o) = pack4(bb[0], bb[1], bb[2], bb[3]); }
                }
            }
            {
                bf16x8_t ww[4][2];
#pragma unroll
                for (int nt = 0; nt < 4; ++nt)
#pragma unroll
                    for (int ks = 0; ks < 2; ++ks) ww[nt][ks] = *(const GAS bf16x8_t*)(W2T + (size_t)(cb + 16 * nt + fr) * 64 + 32 * ks + 8 * fq);
#pragma unroll 1
                for (int mt = 0; mt < 4; ++mt) {
                    const int m = m0 + 16 * mt + fr;
                    f32x4 aw[4];
#pragma unroll
                    for (int nt = 0; nt < 4; ++nt) aw[nt] = (f32x4){0.f, 0.f, 0.f, 0.f};
#pragma unroll
                    for (int ks = 0; ks < 2; ++ks) { const bf16x8_t fw = *(const LAS bf16x8_t*)(ldsb + E1_AW + (16 * mt + fr) * 144 + (32 * ks + 8 * fq) * 2);
#pragma unroll
                        for (int nt = 0; nt < 4; ++nt) aw[nt] = __builtin_amdgcn_mfma_f32_16x16x32_bf16(ww[nt][ks], fw, aw[nt], 0, 0, 0); }
#pragma unroll
                    for (int nt = 0; nt < 4; ++nt) { const int c = cb + 16 * nt + 4 * fq; const f32x4 w0v = *(const f32x4*)(w0 + c); float lw[4];
#pragma unroll
                        for (int j = 0; j < 4; ++j) { const float y = -(w0v[j] + aw[nt][j]); const float sp = fmaxf(y, 0.f) + __logf(1.0f + __expf(-fabsf(y))); lw[j] = -__expf(-sp - 0.5f); }
                        *(GAS v2u*)(LW + (size_t)m * 1024 + c) = pack4(lw[0], lw[1], lw[2], lw[3]); }
                }
            }
            {
                bf16x8_t wg[4][5];
#pragma unroll
                for (int nt = 0; nt < 4; ++nt)
#pragma unroll
                    for (int ks = 0; ks < 5; ++ks) wg[nt][ks] = *(const GAS bf16x8_t*)(G2T + (size_t)(cb + 16 * nt + fr) * 160 + 32 * ks + 8 * fq);
#pragma unroll 1
                for (int mt = 0; mt < 4; ++mt) {
                    const int m = m0 + 16 * mt + fr;
                    f32x4 ag[4];
#pragma unroll
                    for (int nt = 0; nt < 4; ++nt) ag[nt] = (f32x4){0.f, 0.f, 0.f, 0.f};
#pragma unroll
                    for (int ks = 0; ks < 5; ++ks) { const bf16x8_t fg = *(const LAS bf16x8_t*)(ldsb + E1_AG + (16 * mt + fr) * 336 + (32 * ks + 8 * fq) * 2);
#pragma unroll
                        for (int nt = 0; nt < 4; ++nt) ag[nt] = __builtin_amdgcn_mfma_f32_16x16x32_bf16(wg[nt][ks], fg, ag[nt], 0, 0, 0); }
#pragma unroll
                    for (int nt = 0; nt < 4; ++nt) *(GAS v2u*)(GG + (size_t)m * 1024 + cb + 16 * nt + 4 * fq) = pack4(ag[nt][0], ag[nt][1], ag[nt][2], ag[nt][3]);
                }
            }
            {
                bf16x8_t wv2[4];
#pragma unroll
                for (int nt = 0; nt < 4; ++nt) { wv2[nt] = (bf16x8_t){0, 0, 0, 0, 0, 0, 0, 0}; if (li > 0) wv2[nt] = *(const GAS bf16x8_t*)(V2T + (size_t)(cb + 16 * nt + fr) * 32 + 8 * fq); }
#pragma unroll 1
                for (int mt = 0; mt < 4; ++mt) {
                    const int m = m0 + 16 * mt + fr; const bool first = (m & (T - 1)) == 0;
                    f32x4 avr[4];
#pragma unroll
                    for (int nt = 0; nt < 4; ++nt) avr[nt] = (f32x4){0.f, 0.f, 0.f, 0.f};
                    if (li > 0) { const bf16x8_t fp = *(const LAS bf16x8_t*)(ldsb + E1_PB + (16 * mt + fr) * 80 + (8 * fq) * 2);
#pragma unroll
                        for (int nt = 0; nt < 4; ++nt) avr[nt] = __builtin_amdgcn_mfma_f32_16x16x32_bf16(wv2[nt], fp, avr[nt], 0, 0, 0); }
                    const size_t zo = (size_t)m * ZN + ZA + cb + 4 * fq;
#pragma unroll
                    for (int nt = 0; nt < 4; ++nt) { const int c = cb + 16 * nt + 4 * fq; const size_t o = (size_t)m * 1024 + c;
                        const v2u rc = *(const GAS v2u*)(Z + zo + 16 * nt), vc = *(const GAS v2u*)(Z + zo + 2048 + 16 * nt); v2u rp = {0u, 0u}, vp = {0u, 0u};
                        if (!first) { rp = *(const GAS v2u*)(Z + zo - ZN + 16 * nt); vp = *(const GAS v2u*)(Z + zo - ZN + 2048 + 16 * nt); }
                        float rr[4], vv[4]; lerp4(rc, rp, *(const f32x4*)(mu + c), rr); lerp4(vc, vp, *(const f32x4*)(mu + 2048 + c), vv);
                        if (li > 0) { const f32x4 v0v = *(const f32x4*)(v0w + c); const v2u vf = *(const GAS v2u*)(VF + o); const float f0 = bflo(vf.x), f1 = bfhi(vf.x), f2 = bflo(vf.y), f3 = bfhi(vf.y);
                            vv[0] += (f0 - vv[0]) * sigmoidf_(v0v[0] + avr[nt][0]); vv[1] += (f1 - vv[1]) * sigmoidf_(v0v[1] + avr[nt][1]);
                            vv[2] += (f2 - vv[2]) * sigmoidf_(v0v[2] + avr[nt][2]); vv[3] += (f3 - vv[3]) * sigmoidf_(v0v[3] + avr[nt][3]); }
                        *(GAS v2u*)(R + o) = pack4(rr[0], rr[1], rr[2], rr[3]); *(GAS v2u*)(VO + o) = pack4(vv[0], vv[1], vv[2], vv[3]); }
                }
            }
        }
        __syncthreads();
    }
}

constexpr size_t CS_AR = WS_ACT, CS_BK = WS_ACT + 128 * MiB, CS_Y0 = WS_ACT + 256 * MiB, CS_GL = WS_ACT + 320 * MiB;
__device__ __forceinline__ int cs_perm(int k) { return (k & 32) + 8 * ((k >> 2) & 3) + 4 * ((k >> 4) & 1) + (k & 3); }
__device__ __forceinline__ f32x4 mm16_ll(const LAS float* A, const LAS float* B, f32x4 c, int fr, int fq) {
    const f32x4 a4 = *(const LAS f32x4*)(A + fr * 16 + 4 * fq);
#pragma unroll
    for (int s = 0; s < 4; ++s) c = __builtin_amdgcn_mfma_f32_16x16x4f32(a4[s], B[(4 * fq + s) * 16 + fr], c, 0, 0, 0);
    return c;
}
__device__ __forceinline__ f32x4 mm16_la(const LAS float* A, const f32x4 b, f32x4 c, int fr, int fq) {
    const f32x4 a4 = *(const LAS f32x4*)(A + fr * 16 + 4 * fq);
#pragma unroll
    for (int s = 0; s < 4; ++s) c = __builtin_amdgcn_mfma_f32_16x16x4f32(a4[s], b[s], c, 0, 0, 0);
    return c;
}
__device__ __forceinline__ void st16(LAS float* Mx, const f32x4 c, int fr, int fq) {
#pragma unroll
    for (int r = 0; r < 4; ++r) Mx[(4 * fq + r) * 16 + fr] = c[r];
}
__device__ __forceinline__ void scanpre_phase(const Args& a, int li, LAS unsigned char* ldsb, int vcu, int G, int tid) {
    unsigned char* ws = a.ws;
    const bf16* Rr = (const bf16*)(ws + SC_R); const bf16* K2 = (const bf16*)(ws + SC_K2); const bf16* KK = (const bf16*)(ws + SC_KK); const bf16* BB = (const bf16*)(ws + SC_BB); const bf16* LW = (const bf16*)(ws + SC_LW);
    const bf16* V = (const bf16*)(ws + (li ? WS_V2 : WS_VF));
    bf16* ARo = (bf16*)(ws + CS_AR); bf16* BKo = (bf16*)(ws + CS_BK); bf16* Y0o = (bf16*)(ws + CS_Y0); float* GLo = (float*)(ws + CS_GL); bf16* U0o = (bf16*)(ws + WS_U0);
    const int lane = tid & 63, wave = tid >> 6, fr = lane & 15, fq = lane >> 4;
    LAS unsigned char* wl = ldsb + wave * 17408;
    LAS bf16* LAR = (LAS bf16*)wl; LAS bf16* LBK = (LAS bf16*)(wl + 4608); LAS float* LM = (LAS float*)(wl + 9216); LAS float* LX = (LAS float*)(wl + 13312);
    const LAS float* Mab = LM, *Mak = LM + 256, *Mrb = LM + 512, *Mrk = LM + 768;
    LAS float* Tm = LX, *Na = LX + 256, *Nb = LX + 512;
    for (int ch = vcu * NWAVES + wave; ch < 32 * 1024; ch += G * NWAVES) {
        const int bh = ch >> 10, ci = ch & 1023, b = bh >> 4, h = bh & 15; const size_t row0 = (size_t)b * T + 16 * ci;
        f32x4 At[4], Rt[4], vv[4]; float glane;
#pragma unroll
        for (int nt = 0; nt < 4; ++nt) { f32x4 lw, kk, bb, k2, rr;
#pragma unroll
            for (int s = 0; s < 4; ++s) { const size_t o = (row0 + 4 * fq + s) * 1024 + h * 64 + 16 * nt + fr;
                lw[s] = bf2f(LW[o]); kk[s] = bf2f(KK[o]); bb[s] = bf2f(BB[o]); k2[s] = bf2f(K2[o]); rr[s] = bf2f(Rr[o]); vv[nt][s] = bf2f(V[o]); }
            f32x4 cum; cum[0] = lw[0]; cum[1] = cum[0] + lw[1]; cum[2] = cum[1] + lw[2]; cum[3] = cum[2] + lw[3];
            float x = cum[3]; { const float y = __shfl_up(x, 16); if (fq >= 1) x += y; } { const float y = __shfl_up(x, 32); if (fq >= 2) x += y; }
            const float excl = x - cum[3]; const float cl = __shfl(x, 48 + fr);
            bf16* bo = BKo + (size_t)ch * 2048 + (16 * nt + fr) * 32 + 8 * fq; f32x4 bh4, kh4;
#pragma unroll
            for (int s = 0; s < 4; ++s) { const float c = excl + cum[s]; const float g = __expf(c), gp = __expf(c - lw[s]), gi = __expf(-c), e = __expf(cl - c);
                At[nt][s] = -kk[s] * gp; Rt[nt][s] = rr[s] * g; bh4[s] = bb[s] * e; kh4[s] = k2[s] * e;
                const int t = 4 * fq + s, cc = 16 * nt + fr;
                LAR[t * 72 + cc] = (bf16)f2bf(At[nt][s]); LAR[(16 + t) * 72 + cc] = (bf16)f2bf(Rt[nt][s]); LBK[t * 72 + cc] = (bf16)f2bf(bb[s] * gi); LBK[(16 + t) * 72 + cc] = (bf16)f2bf(k2[s] * gi); }
            *(GAS v4u*)bo = (v4u){pk2(bh4[0], bh4[1]), pk2(bh4[2], bh4[3]), pk2(kh4[0], kh4[1]), pk2(kh4[2], kh4[3])};
            if (fq == 0) GLo[(size_t)ch * 64 + 16 * nt + fr] = __expf(cl);
            glane = cl; }
        (void)glane;
        LDS_WAIT(); asm volatile("" ::: "memory");
#pragma unroll
        for (int mt = 0; mt < 2; ++mt)
#pragma unroll
            for (int nt = 0; nt < 2; ++nt) { f32x4 m = {0.f, 0.f, 0.f, 0.f};
#pragma unroll
                for (int ks = 0; ks < 2; ++ks) { const bf16x8_t af = *(const LAS bf16x8_t*)(LAR + (16 * mt + fr) * 72 + 32 * ks + 8 * fq), bfr = *(const LAS bf16x8_t*)(LBK + (16 * nt + fr) * 72 + 32 * ks + 8 * fq);
                    m = __builtin_amdgcn_mfma_f32_16x16x32_bf16(af, bfr, m, 0, 0, 0); }
#pragma unroll
                for (int r = 0; r < 4; ++r) { const int t = 4 * fq + r; const bool keep = mt ? (fr <= t) : (fr < t); LM[((mt * 2 + nt) * 16 + t) * 16 + fr] = keep ? m[r] : 0.f; } }
        LDS_WAIT(); asm volatile("" ::: "memory");
        { const f32x4 z = {0.f, 0.f, 0.f, 0.f};
          f32x4 t1;
#pragma unroll
          for (int r = 0; r < 4; ++r) t1[r] = Mab[(4 * fq + r) * 16 + fr] + ((4 * fq + r) == fr ? 1.0f : 0.f);
          st16(Tm, t1, fr, fq);
          f32x4 n2 = mm16_ll(Mab, Mab, z, fr, fq); st16(Na, n2, fr, fq);
          LDS_WAIT(); asm volatile("" ::: "memory");
          f32x4 t2 = mm16_ll(Tm, Na, t1, fr, fq);
          f32x4 n4 = mm16_ll(Na, Na, z, fr, fq);
          LDS_WAIT(); asm volatile("" ::: "memory");
          st16(Tm, t2, fr, fq); st16(Nb, n4, fr, fq);
          LDS_WAIT(); asm volatile("" ::: "memory");
          f32x4 t3 = mm16_ll(Tm, Nb, t2, fr, fq);
          f32x4 n8 = mm16_ll(Nb, Nb, z, fr, fq);
          LDS_WAIT(); asm volatile("" ::: "memory");
          st16(Tm, t3, fr, fq); st16(Na, n8, fr, fq);
          LDS_WAIT(); asm volatile("" ::: "memory");
          f32x4 t4 = mm16_ll(Tm, Na, t3, fr, fq);
          LDS_WAIT(); asm volatile("" ::: "memory");
          st16(Tm, t4, fr, fq);
          LDS_WAIT(); asm volatile("" ::: "memory"); }
#pragma unroll
        for (int nt = 0; nt < 4; ++nt) { const f32x4 z = {0.f, 0.f, 0.f, 0.f};
            const f32x4 w1 = mm16_la(Mak, vv[nt], z, fr, fq);
            const f32x4 u0 = mm16_la(Tm, w1, z, fr, fq);
            const f32x4 ah = mm16_la(Tm, At[nt], z, fr, fq);
            const f32x4 rh = mm16_la(Mrb, ah, Rt[nt], fr, fq);
            f32x4 y0 = mm16_la(Mrb, u0, z, fr, fq); y0 = mm16_la(Mrk, vv[nt], y0, fr, fq);
            const int k = 16 * nt + fr; bf16* arp = ARo + (size_t)ch * 2048 + cs_perm(k);
#pragma unroll
            for (int s = 0; s < 4; ++s) { arp[(4 * fq + s) * 64] = (bf16)f2bf(ah[s]); arp[(16 + 4 * fq + s) * 64] = (bf16)f2bf(rh[s]); }
            *(GAS v2u*)(Y0o + (size_t)ch * 1024 + k * 16 + 4 * fq) = pack4(y0[0], y0[1], y0[2], y0[3]);
            *(GAS v2u*)(U0o + (size_t)ch * 1024 + k * 16 + 4 * fq) = pack4(u0[0], u0[1], u0[2], u0[3]); }
        LDS_WAIT(); asm volatile("" ::: "memory");
    }
}
constexpr int CQ_NS = 13, CQ_SLOT = 10240, CQ_FULL = CQ_NS * CQ_SLOT, CQ_DONE = CQ_FULL + 64, CQ_NL = 6;
#define CQ_GLDS(src, dst) __builtin_amdgcn_global_load_lds((const unsigned*)(src), (LAS unsigned*)(dst), 16, 0, 0)
__device__ __forceinline__ void scanseq_phase(const Args& a, int li, LAS unsigned char* ldsb, int vcu, int tid) {
    volatile LAS unsigned* FULL = (volatile LAS unsigned*)(ldsb + CQ_FULL); volatile LAS unsigned* DONE = (volatile LAS unsigned*)(ldsb + CQ_DONE);
    if (tid < 32) ((LAS unsigned*)(ldsb + CQ_FULL))[tid] = 0u;
    __syncthreads();
    const int wave = __builtin_amdgcn_readfirstlane(tid >> 6), lane = tid & 63;
    if (vcu < 128 && wave <= CQ_NL) {
        unsigned char* ws = a.ws;
        const int bh = vcu >> 2, vb = vcu & 3, b = bh >> 4, h = bh & 15; const size_t row0 = (size_t)b * T; const size_t ch0 = (size_t)bh * 1024;
        if (wave > 0) {
            const unsigned char* ARo = ws + CS_AR; const unsigned char* BKo = ws + CS_BK; const unsigned char* Y0o = ws + CS_Y0; const unsigned char* GLo = ws + CS_GL; const unsigned char* U0o = ws + WS_U0;
            const unsigned char* V = ws + (li ? WS_V2 : WS_VF);
            const unsigned oAR = (unsigned)((lane >> 3) * 128 + 16 * ((lane & 7) ^ ((lane >> 3) & 7)));
            unsigned oBK[4];
#pragma unroll
            for (int i = 0; i < 4; ++i) { const int k = 16 * i + (lane >> 2); oBK[i] = (unsigned)(k * 64 + 16 * ((lane & 3) ^ ((k >> 2) & 3))); }
            const unsigned oUY = (unsigned)((16 * vb + ((lane & 31) >> 1)) * 32 + 16 * (lane & 1));
            const size_t oV = ((size_t)(lane >> 1) * 1024 + h * 64 + 16 * vb) * 2 + 16 * (lane & 1);
            const unsigned oG = (unsigned)(16 * (lane & 15));
            int pub = wave - 1; unsigned spins = 0;
            for (int c = wave - 1; c < 1024; c += CQ_NL) {
                const int s = c % CQ_NS;
                if (c >= CQ_NS) { while ((int)DONE[0] < c - CQ_NS + 1) { __builtin_amdgcn_s_sleep(1); if (++spins > (1u << 24)) break; } }
                LAS unsigned char* sl = ldsb + s * CQ_SLOT; const size_t ch = ch0 + c;
                const unsigned char* ar = ARo + ch * 4096; const unsigned char* bk = BKo + ch * 4096;
#pragma unroll
                for (int i = 0; i < 4; ++i) CQ_GLDS(ar + i * 1024 + oAR, sl + i * 1024);
#pragma unroll
                for (int i = 0; i < 4; ++i) CQ_GLDS(bk + oBK[i], sl + 4096 + i * 1024);
                CQ_GLDS((lane < 32 ? U0o : Y0o) + ch * 2048 + oUY, sl + 8192);
                CQ_GLDS(lane < 32 ? V + (row0 + 16 * (size_t)c) * 2048 + oV : GLo + ch * 256 + oG, sl + 9216);
                asm volatile("s_waitcnt vmcnt(10)" ::: "memory");
                for (; pub <= c - CQ_NL; pub += CQ_NL) FULL[pub % CQ_NS] = (unsigned)(pub + 1);
            }
            asm volatile("s_waitcnt vmcnt(0)" ::: "memory");
            for (; pub < 1024; pub += CQ_NL) FULL[pub % CQ_NS] = (unsigned)(pub + 1);
        } else {
            float* Y = (float*)(ws + WS_XB);
            const int fr = lane & 15, fq = lane >> 4; const int colv = h * 64 + 16 * vb + fr;
            f32x4 St[4];
#pragma unroll
            for (int kt = 0; kt < 4; ++kt) St[kt] = (f32x4){0.f, 0.f, 0.f, 0.f};
            unsigned spins = 0;
            for (int c = 0; c < 1024; ++c) {
                const int s = c % CQ_NS; LAS unsigned char* sl = ldsb + s * CQ_SLOT;
                while (FULL[s] != (unsigned)(c + 1)) { if (++spins > (1u << 26)) break; }
                __builtin_amdgcn_fence(__ATOMIC_ACQUIRE, "workgroup");
                bf16x8_t ar[2][2], bk[4]; f32x4 gl[4];
#pragma unroll
                for (int mt = 0; mt < 2; ++mt)
#pragma unroll
                    for (int ks = 0; ks < 2; ++ks) { const int r = 16 * mt + fr; ar[mt][ks] = *(const LAS bf16x8_t*)(sl + r * 128 + 16 * ((4 * ks + fq) ^ (r & 7))); }
#pragma unroll
                for (int kt = 0; kt < 4; ++kt) { const int k = 16 * kt + fr; bk[kt] = *(const LAS bf16x8_t*)(sl + 4096 + k * 64 + 16 * (fq ^ ((k >> 2) & 3))); gl[kt] = *(const LAS f32x4*)(sl + 9728 + (16 * kt + 4 * fq) * 4); }
                const v2u u0 = *(const LAS v2u*)(sl + 8192 + fr * 32 + 8 * fq), y0 = *(const LAS v2u*)(sl + 8704 + fr * 32 + 8 * fq);
                unsigned vs[4];
#pragma unroll
                for (int j = 0; j < 4; ++j) vs[j] = *(const LAS unsigned short*)(sl + 9216 + (4 * fq + j) * 32 + 2 * fr);
                bf16x8_t sb[2];
#pragma unroll
                for (int ks = 0; ks < 2; ++ks) { v4u w; w.x = pk2(St[2 * ks][0], St[2 * ks][1]); w.y = pk2(St[2 * ks][2], St[2 * ks][3]); w.z = pk2(St[2 * ks + 1][0], St[2 * ks + 1][1]); w.w = pk2(St[2 * ks + 1][2], St[2 * ks + 1][3]); sb[ks] = __builtin_bit_cast(bf16x8_t, w); }
                f32x4 au = {0.f, 0.f, 0.f, 0.f}, ay = {0.f, 0.f, 0.f, 0.f};
#pragma unroll
                for (int ks = 0; ks < 2; ++ks) { au = __builtin_amdgcn_mfma_f32_16x16x32_bf16(ar[0][ks], sb[ks], au, 0, 0, 0); ay = __builtin_amdgcn_mfma_f32_16x16x32_bf16(ar[1][ks], sb[ks], ay, 0, 0, 0); }
                { const size_t yr = (row0 + 16 * (size_t)c + 4 * fq) * 1024 + colv;
                  Y[yr] = ay[0] + bflo(y0.x); Y[yr + 1024] = ay[1] + bfhi(y0.x); Y[yr + 2048] = ay[2] + bflo(y0.y); Y[yr + 3072] = ay[3] + bfhi(y0.y); }
                v4u uw; uw.x = pk2(au[0] + bflo(u0.x), au[1] + bfhi(u0.x)); uw.y = pk2(au[2] + bflo(u0.y), au[3] + bfhi(u0.y)); uw.z = vs[0] | (vs[1] << 16); uw.w = vs[2] | (vs[3] << 16);
                const bf16x8_t uv = __builtin_bit_cast(bf16x8_t, uw);
#pragma unroll
                for (int kt = 0; kt < 4; ++kt) St[kt] = __builtin_amdgcn_mfma_f32_16x16x32_bf16(bk[kt], uv, St[kt] * gl[kt], 0, 0, 0);
                asm volatile("s_waitcnt lgkmcnt(0)" ::: "memory");
                if (lane == 0) DONE[0] = (unsigned)(c + 1);
            }
        }
    }
    __syncthreads();
}

typedef float f32x16 __attribute__((ext_vector_type(16)));
constexpr int AT_K = 0, AT_V = 36864;
__device__ __forceinline__ bf16x8_t tr_frag(unsigned addr) {
    v2u lo, hi; asm volatile("ds_read_b64_tr_b16 %0, %2\n\tds_read_b64_tr_b16 %1, %2 offset:1536\n\ts_waitcnt lgkmcnt(0)" : "=&v"(lo), "=&v"(hi) : "v"(addr) : "memory");
    v4u w; w.x = lo.x; w.y = lo.y; w.z = hi.x; w.w = hi.y; return __builtin_bit_cast(bf16x8_t, w);
}
__device__ __forceinline__ void attn_unit(const Args& a, int li, int au, LAS unsigned char* ldsb, int tid) {
    unsigned char* ws = a.ws; const bf16* Z = (const bf16*)(ws + WS_ACT); bf16* O = (bf16*)(ws + WS_O);
    const int n = au & 127, kvh = (au >> 7) & 3, b = au >> 9;
    const size_t rblk = (size_t)b * T + (size_t)n * 128;
    for (int e = tid; e < 256 * 8 * 2; e += NTHR) { const int which = e >> 11, rem = e & 2047, j = rem >> 3, c8 = rem & 7; const bool valid = (n > 0) || (j >= 128);
        v4u w = {0u, 0u, 0u, 0u}; if (valid) w = *(const GAS v4u*)(Z + (rblk + j - 128) * ZN + 1024 + which * 256 + kvh * 64 + 8 * c8);
        *(LAS v4u*)(ldsb + (which ? AT_V + j * 192 : AT_K + j * 144) + c8 * 16) = w; }
    __syncthreads();
    const int lane = tid & 63, wave = tid >> 6, l31 = lane & 31, h = lane >> 5;
    const unsigned ldsbase = (unsigned)(size_t)ldsb;
#pragma unroll 1
    for (int it = 0; it < 2; ++it) {
        const int tt = 2 * wave + it, g = tt >> 2, qi = tt & 3, hq = kvh * 4 + g; const size_t qrow = rblk + 32 * qi + l31;
        bf16x8_t qf[4];
#pragma unroll
        for (int ks = 0; ks < 4; ++ks) qf[ks] = *(const GAS bf16x8_t*)(Z + qrow * ZN + hq * 64 + 16 * ks + 8 * h);
        f32x16 st[5];
#pragma unroll
        for (int kt = 0; kt < 5; ++kt) {
#pragma unroll
            for (int r = 0; r < 16; ++r) st[kt][r] = 0.f;
#pragma unroll
            for (int ks = 0; ks < 4; ++ks) { const bf16x8_t kf = *(const LAS bf16x8_t*)(ldsb + AT_K + (32 * (qi + kt) + l31) * 144 + (16 * ks + 8 * h) * 2);
                st[kt] = __builtin_amdgcn_mfma_f32_32x32x16_bf16(kf, qf[ks], st[kt], 0, 0, 0); } }
        const float slope = exp2f(-0.5f * (float)(hq + 1)); const float sink = a.in[I_ESINK][li * 16 + hq];
        float mx = sink;
#pragma unroll
        for (int kt = 0; kt < 5; ++kt)
#pragma unroll
            for (int r = 0; r < 16; ++r) { const int j = 32 * (qi + kt) + (r & 3) + 8 * (r >> 2) + 4 * h; const int dist = 32 * qi + l31 + 128 - j;
                const bool ok = (dist >= 0) && (dist < 128) && ((n > 0) || (j >= 128));
                const float s = ok ? st[kt][r] * 0.125f - slope * (float)dist : -INFINITY; st[kt][r] = s; mx = fmaxf(mx, s); }
        mx = fmaxf(mx, __shfl_xor(mx, 32));
        float l = 0.f;
#pragma unroll
        for (int kt = 0; kt < 5; ++kt)
#pragma unroll
            for (int r = 0; r < 16; ++r) { const float p = __expf(st[kt][r] - mx); st[kt][r] = p; l += p; }
        l += __shfl_xor(l, 32); l += __expf(sink - mx);
        f32x16 ot[2];
#pragma unroll
        for (int r = 0; r < 16; ++r) { ot[0][r] = 0.f; ot[1][r] = 0.f; }
#pragma unroll
        for (int kt = 0; kt < 5; ++kt)
#pragma unroll
            for (int s2 = 0; s2 < 2; ++s2) {
                v4u pw; pw.x = pk2(st[kt][8 * s2 + 0], st[kt][8 * s2 + 1]); pw.y = pk2(st[kt][8 * s2 + 2], st[kt][8 * s2 + 3]); pw.z = pk2(st[kt][8 * s2 + 4], st[kt][8 * s2 + 5]); pw.w = pk2(st[kt][8 * s2 + 6], st[kt][8 * s2 + 7]);
                const bf16x8_t pf = __builtin_bit_cast(bf16x8_t, pw);
#pragma unroll
                for (int db = 0; db < 2; ++db) {
                    const unsigned va = ldsbase + AT_V + (unsigned)(32 * (qi + kt) + 16 * s2 + 4 * h + ((lane & 15) >> 2)) * 192u + (unsigned)(32 * db + 16 * ((lane >> 4) & 1) + 4 * (lane & 3)) * 2u;
                    const bf16x8_t vf = tr_frag(va);
                    ot[db] = __builtin_amdgcn_mfma_f32_32x32x16_bf16(vf, pf, ot[db], 0, 0, 0); } }
        const float inv = 1.0f / l;
#pragma unroll
        for (int db = 0; db < 2; ++db)
#pragma unroll
            for (int g4 = 0; g4 < 4; ++g4)
                *(GAS v2u*)(O + qrow * D + 1024 + hq * 64 + 32 * db + 8 * g4 + 4 * h) = pack4(ot[db][4 * g4] * inv, ot[db][4 * g4 + 1] * inv, ot[db][4 * g4 + 2] * inv, ot[db][4 * g4 + 3] * inv);
    }
    __syncthreads();
}

__device__ __forceinline__ void e3_phase(const Args& a, int li, int vcu, int G, int tid) {
    unsigned char* ws = a.ws; const float* Y = (const float*)(ws + WS_XB);
    const bf16* R = (const bf16*)(ws + SC_R); const bf16* K2 = (const bf16*)(ws + SC_K2); const bf16* GG = (const bf16*)(ws + SC_GG); const bf16* V = (const bf16*)(ws + (li ? WS_V2 : WS_VF));
    bf16* O = (bf16*)(ws + WS_O);
    const float* rk = a.in[I_ERK] + li * 1024; const float* gng = a.in[I_EGNG] + li * 1024; const float* gnb = a.in[I_EGNB] + li * 1024;
    for (size_t e4 = (size_t)vcu * NTHR + tid; e4 < (size_t)M * 256; e4 += (size_t)G * NTHR) {
        const size_t row = e4 >> 8; const int c = (int)(e4 & 255) * 4; const size_t e = row * 1024 + c;
        const f32x4 y = *(const GAS f32x4*)(Y + e);
        const v2u rw = *(const GAS v2u*)(R + e), kw = *(const GAS v2u*)(K2 + e), vw = *(const GAS v2u*)(V + e), gw = *(const GAS v2u*)(GG + e);
        const f32x4 rkv = *(const f32x4*)(rk + c), ggv = *(const f32x4*)(gng + c), gbv = *(const f32x4*)(gnb + c);
        const float mean = row16_sum((y.x + y.y) + (y.z + y.w)) * (1.0f / 64.0f);
        const f32x4 d = y - mean;
        const float var = row16_sum((d.x * d.x + d.y * d.y) + (d.z * d.z + d.w * d.w)) * (1.0f / 64.0f);
        const float rs = rsqrtf(var + 64e-5f);
        const float r0 = bflo(rw.x), r1 = bfhi(rw.x), r2 = bflo(rw.y), r3 = bfhi(rw.y), k0 = bflo(kw.x), k1 = bfhi(kw.x), k2 = bflo(kw.y), k3 = bfhi(kw.y);
        const float bonus = row16_sum((r0 * k0 * rkv.x + r1 * k1 * rkv.y) + (r2 * k2 * rkv.z + r3 * k3 * rkv.w));
        const float o0 = (d.x * rs * ggv.x + gbv.x + bonus * bflo(vw.x)) * bflo(gw.x), o1 = (d.y * rs * ggv.y + gbv.y + bonus * bfhi(vw.x)) * bfhi(gw.x);
        const float o2 = (d.z * rs * ggv.z + gbv.z + bonus * bflo(vw.y)) * bflo(gw.y), o3 = (d.w * rs * ggv.w + gbv.w + bonus * bfhi(vw.y)) * bfhi(gw.y);
        *(GAS v2u*)(O + row * D + c) = pack4(o0, o1, o2, o3);
    }
}

constexpr int SG_W = 0, SG_V = 34816;
__device__ __forceinline__ unsigned sg_off(unsigned row, unsigned ch) { return 256u * row + 16u * (ch ^ (((row & 3u) << 2) | ((row >> 2) & 3u))); }
__device__ __forceinline__ bf16x8_t tr_frag2(unsigned a0, unsigned a1) {
    v2u lo, hi; asm volatile("ds_read_b64_tr_b16 %0, %2\n\tds_read_b64_tr_b16 %1, %3\n\ts_waitcnt lgkmcnt(0)" : "=&v"(lo), "=&v"(hi) : "v"(a0), "v"(a1) : "memory");
    v4u w; w.x = lo.x; w.y = lo.y; w.z = hi.x; w.w = hi.y; return __builtin_bit_cast(bf16x8_t, w);
}
__device__ __forceinline__ void sgu_phase(const Args& a, int li, LAS unsigned char* ldsb, int vcu, int G, int tid) {
    unsigned char* ws = a.ws; const bf16* Z = (const bf16*)(ws + WS_ACT); bf16* O = (bf16*)(ws + WS_O);
    const float* ssv = (const float*)(ws + WS_SS) + (size_t)(13 + li) * SS_REC;
    const bf16* WSB = (const bf16*)(ws + SM_WSB); const float* bs = a.in[I_OBS] + li * 16 * 128; const float* vng = a.in[I_OVNG] + li * D;
    const int lane = tid & 63, wave = tid >> 6, fr = lane & 15, fq = lane >> 4;
    const unsigned ldsbase = (unsigned)(size_t)ldsb;
    int gcur = -1;
    for (int u = vcu; u < 4096; u += G) {
        const int g = u & 15, bn = u >> 4; const size_t m0 = (size_t)bn * 128;
        __syncthreads();
        if (g != gcur) { gcur = g;
            for (int e = tid; e < 128 * 16; e += NTHR) { const int i = e >> 4, ch = e & 15; *(LAS v4u*)(ldsb + SG_W + i * 272 + ch * 16) = *(const GAS v4u*)(WSB + ((size_t)g * 128 + i) * 128 + 8 * ch); } }
        for (int e = tid; e < 128 * 16; e += NTHR) { const int j = e >> 4, ch = e & 15; const float rs = pg8::row_rs(ssv, (int)(m0 + j));
            const v4u w = *(const GAS v4u*)(Z + (m0 + j) * ZO + 2048 + g * 128 + 8 * ch); v4u o;
            o.x = pk2(bflo(w.x) * rs, bfhi(w.x) * rs); o.y = pk2(bflo(w.y) * rs, bfhi(w.y) * rs); o.z = pk2(bflo(w.z) * rs, bfhi(w.z) * rs); o.w = pk2(bflo(w.w) * rs, bfhi(w.w) * rs);
            *(LAS v4u*)(ldsb + SG_V + sg_off((unsigned)j, (unsigned)ch)) = o; }
        __syncthreads();
        bf16x8_t vf[4];
        { const unsigned q = (unsigned)(lane & 15) >> 2, p = (unsigned)lane & 3u;
#pragma unroll
          for (int ks = 0; ks < 4; ++ks) { const unsigned r0 = 32u * ks + 8u * fq + q;
              vf[ks] = tr_frag2(ldsbase + SG_V + sg_off(r0, 2u * wave + (p >> 1)) + 8u * (p & 1u), ldsbase + SG_V + sg_off(r0 + 4u, 2u * wave + (p >> 1)) + 8u * (p & 1u)); } }
        const int cc = g * 128 + 16 * wave + 4 * fq; const f32x4 vg = *(const f32x4*)(vng + cc);
#pragma unroll
        for (int mt = 0; mt < 8; ++mt) {
            f32x4 acc = {0.f, 0.f, 0.f, 0.f};
#pragma unroll
            for (int ks = 0; ks <= (mt >> 1); ++ks) { const bf16x8_t wf = *(const LAS bf16x8_t*)(ldsb + SG_W + (16 * mt + fr) * 272 + (32 * ks + 8 * fq) * 2);
                acc = __builtin_amdgcn_mfma_f32_16x16x32_bf16(vf[ks], wf, acc, 0, 0, 0); }
            const int i = 16 * mt + fr; const float bi = bs[g * 128 + i];
            const v2u uw = *(const GAS v2u*)(Z + (m0 + i) * ZO + cc);
            *(GAS v2u*)(O + (m0 + i) * D + cc) = pack4(bflo(uw.x) * (vg.x * acc[0] + bi), bfhi(uw.x) * (vg.y * acc[1] + bi), bflo(uw.y) * (vg.z * acc[2] + bi), bfhi(uw.y) * (vg.w * acc[3] + bi));
        }
    }
    __syncthreads();
}

__device__ __forceinline__ void final_phase(const Args& a, int vcu, int G, int wave, int lane) {
    const int gw = vcu * NWAVES + wave, NGW = G * NWAVES; const float* ss = (const float*)(a.ws + WS_SS) + (size_t)12 * SS_REC; const float* fg = a.in[I_FG];
    for (int m = gw; m < M; m += NGW) { const float rs = pg8::row_rs(ss, m);
        GAS f32x4* xr = (GAS f32x4*)(a.out + (size_t)m * D) + lane; const GAS f32x4* gr = (const GAS f32x4*)fg + lane;
#pragma unroll
        for (int j = 0; j < 8; ++j) { const f32x4 v = xr[64 * j], gg = gr[64 * j]; xr[64 * j] = v * rs * gg; } }
}

__global__ void __launch_bounds__(NTHR, 2) mk_fwd(Args args) {
    extern __shared__ __attribute__((aligned(16))) unsigned char lds_raw[];
    LAS unsigned char* lds = (LAS unsigned char*)lds_raw;
    const int tid = threadIdx.x, lane = tid & 63, wave = __builtin_amdgcn_readfirstlane(tid >> 6);
    const int G = gridDim.x, bx = blockIdx.x; const int vcu = (G % 8 == 0) ? (bx % 8) * (G / 8) + bx / 8 : bx;
    unsigned char* ws = args.ws; gu32* ctl = (gu32*)(ws + WS_CTL);
    for (int u = tid; u < (LDS_BYTES - LDSCTL_OFF) / 4; u += NTHR) ((LAS unsigned*)(lds + LDSCTL_OFF))[u] = 0u;
    __syncthreads();
    const int lo = args.ph_lo, hi = args.ph_hi;
    const bool multi = (hi - lo) > 1;
    XcdBarrier bar; bar.bar = (unsigned*)(ctl + CW_BAR); bar.x = 0; bar.st = nullptr;
    if (multi) bar = xcd_barrier_post((unsigned*)(ctl + CW_BAR), (volatile LAS unsigned*)(lds + LDSCTL_OFF));
#define IN(k) (lo <= (k) && (k) < hi)
#define SEAM(k) do { if ((k) + 1 < hi) xcd_barrier(bar); } while (0)
#ifndef DUP_G
#define DUP_G 1
#endif
#ifndef DUP_T
#define DUP_T 1
#endif
#ifndef DUP_G1
#define DUP_G1 DUP_G
#endif
#ifndef DUP_SP
#define DUP_SP DUP_S
#endif
#ifndef DUP_SQ
#define DUP_SQ DUP_S
#endif
#ifndef DUP_PREP
#define DUP_PREP DUP_T
#endif
#ifndef DUP_E1
#define DUP_E1 DUP_T
#endif
#ifndef DUP_SGU
#define DUP_SGU DUP_T
#endif
#ifndef DUP_E3
#define DUP_E3 DUP_T
#endif
#define REPN(n) for (int rep_ = 0; rep_ < (n); ++rep_)
#ifndef DUP_S
#define DUP_S 1
#endif
#define REPG for (int rep_ = 0; rep_ < DUP_G; ++rep_)
#define REPT for (int rep_ = 0; rep_ < DUP_T; ++rep_)
#define REPS for (int rep_ = 0; rep_ < DUP_S; ++rep_)
#define RSEAM(n) do { if (rep_ + 1 < (n)) xcd_barrier(bar); } while (0)
    float* ssb = (float*)(ws + WS_SS);
    bf16* XB = (bf16*)(ws + WS_XB); bf16* ACT = (bf16*)(ws + WS_ACT); bf16* OB = (bf16*)(ws + WS_O);

    for (int s = 0; s < NSUB; ++s) {
        const int pb = s * 8, L = s / 3, kind = s % 3, li = L >> 1; const bool even = !(L & 1);
        #ifndef NO_PREP
        if (kind == 0 && IN(pb + 0)) { REPN(DUP_PREP) { const int t_ = opaque(tid); prep_phase(args, L, lds, vcu, G, __builtin_amdgcn_readfirstlane(t_ >> 6), t_ & 63); RSEAM(DUP_PREP); } SEAM(pb + 0); }
#endif
        if (IN(pb + 1)) {
            const float* ss = ssb + (size_t)s * SS_REC;
            if (kind != 1) {
                pg8::Gemm g{XB, (const bf16*)(ws + (kind == 0 ? WT_GU1 : WT_GU2)), M, 2 * FF, D}; pg8::StaticOrder S; S.init(M, 2 * FF, G, bx);
                pg8::EpiSwiGLU E{ACT, FF, ss};
#ifndef NO_G1
                REPN(DUP_G1) { pg8::gemm_phase<pg8::EpiSwiGLU, pg8::StaticOrder, true, true>(lds, g, S, E); RSEAM(DUP_G1); }
#endif
            } else if (even) {
                pg8::Gemm g{XB, (const bf16*)(ws + WT_IN), M, ZN, D}; pg8::StaticOrder S; S.init(M, ZN, G, bx);
                pg8::EpiZ E{ACT, ZN, ss, args.in[I_EBQKV] + li * 1536};
#ifndef NO_GZ
                REPG { pg8::gemm_phase<pg8::EpiZ, pg8::StaticOrder, true, true>(lds, g, S, E); RSEAM(DUP_G); }
#endif
            } else {
                pg8::Gemm g{XB, (const bf16*)(ws + WT_IN), M, ZO, D}; pg8::StaticOrder S; S.init(M, ZO, G, bx);
                pg8::EpiGeluV E{ACT, ZO, ss, ssb + (size_t)(13 + li) * SS_REC, (LAS float*)(lds + 131072)};
#ifndef NO_GG
                REPG { pg8::gemm_phase<pg8::EpiGeluV, pg8::StaticOrder, true, true>(lds, g, S, E); RSEAM(DUP_G); }
#endif
            }
            SEAM(pb + 1);
        }
        if (kind == 1) {
            if (IN(pb + 2)) {
#ifndef NO_E1
                if (even) REPN(DUP_E1) { e1_phase(args, li, lds, vcu, G, opaque(tid)); RSEAM(DUP_E1); }
#endif
#ifndef NO_ATTN
                if (even) for (int au = vcu; au < 1024; au += G) attn_unit(args, li, au, lds, opaque(tid));
#endif
#ifndef NO_SGU
                if (!even) REPN(DUP_SGU) { sgu_phase(args, li, lds, vcu, G, opaque(tid)); RSEAM(DUP_SGU); }
#endif
                SEAM(pb + 2); }
#ifndef NO_SPRE
            if (even && IN(pb + 3)) { REPN(DUP_SP) { scanpre_phase(args, li, lds, vcu, G, opaque(tid)); RSEAM(DUP_SP); } SEAM(pb + 3); }
#endif
#ifndef NO_SSEQ
            if (even && IN(pb + 4)) { REPN(DUP_SQ) { scanseq_phase(args, li, lds, vcu, opaque(tid)); RSEAM(DUP_SQ); } SEAM(pb + 4); }
#endif
#ifndef NO_E3
            if (even && IN(pb + 5)) { REPN(DUP_E3) { e3_phase(args, li, vcu, G, opaque(tid)); RSEAM(DUP_E3); } SEAM(pb + 5); }
#endif
        }
        if (IN(pb + 6)) {
            const bf16* A = (kind == 1) ? OB : ACT; const int K = (kind == 1) ? D : FF;
            const bf16* Bt = (const bf16*)(ws + (kind == 0 ? WT_D1 : kind == 1 ? WT_OUT : WT_D2));
            pg8::Gemm g{A, Bt, M, D, K}; pg8::StaticOrder S; S.init(M, D, G, bx);
            pg8::EpiResid E{s == 0 ? args.in[I_X] : args.out, args.out, XB, ssb + (size_t)(s + 1) * SS_REC, kind == 1 ? 1.0f : 0.5f, (LAS float*)(lds + 131072)};
#ifndef NO_GR
            REPG { if (rep_) { E.base = args.out; E.scale = 0.f; } pg8::gemm_phase<pg8::EpiResid, pg8::StaticOrder, true, true>(lds, g, S, E); RSEAM(DUP_G); }
#endif
            SEAM(pb + 6);
        }
    }
    if (IN(NSUB * 8)) { const int t_ = opaque(tid); final_phase(args, vcu, G, __builtin_amdgcn_readfirstlane(t_ >> 6), t_ & 63); }
#undef IN
#undef SEAM
}

extern "C" void kernel_launch(void* const* d_in, const int* in_sizes, int n_in, void* d_out, int out_size, void* d_ws, size_t ws_size, hipStream_t stream) {
    static int grid = 0;
    if (grid == 0) {
        if (n_in != 29 || out_size != M * D || ws_size < WS_END) { fprintf(stderr, "kernel_launch: unexpected shapes (n_in %d, out %d, ws %zu < %zu); nothing launched\n", n_in, out_size, ws_size, (size_t)WS_END); grid = -1; return; }
        int dev = 0, cus = 0;
        if (hipGetDevice(&dev) != hipSuccess || hipDeviceGetAttribute(&cus, hipDeviceAttributeMultiprocessorCount, dev) != hipSuccess) { grid = -1; return; }
        if (hipFuncSetAttribute((const void*)mk_fwd, hipFuncAttributeMaxDynamicSharedMemorySize, LDS_BYTES) != hipSuccess) { fprintf(stderr, "kernel_launch: hipFuncSetAttribute failed\n"); grid = -1; return; }
        int per_cu = 0;
        if (hipOccupancyMaxActiveBlocksPerMultiprocessor(&per_cu, (const void*)mk_fwd, NTHR, LDS_BYTES) != hipSuccess || per_cu < 1) fprintf(stderr, "kernel_launch: occupancy query says %d\n", per_cu);
        (void)hipGetLastError();
        grid = cus;
    }
    if (grid < 0) return;
    (void)hipMemsetAsync((char*)d_ws + WS_CTL, 0, CTL_ZERO_BYTES, stream);
    Args a{};
    for (int i = 0; i < 29; ++i) a.in[i] = (const float*)d_in[i];
    a.out = (float*)d_out; a.ws = (unsigned char*)d_ws;
#if MK_ONE_LAUNCH
    a.ph_lo = 0; a.ph_hi = NSUB * 8 + 1;
    hipLaunchKernelGGL(mk_fwd, dim3(grid), dim3(NTHR), LDS_BYTES, stream, a);
#else
    for (int s = 0; s <= NSUB; ++s) {
        for (int k = 0; k < (s == NSUB ? 1 : 8); ++k) {
            const int L = s / 3, kind = s % 3; const bool even = !(L & 1);
            bool live;
            if (s == NSUB) live = true;
            else if (k == 0) live = (kind == 0);
            else if (k == 1 || k == 6) live = true;
            else if (k == 2) live = (kind == 1);
            else if (k == 3 || k == 4 || k == 5) live = (kind == 1) && even;
            else live = false;
            if (!live) continue;
            a.ph_lo = s * 8 + k; a.ph_hi = a.ph_lo + 1;
            hipLaunchKernelGGL(mk_fwd, dim3(grid), dim3(NTHR), LDS_BYTES, stream, a);
        }
    }
#endif
}
```

```cpp
#include <hip/hip_runtime.h>
#include <cstdio>
#include <cstdint>
#define MK_ONE_LAUNCH 1
namespace pg8 {
#define PG8_LAS __attribute__((address_space(3)))
typedef unsigned short bf16_t;
typedef short bf16x8 __attribute__((ext_vector_type(8)));
typedef float f32x4 __attribute__((ext_vector_type(4)));
typedef unsigned u32x4 __attribute__((ext_vector_type(4)));
constexpr int BM = 256, BK = 64, HALF = 128, HTB = HALF * BK * 2  , STAGE_BYTES = 8 * HTB, NXCD = 8, WGM = 8;

__host__ __device__ __forceinline__ int lds_byte(int r, int c) { const int st = (r >> 4) * 2 + (c >> 5), rr = r & 15, cc = c & 31, ob = rr * 64 + cc * 2; return st * 1024 + (ob ^ (((ob >> 9) & 1) << 5)); }
__host__ __device__ __forceinline__ void stage_rc(int b, int& R, int& C) { const int st = b / 1024, sb = b % 1024, swz = sb ^ (((sb >> 9) & 1) << 5); R = (st >> 1) * 16 + swz / 64; C = (st & 1) * 32 + (swz % 64) / 2; }
__host__ __device__ __forceinline__ int perm32(int rho) { const int n = rho >> 4, i = rho & 15; return 8 * (i >> 2) + 4 * n + (i & 3); }

struct Unit { int pm, pn; };
struct Gemm { const bf16_t* A; const bf16_t* Bt; int M, N, K; int amode = 0; };

struct StaticOrder {
    int nM, nN, nwg, G, c;
    __host__ __device__ void init(int M, int N, int G_, int c_) { nM = M / BM; nN = N / BM; nwg = nM * nN; G = G_; c = c_; }
    __host__ __device__ bool next(int i, Unit& u) const {
        const long L = (long)i * G + c; if (L >= nwg) return false;
        int wgid = (int)L; { const int q = nwg / NXCD, r = nwg % NXCD, xcd = wgid % NXCD, off = wgid / NXCD; wgid = (xcd < r ? xcd * (q + 1) : r * (q + 1) + (xcd - r) * q) + off; }
        const int nig = WGM * nN, gid = wgid / nig, fm = gid * WGM, gsz = (nM - fm) < WGM ? (nM - fm) : WGM;
        u.pm = fm + ((wgid % nig) % gsz); u.pn = (wgid % nig) / gsz; return true;
    }
    __device__ __forceinline__ void a_ready(const Unit&) const {}
    __device__ __forceinline__ void done(const Unit&) const {}
};
__device__ __forceinline__ unsigned cvt_pk_bf16(float lo, float hi) { unsigned r; asm volatile("v_cvt_pk_bf16_f32 %0, %1, %2" : "=v"(r) : "v"(lo), "v"(hi)); return r; }
typedef float f32x2 __attribute__((ext_vector_type(2)));
__device__ __forceinline__ f32x2 gelu_pk(f32x2 v) {
    const f32x2 av = __builtin_elementwise_abs(v), d = av * 0.2316418882f + 1.0f;
    f32x2 t; t.x = __builtin_amdgcn_rcpf(d.x); t.y = __builtin_amdgcn_rcpf(d.y);
    f32x2 q = t * 0.5307027145f + (-0.7265760135f); q = q * t + 0.7107068705f; q = q * t + (-0.142248368f); q = q * t + 0.127414796f; q = q * t;
    const f32x2 s = (v * v) * (-0.72134752044f);
    f32x2 e; e.x = __builtin_amdgcn_exp2f(s.x); e.y = __builtin_amdgcn_exp2f(s.y);
    const f32x2 m = v * (q * e), r = v - m;
    f32x2 o; o.x = v.x < 0.f ? m.x : r.x; o.y = v.y < 0.f ? m.y : r.y; return o;
}

constexpr int SS_M = 32768;
__device__ __forceinline__ float row_rs(const float* P, int row) {
    const float s = ((P[row] + P[SS_M + row]) + (P[2 * SS_M + row] + P[3 * SS_M + row])) + ((P[4 * SS_M + row] + P[5 * SS_M + row]) + (P[6 * SS_M + row] + P[7 * SS_M + row]));
    return rsqrtf(s * (1.0f / 2048.0f) + 1e-6f);
}
__device__ __forceinline__ void panel_rs(const float* ss, PG8_LAS float* rc, int pm, int t) {
    PG8_LAS int* tag = (PG8_LAS int*)(rc + BM);
    const int have = *tag;
    if (have != pm && t < BM) rc[t] = row_rs(ss, pm * BM + t);
    asm volatile("s_waitcnt lgkmcnt(0)" ::: "memory"); __builtin_amdgcn_s_barrier(); asm volatile("" ::: "memory");
    if (have != pm && t == 0) *tag = pm;
}
struct EpiSwiGLU {
    static constexpr bool PERM = true, AFTER_DRAIN = false;
    bf16_t* O; int ldc; const float* ss; PG8_LAS float* rc;
    __device__ __forceinline__ void operator()(const f32x4 (&acc)[2][2][4][2], const Unit& u, int wr, int wc, int fr, int fq) const {
        const int row0 = u.pm * BM + wr * 64 + fr, col0 = u.pn * HALF + wc * 32 + 8 * fq;
        panel_rs(ss, rc, u.pm, (wr * 4 + wc) * 64 + fq * 16 + fr);
#pragma unroll
        for (int ai = 0; ai < 2; ++ai)
#pragma unroll
            for (int m = 0; m < 4; ++m) {
                const int row = row0 + ai * HALF + m * 16;
                const float rs = rc[row - u.pm * BM];
                float o[8];
#pragma unroll
                for (int n = 0; n < 2; ++n)
#pragma unroll
                    for (int j = 0; j < 4; ++j) { const float g = acc[ai][0][m][n][j] * rs, up = acc[ai][1][m][n][j] * rs; o[4 * n + j] = g * __builtin_amdgcn_rcpf(1.0f + __expf(-g)) * up; }
                u32x4 w; w.x = cvt_pk_bf16(o[0], o[1]); w.y = cvt_pk_bf16(o[2], o[3]); w.z = cvt_pk_bf16(o[4], o[5]); w.w = cvt_pk_bf16(o[6], o[7]);
                *(u32x4*)(O + ((size_t)(u.pm * (ldc >> 6) + (col0 >> 6)) * BM + (row - u.pm * BM)) * BK + (col0 & 63)) = w;
                asm volatile("" ::: "memory");
            }
    }
};
struct EpiResid {
    static constexpr bool PERM = true, AFTER_DRAIN = false;
    bf16_t* xb; float* ssn; float scale; PG8_LAS float* sp;
    int noop = 0;
    __device__ __forceinline__ void operator()(const f32x4 (&acc)[2][2][4][2], const Unit& u, int wr, int wc, int fr, int fq) const {
        const int row0 = u.pm * BM + wr * 64 + fr, col0 = u.pn * BM + wc * 32 + 8 * fq;
        if (noop) return;
        u32x4 bn[2];
#pragma unroll
        for (int bj = 0; bj < 2; ++bj) bn[bj] = *(const u32x4*)(xb + (size_t)row0 * 2048 + col0 + bj * HALF);
#pragma unroll
        for (int gi = 0; gi < 8; ++gi) {
            const int ai = gi >> 2, m = gi & 3;
            const int row = row0 + ai * HALF + m * 16; const size_t off = (size_t)row * 2048 + col0; float s = 0.f;
            u32x4 bc[2]; bc[0] = bn[0]; bc[1] = bn[1];
            if (gi < 7) { const size_t off2 = (size_t)(row0 + ((gi + 1) >> 2) * HALF + ((gi + 1) & 3) * 16) * 2048 + col0;
#pragma unroll
                for (int bj = 0; bj < 2; ++bj) bn[bj] = *(const u32x4*)(xb + off2 + bj * HALF); }
#pragma unroll
            for (int bj = 0; bj < 2; ++bj) {
                const f32x4 a0 = acc[ai][bj][m][0] * scale, a1 = acc[ai][bj][m][1] * scale; const u32x4 b = bc[bj]; u32x4 w;
                w.x = cvt_pk_bf16(__uint_as_float(b.x << 16) + a0[0], __uint_as_float(b.x & 0xffff0000u) + a0[1]);
                w.y = cvt_pk_bf16(__uint_as_float(b.y << 16) + a0[2], __uint_as_float(b.y & 0xffff0000u) + a0[3]);
                w.z = cvt_pk_bf16(__uint_as_float(b.z << 16) + a1[0], __uint_as_float(b.z & 0xffff0000u) + a1[1]);
                w.w = cvt_pk_bf16(__uint_as_float(b.w << 16) + a1[2], __uint_as_float(b.w & 0xffff0000u) + a1[3]);
                *(u32x4*)(xb + off + bj * HALF) = w;
                const float r0 = __uint_as_float(w.x << 16), r1 = __uint_as_float(w.x & 0xffff0000u), r2 = __uint_as_float(w.y << 16), r3 = __uint_as_float(w.y & 0xffff0000u);
                const float r4 = __uint_as_float(w.z << 16), r5 = __uint_as_float(w.z & 0xffff0000u), r6 = __uint_as_float(w.w << 16), r7 = __uint_as_float(w.w & 0xffff0000u);
                s += ((r0 * r0 + r1 * r1) + (r2 * r2 + r3 * r3)) + ((r4 * r4 + r5 * r5) + (r6 * r6 + r7 * r7));
            }
            s += __shfl_xor(s, 16); s += __shfl_xor(s, 32);
            if (fq == 0) sp[(ai * HALF + wr * 64 + m * 16 + fr) * 4 + wc] = s;
            asm volatile("" ::: "memory");
        }
        asm volatile("s_waitcnt lgkmcnt(0)" ::: "memory"); __builtin_amdgcn_s_barrier(); asm volatile("" ::: "memory");
        const int t = (wr * 4 + wc) * 64 + fq * 16 + fr;
        if (t < BM) { const f32x4 p = *(const PG8_LAS f32x4*)(sp + t * 4); ssn[(size_t)u.pn * SS_M + u.pm * BM + t] = (p[0] + p[1]) + (p[2] + p[3]); }
    }
};
struct EpiZ {
    static constexpr bool PERM = true, AFTER_DRAIN = false;
    bf16_t* O; int ldc; const float* ss; const float* bias; PG8_LAS float* rc;
    __device__ __forceinline__ void operator()(const f32x4 (&acc)[2][2][4][2], const Unit& u, int wr, int wc, int fr, int fq) const {
        const int row0 = u.pm * BM + wr * 64 + fr, col0 = u.pn * BM + wc * 32 + 8 * fq;
        panel_rs(ss, rc, u.pm, (wr * 4 + wc) * 64 + fq * 16 + fr);
        const bool hb = u.pn < 6;
        f32x4 bv[2][2];
#pragma unroll
        for (int bj = 0; bj < 2; ++bj)
#pragma unroll
            for (int n = 0; n < 2; ++n) bv[bj][n] = hb ? *(const f32x4*)(bias + col0 + bj * HALF + 4 * n) : (f32x4){0.f, 0.f, 0.f, 0.f};
#pragma unroll
        for (int ai = 0; ai < 2; ++ai)
#pragma unroll
            for (int m = 0; m < 4; ++m) {
                const int row = row0 + ai * HALF + m * 16;
                const float rs = rc[row - u.pm * BM];
                bf16_t* rowp = O + (size_t)row * ldc + col0;
#pragma unroll
                for (int bj = 0; bj < 2; ++bj) {
                    const f32x4 v0 = acc[ai][bj][m][0] * rs + bv[bj][0], v1 = acc[ai][bj][m][1] * rs + bv[bj][1];
                    u32x4 w; w.x = cvt_pk_bf16(v0[0], v0[1]); w.y = cvt_pk_bf16(v0[2], v0[3]); w.z = cvt_pk_bf16(v1[0], v1[1]); w.w = cvt_pk_bf16(v1[2], v1[3]);
                    *(u32x4*)(rowp + bj * HALF) = w;
                }
                asm volatile("" ::: "memory");
            }
    }
};
struct EpiGeluV {
    static constexpr bool PERM = true, AFTER_DRAIN = false;
    bf16_t* O; int ldc; const float* ss; float* ssv; PG8_LAS float* sp; PG8_LAS float* rc;
    __device__ __forceinline__ void operator()(const f32x4 (&acc)[2][2][4][2], const Unit& u, int wr, int wc, int fr, int fq) const {
        const int row0 = u.pm * BM + wr * 64 + fr, col0 = u.pn * BM + wc * 32 + 8 * fq;
        panel_rs(ss, rc, u.pm, (wr * 4 + wc) * 64 + fq * 16 + fr);
        const bool isv = u.pn >= 8;
#pragma unroll
        for (int ai = 0; ai < 2; ++ai)
#pragma unroll
            for (int m = 0; m < 4; ++m) {
                const int row = row0 + ai * HALF + m * 16;
                const float rs = rc[row - u.pm * BM];
                bf16_t* rowp = O + (size_t)row * ldc + col0; float s = 0.f;
#pragma unroll
                for (int bj = 0; bj < 2; ++bj) {
                    f32x4 v0 = acc[ai][bj][m][0] * rs, v1 = acc[ai][bj][m][1] * rs;
                    const f32x2 a = gelu_pk((f32x2){v0[0], v0[1]}), b = gelu_pk((f32x2){v0[2], v0[3]}), c = gelu_pk((f32x2){v1[0], v1[1]}), d = gelu_pk((f32x2){v1[2], v1[3]});
                    s += (a.x * a.x + a.y * a.y) + (b.x * b.x + b.y * b.y) + (c.x * c.x + c.y * c.y) + (d.x * d.x + d.y * d.y);
                    u32x4 w; w.x = cvt_pk_bf16(a.x, a.y); w.y = cvt_pk_bf16(b.x, b.y); w.z = cvt_pk_bf16(c.x, c.y); w.w = cvt_pk_bf16(d.x, d.y);
                    *(u32x4*)(rowp + bj * HALF) = w;
                }
                if (isv) { s += __shfl_xor(s, 16); s += __shfl_xor(s, 32); if (fq == 0) sp[(ai * HALF + wr * 64 + m * 16 + fr) * 4 + wc] = s; }
                asm volatile("" ::: "memory");
            }
        if (isv) {
            asm volatile("s_waitcnt lgkmcnt(0)" ::: "memory"); __builtin_amdgcn_s_barrier(); asm volatile("" ::: "memory");
            const int t = (wr * 4 + wc) * 64 + fq * 16 + fr;
            if (t < BM) { const f32x4 p = *(const PG8_LAS f32x4*)(sp + t * 4); ssv[(size_t)(u.pn - 8) * SS_M + u.pm * BM + t] = (p[0] + p[1]) + (p[2] + p[3]); }
        }
    }
};
template <class Epi, class Sched, bool ALIGN_EPI = false, bool SP2 = false>
__device__ __forceinline__ void gemm_phase(PG8_LAS unsigned char* lds, const Gemm g, const Sched& S, const Epi& E) {
    int tid_ = threadIdx.x; asm volatile("" : "+v"(tid_));
    const int tid = tid_, wid = __builtin_amdgcn_readfirstlane(tid >> 6), lane = tid & 63, wr = wid >> 2, wc = wid & 3, fr = lane & 15, fq = lane >> 4;
    const int K = g.K, nt = K / BK;
    unsigned voffA[2], voffB[2];
#pragma unroll
    for (int i = 0; i < 2; ++i) { int R, C; stage_rc(tid * 16 + i * 8192, R, C); const int Rb = Epi::PERM ? ((R & ~31) + perm32(R & 31)) : R;
        voffA[i] = g.amode ? (unsigned)(R * BK + C) * 2u : (unsigned)(R * K + C) * 2u; voffB[i] = (unsigned)(Rb * K + C) * 2u; }
    const size_t kstep = (size_t)(BK * 2);
    const size_t hstep = (size_t)HALF * K * 2;
    const size_t tstep = 2 * hstep;
    const size_t kstepA = g.amode ? (size_t)(BM * BK * 2) : kstep, hstepA = g.amode ? (size_t)(HALF * BK * 2) : hstep, tstepA = g.amode ? (size_t)(K / BK) * (BM * BK * 2) : tstep;
    const unsigned ldsw = (unsigned)wid * 1024u;
    const int aoff = lds_byte(wr * 64 + fr, fq * 8), boff = lds_byte(wc * 32 + fr, fq * 8);
#define PG8_SA(b, h) (((b) * 2 + (h)) * HTB)
#define PG8_SB(b, h) ((4 + (b) * 2 + (h)) * HTB)
#define PG8_STAGE(bufoff, gbase, voff) do { _Pragma("unroll") for (int _i = 0; _i < 2; ++_i) \
        __builtin_amdgcn_global_load_lds((const unsigned*)((const char*)(gbase) + (voff)[_i]), (PG8_LAS unsigned*)(lds + (bufoff) + ldsw + _i * 8192), 16, 0, 0); } while (0)
#define PG8_LDA(dst, b, h) do { _Pragma("unroll") for (int m = 0; m < 4; ++m) _Pragma("unroll") for (int k = 0; k < 2; ++k) dst[m][k] = *(const PG8_LAS bf16x8*)(lds + PG8_SA(b, h) + aoff + m * 2048 + k * 1024); } while (0)
#define PG8_LDB(dst, b, h) do { _Pragma("unroll") for (int n = 0; n < 2; ++n) _Pragma("unroll") for (int k = 0; k < 2; ++k) dst[n][k] = *(const PG8_LAS bf16x8*)(lds + PG8_SB(b, h) + boff + n * 2048 + k * 1024); } while (0)
#define PG8_MMA(ai, bj, At, Bt) do { __builtin_amdgcn_s_setprio(1); _Pragma("unroll") for (int m = 0; m < 4; ++m) _Pragma("unroll") for (int n = 0; n < 2; ++n) _Pragma("unroll") for (int k = 0; k < 2; ++k) \
        acc[ai][bj][m][n] = __builtin_amdgcn_mfma_f32_16x16x32_bf16(Bt[n][k], At[m][k], acc[ai][bj][m][n], 0, 0, 0); __builtin_amdgcn_s_setprio(0); } while (0)
#define PG8_WAIT_V(n) asm volatile("s_waitcnt vmcnt(" #n ")" ::: "memory")
#define PG8_WAIT_L(n) asm volatile("s_waitcnt lgkmcnt(" #n ")" ::: "memory")
#define PG8_BAR __builtin_amdgcn_s_barrier()
#define PG8_SCHED __builtin_amdgcn_sched_barrier(0)
    Unit cur, nxt; int ui = 0;
    if (!S.next(0, cur)) return;
    f32x4 acc[2][2][4][2];
#pragma unroll
    for (int a = 0; a < 2; ++a)
#pragma unroll
        for (int b = 0; b < 2; ++b)
#pragma unroll
            for (int m = 0; m < 4; ++m)
#pragma unroll
                for (int n = 0; n < 2; ++n) acc[a][b][m][n] = (f32x4){0.f, 0.f, 0.f, 0.f};
    bf16x8 At[4][2], B0[2][2], B1[2][2];
    const char* cA = (const char*)g.A + (size_t)cur.pm * tstepA; const char* cB = (const char*)g.Bt + (size_t)cur.pn * tstep;
    S.a_ready(cur);
    if constexpr (SP2) {
        PG8_STAGE(PG8_SB(0, 0), cB, voffB); PG8_STAGE(PG8_SB(0, 1), cB + hstep, voffB); PG8_STAGE(PG8_SA(0, 0), cA, voffA); PG8_STAGE(PG8_SA(0, 1), cA + hstepA, voffA);
        if (wr == 1) PG8_BAR;
        PG8_WAIT_V(2); PG8_BAR;
        PG8_STAGE(PG8_SB(1, 0), cB + kstep, voffB); PG8_STAGE(PG8_SA(1, 0), cA + kstepA, voffA); PG8_STAGE(PG8_SB(1, 1), cB + hstep + kstep, voffB);
        PG8_WAIT_V(6); PG8_BAR;
    } else {
        PG8_STAGE(PG8_SB(0, 0), cB, voffB); PG8_STAGE(PG8_SA(0, 0), cA, voffA); PG8_STAGE(PG8_SB(0, 1), cB + hstep, voffB); PG8_STAGE(PG8_SA(0, 1), cA + hstepA, voffA);
        if (wr == 1) PG8_BAR;
        PG8_WAIT_V(4); PG8_BAR;
        PG8_STAGE(PG8_SB(1, 0), cB + kstep, voffB); PG8_STAGE(PG8_SA(1, 0), cA + kstepA, voffA); PG8_STAGE(PG8_SB(1, 1), cB + hstep + kstep, voffB);
        PG8_WAIT_V(6); PG8_BAR;
    }
    for (;;) {
        const bool has_next = S.next(ui + 1, nxt);
        const char* nA = has_next ? (const char*)g.A + (size_t)nxt.pm * tstepA : cA; const char* nB = has_next ? (const char*)g.Bt + (size_t)nxt.pn * tstep : cB;
        for (int t = 0; t < nt; t += 2) {
            const bool last = (t == nt - 2);
            const char* a1 = cA + (size_t)(t + 1) * kstepA;
            const char* a2 = last ? nA : cA + (size_t)(t + 2) * kstepA; const char* b2 = last ? nB : cB + (size_t)(t + 2) * kstep;
            const char* a3 = a2 + kstepA; const char* b3 = b2 + kstep;
            if (last && has_next) S.a_ready(nxt);
            if constexpr (SP2) {
            PG8_LDB(B0, 0, 0); PG8_LDB(B1, 0, 1); PG8_SCHED; PG8_LDA(At, 0, 0); PG8_STAGE(PG8_SA(1, 1), a1 + hstepA, voffA);
            PG8_WAIT_V(8); PG8_WAIT_L(0); PG8_BAR; PG8_MMA(0, 0, At, B0); PG8_MMA(0, 1, At, B1); PG8_BAR; PG8_SCHED;
            PG8_LDA(At, 0, 1); PG8_STAGE(PG8_SB(0, 0), b2, voffB); PG8_STAGE(PG8_SB(0, 1), b2 + hstep, voffB); PG8_STAGE(PG8_SA(0, 0), a2, voffA);
            PG8_WAIT_V(8); PG8_WAIT_L(0); PG8_BAR; PG8_MMA(1, 0, At, B0); PG8_MMA(1, 1, At, B1); PG8_BAR; PG8_SCHED;
            PG8_LDB(B0, 1, 0); PG8_LDB(B1, 1, 1); PG8_SCHED; PG8_LDA(At, 1, 0); PG8_STAGE(PG8_SA(0, 1), a2 + hstepA, voffA);
            PG8_WAIT_V(8); PG8_WAIT_L(0); PG8_BAR; PG8_MMA(0, 0, At, B0); PG8_MMA(0, 1, At, B1); PG8_BAR; PG8_SCHED;
            PG8_LDA(At, 1, 1); PG8_STAGE(PG8_SB(1, 0), b3, voffB); PG8_STAGE(PG8_SB(1, 1), b3 + hstep, voffB); PG8_STAGE(PG8_SA(1, 0), a3, voffA);
            PG8_WAIT_V(8); PG8_WAIT_L(0); PG8_BAR; PG8_MMA(1, 0, At, B0); PG8_MMA(1, 1, At, B1); PG8_BAR; PG8_SCHED;
            } else {
            PG8_LDB(B0, 0, 0); PG8_SCHED; PG8_LDA(At, 0, 0); PG8_STAGE(PG8_SA(1, 1), a1 + hstepA, voffA);
            PG8_WAIT_L(8); PG8_BAR; PG8_WAIT_L(0); PG8_MMA(0, 0, At, B0); PG8_BAR; PG8_SCHED;
            PG8_LDB(B1, 0, 1); PG8_STAGE(PG8_SB(0, 0), b2, voffB);
            PG8_BAR; PG8_WAIT_L(0); PG8_MMA(0, 1, At, B1); PG8_BAR;
            PG8_LDA(At, 0, 1); PG8_STAGE(PG8_SA(0, 0), a2, voffA);
            PG8_BAR; PG8_WAIT_L(0); PG8_MMA(1, 0, At, B0); PG8_BAR; PG8_SCHED;
            PG8_STAGE(PG8_SB(0, 1), b2 + hstep, voffB);
            PG8_WAIT_V(6); PG8_BAR; PG8_MMA(1, 1, At, B1); PG8_BAR;
            PG8_LDB(B0, 1, 0); PG8_SCHED; PG8_LDA(At, 1, 0); PG8_STAGE(PG8_SA(0, 1), a2 + hstepA, voffA);
            PG8_WAIT_L(8); PG8_BAR; PG8_WAIT_L(0); PG8_MMA(0, 0, At, B0); PG8_BAR; PG8_SCHED;
            PG8_LDB(B1, 1, 1); PG8_STAGE(PG8_SB(1, 0), b3, voffB);
            PG8_BAR; PG8_WAIT_L(0); PG8_MMA(0, 1, At, B1); PG8_BAR;
            PG8_LDA(At, 1, 1); PG8_STAGE(PG8_SA(1, 0), a3, voffA);
            PG8_BAR; PG8_WAIT_L(0); PG8_MMA(1, 0, At, B0); PG8_BAR; PG8_SCHED;
            PG8_STAGE(PG8_SB(1, 1), b3 + hstep, voffB);
            PG8_WAIT_V(6); PG8_BAR; PG8_MMA(1, 1, At, B1); PG8_BAR;
            }
        }
        if constexpr (ALIGN_EPI) { if (wr == 0) PG8_BAR; }
        if constexpr (!Epi::AFTER_DRAIN) { E(acc, cur, wr, wc, fr, fq); S.done(cur); }
        if (!has_next) break;
#pragma unroll
        for (int a = 0; a < 2; ++a)
#pragma unroll
            for (int b = 0; b < 2; ++b)
#pragma unroll
                for (int m = 0; m < 4; ++m)
#pragma unroll
                    for (int n = 0; n < 2; ++n) acc[a][b][m][n] = (f32x4){0.f, 0.f, 0.f, 0.f};
        cur = nxt; cA = nA; cB = nB; ++ui;
        if constexpr (ALIGN_EPI) { if (wr == 1) PG8_BAR; }
    }
    PG8_WAIT_V(0);
    if constexpr (!ALIGN_EPI) { if (wr == 0) PG8_BAR; }
    PG8_BAR;
    if constexpr (Epi::AFTER_DRAIN) { E.fused(acc, cur, wr, wc, fr, fq, lds, wid, lane); S.done(cur); }
#undef PG8_SA
#undef PG8_SB
#undef PG8_STAGE
#undef PG8_LDA
#undef PG8_LDB
#undef PG8_MMA
#undef PG8_WAIT_V
#undef PG8_WAIT_L
#undef PG8_BAR
#undef PG8_SCHED
}
}
#define LAS_BAR __attribute__((address_space(3)))
#define XB_TMO      128
#define XB_XCNT(j)  (256  + 64 * (j))
#define XB_XSUB(j)  (1280 + 64 * (j))
#define XB_XGEN(j)  (2304 + 64 * (j))
#define XB_TOP      3328
#define XB_TOPGEN   3392
#define XCD_BAR_WORDS 3456
#define XB_SPIN_CAP (1u << 22)

__device__ __forceinline__ unsigned xb_ld(unsigned* p)              { return __hip_atomic_load(p, __ATOMIC_RELAXED, __HIP_MEMORY_SCOPE_AGENT); }
__device__ __forceinline__ unsigned xb_add(unsigned* p, unsigned v) { return __hip_atomic_fetch_add(p, v, __ATOMIC_RELAXED, __HIP_MEMORY_SCOPE_AGENT); }
__device__ __forceinline__ unsigned xb_xcc_id() { return (unsigned)__builtin_amdgcn_s_getreg((3 << 11) | 20) & 0xFu; }
#define XB_SPIN(cond, bar) do { unsigned _sp = 0; while (cond) { __builtin_amdgcn_s_sleep(1); \
    if ((++_sp & 255u) == 0u) { if (xb_ld(&(bar)[XB_TMO])) break; if (_sp > XB_SPIN_CAP) { atomicAdd(&(bar)[XB_TMO], 1u); break; } } } } while (0)

struct XcdBarrier {
    unsigned* bar; unsigned x;
    volatile LAS_BAR unsigned* st;
};

__device__ __forceinline__ XcdBarrier xcd_barrier_post(unsigned* bar, volatile LAS_BAR unsigned* st) {
    XcdBarrier b; b.bar = bar; b.x = xb_xcc_id(); b.st = st;
    if (threadIdx.x == 0) (void)xb_add(&bar[XB_XCNT(b.x)], 1u);
    return b;
}
__device__ __forceinline__ void xcd_barrier_complete(unsigned* bar, unsigned x, unsigned& nloc, unsigned& nx) {
    const unsigned G = gridDim.x * gridDim.y * gridDim.z;
    unsigned sum, cnt, mine, sp = 0u;
    for (;;) {
        sum = 0u; cnt = 0u; mine = 0u;
#pragma unroll
        for (unsigned j = 0; j < 16; ++j) { const unsigned c = xb_ld(&bar[XB_XCNT(j)]); sum += c; cnt += (c > 0u) ? 1u : 0u; mine = (j == x) ? c : mine; }
        if (sum == G) break;
        __builtin_amdgcn_s_sleep(1);
        if ((++sp & 255u) == 0u) { if (xb_ld(&bar[XB_TMO])) break; if (sp > XB_SPIN_CAP) { atomicAdd(&bar[XB_TMO], 1u); break; } }
    }
    nloc = mine > 0u ? mine : 1u; nx = cnt > 0u ? cnt : 1u;
}

__device__ __forceinline__ void xcd_barrier(const XcdBarrier& b) {
    asm volatile("s_waitcnt vmcnt(0)" ::: "memory");
    __syncthreads();
    if (threadIdx.x == 0) {
        unsigned* bar = b.bar;
        __builtin_amdgcn_s_waitcnt(0);
        unsigned nloc = b.st[0], nx = b.st[1];
        if (nloc == 0u) { xcd_barrier_complete(bar, b.x, nloc, nx); b.st[0] = nloc; b.st[1] = nx; }
        const unsigned old = xb_add(&bar[XB_XSUB(b.x)], 1u);
        const unsigned gen = old / nloc;
        if (old + 1u == (gen + 1u) * nloc) {
            __builtin_amdgcn_fence(__ATOMIC_RELEASE, "agent");
            asm volatile("s_waitcnt vmcnt(0)" ::: "memory");
            const unsigned og = xb_add(&bar[XB_TOP], 1u);
            const unsigned tg = og / nx;
            if (og + 1u == (tg + 1u) * nx) xb_add(&bar[XB_TOPGEN], 1u);
            else XB_SPIN(xb_ld(&bar[XB_TOPGEN]) == tg, bar);
            __builtin_amdgcn_fence(__ATOMIC_ACQUIRE, "agent");
            xb_add(&bar[XB_XGEN(b.x)], 1u);
            asm volatile("s_waitcnt vmcnt(0)" ::: "memory");
        } else {
            XB_SPIN(xb_ld(&bar[XB_XGEN(b.x)]) == gen, bar);
            __builtin_amdgcn_fence(__ATOMIC_ACQUIRE, "agent");
            asm volatile("s_waitcnt vmcnt(0)" ::: "memory");
        }
    }
    __syncthreads();
}

constexpr int NWAVES = 8, NTHR = 512;
constexpr int BATCH = 2, T = 16384, D = 2048, FF = 5632, M = BATCH * T;
constexpr int ZN = 5120;
constexpr int ZA = 1536;
constexpr int A_COLS = 3360, E_IN = 4896;
constexpr int ZO = 4096;
constexpr int NSUB = 12;
#ifndef MK_ONE_LAUNCH
#define MK_ONE_LAUNCH 0
#endif

constexpr size_t MiB = 1u << 20;
constexpr size_t WS_CTL = 0, CTL_ZERO_BYTES = 1 * MiB;
constexpr size_t WS_SS = 1 * MiB;
constexpr size_t SS_REC = 8 * (size_t)M;
constexpr size_t WS_WT = 16 * MiB;
constexpr size_t WT_GU1 = WS_WT, WT_D1 = WT_GU1 + 44 * MiB, WT_GU2 = WT_D1 + 22 * MiB, WT_D2 = WT_GU2 + 44 * MiB, WT_IN = WT_D2 + 22 * MiB, WT_OUT = WT_IN + 20 * MiB;
constexpr size_t WS_XB = WT_OUT + 8 * MiB;
constexpr size_t WS_ACT = WS_XB + 128 * MiB;
constexpr size_t WS_SC = WS_ACT + 352 * MiB;
constexpr size_t SC_R = WS_SC, SC_K2 = SC_R + 64 * MiB, SC_KK = SC_K2 + 64 * MiB, SC_BB = SC_KK + 64 * MiB, SC_LW = SC_BB + 64 * MiB, SC_GG = SC_LW + 64 * MiB;
constexpr size_t WS_VF = SC_GG + 64 * MiB;
constexpr size_t WS_V2 = WS_VF + 64 * MiB;
constexpr size_t WS_O = WS_V2 + 64 * MiB;
constexpr size_t WS_SM = WS_O + 128 * MiB;
constexpr size_t SM_W2T = WS_SM, SM_A2T = SM_W2T + 131072, SM_G2T = SM_A2T + 131072, SM_V1T = SM_G2T + 327680, SM_V2T = SM_V1T + 65536, SM_WSB = SM_V2T + 65536;
constexpr size_t WS_U0 = WS_SM + 2 * MiB;
constexpr size_t WS_END = WS_U0 + 64 * MiB;
static_assert(SM_WSB + 524288 <= WS_END, "small-weight map");
static_assert(WT_OUT + 8 * MiB == 176 * MiB && WS_SS + 15 * MiB <= WS_WT, "weight map");
constexpr int CW_TMO = 0, CW_CODE = 1, CW_BAR = 4096;

constexpr int LDS_BYTES = 147456, LDSCTL_OFF = LDS_BYTES - 512;

#define GAS __attribute__((address_space(1)))
#define LAS __attribute__((address_space(3)))
typedef unsigned short bf16;
typedef unsigned v4u __attribute__((ext_vector_type(4)));
typedef unsigned v2u __attribute__((ext_vector_type(2)));
typedef float f32x4 __attribute__((ext_vector_type(4)));
typedef float f32x2 __attribute__((ext_vector_type(2)));
typedef GAS unsigned gu32;
#define RLX_AGENT __ATOMIC_RELAXED, __HIP_MEMORY_SCOPE_AGENT
#define LDS_WAIT() asm volatile("s_waitcnt lgkmcnt(0)" ::: "memory")
__device__ __forceinline__ unsigned f2bf(float f) { unsigned u = __builtin_bit_cast(unsigned, f); return (u + 0x7fffu + ((u >> 16) & 1u)) >> 16; }
typedef __bf16 bf16x2_hw __attribute__((ext_vector_type(2)));
__device__ __forceinline__ unsigned pk2(float lo, float hi) { const bf16x2_hw b = __builtin_convertvector((f32x2){lo, hi}, bf16x2_hw); return __builtin_bit_cast(unsigned, b); }
__device__ __forceinline__ float bf2f(bf16 b) { return __builtin_bit_cast(float, (unsigned)b << 16); }
__device__ __forceinline__ float bflo(unsigned w) { return __builtin_bit_cast(float, w << 16); }
__device__ __forceinline__ float bfhi(unsigned w) { return __builtin_bit_cast(float, w & 0xffff0000u); }
__device__ __forceinline__ float wave_sum(float v) {
#pragma unroll
    for (int o = 1; o < 64; o <<= 1) v += __shfl_xor(v, o);
    return v;
}
template <int CTRL> __device__ __forceinline__ float dpp_mov(float v) { return __builtin_bit_cast(float, __builtin_amdgcn_update_dpp(0, __builtin_bit_cast(int, v), CTRL, 0xf, 0xf, true)); }
__device__ __forceinline__ float row16_sum(float v) { v += dpp_mov<0xB1>(v); v += dpp_mov<0x4E>(v); v += dpp_mov<0x141>(v); v += dpp_mov<0x140>(v); return v; }
__device__ __forceinline__ float sigmoidf_(float x) { return 1.0f / (1.0f + __expf(-x)); }

__device__ __forceinline__ int opaque(int v) { asm volatile("" : "+v"(v)); return v; }
struct Args { const float* in[29]; float* out; unsigned char* ws; int ph_lo, ph_hi; };
static_assert(sizeof(Args) == 29 * 8 + 8 + 8 + 8, "Args has no padding");
enum { I_X = 0, I_NG, I_WG, I_WU, I_WD, I_EWIN, I_EBQKV, I_EMU, I_EW0, I_EW2, I_EA0, I_EA2, I_EG2, I_EKK, I_EKA, I_ERK, I_EGNG, I_EGNB, I_ESINK, I_EWOUT, I_V0, I_V1, I_V2, I_OWIN, I_OVNG, I_OWS, I_OBS, I_OWOUT, I_FG };

struct TrDesc { const float* W; const float* gk; bf16* WT; int ldw, k0, c0, K, drow0; bool zero; };
__device__ __forceinline__ void tr_load(const TrDesc& d, float (&v)[32], int lane) {
#pragma unroll
    for (int i = 0; i < 32; ++i) { const int kk = 2 * i + (lane >> 5); v[i] = d.zero ? 0.f : d.W[(size_t)(d.k0 + kk) * d.ldw + d.c0 + (lane & 31)]; }
}
__device__ __forceinline__ void tr_store(const TrDesc& d, const float (&v)[32], LAS float* scr, int lane) {
#pragma unroll
    for (int i = 0; i < 32; ++i) { const int kk = 2 * i + (lane >> 5); float x = v[i]; if (d.gk) x *= d.gk[d.k0 + kk]; scr[kk * 33 + (lane & 31)] = x; }
    LDS_WAIT(); asm volatile("" ::: "memory");
    const int c = lane & 7;
#pragma unroll
    for (int j = 0; j < 4; ++j) { const int n = (lane >> 3) + 8 * j; const LAS float* s = scr + (8 * c) * 33 + n;
        v4u o; o.x = pk2(s[0 * 33], s[1 * 33]); o.y = pk2(s[2 * 33], s[3 * 33]); o.z = pk2(s[4 * 33], s[5 * 33]); o.w = pk2(s[6 * 33], s[7 * 33]);
        *(GAS v4u*)(d.WT + (size_t)(d.drow0 + n) * d.K + d.k0 + 8 * c) = o; }
    LDS_WAIT(); asm volatile("" ::: "memory");
}
__device__ __forceinline__ TrDesc tr_desc(const Args& a, int L, int it) {
    unsigned char* ws = a.ws; const bool even = !(L & 1); const int li = L >> 1;
    constexpr int nGU = 32 * 352, nD = 88 * 64; const int nIN = 32 * (even ? 160 : 128);
    TrDesc d; d.zero = false; int r = it;
    if (r < 2 * nGU) { const int f = r / nGU; r -= f * nGU; const int kb = r / 352, rb = r % 352, tj = rb >> 3, sub = rb & 7;
        d.W = (sub < 4 ? a.in[I_WG] : a.in[I_WU]) + (size_t)(L * 2 + f) * D * FF; d.ldw = FF; d.k0 = 64 * kb; d.c0 = 128 * tj + 32 * (sub & 3); d.gk = a.in[I_NG] + (L * 3 + (f ? 2 : 0)) * D;
        d.WT = (bf16*)(ws + (f ? WT_GU2 : WT_GU1)); d.K = D; d.drow0 = 32 * rb; return d; }
    r -= 2 * nGU;
    if (r < 2 * nD) { const int f = r / nD; r -= f * nD; const int kb = r / 64, nb = r % 64;
        d.W = a.in[I_WD] + (size_t)(L * 2 + f) * FF * D; d.ldw = D; d.k0 = 64 * kb; d.c0 = 32 * nb; d.gk = nullptr; d.WT = (bf16*)(ws + (f ? WT_D2 : WT_D1)); d.K = FF; d.drow0 = 32 * nb; return d; }
    r -= 2 * nD;
    if (r < nIN) {
        d.gk = a.in[I_NG] + (L * 3 + 1) * D; d.WT = (bf16*)(ws + WT_IN); d.K = D;
        if (even) { const int kb = r / 160, rb = r % 160, dd = 32 * rb; d.zero = dd >= E_IN; d.W = a.in[I_EWIN] + (size_t)li * D * E_IN; d.ldw = E_IN; d.k0 = 64 * kb; d.c0 = d.zero ? 0 : (dd < ZA ? A_COLS + dd : dd - ZA); d.drow0 = dd; }
        else { const int kb = r / 128, rb = r % 128; d.W = a.in[I_OWIN] + (size_t)li * D * ZO; d.ldw = ZO; d.k0 = 64 * kb; d.c0 = 32 * rb; d.drow0 = 32 * rb; }
        return d; }
    r -= nIN;
    { const int kb = r / 64, nb = r % 64; d.W = (even ? a.in[I_EWOUT] : a.in[I_OWOUT]) + (size_t)li * D * D; d.ldw = D; d.k0 = 64 * kb; d.c0 = 32 * nb; d.gk = nullptr; d.WT = (bf16*)(ws + WT_OUT); d.K = D; d.drow0 = 32 * nb; }
    return d;
}
__device__ __forceinline__ void prep_phase(const Args& a, int L, LAS unsigned char* lds, int vcu, int G, int wave, int lane) {
    asm volatile("" : "+s"(G));
    LAS float* scr = (LAS float*)(lds + wave * 16384);
    const int gw = vcu * NWAVES + wave, NGW = G * NWAVES;
    unsigned char* ws = a.ws;
    const bool even = !(L & 1); const int li = L >> 1;
    const int total = 2 * (32 * 352) + 2 * (88 * 64) + 32 * (even ? 160 : 128) + 32 * 64;
    if (gw < total) {
        TrDesc d0 = tr_desc(a, L, gw); float v0[32]; tr_load(d0, v0, lane);
        for (int it = gw; it < total; it += NGW) {
            const int itn = it + NGW; const bool hasn = itn < total;
            TrDesc d1 = tr_desc(a, L, hasn ? itn : it); float v1[32];
            if (hasn) tr_load(d1, v1, lane);
            tr_store(d0, v0, scr, lane);
            d0 = d1;
#pragma unroll
            for (int i = 0; i < 32; ++i) v0[i] = v1[i];
        }
    }
    {
        const int gt = gw * 64 + lane, NGT = NGW * 64;
        if (even) {
            const float* w2 = a.in[I_EW2] + (size_t)li * 64 * 1024; const float* a2 = a.in[I_EA2] + (size_t)li * 64 * 1024; const float* g2 = a.in[I_EG2] + (size_t)li * 160 * 1024;
            bf16* W2T = (bf16*)(ws + SM_W2T); bf16* A2T = (bf16*)(ws + SM_A2T); bf16* G2T = (bf16*)(ws + SM_G2T);
            for (int e = gt; e < 1024 * 64; e += NGT) { const int k = e >> 10, c = e & 1023; W2T[c * 64 + k] = (bf16)f2bf(w2[e]); A2T[c * 64 + k] = (bf16)f2bf(a2[e]); }
            for (int e = gt; e < 1024 * 160; e += NGT) { const int k = e >> 10, c = e & 1023; G2T[c * 160 + k] = (bf16)f2bf(g2[e]); }
            if (li > 0) { bf16* V1T = (bf16*)(ws + SM_V1T); bf16* V2T = (bf16*)(ws + SM_V2T);
                for (int e = gt; e < 1024 * 32; e += NGT) { const int c = e >> 5, j = e & 31; V1T[j * 1024 + c] = (bf16)f2bf(a.in[I_V1][e]); }
                for (int e = gt; e < 32 * 1024; e += NGT) { const int j = e >> 10, c = e & 1023; V2T[c * 32 + j] = (bf16)f2bf(a.in[I_V2][e]); } }
        } else {
            const float* wsg = a.in[I_OWS] + (size_t)li * 16 * 128 * 128; bf16* WSB = (bf16*)(ws + SM_WSB);
            for (int e = gt; e < 16 * 128 * 128; e += NGT) { const int i = (e >> 7) & 127, j = e & 127; WSB[e] = (bf16)f2bf(j <= i ? wsg[e] : 0.f); }
        }
    }
    if (L == 0) {
        float* ss0 = (float*)(ws + WS_SS); bf16* XB = (bf16*)(ws + WS_XB);
        for (int m = gw; m < M; m += NGW) {
            const GAS f32x4* xr = (const GAS f32x4*)(a.in[I_X] + (size_t)m * D) + lane; GAS v2u* o = (GAS v2u*)(XB + (size_t)m * D) + lane; float s = 0.f;
#pragma unroll
            for (int j = 0; j < 8; ++j) { const f32x4 v = xr[64 * j]; s += (v.x * v.x + v.y * v.y) + (v.z * v.z + v.w * v.w); v2u w; w.x = pk2(v.x, v.y); w.y = pk2(v.z, v.w); o[64 * j] = w; }
            s = wave_sum(s); if (lane < 8) ss0[(size_t)lane * M + m] = lane ? 0.f : s;
        }
    }
}

typedef short bf16x8_t __attribute__((ext_vector_type(8)));
__device__ __forceinline__ float fast_tanh(float x) { const float e = __expf(2.0f * x); return 1.0f - 2.0f / (1.0f + e); }
__device__ __forceinline__ void lerp8(const v4u c, const v4u p, const float* mu, float (&o)[8]) {
    const f32x4 m0 = *(const f32x4*)mu, m1 = *(const f32x4*)(mu + 4);
    const float c0 = bflo(c.x), c1 = bfhi(c.x), c2 = bflo(c.y), c3 = bfhi(c.y), c4 = bflo(c.z), c5 = bfhi(c.z), c6 = bflo(c.w), c7 = bfhi(c.w);
    o[0] = c0 + (bflo(p.x) - c0) * m0.x; o[1] = c1 + (bfhi(p.x) - c1) * m0.y; o[2] = c2 + (bflo(p.y) - c2) * m0.z; o[3] = c3 + (bfhi(p.y) - c3) * m0.w;
    o[4] = c4 + (bflo(p.z) - c4) * m1.x; o[5] = c5 + (bfhi(p.z) - c5) * m1.y; o[6] = c6 + (bflo(p.w) - c6) * m1.z; o[7] = c7 + (bfhi(p.w) - c7) * m1.w;
}
__device__ __forceinline__ void lerp4(const v2u c, const v2u p, const f32x4 m, float (&o)[4]) {
    const float c0 = bflo(c.x), c1 = bfhi(c.x), c2 = bflo(c.y), c3 = bfhi(c.y);
    o[0] = c0 + (bflo(p.x) - c0) * m.x; o[1] = c1 + (bfhi(p.x) - c1) * m.y; o[2] = c2 + (bflo(p.y) - c2) * m.z; o[3] = c3 + (bfhi(p.y) - c3) * m.w;
}
__device__ __forceinline__ v2u pack4(float a, float b, float c, float d) { v2u w; w.x = pk2(a, b); w.y = pk2(c, d); return w; }
constexpr int E1_AW = 0, E1_AA = 9216, E1_AG = 18432, E1_PP = 40960, E1_PB = 106496;
__device__ __forceinline__ void e1_phase(const Args& a, int li, LAS unsigned char* ldsb, int vcu, int G, int tid) {
    unsigned char* ws = a.ws;
    const bf16* Z = (const bf16*)(ws + WS_ACT);
    bf16* R = (bf16*)(ws + SC_R); bf16* K2 = (bf16*)(ws + SC_K2); bf16* KK = (bf16*)(ws + SC_KK); bf16* BB = (bf16*)(ws + SC_BB); bf16* LW = (bf16*)(ws + SC_LW); bf16* GG = (bf16*)(ws + SC_GG);
    bf16* VO = (bf16*)(ws + (li ? WS_V2 : WS_VF)); const bf16* VF = (const bf16*)(ws + WS_VF);
    const bf16* W2T = (const bf16*)(ws + SM_W2T); const bf16* A2T = (const bf16*)(ws + SM_A2T); const bf16* G2T = (const bf16*)(ws + SM_G2T);
    const bf16* V1T = (const bf16*)(ws + SM_V1T); const bf16* V2T = (const bf16*)(ws + SM_V2T);
    const float* mu = a.in[I_EMU] + li * A_COLS;
    const float* w0 = a.in[I_EW0] + li * 1024; const float* a0 = a.in[I_EA0] + li * 1024;
    const float* kkw = a.in[I_EKK] + li * 1024; const float* kaw = a.in[I_EKA] + li * 1024; const float* v0w = a.in[I_V0];
    const int lane = tid & 63, wave = tid >> 6, fr = lane & 15, fq = lane >> 4;
    for (int unit = vcu; unit < M / 64; unit += G) {
        const int m0 = unit * 64;
        for (int e = tid; e < 64 * 36; e += NTHR) { const int r = e / 36, ch = e % 36, j0 = 8 * ch, m = m0 + r; const bool first = (m & (T - 1)) == 0;
            const v4u cur = *(const GAS v4u*)(Z + (size_t)m * ZN + ZA + 3072 + j0); v4u prv = {0u, 0u, 0u, 0u}; if (!first) prv = *(const GAS v4u*)(Z + (size_t)(m - 1) * ZN + ZA + 3072 + j0);
            float x[8]; lerp8(cur, prv, mu + 3072 + j0, x);
            if (j0 < 64) {
#pragma unroll
                for (int i = 0; i < 8; ++i) x[i] = fast_tanh(x[i]);
            } else if (j0 >= 128) {
#pragma unroll
                for (int i = 0; i < 8; ++i) x[i] = sigmoidf_(x[i]);
            }
            v4u o; o.x = pk2(x[0], x[1]); o.y = pk2(x[2], x[3]); o.z = pk2(x[4], x[5]); o.w = pk2(x[6], x[7]);
            LAS unsigned char* dst = j0 < 64 ? ldsb + E1_AW + r * 144 + j0 * 2 : j0 < 128 ? ldsb + E1_AA + r * 144 + (j0 - 64) * 2 : ldsb + E1_AG + r * 336 + (j0 - 128) * 2;
            *(LAS v4u*)dst = o; }
        if (li > 0) {
            f32x4 pacc[4][2];
#pragma unroll
            for (int mt = 0; mt < 4; ++mt) { pacc[mt][0] = (f32x4){0.f, 0.f, 0.f, 0.f}; pacc[mt][1] = pacc[mt][0]; }
            for (int ks = 0; ks < 4; ++ks) { const int c = 128 * wave + 32 * ks + 8 * fq;
                const bf16x8_t w0f = *(const GAS bf16x8_t*)(V1T + (size_t)fr * 1024 + c), w1f = *(const GAS bf16x8_t*)(V1T + (size_t)(16 + fr) * 1024 + c);
#pragma unroll
                for (int mt = 0; mt < 4; ++mt) { const int m = m0 + 16 * mt + fr; const bool first = (m & (T - 1)) == 0;
                    const v4u cur = *(const GAS v4u*)(Z + (size_t)m * ZN + ZA + 2048 + c); v4u prv = {0u, 0u, 0u, 0u}; if (!first) prv = *(const GAS v4u*)(Z + (size_t)(m - 1) * ZN + ZA + 2048 + c);
                    float x[8]; lerp8(cur, prv, mu + 2048 + c, x);
                    v4u o; o.x = pk2(x[0], x[1]); o.y = pk2(x[2], x[3]); o.z = pk2(x[4], x[5]); o.w = pk2(x[6], x[7]);
                    const bf16x8_t af = __builtin_bit_cast(bf16x8_t, o);
                    pacc[mt][0] = __builtin_amdgcn_mfma_f32_16x16x32_bf16(w0f, af, pacc[mt][0], 0, 0, 0); pacc[mt][1] = __builtin_amdgcn_mfma_f32_16x16x32_bf16(w1f, af, pacc[mt][1], 0, 0, 0); } }
#pragma unroll
            for (int mt = 0; mt < 4; ++mt)
#pragma unroll
                for (int nt = 0; nt < 2; ++nt) *(LAS f32x4*)(ldsb + E1_PP + ((wave * 64 + 16 * mt + fr) * 32 + 16 * nt + 4 * fq) * 4) = pacc[mt][nt];
        }
        __syncthreads();
        if (li > 0) {
            for (int e = tid; e < 64 * 32; e += NTHR) { float sum = 0.f;
#pragma unroll
                for (int w = 0; w < 8; ++w) sum += *(const LAS float*)(ldsb + E1_PP + (w * 2048 + e) * 4);
                *(LAS bf16*)(ldsb + E1_PB + (e >> 5) * 80 + (e & 31) * 2) = (bf16)f2bf(sum); }
            __syncthreads();
        }
#pragma unroll 1
        for (int hh = 0; hh < 2; ++hh) {
            const int cb = 128 * wave + 64 * hh;
            {
                bf16x8_t wa[4][2];
#pragma unroll
                for (int nt = 0; nt < 4; ++nt)
#pragma unroll
                    for (int ks = 0; ks < 2; ++ks) wa[nt][ks] = *(const GAS bf16x8_t*)(A2T + (size_t)(cb + 16 * nt + fr) * 64 + 32 * ks + 8 * fq);
#pragma unroll 1
                for (int mt = 0; mt < 4; ++mt) {
                    const int m = m0 + 16 * mt + fr; const bool first = (m & (T - 1)) == 0;
                    f32x4 aa[4];
#pragma unroll
                    for (int nt = 0; nt < 4; ++nt) aa[nt] = (f32x4){0.f, 0.f, 0.f, 0.f};
#pragma unroll
                    for (int ks = 0; ks < 2; ++ks) { const bf16x8_t fa = *(const LAS bf16x8_t*)(ldsb + E1_AA + (16 * mt + fr) * 144 + (32 * ks + 8 * fq) * 2);
#pragma unroll
                        for (int nt = 0; nt < 4; ++nt) aa[nt] = __builtin_amdgcn_mfma_f32_16x16x32_bf16(wa[nt][ks], fa, aa[nt], 0, 0, 0); }
                    const size_t zo = (size_t)m * ZN + ZA + cb + 4 * fq;
                    float k1[4][4], av[4][4], kk0[4][4]; float n2 = 0.f;
#pragma unroll
                    for (int nt = 0; nt < 4; ++nt) { const int c = cb + 16 * nt + 4 * fq;
                        const v2u cur = *(const GAS v2u*)(Z + zo + 1024 + 16 * nt); v2u prv = {0u, 0u}; if (!first) prv = *(const GAS v2u*)(Z + zo - ZN + 1024 + 16 * nt);
                        lerp4(cur, prv, *(const f32x4*)(mu + 1024 + c), k1[nt]);
                        const f32x4 a0v = *(const f32x4*)(a0 + c), kkv = *(const f32x4*)(kkw + c);
#pragma unroll
                        for (int j = 0; j < 4; ++j) { av[nt][j] = sigmoidf_(a0v[j] + aa[nt][j]); kk0[nt][j] = k1[nt][j] * kkv[j]; n2 += kk0[nt][j] * kk0[nt][j]; } }
                    n2 += __shfl_xor(n2, 16); n2 += __shfl_xor(n2, 32);
                    const float inv = 1.0f / fmaxf(sqrtf(n2), 1e-12f);
#pragma unroll
                    for (int nt = 0; nt < 4; ++nt) { const int c = cb + 16 * nt + 4 * fq; const size_t o = (size_t)m * 1024 + c; const f32x4 kav = *(const f32x4*)(kaw + c);
                        float kk[4], k2[4], bb[4];
#pragma unroll
                        for (int j = 0; j < 4; ++j) { kk[j] = kk0[nt][j] * inv; k2[j] = k1[nt][j] * (1.0f + (av[nt][j] - 1.0f) * kav[j]); bb[j] = kk[j] * av[nt][j]; }
                        *(GAS v2u*)(KK + o) = pack4(kk[0], kk[1], kk[2], kk[3]); *(GAS v2u*)(K2 + o) = pack4(k2[0], k2[1], k2[2], k2[3]); *(GAS v2u*)(BB + o) = pack4(bb[0], bb[1], bb[2], bb[3]); }
                }
            }
            {
                bf16x8_t ww[4][2];
#pragma unroll
                for (int nt = 0; nt < 4; ++nt)
#pragma unroll
                    for (int ks = 0; ks < 2; ++ks) ww[nt][ks] = *(const GAS bf16x8_t*)(W2T + (size_t)(cb + 16 * nt + fr) * 64 + 32 * ks + 8 * fq);
#pragma unroll 1
                for (int mt = 0; mt < 4; ++mt) {
                    const int m = m0 + 16 * mt + fr;
                    f32x4 aw[4];
#pragma unroll
                    for (int nt = 0; nt < 4; ++nt) aw[nt] = (f32x4){0.f, 0.f, 0.f, 0.f};
#pragma unroll
                    for (int ks = 0; ks < 2; ++ks) { const bf16x8_t fw = *(const LAS bf16x8_t*)(ldsb + E1_AW + (16 * mt + fr) * 144 + (32 * ks + 8 * fq) * 2);
#pragma unroll
                        for (int nt = 0; nt < 4; ++nt) aw[nt] = __builtin_amdgcn_mfma_f32_16x16x32_bf16(ww[nt][ks], fw, aw[nt], 0, 0, 0); }
#pragma unroll
                    for (int nt = 0; nt < 4; ++nt) { const int c = cb + 16 * nt + 4 * fq; const f32x4 w0v = *(const f32x4*)(w0 + c); float lw[4];
#pragma unroll
                        for (int j = 0; j < 4; ++j) { const float y = -(w0v[j] + aw[nt][j]); const float sp = fmaxf(y, 0.f) + __logf(1.0f + __expf(-fabsf(y))); lw[j] = -__expf(-sp - 0.5f); }
                        *(GAS v2u*)(LW + (size_t)m * 1024 + c) = pack4(lw[0], lw[1], lw[2], lw[3]); }
                }
            }
            {
                bf16x8_t wg[4][5];
#pragma unroll
                for (int nt = 0; nt < 4; ++nt)
#pragma unroll
                    for (int ks = 0; ks < 5; ++ks) wg[nt][ks] = *(const GAS bf16x8_t*)(G2T + (size_t)(cb + 16 * nt + fr) * 160 + 32 * ks + 8 * fq);
#pragma unroll 1
                for (int mt = 0; mt < 4; ++mt) {
                    const int m = m0 + 16 * mt + fr;
                    f32x4 ag[4];
#pragma unroll
                    for (int nt = 0; nt < 4; ++nt) ag[nt] = (f32x4){0.f, 0.f, 0.f, 0.f};
#pragma unroll
                    for (int ks = 0; ks < 5; ++ks) { const bf16x8_t fg = *(const LAS bf16x8_t*)(ldsb + E1_AG + (16 * mt + fr) * 336 + (32 * ks + 8 * fq) * 2);
#pragma unroll
                        for (int nt = 0; nt < 4; ++nt) ag[nt] = __builtin_amdgcn_mfma_f32_16x16x32_bf16(wg[nt][ks], fg, ag[nt], 0, 0, 0); }
#pragma unroll
                    for (int nt = 0; nt < 4; ++nt) *(GAS v2u*)(GG + (size_t)m * 1024 + cb + 16 * nt + 4 * fq) = pack4(ag[nt][0], ag[nt][1], ag[nt][2], ag[nt][3]);
                }
            }
            {
                bf16x8_t wv2[4];
#pragma unroll
                for (int nt = 0; nt < 4; ++nt) { wv2[nt] = (bf16x8_t){0, 0, 0, 0, 0, 0, 0, 0}; if (li > 0) wv2[nt] = *(const GAS bf16x8_t*)(V2T + (size_t)(cb + 16 * nt + fr) * 32 + 8 * fq); }
#pragma unroll 1
                for (int mt = 0; mt < 4; ++mt) {
                    const int m = m0 + 16 * mt + fr; const bool first = (m & (T - 1)) == 0;
                    f32x4 avr[4];
#pragma unroll
                    for (int nt = 0; nt < 4; ++nt) avr[nt] = (f32x4){0.f, 0.f, 0.f, 0.f};
                    if (li > 0) { const bf16x8_t fp = *(const LAS bf16x8_t*)(ldsb + E1_PB + (16 * mt + fr) * 80 + (8 * fq) * 2);
#pragma unroll
                        for (int nt = 0; nt < 4; ++nt) avr[nt] = __builtin_amdgcn_mfma_f32_16x16x32_bf16(wv2[nt], fp, avr[nt], 0, 0, 0); }
                    const size_t zo = (size_t)m * ZN + ZA + cb + 4 * fq;
#pragma unroll
                    for (int nt = 0; nt < 4; ++nt) { const int c = cb + 16 * nt + 4 * fq; const size_t o = (size_t)m * 1024 + c;
                        const v2u rc = *(const GAS v2u*)(Z + zo + 16 * nt), vc = *(const GAS v2u*)(Z + zo + 2048 + 16 * nt); v2u rp = {0u, 0u}, vp = {0u, 0u};
                        if (!first) { rp = *(const GAS v2u*)(Z + zo - ZN + 16 * nt); vp = *(const GAS v2u*)(Z + zo - ZN + 2048 + 16 * nt); }
                        float rr[4], vv[4]; lerp4(rc, rp, *(const f32x4*)(mu + c), rr); lerp4(vc, vp, *(const f32x4*)(mu + 2048 + c), vv);
                        if (li > 0) { const f32x4 v0v = *(const f32x4*)(v0w + c); const v2u vf = *(const GAS v2u*)(VF + o); const float f0 = bflo(vf.x), f1 = bfhi(vf.x), f2 = bflo(vf.y), f3 = bfhi(vf.y);
                            vv[0] += (f0 - vv[0]) * sigmoidf_(v0v[0] + avr[nt][0]); vv[1] += (f1 - vv[1]) * sigmoidf_(v0v[1] + avr[nt][1]);
                            vv[2] += (f2 - vv[2]) * sigmoidf_(v0v[2] + avr[nt][2]); vv[3] += (f3 - vv[3]) * sigmoidf_(v0v[3] + avr[nt][3]); }
                        *(GAS v2u*)(R + o) = pack4(rr[0], rr[1], rr[2], rr[3]); *(GAS v2u*)(VO + o) = pack4(vv[0], vv[1], vv[2], vv[3]); }
                }
            }
        }
        __syncthreads();
    }
}

constexpr size_t CS_AR = WS_ACT, CS_BK = WS_ACT + 128 * MiB, CS_Y0 = WS_ACT + 256 * MiB, CS_GL = WS_ACT + 320 * MiB;
__device__ __forceinline__ int cs_perm(int k) { return (k & 32) + 8 * ((k >> 2) & 3) + 4 * ((k >> 4) & 1) + (k & 3); }
__device__ __forceinline__ f32x4 mm16_ll(const LAS float* A, const LAS float* B, f32x4 c, int fr, int fq) {
    const f32x4 a4 = *(const LAS f32x4*)(A + fr * 16 + 4 * fq);
#pragma unroll
    for (int s = 0; s < 4; ++s) c = __builtin_amdgcn_mfma_f32_16x16x4f32(a4[s], B[(4 * fq + s) * 16 + fr], c, 0, 0, 0);
    return c;
}
__device__ __forceinline__ f32x4 mm16_la(const LAS float* A, const f32x4 b, f32x4 c, int fr, int fq) {
    const f32x4 a4 = *(const LAS f32x4*)(A + fr * 16 + 4 * fq);
#pragma unroll
    for (int s = 0; s < 4; ++s) c = __builtin_amdgcn_mfma_f32_16x16x4f32(a4[s], b[s], c, 0, 0, 0);
    return c;
}
__device__ __forceinline__ void st16(LAS float* Mx, const f32x4 c, int fr, int fq) {
#pragma unroll
    for (int r = 0; r < 4; ++r) Mx[(4 * fq + r) * 16 + fr] = c[r];
}
__device__ __forceinline__ void scanpre_phase(const Args& a, int li, LAS unsigned char* ldsb, int vcu, int G, int tid) {
    unsigned char* ws = a.ws;
    const bf16* Rr = (const bf16*)(ws + SC_R); const bf16* K2 = (const bf16*)(ws + SC_K2); const bf16* KK = (const bf16*)(ws + SC_KK); const bf16* BB = (const bf16*)(ws + SC_BB); const bf16* LW = (const bf16*)(ws + SC_LW);
    const bf16* V = (const bf16*)(ws + (li ? WS_V2 : WS_VF));
    bf16* ARo = (bf16*)(ws + CS_AR); bf16* BKo = (bf16*)(ws + CS_BK); bf16* Y0o = (bf16*)(ws + CS_Y0); float* GLo = (float*)(ws + CS_GL); bf16* U0o = (bf16*)(ws + WS_U0);
    const int lane = tid & 63, wave = tid >> 6, fr = lane & 15, fq = lane >> 4;
    LAS unsigned char* wl = ldsb + wave * 17408;
    LAS bf16* LAR = (LAS bf16*)wl; LAS bf16* LBK = (LAS bf16*)(wl + 4608); LAS float* LM = (LAS float*)(wl + 9216); LAS float* LX = (LAS float*)(wl + 13312);
    const LAS float* Mab = LM, *Mak = LM + 256, *Mrb = LM + 512, *Mrk = LM + 768;
    LAS float* Tm = LX, *Na = LX + 256, *Nb = LX + 512;
    for (int ch = vcu * NWAVES + wave; ch < 32 * 1024; ch += G * NWAVES) {
        const int bh = ch >> 10, ci = ch & 1023, b = bh >> 4, h = bh & 15; const size_t row0 = (size_t)b * T + 16 * ci;
        f32x4 At[4], Rt[4], vv[4]; float glane;
#pragma unroll
        for (int nt = 0; nt < 4; ++nt) { f32x4 lw, kk, bb, k2, rr;
#pragma unroll
            for (int s = 0; s < 4; ++s) { const size_t o = (row0 + 4 * fq + s) * 1024 + h * 64 + 16 * nt + fr;
                lw[s] = bf2f(LW[o]); kk[s] = bf2f(KK[o]); bb[s] = bf2f(BB[o]); k2[s] = bf2f(K2[o]); rr[s] = bf2f(Rr[o]); vv[nt][s] = bf2f(V[o]); }
            f32x4 cum; cum[0] = lw[0]; cum[1] = cum[0] + lw[1]; cum[2] = cum[1] + lw[2]; cum[3] = cum[2] + lw[3];
            float x = cum[3]; { const float y = __shfl_up(x, 16); if (fq >= 1) x += y; } { const float y = __shfl_up(x, 32); if (fq >= 2) x += y; }
            const float excl = x - cum[3]; const float cl = __shfl(x, 48 + fr);
            bf16* bo = BKo + (size_t)ch * 2048 + (16 * nt + fr) * 32 + 8 * fq; f32x4 bh4, kh4;
#pragma unroll
            for (int s = 0; s < 4; ++s) { const float c = excl + cum[s]; const float g = __expf(c), gp = __expf(c - lw[s]), gi = __expf(-c), e = __expf(cl - c);
                At[nt][s] = -kk[s] * gp; Rt[nt][s] = rr[s] * g; bh4[s] = bb[s] * e; kh4[s] = k2[s] * e;
                const int t = 4 * fq + s, cc = 16 * nt + fr;
                LAR[t * 72 + cc] = (bf16)f2bf(At[nt][s]); LAR[(16 + t) * 72 + cc] = (bf16)f2bf(Rt[nt][s]); LBK[t * 72 + cc] = (bf16)f2bf(bb[s] * gi); LBK[(16 + t) * 72 + cc] = (bf16)f2bf(k2[s] * gi); }
            *(GAS v4u*)bo = (v4u){pk2(bh4[0], bh4[1]), pk2(bh4[2], bh4[3]), pk2(kh4[0], kh4[1]), pk2(kh4[2], kh4[3])};
            if (fq == 0) GLo[(size_t)ch * 64 + 16 * nt + fr] = __expf(cl);
            glane = cl; }
        (void)glane;
        LDS_WAIT(); asm volatile("" ::: "memory");
#pragma unroll
        for (int mt = 0; mt < 2; ++mt)
#pragma unroll
            for (int nt = 0; nt < 2; ++nt) { f32x4 m = {0.f, 0.f, 0.f, 0.f};
#pragma unroll
                for (int ks = 0; ks < 2; ++ks) { const bf16x8_t af = *(const LAS bf16x8_t*)(LAR + (16 * mt + fr) * 72 + 32 * ks + 8 * fq), bfr = *(const LAS bf16x8_t*)(LBK + (16 * nt + fr) * 72 + 32 * ks + 8 * fq);
                    m = __builtin_amdgcn_mfma_f32_16x16x32_bf16(af, bfr, m, 0, 0, 0); }
#pragma unroll
                for (int r = 0; r < 4; ++r) { const int t = 4 * fq + r; const bool keep = mt ? (fr <= t) : (fr < t); LM[((mt * 2 + nt) * 16 + t) * 16 + fr] = keep ? m[r] : 0.f; } }
        LDS_WAIT(); asm volatile("" ::: "memory");
        { const f32x4 z = {0.f, 0.f, 0.f, 0.f};
          f32x4 t1;
#pragma unroll
          for (int r = 0; r < 4; ++r) t1[r] = Mab[(4 * fq + r) * 16 + fr] + ((4 * fq + r) == fr ? 1.0f : 0.f);
          st16(Tm, t1, fr, fq);
          f32x4 n2 = mm16_ll(Mab, Mab, z, fr, fq); st16(Na, n2, fr, fq);
          LDS_WAIT(); asm volatile("" ::: "memory");
          f32x4 t2 = mm16_ll(Tm, Na, t1, fr, fq);
          f32x4 n4 = mm16_ll(Na, Na, z, fr, fq);
          LDS_WAIT(); asm volatile("" ::: "memory");
          st16(Tm, t2, fr, fq); st16(Nb, n4, fr, fq);
          LDS_WAIT(); asm volatile("" ::: "memory");
          f32x4 t3 = mm16_ll(Tm, Nb, t2, fr, fq);
          f32x4 n8 = mm16_ll(Nb, Nb, z, fr, fq);
          LDS_WAIT(); asm volatile("" ::: "memory");
          st16(Tm, t3, fr, fq); st16(Na, n8, fr, fq);
          LDS_WAIT(); asm volatile("" ::: "memory");
          f32x4 t4 = mm16_ll(Tm, Na, t3, fr, fq);
          LDS_WAIT(); asm volatile("" ::: "memory");
          st16(Tm, t4, fr, fq);
          LDS_WAIT(); asm volatile("" ::: "memory"); }
#pragma unroll
        for (int nt = 0; nt < 4; ++nt) { const f32x4 z = {0.f, 0.f, 0.f, 0.f};
            const f32x4 w1 = mm16_la(Mak, vv[nt], z, fr, fq);
            const f32x4 u0 = mm16_la(Tm, w1, z, fr, fq);
            const f32x4 ah = mm16_la(Tm, At[nt], z, fr, fq);
            const f32x4 rh = mm16_la(Mrb, ah, Rt[nt], fr, fq);
            f32x4 y0 = mm16_la(Mrb, u0, z, fr, fq); y0 = mm16_la(Mrk, vv[nt], y0, fr, fq);
            const int k = 16 * nt + fr; bf16* arp = ARo + (size_t)ch * 2048 + cs_perm(k);
#pragma unroll
            for (int s = 0; s < 4; ++s) { arp[(4 * fq + s) * 64] = (bf16)f2bf(ah[s]); arp[(16 + 4 * fq + s) * 64] = (bf16)f2bf(rh[s]); }
            *(GAS v2u*)(Y0o + (size_t)ch * 1024 + k * 16 + 4 * fq) = pack4(y0[0], y0[1], y0[2], y0[3]);
            *(GAS v2u*)(U0o + (size_t)ch * 1024 + k * 16 + 4 * fq) = pack4(u0[0], u0[1], u0[2], u0[3]); }
        LDS_WAIT(); asm volatile("" ::: "memory");
    }
}
constexpr int CQ_NS = 13, CQ_SLOT = 10240, CQ_FULL = CQ_NS * CQ_SLOT, CQ_DONE = CQ_FULL + 64, CQ_NL = 6;
#define CQ_GLDS(src, dst) __builtin_amdgcn_global_load_lds((const unsigned*)(src), (LAS unsigned*)(dst), 16, 0, 0)
__device__ __forceinline__ void scanseq_phase(const Args& a, int li, LAS unsigned char* ldsb, int vcu, int tid) {
    volatile LAS unsigned* FULL = (volatile LAS unsigned*)(ldsb + CQ_FULL); volatile LAS unsigned* DONE = (volatile LAS unsigned*)(ldsb + CQ_DONE);
    if (tid < 32) ((LAS unsigned*)(ldsb + CQ_FULL))[tid] = 0u;
    __syncthreads();
    const int wave = __builtin_amdgcn_readfirstlane(tid >> 6), lane = tid & 63;
    if (vcu < 128 && wave <= CQ_NL) {
        unsigned char* ws = a.ws;
        const int bh = vcu >> 2, vb = vcu & 3, b = bh >> 4, h = bh & 15; const size_t row0 = (size_t)b * T; const size_t ch0 = (size_t)bh * 1024;
        if (wave > 0) {
            const unsigned char* ARo = ws + CS_AR; const unsigned char* BKo = ws + CS_BK; const unsigned char* Y0o = ws + CS_Y0; const unsigned char* GLo = ws + CS_GL; const unsigned char* U0o = ws + WS_U0;
            const unsigned char* V = ws + (li ? WS_V2 : WS_VF);
            const unsigned oAR = (unsigned)((lane >> 3) * 128 + 16 * ((lane & 7) ^ ((lane >> 3) & 7)));
            unsigned oBK[4];
#pragma unroll
            for (int i = 0; i < 4; ++i) { const int k = 16 * i + (lane >> 2); oBK[i] = (unsigned)(k * 64 + 16 * ((lane & 3) ^ ((k >> 2) & 3))); }
            const unsigned oUY = (unsigned)((16 * vb + ((lane & 31) >> 1)) * 32 + 16 * (lane & 1));
            const size_t oV = ((size_t)(lane >> 1) * 1024 + h * 64 + 16 * vb) * 2 + 16 * (lane & 1);
            const unsigned oG = (unsigned)(16 * (lane & 15));
            int pub = wave - 1; unsigned spins = 0;
            for (int c = wave - 1; c < 1024; c += CQ_NL) {
                const int s = c % CQ_NS;
                if (c >= CQ_NS) { while ((int)DONE[0] < c - CQ_NS + 1) { __builtin_amdgcn_s_sleep(1); if (++spins > (1u << 24)) break; } }
                LAS unsigned char* sl = ldsb + s * CQ_SLOT; const size_t ch = ch0 + c;
                const unsigned char* ar = ARo + ch * 4096; const unsigned char* bk = BKo + ch * 4096;
#pragma unroll
                for (int i = 0; i < 4; ++i) CQ_GLDS(ar + i * 1024 + oAR, sl + i * 1024);
#pragma unroll
                for (int i = 0; i < 4; ++i) CQ_GLDS(bk + oBK[i], sl + 4096 + i * 1024);
                CQ_GLDS((lane < 32 ? U0o : Y0o) + ch * 2048 + oUY, sl + 8192);
                CQ_GLDS(lane < 32 ? V + (row0 + 16 * (size_t)c) * 2048 + oV : GLo + ch * 256 + oG, sl + 9216);
                asm volatile("s_waitcnt vmcnt(10)" ::: "memory");
                for (; pub <= c - CQ_NL; pub += CQ_NL) FULL[pub % CQ_NS] = (unsigned)(pub + 1);
            }
            asm volatile("s_waitcnt vmcnt(0)" ::: "memory");
            for (; pub < 1024; pub += CQ_NL) FULL[pub % CQ_NS] = (unsigned)(pub + 1);
        } else {
            float* Y = a.out;
            const int fr = lane & 15, fq = lane >> 4; const int colv = h * 64 + 16 * vb + fr;
            f32x4 St[4];
#pragma unroll
            for (int kt = 0; kt < 4; ++kt) St[kt] = (f32x4){0.f, 0.f, 0.f, 0.f};
            unsigned spins = 0;
            for (int c = 0; c < 1024; ++c) {
                const int s = c % CQ_NS; LAS unsigned char* sl = ldsb + s * CQ_SLOT;
                while (FULL[s] != (unsigned)(c + 1)) { if (++spins > (1u << 26)) break; }
                __builtin_amdgcn_fence(__ATOMIC_ACQUIRE, "workgroup");
                bf16x8_t ar[2][2], bk[4]; f32x4 gl[4];
#pragma unroll
                for (int mt = 0; mt < 2; ++mt)
#pragma unroll
                    for (int ks = 0; ks < 2; ++ks) { const int r = 16 * mt + fr; ar[mt][ks] = *(const LAS bf16x8_t*)(sl + r * 128 + 16 * ((4 * ks + fq) ^ (r & 7))); }
#pragma unroll
                for (int kt = 0; kt < 4; ++kt) { const int k = 16 * kt + fr; bk[kt] = *(const LAS bf16x8_t*)(sl + 4096 + k * 64 + 16 * (fq ^ ((k >> 2) & 3))); gl[kt] = *(const LAS f32x4*)(sl + 9728 + (16 * kt + 4 * fq) * 4); }
                const v2u u0 = *(const LAS v2u*)(sl + 8192 + fr * 32 + 8 * fq), y0 = *(const LAS v2u*)(sl + 8704 + fr * 32 + 8 * fq);
                unsigned vs[4];
#pragma unroll
                for (int j = 0; j < 4; ++j) vs[j] = *(const LAS unsigned short*)(sl + 9216 + (4 * fq + j) * 32 + 2 * fr);
                bf16x8_t sb[2];
#pragma unroll
                for (int ks = 0; ks < 2; ++ks) { v4u w; w.x = pk2(St[2 * ks][0], St[2 * ks][1]); w.y = pk2(St[2 * ks][2], St[2 * ks][3]); w.z = pk2(St[2 * ks + 1][0], St[2 * ks + 1][1]); w.w = pk2(St[2 * ks + 1][2], St[2 * ks + 1][3]); sb[ks] = __builtin_bit_cast(bf16x8_t, w); }
                f32x4 au = {0.f, 0.f, 0.f, 0.f}, ay = {0.f, 0.f, 0.f, 0.f};
#pragma unroll
                for (int ks = 0; ks < 2; ++ks) { au = __builtin_amdgcn_mfma_f32_16x16x32_bf16(ar[0][ks], sb[ks], au, 0, 0, 0); ay = __builtin_amdgcn_mfma_f32_16x16x32_bf16(ar[1][ks], sb[ks], ay, 0, 0, 0); }
                { const size_t yr = (row0 + 16 * (size_t)c + 4 * fq) * 1024 + colv;
                  Y[yr] = ay[0] + bflo(y0.x); Y[yr + 1024] = ay[1] + bfhi(y0.x); Y[yr + 2048] = ay[2] + bflo(y0.y); Y[yr + 3072] = ay[3] + bfhi(y0.y); }
                v4u uw; uw.x = pk2(au[0] + bflo(u0.x), au[1] + bfhi(u0.x)); uw.y = pk2(au[2] + bflo(u0.y), au[3] + bfhi(u0.y)); uw.z = vs[0] | (vs[1] << 16); uw.w = vs[2] | (vs[3] << 16);
                const bf16x8_t uv = __builtin_bit_cast(bf16x8_t, uw);
#pragma unroll
                for (int kt = 0; kt < 4; ++kt) St[kt] = __builtin_amdgcn_mfma_f32_16x16x32_bf16(bk[kt], uv, St[kt] * gl[kt], 0, 0, 0);
                asm volatile("s_waitcnt lgkmcnt(0)" ::: "memory");
                if (lane == 0) DONE[0] = (unsigned)(c + 1);
            }
        }
    }
    __syncthreads();
}

typedef float f32x16 __attribute__((ext_vector_type(16)));
constexpr int AT_K = 0, AT_V = 36864;
__device__ __forceinline__ bf16x8_t tr_frag(unsigned addr) {
    v2u lo, hi; asm volatile("ds_read_b64_tr_b16 %0, %2\n\tds_read_b64_tr_b16 %1, %2 offset:1536\n\ts_waitcnt lgkmcnt(0)" : "=&v"(lo), "=&v"(hi) : "v"(addr) : "memory");
    v4u w; w.x = lo.x; w.y = lo.y; w.z = hi.x; w.w = hi.y; return __builtin_bit_cast(bf16x8_t, w);
}
__device__ __forceinline__ void attn_unit(const Args& a, int li, int au, LAS unsigned char* ldsb, int tid) {
    unsigned char* ws = a.ws; const bf16* Z = (const bf16*)(ws + WS_ACT); bf16* O = (bf16*)(ws + WS_O);
    const int n = au & 127, kvh = (au >> 7) & 3, b = au >> 9;
    const size_t rblk = (size_t)b * T + (size_t)n * 128;
    for (int e = tid; e < 256 * 8 * 2; e += NTHR) { const int which = e >> 11, rem = e & 2047, j = rem >> 3, c8 = rem & 7; const bool valid = (n > 0) || (j >= 128);
        v4u w = {0u, 0u, 0u, 0u}; if (valid) w = *(const GAS v4u*)(Z + (rblk + j - 128) * ZN + 1024 + which * 256 + kvh * 64 + 8 * c8);
        *(LAS v4u*)(ldsb + (which ? AT_V + j * 192 : AT_K + j * 144) + c8 * 16) = w; }
    __syncthreads();
    const int lane = tid & 63, wave = tid >> 6, l31 = lane & 31, h = lane >> 5;
    const unsigned ldsbase = (unsigned)(size_t)ldsb;
#pragma unroll 1
    for (int it = 0; it < 2; ++it) {
        const int tt = 2 * wave + it, g = tt >> 2, qi = tt & 3, hq = kvh * 4 + g; const size_t qrow = rblk + 32 * qi + l31;
        bf16x8_t qf[4];
#pragma unroll
        for (int ks = 0; ks < 4; ++ks) qf[ks] = *(const GAS bf16x8_t*)(Z + qrow * ZN + hq * 64 + 16 * ks + 8 * h);
        f32x16 st[5];
#pragma unroll
        for (int kt = 0; kt < 5; ++kt) {
#pragma unroll
            for (int r = 0; r < 16; ++r) st[kt][r] = 0.f;
#pragma unroll
            for (int ks = 0; ks < 4; ++ks) { const bf16x8_t kf = *(const LAS bf16x8_t*)(ldsb + AT_K + (32 * (qi + kt) + l31) * 144 + (16 * ks + 8 * h) * 2);
                st[kt] = __builtin_amdgcn_mfma_f32_32x32x16_bf16(kf, qf[ks], st[kt], 0, 0, 0); } }
        const float slope = exp2f(-0.5f * (float)(hq + 1)); const float sink = a.in[I_ESINK][li * 16 + hq];
        float mx = sink;
#pragma unroll
        for (int kt = 0; kt < 5; ++kt)
#pragma unroll
            for (int r = 0; r < 16; ++r) { const int j = 32 * (qi + kt) + (r & 3) + 8 * (r >> 2) + 4 * h; const int dist = 32 * qi + l31 + 128 - j;
                const bool ok = (dist >= 0) && (dist < 128) && ((n > 0) || (j >= 128));
                const float s = ok ? st[kt][r] * 0.125f - slope * (float)dist : -INFINITY; st[kt][r] = s; mx = fmaxf(mx, s); }
        mx = fmaxf(mx, __shfl_xor(mx, 32));
        float l = 0.f;
#pragma unroll
        for (int kt = 0; kt < 5; ++kt)
#pragma unroll
            for (int r = 0; r < 16; ++r) { const float p = __expf(st[kt][r] - mx); st[kt][r] = p; l += p; }
        l += __shfl_xor(l, 32); l += __expf(sink - mx);
        f32x16 ot[2];
#pragma unroll
        for (int r = 0; r < 16; ++r) { ot[0][r] = 0.f; ot[1][r] = 0.f; }
#pragma unroll
        for (int kt = 0; kt < 5; ++kt)
#pragma unroll
            for (int s2 = 0; s2 < 2; ++s2) {
                v4u pw; pw.x = pk2(st[kt][8 * s2 + 0], st[kt][8 * s2 + 1]); pw.y = pk2(st[kt][8 * s2 + 2], st[kt][8 * s2 + 3]); pw.z = pk2(st[kt][8 * s2 + 4], st[kt][8 * s2 + 5]); pw.w = pk2(st[kt][8 * s2 + 6], st[kt][8 * s2 + 7]);
                const bf16x8_t pf = __builtin_bit_cast(bf16x8_t, pw);
#pragma unroll
                for (int db = 0; db < 2; ++db) {
                    const unsigned va = ldsbase + AT_V + (unsigned)(32 * (qi + kt) + 16 * s2 + 4 * h + ((lane & 15) >> 2)) * 192u + (unsigned)(32 * db + 16 * ((lane >> 4) & 1) + 4 * (lane & 3)) * 2u;
                    const bf16x8_t vf = tr_frag(va);
                    ot[db] = __builtin_amdgcn_mfma_f32_32x32x16_bf16(vf, pf, ot[db], 0, 0, 0); } }
        const float inv = 1.0f / l;
#pragma unroll
        for (int db = 0; db < 2; ++db)
#pragma unroll
            for (int g4 = 0; g4 < 4; ++g4)
                *(GAS v2u*)(O + qrow * D + 1024 + hq * 64 + 32 * db + 8 * g4 + 4 * h) = pack4(ot[db][4 * g4] * inv, ot[db][4 * g4 + 1] * inv, ot[db][4 * g4 + 2] * inv, ot[db][4 * g4 + 3] * inv);
    }
    __syncthreads();
}

__device__ __forceinline__ void e3_phase(const Args& a, int li, int vcu, int G, int tid) {
    unsigned char* ws = a.ws; const float* Y = a.out;
    const bf16* R = (const bf16*)(ws + SC_R); const bf16* K2 = (const bf16*)(ws + SC_K2); const bf16* GG = (const bf16*)(ws + SC_GG); const bf16* V = (const bf16*)(ws + (li ? WS_V2 : WS_VF));
    bf16* O = (bf16*)(ws + WS_O);
    const float* rk = a.in[I_ERK] + li * 1024; const float* gng = a.in[I_EGNG] + li * 1024; const float* gnb = a.in[I_EGNB] + li * 1024;
    for (size_t e4 = (size_t)vcu * NTHR + tid; e4 < (size_t)M * 256; e4 += (size_t)G * NTHR) {
        const size_t row = e4 >> 8; const int c = (int)(e4 & 255) * 4; const size_t e = row * 1024 + c;
        const f32x4 y = *(const GAS f32x4*)(Y + e);
        const v2u rw = *(const GAS v2u*)(R + e), kw = *(const GAS v2u*)(K2 + e), vw = *(const GAS v2u*)(V + e), gw = *(const GAS v2u*)(GG + e);
        const f32x4 rkv = *(const f32x4*)(rk + c), ggv = *(const f32x4*)(gng + c), gbv = *(const f32x4*)(gnb + c);
        const float mean = row16_sum((y.x + y.y) + (y.z + y.w)) * (1.0f / 64.0f);
        const f32x4 d = y - mean;
        const float var = row16_sum((d.x * d.x + d.y * d.y) + (d.z * d.z + d.w * d.w)) * (1.0f / 64.0f);
        const float rs = rsqrtf(var + 64e-5f);
        const float r0 = bflo(rw.x), r1 = bfhi(rw.x), r2 = bflo(rw.y), r3 = bfhi(rw.y), k0 = bflo(kw.x), k1 = bfhi(kw.x), k2 = bflo(kw.y), k3 = bfhi(kw.y);
        const float bonus = row16_sum((r0 * k0 * rkv.x + r1 * k1 * rkv.y) + (r2 * k2 * rkv.z + r3 * k3 * rkv.w));
        const float o0 = (d.x * rs * ggv.x + gbv.x + bonus * bflo(vw.x)) * bflo(gw.x), o1 = (d.y * rs * ggv.y + gbv.y + bonus * bfhi(vw.x)) * bfhi(gw.x);
        const float o2 = (d.z * rs * ggv.z + gbv.z + bonus * bflo(vw.y)) * bflo(gw.y), o3 = (d.w * rs * ggv.w + gbv.w + bonus * bfhi(vw.y)) * bfhi(gw.y);
        *(GAS v2u*)(O + row * D + c) = pack4(o0, o1, o2, o3);
    }
}

constexpr int SG_W = 0, SG_V = 34816;
__device__ __forceinline__ unsigned sg_off(unsigned row, unsigned ch) { return 256u * row + 16u * (ch ^ (((row & 3u) << 2) | ((row >> 2) & 3u))); }
__device__ __forceinline__ bf16x8_t tr_frag2(unsigned a0, unsigned a1) {
    v2u lo, hi; asm volatile("ds_read_b64_tr_b16 %0, %2\n\tds_read_b64_tr_b16 %1, %3\n\ts_waitcnt lgkmcnt(0)" : "=&v"(lo), "=&v"(hi) : "v"(a0), "v"(a1) : "memory");
    v4u w; w.x = lo.x; w.y = lo.y; w.z = hi.x; w.w = hi.y; return __builtin_bit_cast(bf16x8_t, w);
}
__device__ __forceinline__ void sgu_phase(const Args& a, int li, LAS unsigned char* ldsb, int vcu, int G, int tid) {
    unsigned char* ws = a.ws; const bf16* Z = (const bf16*)(ws + WS_ACT); bf16* O = (bf16*)(ws + WS_O);
    const float* ssv = (const float*)(ws + WS_SS) + (size_t)(13 + li) * SS_REC;
    const bf16* WSB = (const bf16*)(ws + SM_WSB); const float* bs = a.in[I_OBS] + li * 16 * 128; const float* vng = a.in[I_OVNG] + li * D;
    const int lane = tid & 63, wave = tid >> 6, fr = lane & 15, fq = lane >> 4;
    const unsigned ldsbase = (unsigned)(size_t)ldsb;
    int gcur = -1;
    for (int u = vcu; u < 4096; u += G) {
        const int g = u & 15, bn = u >> 4; const size_t m0 = (size_t)bn * 128;
        __syncthreads();
        if (g != gcur) { gcur = g;
            for (int e = tid; e < 128 * 16; e += NTHR) { const int i = e >> 4, ch = e & 15; *(LAS v4u*)(ldsb + SG_W + i * 272 + ch * 16) = *(const GAS v4u*)(WSB + ((size_t)g * 128 + i) * 128 + 8 * ch); } }
        for (int e = tid; e < 128 * 16; e += NTHR) { const int j = e >> 4, ch = e & 15; const float rs = pg8::row_rs(ssv, (int)(m0 + j));
            const v4u w = *(const GAS v4u*)(Z + (m0 + j) * ZO + 2048 + g * 128 + 8 * ch); v4u o;
            o.x = pk2(bflo(w.x) * rs, bfhi(w.x) * rs); o.y = pk2(bflo(w.y) * rs, bfhi(w.y) * rs); o.z = pk2(bflo(w.z) * rs, bfhi(w.z) * rs); o.w = pk2(bflo(w.w) * rs, bfhi(w.w) * rs);
            *(LAS v4u*)(ldsb + SG_V + sg_off((unsigned)j, (unsigned)ch)) = o; }
        __syncthreads();
        bf16x8_t vf[4];
        { const unsigned q = (unsigned)(lane & 15) >> 2, p = (unsigned)lane & 3u;
#pragma unroll
          for (int ks = 0; ks < 4; ++ks) { const unsigned r0 = 32u * ks + 8u * fq + q;
              vf[ks] = tr_frag2(ldsbase + SG_V + sg_off(r0, 2u * wave + (p >> 1)) + 8u * (p & 1u), ldsbase + SG_V + sg_off(r0 + 4u, 2u * wave + (p >> 1)) + 8u * (p & 1u)); } }
        const int cc = g * 128 + 16 * wave + 4 * fq; const f32x4 vg = *(const f32x4*)(vng + cc);
#pragma unroll
        for (int mt = 0; mt < 8; ++mt) {
            f32x4 acc = {0.f, 0.f, 0.f, 0.f};
#pragma unroll
            for (int ks = 0; ks <= (mt >> 1); ++ks) { const bf16x8_t wf = *(const LAS bf16x8_t*)(ldsb + SG_W + (16 * mt + fr) * 272 + (32 * ks + 8 * fq) * 2);
                acc = __builtin_amdgcn_mfma_f32_16x16x32_bf16(vf[ks], wf, acc, 0, 0, 0); }
            const int i = 16 * mt + fr; const float bi = bs[g * 128 + i];
            const v2u uw = *(const GAS v2u*)(Z + (m0 + i) * ZO + cc);
            *(GAS v2u*)(O + (m0 + i) * D + cc) = pack4(bflo(uw.x) * (vg.x * acc[0] + bi), bfhi(uw.x) * (vg.y * acc[1] + bi), bflo(uw.y) * (vg.z * acc[2] + bi), bfhi(uw.y) * (vg.w * acc[3] + bi));
        }
    }
    __syncthreads();
}

__device__ __forceinline__ void final_phase(const Args& a, int vcu, int G, int wave, int lane) {
    const int gw = vcu * NWAVES + wave, NGW = G * NWAVES; const float* ss = (const float*)(a.ws + WS_SS) + (size_t)12 * SS_REC; const float* fg = a.in[I_FG]; const bf16* XBp = (const bf16*)(a.ws + WS_XB);
    for (int m = gw; m < M; m += NGW) { const float rs = pg8::row_rs(ss, m);
        const GAS v4u* xr = (const GAS v4u*)(XBp + (size_t)m * D) + lane; GAS f32x4* orow = (GAS f32x4*)(a.out + (size_t)m * D) + 2 * lane; const GAS f32x4* gr = (const GAS f32x4*)fg + 2 * lane;
#pragma unroll
        for (int j = 0; j < 4; ++j) { const v4u w = xr[64 * j]; const f32x4 g0 = gr[128 * j], g1 = gr[128 * j + 1];
            orow[128 * j] = (f32x4){bflo(w.x) * rs * g0.x, bfhi(w.x) * rs * g0.y, bflo(w.y) * rs * g0.z, bfhi(w.y) * rs * g0.w};
            orow[128 * j + 1] = (f32x4){bflo(w.z) * rs * g1.x, bfhi(w.z) * rs * g1.y, bflo(w.w) * rs * g1.z, bfhi(w.w) * rs * g1.w}; } }
}

__global__ void __launch_bounds__(NTHR, 2) mk_fwd(Args args) {
    extern __shared__ __attribute__((aligned(16))) unsigned char lds_raw[];
    LAS unsigned char* lds = (LAS unsigned char*)lds_raw;
    const int tid = threadIdx.x, lane = tid & 63, wave = __builtin_amdgcn_readfirstlane(tid >> 6);
    const int G = gridDim.x, bx = blockIdx.x; const int vcu = (G % 8 == 0) ? (bx % 8) * (G / 8) + bx / 8 : bx;
    unsigned char* ws = args.ws; gu32* ctl = (gu32*)(ws + WS_CTL);
    for (int u = tid; u < (LDS_BYTES - LDSCTL_OFF) / 4; u += NTHR) ((LAS unsigned*)(lds + LDSCTL_OFF))[u] = 0u;
    __syncthreads();
    const int lo = args.ph_lo, hi = args.ph_hi;
    const bool multi = (hi - lo) > 1;
    XcdBarrier bar; bar.bar = (unsigned*)(ctl + CW_BAR); bar.x = 0; bar.st = nullptr;
    if (multi) bar = xcd_barrier_post((unsigned*)(ctl + CW_BAR), (volatile LAS unsigned*)(lds + LDSCTL_OFF));
#define IN(k) (lo <= (k) && (k) < hi)
#define SEAM(k) do { if ((k) + 1 < hi) xcd_barrier(bar); } while (0)
#ifndef DUP_G
#define DUP_G 1
#endif
#ifndef DUP_T
#define DUP_T 1
#endif
#ifndef DUP_GR
#define DUP_GR DUP_G
#endif
#ifndef DUP_G1
#define DUP_G1 DUP_G
#endif
#ifndef DUP_SP
#define DUP_SP DUP_S
#endif
#ifndef DUP_SQ
#define DUP_SQ DUP_S
#endif
#ifndef DUP_PREP
#define DUP_PREP DUP_T
#endif
#ifndef DUP_E1
#define DUP_E1 DUP_T
#endif
#ifndef DUP_SGU
#define DUP_SGU DUP_T
#endif
#ifndef DUP_E3
#define DUP_E3 DUP_T
#endif
#define REPN(n) for (int rep_ = 0; rep_ < (n); ++rep_)
#ifndef DUP_S
#define DUP_S 1
#endif
#define REPG for (int rep_ = 0; rep_ < DUP_G; ++rep_)
#define REPT for (int rep_ = 0; rep_ < DUP_T; ++rep_)
#define REPS for (int rep_ = 0; rep_ < DUP_S; ++rep_)
#define RSEAM(n) do { if (rep_ + 1 < (n)) xcd_barrier(bar); } while (0)
    float* ssb = (float*)(ws + WS_SS);
    bf16* XB = (bf16*)(ws + WS_XB); bf16* ACT = (bf16*)(ws + WS_ACT); bf16* OB = (bf16*)(ws + WS_O);

    for (int s = 0; s < NSUB; ++s) {
        const int pb = s * 8, L = s / 3, kind = s % 3, li = L >> 1; const bool even = !(L & 1);
        #ifndef NO_PREP
        if (kind == 0 && IN(pb + 0)) { REPN(DUP_PREP) { const int t_ = opaque(tid); prep_phase(args, L, lds, vcu, G, __builtin_amdgcn_readfirstlane(t_ >> 6), t_ & 63); RSEAM(DUP_PREP); } SEAM(pb + 0); }
#endif
        if (IN(pb + 1)) {
            const float* ss = ssb + (size_t)s * SS_REC;
            LAS float* RC = (LAS float*)(lds + 135168);
            if (tid == 0) *(LAS int*)(RC + 256) = -1;
            __syncthreads();
            if (kind != 1) {
                pg8::Gemm g{XB, (const bf16*)(ws + (kind == 0 ? WT_GU1 : WT_GU2)), M, 2 * FF, D}; pg8::StaticOrder S; S.init(M, 2 * FF, G, bx);
                pg8::EpiSwiGLU E{ACT, FF, ss, RC};
#ifndef NO_G1
                REPN(DUP_G1) { pg8::gemm_phase<pg8::EpiSwiGLU, pg8::StaticOrder, true, true>(lds, g, S, E); RSEAM(DUP_G1); }
#endif
            } else if (even) {
                pg8::Gemm g{XB, (const bf16*)(ws + WT_IN), M, ZN, D}; pg8::StaticOrder S; S.init(M, ZN, G, bx);
                pg8::EpiZ E{ACT, ZN, ss, args.in[I_EBQKV] + li * 1536, RC};
#ifndef NO_GZ
                REPG { pg8::gemm_phase<pg8::EpiZ, pg8::StaticOrder, true, true>(lds, g, S, E); RSEAM(DUP_G); }
#endif
            } else {
                pg8::Gemm g{XB, (const bf16*)(ws + WT_IN), M, ZO, D}; pg8::StaticOrder S; S.init(M, ZO, G, bx);
                pg8::EpiGeluV E{ACT, ZO, ss, ssb + (size_t)(13 + li) * SS_REC, (LAS float*)(lds + 131072), RC};
#ifndef NO_GG
                REPG { pg8::gemm_phase<pg8::EpiGeluV, pg8::StaticOrder, true, true>(lds, g, S, E); RSEAM(DUP_G); }
#endif
            }
            SEAM(pb + 1);
        }
        if (kind == 1) {
            if (IN(pb + 2)) {
#ifndef NO_E1
                if (even) REPN(DUP_E1) { e1_phase(args, li, lds, vcu, G, opaque(tid)); RSEAM(DUP_E1); }
#endif
#ifndef NO_ATTN
                if (even) for (int au = vcu; au < 1024; au += G) attn_unit(args, li, au, lds, opaque(tid));
#endif
#ifndef NO_SGU
                if (!even) REPN(DUP_SGU) { sgu_phase(args, li, lds, vcu, G, opaque(tid)); RSEAM(DUP_SGU); }
#endif
                SEAM(pb + 2); }
#ifndef NO_SPRE
            if (even && IN(pb + 3)) { REPN(DUP_SP) { scanpre_phase(args, li, lds, vcu, G, opaque(tid)); RSEAM(DUP_SP); } SEAM(pb + 3); }
#endif
#ifndef NO_SSEQ
            if (even && IN(pb + 4)) { REPN(DUP_SQ) { scanseq_phase(args, li, lds, vcu, opaque(tid)); RSEAM(DUP_SQ); } SEAM(pb + 4); }
#endif
#ifndef NO_E3
            if (even && IN(pb + 5)) { REPN(DUP_E3) { e3_phase(args, li, vcu, G, opaque(tid)); RSEAM(DUP_E3); } SEAM(pb + 5); }
#endif
        }
        if (IN(pb + 6)) {
            const bf16* A = (kind == 1) ? OB : ACT; const int K = (kind == 1) ? D : FF;
            const bf16* Bt = (const bf16*)(ws + (kind == 0 ? WT_D1 : kind == 1 ? WT_OUT : WT_D2));
            pg8::Gemm g{A, Bt, M, D, K, kind == 1 ? 0 : 1}; pg8::StaticOrder S; S.init(M, D, G, bx);
            pg8::EpiResid E{XB, ssb + (size_t)(s + 1) * SS_REC, kind == 1 ? 1.0f : 0.5f, (LAS float*)(lds + 131072)};
#ifndef NO_GR
            REPN(DUP_GR) { if (rep_) { E.scale = 0.f;
#ifdef PROBE_NOEPI
                E.noop = 1;
#endif
                } pg8::gemm_phase<pg8::EpiResid, pg8::StaticOrder, true, true>(lds, g, S, E); RSEAM(DUP_GR); }
#endif
            SEAM(pb + 6);
        }
    }
    if (IN(NSUB * 8)) { const int t_ = opaque(tid); final_phase(args, vcu, G, __builtin_amdgcn_readfirstlane(t_ >> 6), t_ & 63); }
#undef IN
#undef SEAM
}

extern "C" void kernel_launch(void* const* d_in, const int* in_sizes, int n_in, void* d_out, int out_size, void* d_ws, size_t ws_size, hipStream_t stream) {
    static int grid = 0;
    if (grid == 0) {
        if (n_in != 29 || out_size != M * D || ws_size < WS_END) { fprintf(stderr, "kernel_launch: unexpected shapes (n_in %d, out %d, ws %zu < %zu); nothing launched\n", n_in, out_size, ws_size, (size_t)WS_END); grid = -1; return; }
        int dev = 0, cus = 0;
        if (hipGetDevice(&dev) != hipSuccess || hipDeviceGetAttribute(&cus, hipDeviceAttributeMultiprocessorCount, dev) != hipSuccess) { grid = -1; return; }
        if (hipFuncSetAttribute((const void*)mk_fwd, hipFuncAttributeMaxDynamicSharedMemorySize, LDS_BYTES) != hipSuccess) { fprintf(stderr, "kernel_launch: hipFuncSetAttribute failed\n"); grid = -1; return; }
        int per_cu = 0;
        if (hipOccupancyMaxActiveBlocksPerMultiprocessor(&per_cu, (const void*)mk_fwd, NTHR, LDS_BYTES) != hipSuccess || per_cu < 1) fprintf(stderr, "kernel_launch: occupancy query says %d\n", per_cu);
        (void)hipGetLastError();
        grid = cus;
    }
    if (grid < 0) return;
    (void)hipMemsetAsync((char*)d_ws + WS_CTL, 0, CTL_ZERO_BYTES, stream);
    Args a{};
    for (int i = 0; i < 29; ++i) a.in[i] = (const float*)d_in[i];
    a.out = (float*)d_out; a.ws = (unsigned char*)d_ws;
#if MK_ONE_LAUNCH
    a.ph_lo = 0; a.ph_hi = NSUB * 8 + 1;
    hipLaunchKernelGGL(mk_fwd, dim3(grid), dim3(NTHR), LDS_BYTES, stream, a);
#else
    for (int s = 0; s <= NSUB; ++s) {
        for (int k = 0; k < (s == NSUB ? 1 : 8); ++k) {
            const int L = s / 3, kind = s % 3; const bool even = !(L & 1);
            bool live;
            if (s == NSUB) live = true;
            else if (k == 0) live = (kind == 0);
            else if (k == 1 || k == 6) live = true;
            else if (k == 2) live = (kind == 1);
            else if (k == 3 || k == 4 || k == 5) live = (kind == 1) && even;
            else live = false;
            if (!live) continue;
            a.ph_lo = s * 8 + k; a.ph_hi = a.ph_lo + 1;
            hipLaunchKernelGGL(mk_fwd, dim3(grid), dim3(NTHR), LDS_BYTES, stream, a);
        }
    }
#endif
}
```

```cpp
#include <hip/hip_runtime.h>
#include <cstdio>
#include <cstdint>
#define MK_ONE_LAUNCH 1
namespace pg8 {
#define PG8_LAS __attribute__((address_space(3)))
typedef unsigned short bf16_t;
typedef short bf16x8 __attribute__((ext_vector_type(8)));
typedef float f32x4 __attribute__((ext_vector_type(4)));
typedef unsigned u32x4 __attribute__((ext_vector_type(4)));
constexpr int BM = 256, BK = 64, HALF = 128, HTB = HALF * BK * 2  , STAGE_BYTES = 8 * HTB, NXCD = 8, WGM = 8;

__host__ __device__ __forceinline__ int lds_byte(int r, int c) { const int st = (r >> 4) * 2 + (c >> 5), rr = r & 15, cc = c & 31, ob = rr * 64 + cc * 2; return st * 1024 + (ob ^ (((ob >> 9) & 1) << 5)); }
__host__ __device__ __forceinline__ void stage_rc(int b, int& R, int& C) { const int st = b / 1024, sb = b % 1024, swz = sb ^ (((sb >> 9) & 1) << 5); R = (st >> 1) * 16 + swz / 64; C = (st & 1) * 32 + (swz % 64) / 2; }
__host__ __device__ __forceinline__ int perm32(int rho) { const int n = rho >> 4, i = rho & 15; return 8 * (i >> 2) + 4 * n + (i & 3); }

struct Unit { int pm, pn; };
struct Gemm { const bf16_t* A; const bf16_t* Bt; int M, N, K; int amode = 0; };

struct StaticOrder {
    int nM, nN, nwg, G, c;
    __host__ __device__ void init(int M, int N, int G_, int c_) { nM = M / BM; nN = N / BM; nwg = nM * nN; G = G_; c = c_; }
    __host__ __device__ bool next(int i, Unit& u) const {
        const long L = (long)i * G + c; if (L >= nwg) return false;
        int wgid = (int)L; { const int q = nwg / NXCD, r = nwg % NXCD, xcd = wgid % NXCD, off = wgid / NXCD; wgid = (xcd < r ? xcd * (q + 1) : r * (q + 1) + (xcd - r) * q) + off; }
        const int nig = WGM * nN, gid = wgid / nig, fm = gid * WGM, gsz = (nM - fm) < WGM ? (nM - fm) : WGM;
        u.pm = fm + ((wgid % nig) % gsz); u.pn = (wgid % nig) / gsz; return true;
    }
    __device__ __forceinline__ void a_ready(const Unit&) const {}
    __device__ __forceinline__ void done(const Unit&) const {}
};
__device__ __forceinline__ unsigned cvt_pk_bf16(float lo, float hi) { unsigned r; asm volatile("v_cvt_pk_bf16_f32 %0, %1, %2" : "=v"(r) : "v"(lo), "v"(hi)); return r; }
typedef float f32x2 __attribute__((ext_vector_type(2)));
__device__ __forceinline__ f32x2 gelu_pk(f32x2 v) {
    const f32x2 av = __builtin_elementwise_abs(v), d = av * 0.2316418882f + 1.0f;
    f32x2 t; t.x = __builtin_amdgcn_rcpf(d.x); t.y = __builtin_amdgcn_rcpf(d.y);
    f32x2 q = t * 0.5307027145f + (-0.7265760135f); q = q * t + 0.7107068705f; q = q * t + (-0.142248368f); q = q * t + 0.127414796f; q = q * t;
    const f32x2 s = (v * v) * (-0.72134752044f);
    f32x2 e; e.x = __builtin_amdgcn_exp2f(s.x); e.y = __builtin_amdgcn_exp2f(s.y);
    const f32x2 m = v * (q * e), r = v - m;
    f32x2 o; o.x = v.x < 0.f ? m.x : r.x; o.y = v.y < 0.f ? m.y : r.y; return o;
}

constexpr int SS_M = 32768;
__device__ __forceinline__ float row_rs(const float* P, int row) {
    const float s = ((P[row] + P[SS_M + row]) + (P[2 * SS_M + row] + P[3 * SS_M + row])) + ((P[4 * SS_M + row] + P[5 * SS_M + row]) + (P[6 * SS_M + row] + P[7 * SS_M + row]));
    return rsqrtf(s * (1.0f / 2048.0f) + 1e-6f);
}
__device__ __forceinline__ void panel_rs(const float* ss, PG8_LAS float* rc, int pm, int t) {
    PG8_LAS int* tag = (PG8_LAS int*)(rc + BM);
    const int have = *tag;
    if (have != pm && t < BM) rc[t] = row_rs(ss, pm * BM + t);
    asm volatile("s_waitcnt lgkmcnt(0)" ::: "memory"); __builtin_amdgcn_s_barrier(); asm volatile("" ::: "memory");
    if (have != pm && t == 0) *tag = pm;
}
struct EpiSwiGLU {
    static constexpr bool PERM = true, AFTER_DRAIN = false;
    bf16_t* O; int ldc; const float* ss; PG8_LAS float* rc;
    __device__ __forceinline__ void operator()(const f32x4 (&acc)[2][2][4][2], const Unit& u, int wr, int wc, int fr, int fq) const {
        const int row0 = u.pm * BM + wr * 64 + fr, col0 = u.pn * HALF + wc * 32 + 8 * fq;
        panel_rs(ss, rc, u.pm, (wr * 4 + wc) * 64 + fq * 16 + fr);
#pragma unroll
        for (int ai = 0; ai < 2; ++ai)
#pragma unroll
            for (int m = 0; m < 4; ++m) {
                const int row = row0 + ai * HALF + m * 16;
                const float rs = rc[row - u.pm * BM];
                float o[8];
#pragma unroll
                for (int n = 0; n < 2; ++n)
#pragma unroll
                    for (int j = 0; j < 4; ++j) { const float g = acc[ai][0][m][n][j] * rs, up = acc[ai][1][m][n][j] * rs; o[4 * n + j] = g * __builtin_amdgcn_rcpf(1.0f + __expf(-g)) * up; }
                u32x4 w; w.x = cvt_pk_bf16(o[0], o[1]); w.y = cvt_pk_bf16(o[2], o[3]); w.z = cvt_pk_bf16(o[4], o[5]); w.w = cvt_pk_bf16(o[6], o[7]);
                *(u32x4*)(O + ((size_t)(u.pm * (ldc >> 6) + (col0 >> 6)) * BM + (row - u.pm * BM)) * BK + (col0 & 63)) = w;
                asm volatile("" ::: "memory");
            }
    }
};
struct EpiResid {
    static constexpr bool PERM = true, AFTER_DRAIN = false;
    bf16_t* xb; float* ssn; float scale; PG8_LAS float* sp;
    int noop = 0;
    __device__ __forceinline__ void operator()(const f32x4 (&acc)[2][2][4][2], const Unit& u, int wr, int wc, int fr, int fq) const {
        const int row0 = u.pm * BM + wr * 64 + fr, col0 = u.pn * BM + wc * 32 + 8 * fq;
        if (noop) return;
        u32x4 bn[2];
#pragma unroll
        for (int bj = 0; bj < 2; ++bj) bn[bj] = *(const u32x4*)(xb + (size_t)row0 * 2048 + col0 + bj * HALF);
#pragma unroll
        for (int gi = 0; gi < 8; ++gi) {
            const int ai = gi >> 2, m = gi & 3;
            const int row = row0 + ai * HALF + m * 16; const size_t off = (size_t)row * 2048 + col0; float s = 0.f;
            u32x4 bc[2]; bc[0] = bn[0]; bc[1] = bn[1];
            if (gi < 7) { const size_t off2 = (size_t)(row0 + ((gi + 1) >> 2) * HALF + ((gi + 1) & 3) * 16) * 2048 + col0;
#pragma unroll
                for (int bj = 0; bj < 2; ++bj) bn[bj] = *(const u32x4*)(xb + off2 + bj * HALF); }
#pragma unroll
            for (int bj = 0; bj < 2; ++bj) {
                const f32x4 a0 = acc[ai][bj][m][0] * scale, a1 = acc[ai][bj][m][1] * scale; const u32x4 b = bc[bj]; u32x4 w;
                w.x = cvt_pk_bf16(__uint_as_float(b.x << 16) + a0[0], __uint_as_float(b.x & 0xffff0000u) + a0[1]);
                w.y = cvt_pk_bf16(__uint_as_float(b.y << 16) + a0[2], __uint_as_float(b.y & 0xffff0000u) + a0[3]);
                w.z = cvt_pk_bf16(__uint_as_float(b.z << 16) + a1[0], __uint_as_float(b.z & 0xffff0000u) + a1[1]);
                w.w = cvt_pk_bf16(__uint_as_float(b.w << 16) + a1[2], __uint_as_float(b.w & 0xffff0000u) + a1[3]);
                *(u32x4*)(xb + off + bj * HALF) = w;
                const float r0 = __uint_as_float(w.x << 16), r1 = __uint_as_float(w.x & 0xffff0000u), r2 = __uint_as_float(w.y << 16), r3 = __uint_as_float(w.y & 0xffff0000u);
                const float r4 = __uint_as_float(w.z << 16), r5 = __uint_as_float(w.z & 0xffff0000u), r6 = __uint_as_float(w.w << 16), r7 = __uint_as_float(w.w & 0xffff0000u);
                s += ((r0 * r0 + r1 * r1) + (r2 * r2 + r3 * r3)) + ((r4 * r4 + r5 * r5) + (r6 * r6 + r7 * r7));
            }
            s += __shfl_xor(s, 16); s += __shfl_xor(s, 32);
            if (fq == 0) sp[(ai * HALF + wr * 64 + m * 16 + fr) * 4 + wc] = s;
            asm volatile("" ::: "memory");
        }
        asm volatile("s_waitcnt lgkmcnt(0)" ::: "memory"); __builtin_amdgcn_s_barrier(); asm volatile("" ::: "memory");
        const int t = (wr * 4 + wc) * 64 + fq * 16 + fr;
        if (t < BM) { const f32x4 p = *(const PG8_LAS f32x4*)(sp + t * 4); ssn[(size_t)u.pn * SS_M + u.pm * BM + t] = (p[0] + p[1]) + (p[2] + p[3]); }
    }
};
struct EpiZ {
    static constexpr bool PERM = true, AFTER_DRAIN = false;
    bf16_t* O; int ldc; const float* ss; const float* bias; PG8_LAS float* rc;
    __device__ __forceinline__ void operator()(const f32x4 (&acc)[2][2][4][2], const Unit& u, int wr, int wc, int fr, int fq) const {
        const int row0 = u.pm * BM + wr * 64 + fr, col0 = u.pn * BM + wc * 32 + 8 * fq;
        panel_rs(ss, rc, u.pm, (wr * 4 + wc) * 64 + fq * 16 + fr);
        const bool hb = u.pn < 6;
        f32x4 bv[2][2];
#pragma unroll
        for (int bj = 0; bj < 2; ++bj)
#pragma unroll
            for (int n = 0; n < 2; ++n) bv[bj][n] = hb ? *(const f32x4*)(bias + col0 + bj * HALF + 4 * n) : (f32x4){0.f, 0.f, 0.f, 0.f};
#pragma unroll
        for (int ai = 0; ai < 2; ++ai)
#pragma unroll
            for (int m = 0; m < 4; ++m) {
                const int row = row0 + ai * HALF + m * 16;
                const float rs = rc[row - u.pm * BM];
                bf16_t* rowp = O + (size_t)row * ldc + col0;
#pragma unroll
                for (int bj = 0; bj < 2; ++bj) {
                    const f32x4 v0 = acc[ai][bj][m][0] * rs + bv[bj][0], v1 = acc[ai][bj][m][1] * rs + bv[bj][1];
                    u32x4 w; w.x = cvt_pk_bf16(v0[0], v0[1]); w.y = cvt_pk_bf16(v0[2], v0[3]); w.z = cvt_pk_bf16(v1[0], v1[1]); w.w = cvt_pk_bf16(v1[2], v1[3]);
                    *(u32x4*)(rowp + bj * HALF) = w;
                }
                asm volatile("" ::: "memory");
            }
    }
};
struct EpiGeluV {
    static constexpr bool PERM = true, AFTER_DRAIN = false;
    bf16_t* O; int ldc; const float* ss; float* ssv; PG8_LAS float* sp; PG8_LAS float* rc;
    __device__ __forceinline__ void operator()(const f32x4 (&acc)[2][2][4][2], const Unit& u, int wr, int wc, int fr, int fq) const {
        const int row0 = u.pm * BM + wr * 64 + fr, col0 = u.pn * BM + wc * 32 + 8 * fq;
        panel_rs(ss, rc, u.pm, (wr * 4 + wc) * 64 + fq * 16 + fr);
        const bool isv = u.pn >= 8;
#pragma unroll
        for (int ai = 0; ai < 2; ++ai)
#pragma unroll
            for (int m = 0; m < 4; ++m) {
                const int row = row0 + ai * HALF + m * 16;
                const float rs = rc[row - u.pm * BM];
                bf16_t* rowp = O + (size_t)row * ldc + col0; float s = 0.f;
#pragma unroll
                for (int bj = 0; bj < 2; ++bj) {
                    f32x4 v0 = acc[ai][bj][m][0] * rs, v1 = acc[ai][bj][m][1] * rs;
                    const f32x2 a = gelu_pk((f32x2){v0[0], v0[1]}), b = gelu_pk((f32x2){v0[2], v0[3]}), c = gelu_pk((f32x2){v1[0], v1[1]}), d = gelu_pk((f32x2){v1[2], v1[3]});
                    s += (a.x * a.x + a.y * a.y) + (b.x * b.x + b.y * b.y) + (c.x * c.x + c.y * c.y) + (d.x * d.x + d.y * d.y);
                    u32x4 w; w.x = cvt_pk_bf16(a.x, a.y); w.y = cvt_pk_bf16(b.x, b.y); w.z = cvt_pk_bf16(c.x, c.y); w.w = cvt_pk_bf16(d.x, d.y);
                    *(u32x4*)(rowp + bj * HALF) = w;
                }
                if (isv) { s += __shfl_xor(s, 16); s += __shfl_xor(s, 32); if (fq == 0) sp[(ai * HALF + wr * 64 + m * 16 + fr) * 4 + wc] = s; }
                asm volatile("" ::: "memory");
            }
        if (isv) {
            asm volatile("s_waitcnt lgkmcnt(0)" ::: "memory"); __builtin_amdgcn_s_barrier(); asm volatile("" ::: "memory");
            const int t = (wr * 4 + wc) * 64 + fq * 16 + fr;
            if (t < BM) { const f32x4 p = *(const PG8_LAS f32x4*)(sp + t * 4); ssv[(size_t)(u.pn - 8) * SS_M + u.pm * BM + t] = (p[0] + p[1]) + (p[2] + p[3]); }
        }
    }
};
template <class Epi, class Sched, bool ALIGN_EPI = false, bool SP2 = false>
__device__ __forceinline__ void gemm_phase(PG8_LAS unsigned char* lds, const Gemm g, const Sched& S, const Epi& E) {
    int tid_ = threadIdx.x; asm volatile("" : "+v"(tid_));
    const int tid = tid_, wid = __builtin_amdgcn_readfirstlane(tid >> 6), lane = tid & 63, wr = wid >> 2, wc = wid & 3, fr = lane & 15, fq = lane >> 4;
    const int K = g.K, nt = K / BK;
    unsigned voffA[2], voffB[2];
#pragma unroll
    for (int i = 0; i < 2; ++i) { int R, C; stage_rc(tid * 16 + i * 8192, R, C); const int Rb = Epi::PERM ? ((R & ~31) + perm32(R & 31)) : R;
        voffA[i] = g.amode ? (unsigned)(R * BK + C) * 2u : (unsigned)(R * K + C) * 2u; voffB[i] = (unsigned)(Rb * K + C) * 2u; }
    const size_t kstep = (size_t)(BK * 2);
    const size_t hstep = (size_t)HALF * K * 2;
    const size_t tstep = 2 * hstep;
    const size_t kstepA = g.amode ? (size_t)(BM * BK * 2) : kstep, hstepA = g.amode ? (size_t)(HALF * BK * 2) : hstep, tstepA = g.amode ? (size_t)(K / BK) * (BM * BK * 2) : tstep;
    const unsigned ldsw = (unsigned)wid * 1024u;
    const int aoff = lds_byte(wr * 64 + fr, fq * 8), boff = lds_byte(wc * 32 + fr, fq * 8);
#define PG8_SA(b, h) (((b) * 2 + (h)) * HTB)
#define PG8_SB(b, h) ((4 + (b) * 2 + (h)) * HTB)
#define PG8_STAGE(bufoff, gbase, voff) do { _Pragma("unroll") for (int _i = 0; _i < 2; ++_i) \
        __builtin_amdgcn_global_load_lds((const unsigned*)((const char*)(gbase) + (voff)[_i]), (PG8_LAS unsigned*)(lds + (bufoff) + ldsw + _i * 8192), 16, 0, 0); } while (0)
#define PG8_LDA(dst, b, h) do { _Pragma("unroll") for (int m = 0; m < 4; ++m) _Pragma("unroll") for (int k = 0; k < 2; ++k) dst[m][k] = *(const PG8_LAS bf16x8*)(lds + PG8_SA(b, h) + aoff + m * 2048 + k * 1024); } while (0)
#define PG8_LDB(dst, b, h) do { _Pragma("unroll") for (int n = 0; n < 2; ++n) _Pragma("unroll") for (int k = 0; k < 2; ++k) dst[n][k] = *(const PG8_LAS bf16x8*)(lds + PG8_SB(b, h) + boff + n * 2048 + k * 1024); } while (0)
#define PG8_MMA(ai, bj, At, Bt) do { __builtin_amdgcn_s_setprio(1); _Pragma("unroll") for (int m = 0; m < 4; ++m) _Pragma("unroll") for (int n = 0; n < 2; ++n) _Pragma("unroll") for (int k = 0; k < 2; ++k) \
        acc[ai][bj][m][n] = __builtin_amdgcn_mfma_f32_16x16x32_bf16(Bt[n][k], At[m][k], acc[ai][bj][m][n], 0, 0, 0); __builtin_amdgcn_s_setprio(0); } while (0)
#define PG8_WAIT_V(n) asm volatile("s_waitcnt vmcnt(" #n ")" ::: "memory")
#define PG8_WAIT_L(n) asm volatile("s_waitcnt lgkmcnt(" #n ")" ::: "memory")
#define PG8_BAR __builtin_amdgcn_s_barrier()
#define PG8_SCHED __builtin_amdgcn_sched_barrier(0)
    Unit cur, nxt; int ui = 0;
    if (!S.next(0, cur)) return;
    f32x4 acc[2][2][4][2];
#pragma unroll
    for (int a = 0; a < 2; ++a)
#pragma unroll
        for (int b = 0; b < 2; ++b)
#pragma unroll
            for (int m = 0; m < 4; ++m)
#pragma unroll
                for (int n = 0; n < 2; ++n) acc[a][b][m][n] = (f32x4){0.f, 0.f, 0.f, 0.f};
    bf16x8 At[4][2], B0[2][2], B1[2][2];
    const char* cA = (const char*)g.A + (size_t)cur.pm * tstepA; const char* cB = (const char*)g.Bt + (size_t)cur.pn * tstep;
    S.a_ready(cur);
    if constexpr (SP2) {
        PG8_STAGE(PG8_SB(0, 0), cB, voffB); PG8_STAGE(PG8_SB(0, 1), cB + hstep, voffB); PG8_STAGE(PG8_SA(0, 0), cA, voffA); PG8_STAGE(PG8_SA(0, 1), cA + hstepA, voffA);
        if (wr == 1) PG8_BAR;
        PG8_WAIT_V(2); PG8_BAR;
        PG8_STAGE(PG8_SB(1, 0), cB + kstep, voffB); PG8_STAGE(PG8_SA(1, 0), cA + kstepA, voffA); PG8_STAGE(PG8_SB(1, 1), cB + hstep + kstep, voffB);
        PG8_WAIT_V(6); PG8_BAR;
    } else {
        PG8_STAGE(PG8_SB(0, 0), cB, voffB); PG8_STAGE(PG8_SA(0, 0), cA, voffA); PG8_STAGE(PG8_SB(0, 1), cB + hstep, voffB); PG8_STAGE(PG8_SA(0, 1), cA + hstepA, voffA);
        if (wr == 1) PG8_BAR;
        PG8_WAIT_V(4); PG8_BAR;
        PG8_STAGE(PG8_SB(1, 0), cB + kstep, voffB); PG8_STAGE(PG8_SA(1, 0), cA + kstepA, voffA); PG8_STAGE(PG8_SB(1, 1), cB + hstep + kstep, voffB);
        PG8_WAIT_V(6); PG8_BAR;
    }
    for (;;) {
        const bool has_next = S.next(ui + 1, nxt);
        const char* nA = has_next ? (const char*)g.A + (size_t)nxt.pm * tstepA : cA; const char* nB = has_next ? (const char*)g.Bt + (size_t)nxt.pn * tstep : cB;
        for (int t = 0; t < nt; t += 2) {
            const bool last = (t == nt - 2);
            const char* a1 = cA + (size_t)(t + 1) * kstepA;
            const char* a2 = last ? nA : cA + (size_t)(t + 2) * kstepA; const char* b2 = last ? nB : cB + (size_t)(t + 2) * kstep;
            const char* a3 = a2 + kstepA; const char* b3 = b2 + kstep;
            if (last && has_next) S.a_ready(nxt);
            if constexpr (SP2) {
            PG8_LDB(B0, 0, 0); PG8_LDB(B1, 0, 1); PG8_SCHED; PG8_LDA(At, 0, 0); PG8_STAGE(PG8_SA(1, 1), a1 + hstepA, voffA);
            PG8_WAIT_V(8); PG8_WAIT_L(0); PG8_BAR; PG8_MMA(0, 0, At, B0); PG8_MMA(0, 1, At, B1); PG8_BAR; PG8_SCHED;
            PG8_LDA(At, 0, 1); PG8_STAGE(PG8_SB(0, 0), b2, voffB); PG8_STAGE(PG8_SB(0, 1), b2 + hstep, voffB); PG8_STAGE(PG8_SA(0, 0), a2, voffA);
            PG8_WAIT_V(8); PG8_WAIT_L(0); PG8_BAR; PG8_MMA(1, 0, At, B0); PG8_MMA(1, 1, At, B1); PG8_BAR; PG8_SCHED;
            PG8_LDB(B0, 1, 0); PG8_LDB(B1, 1, 1); PG8_SCHED; PG8_LDA(At, 1, 0); PG8_STAGE(PG8_SA(0, 1), a2 + hstepA, voffA);
            PG8_WAIT_V(8); PG8_WAIT_L(0); PG8_BAR; PG8_MMA(0, 0, At, B0); PG8_MMA(0, 1, At, B1); PG8_BAR; PG8_SCHED;
            PG8_LDA(At, 1, 1); PG8_STAGE(PG8_SB(1, 0), b3, voffB); PG8_STAGE(PG8_SB(1, 1), b3 + hstep, voffB); PG8_STAGE(PG8_SA(1, 0), a3, voffA);
            PG8_WAIT_V(8); PG8_WAIT_L(0); PG8_BAR; PG8_MMA(1, 0, At, B0); PG8_MMA(1, 1, At, B1); PG8_BAR; PG8_SCHED;
            } else {
            PG8_LDB(B0, 0, 0); PG8_SCHED; PG8_LDA(At, 0, 0); PG8_STAGE(PG8_SA(1, 1), a1 + hstepA, voffA);
            PG8_WAIT_L(8); PG8_BAR; PG8_WAIT_L(0); PG8_MMA(0, 0, At, B0); PG8_BAR; PG8_SCHED;
            PG8_LDB(B1, 0, 1); PG8_STAGE(PG8_SB(0, 0), b2, voffB);
            PG8_BAR; PG8_WAIT_L(0); PG8_MMA(0, 1, At, B1); PG8_BAR;
            PG8_LDA(At, 0, 1); PG8_STAGE(PG8_SA(0, 0), a2, voffA);
            PG8_BAR; PG8_WAIT_L(0); PG8_MMA(1, 0, At, B0); PG8_BAR; PG8_SCHED;
            PG8_STAGE(PG8_SB(0, 1), b2 + hstep, voffB);
            PG8_WAIT_V(6); PG8_BAR; PG8_MMA(1, 1, At, B1); PG8_BAR;
            PG8_LDB(B0, 1, 0); PG8_SCHED; PG8_LDA(At, 1, 0); PG8_STAGE(PG8_SA(0, 1), a2 + hstepA, voffA);
            PG8_WAIT_L(8); PG8_BAR; PG8_WAIT_L(0); PG8_MMA(0, 0, At, B0); PG8_BAR; PG8_SCHED;
            PG8_LDB(B1, 1, 1); PG8_STAGE(PG8_SB(1, 0), b3, voffB);
            PG8_BAR; PG8_WAIT_L(0); PG8_MMA(0, 1, At, B1); PG8_BAR;
            PG8_LDA(At, 1, 1); PG8_STAGE(PG8_SA(1, 0), a3, voffA);
            PG8_BAR; PG8_WAIT_L(0); PG8_MMA(1, 0, At, B0); PG8_BAR; PG8_SCHED;
            PG8_STAGE(PG8_SB(1, 1), b3 + hstep, voffB);
            PG8_WAIT_V(6); PG8_BAR; PG8_MMA(1, 1, At, B1); PG8_BAR;
            }
        }
        if constexpr (ALIGN_EPI) { if (wr == 0) PG8_BAR; }
        if constexpr (!Epi::AFTER_DRAIN) { E(acc, cur, wr, wc, fr, fq); S.done(cur); }
        if (!has_next) break;
#pragma unroll
        for (int a = 0; a < 2; ++a)
#pragma unroll
            for (int b = 0; b < 2; ++b)
#pragma unroll
                for (int m = 0; m < 4; ++m)
#pragma unroll
                    for (int n = 0; n < 2; ++n) acc[a][b][m][n] = (f32x4){0.f, 0.f, 0.f, 0.f};
        cur = nxt; cA = nA; cB = nB; ++ui;
        if constexpr (ALIGN_EPI) { if (wr == 1) PG8_BAR; }
    }
    PG8_WAIT_V(0);
    if constexpr (!ALIGN_EPI) { if (wr == 0) PG8_BAR; }
    PG8_BAR;
    if constexpr (Epi::AFTER_DRAIN) { E.fused(acc, cur, wr, wc, fr, fq, lds, wid, lane); S.done(cur); }
#undef PG8_SA
#undef PG8_SB
#undef PG8_STAGE
#undef PG8_LDA
#undef PG8_LDB
#undef PG8_MMA
#undef PG8_WAIT_V
#undef PG8_WAIT_L
#undef PG8_BAR
#undef PG8_SCHED
}
}
#define LAS_BAR __attribute__((address_space(3)))
#define XB_TMO      128
#define XB_XCNT(j)  (256  + 64 * (j))
#define XB_XSUB(j)  (1280 + 64 * (j))
#define XB_XGEN(j)  (2304 + 64 * (j))
#define XB_TOP      3328
#define XB_TOPGEN   3392
#define XCD_BAR_WORDS 3456
#define XB_SPIN_CAP (1u << 22)

__device__ __forceinline__ unsigned xb_ld(unsigned* p)              { return __hip_atomic_load(p, __ATOMIC_RELAXED, __HIP_MEMORY_SCOPE_AGENT); }
__device__ __forceinline__ unsigned xb_add(unsigned* p, unsigned v) { return __hip_atomic_fetch_add(p, v, __ATOMIC_RELAXED, __HIP_MEMORY_SCOPE_AGENT); }
__device__ __forceinline__ unsigned xb_xcc_id() { return (unsigned)__builtin_amdgcn_s_getreg((3 << 11) | 20) & 0xFu; }
#define XB_SPIN(cond, bar) do { unsigned _sp = 0; while (cond) { __builtin_amdgcn_s_sleep(1); \
    if ((++_sp & 255u) == 0u) { if (xb_ld(&(bar)[XB_TMO])) break; if (_sp > XB_SPIN_CAP) { atomicAdd(&(bar)[XB_TMO], 1u); break; } } } } while (0)

struct XcdBarrier {
    unsigned* bar; unsigned x;
    volatile LAS_BAR unsigned* st;
};

__device__ __forceinline__ XcdBarrier xcd_barrier_post(unsigned* bar, volatile LAS_BAR unsigned* st) {
    XcdBarrier b; b.bar = bar; b.x = xb_xcc_id(); b.st = st;
    if (threadIdx.x == 0) (void)xb_add(&bar[XB_XCNT(b.x)], 1u);
    return b;
}
__device__ __forceinline__ void xcd_barrier_complete(unsigned* bar, unsigned x, unsigned& nloc, unsigned& nx) {
    const unsigned G = gridDim.x * gridDim.y * gridDim.z;
    unsigned sum, cnt, mine, sp = 0u;
    for (;;) {
        sum = 0u; cnt = 0u; mine = 0u;
#pragma unroll
        for (unsigned j = 0; j < 16; ++j) { const unsigned c = xb_ld(&bar[XB_XCNT(j)]); sum += c; cnt += (c > 0u) ? 1u : 0u; mine = (j == x) ? c : mine; }
        if (sum == G) break;
        __builtin_amdgcn_s_sleep(1);
        if ((++sp & 255u) == 0u) { if (xb_ld(&bar[XB_TMO])) break; if (sp > XB_SPIN_CAP) { atomicAdd(&bar[XB_TMO], 1u); break; } }
    }
    nloc = mine > 0u ? mine : 1u; nx = cnt > 0u ? cnt : 1u;
}

__device__ __forceinline__ void xcd_barrier(const XcdBarrier& b) {
    asm volatile("s_waitcnt vmcnt(0)" ::: "memory");
    __syncthreads();
    if (threadIdx.x == 0) {
        unsigned* bar = b.bar;
        __builtin_amdgcn_s_waitcnt(0);
        unsigned nloc = b.st[0], nx = b.st[1];
        if (nloc == 0u) { xcd_barrier_complete(bar, b.x, nloc, nx); b.st[0] = nloc; b.st[1] = nx; }
        const unsigned old = xb_add(&bar[XB_XSUB(b.x)], 1u);
        const unsigned gen = old / nloc;
        if (old + 1u == (gen + 1u) * nloc) {
            __builtin_amdgcn_fence(__ATOMIC_RELEASE, "agent");
            asm volatile("s_waitcnt vmcnt(0)" ::: "memory");
            const unsigned og = xb_add(&bar[XB_TOP], 1u);
            const unsigned tg = og / nx;
            if (og + 1u == (tg + 1u) * nx) xb_add(&bar[XB_TOPGEN], 1u);
            else XB_SPIN(xb_ld(&bar[XB_TOPGEN]) == tg, bar);
            __builtin_amdgcn_fence(__ATOMIC_ACQUIRE, "agent");
            xb_add(&bar[XB_XGEN(b.x)], 1u);
            asm volatile("s_waitcnt vmcnt(0)" ::: "memory");
        } else {
            XB_SPIN(xb_ld(&bar[XB_XGEN(b.x)]) == gen, bar);
            __builtin_amdgcn_fence(__ATOMIC_ACQUIRE, "agent");
            asm volatile("s_waitcnt vmcnt(0)" ::: "memory");
        }
    }
    __syncthreads();
}

constexpr int NWAVES = 8, NTHR = 512;
constexpr int BATCH = 2, T = 16384, D = 2048, FF = 5632, M = BATCH * T;
constexpr int ZN = 5120;
constexpr int ZA = 1536;
constexpr int A_COLS = 3360, E_IN = 4896;
constexpr int ZO = 4096;
constexpr int NSUB = 12;
#ifndef MK_ONE_LAUNCH
#define MK_ONE_LAUNCH 0
#endif

constexpr size_t MiB = 1u << 20;
constexpr size_t WS_CTL = 0, CTL_ZERO_BYTES = 1 * MiB;
constexpr size_t WS_SS = 1 * MiB;
constexpr size_t SS_REC = 8 * (size_t)M;
constexpr size_t WS_WT = 16 * MiB;
constexpr size_t WT_GU1 = WS_WT, WT_D1 = WT_GU1 + 44 * MiB, WT_GU2 = WT_D1 + 22 * MiB, WT_D2 = WT_GU2 + 44 * MiB, WT_IN = WT_D2 + 22 * MiB, WT_OUT = WT_IN + 20 * MiB;
constexpr size_t WS_XB = WT_OUT + 8 * MiB;
constexpr size_t WS_ACT = WS_XB + 128 * MiB;
constexpr size_t WS_SC = WS_ACT + 352 * MiB;
constexpr size_t SC_R = WS_SC, SC_K2 = SC_R + 64 * MiB, SC_KK = SC_K2 + 64 * MiB, SC_BB = SC_KK + 64 * MiB, SC_LW = SC_BB + 64 * MiB, SC_GG = SC_LW + 64 * MiB;
constexpr size_t WS_VF = SC_GG + 64 * MiB;
constexpr size_t WS_V2 = WS_VF + 64 * MiB;
constexpr size_t WS_O = WS_V2 + 64 * MiB;
constexpr size_t WS_SM = WS_O + 128 * MiB;
constexpr size_t SM_W2T = WS_SM, SM_A2T = SM_W2T + 131072, SM_G2T = SM_A2T + 131072, SM_V1T = SM_G2T + 327680, SM_V2T = SM_V1T + 65536, SM_WSB = SM_V2T + 65536;
constexpr size_t WS_U0 = WS_SM + 2 * MiB;
constexpr size_t WS_END = WS_U0 + 64 * MiB;
static_assert(SM_WSB + 524288 <= WS_END, "small-weight map");
static_assert(WT_OUT + 8 * MiB == 176 * MiB && WS_SS + 15 * MiB <= WS_WT, "weight map");
constexpr int CW_TMO = 0, CW_CODE = 1, CW_BAR = 4096;

constexpr int LDS_BYTES = 147456, LDSCTL_OFF = LDS_BYTES - 512;

#define GAS __attribute__((address_space(1)))
#define LAS __attribute__((address_space(3)))
typedef unsigned short bf16;
typedef unsigned v4u __attribute__((ext_vector_type(4)));
typedef unsigned v2u __attribute__((ext_vector_type(2)));
typedef float f32x4 __attribute__((ext_vector_type(4)));
typedef float f32x2 __attribute__((ext_vector_type(2)));
typedef GAS unsigned gu32;
#define RLX_AGENT __ATOMIC_RELAXED, __HIP_MEMORY_SCOPE_AGENT
#define LDS_WAIT() asm volatile("s_waitcnt lgkmcnt(0)" ::: "memory")
__device__ __forceinline__ unsigned f2bf(float f) { unsigned u = __builtin_bit_cast(unsigned, f); return (u + 0x7fffu + ((u >> 16) & 1u)) >> 16; }
typedef __bf16 bf16x2_hw __attribute__((ext_vector_type(2)));
__device__ __forceinline__ unsigned pk2(float lo, float hi) { const bf16x2_hw b = __builtin_convertvector((f32x2){lo, hi}, bf16x2_hw); return __builtin_bit_cast(unsigned, b); }
__device__ __forceinline__ float bf2f(bf16 b) { return __builtin_bit_cast(float, (unsigned)b << 16); }
__device__ __forceinline__ float bflo(unsigned w) { return __builtin_bit_cast(float, w << 16); }
__device__ __forceinline__ float bfhi(unsigned w) { return __builtin_bit_cast(float, w & 0xffff0000u); }
__device__ __forceinline__ float wave_sum(float v) {
#pragma unroll
    for (int o = 1; o < 64; o <<= 1) v += __shfl_xor(v, o);
    return v;
}
template <int CTRL> __device__ __forceinline__ float dpp_mov(float v) { return __builtin_bit_cast(float, __builtin_amdgcn_update_dpp(0, __builtin_bit_cast(int, v), CTRL, 0xf, 0xf, true)); }
__device__ __forceinline__ float row16_sum(float v) { v += dpp_mov<0xB1>(v); v += dpp_mov<0x4E>(v); v += dpp_mov<0x141>(v); v += dpp_mov<0x140>(v); return v; }
__device__ __forceinline__ float sigmoidf_(float x) { return 1.0f / (1.0f + __expf(-x)); }

__device__ __forceinline__ int opaque(int v) { asm volatile("" : "+v"(v)); return v; }
struct Args { const float* in[29]; float* out; unsigned char* ws; int ph_lo, ph_hi; };
static_assert(sizeof(Args) == 29 * 8 + 8 + 8 + 8, "Args has no padding");
enum { I_X = 0, I_NG, I_WG, I_WU, I_WD, I_EWIN, I_EBQKV, I_EMU, I_EW0, I_EW2, I_EA0, I_EA2, I_EG2, I_EKK, I_EKA, I_ERK, I_EGNG, I_EGNB, I_ESINK, I_EWOUT, I_V0, I_V1, I_V2, I_OWIN, I_OVNG, I_OWS, I_OBS, I_OWOUT, I_FG };

struct TrDesc { const float* W; const float* gk; bf16* WT; int ldw, k0, c0, K, drow0; bool zero; };
__device__ __forceinline__ void tr_load(const TrDesc& d, float (&v)[32], int lane) {
#pragma unroll
    for (int i = 0; i < 32; ++i) { const int kk = 2 * i + (lane >> 5); v[i] = d.zero ? 0.f : d.W[(size_t)(d.k0 + kk) * d.ldw + d.c0 + (lane & 31)]; }
}
__device__ __forceinline__ void tr_store(const TrDesc& d, const float (&v)[32], LAS float* scr, int lane) {
#pragma unroll
    for (int i = 0; i < 32; ++i) { const int kk = 2 * i + (lane >> 5); float x = v[i]; if (d.gk) x *= d.gk[d.k0 + kk]; scr[kk * 33 + (lane & 31)] = x; }
    LDS_WAIT(); asm volatile("" ::: "memory");
    const int c = lane & 7;
#pragma unroll
    for (int j = 0; j < 4; ++j) { const int n = (lane >> 3) + 8 * j; const LAS float* s = scr + (8 * c) * 33 + n;
        v4u o; o.x = pk2(s[0 * 33], s[1 * 33]); o.y = pk2(s[2 * 33], s[3 * 33]); o.z = pk2(s[4 * 33], s[5 * 33]); o.w = pk2(s[6 * 33], s[7 * 33]);
        *(GAS v4u*)(d.WT + (size_t)(d.drow0 + n) * d.K + d.k0 + 8 * c) = o; }
    LDS_WAIT(); asm volatile("" ::: "memory");
}
__device__ __forceinline__ TrDesc tr_desc(const Args& a, int L, int it) {
    unsigned char* ws = a.ws; const bool even = !(L & 1); const int li = L >> 1;
    constexpr int nGU = 32 * 352, nD = 88 * 64; const int nIN = 32 * (even ? 160 : 128);
    TrDesc d; d.zero = false; int r = it;
    if (r < 2 * nGU) { const int f = r / nGU; r -= f * nGU; const int kb = r / 352, rb = r % 352, tj = rb >> 3, sub = rb & 7;
        d.W = (sub < 4 ? a.in[I_WG] : a.in[I_WU]) + (size_t)(L * 2 + f) * D * FF; d.ldw = FF; d.k0 = 64 * kb; d.c0 = 128 * tj + 32 * (sub & 3); d.gk = a.in[I_NG] + (L * 3 + (f ? 2 : 0)) * D;
        d.WT = (bf16*)(ws + (f ? WT_GU2 : WT_GU1)); d.K = D; d.drow0 = 32 * rb; return d; }
    r -= 2 * nGU;
    if (r < 2 * nD) { const int f = r / nD; r -= f * nD; const int kb = r / 64, nb = r % 64;
        d.W = a.in[I_WD] + (size_t)(L * 2 + f) * FF * D; d.ldw = D; d.k0 = 64 * kb; d.c0 = 32 * nb; d.gk = nullptr; d.WT = (bf16*)(ws + (f ? WT_D2 : WT_D1)); d.K = FF; d.drow0 = 32 * nb; return d; }
    r -= 2 * nD;
    if (r < nIN) {
        d.gk = a.in[I_NG] + (L * 3 + 1) * D; d.WT = (bf16*)(ws + WT_IN); d.K = D;
        if (even) { const int kb = r / 160, rb = r % 160, dd = 32 * rb; d.zero = dd >= E_IN; d.W = a.in[I_EWIN] + (size_t)li * D * E_IN; d.ldw = E_IN; d.k0 = 64 * kb; d.c0 = d.zero ? 0 : (dd < ZA ? A_COLS + dd : dd - ZA); d.drow0 = dd; }
        else { const int kb = r / 128, rb = r % 128; d.W = a.in[I_OWIN] + (size_t)li * D * ZO; d.ldw = ZO; d.k0 = 64 * kb; d.c0 = 32 * rb; d.drow0 = 32 * rb; }
        return d; }
    r -= nIN;
    { const int kb = r / 64, nb = r % 64; d.W = (even ? a.in[I_EWOUT] : a.in[I_OWOUT]) + (size_t)li * D * D; d.ldw = D; d.k0 = 64 * kb; d.c0 = 32 * nb; d.gk = nullptr; d.WT = (bf16*)(ws + WT_OUT); d.K = D; d.drow0 = 32 * nb; }
    return d;
}
__device__ __forceinline__ void prep_phase(const Args& a, int L, LAS unsigned char* lds, int vcu, int G, int wave, int lane) {
    asm volatile("" : "+s"(G));
    LAS float* scr = (LAS float*)(lds + wave * 16384);
    const int gw = vcu * NWAVES + wave, NGW = G * NWAVES;
    unsigned char* ws = a.ws;
    const bool even = !(L & 1); const int li = L >> 1;
    const int total = 2 * (32 * 352) + 2 * (88 * 64) + 32 * (even ? 160 : 128) + 32 * 64;
    if (gw < total) {
        TrDesc d0 = tr_desc(a, L, gw); float v0[32]; tr_load(d0, v0, lane);
        for (int it = gw; it < total; it += NGW) {
            const int itn = it + NGW; const bool hasn = itn < total;
            TrDesc d1 = tr_desc(a, L, hasn ? itn : it); float v1[32];
            if (hasn) tr_load(d1, v1, lane);
            tr_store(d0, v0, scr, lane);
            d0 = d1;
#pragma unroll
            for (int i = 0; i < 32; ++i) v0[i] = v1[i];
        }
    }
    {
        const int gt = gw * 64 + lane, NGT = NGW * 64;
        if (even) {
            const float* w2 = a.in[I_EW2] + (size_t)li * 64 * 1024; const float* a2 = a.in[I_EA2] + (size_t)li * 64 * 1024; const float* g2 = a.in[I_EG2] + (size_t)li * 160 * 1024;
            bf16* W2T = (bf16*)(ws + SM_W2T); bf16* A2T = (bf16*)(ws + SM_A2T); bf16* G2T = (bf16*)(ws + SM_G2T);
            for (int e = gt; e < 1024 * 64; e += NGT) { const int k = e >> 10, c = e & 1023; W2T[c * 64 + k] = (bf16)f2bf(w2[e]); A2T[c * 64 + k] = (bf16)f2bf(a2[e]); }
            for (int e = gt; e < 1024 * 160; e += NGT) { const int k = e >> 10, c = e & 1023; G2T[c * 160 + k] = (bf16)f2bf(g2[e]); }
            if (li > 0) { bf16* V1T = (bf16*)(ws + SM_V1T); bf16* V2T = (bf16*)(ws + SM_V2T);
                for (int e = gt; e < 1024 * 32; e += NGT) { const int c = e >> 5, j = e & 31; V1T[j * 1024 + c] = (bf16)f2bf(a.in[I_V1][e]); }
                for (int e = gt; e < 32 * 1024; e += NGT) { const int j = e >> 10, c = e & 1023; V2T[c * 32 + j] = (bf16)f2bf(a.in[I_V2][e]); } }
        } else {
            const float* wsg = a.in[I_OWS] + (size_t)li * 16 * 128 * 128; bf16* WSB = (bf16*)(ws + SM_WSB);
            for (int e = gt; e < 16 * 128 * 128; e += NGT) { const int i = (e >> 7) & 127, j = e & 127; WSB[e] = (bf16)f2bf(j <= i ? wsg[e] : 0.f); }
        }
    }
    if (L == 0) {
        float* ss0 = (float*)(ws + WS_SS); bf16* XB = (bf16*)(ws + WS_XB);
        for (int m = gw; m < M; m += NGW) {
            const GAS f32x4* xr = (const GAS f32x4*)(a.in[I_X] + (size_t)m * D) + lane; GAS v2u* o = (GAS v2u*)(XB + (size_t)m * D) + lane; float s = 0.f;
#pragma unroll
            for (int j = 0; j < 8; ++j) { const f32x4 v = xr[64 * j]; s += (v.x * v.x + v.y * v.y) + (v.z * v.z + v.w * v.w); v2u w; w.x = pk2(v.x, v.y); w.y = pk2(v.z, v.w); o[64 * j] = w; }
            s = wave_sum(s); if (lane < 8) ss0[(size_t)lane * M + m] = lane ? 0.f : s;
        }
    }
}

typedef short bf16x8_t __attribute__((ext_vector_type(8)));
__device__ __forceinline__ float fast_tanh(float x) { const float e = __expf(2.0f * x); return 1.0f - 2.0f / (1.0f + e); }
__device__ __forceinline__ void lerp8(const v4u c, const v4u p, const float* mu, float (&o)[8]) {
    const f32x4 m0 = *(const f32x4*)mu, m1 = *(const f32x4*)(mu + 4);
    const float c0 = bflo(c.x), c1 = bfhi(c.x), c2 = bflo(c.y), c3 = bfhi(c.y), c4 = bflo(c.z), c5 = bfhi(c.z), c6 = bflo(c.w), c7 = bfhi(c.w);
    o[0] = c0 + (bflo(p.x) - c0) * m0.x; o[1] = c1 + (bfhi(p.x) - c1) * m0.y; o[2] = c2 + (bflo(p.y) - c2) * m0.z; o[3] = c3 + (bfhi(p.y) - c3) * m0.w;
    o[4] = c4 + (bflo(p.z) - c4) * m1.x; o[5] = c5 + (bfhi(p.z) - c5) * m1.y; o[6] = c6 + (bflo(p.w) - c6) * m1.z; o[7] = c7 + (bfhi(p.w) - c7) * m1.w;
}
__device__ __forceinline__ void lerp4(const v2u c, const v2u p, const f32x4 m, float (&o)[4]) {
    const float c0 = bflo(c.x), c1 = bfhi(c.x), c2 = bflo(c.y), c3 = bfhi(c.y);
    o[0] = c0 + (bflo(p.x) - c0) * m.x; o[1] = c1 + (bfhi(p.x) - c1) * m.y; o[2] = c2 + (bflo(p.y) - c2) * m.z; o[3] = c3 + (bfhi(p.y) - c3) * m.w;
}
__device__ __forceinline__ v2u pack4(float a, float b, float c, float d) { v2u w; w.x = pk2(a, b); w.y = pk2(c, d); return w; }
constexpr int E1_AW = 0, E1_AA = 9216, E1_AG = 18432, E1_PP = 40960, E1_PB = 106496;
__device__ __forceinline__ void e1_phase(const Args& a, int li, LAS unsigned char* ldsb, int vcu, int G, int tid) {
    unsigned char* ws = a.ws;
    const bf16* Z = (const bf16*)(ws + WS_ACT);
    bf16* R = (bf16*)(ws + SC_R); bf16* K2 = (bf16*)(ws + SC_K2); bf16* KK = (bf16*)(ws + SC_KK); bf16* BB = (bf16*)(ws + SC_BB); bf16* LW = (bf16*)(ws + SC_LW); bf16* GG = (bf16*)(ws + SC_GG);
    bf16* VO = (bf16*)(ws + (li ? WS_V2 : WS_VF)); const bf16* VF = (const bf16*)(ws + WS_VF);
    const bf16* W2T = (const bf16*)(ws + SM_W2T); const bf16* A2T = (const bf16*)(ws + SM_A2T); const bf16* G2T = (const bf16*)(ws + SM_G2T);
    const bf16* V1T = (const bf16*)(ws + SM_V1T); const bf16* V2T = (const bf16*)(ws + SM_V2T);
    const float* mu = a.in[I_EMU] + li * A_COLS;
    const float* w0 = a.in[I_EW0] + li * 1024; const float* a0 = a.in[I_EA0] + li * 1024;
    const float* kkw = a.in[I_EKK] + li * 1024; const float* kaw = a.in[I_EKA] + li * 1024; const float* v0w = a.in[I_V0];
    const int lane = tid & 63, wave = tid >> 6, fr = lane & 15, fq = lane >> 4;
    for (int unit = vcu; unit < M / 64; unit += G) {
        const int m0 = unit * 64;
        for (int e = tid; e < 64 * 36; e += NTHR) { const int r = e / 36, ch = e % 36, j0 = 8 * ch, m = m0 + r; const bool first = (m & (T - 1)) == 0;
            const v4u cur = *(const GAS v4u*)(Z + (size_t)m * ZN + ZA + 3072 + j0); v4u prv = {0u, 0u, 0u, 0u}; if (!first) prv = *(const GAS v4u*)(Z + (size_t)(m - 1) * ZN + ZA + 3072 + j0);
            float x[8]; lerp8(cur, prv, mu + 3072 + j0, x);
            if (j0 < 64) {
#pragma unroll
                for (int i = 0; i < 8; ++i) x[i] = fast_tanh(x[i]);
            } else if (j0 >= 128) {
#pragma unroll
                for (int i = 0; i < 8; ++i) x[i] = sigmoidf_(x[i]);
            }
            v4u o; o.x = pk2(x[0], x[1]); o.y = pk2(x[2], x[3]); o.z = pk2(x[4], x[5]); o.w = pk2(x[6], x[7]);
            LAS unsigned char* dst = j0 < 64 ? ldsb + E1_AW + r * 144 + j0 * 2 : j0 < 128 ? ldsb + E1_AA + r * 144 + (j0 - 64) * 2 : ldsb + E1_AG + r * 336 + (j0 - 128) * 2;
            *(LAS v4u*)dst = o; }
        if (li > 0) {
            f32x4 pacc[4][2];
#pragma unroll
            for (int mt = 0; mt < 4; ++mt) { pacc[mt][0] = (f32x4){0.f, 0.f, 0.f, 0.f}; pacc[mt][1] = pacc[mt][0]; }
            for (int ks = 0; ks < 4; ++ks) { const int c = 128 * wave + 32 * ks + 8 * fq;
                const bf16x8_t w0f = *(const GAS bf16x8_t*)(V1T + (size_t)fr * 1024 + c), w1f = *(const GAS bf16x8_t*)(V1T + (size_t)(16 + fr) * 1024 + c);
#pragma unroll
                for (int mt = 0; mt < 4; ++mt) { const int m = m0 + 16 * mt + fr; const bool first = (m & (T - 1)) == 0;
                    const v4u cur = *(const GAS v4u*)(Z + (size_t)m * ZN + ZA + 2048 + c); v4u prv = {0u, 0u, 0u, 0u}; if (!first) prv = *(const GAS v4u*)(Z + (size_t)(m - 1) * ZN + ZA + 2048 + c);
                    float x[8]; lerp8(cur, prv, mu + 2048 + c, x);
                    v4u o; o.x = pk2(x[0], x[1]); o.y = pk2(x[2], x[3]); o.z = pk2(x[4], x[5]); o.w = pk2(x[6], x[7]);
                    const bf16x8_t af = __builtin_bit_cast(bf16x8_t, o);
                    pacc[mt][0] = __builtin_amdgcn_mfma_f32_16x16x32_bf16(w0f, af, pacc[mt][0], 0, 0, 0); pacc[mt][1] = __builtin_amdgcn_mfma_f32_16x16x32_bf16(w1f, af, pacc[mt][1], 0, 0, 0); } }
#pragma unroll
            for (int mt = 0; mt < 4; ++mt)
#pragma unroll
                for (int nt = 0; nt < 2; ++nt) *(LAS f32x4*)(ldsb + E1_PP + ((wave * 64 + 16 * mt + fr) * 32 + 16 * nt + 4 * fq) * 4) = pacc[mt][nt];
        }
        __syncthreads();
        if (li > 0) {
            for (int e = tid; e < 64 * 32; e += NTHR) { float sum = 0.f;
#pragma unroll
                for (int w = 0; w < 8; ++w) sum += *(const LAS float*)(ldsb + E1_PP + (w * 2048 + e) * 4);
                *(LAS bf16*)(ldsb + E1_PB + (e >> 5) * 80 + (e & 31) * 2) = (bf16)f2bf(sum); }
            __syncthreads();
        }
#define E1_WROW(nt) (cb + 32 * ((nt) >> 1) + 8 * (fr >> 2) + 4 * ((nt) & 1) + (fr & 3))
#pragma unroll 1
        for (int hh = 0; hh < 2; ++hh) {
            const int cb = 128 * wave + 64 * hh;
            {
                bf16x8_t wa[4][2];
#pragma unroll
                for (int nt = 0; nt < 4; ++nt)
#pragma unroll
                    for (int ks = 0; ks < 2; ++ks) wa[nt][ks] = *(const GAS bf16x8_t*)(A2T + (size_t)E1_WROW(nt) * 64 + 32 * ks + 8 * fq);
#pragma unroll 1
                for (int mt = 0; mt < 4; ++mt) {
                    const int m = m0 + 16 * mt + fr; const bool first = (m & (T - 1)) == 0;
                    f32x4 aa[4];
#pragma unroll
                    for (int nt = 0; nt < 4; ++nt) aa[nt] = (f32x4){0.f, 0.f, 0.f, 0.f};
#pragma unroll
                    for (int ks = 0; ks < 2; ++ks) { const bf16x8_t fa = *(const LAS bf16x8_t*)(ldsb + E1_AA + (16 * mt + fr) * 144 + (32 * ks + 8 * fq) * 2);
#pragma unroll
                        for (int nt = 0; nt < 4; ++nt) aa[nt] = __builtin_amdgcn_mfma_f32_16x16x32_bf16(wa[nt][ks], fa, aa[nt], 0, 0, 0); }
                    const size_t zo = (size_t)m * ZN + ZA + cb + 8 * fq;
                    float k1[2][8], av[2][8], kk0[2][8]; float n2 = 0.f;
#pragma unroll
                    for (int p = 0; p < 2; ++p) { const int c = cb + 32 * p + 8 * fq;
                        const v4u cur = *(const GAS v4u*)(Z + zo + 1024 + 32 * p); v4u prv = {0u, 0u, 0u, 0u}; if (!first) prv = *(const GAS v4u*)(Z + zo - ZN + 1024 + 32 * p);
                        lerp8(cur, prv, mu + 1024 + c, k1[p]);
                        const f32x4 a00 = *(const f32x4*)(a0 + c), a01 = *(const f32x4*)(a0 + c + 4), kk00 = *(const f32x4*)(kkw + c), kk01 = *(const f32x4*)(kkw + c + 4);
#pragma unroll
                        for (int j = 0; j < 8; ++j) { const float a0j = j < 4 ? a00[j & 3] : a01[j & 3], kkj = j < 4 ? kk00[j & 3] : kk01[j & 3];
                            av[p][j] = sigmoidf_(a0j + aa[2 * p + (j >> 2)][j & 3]); kk0[p][j] = k1[p][j] * kkj; n2 += kk0[p][j] * kk0[p][j]; } }
                    n2 += __shfl_xor(n2, 16); n2 += __shfl_xor(n2, 32);
                    const float inv = 1.0f / fmaxf(sqrtf(n2), 1e-12f);
#pragma unroll
                    for (int p = 0; p < 2; ++p) { const int c = cb + 32 * p + 8 * fq; const size_t o = (size_t)m * 1024 + c; const f32x4 ka0 = *(const f32x4*)(kaw + c), ka1 = *(const f32x4*)(kaw + c + 4);
                        float kk[8], k2[8], bb[8];
#pragma unroll
                        for (int j = 0; j < 8; ++j) { const float kaj = j < 4 ? ka0[j & 3] : ka1[j & 3]; kk[j] = kk0[p][j] * inv; k2[j] = k1[p][j] * (1.0f + (av[p][j] - 1.0f) * kaj); bb[j] = kk[j] * av[p][j]; }
                        *(GAS v4u*)(KK + o) = (v4u){pk2(kk[0], kk[1]), pk2(kk[2], kk[3]), pk2(kk[4], kk[5]), pk2(kk[6], kk[7])};
                        *(GAS v4u*)(K2 + o) = (v4u){pk2(k2[0], k2[1]), pk2(k2[2], k2[3]), pk2(k2[4], k2[5]), pk2(k2[6], k2[7])};
                        *(GAS v4u*)(BB + o) = (v4u){pk2(bb[0], bb[1]), pk2(bb[2], bb[3]), pk2(bb[4], bb[5]), pk2(bb[6], bb[7])}; }
                }
            }
            {
                bf16x8_t ww[4][2];
#pragma unroll
                for (int nt = 0; nt < 4; ++nt)
#pragma unroll
                    for (int ks = 0; ks < 2; ++ks) ww[nt][ks] = *(const GAS bf16x8_t*)(W2T + (size_t)E1_WROW(nt) * 64 + 32 * ks + 8 * fq);
#pragma unroll 1
                for (int mt = 0; mt < 4; ++mt) {
                    const int m = m0 + 16 * mt + fr;
                    f32x4 aw[4];
#pragma unroll
                    for (int nt = 0; nt < 4; ++nt) aw[nt] = (f32x4){0.f, 0.f, 0.f, 0.f};
#pragma unroll
                    for (int ks = 0; ks < 2; ++ks) { const bf16x8_t fw = *(const LAS bf16x8_t*)(ldsb + E1_AW + (16 * mt + fr) * 144 + (32 * ks + 8 * fq) * 2);
#pragma unroll
                        for (int nt = 0; nt < 4; ++nt) aw[nt] = __builtin_amdgcn_mfma_f32_16x16x32_bf16(ww[nt][ks], fw, aw[nt], 0, 0, 0); }
#pragma unroll
                    for (int p = 0; p < 2; ++p) { const int c = cb + 32 * p + 8 * fq; const f32x4 w00 = *(const f32x4*)(w0 + c), w01 = *(const f32x4*)(w0 + c + 4); float lw[8];
#pragma unroll
                        for (int j = 0; j < 8; ++j) { const float y = -((j < 4 ? w00[j & 3] : w01[j & 3]) + aw[2 * p + (j >> 2)][j & 3]); const float sp = fmaxf(y, 0.f) + __logf(1.0f + __expf(-fabsf(y))); lw[j] = -__expf(-sp - 0.5f); }
                        *(GAS v4u*)(LW + (size_t)m * 1024 + c) = (v4u){pk2(lw[0], lw[1]), pk2(lw[2], lw[3]), pk2(lw[4], lw[5]), pk2(lw[6], lw[7])}; }
                }
            }
            {
                bf16x8_t wg[4][5];
#pragma unroll
                for (int nt = 0; nt < 4; ++nt)
#pragma unroll
                    for (int ks = 0; ks < 5; ++ks) wg[nt][ks] = *(const GAS bf16x8_t*)(G2T + (size_t)E1_WROW(nt) * 160 + 32 * ks + 8 * fq);
#pragma unroll 1
                for (int mt = 0; mt < 4; ++mt) {
                    const int m = m0 + 16 * mt + fr;
                    f32x4 ag[4];
#pragma unroll
                    for (int nt = 0; nt < 4; ++nt) ag[nt] = (f32x4){0.f, 0.f, 0.f, 0.f};
#pragma unroll
                    for (int ks = 0; ks < 5; ++ks) { const bf16x8_t fg = *(const LAS bf16x8_t*)(ldsb + E1_AG + (16 * mt + fr) * 336 + (32 * ks + 8 * fq) * 2);
#pragma unroll
                        for (int nt = 0; nt < 4; ++nt) ag[nt] = __builtin_amdgcn_mfma_f32_16x16x32_bf16(wg[nt][ks], fg, ag[nt], 0, 0, 0); }
#pragma unroll
                    for (int p = 0; p < 2; ++p) *(GAS v4u*)(GG + (size_t)m * 1024 + cb + 32 * p + 8 * fq) = (v4u){pk2(ag[2 * p][0], ag[2 * p][1]), pk2(ag[2 * p][2], ag[2 * p][3]), pk2(ag[2 * p + 1][0], ag[2 * p + 1][1]), pk2(ag[2 * p + 1][2], ag[2 * p + 1][3])};
                }
            }
            {
                bf16x8_t wv2[4];
#pragma unroll
                for (int nt = 0; nt < 4; ++nt) { wv2[nt] = (bf16x8_t){0, 0, 0, 0, 0, 0, 0, 0}; if (li > 0) wv2[nt] = *(const GAS bf16x8_t*)(V2T + (size_t)E1_WROW(nt) * 32 + 8 * fq); }
#pragma unroll 1
                for (int mt = 0; mt < 4; ++mt) {
                    const int m = m0 + 16 * mt + fr; const bool first = (m & (T - 1)) == 0;
                    f32x4 avr[4];
#pragma unroll
                    for (int nt = 0; nt < 4; ++nt) avr[nt] = (f32x4){0.f, 0.f, 0.f, 0.f};
                    if (li > 0) { const bf16x8_t fp = *(const LAS bf16x8_t*)(ldsb + E1_PB + (16 * mt + fr) * 80 + (8 * fq) * 2);
#pragma unroll
                        for (int nt = 0; nt < 4; ++nt) avr[nt] = __builtin_amdgcn_mfma_f32_16x16x32_bf16(wv2[nt], fp, avr[nt], 0, 0, 0); }
                    const size_t zo = (size_t)m * ZN + ZA + cb + 8 * fq;
#pragma unroll
                    for (int p = 0; p < 2; ++p) { const int c = cb + 32 * p + 8 * fq; const size_t o = (size_t)m * 1024 + c;
                        const v4u rc = *(const GAS v4u*)(Z + zo + 32 * p), vc = *(const GAS v4u*)(Z + zo + 2048 + 32 * p); v4u rp = {0u, 0u, 0u, 0u}, vp = {0u, 0u, 0u, 0u};
                        if (!first) { rp = *(const GAS v4u*)(Z + zo - ZN + 32 * p); vp = *(const GAS v4u*)(Z + zo - ZN + 2048 + 32 * p); }
                        float rr[8], vv[8]; lerp8(rc, rp, mu + c, rr); lerp8(vc, vp, mu + 2048 + c, vv);
                        if (li > 0) { const f32x4 v00 = *(const f32x4*)(v0w + c), v01 = *(const f32x4*)(v0w + c + 4); const v4u vf = *(const GAS v4u*)(VF + o);
                            const float f[8] = {bflo(vf.x), bfhi(vf.x), bflo(vf.y), bfhi(vf.y), bflo(vf.z), bfhi(vf.z), bflo(vf.w), bfhi(vf.w)};
#pragma unroll
                            for (int j = 0; j < 8; ++j) vv[j] += (f[j] - vv[j]) * sigmoidf_((j < 4 ? v00[j & 3] : v01[j & 3]) + avr[2 * p + (j >> 2)][j & 3]); }
                        *(GAS v4u*)(R + o) = (v4u){pk2(rr[0], rr[1]), pk2(rr[2], rr[3]), pk2(rr[4], rr[5]), pk2(rr[6], rr[7])};
                        *(GAS v4u*)(VO + o) = (v4u){pk2(vv[0], vv[1]), pk2(vv[2], vv[3]), pk2(vv[4], vv[5]), pk2(vv[6], vv[7])}; }
                }
            }
        }
#undef E1_WROW
        __syncthreads();
    }
}

constexpr size_t CS_AR = WS_ACT, CS_BK = WS_ACT + 128 * MiB, CS_Y0 = WS_ACT + 256 * MiB, CS_GL = WS_ACT + 320 * MiB;
__device__ __forceinline__ int cs_perm(int k) { return (k & 32) + 8 * ((k >> 2) & 3) + 4 * ((k >> 4) & 1) + (k & 3); }
__device__ __forceinline__ f32x4 mm16_ll(const LAS float* A, const LAS float* B, f32x4 c, int fr, int fq) {
    const f32x4 a4 = *(const LAS f32x4*)(A + fr * 16 + 4 * fq);
#pragma unroll
    for (int s = 0; s < 4; ++s) c = __builtin_amdgcn_mfma_f32_16x16x4f32(a4[s], B[(4 * fq + s) * 16 + fr], c, 0, 0, 0);
    return c;
}
__device__ __forceinline__ f32x4 mm16_la(const LAS float* A, const f32x4 b, f32x4 c, int fr, int fq) {
    const f32x4 a4 = *(const LAS f32x4*)(A + fr * 16 + 4 * fq);
#pragma unroll
    for (int s = 0; s < 4; ++s) c = __builtin_amdgcn_mfma_f32_16x16x4f32(a4[s], b[s], c, 0, 0, 0);
    return c;
}
__device__ __forceinline__ void st16(LAS float* Mx, const f32x4 c, int fr, int fq) {
#pragma unroll
    for (int r = 0; r < 4; ++r) Mx[(4 * fq + r) * 16 + fr] = c[r];
}
__device__ __forceinline__ void scanpre_phase(const Args& a, int li, LAS unsigned char* ldsb, int vcu, int G, int tid) {
    unsigned char* ws = a.ws;
    const bf16* Rr = (const bf16*)(ws + SC_R); const bf16* K2 = (const bf16*)(ws + SC_K2); const bf16* KK = (const bf16*)(ws + SC_KK); const bf16* BB = (const bf16*)(ws + SC_BB); const bf16* LW = (const bf16*)(ws + SC_LW);
    const bf16* V = (const bf16*)(ws + (li ? WS_V2 : WS_VF));
    bf16* ARo = (bf16*)(ws + CS_AR); bf16* BKo = (bf16*)(ws + CS_BK); bf16* Y0o = (bf16*)(ws + CS_Y0); float* GLo = (float*)(ws + CS_GL); bf16* U0o = (bf16*)(ws + WS_U0);
    const int lane = tid & 63, wave = tid >> 6, fr = lane & 15, fq = lane >> 4;
    LAS unsigned char* wl = ldsb + wave * 17408;
    LAS bf16* LAR = (LAS bf16*)wl; LAS bf16* LBK = (LAS bf16*)(wl + 4608); LAS float* LM = (LAS float*)(wl + 9216); LAS float* LX = (LAS float*)(wl + 13312);
    const LAS float* Mab = LM, *Mak = LM + 256, *Mrb = LM + 512, *Mrk = LM + 768;
    LAS float* Tm = LX, *Na = LX + 256, *Nb = LX + 512;
    for (int ch = vcu * NWAVES + wave; ch < 32 * 1024; ch += G * NWAVES) {
        const int bh = ch >> 10, ci = ch & 1023, b = bh >> 4, h = bh & 15; const size_t row0 = (size_t)b * T + 16 * ci;
        f32x4 At[4], Rt[4], vv[4]; float glane;
#pragma unroll
        for (int nt = 0; nt < 4; ++nt) { f32x4 lw, kk, bb, k2, rr;
#pragma unroll
            for (int s = 0; s < 4; ++s) { const size_t o = (row0 + 4 * fq + s) * 1024 + h * 64 + 16 * nt + fr;
                lw[s] = bf2f(LW[o]); kk[s] = bf2f(KK[o]); bb[s] = bf2f(BB[o]); k2[s] = bf2f(K2[o]); rr[s] = bf2f(Rr[o]); vv[nt][s] = bf2f(V[o]); }
            f32x4 cum; cum[0] = lw[0]; cum[1] = cum[0] + lw[1]; cum[2] = cum[1] + lw[2]; cum[3] = cum[2] + lw[3];
            float x = cum[3]; { const float y = __shfl_up(x, 16); if (fq >= 1) x += y; } { const float y = __shfl_up(x, 32); if (fq >= 2) x += y; }
            const float excl = x - cum[3]; const float cl = __shfl(x, 48 + fr);
            bf16* bo = BKo + (size_t)ch * 2048 + (16 * nt + fr) * 32 + 8 * fq; f32x4 bh4, kh4;
#pragma unroll
            for (int s = 0; s < 4; ++s) { const float c = excl + cum[s]; const float g = __expf(c), gp = __expf(c - lw[s]), gi = __expf(-c), e = __expf(cl - c);
                At[nt][s] = -kk[s] * gp; Rt[nt][s] = rr[s] * g; bh4[s] = bb[s] * e; kh4[s] = k2[s] * e;
                const int t = 4 * fq + s, cc = 16 * nt + fr;
                LAR[t * 72 + cc] = (bf16)f2bf(At[nt][s]); LAR[(16 + t) * 72 + cc] = (bf16)f2bf(Rt[nt][s]); LBK[t * 72 + cc] = (bf16)f2bf(bb[s] * gi); LBK[(16 + t) * 72 + cc] = (bf16)f2bf(k2[s] * gi); }
            *(GAS v4u*)bo = (v4u){pk2(bh4[0], bh4[1]), pk2(bh4[2], bh4[3]), pk2(kh4[0], kh4[1]), pk2(kh4[2], kh4[3])};
            if (fq == 0) GLo[(size_t)ch * 64 + 16 * nt + fr] = __expf(cl);
            glane = cl; }
        (void)glane;
        LDS_WAIT(); asm volatile("" ::: "memory");
#pragma unroll
        for (int mt = 0; mt < 2; ++mt)
#pragma unroll
            for (int nt = 0; nt < 2; ++nt) { f32x4 m = {0.f, 0.f, 0.f, 0.f};
#pragma unroll
                for (int ks = 0; ks < 2; ++ks) { const bf16x8_t af = *(const LAS bf16x8_t*)(LAR + (16 * mt + fr) * 72 + 32 * ks + 8 * fq), bfr = *(const LAS bf16x8_t*)(LBK + (16 * nt + fr) * 72 + 32 * ks + 8 * fq);
                    m = __builtin_amdgcn_mfma_f32_16x16x32_bf16(af, bfr, m, 0, 0, 0); }
#pragma unroll
                for (int r = 0; r < 4; ++r) { const int t = 4 * fq + r; const bool keep = mt ? (fr <= t) : (fr < t); LM[((mt * 2 + nt) * 16 + t) * 16 + fr] = keep ? m[r] : 0.f; } }
        LDS_WAIT(); asm volatile("" ::: "memory");
        { const f32x4 z = {0.f, 0.f, 0.f, 0.f};
          f32x4 t1;
#pragma unroll
          for (int r = 0; r < 4; ++r) t1[r] = Mab[(4 * fq + r) * 16 + fr] + ((4 * fq + r) == fr ? 1.0f : 0.f);
          st16(Tm, t1, fr, fq);
          f32x4 n2 = mm16_ll(Mab, Mab, z, fr, fq); st16(Na, n2, fr, fq);
          LDS_WAIT(); asm volatile("" ::: "memory");
          f32x4 t2 = mm16_ll(Tm, Na, t1, fr, fq);
          f32x4 n4 = mm16_ll(Na, Na, z, fr, fq);
          LDS_WAIT(); asm volatile("" ::: "memory");
          st16(Tm, t2, fr, fq); st16(Nb, n4, fr, fq);
          LDS_WAIT(); asm volatile("" ::: "memory");
          f32x4 t3 = mm16_ll(Tm, Nb, t2, fr, fq);
          f32x4 n8 = mm16_ll(Nb, Nb, z, fr, fq);
          LDS_WAIT(); asm volatile("" ::: "memory");
          st16(Tm, t3, fr, fq); st16(Na, n8, fr, fq);
          LDS_WAIT(); asm volatile("" ::: "memory");
          f32x4 t4 = mm16_ll(Tm, Na, t3, fr, fq);
          LDS_WAIT(); asm volatile("" ::: "memory");
          st16(Tm, t4, fr, fq);
          LDS_WAIT(); asm volatile("" ::: "memory"); }
#pragma unroll
        for (int nt = 0; nt < 4; ++nt) { const f32x4 z = {0.f, 0.f, 0.f, 0.f};
            const f32x4 w1 = mm16_la(Mak, vv[nt], z, fr, fq);
            const f32x4 u0 = mm16_la(Tm, w1, z, fr, fq);
            const f32x4 ah = mm16_la(Tm, At[nt], z, fr, fq);
            const f32x4 rh = mm16_la(Mrb, ah, Rt[nt], fr, fq);
            f32x4 y0 = mm16_la(Mrb, u0, z, fr, fq); y0 = mm16_la(Mrk, vv[nt], y0, fr, fq);
            const int k = 16 * nt + fr; bf16* arp = ARo + (size_t)ch * 2048 + cs_perm(k);
#pragma unroll
            for (int s = 0; s < 4; ++s) { arp[(4 * fq + s) * 64] = (bf16)f2bf(ah[s]); arp[(16 + 4 * fq + s) * 64] = (bf16)f2bf(rh[s]); }
            *(GAS v2u*)(Y0o + (size_t)ch * 1024 + k * 16 + 4 * fq) = pack4(y0[0], y0[1], y0[2], y0[3]);
            *(GAS v2u*)(U0o + (size_t)ch * 1024 + k * 16 + 4 * fq) = pack4(u0[0], u0[1], u0[2], u0[3]); }
        LDS_WAIT(); asm volatile("" ::: "memory");
    }
}
constexpr int CQ_NS = 13, CQ_SLOT = 10240, CQ_FULL = CQ_NS * CQ_SLOT, CQ_DONE = CQ_FULL + 64, CQ_NL = 6;
#define CQ_GLDS(src, dst) __builtin_amdgcn_global_load_lds((const unsigned*)(src), (LAS unsigned*)(dst), 16, 0, 0)
__device__ __forceinline__ void scanseq_phase(const Args& a, int li, LAS unsigned char* ldsb, int vcu, int tid) {
    volatile LAS unsigned* FULL = (volatile LAS unsigned*)(ldsb + CQ_FULL); volatile LAS unsigned* DONE = (volatile LAS unsigned*)(ldsb + CQ_DONE);
    if (tid < 32) ((LAS unsigned*)(ldsb + CQ_FULL))[tid] = 0u;
    __syncthreads();
    const int wave = __builtin_amdgcn_readfirstlane(tid >> 6), lane = tid & 63;
    if (vcu < 128 && wave <= CQ_NL) {
        unsigned char* ws = a.ws;
        const int bh = vcu >> 2, vb = vcu & 3, b = bh >> 4, h = bh & 15; const size_t row0 = (size_t)b * T; const size_t ch0 = (size_t)bh * 1024;
        if (wave > 0) {
            const unsigned char* ARo = ws + CS_AR; const unsigned char* BKo = ws + CS_BK; const unsigned char* Y0o = ws + CS_Y0; const unsigned char* GLo = ws + CS_GL; const unsigned char* U0o = ws + WS_U0;
            const unsigned char* V = ws + (li ? WS_V2 : WS_VF);
            const unsigned oAR = (unsigned)((lane >> 3) * 128 + 16 * ((lane & 7) ^ ((lane >> 3) & 7)));
            unsigned oBK[4];
#pragma unroll
            for (int i = 0; i < 4; ++i) { const int k = 16 * i + (lane >> 2); oBK[i] = (unsigned)(k * 64 + 16 * ((lane & 3) ^ ((k >> 2) & 3))); }
            const unsigned oUY = (unsigned)((16 * vb + ((lane & 31) >> 1)) * 32 + 16 * (lane & 1));
            const size_t oV = ((size_t)(lane >> 1) * 1024 + h * 64 + 16 * vb) * 2 + 16 * (lane & 1);
            const unsigned oG = (unsigned)(16 * (lane & 15));
            int pub = wave - 1; unsigned spins = 0;
            for (int c = wave - 1; c < 1024; c += CQ_NL) {
                const int s = c % CQ_NS;
                if (c >= CQ_NS) { while ((int)DONE[0] < c - CQ_NS + 1) { __builtin_amdgcn_s_sleep(1); if (++spins > (1u << 24)) break; } }
                LAS unsigned char* sl = ldsb + s * CQ_SLOT; const size_t ch = ch0 + c;
                const unsigned char* ar = ARo + ch * 4096; const unsigned char* bk = BKo + ch * 4096;
#pragma unroll
                for (int i = 0; i < 4; ++i) CQ_GLDS(ar + i * 1024 + oAR, sl + i * 1024);
#pragma unroll
                for (int i = 0; i < 4; ++i) CQ_GLDS(bk + oBK[i], sl + 4096 + i * 1024);
                CQ_GLDS((lane < 32 ? U0o : Y0o) + ch * 2048 + oUY, sl + 8192);
                CQ_GLDS(lane < 32 ? V + (row0 + 16 * (size_t)c) * 2048 + oV : GLo + ch * 256 + oG, sl + 9216);
                asm volatile("s_waitcnt vmcnt(10)" ::: "memory");
                for (; pub <= c - CQ_NL; pub += CQ_NL) FULL[pub % CQ_NS] = (unsigned)(pub + 1);
            }
            asm volatile("s_waitcnt vmcnt(0)" ::: "memory");
            for (; pub < 1024; pub += CQ_NL) FULL[pub % CQ_NS] = (unsigned)(pub + 1);
        } else {
            float* Y = a.out;
            const int fr = lane & 15, fq = lane >> 4; const int colv = h * 64 + 16 * vb + fr;
            f32x4 St[4];
#pragma unroll
            for (int kt = 0; kt < 4; ++kt) St[kt] = (f32x4){0.f, 0.f, 0.f, 0.f};
            unsigned spins = 0;
            for (int c = 0; c < 1024; ++c) {
                const int s = c % CQ_NS; LAS unsigned char* sl = ldsb + s * CQ_SLOT;
                while (FULL[s] != (unsigned)(c + 1)) { if (++spins > (1u << 26)) break; }
                __builtin_amdgcn_fence(__ATOMIC_ACQUIRE, "workgroup");
                bf16x8_t ar[2][2], bk[4]; f32x4 gl[4];
#pragma unroll
                for (int mt = 0; mt < 2; ++mt)
#pragma unroll
                    for (int ks = 0; ks < 2; ++ks) { const int r = 16 * mt + fr; ar[mt][ks] = *(const LAS bf16x8_t*)(sl + r * 128 + 16 * ((4 * ks + fq) ^ (r & 7))); }
#pragma unroll
                for (int kt = 0; kt < 4; ++kt) { const int k = 16 * kt + fr; bk[kt] = *(const LAS bf16x8_t*)(sl + 4096 + k * 64 + 16 * (fq ^ ((k >> 2) & 3))); gl[kt] = *(const LAS f32x4*)(sl + 9728 + (16 * kt + 4 * fq) * 4); }
                const v2u u0 = *(const LAS v2u*)(sl + 8192 + fr * 32 + 8 * fq), y0 = *(const LAS v2u*)(sl + 8704 + fr * 32 + 8 * fq);
                unsigned vs[4];
#pragma unroll
                for (int j = 0; j < 4; ++j) vs[j] = *(const LAS unsigned short*)(sl + 9216 + (4 * fq + j) * 32 + 2 * fr);
                bf16x8_t sb[2];
#pragma unroll
                for (int ks = 0; ks < 2; ++ks) { v4u w; w.x = pk2(St[2 * ks][0], St[2 * ks][1]); w.y = pk2(St[2 * ks][2], St[2 * ks][3]); w.z = pk2(St[2 * ks + 1][0], St[2 * ks + 1][1]); w.w = pk2(St[2 * ks + 1][2], St[2 * ks + 1][3]); sb[ks] = __builtin_bit_cast(bf16x8_t, w); }
                f32x4 au = {0.f, 0.f, 0.f, 0.f}, ay = {0.f, 0.f, 0.f, 0.f};
#pragma unroll
                for (int ks = 0; ks < 2; ++ks) { au = __builtin_amdgcn_mfma_f32_16x16x32_bf16(ar[0][ks], sb[ks], au, 0, 0, 0); ay = __builtin_amdgcn_mfma_f32_16x16x32_bf16(ar[1][ks], sb[ks], ay, 0, 0, 0); }
                { const size_t yr = (row0 + 16 * (size_t)c + 4 * fq) * 1024 + colv;
                  Y[yr] = ay[0] + bflo(y0.x); Y[yr + 1024] = ay[1] + bfhi(y0.x); Y[yr + 2048] = ay[2] + bflo(y0.y); Y[yr + 3072] = ay[3] + bfhi(y0.y); }
                v4u uw; uw.x = pk2(au[0] + bflo(u0.x), au[1] + bfhi(u0.x)); uw.y = pk2(au[2] + bflo(u0.y), au[3] + bfhi(u0.y)); uw.z = vs[0] | (vs[1] << 16); uw.w = vs[2] | (vs[3] << 16);
                const bf16x8_t uv = __builtin_bit_cast(bf16x8_t, uw);
#pragma unroll
                for (int kt = 0; kt < 4; ++kt) St[kt] = __builtin_amdgcn_mfma_f32_16x16x32_bf16(bk[kt], uv, St[kt] * gl[kt], 0, 0, 0);
                asm volatile("s_waitcnt lgkmcnt(0)" ::: "memory");
                if (lane == 0) DONE[0] = (unsigned)(c + 1);
            }
        }
    }
    __syncthreads();
}

typedef float f32x16 __attribute__((ext_vector_type(16)));
constexpr int AT_K = 0, AT_V = 36864;
__device__ __forceinline__ bf16x8_t tr_frag(unsigned addr) {
    v2u lo, hi; asm volatile("ds_read_b64_tr_b16 %0, %2\n\tds_read_b64_tr_b16 %1, %2 offset:1536\n\ts_waitcnt lgkmcnt(0)" : "=&v"(lo), "=&v"(hi) : "v"(addr) : "memory");
    v4u w; w.x = lo.x; w.y = lo.y; w.z = hi.x; w.w = hi.y; return __builtin_bit_cast(bf16x8_t, w);
}
__device__ __forceinline__ void attn_unit(const Args& a, int li, int au, LAS unsigned char* ldsb, int tid) {
    unsigned char* ws = a.ws; const bf16* Z = (const bf16*)(ws + WS_ACT); bf16* O = (bf16*)(ws + WS_O);
    const int n = au & 127, kvh = (au >> 7) & 3, b = au >> 9;
    const size_t rblk = (size_t)b * T + (size_t)n * 128;
    for (int e = tid; e < 256 * 8 * 2; e += NTHR) { const int which = e >> 11, rem = e & 2047, j = rem >> 3, c8 = rem & 7; const bool valid = (n > 0) || (j >= 128);
        v4u w = {0u, 0u, 0u, 0u}; if (valid) w = *(const GAS v4u*)(Z + (rblk + j - 128) * ZN + 1024 + which * 256 + kvh * 64 + 8 * c8);
        *(LAS v4u*)(ldsb + (which ? AT_V + j * 192 : AT_K + j * 144) + c8 * 16) = w; }
    __syncthreads();
    const int lane = tid & 63, wave = tid >> 6, l31 = lane & 31, h = lane >> 5;
    const unsigned ldsbase = (unsigned)(size_t)ldsb;
#pragma unroll 1
    for (int it = 0; it < 2; ++it) {
        const int tt = 2 * wave + it, g = tt >> 2, qi = tt & 3, hq = kvh * 4 + g; const size_t qrow = rblk + 32 * qi + l31;
        bf16x8_t qf[4];
#pragma unroll
        for (int ks = 0; ks < 4; ++ks) qf[ks] = *(const GAS bf16x8_t*)(Z + qrow * ZN + hq * 64 + 16 * ks + 8 * h);
        f32x16 st[5];
#pragma unroll
        for (int kt = 0; kt < 5; ++kt) {
#pragma unroll
            for (int r = 0; r < 16; ++r) st[kt][r] = 0.f;
#pragma unroll
            for (int ks = 0; ks < 4; ++ks) { const bf16x8_t kf = *(const LAS bf16x8_t*)(ldsb + AT_K + (32 * (qi + kt) + l31) * 144 + (16 * ks + 8 * h) * 2);
                st[kt] = __builtin_amdgcn_mfma_f32_32x32x16_bf16(kf, qf[ks], st[kt], 0, 0, 0); } }
        const float slope = exp2f(-0.5f * (float)(hq + 1)); const float sink = a.in[I_ESINK][li * 16 + hq];
        float mx = sink;
#pragma unroll
        for (int kt = 0; kt < 5; ++kt)
#pragma unroll
            for (int r = 0; r < 16; ++r) { const int j = 32 * (qi + kt) + (r & 3) + 8 * (r >> 2) + 4 * h; const int dist = 32 * qi + l31 + 128 - j;
                const bool ok = (dist >= 0) && (dist < 128) && ((n > 0) || (j >= 128));
                const float s = ok ? st[kt][r] * 0.125f - slope * (float)dist : -INFINITY; st[kt][r] = s; mx = fmaxf(mx, s); }
        mx = fmaxf(mx, __shfl_xor(mx, 32));
        float l = 0.f;
#pragma unroll
        for (int kt = 0; kt < 5; ++kt)
#pragma unroll
            for (int r = 0; r < 16; ++r) { const float p = __expf(st[kt][r] - mx); st[kt][r] = p; l += p; }
        l += __shfl_xor(l, 32); l += __expf(sink - mx);
        f32x16 ot[2];
#pragma unroll
        for (int r = 0; r < 16; ++r) { ot[0][r] = 0.f; ot[1][r] = 0.f; }
#pragma unroll
        for (int kt = 0; kt < 5; ++kt)
#pragma unroll
            for (int s2 = 0; s2 < 2; ++s2) {
                v4u pw; pw.x = pk2(st[kt][8 * s2 + 0], st[kt][8 * s2 + 1]); pw.y = pk2(st[kt][8 * s2 + 2], st[kt][8 * s2 + 3]); pw.z = pk2(st[kt][8 * s2 + 4], st[kt][8 * s2 + 5]); pw.w = pk2(st[kt][8 * s2 + 6], st[kt][8 * s2 + 7]);
                const bf16x8_t pf = __builtin_bit_cast(bf16x8_t, pw);
#pragma unroll
                for (int db = 0; db < 2; ++db) {
                    const unsigned va = ldsbase + AT_V + (unsigned)(32 * (qi + kt) + 16 * s2 + 4 * h + ((lane & 15) >> 2)) * 192u + (unsigned)(32 * db + 16 * ((lane >> 4) & 1) + 4 * (lane & 3)) * 2u;
                    const bf16x8_t vf = tr_frag(va);
                    ot[db] = __builtin_amdgcn_mfma_f32_32x32x16_bf16(vf, pf, ot[db], 0, 0, 0); } }
        const float inv = 1.0f / l;
#pragma unroll
        for (int db = 0; db < 2; ++db)
#pragma unroll
            for (int g4 = 0; g4 < 4; ++g4)
                *(GAS v2u*)(O + qrow * D + 1024 + hq * 64 + 32 * db + 8 * g4 + 4 * h) = pack4(ot[db][4 * g4] * inv, ot[db][4 * g4 + 1] * inv, ot[db][4 * g4 + 2] * inv, ot[db][4 * g4 + 3] * inv);
    }
    __syncthreads();
}

__device__ __forceinline__ void e3_phase(const Args& a, int li, int vcu, int G, int tid) {
    unsigned char* ws = a.ws; const float* Y = a.out;
    const bf16* R = (const bf16*)(ws + SC_R); const bf16* K2 = (const bf16*)(ws + SC_K2); const bf16* GG = (const bf16*)(ws + SC_GG); const bf16* V = (const bf16*)(ws + (li ? WS_V2 : WS_VF));
    bf16* O = (bf16*)(ws + WS_O);
    const float* rk = a.in[I_ERK] + li * 1024; const float* gng = a.in[I_EGNG] + li * 1024; const float* gnb = a.in[I_EGNB] + li * 1024;
    for (size_t e4 = (size_t)vcu * NTHR + tid; e4 < (size_t)M * 256; e4 += (size_t)G * NTHR) {
        const size_t row = e4 >> 8; const int c = (int)(e4 & 255) * 4; const size_t e = row * 1024 + c;
        const f32x4 y = *(const GAS f32x4*)(Y + e);
        const v2u rw = *(const GAS v2u*)(R + e), kw = *(const GAS v2u*)(K2 + e), vw = *(const GAS v2u*)(V + e), gw = *(const GAS v2u*)(GG + e);
        const f32x4 rkv = *(const f32x4*)(rk + c), ggv = *(const f32x4*)(gng + c), gbv = *(const f32x4*)(gnb + c);
        const float mean = row16_sum((y.x + y.y) + (y.z + y.w)) * (1.0f / 64.0f);
        const f32x4 d = y - mean;
        const float var = row16_sum((d.x * d.x + d.y * d.y) + (d.z * d.z + d.w * d.w)) * (1.0f / 64.0f);
        const float rs = rsqrtf(var + 64e-5f);
        const float r0 = bflo(rw.x), r1 = bfhi(rw.x), r2 = bflo(rw.y), r3 = bfhi(rw.y), k0 = bflo(kw.x), k1 = bfhi(kw.x), k2 = bflo(kw.y), k3 = bfhi(kw.y);
        const float bonus = row16_sum((r0 * k0 * rkv.x + r1 * k1 * rkv.y) + (r2 * k2 * rkv.z + r3 * k3 * rkv.w));
        const float o0 = (d.x * rs * ggv.x + gbv.x + bonus * bflo(vw.x)) * bflo(gw.x), o1 = (d.y * rs * ggv.y + gbv.y + bonus * bfhi(vw.x)) * bfhi(gw.x);
        const float o2 = (d.z * rs * ggv.z + gbv.z + bonus * bflo(vw.y)) * bflo(gw.y), o3 = (d.w * rs * ggv.w + gbv.w + bonus * bfhi(vw.y)) * bfhi(gw.y);
        *(GAS v2u*)(O + row * D + c) = pack4(o0, o1, o2, o3);
    }
}

constexpr int SG_W = 0, SG_V = 34816;
__device__ __forceinline__ unsigned sg_off(unsigned row, unsigned ch) { return 256u * row + 16u * (ch ^ (((row & 3u) << 2) | ((row >> 2) & 3u))); }
__device__ __forceinline__ bf16x8_t tr_frag2(unsigned a0, unsigned a1) {
    v2u lo, hi; asm volatile("ds_read_b64_tr_b16 %0, %2\n\tds_read_b64_tr_b16 %1, %3\n\ts_waitcnt lgkmcnt(0)" : "=&v"(lo), "=&v"(hi) : "v"(a0), "v"(a1) : "memory");
    v4u w; w.x = lo.x; w.y = lo.y; w.z = hi.x; w.w = hi.y; return __builtin_bit_cast(bf16x8_t, w);
}
__device__ __forceinline__ void sgu_phase(const Args& a, int li, LAS unsigned char* ldsb, int vcu, int G, int tid) {
    unsigned char* ws = a.ws; const bf16* Z = (const bf16*)(ws + WS_ACT); bf16* O = (bf16*)(ws + WS_O);
    const float* ssv = (const float*)(ws + WS_SS) + (size_t)(13 + li) * SS_REC;
    const bf16* WSB = (const bf16*)(ws + SM_WSB); const float* bs = a.in[I_OBS] + li * 16 * 128; const float* vng = a.in[I_OVNG] + li * D;
    const int lane = tid & 63, wave = tid >> 6, fr = lane & 15, fq = lane >> 4;
    const unsigned ldsbase = (unsigned)(size_t)ldsb;
    int gcur = -1;
    for (int u = vcu; u < 4096; u += G) {
        const int g = u & 15, bn = u >> 4; const size_t m0 = (size_t)bn * 128;
        __syncthreads();
        if (g != gcur) { gcur = g;
            for (int e = tid; e < 128 * 16; e += NTHR) { const int i = e >> 4, ch = e & 15; *(LAS v4u*)(ldsb + SG_W + i * 272 + ch * 16) = *(const GAS v4u*)(WSB + ((size_t)g * 128 + i) * 128 + 8 * ch); } }
        for (int e = tid; e < 128 * 16; e += NTHR) { const int j = e >> 4, ch = e & 15; const float rs = pg8::row_rs(ssv, (int)(m0 + j));
            const v4u w = *(const GAS v4u*)(Z + (m0 + j) * ZO + 2048 + g * 128 + 8 * ch); v4u o;
            o.x = pk2(bflo(w.x) * rs, bfhi(w.x) * rs); o.y = pk2(bflo(w.y) * rs, bfhi(w.y) * rs); o.z = pk2(bflo(w.z) * rs, bfhi(w.z) * rs); o.w = pk2(bflo(w.w) * rs, bfhi(w.w) * rs);
            *(LAS v4u*)(ldsb + SG_V + sg_off((unsigned)j, (unsigned)ch)) = o; }
        __syncthreads();
        bf16x8_t vf[4];
        { const unsigned q = (unsigned)(lane & 15) >> 2, p = (unsigned)lane & 3u;
#pragma unroll
          for (int ks = 0; ks < 4; ++ks) { const unsigned r0 = 32u * ks + 8u * fq + q;
              vf[ks] = tr_frag2(ldsbase + SG_V + sg_off(r0, 2u * wave + (p >> 1)) + 8u * (p & 1u), ldsbase + SG_V + sg_off(r0 + 4u, 2u * wave + (p >> 1)) + 8u * (p & 1u)); } }
        const int cc = g * 128 + 16 * wave + 4 * fq; const f32x4 vg = *(const f32x4*)(vng + cc);
#pragma unroll
        for (int mt = 0; mt < 8; ++mt) {
            f32x4 acc = {0.f, 0.f, 0.f, 0.f};
#pragma unroll
            for (int ks = 0; ks <= (mt >> 1); ++ks) { const bf16x8_t wf = *(const LAS bf16x8_t*)(ldsb + SG_W + (16 * mt + fr) * 272 + (32 * ks + 8 * fq) * 2);
                acc = __builtin_amdgcn_mfma_f32_16x16x32_bf16(vf[ks], wf, acc, 0, 0, 0); }
            const int i = 16 * mt + fr; const float bi = bs[g * 128 + i];
            const v2u uw = *(const GAS v2u*)(Z + (m0 + i) * ZO + cc);
            *(GAS v2u*)(O + (m0 + i) * D + cc) = pack4(bflo(uw.x) * (vg.x * acc[0] + bi), bfhi(uw.x) * (vg.y * acc[1] + bi), bflo(uw.y) * (vg.z * acc[2] + bi), bfhi(uw.y) * (vg.w * acc[3] + bi));
        }
    }
    __syncthreads();
}

__device__ __forceinline__ void final_phase(const Args& a, int vcu, int G, int wave, int lane) {
    const int gw = vcu * NWAVES + wave, NGW = G * NWAVES; const float* ss = (const float*)(a.ws + WS_SS) + (size_t)12 * SS_REC; const float* fg = a.in[I_FG]; const bf16* XBp = (const bf16*)(a.ws + WS_XB);
    for (int m = gw; m < M; m += NGW) { const float rs = pg8::row_rs(ss, m);
        const GAS v4u* xr = (const GAS v4u*)(XBp + (size_t)m * D) + lane; GAS f32x4* orow = (GAS f32x4*)(a.out + (size_t)m * D) + 2 * lane; const GAS f32x4* gr = (const GAS f32x4*)fg + 2 * lane;
#pragma unroll
        for (int j = 0; j < 4; ++j) { const v4u w = xr[64 * j]; const f32x4 g0 = gr[128 * j], g1 = gr[128 * j + 1];
            orow[128 * j] = (f32x4){bflo(w.x) * rs * g0.x, bfhi(w.x) * rs * g0.y, bflo(w.y) * rs * g0.z, bfhi(w.y) * rs * g0.w};
            orow[128 * j + 1] = (f32x4){bflo(w.z) * rs * g1.x, bfhi(w.z) * rs * g1.y, bflo(w.w) * rs * g1.z, bfhi(w.w) * rs * g1.w}; } }
}

__global__ void __launch_bounds__(NTHR, 2) mk_fwd(Args args) {
    extern __shared__ __attribute__((aligned(16))) unsigned char lds_raw[];
    LAS unsigned char* lds = (LAS unsigned char*)lds_raw;
    const int tid = threadIdx.x, lane = tid & 63, wave = __builtin_amdgcn_readfirstlane(tid >> 6);
    const int G = gridDim.x, bx = blockIdx.x; const int vcu = (G % 8 == 0) ? (bx % 8) * (G / 8) + bx / 8 : bx;
    unsigned char* ws = args.ws; gu32* ctl = (gu32*)(ws + WS_CTL);
    for (int u = tid; u < (LDS_BYTES - LDSCTL_OFF) / 4; u += NTHR) ((LAS unsigned*)(lds + LDSCTL_OFF))[u] = 0u;
    __syncthreads();
    const int lo = args.ph_lo, hi = args.ph_hi;
    const bool multi = (hi - lo) > 1;
    XcdBarrier bar; bar.bar = (unsigned*)(ctl + CW_BAR); bar.x = 0; bar.st = nullptr;
    if (multi) bar = xcd_barrier_post((unsigned*)(ctl + CW_BAR), (volatile LAS unsigned*)(lds + LDSCTL_OFF));
#define IN(k) (lo <= (k) && (k) < hi)
#define SEAM(k) do { if ((k) + 1 < hi) xcd_barrier(bar); } while (0)
#ifndef DUP_G
#define DUP_G 1
#endif
#ifndef DUP_T
#define DUP_T 1
#endif
#ifndef DUP_GR
#define DUP_GR DUP_G
#endif
#ifndef DUP_G1
#define DUP_G1 DUP_G
#endif
#ifndef DUP_SP
#define DUP_SP DUP_S
#endif
#ifndef DUP_SQ
#define DUP_SQ DUP_S
#endif
#ifndef DUP_PREP
#define DUP_PREP DUP_T
#endif
#ifndef DUP_E1
#define DUP_E1 DUP_T
#endif
#ifndef DUP_SGU
#define DUP_SGU DUP_T
#endif
#ifndef DUP_E3
#define DUP_E3 DUP_T
#endif
#define REPN(n) for (int rep_ = 0; rep_ < (n); ++rep_)
#ifndef DUP_S
#define DUP_S 1
#endif
#define REPG for (int rep_ = 0; rep_ < DUP_G; ++rep_)
#define REPT for (int rep_ = 0; rep_ < DUP_T; ++rep_)
#define REPS for (int rep_ = 0; rep_ < DUP_S; ++rep_)
#define RSEAM(n) do { if (rep_ + 1 < (n)) xcd_barrier(bar); } while (0)
    float* ssb = (float*)(ws + WS_SS);
    bf16* XB = (bf16*)(ws + WS_XB); bf16* ACT = (bf16*)(ws + WS_ACT); bf16* OB = (bf16*)(ws + WS_O);

    for (int s = 0; s < NSUB; ++s) {
        const int pb = s * 8, L = s / 3, kind = s % 3, li = L >> 1; const bool even = !(L & 1);
        #ifndef NO_PREP
        if (kind == 0 && IN(pb + 0)) { REPN(DUP_PREP) { const int t_ = opaque(tid); prep_phase(args, L, lds, vcu, G, __builtin_amdgcn_readfirstlane(t_ >> 6), t_ & 63); RSEAM(DUP_PREP); } SEAM(pb + 0); }
#endif
        if (IN(pb + 1)) {
            const float* ss = ssb + (size_t)s * SS_REC;
            LAS float* RC = (LAS float*)(lds + 135168);
            if (tid == 0) *(LAS int*)(RC + 256) = -1;
            __syncthreads();
            if (kind != 1) {
                pg8::Gemm g{XB, (const bf16*)(ws + (kind == 0 ? WT_GU1 : WT_GU2)), M, 2 * FF, D}; pg8::StaticOrder S; S.init(M, 2 * FF, G, bx);
                pg8::EpiSwiGLU E{ACT, FF, ss, RC};
#ifndef NO_G1
                REPN(DUP_G1) { pg8::gemm_phase<pg8::EpiSwiGLU, pg8::StaticOrder, true, true>(lds, g, S, E); RSEAM(DUP_G1); }
#endif
            } else if (even) {
                pg8::Gemm g{XB, (const bf16*)(ws + WT_IN), M, ZN, D}; pg8::StaticOrder S; S.init(M, ZN, G, bx);
                pg8::EpiZ E{ACT, ZN, ss, args.in[I_EBQKV] + li * 1536, RC};
#ifndef NO_GZ
                REPG { pg8::gemm_phase<pg8::EpiZ, pg8::StaticOrder, true, true>(lds, g, S, E); RSEAM(DUP_G); }
#endif
            } else {
                pg8::Gemm g{XB, (const bf16*)(ws + WT_IN), M, ZO, D}; pg8::StaticOrder S; S.init(M, ZO, G, bx);
                pg8::EpiGeluV E{ACT, ZO, ss, ssb + (size_t)(13 + li) * SS_REC, (LAS float*)(lds + 131072), RC};
#ifndef NO_GG
                REPG { pg8::gemm_phase<pg8::EpiGeluV, pg8::StaticOrder, true, true>(lds, g, S, E); RSEAM(DUP_G); }
#endif
            }
            SEAM(pb + 1);
        }
        if (kind == 1) {
            if (IN(pb + 2)) {
#ifndef NO_E1
                if (even) REPN(DUP_E1) { e1_phase(args, li, lds, vcu, G, opaque(tid)); RSEAM(DUP_E1); }
#endif
#ifndef NO_ATTN
                if (even) for (int au = vcu; au < 1024; au += G) attn_unit(args, li, au, lds, opaque(tid));
#endif
#ifndef NO_SGU
                if (!even) REPN(DUP_SGU) { sgu_phase(args, li, lds, vcu, G, opaque(tid)); RSEAM(DUP_SGU); }
#endif
                SEAM(pb + 2); }
#ifndef NO_SPRE
            if (even && IN(pb + 3)) { REPN(DUP_SP) { scanpre_phase(args, li, lds, vcu, G, opaque(tid)); RSEAM(DUP_SP); } SEAM(pb + 3); }
#endif
#ifndef NO_SSEQ
            if (even && IN(pb + 4)) { REPN(DUP_SQ) { scanseq_phase(args, li, lds, vcu, opaque(tid)); RSEAM(DUP_SQ); } SEAM(pb + 4); }
#endif
#ifndef NO_E3
            if (even && IN(pb + 5)) { REPN(DUP_E3) { e3_phase(args, li, vcu, G, opaque(tid)); RSEAM(DUP_E3); } SEAM(pb + 5); }
#endif
        }
        if (IN(pb + 6)) {
            const bf16* A = (kind == 1) ? OB : ACT; const int K = (kind == 1) ? D : FF;
            const bf16* Bt = (const bf16*)(ws + (kind == 0 ? WT_D1 : kind == 1 ? WT_OUT : WT_D2));
            pg8::Gemm g{A, Bt, M, D, K, kind == 1 ? 0 : 1}; pg8::StaticOrder S; S.init(M, D, G, bx);
            pg8::EpiResid E{XB, ssb + (size_t)(s + 1) * SS_REC, kind == 1 ? 1.0f : 0.5f, (LAS float*)(lds + 131072)};
#ifndef NO_GR
            REPN(DUP_GR) { if (rep_) { E.scale = 0.f;
#ifdef PROBE_NOEPI
                E.noop = 1;
#endif
                } pg8::gemm_phase<pg8::EpiResid, pg8::StaticOrder, true, true>(lds, g, S, E); RSEAM(DUP_GR); }
#endif
            SEAM(pb + 6);
        }
    }
    if (IN(NSUB * 8)) { const int t_ = opaque(tid); final_phase(args, vcu, G, __builtin_amdgcn_readfirstlane(t_ >> 6), t_ & 63); }
#undef IN
#undef SEAM
}

extern "C" void kernel_launch(void* const* d_in, const int* in_sizes, int n_in, void* d_out, int out_size, void* d_ws, size_t ws_size, hipStream_t stream) {
    static int grid = 0;
    if (grid == 0) {
        if (n_in != 29 || out_size != M * D || ws_size < WS_END) { fprintf(stderr, "kernel_launch: unexpected shapes (n_in %d, out %d, ws %zu < %zu); nothing launched\n", n_in, out_size, ws_size, (size_t)WS_END); grid = -1; return; }
        int dev = 0, cus = 0;
        if (hipGetDevice(&dev) != hipSuccess || hipDeviceGetAttribute(&cus, hipDeviceAttributeMultiprocessorCount, dev) != hipSuccess) { grid = -1; return; }
        if (hipFuncSetAttribute((const void*)mk_fwd, hipFuncAttributeMaxDynamicSharedMemorySize, LDS_BYTES) != hipSuccess) { fprintf(stderr, "kernel_launch: hipFuncSetAttribute failed\n"); grid = -1; return; }
        int per_cu = 0;
        if (hipOccupancyMaxActiveBlocksPerMultiprocessor(&per_cu, (const void*)mk_fwd, NTHR, LDS_BYTES) != hipSuccess || per_cu < 1) fprintf(stderr, "kernel_launch: occupancy query says %d\n", per_cu);
        (void)hipGetLastError();
        grid = cus;
    }
    if (grid < 0) return;
    (void)hipMemsetAsync((char*)d_ws + WS_CTL, 0, CTL_ZERO_BYTES, stream);
    Args a{};
    for (int i = 0; i < 29; ++i) a.in[i] = (const float*)d_in[i];
    a.out = (float*)d_out; a.ws = (unsigned char*)d_ws;
#if MK_ONE_LAUNCH
    a.ph_lo = 0; a.ph_hi = NSUB * 8 + 1;
    hipLaunchKernelGGL(mk_fwd, dim3(grid), dim3(NTHR), LDS_BYTES, stream, a);
#else
    for (int s = 0; s <= NSUB; ++s) {
        for (int k = 0; k < (s == NSUB ? 1 : 8); ++k) {
            const int L = s / 3, kind = s % 3; const bool even = !(L & 1);
            bool live;
            if (s == NSUB) live = true;
            else if (k == 0) live = (kind == 0);
            else if (k == 1 || k == 6) live = true;
            else if (k == 2) live = (kind == 1);
            else if (k == 3 || k == 4 || k == 5) live = (kind == 1) && even;
            else live = false;
            if (!live) continue;
            a.ph_lo = s * 8 + k; a.ph_hi = a.ph_lo + 1;
            hipLaunchKernelGGL(mk_fwd, dim3(grid), dim3(NTHR), LDS_BYTES, stream, a);
        }
    }
#endif
}
```

```cpp
#include <hip/hip_runtime.h>
#include <cstdio>
#include <cstdint>
#define MK_ONE_LAUNCH 1
namespace pg8 {
#define PG8_LAS __attribute__((address_space(3)))
typedef unsigned short bf16_t;
typedef short bf16x8 __attribute__((ext_vector_type(8)));
typedef float f32x4 __attribute__((ext_vector_type(4)));
typedef unsigned u32x4 __attribute__((ext_vector_type(4)));
constexpr int BM = 256, BK = 64, HALF = 128, HTB = HALF * BK * 2  , STAGE_BYTES = 8 * HTB, NXCD = 8, WGM = 8;

__host__ __device__ __forceinline__ int lds_byte(int r, int c) { const int st = (r >> 4) * 2 + (c >> 5), rr = r & 15, cc = c & 31, ob = rr * 64 + cc * 2; return st * 1024 + (ob ^ (((ob >> 9) & 1) << 5)); }
__host__ __device__ __forceinline__ void stage_rc(int b, int& R, int& C) { const int st = b / 1024, sb = b % 1024, swz = sb ^ (((sb >> 9) & 1) << 5); R = (st >> 1) * 16 + swz / 64; C = (st & 1) * 32 + (swz % 64) / 2; }
__host__ __device__ __forceinline__ int perm32(int rho) { const int n = rho >> 4, i = rho & 15; return 8 * (i >> 2) + 4 * n + (i & 3); }

struct Unit { int pm, pn; };
struct Gemm { const bf16_t* A; const bf16_t* Bt; int M, N, K; int amode = 0; };

struct StaticOrder {
    int nM, nN, nwg, G, c;
    __host__ __device__ void init(int M, int N, int G_, int c_) { nM = M / BM; nN = N / BM; nwg = nM * nN; G = G_; c = c_; }
    __host__ __device__ bool next(int i, Unit& u) const {
        const long L = (long)i * G + c; if (L >= nwg) return false;
        int wgid = (int)L; { const int q = nwg / NXCD, r = nwg % NXCD, xcd = wgid % NXCD, off = wgid / NXCD; wgid = (xcd < r ? xcd * (q + 1) : r * (q + 1) + (xcd - r) * q) + off; }
        const int nig = WGM * nN, gid = wgid / nig, fm = gid * WGM, gsz = (nM - fm) < WGM ? (nM - fm) : WGM;
        u.pm = fm + ((wgid % nig) % gsz); u.pn = (wgid % nig) / gsz; return true;
    }
    __device__ __forceinline__ void a_ready(const Unit&) const {}
    __device__ __forceinline__ void done(const Unit&) const {}
};
__device__ __forceinline__ unsigned cvt_pk_bf16(float lo, float hi) { unsigned r; asm volatile("v_cvt_pk_bf16_f32 %0, %1, %2" : "=v"(r) : "v"(lo), "v"(hi)); return r; }
typedef float f32x2 __attribute__((ext_vector_type(2)));
__device__ __forceinline__ f32x2 gelu_pk(f32x2 v) {
    const f32x2 av = __builtin_elementwise_abs(v), d = av * 0.2316418882f + 1.0f;
    f32x2 t; t.x = __builtin_amdgcn_rcpf(d.x); t.y = __builtin_amdgcn_rcpf(d.y);
    f32x2 q = t * 0.5307027145f + (-0.7265760135f); q = q * t + 0.7107068705f; q = q * t + (-0.142248368f); q = q * t + 0.127414796f; q = q * t;
    const f32x2 s = (v * v) * (-0.72134752044f);
    f32x2 e; e.x = __builtin_amdgcn_exp2f(s.x); e.y = __builtin_amdgcn_exp2f(s.y);
    const f32x2 m = v * (q * e), r = v - m;
    f32x2 o; o.x = v.x < 0.f ? m.x : r.x; o.y = v.y < 0.f ? m.y : r.y; return o;
}

constexpr int SS_M = 32768;
__device__ __forceinline__ float row_rs(const float* P, int row) {
    const float s = ((P[row] + P[SS_M + row]) + (P[2 * SS_M + row] + P[3 * SS_M + row])) + ((P[4 * SS_M + row] + P[5 * SS_M + row]) + (P[6 * SS_M + row] + P[7 * SS_M + row]));
    return rsqrtf(s * (1.0f / 2048.0f) + 1e-6f);
}
__device__ __forceinline__ void panel_rs(const float* ss, PG8_LAS float* rc, int pm, int t) {
    PG8_LAS int* tag = (PG8_LAS int*)(rc + BM);
    const int have = *tag;
    if (have != pm && t < BM) rc[t] = row_rs(ss, pm * BM + t);
    asm volatile("s_waitcnt lgkmcnt(0)" ::: "memory"); __builtin_amdgcn_s_barrier(); asm volatile("" ::: "memory");
    if (have != pm && t == 0) *tag = pm;
}
struct EpiSwiGLU {
    static constexpr bool PERM = true, AFTER_DRAIN = false;
    bf16_t* O; int ldc; const float* ss; PG8_LAS float* rc;
    __device__ __forceinline__ void operator()(const f32x4 (&acc)[2][2][4][2], const Unit& u, int wr, int wc, int fr, int fq) const {
        const int row0 = u.pm * BM + wr * 64 + fr, col0 = u.pn * HALF + wc * 32 + 8 * fq;
        panel_rs(ss, rc, u.pm, (wr * 4 + wc) * 64 + fq * 16 + fr);
#pragma unroll
        for (int ai = 0; ai < 2; ++ai)
#pragma unroll
            for (int m = 0; m < 4; ++m) {
                const int row = row0 + ai * HALF + m * 16;
                const float rs = rc[row - u.pm * BM];
                float o[8];
#pragma unroll
                for (int n = 0; n < 2; ++n)
#pragma unroll
                    for (int j = 0; j < 4; ++j) { const float g = acc[ai][0][m][n][j] * rs, up = acc[ai][1][m][n][j] * rs; o[4 * n + j] = g * __builtin_amdgcn_rcpf(1.0f + __expf(-g)) * up; }
                u32x4 w; w.x = cvt_pk_bf16(o[0], o[1]); w.y = cvt_pk_bf16(o[2], o[3]); w.z = cvt_pk_bf16(o[4], o[5]); w.w = cvt_pk_bf16(o[6], o[7]);
                *(u32x4*)(O + ((size_t)(u.pm * (ldc >> 6) + (col0 >> 6)) * BM + (row - u.pm * BM)) * BK + (col0 & 63)) = w;
                asm volatile("" ::: "memory");
            }
    }
};
struct EpiResid {
    static constexpr bool PERM = true, AFTER_DRAIN = false;
    bf16_t* xb; float* ssn; float scale; PG8_LAS float* sp;
    int noop = 0;
    __device__ __forceinline__ void operator()(const f32x4 (&acc)[2][2][4][2], const Unit& u, int wr, int wc, int fr, int fq) const {
        const int row0 = u.pm * BM + wr * 64 + fr, col0 = u.pn * BM + wc * 32 + 8 * fq;
        if (noop) return;
        u32x4 bn[2];
#pragma unroll
        for (int bj = 0; bj < 2; ++bj) bn[bj] = *(const u32x4*)(xb + (size_t)row0 * 2048 + col0 + bj * HALF);
#pragma unroll
        for (int gi = 0; gi < 8; ++gi) {
            const int ai = gi >> 2, m = gi & 3;
            const int row = row0 + ai * HALF + m * 16; const size_t off = (size_t)row * 2048 + col0; float s = 0.f;
            u32x4 bc[2]; bc[0] = bn[0]; bc[1] = bn[1];
            if (gi < 7) { const size_t off2 = (size_t)(row0 + ((gi + 1) >> 2) * HALF + ((gi + 1) & 3) * 16) * 2048 + col0;
#pragma unroll
                for (int bj = 0; bj < 2; ++bj) bn[bj] = *(const u32x4*)(xb + off2 + bj * HALF); }
#pragma unroll
            for (int bj = 0; bj < 2; ++bj) {
                const f32x4 a0 = acc[ai][bj][m][0] * scale, a1 = acc[ai][bj][m][1] * scale; const u32x4 b = bc[bj]; u32x4 w;
                w.x = cvt_pk_bf16(__uint_as_float(b.x << 16) + a0[0], __uint_as_float(b.x & 0xffff0000u) + a0[1]);
                w.y = cvt_pk_bf16(__uint_as_float(b.y << 16) + a0[2], __uint_as_float(b.y & 0xffff0000u) + a0[3]);
                w.z = cvt_pk_bf16(__uint_as_float(b.z << 16) + a1[0], __uint_as_float(b.z & 0xffff0000u) + a1[1]);
                w.w = cvt_pk_bf16(__uint_as_float(b.w << 16) + a1[2], __uint_as_float(b.w & 0xffff0000u) + a1[3]);
                *(u32x4*)(xb + off + bj * HALF) = w;
                const float r0 = __uint_as_float(w.x << 16), r1 = __uint_as_float(w.x & 0xffff0000u), r2 = __uint_as_float(w.y << 16), r3 = __uint_as_float(w.y & 0xffff0000u);
                const float r4 = __uint_as_float(w.z << 16), r5 = __uint_as_float(w.z & 0xffff0000u), r6 = __uint_as_float(w.w << 16), r7 = __uint_as_float(w.w & 0xffff0000u);
                s += ((r0 * r0 + r1 * r1) + (r2 * r2 + r3 * r3)) + ((r4 * r4 + r5 * r5) + (r6 * r6 + r7 * r7));
            }
            s += __shfl_xor(s, 16); s += __shfl_xor(s, 32);
            if (fq == 0) sp[(ai * HALF + wr * 64 + m * 16 + fr) * 4 + wc] = s;
            asm volatile("" ::: "memory");
        }
        asm volatile("s_waitcnt lgkmcnt(0)" ::: "memory"); __builtin_amdgcn_s_barrier(); asm volatile("" ::: "memory");
        const int t = (wr * 4 + wc) * 64 + fq * 16 + fr;
        if (t < BM) { const f32x4 p = *(const PG8_LAS f32x4*)(sp + t * 4); ssn[(size_t)u.pn * SS_M + u.pm * BM + t] = (p[0] + p[1]) + (p[2] + p[3]); }
    }
};
struct EpiZ {
    static constexpr bool PERM = true, AFTER_DRAIN = false;
    bf16_t* O; int ldc; const float* ss; const float* bias; PG8_LAS float* rc;
    __device__ __forceinline__ void operator()(const f32x4 (&acc)[2][2][4][2], const Unit& u, int wr, int wc, int fr, int fq) const {
        const int row0 = u.pm * BM + wr * 64 + fr, col0 = u.pn * BM + wc * 32 + 8 * fq;
        panel_rs(ss, rc, u.pm, (wr * 4 + wc) * 64 + fq * 16 + fr);
        const bool hb = u.pn < 6;
        f32x4 bv[2][2];
#pragma unroll
        for (int bj = 0; bj < 2; ++bj)
#pragma unroll
            for (int n = 0; n < 2; ++n) bv[bj][n] = hb ? *(const f32x4*)(bias + col0 + bj * HALF + 4 * n) : (f32x4){0.f, 0.f, 0.f, 0.f};
#pragma unroll
        for (int ai = 0; ai < 2; ++ai)
#pragma unroll
            for (int m = 0; m < 4; ++m) {
                const int row = row0 + ai * HALF + m * 16;
                const float rs = rc[row - u.pm * BM];
                bf16_t* rowp = O + (size_t)row * ldc + col0;
#pragma unroll
                for (int bj = 0; bj < 2; ++bj) {
                    const f32x4 v0 = acc[ai][bj][m][0] * rs + bv[bj][0], v1 = acc[ai][bj][m][1] * rs + bv[bj][1];
                    u32x4 w; w.x = cvt_pk_bf16(v0[0], v0[1]); w.y = cvt_pk_bf16(v0[2], v0[3]); w.z = cvt_pk_bf16(v1[0], v1[1]); w.w = cvt_pk_bf16(v1[2], v1[3]);
                    *(u32x4*)(rowp + bj * HALF) = w;
                }
                asm volatile("" ::: "memory");
            }
    }
};
struct EpiGeluV {
    static constexpr bool PERM = true, AFTER_DRAIN = false;
    bf16_t* O; int ldc; const float* ss; float* ssv; PG8_LAS float* sp; PG8_LAS float* rc;
    __device__ __forceinline__ void operator()(const f32x4 (&acc)[2][2][4][2], const Unit& u, int wr, int wc, int fr, int fq) const {
        const int row0 = u.pm * BM + wr * 64 + fr, col0 = u.pn * BM + wc * 32 + 8 * fq;
        panel_rs(ss, rc, u.pm, (wr * 4 + wc) * 64 + fq * 16 + fr);
        const bool isv = u.pn >= 8;
#pragma unroll
        for (int ai = 0; ai < 2; ++ai)
#pragma unroll
            for (int m = 0; m < 4; ++m) {
                const int row = row0 + ai * HALF + m * 16;
                const float rs = rc[row - u.pm * BM];
                bf16_t* rowp = O + (size_t)row * ldc + col0; float s = 0.f;
#pragma unroll
                for (int bj = 0; bj < 2; ++bj) {
                    f32x4 v0 = acc[ai][bj][m][0] * rs, v1 = acc[ai][bj][m][1] * rs;
                    const f32x2 a = gelu_pk((f32x2){v0[0], v0[1]}), b = gelu_pk((f32x2){v0[2], v0[3]}), c = gelu_pk((f32x2){v1[0], v1[1]}), d = gelu_pk((f32x2){v1[2], v1[3]});
                    s += (a.x * a.x + a.y * a.y) + (b.x * b.x + b.y * b.y) + (c.x * c.x + c.y * c.y) + (d.x * d.x + d.y * d.y);
                    u32x4 w; w.x = cvt_pk_bf16(a.x, a.y); w.y = cvt_pk_bf16(b.x, b.y); w.z = cvt_pk_bf16(c.x, c.y); w.w = cvt_pk_bf16(d.x, d.y);
                    *(u32x4*)(rowp + bj * HALF) = w;
                }
                if (isv) { s += __shfl_xor(s, 16); s += __shfl_xor(s, 32); if (fq == 0) sp[(ai * HALF + wr * 64 + m * 16 + fr) * 4 + wc] = s; }
                asm volatile("" ::: "memory");
            }
        if (isv) {
            asm volatile("s_waitcnt lgkmcnt(0)" ::: "memory"); __builtin_amdgcn_s_barrier(); asm volatile("" ::: "memory");
            const int t = (wr * 4 + wc) * 64 + fq * 16 + fr;
            if (t < BM) { const f32x4 p = *(const PG8_LAS f32x4*)(sp + t * 4); ssv[(size_t)(u.pn - 8) * SS_M + u.pm * BM + t] = (p[0] + p[1]) + (p[2] + p[3]); }
        }
    }
};
template <class Epi, class Sched, bool ALIGN_EPI = false, bool SP2 = false>
__device__ __forceinline__ void gemm_phase(PG8_LAS unsigned char* lds, const Gemm g, const Sched& S, const Epi& E) {
    int tid_ = threadIdx.x; asm volatile("" : "+v"(tid_));
    const int tid = tid_, wid = __builtin_amdgcn_readfirstlane(tid >> 6), lane = tid & 63, wr = wid >> 2, wc = wid & 3, fr = lane & 15, fq = lane >> 4;
    const int K = g.K, nt = K / BK;
    unsigned voffA[2], voffB[2];
#pragma unroll
    for (int i = 0; i < 2; ++i) { int R, C; stage_rc(tid * 16 + i * 8192, R, C); const int Rb = Epi::PERM ? ((R & ~31) + perm32(R & 31)) : R;
        voffA[i] = g.amode ? (unsigned)(R * BK + C) * 2u : (unsigned)(R * K + C) * 2u; voffB[i] = (unsigned)(Rb * K + C) * 2u; }
    const size_t kstep = (size_t)(BK * 2);
    const size_t hstep = (size_t)HALF * K * 2;
    const size_t tstep = 2 * hstep;
    const size_t kstepA = g.amode ? (size_t)(BM * BK * 2) : kstep, hstepA = g.amode ? (size_t)(HALF * BK * 2) : hstep, tstepA = g.amode ? (size_t)(K / BK) * (BM * BK * 2) : tstep;
    const unsigned ldsw = (unsigned)wid * 1024u;
    const int aoff = lds_byte(wr * 64 + fr, fq * 8), boff = lds_byte(wc * 32 + fr, fq * 8);
#define PG8_SA(b, h) (((b) * 2 + (h)) * HTB)
#define PG8_SB(b, h) ((4 + (b) * 2 + (h)) * HTB)
#define PG8_STAGE(bufoff, gbase, voff) do { _Pragma("unroll") for (int _i = 0; _i < 2; ++_i) \
        __builtin_amdgcn_global_load_lds((const unsigned*)((const char*)(gbase) + (voff)[_i]), (PG8_LAS unsigned*)(lds + (bufoff) + ldsw + _i * 8192), 16, 0, 0); } while (0)
#define PG8_LDA(dst, b, h) do { _Pragma("unroll") for (int m = 0; m < 4; ++m) _Pragma("unroll") for (int k = 0; k < 2; ++k) dst[m][k] = *(const PG8_LAS bf16x8*)(lds + PG8_SA(b, h) + aoff + m * 2048 + k * 1024); } while (0)
#define PG8_LDB(dst, b, h) do { _Pragma("unroll") for (int n = 0; n < 2; ++n) _Pragma("unroll") for (int k = 0; k < 2; ++k) dst[n][k] = *(const PG8_LAS bf16x8*)(lds + PG8_SB(b, h) + boff + n * 2048 + k * 1024); } while (0)
#define PG8_MMA(ai, bj, At, Bt) do { __builtin_amdgcn_s_setprio(1); _Pragma("unroll") for (int m = 0; m < 4; ++m) _Pragma("unroll") for (int n = 0; n < 2; ++n) _Pragma("unroll") for (int k = 0; k < 2; ++k) \
        acc[ai][bj][m][n] = __builtin_amdgcn_mfma_f32_16x16x32_bf16(Bt[n][k], At[m][k], acc[ai][bj][m][n], 0, 0, 0); __builtin_amdgcn_s_setprio(0); } while (0)
#define PG8_WAIT_V(n) asm volatile("s_waitcnt vmcnt(" #n ")" ::: "memory")
#define PG8_WAIT_L(n) asm volatile("s_waitcnt lgkmcnt(" #n ")" ::: "memory")
#define PG8_BAR __builtin_amdgcn_s_barrier()
#define PG8_SCHED __builtin_amdgcn_sched_barrier(0)
    Unit cur, nxt; int ui = 0;
    if (!S.next(0, cur)) return;
    f32x4 acc[2][2][4][2];
#pragma unroll
    for (int a = 0; a < 2; ++a)
#pragma unroll
        for (int b = 0; b < 2; ++b)
#pragma unroll
            for (int m = 0; m < 4; ++m)
#pragma unroll
                for (int n = 0; n < 2; ++n) acc[a][b][m][n] = (f32x4){0.f, 0.f, 0.f, 0.f};
    bf16x8 At[4][2], B0[2][2], B1[2][2];
    const char* cA = (const char*)g.A + (size_t)cur.pm * tstepA; const char* cB = (const char*)g.Bt + (size_t)cur.pn * tstep;
    S.a_ready(cur);
    if constexpr (SP2) {
        PG8_STAGE(PG8_SB(0, 0), cB, voffB); PG8_STAGE(PG8_SB(0, 1), cB + hstep, voffB); PG8_STAGE(PG8_SA(0, 0), cA, voffA); PG8_STAGE(PG8_SA(0, 1), cA + hstepA, voffA);
        if (wr == 1) PG8_BAR;
        PG8_WAIT_V(2); PG8_BAR;
        PG8_STAGE(PG8_SB(1, 0), cB + kstep, voffB); PG8_STAGE(PG8_SA(1, 0), cA + kstepA, voffA); PG8_STAGE(PG8_SB(1, 1), cB + hstep + kstep, voffB);
        PG8_WAIT_V(6); PG8_BAR;
    } else {
        PG8_STAGE(PG8_SB(0, 0), cB, voffB); PG8_STAGE(PG8_SA(0, 0), cA, voffA); PG8_STAGE(PG8_SB(0, 1), cB + hstep, voffB); PG8_STAGE(PG8_SA(0, 1), cA + hstepA, voffA);
        if (wr == 1) PG8_BAR;
        PG8_WAIT_V(4); PG8_BAR;
        PG8_STAGE(PG8_SB(1, 0), cB + kstep, voffB); PG8_STAGE(PG8_SA(1, 0), cA + kstepA, voffA); PG8_STAGE(PG8_SB(1, 1), cB + hstep + kstep, voffB);
        PG8_WAIT_V(6); PG8_BAR;
    }
    for (;;) {
        const bool has_next = S.next(ui + 1, nxt);
        const char* nA = has_next ? (const char*)g.A + (size_t)nxt.pm * tstepA : cA; const char* nB = has_next ? (const char*)g.Bt + (size_t)nxt.pn * tstep : cB;
        for (int t = 0; t < nt; t += 2) {
            const bool last = (t == nt - 2);
            const char* a1 = cA + (size_t)(t + 1) * kstepA;
            const char* a2 = last ? nA : cA + (size_t)(t + 2) * kstepA; const char* b2 = last ? nB : cB + (size_t)(t + 2) * kstep;
            const char* a3 = a2 + kstepA; const char* b3 = b2 + kstep;
            if (last && has_next) S.a_ready(nxt);
            if constexpr (SP2) {
            PG8_LDB(B0, 0, 0); PG8_LDB(B1, 0, 1); PG8_SCHED; PG8_LDA(At, 0, 0); PG8_STAGE(PG8_SA(1, 1), a1 + hstepA, voffA);
            PG8_WAIT_V(8); PG8_WAIT_L(0); PG8_BAR; PG8_MMA(0, 0, At, B0); PG8_MMA(0, 1, At, B1); PG8_BAR; PG8_SCHED;
            PG8_LDA(At, 0, 1); PG8_STAGE(PG8_SB(0, 0), b2, voffB); PG8_STAGE(PG8_SB(0, 1), b2 + hstep, voffB); PG8_STAGE(PG8_SA(0, 0), a2, voffA);
            PG8_WAIT_V(8); PG8_WAIT_L(0); PG8_BAR; PG8_MMA(1, 0, At, B0); PG8_MMA(1, 1, At, B1); PG8_BAR; PG8_SCHED;
            PG8_LDB(B0, 1, 0); PG8_LDB(B1, 1, 1); PG8_SCHED; PG8_LDA(At, 1, 0); PG8_STAGE(PG8_SA(0, 1), a2 + hstepA, voffA);
            PG8_WAIT_V(8); PG8_WAIT_L(0); PG8_BAR; PG8_MMA(0, 0, At, B0); PG8_MMA(0, 1, At, B1); PG8_BAR; PG8_SCHED;
            PG8_LDA(At, 1, 1); PG8_STAGE(PG8_SB(1, 0), b3, voffB); PG8_STAGE(PG8_SB(1, 1), b3 + hstep, voffB); PG8_STAGE(PG8_SA(1, 0), a3, voffA);
            PG8_WAIT_V(8); PG8_WAIT_L(0); PG8_BAR; PG8_MMA(1, 0, At, B0); PG8_MMA(1, 1, At, B1); PG8_BAR; PG8_SCHED;
            } else {
            PG8_LDB(B0, 0, 0); PG8_SCHED; PG8_LDA(At, 0, 0); PG8_STAGE(PG8_SA(1, 1), a1 + hstepA, voffA);
            PG8_WAIT_L(8); PG8_BAR; PG8_WAIT_L(0); PG8_MMA(0, 0, At, B0); PG8_BAR; PG8_SCHED;
            PG8_LDB(B1, 0, 1); PG8_STAGE(PG8_SB(0, 0), b2, voffB);
            PG8_BAR; PG8_WAIT_L(0); PG8_MMA(0, 1, At, B1); PG8_BAR;
            PG8_LDA(At, 0, 1); PG8_STAGE(PG8_SA(0, 0), a2, voffA);
            PG8_BAR; PG8_WAIT_L(0); PG8_MMA(1, 0, At, B0); PG8_BAR; PG8_SCHED;
            PG8_STAGE(PG8_SB(0, 1), b2 + hstep, voffB);
            PG8_WAIT_V(6); PG8_BAR; PG8_MMA(1, 1, At, B1); PG8_BAR;
            PG8_LDB(B0, 1, 0); PG8_SCHED; PG8_LDA(At, 1, 0); PG8_STAGE(PG8_SA(0, 1), a2 + hstepA, voffA);
            PG8_WAIT_L(8); PG8_BAR; PG8_WAIT_L(0); PG8_MMA(0, 0, At, B0); PG8_BAR; PG8_SCHED;
            PG8_LDB(B1, 1, 1); PG8_STAGE(PG8_SB(1, 0), b3, voffB);
            PG8_BAR; PG8_WAIT_L(0); PG8_MMA(0, 1, At, B1); PG8_BAR;
            PG8_LDA(At, 1, 1); PG8_STAGE(PG8_SA(1, 0), a3, voffA);
            PG8_BAR; PG8_WAIT_L(0); PG8_MMA(1, 0, At, B0); PG8_BAR; PG8_SCHED;
            PG8_STAGE(PG8_SB(1, 1), b3 + hstep, voffB);
            PG8_WAIT_V(6); PG8_BAR; PG8_MMA(1, 1, At, B1); PG8_BAR;
            }
        }
        if constexpr (ALIGN_EPI) { if (wr == 0) PG8_BAR; }
        if constexpr (!Epi::AFTER_DRAIN) { E(acc, cur, wr, wc, fr, fq); S.done(cur); }
        if (!has_next) break;
#pragma unroll
        for (int a = 0; a < 2; ++a)
#pragma unroll
            for (int b = 0; b < 2; ++b)
#pragma unroll
                for (int m = 0; m < 4; ++m)
#pragma unroll
                    for (int n = 0; n < 2; ++n) acc[a][b][m][n] = (f32x4){0.f, 0.f, 0.f, 0.f};
        cur = nxt; cA = nA; cB = nB; ++ui;
        if constexpr (ALIGN_EPI) { if (wr == 1) PG8_BAR; }
    }
    PG8_WAIT_V(0);
    if constexpr (!ALIGN_EPI) { if (wr == 0) PG8_BAR; }
    PG8_BAR;
    if constexpr (Epi::AFTER_DRAIN) { E.fused(acc, cur, wr, wc, fr, fq, lds, wid, lane); S.done(cur); }
#undef PG8_SA
#undef PG8_SB
#undef PG8_STAGE
#undef PG8_LDA
#undef PG8_LDB
#undef PG8_MMA
#undef PG8_WAIT_V
#undef PG8_WAIT_L
#undef PG8_BAR
#undef PG8_SCHED
}
}
#define LAS_BAR __attribute__((address_space(3)))
#define XB_TMO      128
#define XB_XCNT(j)  (256  + 64 * (j))
#define XB_XSUB(j)  (1280 + 64 * (j))
#define XB_XGEN(j)  (2304 + 64 * (j))
#define XB_TOP      3328
#define XB_TOPGEN   3392
#define XCD_BAR_WORDS 3456
#define XB_SPIN_CAP (1u << 22)

__device__ __forceinline__ unsigned xb_ld(unsigned* p)              { return __hip_atomic_load(p, __ATOMIC_RELAXED, __HIP_MEMORY_SCOPE_AGENT); }
__device__ __forceinline__ unsigned xb_add(unsigned* p, unsigned v) { return __hip_atomic_fetch_add(p, v, __ATOMIC_RELAXED, __HIP_MEMORY_SCOPE_AGENT); }
__device__ __forceinline__ unsigned xb_xcc_id() { return (unsigned)__builtin_amdgcn_s_getreg((3 << 11) | 20) & 0xFu; }
#define XB_SPIN(cond, bar) do { unsigned _sp = 0; while (cond) { __builtin_amdgcn_s_sleep(1); \
    if ((++_sp & 255u) == 0u) { if (xb_ld(&(bar)[XB_TMO])) break; if (_sp > XB_SPIN_CAP) { atomicAdd(&(bar)[XB_TMO], 1u); break; } } } } while (0)

struct XcdBarrier {
    unsigned* bar; unsigned x;
    volatile LAS_BAR unsigned* st;
};

__device__ __forceinline__ XcdBarrier xcd_barrier_post(unsigned* bar, volatile LAS_BAR unsigned* st) {
    XcdBarrier b; b.bar = bar; b.x = xb_xcc_id(); b.st = st;
    if (threadIdx.x == 0) (void)xb_add(&bar[XB_XCNT(b.x)], 1u);
    return b;
}
__device__ __forceinline__ void xcd_barrier_complete(unsigned* bar, unsigned x, unsigned& nloc, unsigned& nx) {
    const unsigned G = gridDim.x * gridDim.y * gridDim.z;
    unsigned sum, cnt, mine, sp = 0u;
    for (;;) {
        sum = 0u; cnt = 0u; mine = 0u;
#pragma unroll
        for (unsigned j = 0; j < 16; ++j) { const unsigned c = xb_ld(&bar[XB_XCNT(j)]); sum += c; cnt += (c > 0u) ? 1u : 0u; mine = (j == x) ? c : mine; }
        if (sum == G) break;
        __builtin_amdgcn_s_sleep(1);
        if ((++sp & 255u) == 0u) { if (xb_ld(&bar[XB_TMO])) break; if (sp > XB_SPIN_CAP) { atomicAdd(&bar[XB_TMO], 1u); break; } }
    }
    nloc = mine > 0u ? mine : 1u; nx = cnt > 0u ? cnt : 1u;
}

__device__ __forceinline__ void xcd_barrier(const XcdBarrier& b) {
    asm volatile("s_waitcnt vmcnt(0)" ::: "memory");
    __syncthreads();
    if (threadIdx.x == 0) {
        unsigned* bar = b.bar;
        __builtin_amdgcn_s_waitcnt(0);
        unsigned nloc = b.st[0], nx = b.st[1];
        if (nloc == 0u) { xcd_barrier_complete(bar, b.x, nloc, nx); b.st[0] = nloc; b.st[1] = nx; }
        const unsigned old = xb_add(&bar[XB_XSUB(b.x)], 1u);
        const unsigned gen = old / nloc;
        if (old + 1u == (gen + 1u) * nloc) {
            __builtin_amdgcn_fence(__ATOMIC_RELEASE, "agent");
            asm volatile("s_waitcnt vmcnt(0)" ::: "memory");
            const unsigned og = xb_add(&bar[XB_TOP], 1u);
            const unsigned tg = og / nx;
            if (og + 1u == (tg + 1u) * nx) xb_add(&bar[XB_TOPGEN], 1u);
            else XB_SPIN(xb_ld(&bar[XB_TOPGEN]) == tg, bar);
            __builtin_amdgcn_fence(__ATOMIC_ACQUIRE, "agent");
            xb_add(&bar[XB_XGEN(b.x)], 1u);
            asm volatile("s_waitcnt vmcnt(0)" ::: "memory");
        } else {
            XB_SPIN(xb_ld(&bar[XB_XGEN(b.x)]) == gen, bar);
            __builtin_amdgcn_fence(__ATOMIC_ACQUIRE, "agent");
            asm volatile("s_waitcnt vmcnt(0)" ::: "memory");
        }
    }
    __syncthreads();
}

constexpr int NWAVES = 8, NTHR = 512;
constexpr int BATCH = 2, T = 16384, D = 2048, FF = 5632, M = BATCH * T;
constexpr int ZN = 5120;
constexpr int ZA = 1536;
constexpr int A_COLS = 3360, E_IN = 4896;
constexpr int ZO = 4096;
constexpr int NSUB = 12;
#ifndef MK_ONE_LAUNCH
#define MK_ONE_LAUNCH 0
#endif

constexpr size_t MiB = 1u << 20;
constexpr size_t WS_CTL = 0, CTL_ZERO_BYTES = 1 * MiB;
constexpr size_t WS_SS = 1 * MiB;
constexpr size_t SS_REC = 8 * (size_t)M;
constexpr size_t WS_WT = 16 * MiB;
constexpr size_t WT_GU1 = WS_WT, WT_D1 = WT_GU1 + 44 * MiB, WT_GU2 = WT_D1 + 22 * MiB, WT_D2 = WT_GU2 + 44 * MiB, WT_IN = WT_D2 + 22 * MiB, WT_OUT = WT_IN + 20 * MiB;
constexpr size_t WS_XB = WT_OUT + 8 * MiB;
constexpr size_t WS_ACT = WS_XB + 128 * MiB;
constexpr size_t WS_SC = WS_ACT + 352 * MiB;
constexpr size_t SC_R = WS_SC, SC_K2 = SC_R + 64 * MiB, SC_KK = SC_K2 + 64 * MiB, SC_BB = SC_KK + 64 * MiB, SC_LW = SC_BB + 64 * MiB, SC_GG = SC_LW + 64 * MiB;
constexpr size_t WS_VF = SC_GG + 64 * MiB;
constexpr size_t WS_V2 = WS_VF + 64 * MiB;
constexpr size_t WS_O = WS_V2 + 64 * MiB;
constexpr size_t WS_SM = WS_O + 128 * MiB;
constexpr size_t SM_W2T = WS_SM, SM_A2T = SM_W2T + 131072, SM_G2T = SM_A2T + 131072, SM_V1T = SM_G2T + 327680, SM_V2T = SM_V1T + 65536, SM_WSB = SM_V2T + 65536;
constexpr size_t WS_U0 = WS_SM + 2 * MiB;
constexpr size_t WS_END = WS_U0 + 64 * MiB;
static_assert(SM_WSB + 524288 <= WS_END, "small-weight map");
static_assert(WT_OUT + 8 * MiB == 176 * MiB && WS_SS + 15 * MiB <= WS_WT, "weight map");
constexpr int CW_TMO = 0, CW_CODE = 1, CW_BAR = 4096;

constexpr int LDS_BYTES = 147456, LDSCTL_OFF = LDS_BYTES - 512;

#define GAS __attribute__((address_space(1)))
#define LAS __attribute__((address_space(3)))
typedef unsigned short bf16;
typedef unsigned v4u __attribute__((ext_vector_type(4)));
typedef unsigned v2u __attribute__((ext_vector_type(2)));
typedef float f32x4 __attribute__((ext_vector_type(4)));
typedef float f32x2 __attribute__((ext_vector_type(2)));
typedef GAS unsigned gu32;
#define RLX_AGENT __ATOMIC_RELAXED, __HIP_MEMORY_SCOPE_AGENT
#define LDS_WAIT() asm volatile("s_waitcnt lgkmcnt(0)" ::: "memory")
typedef __bf16 bf16x2_hw __attribute__((ext_vector_type(2)));
__device__ __forceinline__ unsigned pk2(float lo, float hi) { const bf16x2_hw b = __builtin_convertvector((f32x2){lo, hi}, bf16x2_hw); return __builtin_bit_cast(unsigned, b); }
__device__ __forceinline__ unsigned f2bf(float f) { return pk2(f, f) & 0xffffu; }
__device__ __forceinline__ float bf2f(bf16 b) { return __builtin_bit_cast(float, (unsigned)b << 16); }
__device__ __forceinline__ float bflo(unsigned w) { return __builtin_bit_cast(float, w << 16); }
__device__ __forceinline__ float bfhi(unsigned w) { return __builtin_bit_cast(float, w & 0xffff0000u); }
__device__ __forceinline__ float wave_sum(float v) {
#pragma unroll
    for (int o = 1; o < 64; o <<= 1) v += __shfl_xor(v, o);
    return v;
}
template <int CTRL> __device__ __forceinline__ float dpp_mov(float v) { return __builtin_bit_cast(float, __builtin_amdgcn_update_dpp(0, __builtin_bit_cast(int, v), CTRL, 0xf, 0xf, true)); }
__device__ __forceinline__ float row16_sum(float v) { v += dpp_mov<0xB1>(v); v += dpp_mov<0x4E>(v); v += dpp_mov<0x141>(v); v += dpp_mov<0x140>(v); return v; }
__device__ __forceinline__ float sigmoidf_(float x) { return 1.0f / (1.0f + __expf(-x)); }

__device__ __forceinline__ int opaque(int v) { asm volatile("" : "+v"(v)); return v; }
struct Args { const float* in[29]; float* out; unsigned char* ws; int ph_lo, ph_hi; };
static_assert(sizeof(Args) == 29 * 8 + 8 + 8 + 8, "Args has no padding");
enum { I_X = 0, I_NG, I_WG, I_WU, I_WD, I_EWIN, I_EBQKV, I_EMU, I_EW0, I_EW2, I_EA0, I_EA2, I_EG2, I_EKK, I_EKA, I_ERK, I_EGNG, I_EGNB, I_ESINK, I_EWOUT, I_V0, I_V1, I_V2, I_OWIN, I_OVNG, I_OWS, I_OBS, I_OWOUT, I_FG };

struct TrDesc { const float* W; const float* gk; bf16* WT; int ldw, k0, c0, K, drow0; bool zero; };
__device__ __forceinline__ void tr_load(const TrDesc& d, float (&v)[32], int lane) {
#pragma unroll
    for (int i = 0; i < 32; ++i) { const int kk = 2 * i + (lane >> 5); v[i] = d.zero ? 0.f : d.W[(size_t)(d.k0 + kk) * d.ldw + d.c0 + (lane & 31)]; }
}
__device__ __forceinline__ void tr_store(const TrDesc& d, const float (&v)[32], LAS float* scr, int lane) {
#pragma unroll
    for (int i = 0; i < 32; ++i) { const int kk = 2 * i + (lane >> 5); float x = v[i]; if (d.gk) x *= d.gk[d.k0 + kk]; scr[kk * 33 + (lane & 31)] = x; }
    LDS_WAIT(); asm volatile("" ::: "memory");
    const int c = lane & 7;
#pragma unroll
    for (int j = 0; j < 4; ++j) { const int n = (lane >> 3) + 8 * j; const LAS float* s = scr + (8 * c) * 33 + n;
        v4u o; o.x = pk2(s[0 * 33], s[1 * 33]); o.y = pk2(s[2 * 33], s[3 * 33]); o.z = pk2(s[4 * 33], s[5 * 33]); o.w = pk2(s[6 * 33], s[7 * 33]);
        *(GAS v4u*)(d.WT + (size_t)(d.drow0 + n) * d.K + d.k0 + 8 * c) = o; }
    LDS_WAIT(); asm volatile("" ::: "memory");
}
__device__ __forceinline__ TrDesc tr_desc(const Args& a, int L, int it) {
    unsigned char* ws = a.ws; const bool even = !(L & 1); const int li = L >> 1;
    constexpr int nGU = 32 * 352, nD = 88 * 64; const int nIN = 32 * (even ? 160 : 128);
    TrDesc d; d.zero = false; int r = it;
    if (r < 2 * nGU) { const int f = r / nGU; r -= f * nGU; const int kb = r / 352, rb = r % 352, tj = rb >> 3, sub = rb & 7;
        d.W = (sub < 4 ? a.in[I_WG] : a.in[I_WU]) + (size_t)(L * 2 + f) * D * FF; d.ldw = FF; d.k0 = 64 * kb; d.c0 = 128 * tj + 32 * (sub & 3); d.gk = a.in[I_NG] + (L * 3 + (f ? 2 : 0)) * D;
        d.WT = (bf16*)(ws + (f ? WT_GU2 : WT_GU1)); d.K = D; d.drow0 = 32 * rb; return d; }
    r -= 2 * nGU;
    if (r < 2 * nD) { const int f = r / nD; r -= f * nD; const int kb = r / 64, nb = r % 64;
        d.W = a.in[I_WD] + (size_t)(L * 2 + f) * FF * D; d.ldw = D; d.k0 = 64 * kb; d.c0 = 32 * nb; d.gk = nullptr; d.WT = (bf16*)(ws + (f ? WT_D2 : WT_D1)); d.K = FF; d.drow0 = 32 * nb; return d; }
    r -= 2 * nD;
    if (r < nIN) {
        d.gk = a.in[I_NG] + (L * 3 + 1) * D; d.WT = (bf16*)(ws + WT_IN); d.K = D;
        if (even) { const int kb = r / 160, rb = r % 160, dd = 32 * rb; d.zero = dd >= E_IN; d.W = a.in[I_EWIN] + (size_t)li * D * E_IN; d.ldw = E_IN; d.k0 = 64 * kb; d.c0 = d.zero ? 0 : (dd < ZA ? A_COLS + dd : dd - ZA); d.drow0 = dd; }
        else { const int kb = r / 128, rb = r % 128; d.W = a.in[I_OWIN] + (size_t)li * D * ZO; d.ldw = ZO; d.k0 = 64 * kb; d.c0 = 32 * rb; d.drow0 = 32 * rb; }
        return d; }
    r -= nIN;
    { const int kb = r / 64, nb = r % 64; d.W = (even ? a.in[I_EWOUT] : a.in[I_OWOUT]) + (size_t)li * D * D; d.ldw = D; d.k0 = 64 * kb; d.c0 = 32 * nb; d.gk = nullptr; d.WT = (bf16*)(ws + WT_OUT); d.K = D; d.drow0 = 32 * nb; }
    return d;
}
__device__ __forceinline__ void prep_phase(const Args& a, int L, LAS unsigned char* lds, int vcu, int G, int wave, int lane) {
    asm volatile("" : "+s"(G));
    LAS float* scr = (LAS float*)(lds + wave * 16384);
    const int gw = vcu * NWAVES + wave, NGW = G * NWAVES;
    unsigned char* ws = a.ws;
    const bool even = !(L & 1); const int li = L >> 1;
    const int total = 2 * (32 * 352) + 2 * (88 * 64) + 32 * (even ? 160 : 128) + 32 * 64;
    if (gw < total) {
        TrDesc d0 = tr_desc(a, L, gw); float v0[32]; tr_load(d0, v0, lane);
        for (int it = gw; it < total; it += NGW) {
            const int itn = it + NGW; const bool hasn = itn < total;
            TrDesc d1 = tr_desc(a, L, hasn ? itn : it); float v1[32];
            if (hasn) tr_load(d1, v1, lane);
            tr_store(d0, v0, scr, lane);
            d0 = d1;
#pragma unroll
            for (int i = 0; i < 32; ++i) v0[i] = v1[i];
        }
    }
    {
        const int gt = gw * 64 + lane, NGT = NGW * 64;
        if (even) {
            const float* w2 = a.in[I_EW2] + (size_t)li * 64 * 1024; const float* a2 = a.in[I_EA2] + (size_t)li * 64 * 1024; const float* g2 = a.in[I_EG2] + (size_t)li * 160 * 1024;
            bf16* W2T = (bf16*)(ws + SM_W2T); bf16* A2T = (bf16*)(ws + SM_A2T); bf16* G2T = (bf16*)(ws + SM_G2T);
            for (int e = gt; e < 1024 * 64; e += NGT) { const int k = e >> 10, c = e & 1023; W2T[c * 64 + k] = (bf16)f2bf(w2[e]); A2T[c * 64 + k] = (bf16)f2bf(a2[e]); }
            for (int e = gt; e < 1024 * 160; e += NGT) { const int k = e >> 10, c = e & 1023; G2T[c * 160 + k] = (bf16)f2bf(g2[e]); }
            if (li > 0) { bf16* V1T = (bf16*)(ws + SM_V1T); bf16* V2T = (bf16*)(ws + SM_V2T);
                for (int e = gt; e < 1024 * 32; e += NGT) { const int c = e >> 5, j = e & 31; V1T[j * 1024 + c] = (bf16)f2bf(a.in[I_V1][e]); }
                for (int e = gt; e < 32 * 1024; e += NGT) { const int j = e >> 10, c = e & 1023; V2T[c * 32 + j] = (bf16)f2bf(a.in[I_V2][e]); } }
        } else {
            const float* wsg = a.in[I_OWS] + (size_t)li * 16 * 128 * 128; bf16* WSB = (bf16*)(ws + SM_WSB);
            for (int e = gt; e < 16 * 128 * 128; e += NGT) { const int i = (e >> 7) & 127, j = e & 127; WSB[e] = (bf16)f2bf(j <= i ? wsg[e] : 0.f); }
        }
    }
    if (L == 0) {
        float* ss0 = (float*)(ws + WS_SS); bf16* XB = (bf16*)(ws + WS_XB);
        for (int m = gw; m < M; m += NGW) {
            const GAS f32x4* xr = (const GAS f32x4*)(a.in[I_X] + (size_t)m * D) + lane; GAS v2u* o = (GAS v2u*)(XB + (size_t)m * D) + lane; float s = 0.f;
#pragma unroll
            for (int j = 0; j < 8; ++j) { const f32x4 v = xr[64 * j]; s += (v.x * v.x + v.y * v.y) + (v.z * v.z + v.w * v.w); v2u w; w.x = pk2(v.x, v.y); w.y = pk2(v.z, v.w); o[64 * j] = w; }
            s = wave_sum(s); if (lane < 8) ss0[(size_t)lane * M + m] = lane ? 0.f : s;
        }
    }
}

typedef short bf16x8_t __attribute__((ext_vector_type(8)));
__device__ __forceinline__ float fast_tanh(float x) { const float e = __expf(2.0f * x); return 1.0f - 2.0f / (1.0f + e); }
__device__ __forceinline__ void lerp8(const v4u c, const v4u p, const float* mu, float (&o)[8]) {
    const f32x4 m0 = *(const f32x4*)mu, m1 = *(const f32x4*)(mu + 4);
    const float c0 = bflo(c.x), c1 = bfhi(c.x), c2 = bflo(c.y), c3 = bfhi(c.y), c4 = bflo(c.z), c5 = bfhi(c.z), c6 = bflo(c.w), c7 = bfhi(c.w);
    o[0] = c0 + (bflo(p.x) - c0) * m0.x; o[1] = c1 + (bfhi(p.x) - c1) * m0.y; o[2] = c2 + (bflo(p.y) - c2) * m0.z; o[3] = c3 + (bfhi(p.y) - c3) * m0.w;
    o[4] = c4 + (bflo(p.z) - c4) * m1.x; o[5] = c5 + (bfhi(p.z) - c5) * m1.y; o[6] = c6 + (bflo(p.w) - c6) * m1.z; o[7] = c7 + (bfhi(p.w) - c7) * m1.w;
}
__device__ __forceinline__ void lerp4(const v2u c, const v2u p, const f32x4 m, float (&o)[4]) {
    const float c0 = bflo(c.x), c1 = bfhi(c.x), c2 = bflo(c.y), c3 = bfhi(c.y);
    o[0] = c0 + (bflo(p.x) - c0) * m.x; o[1] = c1 + (bfhi(p.x) - c1) * m.y; o[2] = c2 + (bflo(p.y) - c2) * m.z; o[3] = c3 + (bfhi(p.y) - c3) * m.w;
}
__device__ __forceinline__ v2u pack4(float a, float b, float c, float d) { v2u w; w.x = pk2(a, b); w.y = pk2(c, d); return w; }
constexpr int E1_AW = 0, E1_AA = 9216, E1_AG = 18432, E1_PP = 40960, E1_PB = 106496;
__device__ __forceinline__ void e1_phase(const Args& a, int li, LAS unsigned char* ldsb, int vcu, int G, int tid) {
    unsigned char* ws = a.ws;
    const bf16* Z = (const bf16*)(ws + WS_ACT);
    bf16* R = (bf16*)(ws + SC_R); bf16* K2 = (bf16*)(ws + SC_K2); bf16* KK = (bf16*)(ws + SC_KK); bf16* BB = (bf16*)(ws + SC_BB); bf16* LW = (bf16*)(ws + SC_LW); bf16* GG = (bf16*)(ws + SC_GG);
    bf16* VO = (bf16*)(ws + (li ? WS_V2 : WS_VF)); const bf16* VF = (const bf16*)(ws + WS_VF);
    const bf16* W2T = (const bf16*)(ws + SM_W2T); const bf16* A2T = (const bf16*)(ws + SM_A2T); const bf16* G2T = (const bf16*)(ws + SM_G2T);
    const bf16* V1T = (const bf16*)(ws + SM_V1T); const bf16* V2T = (const bf16*)(ws + SM_V2T);
    const float* mu = a.in[I_EMU] + li * A_COLS;
    const float* w0 = a.in[I_EW0] + li * 1024; const float* a0 = a.in[I_EA0] + li * 1024;
    const float* kkw = a.in[I_EKK] + li * 1024; const float* kaw = a.in[I_EKA] + li * 1024; const float* v0w = a.in[I_V0];
    const int lane = tid & 63, wave = tid >> 6, fr = lane & 15, fq = lane >> 4;
    for (int unit = vcu; unit < M / 64; unit += G) {
        const int m0 = unit * 64;
        for (int e = tid; e < 64 * 36; e += NTHR) { const int r = e / 36, ch = e % 36, j0 = 8 * ch, m = m0 + r; const bool first = (m & (T - 1)) == 0;
            const v4u cur = *(const GAS v4u*)(Z + (size_t)m * ZN + ZA + 3072 + j0); v4u prv = {0u, 0u, 0u, 0u}; if (!first) prv = *(const GAS v4u*)(Z + (size_t)(m - 1) * ZN + ZA + 3072 + j0);
            float x[8]; lerp8(cur, prv, mu + 3072 + j0, x);
            if (j0 < 64) {
#pragma unroll
                for (int i = 0; i < 8; ++i) x[i] = fast_tanh(x[i]);
            } else if (j0 >= 128) {
#pragma unroll
                for (int i = 0; i < 8; ++i) x[i] = sigmoidf_(x[i]);
            }
            v4u o; o.x = pk2(x[0], x[1]); o.y = pk2(x[2], x[3]); o.z = pk2(x[4], x[5]); o.w = pk2(x[6], x[7]);
            LAS unsigned char* dst = j0 < 64 ? ldsb + E1_AW + r * 144 + j0 * 2 : j0 < 128 ? ldsb + E1_AA + r * 144 + (j0 - 64) * 2 : ldsb + E1_AG + r * 336 + (j0 - 128) * 2;
            *(LAS v4u*)dst = o; }
        if (li > 0) {
            f32x4 pacc[4][2];
#pragma unroll
            for (int mt = 0; mt < 4; ++mt) { pacc[mt][0] = (f32x4){0.f, 0.f, 0.f, 0.f}; pacc[mt][1] = pacc[mt][0]; }
            for (int ks = 0; ks < 4; ++ks) { const int c = 128 * wave + 32 * ks + 8 * fq;
                const bf16x8_t w0f = *(const GAS bf16x8_t*)(V1T + (size_t)fr * 1024 + c), w1f = *(const GAS bf16x8_t*)(V1T + (size_t)(16 + fr) * 1024 + c);
#pragma unroll
                for (int mt = 0; mt < 4; ++mt) { const int m = m0 + 16 * mt + fr; const bool first = (m & (T - 1)) == 0;
                    const v4u cur = *(const GAS v4u*)(Z + (size_t)m * ZN + ZA + 2048 + c); v4u prv = {0u, 0u, 0u, 0u}; if (!first) prv = *(const GAS v4u*)(Z + (size_t)(m - 1) * ZN + ZA + 2048 + c);
                    float x[8]; lerp8(cur, prv, mu + 2048 + c, x);
                    v4u o; o.x = pk2(x[0], x[1]); o.y = pk2(x[2], x[3]); o.z = pk2(x[4], x[5]); o.w = pk2(x[6], x[7]);
                    const bf16x8_t af = __builtin_bit_cast(bf16x8_t, o);
                    pacc[mt][0] = __builtin_amdgcn_mfma_f32_16x16x32_bf16(w0f, af, pacc[mt][0], 0, 0, 0); pacc[mt][1] = __builtin_amdgcn_mfma_f32_16x16x32_bf16(w1f, af, pacc[mt][1], 0, 0, 0); } }
#pragma unroll
            for (int mt = 0; mt < 4; ++mt)
#pragma unroll
                for (int nt = 0; nt < 2; ++nt) *(LAS f32x4*)(ldsb + E1_PP + ((wave * 64 + 16 * mt + fr) * 32 + 16 * nt + 4 * fq) * 4) = pacc[mt][nt];
        }
        __syncthreads();
        if (li > 0) {
            for (int e = tid; e < 64 * 32; e += NTHR) { float sum = 0.f;
#pragma unroll
                for (int w = 0; w < 8; ++w) sum += *(const LAS float*)(ldsb + E1_PP + (w * 2048 + e) * 4);
                *(LAS bf16*)(ldsb + E1_PB + (e >> 5) * 80 + (e & 31) * 2) = (bf16)f2bf(sum); }
            __syncthreads();
        }
#define E1_WROW(nt) (cb + 32 * ((nt) >> 1) + 8 * (fr >> 2) + 4 * ((nt) & 1) + (fr & 3))
#pragma unroll 1
        for (int hh = 0; hh < 2; ++hh) {
            const int cb = 128 * wave + 64 * hh;
            {
                bf16x8_t wa[4][2];
#pragma unroll
                for (int nt = 0; nt < 4; ++nt)
#pragma unroll
                    for (int ks = 0; ks < 2; ++ks) wa[nt][ks] = *(const GAS bf16x8_t*)(A2T + (size_t)E1_WROW(nt) * 64 + 32 * ks + 8 * fq);
#pragma unroll 1
                for (int mt = 0; mt < 4; ++mt) {
                    const int m = m0 + 16 * mt + fr; const bool first = (m & (T - 1)) == 0;
                    f32x4 aa[4];
#pragma unroll
                    for (int nt = 0; nt < 4; ++nt) aa[nt] = (f32x4){0.f, 0.f, 0.f, 0.f};
#pragma unroll
                    for (int ks = 0; ks < 2; ++ks) { const bf16x8_t fa = *(const LAS bf16x8_t*)(ldsb + E1_AA + (16 * mt + fr) * 144 + (32 * ks + 8 * fq) * 2);
#pragma unroll
                        for (int nt = 0; nt < 4; ++nt) aa[nt] = __builtin_amdgcn_mfma_f32_16x16x32_bf16(wa[nt][ks], fa, aa[nt], 0, 0, 0); }
                    const size_t zo = (size_t)m * ZN + ZA + cb + 8 * fq;
                    float k1[2][8], av[2][8], kk0[2][8]; float n2 = 0.f;
#pragma unroll
                    for (int p = 0; p < 2; ++p) { const int c = cb + 32 * p + 8 * fq;
                        const v4u cur = *(const GAS v4u*)(Z + zo + 1024 + 32 * p); v4u prv = {0u, 0u, 0u, 0u}; if (!first) prv = *(const GAS v4u*)(Z + zo - ZN + 1024 + 32 * p);
                        lerp8(cur, prv, mu + 1024 + c, k1[p]);
                        const f32x4 a00 = *(const f32x4*)(a0 + c), a01 = *(const f32x4*)(a0 + c + 4), kk00 = *(const f32x4*)(kkw + c), kk01 = *(const f32x4*)(kkw + c + 4);
#pragma unroll
                        for (int j = 0; j < 8; ++j) { const float a0j = j < 4 ? a00[j & 3] : a01[j & 3], kkj = j < 4 ? kk00[j & 3] : kk01[j & 3];
                            av[p][j] = sigmoidf_(a0j + aa[2 * p + (j >> 2)][j & 3]); kk0[p][j] = k1[p][j] * kkj; n2 += kk0[p][j] * kk0[p][j]; } }
                    n2 += __shfl_xor(n2, 16); n2 += __shfl_xor(n2, 32);
                    const float inv = 1.0f / fmaxf(sqrtf(n2), 1e-12f);
#pragma unroll
                    for (int p = 0; p < 2; ++p) { const int c = cb + 32 * p + 8 * fq; const size_t o = (size_t)m * 1024 + c; const f32x4 ka0 = *(const f32x4*)(kaw + c), ka1 = *(const f32x4*)(kaw + c + 4);
                        float kk[8], k2[8], bb[8];
#pragma unroll
                        for (int j = 0; j < 8; ++j) { const float kaj = j < 4 ? ka0[j & 3] : ka1[j & 3]; kk[j] = kk0[p][j] * inv; k2[j] = k1[p][j] * (1.0f + (av[p][j] - 1.0f) * kaj); bb[j] = kk[j] * av[p][j]; }
                        *(GAS v4u*)(KK + o) = (v4u){pk2(kk[0], kk[1]), pk2(kk[2], kk[3]), pk2(kk[4], kk[5]), pk2(kk[6], kk[7])};
                        *(GAS v4u*)(K2 + o) = (v4u){pk2(k2[0], k2[1]), pk2(k2[2], k2[3]), pk2(k2[4], k2[5]), pk2(k2[6], k2[7])};
                        *(GAS v4u*)(BB + o) = (v4u){pk2(bb[0], bb[1]), pk2(bb[2], bb[3]), pk2(bb[4], bb[5]), pk2(bb[6], bb[7])}; }
                }
            }
            {
                bf16x8_t ww[4][2];
#pragma unroll
                for (int nt = 0; nt < 4; ++nt)
#pragma unroll
                    for (int ks = 0; ks < 2; ++ks) ww[nt][ks] = *(const GAS bf16x8_t*)(W2T + (size_t)E1_WROW(nt) * 64 + 32 * ks + 8 * fq);
#pragma unroll 1
                for (int mt = 0; mt < 4; ++mt) {
                    const int m = m0 + 16 * mt + fr;
                    f32x4 aw[4];
#pragma unroll
                    for (int nt = 0; nt < 4; ++nt) aw[nt] = (f32x4){0.f, 0.f, 0.f, 0.f};
#pragma unroll
                    for (int ks = 0; ks < 2; ++ks) { const bf16x8_t fw = *(const LAS bf16x8_t*)(ldsb + E1_AW + (16 * mt + fr) * 144 + (32 * ks + 8 * fq) * 2);
#pragma unroll
                        for (int nt = 0; nt < 4; ++nt) aw[nt] = __builtin_amdgcn_mfma_f32_16x16x32_bf16(ww[nt][ks], fw, aw[nt], 0, 0, 0); }
#pragma unroll
                    for (int p = 0; p < 2; ++p) { const int c = cb + 32 * p + 8 * fq; const f32x4 w00 = *(const f32x4*)(w0 + c), w01 = *(const f32x4*)(w0 + c + 4); float lw[8];
#pragma unroll
                        for (int j = 0; j < 8; ++j) { const float y = -((j < 4 ? w00[j & 3] : w01[j & 3]) + aw[2 * p + (j >> 2)][j & 3]); const float sp = fmaxf(y, 0.f) + __logf(1.0f + __expf(-fabsf(y))); lw[j] = -__expf(-sp - 0.5f); }
                        *(GAS v4u*)(LW + (size_t)m * 1024 + c) = (v4u){pk2(lw[0], lw[1]), pk2(lw[2], lw[3]), pk2(lw[4], lw[5]), pk2(lw[6], lw[7])}; }
                }
            }
            {
                bf16x8_t wg[4][5];
#pragma unroll
                for (int nt = 0; nt < 4; ++nt)
#pragma unroll
                    for (int ks = 0; ks < 5; ++ks) wg[nt][ks] = *(const GAS bf16x8_t*)(G2T + (size_t)E1_WROW(nt) * 160 + 32 * ks + 8 * fq);
#pragma unroll 1
                for (int mt = 0; mt < 4; ++mt) {
                    const int m = m0 + 16 * mt + fr;
                    f32x4 ag[4];
#pragma unroll
                    for (int nt = 0; nt < 4; ++nt) ag[nt] = (f32x4){0.f, 0.f, 0.f, 0.f};
#pragma unroll
                    for (int ks = 0; ks < 5; ++ks) { const bf16x8_t fg = *(const LAS bf16x8_t*)(ldsb + E1_AG + (16 * mt + fr) * 336 + (32 * ks + 8 * fq) * 2);
#pragma unroll
                        for (int nt = 0; nt < 4; ++nt) ag[nt] = __builtin_amdgcn_mfma_f32_16x16x32_bf16(wg[nt][ks], fg, ag[nt], 0, 0, 0); }
#pragma unroll
                    for (int p = 0; p < 2; ++p) *(GAS v4u*)(GG + (size_t)m * 1024 + cb + 32 * p + 8 * fq) = (v4u){pk2(ag[2 * p][0], ag[2 * p][1]), pk2(ag[2 * p][2], ag[2 * p][3]), pk2(ag[2 * p + 1][0], ag[2 * p + 1][1]), pk2(ag[2 * p + 1][2], ag[2 * p + 1][3])};
                }
            }
            {
                bf16x8_t wv2[4];
#pragma unroll
                for (int nt = 0; nt < 4; ++nt) { wv2[nt] = (bf16x8_t){0, 0, 0, 0, 0, 0, 0, 0}; if (li > 0) wv2[nt] = *(const GAS bf16x8_t*)(V2T + (size_t)E1_WROW(nt) * 32 + 8 * fq); }
#pragma unroll 1
                for (int mt = 0; mt < 4; ++mt) {
                    const int m = m0 + 16 * mt + fr; const bool first = (m & (T - 1)) == 0;
                    f32x4 avr[4];
#pragma unroll
                    for (int nt = 0; nt < 4; ++nt) avr[nt] = (f32x4){0.f, 0.f, 0.f, 0.f};
                    if (li > 0) { const bf16x8_t fp = *(const LAS bf16x8_t*)(ldsb + E1_PB + (16 * mt + fr) * 80 + (8 * fq) * 2);
#pragma unroll
                        for (int nt = 0; nt < 4; ++nt) avr[nt] = __builtin_amdgcn_mfma_f32_16x16x32_bf16(wv2[nt], fp, avr[nt], 0, 0, 0); }
                    const size_t zo = (size_t)m * ZN + ZA + cb + 8 * fq;
#pragma unroll
                    for (int p = 0; p < 2; ++p) { const int c = cb + 32 * p + 8 * fq; const size_t o = (size_t)m * 1024 + c;
                        const v4u rc = *(const GAS v4u*)(Z + zo + 32 * p), vc = *(const GAS v4u*)(Z + zo + 2048 + 32 * p); v4u rp = {0u, 0u, 0u, 0u}, vp = {0u, 0u, 0u, 0u};
                        if (!first) { rp = *(const GAS v4u*)(Z + zo - ZN + 32 * p); vp = *(const GAS v4u*)(Z + zo - ZN + 2048 + 32 * p); }
                        float rr[8], vv[8]; lerp8(rc, rp, mu + c, rr); lerp8(vc, vp, mu + 2048 + c, vv);
                        if (li > 0) { const f32x4 v00 = *(const f32x4*)(v0w + c), v01 = *(const f32x4*)(v0w + c + 4); const v4u vf = *(const GAS v4u*)(VF + o);
                            const float f[8] = {bflo(vf.x), bfhi(vf.x), bflo(vf.y), bfhi(vf.y), bflo(vf.z), bfhi(vf.z), bflo(vf.w), bfhi(vf.w)};
#pragma unroll
                            for (int j = 0; j < 8; ++j) vv[j] += (f[j] - vv[j]) * sigmoidf_((j < 4 ? v00[j & 3] : v01[j & 3]) + avr[2 * p + (j >> 2)][j & 3]); }
                        *(GAS v4u*)(R + o) = (v4u){pk2(rr[0], rr[1]), pk2(rr[2], rr[3]), pk2(rr[4], rr[5]), pk2(rr[6], rr[7])};
                        *(GAS v4u*)(VO + o) = (v4u){pk2(vv[0], vv[1]), pk2(vv[2], vv[3]), pk2(vv[4], vv[5]), pk2(vv[6], vv[7])}; }
                }
            }
        }
#undef E1_WROW
        __syncthreads();
    }
}

constexpr size_t CS_AR = WS_ACT, CS_BK = WS_ACT + 128 * MiB, CS_Y0 = WS_ACT + 256 * MiB, CS_GL = WS_ACT + 320 * MiB;
__device__ __forceinline__ int cs_perm(int k) { return (k & 32) + 8 * ((k >> 2) & 3) + 4 * ((k >> 4) & 1) + (k & 3); }
__device__ __forceinline__ f32x4 mm16_ll(const LAS float* A, const LAS float* B, f32x4 c, int fr, int fq) {
    const f32x4 a4 = *(const LAS f32x4*)(A + fr * 16 + 4 * fq);
#pragma unroll
    for (int s = 0; s < 4; ++s) c = __builtin_amdgcn_mfma_f32_16x16x4f32(a4[s], B[(4 * fq + s) * 16 + fr], c, 0, 0, 0);
    return c;
}
__device__ __forceinline__ f32x4 mm16_la(const LAS float* A, const f32x4 b, f32x4 c, int fr, int fq) {
    const f32x4 a4 = *(const LAS f32x4*)(A + fr * 16 + 4 * fq);
#pragma unroll
    for (int s = 0; s < 4; ++s) c = __builtin_amdgcn_mfma_f32_16x16x4f32(a4[s], b[s], c, 0, 0, 0);
    return c;
}
__device__ __forceinline__ void st16(LAS float* Mx, const f32x4 c, int fr, int fq) {
#pragma unroll
    for (int r = 0; r < 4; ++r) Mx[(4 * fq + r) * 16 + fr] = c[r];
}
__device__ __forceinline__ void scanpre_phase(const Args& a, int li, LAS unsigned char* ldsb, int vcu, int G, int tid) {
    unsigned char* ws = a.ws;
    const bf16* Rr = (const bf16*)(ws + SC_R); const bf16* K2 = (const bf16*)(ws + SC_K2); const bf16* KK = (const bf16*)(ws + SC_KK); const bf16* BB = (const bf16*)(ws + SC_BB); const bf16* LW = (const bf16*)(ws + SC_LW);
    const bf16* V = (const bf16*)(ws + (li ? WS_V2 : WS_VF));
    bf16* ARo = (bf16*)(ws + CS_AR); bf16* BKo = (bf16*)(ws + CS_BK); bf16* Y0o = (bf16*)(ws + CS_Y0); float* GLo = (float*)(ws + CS_GL); bf16* U0o = (bf16*)(ws + WS_U0);
    const int lane = tid & 63, wave = tid >> 6, fr = lane & 15, fq = lane >> 4;
    LAS unsigned char* wl = ldsb + wave * 17408;
    LAS bf16* LAR = (LAS bf16*)wl; LAS bf16* LBK = (LAS bf16*)(wl + 4608); LAS float* LM = (LAS float*)(wl + 9216); LAS float* LX = (LAS float*)(wl + 13312);
    const LAS float* Mab = LM, *Mak = LM + 256, *Mrb = LM + 512, *Mrk = LM + 768;
    LAS float* Tm = LX, *Na = LX + 256, *Nb = LX + 512;
    for (int ch = vcu * NWAVES + wave; ch < 32 * 1024; ch += G * NWAVES) {
        const int bh = ch >> 10, ci = ch & 1023, b = bh >> 4, h = bh & 15; const size_t row0 = (size_t)b * T + 16 * ci;
        f32x4 At[4], Rt[4], vv[4]; float glane;
#pragma unroll
        for (int nt = 0; nt < 4; ++nt) { f32x4 lw, kk, bb, k2, rr;
#pragma unroll
            for (int s = 0; s < 4; ++s) { const size_t o = (row0 + 4 * fq + s) * 1024 + h * 64 + 16 * nt + fr;
                lw[s] = bf2f(LW[o]); kk[s] = bf2f(KK[o]); bb[s] = bf2f(BB[o]); k2[s] = bf2f(K2[o]); rr[s] = bf2f(Rr[o]); vv[nt][s] = bf2f(V[o]); }
            f32x4 cum; cum[0] = lw[0]; cum[1] = cum[0] + lw[1]; cum[2] = cum[1] + lw[2]; cum[3] = cum[2] + lw[3];
            float x = cum[3]; { const float y = __shfl_up(x, 16); if (fq >= 1) x += y; } { const float y = __shfl_up(x, 32); if (fq >= 2) x += y; }
            const float excl = x - cum[3]; const float cl = __shfl(x, 48 + fr);
            bf16* bo = BKo + (size_t)ch * 2048 + (16 * nt + fr) * 32 + 8 * fq; f32x4 bh4, kh4;
#pragma unroll
            for (int s = 0; s < 4; ++s) { const float c = excl + cum[s]; const float g = __expf(c), gp = __expf(c - lw[s]), gi = __expf(-c), e = __expf(cl - c);
                At[nt][s] = -kk[s] * gp; Rt[nt][s] = rr[s] * g; bh4[s] = bb[s] * e; kh4[s] = k2[s] * e;
                const int t = 4 * fq + s, cc = 16 * nt + fr;
                LAR[t * 72 + cc] = (bf16)f2bf(At[nt][s]); LAR[(16 + t) * 72 + cc] = (bf16)f2bf(Rt[nt][s]); LBK[t * 72 + cc] = (bf16)f2bf(bb[s] * gi); LBK[(16 + t) * 72 + cc] = (bf16)f2bf(k2[s] * gi); }
            *(GAS v4u*)bo = (v4u){pk2(bh4[0], bh4[1]), pk2(bh4[2], bh4[3]), pk2(kh4[0], kh4[1]), pk2(kh4[2], kh4[3])};
            if (fq == 0) GLo[(size_t)ch * 64 + 16 * nt + fr] = __expf(cl);
            glane = cl; }
        (void)glane;
        LDS_WAIT(); asm volatile("" ::: "memory");
#pragma unroll
        for (int mt = 0; mt < 2; ++mt)
#pragma unroll
            for (int nt = 0; nt < 2; ++nt) { f32x4 m = {0.f, 0.f, 0.f, 0.f};
#pragma unroll
                for (int ks = 0; ks < 2; ++ks) { const bf16x8_t af = *(const LAS bf16x8_t*)(LAR + (16 * mt + fr) * 72 + 32 * ks + 8 * fq), bfr = *(const LAS bf16x8_t*)(LBK + (16 * nt + fr) * 72 + 32 * ks + 8 * fq);
                    m = __builtin_amdgcn_mfma_f32_16x16x32_bf16(af, bfr, m, 0, 0, 0); }
#pragma unroll
                for (int r = 0; r < 4; ++r) { const int t = 4 * fq + r; const bool keep = mt ? (fr <= t) : (fr < t); LM[((mt * 2 + nt) * 16 + t) * 16 + fr] = keep ? m[r] : 0.f; } }
        LDS_WAIT(); asm volatile("" ::: "memory");
        { const f32x4 z = {0.f, 0.f, 0.f, 0.f};
          f32x4 t1;
#pragma unroll
          for (int r = 0; r < 4; ++r) t1[r] = Mab[(4 * fq + r) * 16 + fr] + ((4 * fq + r) == fr ? 1.0f : 0.f);
          st16(Tm, t1, fr, fq);
          f32x4 n2 = mm16_ll(Mab, Mab, z, fr, fq); st16(Na, n2, fr, fq);
          LDS_WAIT(); asm volatile("" ::: "memory");
          f32x4 t2 = mm16_ll(Tm, Na, t1, fr, fq);
          f32x4 n4 = mm16_ll(Na, Na, z, fr, fq);
          LDS_WAIT(); asm volatile("" ::: "memory");
          st16(Tm, t2, fr, fq); st16(Nb, n4, fr, fq);
          LDS_WAIT(); asm volatile("" ::: "memory");
          f32x4 t3 = mm16_ll(Tm, Nb, t2, fr, fq);
          f32x4 n8 = mm16_ll(Nb, Nb, z, fr, fq);
          LDS_WAIT(); asm volatile("" ::: "memory");
          st16(Tm, t3, fr, fq); st16(Na, n8, fr, fq);
          LDS_WAIT(); asm volatile("" ::: "memory");
          f32x4 t4 = mm16_ll(Tm, Na, t3, fr, fq);
          LDS_WAIT(); asm volatile("" ::: "memory");
          st16(Tm, t4, fr, fq);
          LDS_WAIT(); asm volatile("" ::: "memory"); }
#pragma unroll
        for (int nt = 0; nt < 4; ++nt) { const f32x4 z = {0.f, 0.f, 0.f, 0.f};
            const f32x4 w1 = mm16_la(Mak, vv[nt], z, fr, fq);
            const f32x4 u0 = mm16_la(Tm, w1, z, fr, fq);
            const f32x4 ah = mm16_la(Tm, At[nt], z, fr, fq);
            const f32x4 rh = mm16_la(Mrb, ah, Rt[nt], fr, fq);
            f32x4 y0 = mm16_la(Mrb, u0, z, fr, fq); y0 = mm16_la(Mrk, vv[nt], y0, fr, fq);
            const int k = 16 * nt + fr; bf16* arp = ARo + (size_t)ch * 2048 + cs_perm(k);
#pragma unroll
            for (int s = 0; s < 4; ++s) { arp[(4 * fq + s) * 64] = (bf16)f2bf(ah[s]); arp[(16 + 4 * fq + s) * 64] = (bf16)f2bf(rh[s]); }
            *(GAS v2u*)(Y0o + (size_t)ch * 1024 + k * 16 + 4 * fq) = pack4(y0[0], y0[1], y0[2], y0[3]);
            *(GAS v2u*)(U0o + (size_t)ch * 1024 + k * 16 + 4 * fq) = pack4(u0[0], u0[1], u0[2], u0[3]); }
        LDS_WAIT(); asm volatile("" ::: "memory");
    }
}
constexpr int CQ_NS = 13, CQ_SLOT = 10240, CQ_FULL = CQ_NS * CQ_SLOT, CQ_DONE = CQ_FULL + 64, CQ_NL = 6;
#define CQ_GLDS(src, dst) __builtin_amdgcn_global_load_lds((const unsigned*)(src), (LAS unsigned*)(dst), 16, 0, 0)
__device__ __forceinline__ void scanseq_phase(const Args& a, int li, LAS unsigned char* ldsb, int vcu, int tid) {
    volatile LAS unsigned* FULL = (volatile LAS unsigned*)(ldsb + CQ_FULL); volatile LAS unsigned* DONE = (volatile LAS unsigned*)(ldsb + CQ_DONE);
    if (tid < 32) ((LAS unsigned*)(ldsb + CQ_FULL))[tid] = 0u;
    __syncthreads();
    const int wave = __builtin_amdgcn_readfirstlane(tid >> 6), lane = tid & 63;
    if (vcu < 128 && wave <= CQ_NL) {
        unsigned char* ws = a.ws;
        const int bh = vcu >> 2, vb = vcu & 3, b = bh >> 4, h = bh & 15; const size_t row0 = (size_t)b * T; const size_t ch0 = (size_t)bh * 1024;
        if (wave > 0) {
            const unsigned char* ARo = ws + CS_AR; const unsigned char* BKo = ws + CS_BK; const unsigned char* Y0o = ws + CS_Y0; const unsigned char* GLo = ws + CS_GL; const unsigned char* U0o = ws + WS_U0;
            const unsigned char* V = ws + (li ? WS_V2 : WS_VF);
            const unsigned oAR = (unsigned)((lane >> 3) * 128 + 16 * ((lane & 7) ^ ((lane >> 3) & 7)));
            unsigned oBK[4];
#pragma unroll
            for (int i = 0; i < 4; ++i) { const int k = 16 * i + (lane >> 2); oBK[i] = (unsigned)(k * 64 + 16 * ((lane & 3) ^ ((k >> 2) & 3))); }
            const unsigned oUY = (unsigned)((16 * vb + ((lane & 31) >> 1)) * 32 + 16 * (lane & 1));
            const size_t oV = ((size_t)(lane >> 1) * 1024 + h * 64 + 16 * vb) * 2 + 16 * (lane & 1);
            const unsigned oG = (unsigned)(16 * (lane & 15));
            int pub = wave - 1; unsigned spins = 0;
            for (int c = wave - 1; c < 1024; c += CQ_NL) {
                const int s = c % CQ_NS;
                if (c >= CQ_NS) { while ((int)DONE[0] < c - CQ_NS + 1) { __builtin_amdgcn_s_sleep(1); if (++spins > (1u << 24)) break; } }
                LAS unsigned char* sl = ldsb + s * CQ_SLOT; const size_t ch = ch0 + c;
                const unsigned char* ar = ARo + ch * 4096; const unsigned char* bk = BKo + ch * 4096;
#pragma unroll
                for (int i = 0; i < 4; ++i) CQ_GLDS(ar + i * 1024 + oAR, sl + i * 1024);
#pragma unroll
                for (int i = 0; i < 4; ++i) CQ_GLDS(bk + oBK[i], sl + 4096 + i * 1024);
                CQ_GLDS((lane < 32 ? U0o : Y0o) + ch * 2048 + oUY, sl + 8192);
                CQ_GLDS(lane < 32 ? V + (row0 + 16 * (size_t)c) * 2048 + oV : GLo + ch * 256 + oG, sl + 9216);
                asm volatile("s_waitcnt vmcnt(10)" ::: "memory");
                for (; pub <= c - CQ_NL; pub += CQ_NL) FULL[pub % CQ_NS] = (unsigned)(pub + 1);
            }
            asm volatile("s_waitcnt vmcnt(0)" ::: "memory");
            for (; pub < 1024; pub += CQ_NL) FULL[pub % CQ_NS] = (unsigned)(pub + 1);
        } else {
            float* Y = a.out;
            const int fr = lane & 15, fq = lane >> 4; const int colv = h * 64 + 16 * vb + fr;
            f32x4 St[4];
#pragma unroll
            for (int kt = 0; kt < 4; ++kt) St[kt] = (f32x4){0.f, 0.f, 0.f, 0.f};
            unsigned spins = 0;
            for (int c = 0; c < 1024; ++c) {
                const int s = c % CQ_NS; LAS unsigned char* sl = ldsb + s * CQ_SLOT;
                while (FULL[s] != (unsigned)(c + 1)) { if (++spins > (1u << 26)) break; }
                __builtin_amdgcn_fence(__ATOMIC_ACQUIRE, "workgroup");
                bf16x8_t ar[2][2], bk[4]; f32x4 gl[4];
#pragma unroll
                for (int mt = 0; mt < 2; ++mt)
#pragma unroll
                    for (int ks = 0; ks < 2; ++ks) { const int r = 16 * mt + fr; ar[mt][ks] = *(const LAS bf16x8_t*)(sl + r * 128 + 16 * ((4 * ks + fq) ^ (r & 7))); }
#pragma unroll
                for (int kt = 0; kt < 4; ++kt) { const int k = 16 * kt + fr; bk[kt] = *(const LAS bf16x8_t*)(sl + 4096 + k * 64 + 16 * (fq ^ ((k >> 2) & 3))); gl[kt] = *(const LAS f32x4*)(sl + 9728 + (16 * kt + 4 * fq) * 4); }
                const v2u u0 = *(const LAS v2u*)(sl + 8192 + fr * 32 + 8 * fq), y0 = *(const LAS v2u*)(sl + 8704 + fr * 32 + 8 * fq);
                unsigned vs[4];
#pragma unroll
                for (int j = 0; j < 4; ++j) vs[j] = *(const LAS unsigned short*)(sl + 9216 + (4 * fq + j) * 32 + 2 * fr);
                bf16x8_t sb[2];
#pragma unroll
                for (int ks = 0; ks < 2; ++ks) { v4u w; w.x = pk2(St[2 * ks][0], St[2 * ks][1]); w.y = pk2(St[2 * ks][2], St[2 * ks][3]); w.z = pk2(St[2 * ks + 1][0], St[2 * ks + 1][1]); w.w = pk2(St[2 * ks + 1][2], St[2 * ks + 1][3]); sb[ks] = __builtin_bit_cast(bf16x8_t, w); }
                f32x4 au = {0.f, 0.f, 0.f, 0.f}, ay = {0.f, 0.f, 0.f, 0.f};
#pragma unroll
                for (int ks = 0; ks < 2; ++ks) { au = __builtin_amdgcn_mfma_f32_16x16x32_bf16(ar[0][ks], sb[ks], au, 0, 0, 0); ay = __builtin_amdgcn_mfma_f32_16x16x32_bf16(ar[1][ks], sb[ks], ay, 0, 0, 0); }
                { const size_t yr = (row0 + 16 * (size_t)c + 4 * fq) * 1024 + colv;
                  Y[yr] = ay[0] + bflo(y0.x); Y[yr + 1024] = ay[1] + bfhi(y0.x); Y[yr + 2048] = ay[2] + bflo(y0.y); Y[yr + 3072] = ay[3] + bfhi(y0.y); }
                v4u uw; uw.x = pk2(au[0] + bflo(u0.x), au[1] + bfhi(u0.x)); uw.y = pk2(au[2] + bflo(u0.y), au[3] + bfhi(u0.y)); uw.z = vs[0] | (vs[1] << 16); uw.w = vs[2] | (vs[3] << 16);
                const bf16x8_t uv = __builtin_bit_cast(bf16x8_t, uw);
#pragma unroll
                for (int kt = 0; kt < 4; ++kt) St[kt] = __builtin_amdgcn_mfma_f32_16x16x32_bf16(bk[kt], uv, St[kt] * gl[kt], 0, 0, 0);
                asm volatile("s_waitcnt lgkmcnt(0)" ::: "memory");
                if (lane == 0) DONE[0] = (unsigned)(c + 1);
            }
        }
    }
    __syncthreads();
}

typedef float f32x16 __attribute__((ext_vector_type(16)));
constexpr int AT_K = 0, AT_V = 36864;
__device__ __forceinline__ bf16x8_t tr_frag(unsigned addr) {
    v2u lo, hi; asm volatile("ds_read_b64_tr_b16 %0, %2\n\tds_read_b64_tr_b16 %1, %2 offset:1536\n\ts_waitcnt lgkmcnt(0)" : "=&v"(lo), "=&v"(hi) : "v"(addr) : "memory");
    v4u w; w.x = lo.x; w.y = lo.y; w.z = hi.x; w.w = hi.y; return __builtin_bit_cast(bf16x8_t, w);
}
__device__ __forceinline__ void attn_unit(const Args& a, int li, int au, LAS unsigned char* ldsb, int tid) {
    unsigned char* ws = a.ws; const bf16* Z = (const bf16*)(ws + WS_ACT); bf16* O = (bf16*)(ws + WS_O);
    const int n = au & 127, kvh = (au >> 7) & 3, b = au >> 9;
    const size_t rblk = (size_t)b * T + (size_t)n * 128;
    for (int e = tid; e < 256 * 8 * 2; e += NTHR) { const int which = e >> 11, rem = e & 2047, j = rem >> 3, c8 = rem & 7; const bool valid = (n > 0) || (j >= 128);
        v4u w = {0u, 0u, 0u, 0u}; if (valid) w = *(const GAS v4u*)(Z + (rblk + j - 128) * ZN + 1024 + which * 256 + kvh * 64 + 8 * c8);
        *(LAS v4u*)(ldsb + (which ? AT_V + j * 192 : AT_K + j * 144) + c8 * 16) = w; }
    __syncthreads();
    const int lane = tid & 63, wave = tid >> 6, l31 = lane & 31, h = lane >> 5;
    const unsigned ldsbase = (unsigned)(size_t)ldsb;
#pragma unroll 1
    for (int it = 0; it < 2; ++it) {
        const int tt = 2 * wave + it, g = tt >> 2, qi = tt & 3, hq = kvh * 4 + g; const size_t qrow = rblk + 32 * qi + l31;
        bf16x8_t qf[4];
#pragma unroll
        for (int ks = 0; ks < 4; ++ks) qf[ks] = *(const GAS bf16x8_t*)(Z + qrow * ZN + hq * 64 + 16 * ks + 8 * h);
        f32x16 st[5];
#pragma unroll
        for (int kt = 0; kt < 5; ++kt) {
#pragma unroll
            for (int r = 0; r < 16; ++r) st[kt][r] = 0.f;
#pragma unroll
            for (int ks = 0; ks < 4; ++ks) { const bf16x8_t kf = *(const LAS bf16x8_t*)(ldsb + AT_K + (32 * (qi + kt) + l31) * 144 + (16 * ks + 8 * h) * 2);
                st[kt] = __builtin_amdgcn_mfma_f32_32x32x16_bf16(kf, qf[ks], st[kt], 0, 0, 0); } }
        const float slope = exp2f(-0.5f * (float)(hq + 1)); const float sink = a.in[I_ESINK][li * 16 + hq];
        float mx = sink;
#pragma unroll
        for (int kt = 0; kt < 5; ++kt)
#pragma unroll
            for (int r = 0; r < 16; ++r) { const int j = 32 * (qi + kt) + (r & 3) + 8 * (r >> 2) + 4 * h; const int dist = 32 * qi + l31 + 128 - j;
                const bool ok = (dist >= 0) && (dist < 128) && ((n > 0) || (j >= 128));
                const float s = ok ? st[kt][r] * 0.125f - slope * (float)dist : -INFINITY; st[kt][r] = s; mx = fmaxf(mx, s); }
        mx = fmaxf(mx, __shfl_xor(mx, 32));
        float l = 0.f;
#pragma unroll
        for (int kt = 0; kt < 5; ++kt)
#pragma unroll
            for (int r = 0; r < 16; ++r) { const float p = __expf(st[kt][r] - mx); st[kt][r] = p; l += p; }
        l += __shfl_xor(l, 32); l += __expf(sink - mx);
        f32x16 ot[2];
#pragma unroll
        for (int r = 0; r < 16; ++r) { ot[0][r] = 0.f; ot[1][r] = 0.f; }
#pragma unroll
        for (int kt = 0; kt < 5; ++kt)
#pragma unroll
            for (int s2 = 0; s2 < 2; ++s2) {
                v4u pw; pw.x = pk2(st[kt][8 * s2 + 0], st[kt][8 * s2 + 1]); pw.y = pk2(st[kt][8 * s2 + 2], st[kt][8 * s2 + 3]); pw.z = pk2(st[kt][8 * s2 + 4], st[kt][8 * s2 + 5]); pw.w = pk2(st[kt][8 * s2 + 6], st[kt][8 * s2 + 7]);
                const bf16x8_t pf = __builtin_bit_cast(bf16x8_t, pw);
#pragma unroll
                for (int db = 0; db < 2; ++db) {
                    const unsigned va = ldsbase + AT_V + (unsigned)(32 * (qi + kt) + 16 * s2 + 4 * h + ((lane & 15) >> 2)) * 192u + (unsigned)(32 * db + 16 * ((lane >> 4) & 1) + 4 * (lane & 3)) * 2u;
                    const bf16x8_t vf = tr_frag(va);
                    ot[db] = __builtin_amdgcn_mfma_f32_32x32x16_bf16(vf, pf, ot[db], 0, 0, 0); } }
        const float inv = 1.0f / l;
#pragma unroll
        for (int db = 0; db < 2; ++db)
#pragma unroll
            for (int g4 = 0; g4 < 4; ++g4)
                *(GAS v2u*)(O + qrow * D + 1024 + hq * 64 + 32 * db + 8 * g4 + 4 * h) = pack4(ot[db][4 * g4] * inv, ot[db][4 * g4 + 1] * inv, ot[db][4 * g4 + 2] * inv, ot[db][4 * g4 + 3] * inv);
    }
    __syncthreads();
}

__device__ __forceinline__ void e3_phase(const Args& a, int li, int vcu, int G, int tid) {
    unsigned char* ws = a.ws; const float* Y = a.out;
    const bf16* R = (const bf16*)(ws + SC_R); const bf16* K2 = (const bf16*)(ws + SC_K2); const bf16* GG = (const bf16*)(ws + SC_GG); const bf16* V = (const bf16*)(ws + (li ? WS_V2 : WS_VF));
    bf16* O = (bf16*)(ws + WS_O);
    const float* rk = a.in[I_ERK] + li * 1024; const float* gng = a.in[I_EGNG] + li * 1024; const float* gnb = a.in[I_EGNB] + li * 1024;
    for (size_t e4 = (size_t)vcu * NTHR + tid; e4 < (size_t)M * 256; e4 += (size_t)G * NTHR) {
        const size_t row = e4 >> 8; const int c = (int)(e4 & 255) * 4; const size_t e = row * 1024 + c;
        const f32x4 y = *(const GAS f32x4*)(Y + e);
        const v2u rw = *(const GAS v2u*)(R + e), kw = *(const GAS v2u*)(K2 + e), vw = *(const GAS v2u*)(V + e), gw = *(const GAS v2u*)(GG + e);
        const f32x4 rkv = *(const f32x4*)(rk + c), ggv = *(const f32x4*)(gng + c), gbv = *(const f32x4*)(gnb + c);
        const float mean = row16_sum((y.x + y.y) + (y.z + y.w)) * (1.0f / 64.0f);
        const f32x4 d = y - mean;
        const float var = row16_sum((d.x * d.x + d.y * d.y) + (d.z * d.z + d.w * d.w)) * (1.0f / 64.0f);
        const float rs = rsqrtf(var + 64e-5f);
        const float r0 = bflo(rw.x), r1 = bfhi(rw.x), r2 = bflo(rw.y), r3 = bfhi(rw.y), k0 = bflo(kw.x), k1 = bfhi(kw.x), k2 = bflo(kw.y), k3 = bfhi(kw.y);
        const float bonus = row16_sum((r0 * k0 * rkv.x + r1 * k1 * rkv.y) + (r2 * k2 * rkv.z + r3 * k3 * rkv.w));
        const float o0 = (d.x * rs * ggv.x + gbv.x + bonus * bflo(vw.x)) * bflo(gw.x), o1 = (d.y * rs * ggv.y + gbv.y + bonus * bfhi(vw.x)) * bfhi(gw.x);
        const float o2 = (d.z * rs * ggv.z + gbv.z + bonus * bflo(vw.y)) * bflo(gw.y), o3 = (d.w * rs * ggv.w + gbv.w + bonus * bfhi(vw.y)) * bfhi(gw.y);
        *(GAS v2u*)(O + row * D + c) = pack4(o0, o1, o2, o3);
    }
}

constexpr int SG_W = 0, SG_V = 34816;
__device__ __forceinline__ unsigned sg_off(unsigned row, unsigned ch) { return 256u * row + 16u * (ch ^ (((row & 3u) << 2) | ((row >> 2) & 3u))); }
__device__ __forceinline__ bf16x8_t tr_frag2(unsigned a0, unsigned a1) {
    v2u lo, hi; asm volatile("ds_read_b64_tr_b16 %0, %2\n\tds_read_b64_tr_b16 %1, %3\n\ts_waitcnt lgkmcnt(0)" : "=&v"(lo), "=&v"(hi) : "v"(a0), "v"(a1) : "memory");
    v4u w; w.x = lo.x; w.y = lo.y; w.z = hi.x; w.w = hi.y; return __builtin_bit_cast(bf16x8_t, w);
}
__device__ __forceinline__ void sgu_phase(const Args& a, int li, LAS unsigned char* ldsb, int vcu, int G, int tid) {
    unsigned char* ws = a.ws; const bf16* Z = (const bf16*)(ws + WS_ACT); bf16* O = (bf16*)(ws + WS_O);
    const float* ssv = (const float*)(ws + WS_SS) + (size_t)(13 + li) * SS_REC;
    const bf16* WSB = (const bf16*)(ws + SM_WSB); const float* bs = a.in[I_OBS] + li * 16 * 128; const float* vng = a.in[I_OVNG] + li * D;
    const int lane = tid & 63, wave = tid >> 6, fr = lane & 15, fq = lane >> 4;
    const unsigned ldsbase = (unsigned)(size_t)ldsb;
    int gcur = -1;
    for (int u = vcu; u < 4096; u += G) {
        const int g = u & 15, bn = u >> 4; const size_t m0 = (size_t)bn * 128;
        __syncthreads();
        if (g != gcur) { gcur = g;
            for (int e = tid; e < 128 * 16; e += NTHR) { const int i = e >> 4, ch = e & 15; *(LAS v4u*)(ldsb + SG_W + i * 272 + ch * 16) = *(const GAS v4u*)(WSB + ((size_t)g * 128 + i) * 128 + 8 * ch); } }
        for (int e = tid; e < 128 * 16; e += NTHR) { const int j = e >> 4, ch = e & 15; const float rs = pg8::row_rs(ssv, (int)(m0 + j));
            const v4u w = *(const GAS v4u*)(Z + (m0 + j) * ZO + 2048 + g * 128 + 8 * ch); v4u o;
            o.x = pk2(bflo(w.x) * rs, bfhi(w.x) * rs); o.y = pk2(bflo(w.y) * rs, bfhi(w.y) * rs); o.z = pk2(bflo(w.z) * rs, bfhi(w.z) * rs); o.w = pk2(bflo(w.w) * rs, bfhi(w.w) * rs);
            *(LAS v4u*)(ldsb + SG_V + sg_off((unsigned)j, (unsigned)ch)) = o; }
        __syncthreads();
        bf16x8_t vf[4];
        { const unsigned q = (unsigned)(lane & 15) >> 2, p = (unsigned)lane & 3u;
#pragma unroll
          for (int ks = 0; ks < 4; ++ks) { const unsigned r0 = 32u * ks + 8u * fq + q;
              vf[ks] = tr_frag2(ldsbase + SG_V + sg_off(r0, 2u * wave + (p >> 1)) + 8u * (p & 1u), ldsbase + SG_V + sg_off(r0 + 4u, 2u * wave + (p >> 1)) + 8u * (p & 1u)); } }
        const int cc = g * 128 + 16 * wave + 4 * fq; const f32x4 vg = *(const f32x4*)(vng + cc);
#pragma unroll
        for (int mt = 0; mt < 8; ++mt) {
            f32x4 acc = {0.f, 0.f, 0.f, 0.f};
#pragma unroll
            for (int ks = 0; ks <= (mt >> 1); ++ks) { const bf16x8_t wf = *(const LAS bf16x8_t*)(ldsb + SG_W + (16 * mt + fr) * 272 + (32 * ks + 8 * fq) * 2);
                acc = __builtin_amdgcn_mfma_f32_16x16x32_bf16(vf[ks], wf, acc, 0, 0, 0); }
            const int i = 16 * mt + fr; const float bi = bs[g * 128 + i];
            const v2u uw = *(const GAS v2u*)(Z + (m0 + i) * ZO + cc);
            *(GAS v2u*)(O + (m0 + i) * D + cc) = pack4(bflo(uw.x) * (vg.x * acc[0] + bi), bfhi(uw.x) * (vg.y * acc[1] + bi), bflo(uw.y) * (vg.z * acc[2] + bi), bfhi(uw.y) * (vg.w * acc[3] + bi));
        }
    }
    __syncthreads();
}

__device__ __forceinline__ void final_phase(const Args& a, int vcu, int G, int wave, int lane) {
    const int gw = vcu * NWAVES + wave, NGW = G * NWAVES; const float* ss = (const float*)(a.ws + WS_SS) + (size_t)12 * SS_REC; const float* fg = a.in[I_FG]; const bf16* XBp = (const bf16*)(a.ws + WS_XB);
    for (int m = gw; m < M; m += NGW) { const float rs = pg8::row_rs(ss, m);
        const GAS v4u* xr = (const GAS v4u*)(XBp + (size_t)m * D) + lane; GAS f32x4* orow = (GAS f32x4*)(a.out + (size_t)m * D) + 2 * lane; const GAS f32x4* gr = (const GAS f32x4*)fg + 2 * lane;
#pragma unroll
        for (int j = 0; j < 4; ++j) { const v4u w = xr[64 * j]; const f32x4 g0 = gr[128 * j], g1 = gr[128 * j + 1];
            orow[128 * j] = (f32x4){bflo(w.x) * rs * g0.x, bfhi(w.x) * rs * g0.y, bflo(w.y) * rs * g0.z, bfhi(w.y) * rs * g0.w};
            orow[128 * j + 1] = (f32x4){bflo(w.z) * rs * g1.x, bfhi(w.z) * rs * g1.y, bflo(w.w) * rs * g1.z, bfhi(w.w) * rs * g1.w}; } }
}

__global__ void __launch_bounds__(NTHR, 2) mk_fwd(Args args) {
    extern __shared__ __attribute__((aligned(16))) unsigned char lds_raw[];
    LAS unsigned char* lds = (LAS unsigned char*)lds_raw;
    const int tid = threadIdx.x, lane = tid & 63, wave = __builtin_amdgcn_readfirstlane(tid >> 6);
    const int G = gridDim.x, bx = blockIdx.x; const int vcu = (G % 8 == 0) ? (bx % 8) * (G / 8) + bx / 8 : bx;
    unsigned char* ws = args.ws; gu32* ctl = (gu32*)(ws + WS_CTL);
    for (int u = tid; u < (LDS_BYTES - LDSCTL_OFF) / 4; u += NTHR) ((LAS unsigned*)(lds + LDSCTL_OFF))[u] = 0u;
    __syncthreads();
    const int lo = args.ph_lo, hi = args.ph_hi;
    const bool multi = (hi - lo) > 1;
    XcdBarrier bar; bar.bar = (unsigned*)(ctl + CW_BAR); bar.x = 0; bar.st = nullptr;
    if (multi) bar = xcd_barrier_post((unsigned*)(ctl + CW_BAR), (volatile LAS unsigned*)(lds + LDSCTL_OFF));
#define IN(k) (lo <= (k) && (k) < hi)
#define SEAM(k) do { if ((k) + 1 < hi) xcd_barrier(bar); } while (0)
#ifndef DUP_G
#define DUP_G 1
#endif
#ifndef DUP_T
#define DUP_T 1
#endif
#ifndef DUP_GR
#define DUP_GR DUP_G
#endif
#ifndef DUP_G1
#define DUP_G1 DUP_G
#endif
#ifndef DUP_SP
#define DUP_SP DUP_S
#endif
#ifndef DUP_SQ
#define DUP_SQ DUP_S
#endif
#ifndef DUP_PREP
#define DUP_PREP DUP_T
#endif
#ifndef DUP_E1
#define DUP_E1 DUP_T
#endif
#ifndef DUP_SGU
#define DUP_SGU DUP_T
#endif
#ifndef DUP_E3
#define DUP_E3 DUP_T
#endif
#define REPN(n) for (int rep_ = 0; rep_ < (n); ++rep_)
#ifndef DUP_S
#define DUP_S 1
#endif
#define REPG for (int rep_ = 0; rep_ < DUP_G; ++rep_)
#define REPT for (int rep_ = 0; rep_ < DUP_T; ++rep_)
#define REPS for (int rep_ = 0; rep_ < DUP_S; ++rep_)
#define RSEAM(n) do { if (rep_ + 1 < (n)) xcd_barrier(bar); } while (0)
    float* ssb = (float*)(ws + WS_SS);
    bf16* XB = (bf16*)(ws + WS_XB); bf16* ACT = (bf16*)(ws + WS_ACT); bf16* OB = (bf16*)(ws + WS_O);

    for (int s = 0; s < NSUB; ++s) {
        const int pb = s * 8, L = s / 3, kind = s % 3, li = L >> 1; const bool even = !(L & 1);
        #ifndef NO_PREP
        if (kind == 0 && IN(pb + 0)) { REPN(DUP_PREP) { const int t_ = opaque(tid); prep_phase(args, L, lds, vcu, G, __builtin_amdgcn_readfirstlane(t_ >> 6), t_ & 63); RSEAM(DUP_PREP); } SEAM(pb + 0); }
#endif
        if (IN(pb + 1)) {
            const float* ss = ssb + (size_t)s * SS_REC;
            LAS float* RC = (LAS float*)(lds + 135168);
            if (tid == 0) *(LAS int*)(RC + 256) = -1;
            __syncthreads();
            if (kind != 1) {
                pg8::Gemm g{XB, (const bf16*)(ws + (kind == 0 ? WT_GU1 : WT_GU2)), M, 2 * FF, D}; pg8::StaticOrder S; S.init(M, 2 * FF, G, bx);
                pg8::EpiSwiGLU E{ACT, FF, ss, RC};
#ifndef NO_G1
                REPN(DUP_G1) { pg8::gemm_phase<pg8::EpiSwiGLU, pg8::StaticOrder, true, true>(lds, g, S, E); RSEAM(DUP_G1); }
#endif
            } else if (even) {
                pg8::Gemm g{XB, (const bf16*)(ws + WT_IN), M, ZN, D}; pg8::StaticOrder S; S.init(M, ZN, G, bx);
                pg8::EpiZ E{ACT, ZN, ss, args.in[I_EBQKV] + li * 1536, RC};
#ifndef NO_GZ
                REPG { pg8::gemm_phase<pg8::EpiZ, pg8::StaticOrder, true, true>(lds, g, S, E); RSEAM(DUP_G); }
#endif
            } else {
                pg8::Gemm g{XB, (const bf16*)(ws + WT_IN), M, ZO, D}; pg8::StaticOrder S; S.init(M, ZO, G, bx);
                pg8::EpiGeluV E{ACT, ZO, ss, ssb + (size_t)(13 + li) * SS_REC, (LAS float*)(lds + 131072), RC};
#ifndef NO_GG
                REPG { pg8::gemm_phase<pg8::EpiGeluV, pg8::StaticOrder, true, true>(lds, g, S, E); RSEAM(DUP_G); }
#endif
            }
            SEAM(pb + 1);
        }
        if (kind == 1) {
            if (IN(pb + 2)) {
#ifndef NO_E1
                if (even) REPN(DUP_E1) { e1_phase(args, li, lds, vcu, G, opaque(tid)); RSEAM(DUP_E1); }
#endif
#ifndef NO_ATTN
                if (even) for (int au = vcu; au < 1024; au += G) attn_unit(args, li, au, lds, opaque(tid));
#endif
#ifndef NO_SGU
                if (!even) REPN(DUP_SGU) { sgu_phase(args, li, lds, vcu, G, opaque(tid)); RSEAM(DUP_SGU); }
#endif
                SEAM(pb + 2); }
#ifndef NO_SPRE
            if (even && IN(pb + 3)) { REPN(DUP_SP) { scanpre_phase(args, li, lds, vcu, G, opaque(tid)); RSEAM(DUP_SP); } SEAM(pb + 3); }
#endif
#ifndef NO_SSEQ
            if (even && IN(pb + 4)) { REPN(DUP_SQ) { scanseq_phase(args, li, lds, vcu, opaque(tid)); RSEAM(DUP_SQ); } SEAM(pb + 4); }
#endif
#ifndef NO_E3
            if (even && IN(pb + 5)) { REPN(DUP_E3) { e3_phase(args, li, vcu, G, opaque(tid)); RSEAM(DUP_E3); } SEAM(pb + 5); }
#endif
        }
        if (IN(pb + 6)) {
            const bf16* A = (kind == 1) ? OB : ACT; const int K = (kind == 1) ? D : FF;
            const bf16* Bt = (const bf16*)(ws + (kind == 0 ? WT_D1 : kind == 1 ? WT_OUT : WT_D2));
            pg8::Gemm g{A, Bt, M, D, K, kind == 1 ? 0 : 1}; pg8::StaticOrder S; S.init(M, D, G, bx);
            pg8::EpiResid E{XB, ssb + (size_t)(s + 1) * SS_REC, kind == 1 ? 1.0f : 0.5f, (LAS float*)(lds + 131072)};
#ifndef NO_GR
            REPN(DUP_GR) { if (rep_) { E.scale = 0.f;
#ifdef PROBE_NOEPI
                E.noop = 1;
#endif
                } pg8::gemm_phase<pg8::EpiResid, pg8::StaticOrder, true, true>(lds, g, S, E); RSEAM(DUP_GR); }
#endif
            SEAM(pb + 6);
        }
    }
    if (IN(NSUB * 8)) { const int t_ = opaque(tid); final_phase(args, vcu, G, __builtin_amdgcn_readfirstlane(t_ >> 6), t_ & 63); }
#undef IN
#undef SEAM
}

extern "C" void kernel_launch(void* const* d_in, const int* in_sizes, int n_in, void* d_out, int out_size, void* d_ws, size_t ws_size, hipStream_t stream) {
    static int grid = 0;
    if (grid == 0) {
        if (n_in != 29 || out_size != M * D || ws_size < WS_END) { fprintf(stderr, "kernel_launch: unexpected shapes (n_in %d, out %d, ws %zu < %zu); nothing launched\n", n_in, out_size, ws_size, (size_t)WS_END); grid = -1; return; }
        int dev = 0, cus = 0;
        if (hipGetDevice(&dev) != hipSuccess || hipDeviceGetAttribute(&cus, hipDeviceAttributeMultiprocessorCount, dev) != hipSuccess) { grid = -1; return; }
        if (hipFuncSetAttribute((const void*)mk_fwd, hipFuncAttributeMaxDynamicSharedMemorySize, LDS_BYTES) != hipSuccess) { fprintf(stderr, "kernel_launch: hipFuncSetAttribute failed\n"); grid = -1; return; }
        int per_cu = 0;
        if (hipOccupancyMaxActiveBlocksPerMultiprocessor(&per_cu, (const void*)mk_fwd, NTHR, LDS_BYTES) != hipSuccess || per_cu < 1) fprintf(stderr, "kernel_launch: occupancy query says %d\n", per_cu);
        (void)hipGetLastError();
        grid = cus;
    }
    if (grid < 0) return;
    (void)hipMemsetAsync((char*)d_ws + WS_CTL, 0, CTL_ZERO_BYTES, stream);
    Args a{};
    for (int i = 0; i < 29; ++i) a.in[i] = (const float*)d_in[i];
    a.out = (float*)d_out; a.ws = (unsigned char*)d_ws;
#if MK_ONE_LAUNCH
    a.ph_lo = 0; a.ph_hi = NSUB * 8 + 1;
    hipLaunchKernelGGL(mk_fwd, dim3(grid), dim3(NTHR), LDS_BYTES, stream, a);
#else
    for (int s = 0; s <= NSUB; ++s) {
        for (int k = 0; k < (s == NSUB ? 1 : 8); ++k) {
            const int L = s / 3, kind = s % 3; const bool even = !(L & 1);
            bool live;
            if (s == NSUB) live = true;
            else if (k == 0) live = (kind == 0);
            else if (k == 1 || k == 6) live = true;
            else if (k == 2) live = (kind == 1);
            else if (k == 3 || k == 4 || k == 5) live = (kind == 1) && even;
            else live = false;
            if (!live) continue;
            a.ph_lo = s * 8 + k; a.ph_hi = a.ph_lo + 1;
            hipLaunchKernelGGL(mk_fwd, dim3(grid), dim3(NTHR), LDS_BYTES, stream, a);
        }
    }
#endif
}
```

```cpp
#include <hip/hip_runtime.h>
#include <cstdio>
#include <cstdint>
#define MK_ONE_LAUNCH 1
namespace pg8 {
#define PG8_LAS __attribute__((address_space(3)))
typedef unsigned short bf16_t;
typedef short bf16x8 __attribute__((ext_vector_type(8)));
typedef float f32x4 __attribute__((ext_vector_type(4)));
typedef unsigned u32x4 __attribute__((ext_vector_type(4)));
constexpr int BM = 256, BK = 64, HALF = 128, HTB = HALF * BK * 2  , STAGE_BYTES = 8 * HTB, NXCD = 8, WGM = 8;

__host__ __device__ __forceinline__ int lds_byte(int r, int c) { const int st = (r >> 4) * 2 + (c >> 5), rr = r & 15, cc = c & 31, ob = rr * 64 + cc * 2; return st * 1024 + (ob ^ (((ob >> 9) & 1) << 5)); }
__host__ __device__ __forceinline__ void stage_rc(int b, int& R, int& C) { const int st = b / 1024, sb = b % 1024, swz = sb ^ (((sb >> 9) & 1) << 5); R = (st >> 1) * 16 + swz / 64; C = (st & 1) * 32 + (swz % 64) / 2; }
__host__ __device__ __forceinline__ int perm32(int rho) { const int n = rho >> 4, i = rho & 15; return 8 * (i >> 2) + 4 * n + (i & 3); }

struct Unit { int pm, pn; };
struct Gemm { const bf16_t* A; const bf16_t* Bt; int M, N, K; int amode = 0; };

struct StaticOrder {
    int nM, nN, nwg, G, c;
    __host__ __device__ void init(int M, int N, int G_, int c_) { nM = M / BM; nN = N / BM; nwg = nM * nN; G = G_; c = c_; }
    __host__ __device__ bool next(int i, Unit& u) const {
        const long L = (long)i * G + c; if (L >= nwg) return false;
        int wgid = (int)L; { const int q = nwg / NXCD, r = nwg % NXCD, xcd = wgid % NXCD, off = wgid / NXCD; wgid = (xcd < r ? xcd * (q + 1) : r * (q + 1) + (xcd - r) * q) + off; }
        const int nig = WGM * nN, gid = wgid / nig, fm = gid * WGM, gsz = (nM - fm) < WGM ? (nM - fm) : WGM;
        u.pm = fm + ((wgid % nig) % gsz); u.pn = (wgid % nig) / gsz; return true;
    }
    __device__ __forceinline__ void a_ready(const Unit&) const {}
    __device__ __forceinline__ void done(const Unit&) const {}
};
__device__ __forceinline__ unsigned cvt_pk_bf16(float lo, float hi) { unsigned r; asm volatile("v_cvt_pk_bf16_f32 %0, %1, %2" : "=v"(r) : "v"(lo), "v"(hi)); return r; }
typedef float f32x2 __attribute__((ext_vector_type(2)));
__device__ __forceinline__ f32x2 gelu_pk(f32x2 v) {
    const f32x2 av = __builtin_elementwise_abs(v), d = av * 0.2316418882f + 1.0f;
    f32x2 t; t.x = __builtin_amdgcn_rcpf(d.x); t.y = __builtin_amdgcn_rcpf(d.y);
    f32x2 q = t * 0.5307027145f + (-0.7265760135f); q = q * t + 0.7107068705f; q = q * t + (-0.142248368f); q = q * t + 0.127414796f; q = q * t;
    const f32x2 s = (v * v) * (-0.72134752044f);
    f32x2 e; e.x = __builtin_amdgcn_exp2f(s.x); e.y = __builtin_amdgcn_exp2f(s.y);
    const f32x2 m = v * (q * e), r = v - m;
    f32x2 o; o.x = v.x < 0.f ? m.x : r.x; o.y = v.y < 0.f ? m.y : r.y; return o;
}

constexpr int SS_M = 32768;
__device__ __forceinline__ float row_rs(const float* P, int row) {
    const float s = ((P[row] + P[SS_M + row]) + (P[2 * SS_M + row] + P[3 * SS_M + row])) + ((P[4 * SS_M + row] + P[5 * SS_M + row]) + (P[6 * SS_M + row] + P[7 * SS_M + row]));
    return rsqrtf(s * (1.0f / 2048.0f) + 1e-6f);
}
__device__ __forceinline__ void panel_rs(const float* ss, PG8_LAS float* rc, int pm, int t) {
    PG8_LAS int* tag = (PG8_LAS int*)(rc + BM);
    const int have = *tag;
    if (have != pm && t < BM) rc[t] = row_rs(ss, pm * BM + t);
    asm volatile("s_waitcnt lgkmcnt(0)" ::: "memory"); __builtin_amdgcn_s_barrier(); asm volatile("" ::: "memory");
    if (have != pm && t == 0) *tag = pm;
}
struct EpiSwiGLU {
    static constexpr bool PERM = true, AFTER_DRAIN = false;
    bf16_t* O; int ldc; const float* ss; PG8_LAS float* rc;
    __device__ __forceinline__ void operator()(const f32x4 (&acc)[2][2][4][2], const Unit& u, int wr, int wc, int fr, int fq) const {
        const int row0 = u.pm * BM + wr * 64 + fr, col0 = u.pn * HALF + wc * 32 + 8 * fq;
        panel_rs(ss, rc, u.pm, (wr * 4 + wc) * 64 + fq * 16 + fr);
#pragma unroll
        for (int ai = 0; ai < 2; ++ai)
#pragma unroll
            for (int m = 0; m < 4; ++m) {
                const int row = row0 + ai * HALF + m * 16;
                const float rs = rc[row - u.pm * BM];
                float o[8];
#pragma unroll
                for (int n = 0; n < 2; ++n)
#pragma unroll
                    for (int j = 0; j < 4; ++j) { const float g = acc[ai][0][m][n][j] * rs, up = acc[ai][1][m][n][j] * rs; o[4 * n + j] = g * __builtin_amdgcn_rcpf(1.0f + __expf(-g)) * up; }
                u32x4 w; w.x = cvt_pk_bf16(o[0], o[1]); w.y = cvt_pk_bf16(o[2], o[3]); w.z = cvt_pk_bf16(o[4], o[5]); w.w = cvt_pk_bf16(o[6], o[7]);
                *(u32x4*)(O + ((size_t)(u.pm * (ldc >> 6) + (col0 >> 6)) * BM + (row - u.pm * BM)) * BK + (col0 & 63)) = w;
                asm volatile("" ::: "memory");
            }
    }
};
struct EpiResid {
    static constexpr bool PERM = true, AFTER_DRAIN = false;
    bf16_t* xb; float* ssn; float scale; PG8_LAS float* sp;
    int noop = 0;
    __device__ __forceinline__ void operator()(const f32x4 (&acc)[2][2][4][2], const Unit& u, int wr, int wc, int fr, int fq) const {
        const int row0 = u.pm * BM + wr * 64 + fr, col0 = u.pn * BM + wc * 32 + 8 * fq;
        if (noop) return;
        u32x4 bn[2];
#pragma unroll
        for (int bj = 0; bj < 2; ++bj) bn[bj] = *(const u32x4*)(xb + (size_t)row0 * 2048 + col0 + bj * HALF);
#pragma unroll
        for (int gi = 0; gi < 8; ++gi) {
            const int ai = gi >> 2, m = gi & 3;
            const int row = row0 + ai * HALF + m * 16; const size_t off = (size_t)row * 2048 + col0; float s = 0.f;
            u32x4 bc[2]; bc[0] = bn[0]; bc[1] = bn[1];
            if (gi < 7) { const size_t off2 = (size_t)(row0 + ((gi + 1) >> 2) * HALF + ((gi + 1) & 3) * 16) * 2048 + col0;
#pragma unroll
                for (int bj = 0; bj < 2; ++bj) bn[bj] = *(const u32x4*)(xb + off2 + bj * HALF); }
#pragma unroll
            for (int bj = 0; bj < 2; ++bj) {
                const f32x4 a0 = acc[ai][bj][m][0] * scale, a1 = acc[ai][bj][m][1] * scale; const u32x4 b = bc[bj]; u32x4 w;
                w.x = cvt_pk_bf16(__uint_as_float(b.x << 16) + a0[0], __uint_as_float(b.x & 0xffff0000u) + a0[1]);
                w.y = cvt_pk_bf16(__uint_as_float(b.y << 16) + a0[2], __uint_as_float(b.y & 0xffff0000u) + a0[3]);
                w.z = cvt_pk_bf16(__uint_as_float(b.z << 16) + a1[0], __uint_as_float(b.z & 0xffff0000u) + a1[1]);
                w.w = cvt_pk_bf16(__uint_as_float(b.w << 16) + a1[2], __uint_as_float(b.w & 0xffff0000u) + a1[3]);
                *(u32x4*)(xb + off + bj * HALF) = w;
                const float r0 = __uint_as_float(w.x << 16), r1 = __uint_as_float(w.x & 0xffff0000u), r2 = __uint_as_float(w.y << 16), r3 = __uint_as_float(w.y & 0xffff0000u);
                const float r4 = __uint_as_float(w.z << 16), r5 = __uint_as_float(w.z & 0xffff0000u), r6 = __uint_as_float(w.w << 16), r7 = __uint_as_float(w.w & 0xffff0000u);
                s += ((r0 * r0 + r1 * r1) + (r2 * r2 + r3 * r3)) + ((r4 * r4 + r5 * r5) + (r6 * r6 + r7 * r7));
            }
            s += __shfl_xor(s, 16); s += __shfl_xor(s, 32);
            if (fq == 0) sp[(ai * HALF + wr * 64 + m * 16 + fr) * 4 + wc] = s;
            asm volatile("" ::: "memory");
        }
        asm volatile("s_waitcnt lgkmcnt(0)" ::: "memory"); __builtin_amdgcn_s_barrier(); asm volatile("" ::: "memory");
        const int t = (wr * 4 + wc) * 64 + fq * 16 + fr;
        if (t < BM) { const f32x4 p = *(const PG8_LAS f32x4*)(sp + t * 4); ssn[(size_t)u.pn * SS_M + u.pm * BM + t] = (p[0] + p[1]) + (p[2] + p[3]); }
    }
};
struct EpiZ {
    static constexpr bool PERM = true, AFTER_DRAIN = false;
    bf16_t* O; int ldc; const float* ss; const float* bias; PG8_LAS float* rc;
    __device__ __forceinline__ void operator()(const f32x4 (&acc)[2][2][4][2], const Unit& u, int wr, int wc, int fr, int fq) const {
        const int row0 = u.pm * BM + wr * 64 + fr, col0 = u.pn * BM + wc * 32 + 8 * fq;
        panel_rs(ss, rc, u.pm, (wr * 4 + wc) * 64 + fq * 16 + fr);
        const bool hb = u.pn < 6;
        f32x4 bv[2][2];
#pragma unroll
        for (int bj = 0; bj < 2; ++bj)
#pragma unroll
            for (int n = 0; n < 2; ++n) bv[bj][n] = hb ? *(const f32x4*)(bias + col0 + bj * HALF + 4 * n) : (f32x4){0.f, 0.f, 0.f, 0.f};
#pragma unroll
        for (int ai = 0; ai < 2; ++ai)
#pragma unroll
            for (int m = 0; m < 4; ++m) {
                const int row = row0 + ai * HALF + m * 16;
                const float rs = rc[row - u.pm * BM];
                bf16_t* rowp = O + (size_t)row * ldc + col0;
#pragma unroll
                for (int bj = 0; bj < 2; ++bj) {
                    const f32x4 v0 = acc[ai][bj][m][0] * rs + bv[bj][0], v1 = acc[ai][bj][m][1] * rs + bv[bj][1];
                    u32x4 w; w.x = cvt_pk_bf16(v0[0], v0[1]); w.y = cvt_pk_bf16(v0[2], v0[3]); w.z = cvt_pk_bf16(v1[0], v1[1]); w.w = cvt_pk_bf16(v1[2], v1[3]);
                    *(u32x4*)(rowp + bj * HALF) = w;
                }
                asm volatile("" ::: "memory");
            }
    }
};
struct EpiGeluV {
    static constexpr bool PERM = true, AFTER_DRAIN = false;
    bf16_t* O; int ldc; const float* ss; float* ssv; PG8_LAS float* sp; PG8_LAS float* rc;
    __device__ __forceinline__ void operator()(const f32x4 (&acc)[2][2][4][2], const Unit& u, int wr, int wc, int fr, int fq) const {
        const int row0 = u.pm * BM + wr * 64 + fr, col0 = u.pn * BM + wc * 32 + 8 * fq;
        panel_rs(ss, rc, u.pm, (wr * 4 + wc) * 64 + fq * 16 + fr);
        const bool isv = u.pn >= 8;
#pragma unroll
        for (int ai = 0; ai < 2; ++ai)
#pragma unroll
            for (int m = 0; m < 4; ++m) {
                const int row = row0 + ai * HALF + m * 16;
                const float rs = rc[row - u.pm * BM];
                bf16_t* rowp = O + (size_t)row * ldc + col0; float s = 0.f;
#pragma unroll
                for (int bj = 0; bj < 2; ++bj) {
                    f32x4 v0 = acc[ai][bj][m][0] * rs, v1 = acc[ai][bj][m][1] * rs;
                    const f32x2 a = gelu_pk((f32x2){v0[0], v0[1]}), b = gelu_pk((f32x2){v0[2], v0[3]}), c = gelu_pk((f32x2){v1[0], v1[1]}), d = gelu_pk((f32x2){v1[2], v1[3]});
                    s += (a.x * a.x + a.y * a.y) + (b.x * b.x + b.y * b.y) + (c.x * c.x + c.y * c.y) + (d.x * d.x + d.y * d.y);
                    u32x4 w; w.x = cvt_pk_bf16(a.x, a.y); w.y = cvt_pk_bf16(b.x, b.y); w.z = cvt_pk_bf16(c.x, c.y); w.w = cvt_pk_bf16(d.x, d.y);
                    *(u32x4*)(rowp + bj * HALF) = w;
                }
                if (isv) { s += __shfl_xor(s, 16); s += __shfl_xor(s, 32); if (fq == 0) sp[(ai * HALF + wr * 64 + m * 16 + fr) * 4 + wc] = s; }
                asm volatile("" ::: "memory");
            }
        if (isv) {
            asm volatile("s_waitcnt lgkmcnt(0)" ::: "memory"); __builtin_amdgcn_s_barrier(); asm volatile("" ::: "memory");
            const int t = (wr * 4 + wc) * 64 + fq * 16 + fr;
            if (t < BM) { const f32x4 p = *(const PG8_LAS f32x4*)(sp + t * 4); ssv[(size_t)(u.pn - 8) * SS_M + u.pm * BM + t] = (p[0] + p[1]) + (p[2] + p[3]); }
        }
    }
};
template <class Epi, class Sched, bool ALIGN_EPI = false, bool SP2 = false>
__device__ __forceinline__ void gemm_phase(PG8_LAS unsigned char* lds, const Gemm g, const Sched& S, const Epi& E) {
    int tid_ = threadIdx.x; asm volatile("" : "+v"(tid_));
    const int tid = tid_, wid = __builtin_amdgcn_readfirstlane(tid >> 6), lane = tid & 63, wr = wid >> 2, wc = wid & 3, fr = lane & 15, fq = lane >> 4;
    const int K = g.K, nt = K / BK;
    unsigned voffA[2], voffB[2];
#pragma unroll
    for (int i = 0; i < 2; ++i) { int R, C; stage_rc(tid * 16 + i * 8192, R, C); const int Rb = Epi::PERM ? ((R & ~31) + perm32(R & 31)) : R;
        voffA[i] = g.amode ? (unsigned)(R * BK + C) * 2u : (unsigned)(R * K + C) * 2u; voffB[i] = (unsigned)(Rb * K + C) * 2u; }
    const size_t kstep = (size_t)(BK * 2);
    const size_t hstep = (size_t)HALF * K * 2;
    const size_t tstep = 2 * hstep;
    const size_t kstepA = g.amode ? (size_t)(BM * BK * 2) : kstep, hstepA = g.amode ? (size_t)(HALF * BK * 2) : hstep, tstepA = g.amode ? (size_t)(K / BK) * (BM * BK * 2) : tstep;
    const unsigned ldsw = (unsigned)wid * 1024u;
    const int aoff = lds_byte(wr * 64 + fr, fq * 8), boff = lds_byte(wc * 32 + fr, fq * 8);
#define PG8_SA(b, h) (((b) * 2 + (h)) * HTB)
#define PG8_SB(b, h) ((4 + (b) * 2 + (h)) * HTB)
#define PG8_STAGE(bufoff, gbase, voff) do { _Pragma("unroll") for (int _i = 0; _i < 2; ++_i) \
        __builtin_amdgcn_global_load_lds((const unsigned*)((const char*)(gbase) + (voff)[_i]), (PG8_LAS unsigned*)(lds + (bufoff) + ldsw + _i * 8192), 16, 0, 0); } while (0)
#define PG8_LDA(dst, b, h) do { _Pragma("unroll") for (int m = 0; m < 4; ++m) _Pragma("unroll") for (int k = 0; k < 2; ++k) dst[m][k] = *(const PG8_LAS bf16x8*)(lds + PG8_SA(b, h) + aoff + m * 2048 + k * 1024); } while (0)
#define PG8_LDB(dst, b, h) do { _Pragma("unroll") for (int n = 0; n < 2; ++n) _Pragma("unroll") for (int k = 0; k < 2; ++k) dst[n][k] = *(const PG8_LAS bf16x8*)(lds + PG8_SB(b, h) + boff + n * 2048 + k * 1024); } while (0)
#define PG8_MMA(ai, bj, At, Bt) do { __builtin_amdgcn_s_setprio(1); _Pragma("unroll") for (int m = 0; m < 4; ++m) _Pragma("unroll") for (int n = 0; n < 2; ++n) _Pragma("unroll") for (int k = 0; k < 2; ++k) \
        acc[ai][bj][m][n] = __builtin_amdgcn_mfma_f32_16x16x32_bf16(Bt[n][k], At[m][k], acc[ai][bj][m][n], 0, 0, 0); __builtin_amdgcn_s_setprio(0); } while (0)
#define PG8_WAIT_V(n) asm volatile("s_waitcnt vmcnt(" #n ")" ::: "memory")
#define PG8_WAIT_L(n) asm volatile("s_waitcnt lgkmcnt(" #n ")" ::: "memory")
#define PG8_BAR __builtin_amdgcn_s_barrier()
#define PG8_SCHED __builtin_amdgcn_sched_barrier(0)
    Unit cur, nxt; int ui = 0;
    if (!S.next(0, cur)) return;
    f32x4 acc[2][2][4][2];
#pragma unroll
    for (int a = 0; a < 2; ++a)
#pragma unroll
        for (int b = 0; b < 2; ++b)
#pragma unroll
            for (int m = 0; m < 4; ++m)
#pragma unroll
                for (int n = 0; n < 2; ++n) acc[a][b][m][n] = (f32x4){0.f, 0.f, 0.f, 0.f};
    bf16x8 At[4][2], B0[2][2], B1[2][2];
    const char* cA = (const char*)g.A + (size_t)cur.pm * tstepA; const char* cB = (const char*)g.Bt + (size_t)cur.pn * tstep;
    S.a_ready(cur);
    if constexpr (SP2) {
        PG8_STAGE(PG8_SB(0, 0), cB, voffB); PG8_STAGE(PG8_SB(0, 1), cB + hstep, voffB); PG8_STAGE(PG8_SA(0, 0), cA, voffA); PG8_STAGE(PG8_SA(0, 1), cA + hstepA, voffA);
        if (wr == 1) PG8_BAR;
        PG8_WAIT_V(2); PG8_BAR;
        PG8_STAGE(PG8_SB(1, 0), cB + kstep, voffB); PG8_STAGE(PG8_SA(1, 0), cA + kstepA, voffA); PG8_STAGE(PG8_SB(1, 1), cB + hstep + kstep, voffB);
        PG8_WAIT_V(6); PG8_BAR;
    } else {
        PG8_STAGE(PG8_SB(0, 0), cB, voffB); PG8_STAGE(PG8_SA(0, 0), cA, voffA); PG8_STAGE(PG8_SB(0, 1), cB + hstep, voffB); PG8_STAGE(PG8_SA(0, 1), cA + hstepA, voffA);
        if (wr == 1) PG8_BAR;
        PG8_WAIT_V(4); PG8_BAR;
        PG8_STAGE(PG8_SB(1, 0), cB + kstep, voffB); PG8_STAGE(PG8_SA(1, 0), cA + kstepA, voffA); PG8_STAGE(PG8_SB(1, 1), cB + hstep + kstep, voffB);
        PG8_WAIT_V(6); PG8_BAR;
    }
    for (;;) {
        const bool has_next = S.next(ui + 1, nxt);
        const char* nA = has_next ? (const char*)g.A + (size_t)nxt.pm * tstepA : cA; const char* nB = has_next ? (const char*)g.Bt + (size_t)nxt.pn * tstep : cB;
        for (int t = 0; t < nt; t += 2) {
            const bool last = (t == nt - 2);
            const char* a1 = cA + (size_t)(t + 1) * kstepA;
            const char* a2 = last ? nA : cA + (size_t)(t + 2) * kstepA; const char* b2 = last ? nB : cB + (size_t)(t + 2) * kstep;
            const char* a3 = a2 + kstepA; const char* b3 = b2 + kstep;
            if (last && has_next) S.a_ready(nxt);
            if constexpr (SP2) {
            PG8_LDB(B0, 0, 0); PG8_LDB(B1, 0, 1); PG8_SCHED; PG8_LDA(At, 0, 0); PG8_STAGE(PG8_SA(1, 1), a1 + hstepA, voffA);
            PG8_WAIT_V(8); PG8_WAIT_L(0); PG8_BAR; PG8_MMA(0, 0, At, B0); PG8_MMA(0, 1, At, B1); PG8_BAR; PG8_SCHED;
            PG8_LDA(At, 0, 1); PG8_STAGE(PG8_SB(0, 0), b2, voffB); PG8_STAGE(PG8_SB(0, 1), b2 + hstep, voffB); PG8_STAGE(PG8_SA(0, 0), a2, voffA);
            PG8_WAIT_V(8); PG8_WAIT_L(0); PG8_BAR; PG8_MMA(1, 0, At, B0); PG8_MMA(1, 1, At, B1); PG8_BAR; PG8_SCHED;
            PG8_LDB(B0, 1, 0); PG8_LDB(B1, 1, 1); PG8_SCHED; PG8_LDA(At, 1, 0); PG8_STAGE(PG8_SA(0, 1), a2 + hstepA, voffA);
            PG8_WAIT_V(8); PG8_WAIT_L(0); PG8_BAR; PG8_MMA(0, 0, At, B0); PG8_MMA(0, 1, At, B1); PG8_BAR; PG8_SCHED;
            PG8_LDA(At, 1, 1); PG8_STAGE(PG8_SB(1, 0), b3, voffB); PG8_STAGE(PG8_SB(1, 1), b3 + hstep, voffB); PG8_STAGE(PG8_SA(1, 0), a3, voffA);
            PG8_WAIT_V(8); PG8_WAIT_L(0); PG8_BAR; PG8_MMA(1, 0, At, B0); PG8_MMA(1, 1, At, B1); PG8_BAR; PG8_SCHED;
            } else {
            PG8_LDB(B0, 0, 0); PG8_SCHED; PG8_LDA(At, 0, 0); PG8_STAGE(PG8_SA(1, 1), a1 + hstepA, voffA);
            PG8_WAIT_L(8); PG8_BAR; PG8_WAIT_L(0); PG8_MMA(0, 0, At, B0); PG8_BAR; PG8_SCHED;
            PG8_LDB(B1, 0, 1); PG8_STAGE(PG8_SB(0, 0), b2, voffB);
            PG8_BAR; PG8_WAIT_L(0); PG8_MMA(0, 1, At, B1); PG8_BAR;
            PG8_LDA(At, 0, 1); PG8_STAGE(PG8_SA(0, 0), a2, voffA);
            PG8_BAR; PG8_WAIT_L(0); PG8_MMA(1, 0, At, B0); PG8_BAR; PG8_SCHED;
            PG8_STAGE(PG8_SB(0, 1), b2 + hstep, voffB);
            PG8_WAIT_V(6); PG8_BAR; PG8_MMA(1, 1, At, B1); PG8_BAR;
            PG8_LDB(B0, 1, 0); PG8_SCHED; PG8_LDA(At, 1, 0); PG8_STAGE(PG8_SA(0, 1), a2 + hstepA, voffA);
            PG8_WAIT_L(8); PG8_BAR; PG8_WAIT_L(0); PG8_MMA(0, 0, At, B0); PG8_BAR; PG8_SCHED;
            PG8_LDB(B1, 1, 1); PG8_STAGE(PG8_SB(1, 0), b3, voffB);
            PG8_BAR; PG8_WAIT_L(0); PG8_MMA(0, 1, At, B1); PG8_BAR;
            PG8_LDA(At, 1, 1); PG8_STAGE(PG8_SA(1, 0), a3, voffA);
            PG8_BAR; PG8_WAIT_L(0); PG8_MMA(1, 0, At, B0); PG8_BAR; PG8_SCHED;
            PG8_STAGE(PG8_SB(1, 1), b3 + hstep, voffB);
            PG8_WAIT_V(6); PG8_BAR; PG8_MMA(1, 1, At, B1); PG8_BAR;
            }
        }
        if constexpr (ALIGN_EPI) { if (wr == 0) PG8_BAR; }
        if constexpr (!Epi::AFTER_DRAIN) { E(acc, cur, wr, wc, fr, fq); S.done(cur); }
        if (!has_next) break;
#pragma unroll
        for (int a = 0; a < 2; ++a)
#pragma unroll
            for (int b = 0; b < 2; ++b)
#pragma unroll
                for (int m = 0; m < 4; ++m)
#pragma unroll
                    for (int n = 0; n < 2; ++n) acc[a][b][m][n] = (f32x4){0.f, 0.f, 0.f, 0.f};
        cur = nxt; cA = nA; cB = nB; ++ui;
        if constexpr (ALIGN_EPI) { if (wr == 1) PG8_BAR; }
    }
    PG8_WAIT_V(0);
    if constexpr (!ALIGN_EPI) { if (wr == 0) PG8_BAR; }
    PG8_BAR;
    if constexpr (Epi::AFTER_DRAIN) { E.fused(acc, cur, wr, wc, fr, fq, lds, wid, lane); S.done(cur); }
#undef PG8_SA
#undef PG8_SB
#undef PG8_STAGE
#undef PG8_LDA
#undef PG8_LDB
#undef PG8_MMA
#undef PG8_WAIT_V
#undef PG8_WAIT_L
#undef PG8_BAR
#undef PG8_SCHED
}
}
#define LAS_BAR __attribute__((address_space(3)))
#define XB_TMO      128
#define XB_XCNT(j)  (256  + 64 * (j))
#define XB_XSUB(j)  (1280 + 64 * (j))
#define XB_XGEN(j)  (2304 + 64 * (j))
#define XB_TOP      3328
#define XB_TOPGEN   3392
#define XCD_BAR_WORDS 3456
#define XB_SPIN_CAP (1u << 22)

__device__ __forceinline__ unsigned xb_ld(unsigned* p)              { return __hip_atomic_load(p, __ATOMIC_RELAXED, __HIP_MEMORY_SCOPE_AGENT); }
__device__ __forceinline__ unsigned xb_add(unsigned* p, unsigned v) { return __hip_atomic_fetch_add(p, v, __ATOMIC_RELAXED, __HIP_MEMORY_SCOPE_AGENT); }
__device__ __forceinline__ unsigned xb_xcc_id() { return (unsigned)__builtin_amdgcn_s_getreg((3 << 11) | 20) & 0xFu; }
#define XB_SPIN(cond, bar) do { unsigned _sp = 0; while (cond) { __builtin_amdgcn_s_sleep(1); \
    if ((++_sp & 255u) == 0u) { if (xb_ld(&(bar)[XB_TMO])) break; if (_sp > XB_SPIN_CAP) { atomicAdd(&(bar)[XB_TMO], 1u); break; } } } } while (0)

struct XcdBarrier {
    unsigned* bar; unsigned x;
    volatile LAS_BAR unsigned* st;
};

__device__ __forceinline__ XcdBarrier xcd_barrier_post(unsigned* bar, volatile LAS_BAR unsigned* st) {
    XcdBarrier b; b.bar = bar; b.x = xb_xcc_id(); b.st = st;
    if (threadIdx.x == 0) (void)xb_add(&bar[XB_XCNT(b.x)], 1u);
    return b;
}
__device__ __forceinline__ void xcd_barrier_complete(unsigned* bar, unsigned x, unsigned& nloc, unsigned& nx) {
    const unsigned G = gridDim.x * gridDim.y * gridDim.z;
    unsigned sum, cnt, mine, sp = 0u;
    for (;;) {
        sum = 0u; cnt = 0u; mine = 0u;
#pragma unroll
        for (unsigned j = 0; j < 16; ++j) { const unsigned c = xb_ld(&bar[XB_XCNT(j)]); sum += c; cnt += (c > 0u) ? 1u : 0u; mine = (j == x) ? c : mine; }
        if (sum == G) break;
        __builtin_amdgcn_s_sleep(1);
        if ((++sp & 255u) == 0u) { if (xb_ld(&bar[XB_TMO])) break; if (sp > XB_SPIN_CAP) { atomicAdd(&bar[XB_TMO], 1u); break; } }
    }
    nloc = mine > 0u ? mine : 1u; nx = cnt > 0u ? cnt : 1u;
}

__device__ __forceinline__ void xcd_barrier(const XcdBarrier& b) {
    asm volatile("s_waitcnt vmcnt(0)" ::: "memory");
    __syncthreads();
    if (threadIdx.x == 0) {
        unsigned* bar = b.bar;
        __builtin_amdgcn_s_waitcnt(0);
#ifdef PROBE_STAMP
        const unsigned long long pt0_ = __builtin_amdgcn_s_memrealtime();
#endif
        unsigned nloc = b.st[0], nx = b.st[1];
        if (nloc == 0u) { xcd_barrier_complete(bar, b.x, nloc, nx); b.st[0] = nloc; b.st[1] = nx; }
        const unsigned old = xb_add(&bar[XB_XSUB(b.x)], 1u);
        const unsigned gen = old / nloc;
        if (old + 1u == (gen + 1u) * nloc) {
            __builtin_amdgcn_fence(__ATOMIC_RELEASE, "agent");
            asm volatile("s_waitcnt vmcnt(0)" ::: "memory");
            const unsigned og = xb_add(&bar[XB_TOP], 1u);
            const unsigned tg = og / nx;
            if (og + 1u == (tg + 1u) * nx) xb_add(&bar[XB_TOPGEN], 1u);
            else XB_SPIN(xb_ld(&bar[XB_TOPGEN]) == tg, bar);
            __builtin_amdgcn_fence(__ATOMIC_ACQUIRE, "agent");
            xb_add(&bar[XB_XGEN(b.x)], 1u);
            asm volatile("s_waitcnt vmcnt(0)" ::: "memory");
        } else {
            XB_SPIN(xb_ld(&bar[XB_XGEN(b.x)]) == gen, bar);
            __builtin_amdgcn_fence(__ATOMIC_ACQUIRE, "agent");
            asm volatile("s_waitcnt vmcnt(0)" ::: "memory");
        }
#ifdef PROBE_STAMP
        { const unsigned cls_ = b.st[4]; b.st[8 + cls_] += (unsigned)(__builtin_amdgcn_s_memrealtime() - pt0_); }
#endif
    }
    __syncthreads();
}

constexpr int NWAVES = 8, NTHR = 512;
constexpr int BATCH = 2, T = 16384, D = 2048, FF = 5632, M = BATCH * T;
constexpr int ZN = 5120;
constexpr int ZA = 1536;
constexpr int A_COLS = 3360, E_IN = 4896;
constexpr int ZO = 4096;
constexpr int NSUB = 12;
#ifndef MK_ONE_LAUNCH
#define MK_ONE_LAUNCH 0
#endif

constexpr size_t MiB = 1u << 20;
constexpr size_t WS_CTL = 0, CTL_ZERO_BYTES = 1 * MiB;
constexpr size_t WS_SS = 1 * MiB;
constexpr size_t SS_REC = 8 * (size_t)M;
constexpr size_t WS_WT = 16 * MiB;
constexpr size_t WT_GU1 = WS_WT, WT_D1 = WT_GU1 + 44 * MiB, WT_GU2 = WT_D1 + 22 * MiB, WT_D2 = WT_GU2 + 44 * MiB, WT_IN = WT_D2 + 22 * MiB, WT_OUT = WT_IN + 20 * MiB;
constexpr size_t WS_XB = WT_OUT + 8 * MiB;
constexpr size_t WS_ACT = WS_XB + 128 * MiB;
constexpr size_t WS_SC = WS_ACT + 352 * MiB;
constexpr size_t SC_R = WS_SC, SC_K2 = SC_R + 64 * MiB, SC_KK = SC_K2 + 64 * MiB, SC_BB = SC_KK + 64 * MiB, SC_LW = SC_BB + 64 * MiB, SC_GG = SC_LW + 64 * MiB;
constexpr size_t WS_VF = SC_GG + 64 * MiB;
constexpr size_t WS_V2 = WS_VF + 64 * MiB;
constexpr size_t WS_O = WS_V2 + 64 * MiB;
constexpr size_t WS_SM = WS_O + 128 * MiB;
constexpr size_t SM_W2T = WS_SM, SM_A2T = SM_W2T + 131072, SM_G2T = SM_A2T + 131072, SM_V1T = SM_G2T + 327680, SM_V2T = SM_V1T + 65536, SM_WSB = SM_V2T + 65536;
constexpr size_t WS_U0 = WS_SM + 2 * MiB;
constexpr size_t WS_END = WS_U0 + 64 * MiB;
static_assert(SM_WSB + 524288 <= WS_END, "small-weight map");
static_assert(WT_OUT + 8 * MiB == 176 * MiB && WS_SS + 15 * MiB <= WS_WT, "weight map");
constexpr int CW_TMO = 0, CW_CODE = 1, CW_BAR = 4096;

constexpr int LDS_BYTES = 147456, LDSCTL_OFF = LDS_BYTES - 512;

#define GAS __attribute__((address_space(1)))
#define LAS __attribute__((address_space(3)))
typedef unsigned short bf16;
typedef unsigned v4u __attribute__((ext_vector_type(4)));
typedef unsigned v2u __attribute__((ext_vector_type(2)));
typedef float f32x4 __attribute__((ext_vector_type(4)));
typedef float f32x2 __attribute__((ext_vector_type(2)));
typedef GAS unsigned gu32;
#define RLX_AGENT __ATOMIC_RELAXED, __HIP_MEMORY_SCOPE_AGENT
#define LDS_WAIT() asm volatile("s_waitcnt lgkmcnt(0)" ::: "memory")
typedef __bf16 bf16x2_hw __attribute__((ext_vector_type(2)));
__device__ __forceinline__ unsigned pk2(float lo, float hi) { const bf16x2_hw b = __builtin_convertvector((f32x2){lo, hi}, bf16x2_hw); return __builtin_bit_cast(unsigned, b); }
__device__ __forceinline__ unsigned f2bf(float f) { return pk2(f, f) & 0xffffu; }
__device__ __forceinline__ float bf2f(bf16 b) { return __builtin_bit_cast(float, (unsigned)b << 16); }
__device__ __forceinline__ float bflo(unsigned w) { return __builtin_bit_cast(float, w << 16); }
__device__ __forceinline__ float bfhi(unsigned w) { return __builtin_bit_cast(float, w & 0xffff0000u); }
__device__ __forceinline__ float wave_sum(float v) {
#pragma unroll
    for (int o = 1; o < 64; o <<= 1) v += __shfl_xor(v, o);
    return v;
}
template <int CTRL> __device__ __forceinline__ float dpp_mov(float v) { return __builtin_bit_cast(float, __builtin_amdgcn_update_dpp(0, __builtin_bit_cast(int, v), CTRL, 0xf, 0xf, true)); }
__device__ __forceinline__ float row16_sum(float v) { v += dpp_mov<0xB1>(v); v += dpp_mov<0x4E>(v); v += dpp_mov<0x141>(v); v += dpp_mov<0x140>(v); return v; }
__device__ __forceinline__ float sigmoidf_(float x) { return 1.0f / (1.0f + __expf(-x)); }

__device__ __forceinline__ int opaque(int v) { asm volatile("" : "+v"(v)); return v; }
struct Args { const float* in[29]; float* out; unsigned char* ws; int ph_lo, ph_hi; };
static_assert(sizeof(Args) == 29 * 8 + 8 + 8 + 8, "Args has no padding");
enum { I_X = 0, I_NG, I_WG, I_WU, I_WD, I_EWIN, I_EBQKV, I_EMU, I_EW0, I_EW2, I_EA0, I_EA2, I_EG2, I_EKK, I_EKA, I_ERK, I_EGNG, I_EGNB, I_ESINK, I_EWOUT, I_V0, I_V1, I_V2, I_OWIN, I_OVNG, I_OWS, I_OBS, I_OWOUT, I_FG };

struct TrDesc { const float* W; const float* gk; bf16* WT; int ldw, k0, c0, K, drow0; bool zero; };
__device__ __forceinline__ void tr_load(const TrDesc& d, float (&v)[32], int lane) {
#pragma unroll
    for (int i = 0; i < 32; ++i) { const int kk = 2 * i + (lane >> 5); v[i] = d.zero ? 0.f : d.W[(size_t)(d.k0 + kk) * d.ldw + d.c0 + (lane & 31)]; }
}
__device__ __forceinline__ void tr_store(const TrDesc& d, const float (&v)[32], LAS float* scr, int lane) {
#pragma unroll
    for (int i = 0; i < 32; ++i) { const int kk = 2 * i + (lane >> 5); float x = v[i]; if (d.gk) x *= d.gk[d.k0 + kk]; scr[kk * 33 + (lane & 31)] = x; }
    LDS_WAIT(); asm volatile("" ::: "memory");
    const int c = lane & 7;
#pragma unroll
    for (int j = 0; j < 4; ++j) { const int n = (lane >> 3) + 8 * j; const LAS float* s = scr + (8 * c) * 33 + n;
        v4u o; o.x = pk2(s[0 * 33], s[1 * 33]); o.y = pk2(s[2 * 33], s[3 * 33]); o.z = pk2(s[4 * 33], s[5 * 33]); o.w = pk2(s[6 * 33], s[7 * 33]);
        *(GAS v4u*)(d.WT + (size_t)(d.drow0 + n) * d.K + d.k0 + 8 * c) = o; }
    LDS_WAIT(); asm volatile("" ::: "memory");
}
__device__ __forceinline__ TrDesc tr_desc(const Args& a, int L, int it) {
    unsigned char* ws = a.ws; const bool even = !(L & 1); const int li = L >> 1;
    constexpr int nGU = 32 * 352, nD = 88 * 64; const int nIN = 32 * (even ? 160 : 128);
    TrDesc d; d.zero = false; int r = it;
    if (r < 2 * nGU) { const int f = r / nGU; r -= f * nGU; const int kb = r / 352, rb = r % 352, tj = rb >> 3, sub = rb & 7;
        d.W = (sub < 4 ? a.in[I_WG] : a.in[I_WU]) + (size_t)(L * 2 + f) * D * FF; d.ldw = FF; d.k0 = 64 * kb; d.c0 = 128 * tj + 32 * (sub & 3); d.gk = a.in[I_NG] + (L * 3 + (f ? 2 : 0)) * D;
        d.WT = (bf16*)(ws + (f ? WT_GU2 : WT_GU1)); d.K = D; d.drow0 = 32 * rb; return d; }
    r -= 2 * nGU;
    if (r < 2 * nD) { const int f = r / nD; r -= f * nD; const int kb = r / 64, nb = r % 64;
        d.W = a.in[I_WD] + (size_t)(L * 2 + f) * FF * D; d.ldw = D; d.k0 = 64 * kb; d.c0 = 32 * nb; d.gk = nullptr; d.WT = (bf16*)(ws + (f ? WT_D2 : WT_D1)); d.K = FF; d.drow0 = 32 * nb; return d; }
    r -= 2 * nD;
    if (r < nIN) {
        d.gk = a.in[I_NG] + (L * 3 + 1) * D; d.WT = (bf16*)(ws + WT_IN); d.K = D;
        if (even) { const int kb = r / 160, rb = r % 160, dd = 32 * rb; d.zero = dd >= E_IN; d.W = a.in[I_EWIN] + (size_t)li * D * E_IN; d.ldw = E_IN; d.k0 = 64 * kb; d.c0 = d.zero ? 0 : (dd < ZA ? A_COLS + dd : dd - ZA); d.drow0 = dd; }
        else { const int kb = r / 128, rb = r % 128; d.W = a.in[I_OWIN] + (size_t)li * D * ZO; d.ldw = ZO; d.k0 = 64 * kb; d.c0 = 32 * rb; d.drow0 = 32 * rb; }
        return d; }
    r -= nIN;
    { const int kb = r / 64, nb = r % 64; d.W = (even ? a.in[I_EWOUT] : a.in[I_OWOUT]) + (size_t)li * D * D; d.ldw = D; d.k0 = 64 * kb; d.c0 = 32 * nb; d.gk = nullptr; d.WT = (bf16*)(ws + WT_OUT); d.K = D; d.drow0 = 32 * nb; }
    return d;
}
__device__ __forceinline__ void prep_phase(const Args& a, int L, LAS unsigned char* lds, int vcu, int G, int wave, int lane) {
    asm volatile("" : "+s"(G));
    LAS float* scr = (LAS float*)(lds + wave * 16384);
    const int gw = vcu * NWAVES + wave, NGW = G * NWAVES;
    unsigned char* ws = a.ws;
    const bool even = !(L & 1); const int li = L >> 1;
    const int total = 2 * (32 * 352) + 2 * (88 * 64) + 32 * (even ? 160 : 128) + 32 * 64;
    if (gw < total) {
        TrDesc d0 = tr_desc(a, L, gw); float v0[32]; tr_load(d0, v0, lane);
        for (int it = gw; it < total; it += NGW) {
            const int itn = it + NGW; const bool hasn = itn < total;
            TrDesc d1 = tr_desc(a, L, hasn ? itn : it); float v1[32];
            if (hasn) tr_load(d1, v1, lane);
            tr_store(d0, v0, scr, lane);
            d0 = d1;
#pragma unroll
            for (int i = 0; i < 32; ++i) v0[i] = v1[i];
        }
    }
    {
        const int gt = gw * 64 + lane, NGT = NGW * 64;
        if (even) {
            const float* w2 = a.in[I_EW2] + (size_t)li * 64 * 1024; const float* a2 = a.in[I_EA2] + (size_t)li * 64 * 1024; const float* g2 = a.in[I_EG2] + (size_t)li * 160 * 1024;
            bf16* W2T = (bf16*)(ws + SM_W2T); bf16* A2T = (bf16*)(ws + SM_A2T); bf16* G2T = (bf16*)(ws + SM_G2T);
            for (int e = gt; e < 1024 * 64; e += NGT) { const int k = e >> 10, c = e & 1023; W2T[c * 64 + k] = (bf16)f2bf(w2[e]); A2T[c * 64 + k] = (bf16)f2bf(a2[e]); }
            for (int e = gt; e < 1024 * 160; e += NGT) { const int k = e >> 10, c = e & 1023; G2T[c * 160 + k] = (bf16)f2bf(g2[e]); }
            if (li > 0) { bf16* V1T = (bf16*)(ws + SM_V1T); bf16* V2T = (bf16*)(ws + SM_V2T);
                for (int e = gt; e < 1024 * 32; e += NGT) { const int c = e >> 5, j = e & 31; V1T[j * 1024 + c] = (bf16)f2bf(a.in[I_V1][e]); }
                for (int e = gt; e < 32 * 1024; e += NGT) { const int j = e >> 10, c = e & 1023; V2T[c * 32 + j] = (bf16)f2bf(a.in[I_V2][e]); } }
        } else {
            const float* wsg = a.in[I_OWS] + (size_t)li * 16 * 128 * 128; bf16* WSB = (bf16*)(ws + SM_WSB);
            for (int e = gt; e < 16 * 128 * 128; e += NGT) { const int i = (e >> 7) & 127, j = e & 127; WSB[e] = (bf16)f2bf(j <= i ? wsg[e] : 0.f); }
        }
    }
    if (L == 0) {
        float* ss0 = (float*)(ws + WS_SS); bf16* XB = (bf16*)(ws + WS_XB);
        for (int m = gw; m < M; m += NGW) {
            const GAS f32x4* xr = (const GAS f32x4*)(a.in[I_X] + (size_t)m * D) + lane; GAS v2u* o = (GAS v2u*)(XB + (size_t)m * D) + lane; float s = 0.f;
#pragma unroll
            for (int j = 0; j < 8; ++j) { const f32x4 v = xr[64 * j]; s += (v.x * v.x + v.y * v.y) + (v.z * v.z + v.w * v.w); v2u w; w.x = pk2(v.x, v.y); w.y = pk2(v.z, v.w); o[64 * j] = w; }
            s = wave_sum(s); if (lane < 8) ss0[(size_t)lane * M + m] = lane ? 0.f : s;
        }
    }
}

typedef short bf16x8_t __attribute__((ext_vector_type(8)));
__device__ __forceinline__ float fast_tanh(float x) { const float e = __expf(2.0f * x); return 1.0f - 2.0f / (1.0f + e); }
__device__ __forceinline__ void lerp8(const v4u c, const v4u p, const float* mu, float (&o)[8]) {
    const f32x4 m0 = *(const f32x4*)mu, m1 = *(const f32x4*)(mu + 4);
    const float c0 = bflo(c.x), c1 = bfhi(c.x), c2 = bflo(c.y), c3 = bfhi(c.y), c4 = bflo(c.z), c5 = bfhi(c.z), c6 = bflo(c.w), c7 = bfhi(c.w);
    o[0] = c0 + (bflo(p.x) - c0) * m0.x; o[1] = c1 + (bfhi(p.x) - c1) * m0.y; o[2] = c2 + (bflo(p.y) - c2) * m0.z; o[3] = c3 + (bfhi(p.y) - c3) * m0.w;
    o[4] = c4 + (bflo(p.z) - c4) * m1.x; o[5] = c5 + (bfhi(p.z) - c5) * m1.y; o[6] = c6 + (bflo(p.w) - c6) * m1.z; o[7] = c7 + (bfhi(p.w) - c7) * m1.w;
}
__device__ __forceinline__ void lerp4(const v2u c, const v2u p, const f32x4 m, float (&o)[4]) {
    const float c0 = bflo(c.x), c1 = bfhi(c.x), c2 = bflo(c.y), c3 = bfhi(c.y);
    o[0] = c0 + (bflo(p.x) - c0) * m.x; o[1] = c1 + (bfhi(p.x) - c1) * m.y; o[2] = c2 + (bflo(p.y) - c2) * m.z; o[3] = c3 + (bfhi(p.y) - c3) * m.w;
}
__device__ __forceinline__ v2u pack4(float a, float b, float c, float d) { v2u w; w.x = pk2(a, b); w.y = pk2(c, d); return w; }
constexpr int E1_AW = 0, E1_AA = 9216, E1_AG = 18432, E1_PP = 40960, E1_PB = 106496;
__device__ __forceinline__ void e1_phase(const Args& a, int li, LAS unsigned char* ldsb, int vcu, int G, int tid) {
    unsigned char* ws = a.ws;
    const bf16* Z = (const bf16*)(ws + WS_ACT);
    bf16* R = (bf16*)(ws + SC_R); bf16* K2 = (bf16*)(ws + SC_K2); bf16* KK = (bf16*)(ws + SC_KK); bf16* BB = (bf16*)(ws + SC_BB); bf16* LW = (bf16*)(ws + SC_LW); bf16* GG = (bf16*)(ws + SC_GG);
    bf16* VO = (bf16*)(ws + (li ? WS_V2 : WS_VF)); const bf16* VF = (const bf16*)(ws + WS_VF);
    const bf16* W2T = (const bf16*)(ws + SM_W2T); const bf16* A2T = (const bf16*)(ws + SM_A2T); const bf16* G2T = (const bf16*)(ws + SM_G2T);
    const bf16* V1T = (const bf16*)(ws + SM_V1T); const bf16* V2T = (const bf16*)(ws + SM_V2T);
    const float* mu = a.in[I_EMU] + li * A_COLS;
    const float* w0 = a.in[I_EW0] + li * 1024; const float* a0 = a.in[I_EA0] + li * 1024;
    const float* kkw = a.in[I_EKK] + li * 1024; const float* kaw = a.in[I_EKA] + li * 1024; const float* v0w = a.in[I_V0];
    const int lane = tid & 63, wave = tid >> 6, fr = lane & 15, fq = lane >> 4;
    for (int unit = vcu; unit < M / 64; unit += G) {
        const int m0 = unit * 64;
        for (int e = tid; e < 64 * 36; e += NTHR) { const int r = e / 36, ch = e % 36, j0 = 8 * ch, m = m0 + r; const bool first = (m & (T - 1)) == 0;
            const v4u cur = *(const GAS v4u*)(Z + (size_t)m * ZN + ZA + 3072 + j0); v4u prv = {0u, 0u, 0u, 0u}; if (!first) prv = *(const GAS v4u*)(Z + (size_t)(m - 1) * ZN + ZA + 3072 + j0);
            float x[8]; lerp8(cur, prv, mu + 3072 + j0, x);
            if (j0 < 64) {
#pragma unroll
                for (int i = 0; i < 8; ++i) x[i] = fast_tanh(x[i]);
            } else if (j0 >= 128) {
#pragma unroll
                for (int i = 0; i < 8; ++i) x[i] = sigmoidf_(x[i]);
            }
            v4u o; o.x = pk2(x[0], x[1]); o.y = pk2(x[2], x[3]); o.z = pk2(x[4], x[5]); o.w = pk2(x[6], x[7]);
            LAS unsigned char* dst = j0 < 64 ? ldsb + E1_AW + r * 144 + j0 * 2 : j0 < 128 ? ldsb + E1_AA + r * 144 + (j0 - 64) * 2 : ldsb + E1_AG + r * 336 + (j0 - 128) * 2;
            *(LAS v4u*)dst = o; }
        if (li > 0) {
            f32x4 pacc[4][2];
#pragma unroll
            for (int mt = 0; mt < 4; ++mt) { pacc[mt][0] = (f32x4){0.f, 0.f, 0.f, 0.f}; pacc[mt][1] = pacc[mt][0]; }
            for (int ks = 0; ks < 4; ++ks) { const int c = 128 * wave + 32 * ks + 8 * fq;
                const bf16x8_t w0f = *(const GAS bf16x8_t*)(V1T + (size_t)fr * 1024 + c), w1f = *(const GAS bf16x8_t*)(V1T + (size_t)(16 + fr) * 1024 + c);
#pragma unroll
                for (int mt = 0; mt < 4; ++mt) { const int m = m0 + 16 * mt + fr; const bool first = (m & (T - 1)) == 0;
                    const v4u cur = *(const GAS v4u*)(Z + (size_t)m * ZN + ZA + 2048 + c); v4u prv = {0u, 0u, 0u, 0u}; if (!first) prv = *(const GAS v4u*)(Z + (size_t)(m - 1) * ZN + ZA + 2048 + c);
                    float x[8]; lerp8(cur, prv, mu + 2048 + c, x);
                    v4u o; o.x = pk2(x[0], x[1]); o.y = pk2(x[2], x[3]); o.z = pk2(x[4], x[5]); o.w = pk2(x[6], x[7]);
                    const bf16x8_t af = __builtin_bit_cast(bf16x8_t, o);
                    pacc[mt][0] = __builtin_amdgcn_mfma_f32_16x16x32_bf16(w0f, af, pacc[mt][0], 0, 0, 0); pacc[mt][1] = __builtin_amdgcn_mfma_f32_16x16x32_bf16(w1f, af, pacc[mt][1], 0, 0, 0); } }
#pragma unroll
            for (int mt = 0; mt < 4; ++mt)
#pragma unroll
                for (int nt = 0; nt < 2; ++nt) *(LAS f32x4*)(ldsb + E1_PP + ((wave * 64 + 16 * mt + fr) * 32 + 16 * nt + 4 * fq) * 4) = pacc[mt][nt];
        }
        __syncthreads();
        if (li > 0) {
            for (int e = tid; e < 64 * 32; e += NTHR) { float sum = 0.f;
#pragma unroll
                for (int w = 0; w < 8; ++w) sum += *(const LAS float*)(ldsb + E1_PP + (w * 2048 + e) * 4);
                *(LAS bf16*)(ldsb + E1_PB + (e >> 5) * 80 + (e & 31) * 2) = (bf16)f2bf(sum); }
            __syncthreads();
        }
#define E1_WROW(nt) (cb + 32 * ((nt) >> 1) + 8 * (fr >> 2) + 4 * ((nt) & 1) + (fr & 3))
#pragma unroll 1
        for (int hh = 0; hh < 2; ++hh) {
            const int cb = 128 * wave + 64 * hh;
            {
                bf16x8_t wa[4][2];
#pragma unroll
                for (int nt = 0; nt < 4; ++nt)
#pragma unroll
                    for (int ks = 0; ks < 2; ++ks) wa[nt][ks] = *(const GAS bf16x8_t*)(A2T + (size_t)E1_WROW(nt) * 64 + 32 * ks + 8 * fq);
#pragma unroll 1
                for (int mt = 0; mt < 4; ++mt) {
                    const int m = m0 + 16 * mt + fr; const bool first = (m & (T - 1)) == 0;
                    f32x4 aa[4];
#pragma unroll
                    for (int nt = 0; nt < 4; ++nt) aa[nt] = (f32x4){0.f, 0.f, 0.f, 0.f};
#pragma unroll
                    for (int ks = 0; ks < 2; ++ks) { const bf16x8_t fa = *(const LAS bf16x8_t*)(ldsb + E1_AA + (16 * mt + fr) * 144 + (32 * ks + 8 * fq) * 2);
#pragma unroll
                        for (int nt = 0; nt < 4; ++nt) aa[nt] = __builtin_amdgcn_mfma_f32_16x16x32_bf16(wa[nt][ks], fa, aa[nt], 0, 0, 0); }
                    const size_t zo = (size_t)m * ZN + ZA + cb + 8 * fq;
                    float k1[2][8], av[2][8], kk0[2][8]; float n2 = 0.f;
#pragma unroll
                    for (int p = 0; p < 2; ++p) { const int c = cb + 32 * p + 8 * fq;
                        const v4u cur = *(const GAS v4u*)(Z + zo + 1024 + 32 * p); v4u prv = {0u, 0u, 0u, 0u}; if (!first) prv = *(const GAS v4u*)(Z + zo - ZN + 1024 + 32 * p);
                        lerp8(cur, prv, mu + 1024 + c, k1[p]);
                        const f32x4 a00 = *(const f32x4*)(a0 + c), a01 = *(const f32x4*)(a0 + c + 4), kk00 = *(const f32x4*)(kkw + c), kk01 = *(const f32x4*)(kkw + c + 4);
#pragma unroll
                        for (int j = 0; j < 8; ++j) { const float a0j = j < 4 ? a00[j & 3] : a01[j & 3], kkj = j < 4 ? kk00[j & 3] : kk01[j & 3];
                            av[p][j] = sigmoidf_(a0j + aa[2 * p + (j >> 2)][j & 3]); kk0[p][j] = k1[p][j] * kkj; n2 += kk0[p][j] * kk0[p][j]; } }
                    n2 += __shfl_xor(n2, 16); n2 += __shfl_xor(n2, 32);
                    const float inv = 1.0f / fmaxf(sqrtf(n2), 1e-12f);
#pragma unroll
                    for (int p = 0; p < 2; ++p) { const int c = cb + 32 * p + 8 * fq; const size_t o = (size_t)m * 1024 + c; const f32x4 ka0 = *(const f32x4*)(kaw + c), ka1 = *(const f32x4*)(kaw + c + 4);
                        float kk[8], k2[8], bb[8];
#pragma unroll
                        for (int j = 0; j < 8; ++j) { const float kaj = j < 4 ? ka0[j & 3] : ka1[j & 3]; kk[j] = kk0[p][j] * inv; k2[j] = k1[p][j] * (1.0f + (av[p][j] - 1.0f) * kaj); bb[j] = kk[j] * av[p][j]; }
                        *(GAS v4u*)(KK + o) = (v4u){pk2(kk[0], kk[1]), pk2(kk[2], kk[3]), pk2(kk[4], kk[5]), pk2(kk[6], kk[7])};
                        *(GAS v4u*)(K2 + o) = (v4u){pk2(k2[0], k2[1]), pk2(k2[2], k2[3]), pk2(k2[4], k2[5]), pk2(k2[6], k2[7])};
                        *(GAS v4u*)(BB + o) = (v4u){pk2(bb[0], bb[1]), pk2(bb[2], bb[3]), pk2(bb[4], bb[5]), pk2(bb[6], bb[7])}; }
                }
            }
            {
                bf16x8_t ww[4][2];
#pragma unroll
                for (int nt = 0; nt < 4; ++nt)
#pragma unroll
                    for (int ks = 0; ks < 2; ++ks) ww[nt][ks] = *(const GAS bf16x8_t*)(W2T + (size_t)E1_WROW(nt) * 64 + 32 * ks + 8 * fq);
#pragma unroll 1
                for (int mt = 0; mt < 4; ++mt) {
                    const int m = m0 + 16 * mt + fr;
                    f32x4 aw[4];
#pragma unroll
                    for (int nt = 0; nt < 4; ++nt) aw[nt] = (f32x4){0.f, 0.f, 0.f, 0.f};
#pragma unroll
                    for (int ks = 0; ks < 2; ++ks) { const bf16x8_t fw = *(const LAS bf16x8_t*)(ldsb + E1_AW + (16 * mt + fr) * 144 + (32 * ks + 8 * fq) * 2);
#pragma unroll
                        for (int nt = 0; nt < 4; ++nt) aw[nt] = __builtin_amdgcn_mfma_f32_16x16x32_bf16(ww[nt][ks], fw, aw[nt], 0, 0, 0); }
#pragma unroll
                    for (int p = 0; p < 2; ++p) { const int c = cb + 32 * p + 8 * fq; const f32x4 w00 = *(const f32x4*)(w0 + c), w01 = *(const f32x4*)(w0 + c + 4); float lw[8];
#pragma unroll
                        for (int j = 0; j < 8; ++j) { const float y = -((j < 4 ? w00[j & 3] : w01[j & 3]) + aw[2 * p + (j >> 2)][j & 3]); const float sp = fmaxf(y, 0.f) + __logf(1.0f + __expf(-fabsf(y))); lw[j] = -__expf(-sp - 0.5f); }
                        *(GAS v4u*)(LW + (size_t)m * 1024 + c) = (v4u){pk2(lw[0], lw[1]), pk2(lw[2], lw[3]), pk2(lw[4], lw[5]), pk2(lw[6], lw[7])}; }
                }
            }
            {
                bf16x8_t wg[4][5];
#pragma unroll
                for (int nt = 0; nt < 4; ++nt)
#pragma unroll
                    for (int ks = 0; ks < 5; ++ks) wg[nt][ks] = *(const GAS bf16x8_t*)(G2T + (size_t)E1_WROW(nt) * 160 + 32 * ks + 8 * fq);
#pragma unroll 1
                for (int mt = 0; mt < 4; ++mt) {
                    const int m = m0 + 16 * mt + fr;
                    f32x4 ag[4];
#pragma unroll
                    for (int nt = 0; nt < 4; ++nt) ag[nt] = (f32x4){0.f, 0.f, 0.f, 0.f};
#pragma unroll
                    for (int ks = 0; ks < 5; ++ks) { const bf16x8_t fg = *(const LAS bf16x8_t*)(ldsb + E1_AG + (16 * mt + fr) * 336 + (32 * ks + 8 * fq) * 2);
#pragma unroll
                        for (int nt = 0; nt < 4; ++nt) ag[nt] = __builtin_amdgcn_mfma_f32_16x16x32_bf16(wg[nt][ks], fg, ag[nt], 0, 0, 0); }
#pragma unroll
                    for (int p = 0; p < 2; ++p) *(GAS v4u*)(GG + (size_t)m * 1024 + cb + 32 * p + 8 * fq) = (v4u){pk2(ag[2 * p][0], ag[2 * p][1]), pk2(ag[2 * p][2], ag[2 * p][3]), pk2(ag[2 * p + 1][0], ag[2 * p + 1][1]), pk2(ag[2 * p + 1][2], ag[2 * p + 1][3])};
                }
            }
            {
                bf16x8_t wv2[4];
#pragma unroll
                for (int nt = 0; nt < 4; ++nt) { wv2[nt] = (bf16x8_t){0, 0, 0, 0, 0, 0, 0, 0}; if (li > 0) wv2[nt] = *(const GAS bf16x8_t*)(V2T + (size_t)E1_WROW(nt) * 32 + 8 * fq); }
#pragma unroll 1
                for (int mt = 0; mt < 4; ++mt) {
                    const int m = m0 + 16 * mt + fr; const bool first = (m & (T - 1)) == 0;
                    f32x4 avr[4];
#pragma unroll
                    for (int nt = 0; nt < 4; ++nt) avr[nt] = (f32x4){0.f, 0.f, 0.f, 0.f};
                    if (li > 0) { const bf16x8_t fp = *(const LAS bf16x8_t*)(ldsb + E1_PB + (16 * mt + fr) * 80 + (8 * fq) * 2);
#pragma unroll
                        for (int nt = 0; nt < 4; ++nt) avr[nt] = __builtin_amdgcn_mfma_f32_16x16x32_bf16(wv2[nt], fp, avr[nt], 0, 0, 0); }
                    const size_t zo = (size_t)m * ZN + ZA + cb + 8 * fq;
#pragma unroll
                    for (int p = 0; p < 2; ++p) { const int c = cb + 32 * p + 8 * fq; const size_t o = (size_t)m * 1024 + c;
                        const v4u rc = *(const GAS v4u*)(Z + zo + 32 * p), vc = *(const GAS v4u*)(Z + zo + 2048 + 32 * p); v4u rp = {0u, 0u, 0u, 0u}, vp = {0u, 0u, 0u, 0u};
                        if (!first) { rp = *(const GAS v4u*)(Z + zo - ZN + 32 * p); vp = *(const GAS v4u*)(Z + zo - ZN + 2048 + 32 * p); }
                        float rr[8], vv[8]; lerp8(rc, rp, mu + c, rr); lerp8(vc, vp, mu + 2048 + c, vv);
                        if (li > 0) { const f32x4 v00 = *(const f32x4*)(v0w + c), v01 = *(const f32x4*)(v0w + c + 4); const v4u vf = *(const GAS v4u*)(VF + o);
                            const float f[8] = {bflo(vf.x), bfhi(vf.x), bflo(vf.y), bfhi(vf.y), bflo(vf.z), bfhi(vf.z), bflo(vf.w), bfhi(vf.w)};
#pragma unroll
                            for (int j = 0; j < 8; ++j) vv[j] += (f[j] - vv[j]) * sigmoidf_((j < 4 ? v00[j & 3] : v01[j & 3]) + avr[2 * p + (j >> 2)][j & 3]); }
                        *(GAS v4u*)(R + o) = (v4u){pk2(rr[0], rr[1]), pk2(rr[2], rr[3]), pk2(rr[4], rr[5]), pk2(rr[6], rr[7])};
                        *(GAS v4u*)(VO + o) = (v4u){pk2(vv[0], vv[1]), pk2(vv[2], vv[3]), pk2(vv[4], vv[5]), pk2(vv[6], vv[7])}; }
                }
            }
        }
#undef E1_WROW
        __syncthreads();
    }
}

constexpr size_t CS_AR = WS_ACT, CS_BK = WS_ACT + 128 * MiB, CS_Y0 = WS_ACT + 256 * MiB, CS_GL = WS_ACT + 320 * MiB;
__device__ __forceinline__ int cs_perm(int k) { return (k & 32) + 8 * ((k >> 2) & 3) + 4 * ((k >> 4) & 1) + (k & 3); }
__device__ __forceinline__ f32x4 mm16_ll(const LAS float* A, const LAS float* B, f32x4 c, int fr, int fq) {
    const f32x4 a4 = *(const LAS f32x4*)(A + fr * 16 + 4 * fq);
#pragma unroll
    for (int s = 0; s < 4; ++s) c = __builtin_amdgcn_mfma_f32_16x16x4f32(a4[s], B[(4 * fq + s) * 16 + fr], c, 0, 0, 0);
    return c;
}
__device__ __forceinline__ f32x4 mm16_la(const LAS float* A, const f32x4 b, f32x4 c, int fr, int fq) {
    const f32x4 a4 = *(const LAS f32x4*)(A + fr * 16 + 4 * fq);
#pragma unroll
    for (int s = 0; s < 4; ++s) c = __builtin_amdgcn_mfma_f32_16x16x4f32(a4[s], b[s], c, 0, 0, 0);
    return c;
}
__device__ __forceinline__ void st16(LAS float* Mx, const f32x4 c, int fr, int fq) {
#pragma unroll
    for (int r = 0; r < 4; ++r) Mx[(4 * fq + r) * 16 + fr] = c[r];
}
__device__ __forceinline__ void scanpre_phase(const Args& a, int li, LAS unsigned char* ldsb, int vcu, int G, int tid) {
    unsigned char* ws = a.ws;
    const bf16* Rr = (const bf16*)(ws + SC_R); const bf16* K2 = (const bf16*)(ws + SC_K2); const bf16* KK = (const bf16*)(ws + SC_KK); const bf16* BB = (const bf16*)(ws + SC_BB); const bf16* LW = (const bf16*)(ws + SC_LW);
    const bf16* V = (const bf16*)(ws + (li ? WS_V2 : WS_VF));
    bf16* ARo = (bf16*)(ws + CS_AR); bf16* BKo = (bf16*)(ws + CS_BK); bf16* Y0o = (bf16*)(ws + CS_Y0); float* GLo = (float*)(ws + CS_GL); bf16* U0o = (bf16*)(ws + WS_U0);
    const int lane = tid & 63, wave = tid >> 6, fr = lane & 15, fq = lane >> 4;
    LAS unsigned char* wl = ldsb + wave * 17408;
    LAS bf16* LAR = (LAS bf16*)wl; LAS bf16* LBK = (LAS bf16*)(wl + 4608); LAS float* LM = (LAS float*)(wl + 9216); LAS float* LX = (LAS float*)(wl + 13312);
    const LAS float* Mab = LM, *Mak = LM + 256, *Mrb = LM + 512, *Mrk = LM + 768;
    LAS float* Tm = LX, *Na = LX + 256, *Nb = LX + 512;
    for (int ch = vcu * NWAVES + wave; ch < 32 * 1024; ch += G * NWAVES) {
        const int bh = ch >> 10, ci = ch & 1023, b = bh >> 4, h = bh & 15; const size_t row0 = (size_t)b * T + 16 * ci;
        f32x4 At[4], Rt[4], vv[4]; float glane;
#pragma unroll
        for (int nt = 0; nt < 4; ++nt) { f32x4 lw, kk, bb, k2, rr;
#pragma unroll
            for (int s = 0; s < 4; ++s) { const size_t o = (row0 + 4 * fq + s) * 1024 + h * 64 + 16 * nt + fr;
                lw[s] = bf2f(LW[o]); kk[s] = bf2f(KK[o]); bb[s] = bf2f(BB[o]); k2[s] = bf2f(K2[o]); rr[s] = bf2f(Rr[o]); vv[nt][s] = bf2f(V[o]); }
            f32x4 cum; cum[0] = lw[0]; cum[1] = cum[0] + lw[1]; cum[2] = cum[1] + lw[2]; cum[3] = cum[2] + lw[3];
            float x = cum[3]; { const float y = __shfl_up(x, 16); if (fq >= 1) x += y; } { const float y = __shfl_up(x, 32); if (fq >= 2) x += y; }
            const float excl = x - cum[3]; const float cl = __shfl(x, 48 + fr);
            bf16* bo = BKo + (size_t)ch * 2048 + (16 * nt + fr) * 32 + 8 * fq; f32x4 bh4, kh4;
#pragma unroll
            for (int s = 0; s < 4; ++s) { const float c = excl + cum[s]; const float g = __expf(c), gp = __expf(c - lw[s]), gi = __expf(-c), e = __expf(cl - c);
                At[nt][s] = -kk[s] * gp; Rt[nt][s] = rr[s] * g; bh4[s] = bb[s] * e; kh4[s] = k2[s] * e;
                const int t = 4 * fq + s, cc = 16 * nt + fr;
                LAR[t * 72 + cc] = (bf16)f2bf(At[nt][s]); LAR[(16 + t) * 72 + cc] = (bf16)f2bf(Rt[nt][s]); LBK[t * 72 + cc] = (bf16)f2bf(bb[s] * gi); LBK[(16 + t) * 72 + cc] = (bf16)f2bf(k2[s] * gi); }
            *(GAS v4u*)bo = (v4u){pk2(bh4[0], bh4[1]), pk2(bh4[2], bh4[3]), pk2(kh4[0], kh4[1]), pk2(kh4[2], kh4[3])};
            if (fq == 0) GLo[(size_t)ch * 64 + 16 * nt + fr] = __expf(cl);
            glane = cl; }
        (void)glane;
        LDS_WAIT(); asm volatile("" ::: "memory");
#pragma unroll
        for (int mt = 0; mt < 2; ++mt)
#pragma unroll
            for (int nt = 0; nt < 2; ++nt) { f32x4 m = {0.f, 0.f, 0.f, 0.f};
#pragma unroll
                for (int ks = 0; ks < 2; ++ks) { const bf16x8_t af = *(const LAS bf16x8_t*)(LAR + (16 * mt + fr) * 72 + 32 * ks + 8 * fq), bfr = *(const LAS bf16x8_t*)(LBK + (16 * nt + fr) * 72 + 32 * ks + 8 * fq);
                    m = __builtin_amdgcn_mfma_f32_16x16x32_bf16(af, bfr, m, 0, 0, 0); }
#pragma unroll
                for (int r = 0; r < 4; ++r) { const int t = 4 * fq + r; const bool keep = mt ? (fr <= t) : (fr < t); LM[((mt * 2 + nt) * 16 + t) * 16 + fr] = keep ? m[r] : 0.f; } }
        LDS_WAIT(); asm volatile("" ::: "memory");
        { const f32x4 z = {0.f, 0.f, 0.f, 0.f};
          f32x4 t1;
#pragma unroll
          for (int r = 0; r < 4; ++r) t1[r] = Mab[(4 * fq + r) * 16 + fr] + ((4 * fq + r) == fr ? 1.0f : 0.f);
          st16(Tm, t1, fr, fq);
          f32x4 n2 = mm16_ll(Mab, Mab, z, fr, fq); st16(Na, n2, fr, fq);
          LDS_WAIT(); asm volatile("" ::: "memory");
          f32x4 t2 = mm16_ll(Tm, Na, t1, fr, fq);
          f32x4 n4 = mm16_ll(Na, Na, z, fr, fq);
          LDS_WAIT(); asm volatile("" ::: "memory");
          st16(Tm, t2, fr, fq); st16(Nb, n4, fr, fq);
          LDS_WAIT(); asm volatile("" ::: "memory");
          f32x4 t3 = mm16_ll(Tm, Nb, t2, fr, fq);
          f32x4 n8 = mm16_ll(Nb, Nb, z, fr, fq);
          LDS_WAIT(); asm volatile("" ::: "memory");
          st16(Tm, t3, fr, fq); st16(Na, n8, fr, fq);
          LDS_WAIT(); asm volatile("" ::: "memory");
          f32x4 t4 = mm16_ll(Tm, Na, t3, fr, fq);
          LDS_WAIT(); asm volatile("" ::: "memory");
          st16(Tm, t4, fr, fq);
          LDS_WAIT(); asm volatile("" ::: "memory"); }
#pragma unroll
        for (int nt = 0; nt < 4; ++nt) { const f32x4 z = {0.f, 0.f, 0.f, 0.f};
            const f32x4 w1 = mm16_la(Mak, vv[nt], z, fr, fq);
            const f32x4 u0 = mm16_la(Tm, w1, z, fr, fq);
            const f32x4 ah = mm16_la(Tm, At[nt], z, fr, fq);
            const f32x4 rh = mm16_la(Mrb, ah, Rt[nt], fr, fq);
            f32x4 y0 = mm16_la(Mrb, u0, z, fr, fq); y0 = mm16_la(Mrk, vv[nt], y0, fr, fq);
            const int k = 16 * nt + fr; bf16* arp = ARo + (size_t)ch * 2048 + cs_perm(k);
#pragma unroll
            for (int s = 0; s < 4; ++s) { arp[(4 * fq + s) * 64] = (bf16)f2bf(ah[s]); arp[(16 + 4 * fq + s) * 64] = (bf16)f2bf(rh[s]); }
            *(GAS v2u*)(Y0o + (size_t)ch * 1024 + k * 16 + 4 * fq) = pack4(y0[0], y0[1], y0[2], y0[3]);
            *(GAS v2u*)(U0o + (size_t)ch * 1024 + k * 16 + 4 * fq) = pack4(u0[0], u0[1], u0[2], u0[3]); }
        LDS_WAIT(); asm volatile("" ::: "memory");
    }
}
#ifndef PF_ON
#define PF_ON 0
#endif
constexpr int CQ_NS = 13, CQ_SLOT = 10240, CQ_FULL = CQ_NS * CQ_SLOT, CQ_DONE = CQ_FULL + 64, CQ_NL = 6;
#define CQ_GLDS(src, dst) __builtin_amdgcn_global_load_lds((const unsigned*)(src), (LAS unsigned*)(dst), 16, 0, 0)
struct CqOps { bf16x8_t ar[2][2], bk[4]; f32x4 gl[4]; v2u u0, y0; unsigned vs[4]; };
__device__ __forceinline__ void cq_load(CqOps& o, LAS unsigned char* sl, int fr, int fq) {
#pragma unroll
    for (int mt = 0; mt < 2; ++mt)
#pragma unroll
        for (int ks = 0; ks < 2; ++ks) { const int r = 16 * mt + fr; o.ar[mt][ks] = *(const LAS bf16x8_t*)(sl + r * 128 + 16 * ((4 * ks + fq) ^ (r & 7))); }
#pragma unroll
    for (int kt = 0; kt < 4; ++kt) { const int k = 16 * kt + fr; o.bk[kt] = *(const LAS bf16x8_t*)(sl + 4096 + k * 64 + 16 * (fq ^ ((k >> 2) & 3))); o.gl[kt] = *(const LAS f32x4*)(sl + 9728 + (16 * kt + 4 * fq) * 4); }
    o.u0 = *(const LAS v2u*)(sl + 8192 + fr * 32 + 8 * fq); o.y0 = *(const LAS v2u*)(sl + 8704 + fr * 32 + 8 * fq);
#pragma unroll
    for (int j = 0; j < 4; ++j) o.vs[j] = *(const LAS unsigned short*)(sl + 9216 + (4 * fq + j) * 32 + 2 * fr);
}
__device__ __forceinline__ void cq_step(int c, const CqOps& cur, CqOps& nxt, f32x4 (&St)[4], LAS unsigned char* ldsb, volatile LAS unsigned* FULL, volatile LAS unsigned* DONE, float* Yp, int fr, int fq, int lane, unsigned& spins) {
    const int cn = c + 1 < 1024 ? c + 1 : 1023, sn = cn % CQ_NS; LAS unsigned char* sln = ldsb + sn * CQ_SLOT;
    unsigned fl = FULL[sn];
    bf16x8_t sb[2];
#pragma unroll
    for (int ks = 0; ks < 2; ++ks) { v4u w; w.x = pk2(St[2 * ks][0], St[2 * ks][1]); w.y = pk2(St[2 * ks][2], St[2 * ks][3]); w.z = pk2(St[2 * ks + 1][0], St[2 * ks + 1][1]); w.w = pk2(St[2 * ks + 1][2], St[2 * ks + 1][3]); sb[ks] = __builtin_bit_cast(bf16x8_t, w); }
    f32x4 au = {0.f, 0.f, 0.f, 0.f}, ay = {0.f, 0.f, 0.f, 0.f};
#pragma unroll
    for (int ks = 0; ks < 2; ++ks) { au = __builtin_amdgcn_mfma_f32_16x16x32_bf16(cur.ar[0][ks], sb[ks], au, 0, 0, 0); ay = __builtin_amdgcn_mfma_f32_16x16x32_bf16(cur.ar[1][ks], sb[ks], ay, 0, 0, 0); }
    while ((unsigned)__builtin_amdgcn_readfirstlane(fl) != (unsigned)(cn + 1)) { fl = FULL[sn]; if (++spins > (1u << 26)) break; }
    __builtin_amdgcn_fence(__ATOMIC_ACQUIRE, "workgroup");
    cq_load(nxt, sln, fr, fq);
    { float* yr = Yp + (size_t)c * 16384;
      yr[0] = ay[0] + bflo(cur.y0.x); yr[1024] = ay[1] + bfhi(cur.y0.x); yr[2048] = ay[2] + bflo(cur.y0.y); yr[3072] = ay[3] + bfhi(cur.y0.y); }
    v4u uw; uw.x = pk2(au[0] + bflo(cur.u0.x), au[1] + bfhi(cur.u0.x)); uw.y = pk2(au[2] + bflo(cur.u0.y), au[3] + bfhi(cur.u0.y)); uw.z = cur.vs[0] | (cur.vs[1] << 16); uw.w = cur.vs[2] | (cur.vs[3] << 16);
    const bf16x8_t uv = __builtin_bit_cast(bf16x8_t, uw);
#pragma unroll
    for (int kt = 0; kt < 4; ++kt) St[kt] = __builtin_amdgcn_mfma_f32_16x16x32_bf16(cur.bk[kt], uv, St[kt] * cur.gl[kt], 0, 0, 0);
    __builtin_amdgcn_s_waitcnt(0xC07F);
    if (lane == 0) DONE[0] = (unsigned)(cn + 1);
}
__device__ __forceinline__ void scanseq_phase(const Args& a, int li, LAS unsigned char* ldsb, int vcu, int tid) {
    volatile LAS unsigned* FULL = (volatile LAS unsigned*)(ldsb + CQ_FULL); volatile LAS unsigned* DONE = (volatile LAS unsigned*)(ldsb + CQ_DONE);
    if (tid < 32) ((LAS unsigned*)(ldsb + CQ_FULL))[tid] = 0u;
    __syncthreads();
    const int wave = __builtin_amdgcn_readfirstlane(tid >> 6), lane = tid & 63;
    if (vcu < 128 && wave <= CQ_NL) {
        unsigned char* ws = a.ws;
        const int bh = vcu >> 2, vb = vcu & 3, b = bh >> 4, h = bh & 15; const size_t row0 = (size_t)b * T; const size_t ch0 = (size_t)bh * 1024;
        if (wave > 0) {
            const unsigned char* ARo = ws + CS_AR; const unsigned char* BKo = ws + CS_BK; const unsigned char* Y0o = ws + CS_Y0; const unsigned char* GLo = ws + CS_GL; const unsigned char* U0o = ws + WS_U0;
            const unsigned char* V = ws + (li ? WS_V2 : WS_VF);
            const unsigned oAR = (unsigned)((lane >> 3) * 128 + 16 * ((lane & 7) ^ ((lane >> 3) & 7)));
            unsigned oBK[4];
#pragma unroll
            for (int i = 0; i < 4; ++i) { const int k = 16 * i + (lane >> 2); oBK[i] = (unsigned)(k * 64 + 16 * ((lane & 3) ^ ((k >> 2) & 3))); }
            const unsigned oUY = (unsigned)((16 * vb + ((lane & 31) >> 1)) * 32 + 16 * (lane & 1));
            const size_t oV = ((size_t)(lane >> 1) * 1024 + h * 64 + 16 * vb) * 2 + 16 * (lane & 1);
            const unsigned oG = (unsigned)(16 * (lane & 15));
            int pub = wave - 1; unsigned spins = 0;
            for (int c = wave - 1; c < 1024; c += CQ_NL) {
                const int s = c % CQ_NS;
                if (c >= CQ_NS) { while ((int)DONE[0] < c - CQ_NS + 1) { __builtin_amdgcn_s_sleep(1); if (++spins > (1u << 24)) break; } }
                LAS unsigned char* sl = ldsb + s * CQ_SLOT; const size_t ch = ch0 + c;
                const unsigned char* ar = ARo + ch * 4096; const unsigned char* bk = BKo + ch * 4096;
#pragma unroll
                for (int i = 0; i < 4; ++i) CQ_GLDS(ar + i * 1024 + oAR, sl + i * 1024);
#pragma unroll
                for (int i = 0; i < 4; ++i) CQ_GLDS(bk + oBK[i], sl + 4096 + i * 1024);
                CQ_GLDS((lane < 32 ? U0o : Y0o) + ch * 2048 + oUY, sl + 8192);
                CQ_GLDS(lane < 32 ? V + (row0 + 16 * (size_t)c) * 2048 + oV : GLo + ch * 256 + oG, sl + 9216);
                asm volatile("s_waitcnt vmcnt(10)" ::: "memory");
                for (; pub <= c - CQ_NL; pub += CQ_NL) FULL[pub % CQ_NS] = (unsigned)(pub + 1);
            }
            asm volatile("s_waitcnt vmcnt(0)" ::: "memory");
            for (; pub < 1024; pub += CQ_NL) FULL[pub % CQ_NS] = (unsigned)(pub + 1);
        } else {
            float* Y = a.out;
            const int fr = lane & 15, fq = lane >> 4; const int colv = h * 64 + 16 * vb + fr;
            f32x4 St[4];
#pragma unroll
            for (int kt = 0; kt < 4; ++kt) St[kt] = (f32x4){0.f, 0.f, 0.f, 0.f};
            unsigned spins = 0;
            CqOps oa, ob;
            while (FULL[0] != 1u) { if (++spins > (1u << 26)) break; }
            __builtin_amdgcn_fence(__ATOMIC_ACQUIRE, "workgroup");
            cq_load(oa, ldsb, fr, fq);
            __builtin_amdgcn_s_waitcnt(0xC07F);
            if (lane == 0) DONE[0] = 1u;
            float* Yp = Y + (row0 + 4 * fq) * 1024 + colv;
            for (int c = 0; c < 1024; c += 2) {
                cq_step(c, oa, ob, St, ldsb, FULL, DONE, Yp, fr, fq, lane, spins);
                cq_step(c + 1, ob, oa, St, ldsb, FULL, DONE, Yp, fr, fq, lane, spins);
            }
#ifdef PROBE_STAMP
            if (lane == 0) atomicAdd((unsigned*)(ws + WS_CTL) + 24576 + (vcu & 127), spins);
#endif
        }
    }
    if (PF_ON && vcu >= 128 && vcu < 256) {
        unsigned char* ws = a.ws; const int pv = vcu - 128; const int bh = pv >> 2, vb = pv & 3, b = bh >> 4, h = bh & 15; const size_t row0 = (size_t)b * T; const size_t ch0 = (size_t)bh * 1024;
        const unsigned char* ARo = ws + CS_AR; const unsigned char* BKo = ws + CS_BK; const unsigned char* Y0o = ws + CS_Y0; const unsigned char* GLo = ws + CS_GL; const unsigned char* U0o = ws + WS_U0;
        const unsigned char* V = ws + (li ? WS_V2 : WS_VF);
        unsigned x = 0u;
        for (int c0 = wave * 4; c0 < 1024; c0 += 32) {
            unsigned t[8];
#pragma unroll
            for (int j = 0; j < 4; ++j) { const int c = c0 + j; const size_t ch = ch0 + c;
                const unsigned char* p0 = lane < 32 ? ARo + ch * 4096 + lane * 128 : BKo + ch * 4096 + (lane - 32) * 128;
                const unsigned char* p1 = lane < 4 ? U0o + ch * 2048 + 512 * vb + lane * 128 : lane < 8 ? Y0o + ch * 2048 + 512 * vb + (lane - 4) * 128
                                        : lane < 24 ? V + ((row0 + 16 * (size_t)c + (lane - 8)) * 1024 + h * 64 + 16 * vb) * 2 : GLo + ch * 256 + (lane & 1) * 128;
                t[2 * j] = *(const volatile GAS unsigned*)p0; t[2 * j + 1] = *(const volatile GAS unsigned*)p1; }
#pragma unroll
            for (int j = 0; j < 8; ++j) x ^= t[j];
        }
        if (x == 0x9e3779b9u && li == 77) *(volatile GAS unsigned*)(ws + WS_CTL + 65536) = x;
    }
    __syncthreads();
}

typedef float f32x16 __attribute__((ext_vector_type(16)));
constexpr int AT_K = 0, AT_V = 36864;
__device__ __forceinline__ bf16x8_t tr_frag(unsigned addr) {
    v2u lo, hi; asm volatile("ds_read_b64_tr_b16 %0, %2\n\tds_read_b64_tr_b16 %1, %2 offset:1536\n\ts_waitcnt lgkmcnt(0)" : "=&v"(lo), "=&v"(hi) : "v"(addr) : "memory");
    v4u w; w.x = lo.x; w.y = lo.y; w.z = hi.x; w.w = hi.y; return __builtin_bit_cast(bf16x8_t, w);
}
__device__ __forceinline__ void attn_unit(const Args& a, int li, int au, LAS unsigned char* ldsb, int tid) {
    unsigned char* ws = a.ws; const bf16* Z = (const bf16*)(ws + WS_ACT); bf16* O = (bf16*)(ws + WS_O);
    const int n = au & 127, kvh = (au >> 7) & 3, b = au >> 9;
    const size_t rblk = (size_t)b * T + (size_t)n * 128;
    for (int e = tid; e < 256 * 8 * 2; e += NTHR) { const int which = e >> 11, rem = e & 2047, j = rem >> 3, c8 = rem & 7; const bool valid = (n > 0) || (j >= 128);
        v4u w = {0u, 0u, 0u, 0u}; if (valid) w = *(const GAS v4u*)(Z + (rblk + j - 128) * ZN + 1024 + which * 256 + kvh * 64 + 8 * c8);
        *(LAS v4u*)(ldsb + (which ? AT_V + j * 192 : AT_K + j * 144) + c8 * 16) = w; }
    __syncthreads();
    const int lane = tid & 63, wave = tid >> 6, l31 = lane & 31, h = lane >> 5;
    const unsigned ldsbase = (unsigned)(size_t)ldsb;
#pragma unroll 1
    for (int it = 0; it < 2; ++it) {
        const int tt = 2 * wave + it, g = tt >> 2, qi = tt & 3, hq = kvh * 4 + g; const size_t qrow = rblk + 32 * qi + l31;
        bf16x8_t qf[4];
#pragma unroll
        for (int ks = 0; ks < 4; ++ks) qf[ks] = *(const GAS bf16x8_t*)(Z + qrow * ZN + hq * 64 + 16 * ks + 8 * h);
        f32x16 st[5];
#pragma unroll
        for (int kt = 0; kt < 5; ++kt) {
#pragma unroll
            for (int r = 0; r < 16; ++r) st[kt][r] = 0.f;
#pragma unroll
            for (int ks = 0; ks < 4; ++ks) { const bf16x8_t kf = *(const LAS bf16x8_t*)(ldsb + AT_K + (32 * (qi + kt) + l31) * 144 + (16 * ks + 8 * h) * 2);
                st[kt] = __builtin_amdgcn_mfma_f32_32x32x16_bf16(kf, qf[ks], st[kt], 0, 0, 0); } }
        const float slope = exp2f(-0.5f * (float)(hq + 1)); const float sink = a.in[I_ESINK][li * 16 + hq];
        float mx = sink;
#pragma unroll
        for (int kt = 0; kt < 5; ++kt)
#pragma unroll
            for (int r = 0; r < 16; ++r) { const int j = 32 * (qi + kt) + (r & 3) + 8 * (r >> 2) + 4 * h; const int dist = 32 * qi + l31 + 128 - j;
                const bool ok = (dist >= 0) && (dist < 128) && ((n > 0) || (j >= 128));
                const float s = ok ? st[kt][r] * 0.125f - slope * (float)dist : -INFINITY; st[kt][r] = s; mx = fmaxf(mx, s); }
        mx = fmaxf(mx, __shfl_xor(mx, 32));
        float l = 0.f;
#pragma unroll
        for (int kt = 0; kt < 5; ++kt)
#pragma unroll
            for (int r = 0; r < 16; ++r) { const float p = __expf(st[kt][r] - mx); st[kt][r] = p; l += p; }
        l += __shfl_xor(l, 32); l += __expf(sink - mx);
        f32x16 ot[2];
#pragma unroll
        for (int r = 0; r < 16; ++r) { ot[0][r] = 0.f; ot[1][r] = 0.f; }
#pragma unroll
        for (int kt = 0; kt < 5; ++kt)
#pragma unroll
            for (int s2 = 0; s2 < 2; ++s2) {
                v4u pw; pw.x = pk2(st[kt][8 * s2 + 0], st[kt][8 * s2 + 1]); pw.y = pk2(st[kt][8 * s2 + 2], st[kt][8 * s2 + 3]); pw.z = pk2(st[kt][8 * s2 + 4], st[kt][8 * s2 + 5]); pw.w = pk2(st[kt][8 * s2 + 6], st[kt][8 * s2 + 7]);
                const bf16x8_t pf = __builtin_bit_cast(bf16x8_t, pw);
#pragma unroll
                for (int db = 0; db < 2; ++db) {
                    const unsigned va = ldsbase + AT_V + (unsigned)(32 * (qi + kt) + 16 * s2 + 4 * h + ((lane & 15) >> 2)) * 192u + (unsigned)(32 * db + 16 * ((lane >> 4) & 1) + 4 * (lane & 3)) * 2u;
                    const bf16x8_t vf = tr_frag(va);
                    ot[db] = __builtin_amdgcn_mfma_f32_32x32x16_bf16(vf, pf, ot[db], 0, 0, 0); } }
        const float inv = 1.0f / l;
#pragma unroll
        for (int db = 0; db < 2; ++db)
#pragma unroll
            for (int g4 = 0; g4 < 4; ++g4)
                *(GAS v2u*)(O + qrow * D + 1024 + hq * 64 + 32 * db + 8 * g4 + 4 * h) = pack4(ot[db][4 * g4] * inv, ot[db][4 * g4 + 1] * inv, ot[db][4 * g4 + 2] * inv, ot[db][4 * g4 + 3] * inv);
    }
    __syncthreads();
}

__device__ __forceinline__ void e3_phase(const Args& a, int li, int vcu, int G, int tid) {
    unsigned char* ws = a.ws; const float* Y = a.out;
    const bf16* R = (const bf16*)(ws + SC_R); const bf16* K2 = (const bf16*)(ws + SC_K2); const bf16* GG = (const bf16*)(ws + SC_GG); const bf16* V = (const bf16*)(ws + (li ? WS_V2 : WS_VF));
    bf16* O = (bf16*)(ws + WS_O);
    const float* rk = a.in[I_ERK] + li * 1024; const float* gng = a.in[I_EGNG] + li * 1024; const float* gnb = a.in[I_EGNB] + li * 1024;
    for (size_t e4 = (size_t)vcu * NTHR + tid; e4 < (size_t)M * 256; e4 += (size_t)G * NTHR) {
        const size_t row = e4 >> 8; const int c = (int)(e4 & 255) * 4; const size_t e = row * 1024 + c;
        const f32x4 y = *(const GAS f32x4*)(Y + e);
        const v2u rw = *(const GAS v2u*)(R + e), kw = *(const GAS v2u*)(K2 + e), vw = *(const GAS v2u*)(V + e), gw = *(const GAS v2u*)(GG + e);
        const f32x4 rkv = *(const f32x4*)(rk + c), ggv = *(const f32x4*)(gng + c), gbv = *(const f32x4*)(gnb + c);
        const float mean = row16_sum((y.x + y.y) + (y.z + y.w)) * (1.0f / 64.0f);
        const f32x4 d = y - mean;
        const float var = row16_sum((d.x * d.x + d.y * d.y) + (d.z * d.z + d.w * d.w)) * (1.0f / 64.0f);
        const float rs = rsqrtf(var + 64e-5f);
        const float r0 = bflo(rw.x), r1 = bfhi(rw.x), r2 = bflo(rw.y), r3 = bfhi(rw.y), k0 = bflo(kw.x), k1 = bfhi(kw.x), k2 = bflo(kw.y), k3 = bfhi(kw.y);
        const float bonus = row16_sum((r0 * k0 * rkv.x + r1 * k1 * rkv.y) + (r2 * k2 * rkv.z + r3 * k3 * rkv.w));
        const float o0 = (d.x * rs * ggv.x + gbv.x + bonus * bflo(vw.x)) * bflo(gw.x), o1 = (d.y * rs * ggv.y + gbv.y + bonus * bfhi(vw.x)) * bfhi(gw.x);
        const float o2 = (d.z * rs * ggv.z + gbv.z + bonus * bflo(vw.y)) * bflo(gw.y), o3 = (d.w * rs * ggv.w + gbv.w + bonus * bfhi(vw.y)) * bfhi(gw.y);
        *(GAS v2u*)(O + row * D + c) = pack4(o0, o1, o2, o3);
    }
}

constexpr int SG_W = 0, SG_V = 34816;
__device__ __forceinline__ unsigned sg_off(unsigned row, unsigned ch) { return 256u * row + 16u * (ch ^ (((row & 3u) << 2) | ((row >> 2) & 3u))); }
__device__ __forceinline__ bf16x8_t tr_frag2(unsigned a0, unsigned a1) {
    v2u lo, hi; asm volatile("ds_read_b64_tr_b16 %0, %2\n\tds_read_b64_tr_b16 %1, %3\n\ts_waitcnt lgkmcnt(0)" : "=&v"(lo), "=&v"(hi) : "v"(a0), "v"(a1) : "memory");
    v4u w; w.x = lo.x; w.y = lo.y; w.z = hi.x; w.w = hi.y; return __builtin_bit_cast(bf16x8_t, w);
}
__device__ __forceinline__ void sgu_phase(const Args& a, int li, LAS unsigned char* ldsb, int vcu, int G, int tid) {
    unsigned char* ws = a.ws; const bf16* Z = (const bf16*)(ws + WS_ACT); bf16* O = (bf16*)(ws + WS_O);
    const float* ssv = (const float*)(ws + WS_SS) + (size_t)(13 + li) * SS_REC;
    const bf16* WSB = (const bf16*)(ws + SM_WSB); const float* bs = a.in[I_OBS] + li * 16 * 128; const float* vng = a.in[I_OVNG] + li * D;
    const int lane = tid & 63, wave = tid >> 6, fr = lane & 15, fq = lane >> 4;
    const unsigned ldsbase = (unsigned)(size_t)ldsb;
    int gcur = -1;
    for (int u = vcu; u < 4096; u += G) {
        const int g = u & 15, bn = u >> 4; const size_t m0 = (size_t)bn * 128;
        __syncthreads();
        if (g != gcur) { gcur = g;
            for (int e = tid; e < 128 * 16; e += NTHR) { const int i = e >> 4, ch = e & 15; *(LAS v4u*)(ldsb + SG_W + i * 272 + ch * 16) = *(const GAS v4u*)(WSB + ((size_t)g * 128 + i) * 128 + 8 * ch); } }
        for (int e = tid; e < 128 * 16; e += NTHR) { const int j = e >> 4, ch = e & 15; const float rs = pg8::row_rs(ssv, (int)(m0 + j));
            const v4u w = *(const GAS v4u*)(Z + (m0 + j) * ZO + 2048 + g * 128 + 8 * ch); v4u o;
            o.x = pk2(bflo(w.x) * rs, bfhi(w.x) * rs); o.y = pk2(bflo(w.y) * rs, bfhi(w.y) * rs); o.z = pk2(bflo(w.z) * rs, bfhi(w.z) * rs); o.w = pk2(bflo(w.w) * rs, bfhi(w.w) * rs);
            *(LAS v4u*)(ldsb + SG_V + sg_off((unsigned)j, (unsigned)ch)) = o; }
        __syncthreads();
        bf16x8_t vf[4];
        { const unsigned q = (unsigned)(lane & 15) >> 2, p = (unsigned)lane & 3u;
#pragma unroll
          for (int ks = 0; ks < 4; ++ks) { const unsigned r0 = 32u * ks + 8u * fq + q;
              vf[ks] = tr_frag2(ldsbase + SG_V + sg_off(r0, 2u * wave + (p >> 1)) + 8u * (p & 1u), ldsbase + SG_V + sg_off(r0 + 4u, 2u * wave + (p >> 1)) + 8u * (p & 1u)); } }
        const int cc = g * 128 + 16 * wave + 4 * fq; const f32x4 vg = *(const f32x4*)(vng + cc);
#pragma unroll
        for (int mt = 0; mt < 8; ++mt) {
            f32x4 acc = {0.f, 0.f, 0.f, 0.f};
#pragma unroll
            for (int ks = 0; ks <= (mt >> 1); ++ks) { const bf16x8_t wf = *(const LAS bf16x8_t*)(ldsb + SG_W + (16 * mt + fr) * 272 + (32 * ks + 8 * fq) * 2);
                acc = __builtin_amdgcn_mfma_f32_16x16x32_bf16(vf[ks], wf, acc, 0, 0, 0); }
            const int i = 16 * mt + fr; const float bi = bs[g * 128 + i];
            const v2u uw = *(const GAS v2u*)(Z + (m0 + i) * ZO + cc);
            *(GAS v2u*)(O + (m0 + i) * D + cc) = pack4(bflo(uw.x) * (vg.x * acc[0] + bi), bfhi(uw.x) * (vg.y * acc[1] + bi), bflo(uw.y) * (vg.z * acc[2] + bi), bfhi(uw.y) * (vg.w * acc[3] + bi));
        }
    }
    __syncthreads();
}

__device__ __forceinline__ void final_phase(const Args& a, int vcu, int G, int wave, int lane) {
    const int gw = vcu * NWAVES + wave, NGW = G * NWAVES; const float* ss = (const float*)(a.ws + WS_SS) + (size_t)12 * SS_REC; const float* fg = a.in[I_FG]; const bf16* XBp = (const bf16*)(a.ws + WS_XB);
    for (int m = gw; m < M; m += NGW) { const float rs = pg8::row_rs(ss, m);
        const GAS v4u* xr = (const GAS v4u*)(XBp + (size_t)m * D) + lane; GAS f32x4* orow = (GAS f32x4*)(a.out + (size_t)m * D) + 2 * lane; const GAS f32x4* gr = (const GAS f32x4*)fg + 2 * lane;
#pragma unroll
        for (int j = 0; j < 4; ++j) { const v4u w = xr[64 * j]; const f32x4 g0 = gr[128 * j], g1 = gr[128 * j + 1];
            orow[128 * j] = (f32x4){bflo(w.x) * rs * g0.x, bfhi(w.x) * rs * g0.y, bflo(w.y) * rs * g0.z, bfhi(w.y) * rs * g0.w};
            orow[128 * j + 1] = (f32x4){bflo(w.z) * rs * g1.x, bfhi(w.z) * rs * g1.y, bflo(w.w) * rs * g1.z, bfhi(w.w) * rs * g1.w}; } }
}

__global__ void __launch_bounds__(NTHR, 2) mk_fwd(Args args) {
    extern __shared__ __attribute__((aligned(16))) unsigned char lds_raw[];
    LAS unsigned char* lds = (LAS unsigned char*)lds_raw;
    const int tid = threadIdx.x, lane = tid & 63, wave = __builtin_amdgcn_readfirstlane(tid >> 6);
    const int G = gridDim.x, bx = blockIdx.x; const int vcu = (G % 8 == 0) ? (bx % 8) * (G / 8) + bx / 8 : bx;
    unsigned char* ws = args.ws; gu32* ctl = (gu32*)(ws + WS_CTL);
    for (int u = tid; u < (LDS_BYTES - LDSCTL_OFF) / 4; u += NTHR) ((LAS unsigned*)(lds + LDSCTL_OFF))[u] = 0u;
    __syncthreads();
    const int lo = args.ph_lo, hi = args.ph_hi;
    const bool multi = (hi - lo) > 1;
    XcdBarrier bar; bar.bar = (unsigned*)(ctl + CW_BAR); bar.x = 0; bar.st = nullptr;
    if (multi) bar = xcd_barrier_post((unsigned*)(ctl + CW_BAR), (volatile LAS unsigned*)(lds + LDSCTL_OFF));
#define IN(k) (lo <= (k) && (k) < hi)
#ifdef PROBE_STAMP
#define SEAM(k) do { if ((k) + 1 < hi) { if (tid == 0) bar.st[4] = ((((k) & 7) == 2 && (((k) / 24) & 1)) ? 7u : (unsigned)((k) & 7)); xcd_barrier(bar); } } while (0)
#else
#define SEAM(k) do { if ((k) + 1 < hi) xcd_barrier(bar); } while (0)
#endif
#ifndef DUP_G
#define DUP_G 1
#endif
#ifndef DUP_T
#define DUP_T 1
#endif
#ifndef DUP_GR
#define DUP_GR DUP_G
#endif
#ifndef DUP_G1
#define DUP_G1 DUP_G
#endif
#ifndef DUP_SP
#define DUP_SP DUP_S
#endif
#ifndef DUP_SQ
#define DUP_SQ DUP_S
#endif
#ifndef DUP_PREP
#define DUP_PREP DUP_T
#endif
#ifndef DUP_E1
#define DUP_E1 DUP_T
#endif
#ifndef DUP_SGU
#define DUP_SGU DUP_T
#endif
#ifndef DUP_E3
#define DUP_E3 DUP_T
#endif
#define REPN(n) for (int rep_ = 0; rep_ < (n); ++rep_)
#ifndef DUP_S
#define DUP_S 1
#endif
#define REPG for (int rep_ = 0; rep_ < DUP_G; ++rep_)
#define REPT for (int rep_ = 0; rep_ < DUP_T; ++rep_)
#define REPS for (int rep_ = 0; rep_ < DUP_S; ++rep_)
#define RSEAM(n) do { if (rep_ + 1 < (n)) xcd_barrier(bar); } while (0)
    float* ssb = (float*)(ws + WS_SS);
    bf16* XB = (bf16*)(ws + WS_XB); bf16* ACT = (bf16*)(ws + WS_ACT); bf16* OB = (bf16*)(ws + WS_O);

    for (int s = 0; s < NSUB; ++s) {
        const int pb = s * 8, L = s / 3, kind = s % 3, li = L >> 1; const bool even = !(L & 1);
        #ifndef NO_PREP
        if (kind == 0 && IN(pb + 0)) { REPN(DUP_PREP) { const int t_ = opaque(tid); prep_phase(args, L, lds, vcu, G, __builtin_amdgcn_readfirstlane(t_ >> 6), t_ & 63); RSEAM(DUP_PREP); } SEAM(pb + 0); }
#endif
        if (IN(pb + 1)) {
            const float* ss = ssb + (size_t)s * SS_REC;
            LAS float* RC = (LAS float*)(lds + 135168);
            if (tid == 0) *(LAS int*)(RC + 256) = -1;
            __syncthreads();
            if (kind != 1) {
                pg8::Gemm g{XB, (const bf16*)(ws + (kind == 0 ? WT_GU1 : WT_GU2)), M, 2 * FF, D}; pg8::StaticOrder S; S.init(M, 2 * FF, G, bx);
                pg8::EpiSwiGLU E{ACT, FF, ss, RC};
#ifndef NO_G1
                REPN(DUP_G1) { pg8::gemm_phase<pg8::EpiSwiGLU, pg8::StaticOrder, true, true>(lds, g, S, E); RSEAM(DUP_G1); }
#endif
            } else if (even) {
                pg8::Gemm g{XB, (const bf16*)(ws + WT_IN), M, ZN, D}; pg8::StaticOrder S; S.init(M, ZN, G, bx);
                pg8::EpiZ E{ACT, ZN, ss, args.in[I_EBQKV] + li * 1536, RC};
#ifndef NO_GZ
                REPG { pg8::gemm_phase<pg8::EpiZ, pg8::StaticOrder, true, true>(lds, g, S, E); RSEAM(DUP_G); }
#endif
            } else {
                pg8::Gemm g{XB, (const bf16*)(ws + WT_IN), M, ZO, D}; pg8::StaticOrder S; S.init(M, ZO, G, bx);
                pg8::EpiGeluV E{ACT, ZO, ss, ssb + (size_t)(13 + li) * SS_REC, (LAS float*)(lds + 131072), RC};
#ifndef NO_GG
                REPG { pg8::gemm_phase<pg8::EpiGeluV, pg8::StaticOrder, true, true>(lds, g, S, E); RSEAM(DUP_G); }
#endif
            }
            SEAM(pb + 1);
        }
        if (kind == 1) {
            if (IN(pb + 2)) {
#ifndef NO_E1
                if (even) REPN(DUP_E1) { e1_phase(args, li, lds, vcu, G, opaque(tid)); RSEAM(DUP_E1); }
#endif
#ifndef NO_ATTN
                if (even) for (int au = vcu; au < 1024; au += G) attn_unit(args, li, au, lds, opaque(tid));
#endif
#ifndef NO_SGU
                if (!even) REPN(DUP_SGU) { sgu_phase(args, li, lds, vcu, G, opaque(tid)); RSEAM(DUP_SGU); }
#endif
                SEAM(pb + 2); }
#ifndef NO_SPRE
            if (even && IN(pb + 3)) { REPN(DUP_SP) { scanpre_phase(args, li, lds, vcu, G, opaque(tid)); RSEAM(DUP_SP); } SEAM(pb + 3); }
#endif
#ifndef NO_SSEQ
            if (even && IN(pb + 4)) { REPN(DUP_SQ) { scanseq_phase(args, li, lds, (G == 256) ? (bx & 7) * 16 + (bx >> 3) + ((bx >> 3) < 16 ? 0 : 128 - 16) : vcu, opaque(tid));     RSEAM(DUP_SQ); } SEAM(pb + 4); }
#endif
#ifndef NO_E3
            if (even && IN(pb + 5)) { REPN(DUP_E3) { e3_phase(args, li, vcu, G, opaque(tid)); RSEAM(DUP_E3); } SEAM(pb + 5); }
#endif
        }
        if (IN(pb + 6)) {
            const bf16* A = (kind == 1) ? OB : ACT; const int K = (kind == 1) ? D : FF;
            const bf16* Bt = (const bf16*)(ws + (kind == 0 ? WT_D1 : kind == 1 ? WT_OUT : WT_D2));
            pg8::Gemm g{A, Bt, M, D, K, kind == 1 ? 0 : 1}; pg8::StaticOrder S; S.init(M, D, G, bx);
            pg8::EpiResid E{XB, ssb + (size_t)(s + 1) * SS_REC, kind == 1 ? 1.0f : 0.5f, (LAS float*)(lds + 131072)};
#ifndef NO_GR
            REPN(DUP_GR) { if (rep_) { E.scale = 0.f;
#ifdef PROBE_NOEPI
                E.noop = 1;
#endif
                } pg8::gemm_phase<pg8::EpiResid, pg8::StaticOrder, true, true>(lds, g, S, E); RSEAM(DUP_GR); }
#endif
            SEAM(pb + 6);
        }
    }
    if (IN(NSUB * 8)) { const int t_ = opaque(tid); final_phase(args, vcu, G, __builtin_amdgcn_readfirstlane(t_ >> 6), t_ & 63); }
#ifdef PROBE_STAMP
    if (multi) {
        if (tid == 0) { for (int c = 0; c < 8; ++c) __hip_atomic_store((unsigned*)(ctl + 16384 + bx * 8 + c), bar.st[8 + c], __ATOMIC_RELAXED, __HIP_MEMORY_SCOPE_AGENT); __hip_atomic_store((unsigned*)(ctl + 20480 + bx), bar.x, __ATOMIC_RELAXED, __HIP_MEMORY_SCOPE_AGENT); bar.st[4] = 0u; }
        xcd_barrier(bar);
        if (bx == 0 && tid == 0) {
            unsigned long long sum = 0ull; unsigned mn = 0xffffffffu, mx = 0u;
            unsigned ncnt = 0u;
            for (int j = 0; j < G; ++j) { unsigned v = 0u; if (PROBE_SEL && (j >> 3) >= 16) continue; ++ncnt;
                for (int c = 0; c < 8; ++c) if ((PROBE_MASK >> c) & 1) v += __hip_atomic_load((unsigned*)(ctl + 16384 + j * 8 + c), __ATOMIC_RELAXED, __HIP_MEMORY_SCOPE_AGENT);
                sum += v; mn = v < mn ? v : mn; mx = v > mx ? v : mx; }
            unsigned long long stat = PROBE_STAT == 0 ? sum / ncnt : PROBE_STAT == 1 ? mn : mx;
            if (PROBE_STAT == 5) { unsigned long long sp_ = 0ull; for (int j = 0; j < 128; ++j) sp_ += __hip_atomic_load((unsigned*)(ctl + 24576 + j), __ATOMIC_RELAXED, __HIP_MEMORY_SCOPE_AGENT); stat = sp_ / 128ull * 100ull / PROBE_SCALE; }
            else if (PROBE_STAT >= 3) {
                unsigned xmn = 0xffffffffu, xmx = 0u, wsum = 0u, nx_ = 0u;
                for (unsigned x = 0; x < 16; ++x) { unsigned s_ = 0u, n_ = 0u, a_ = 0xffffffffu, b_ = 0u;
                    for (int j = 0; j < G; ++j) { if (__hip_atomic_load((unsigned*)(ctl + 20480 + j), __ATOMIC_RELAXED, __HIP_MEMORY_SCOPE_AGENT) != x) continue; if (PROBE_SEL && (j >> 3) >= 16) continue; unsigned v = 0u;
                        for (int c = 0; c < 8; ++c) if ((PROBE_MASK >> c) & 1) v += __hip_atomic_load((unsigned*)(ctl + 16384 + j * 8 + c), __ATOMIC_RELAXED, __HIP_MEMORY_SCOPE_AGENT);
                        s_ += v; ++n_; a_ = v < a_ ? v : a_; b_ = v > b_ ? v : b_; }
                    if (n_) { const unsigned m_ = s_ / n_; xmn = m_ < xmn ? m_ : xmn; xmx = m_ > xmx ? m_ : xmx; wsum += b_ - a_; ++nx_; } }
                stat = PROBE_STAT == 3 ? (xmx - xmn) : wsum / (nx_ ? nx_ : 1u);
            }
            const unsigned long long ts = __builtin_amdgcn_s_memrealtime();
            while (__builtin_amdgcn_s_memrealtime() - ts < stat * PROBE_SCALE) __builtin_amdgcn_s_sleep(8);
        }
    }
#endif
#undef IN
#undef SEAM
}

extern "C" void kernel_launch(void* const* d_in, const int* in_sizes, int n_in, void* d_out, int out_size, void* d_ws, size_t ws_size, hipStream_t stream) {
    static int grid = 0;
    if (grid == 0) {
        if (n_in != 29 || out_size != M * D || ws_size < WS_END) { fprintf(stderr, "kernel_launch: unexpected shapes (n_in %d, out %d, ws %zu < %zu); nothing launched\n", n_in, out_size, ws_size, (size_t)WS_END); grid = -1; return; }
        int dev = 0, cus = 0;
        if (hipGetDevice(&dev) != hipSuccess || hipDeviceGetAttribute(&cus, hipDeviceAttributeMultiprocessorCount, dev) != hipSuccess) { grid = -1; return; }
        if (hipFuncSetAttribute((const void*)mk_fwd, hipFuncAttributeMaxDynamicSharedMemorySize, LDS_BYTES) != hipSuccess) { fprintf(stderr, "kernel_launch: hipFuncSetAttribute failed\n"); grid = -1; return; }
        int per_cu = 0;
        if (hipOccupancyMaxActiveBlocksPerMultiprocessor(&per_cu, (const void*)mk_fwd, NTHR, LDS_BYTES) != hipSuccess || per_cu < 1) fprintf(stderr, "kernel_launch: occupancy query says %d\n", per_cu);
        (void)hipGetLastError();
        grid = cus;
    }
    if (grid < 0) return;
    (void)hipMemsetAsync((char*)d_ws + WS_CTL, 0, CTL_ZERO_BYTES, stream);
    Args a{};
    for (int i = 0; i < 29; ++i) a.in[i] = (const float*)d_in[i];
    a.out = (float*)d_out; a.ws = (unsigned char*)d_ws;
#if MK_ONE_LAUNCH
    a.ph_lo = 0; a.ph_hi = NSUB * 8 + 1;
    hipLaunchKernelGGL(mk_fwd, dim3(grid), dim3(NTHR), LDS_BYTES, stream, a);
#else
    for (int s = 0; s <= NSUB; ++s) {
        for (int k = 0; k < (s == NSUB ? 1 : 8); ++k) {
            const int L = s / 3, kind = s % 3; const bool even = !(L & 1);
            bool live;
            if (s == NSUB) live = true;
            else if (k == 0) live = (kind == 0);
            else if (k == 1 || k == 6) live = true;
            else if (k == 2) live = (kind == 1);
            else if (k == 3 || k == 4 || k == 5) live = (kind == 1) && even;
            else live = false;
            if (!live) continue;
            a.ph_lo = s * 8 + k; a.ph_hi = a.ph_lo + 1;
            hipLaunchKernelGGL(mk_fwd, dim3(grid), dim3(NTHR), LDS_BYTES, stream, a);
        }
    }
#endif
}
```

```cpp
#include <hip/hip_runtime.h>
#include <cstdio>
#include <cstdint>
#define MK_ONE_LAUNCH 1
namespace pg8 {
#define PG8_LAS __attribute__((address_space(3)))
typedef unsigned short bf16_t;
typedef short bf16x8 __attribute__((ext_vector_type(8)));
typedef float f32x4 __attribute__((ext_vector_type(4)));
typedef unsigned u32x4 __attribute__((ext_vector_type(4)));
constexpr int BM = 256, BK = 64, HALF = 128, HTB = HALF * BK * 2  , STAGE_BYTES = 8 * HTB, NXCD = 8, WGM = 8;

__host__ __device__ __forceinline__ int lds_byte(int r, int c) { const int st = (r >> 4) * 2 + (c >> 5), rr = r & 15, cc = c & 31, ob = rr * 64 + cc * 2; return st * 1024 + (ob ^ (((ob >> 9) & 1) << 5)); }
__host__ __device__ __forceinline__ void stage_rc(int b, int& R, int& C) { const int st = b / 1024, sb = b % 1024, swz = sb ^ (((sb >> 9) & 1) << 5); R = (st >> 1) * 16 + swz / 64; C = (st & 1) * 32 + (swz % 64) / 2; }
__host__ __device__ __forceinline__ int perm32(int rho) { const int n = rho >> 4, i = rho & 15; return 8 * (i >> 2) + 4 * n + (i & 3); }

struct Unit { int pm, pn; };
struct Gemm { const bf16_t* A; const bf16_t* Bt; int M, N, K; int amode = 0; };

struct StaticOrder {
    int nM, nN, nwg, G, c;
    __host__ __device__ void init(int M, int N, int G_, int c_) { nM = M / BM; nN = N / BM; nwg = nM * nN; G = G_; c = c_; }
    __host__ __device__ bool next(int i, Unit& u) const {
        const long L = (long)i * G + c; if (L >= nwg) return false;
        int wgid = (int)L; { const int q = nwg / NXCD, r = nwg % NXCD, xcd = wgid % NXCD, off = wgid / NXCD; wgid = (xcd < r ? xcd * (q + 1) : r * (q + 1) + (xcd - r) * q) + off; }
        const int nig = WGM * nN, gid = wgid / nig, fm = gid * WGM, gsz = (nM - fm) < WGM ? (nM - fm) : WGM;
        u.pm = fm + ((wgid % nig) % gsz); u.pn = (wgid % nig) / gsz; return true;
    }
    __device__ __forceinline__ void a_ready(const Unit&) const {}
    __device__ __forceinline__ void done(const Unit&) const {}
};
__device__ __forceinline__ unsigned cvt_pk_bf16(float lo, float hi) { unsigned r; asm volatile("v_cvt_pk_bf16_f32 %0, %1, %2" : "=v"(r) : "v"(lo), "v"(hi)); return r; }
typedef float f32x2 __attribute__((ext_vector_type(2)));
__device__ __forceinline__ f32x2 gelu_pk(f32x2 v) {
    const f32x2 av = __builtin_elementwise_abs(v), d = av * 0.2316418882f + 1.0f;
    f32x2 t; t.x = __builtin_amdgcn_rcpf(d.x); t.y = __builtin_amdgcn_rcpf(d.y);
    f32x2 q = t * 0.5307027145f + (-0.7265760135f); q = q * t + 0.7107068705f; q = q * t + (-0.142248368f); q = q * t + 0.127414796f; q = q * t;
    const f32x2 s = (v * v) * (-0.72134752044f);
    f32x2 e; e.x = __builtin_amdgcn_exp2f(s.x); e.y = __builtin_amdgcn_exp2f(s.y);
    const f32x2 m = v * (q * e), r = v - m;
    f32x2 o; o.x = v.x < 0.f ? m.x : r.x; o.y = v.y < 0.f ? m.y : r.y; return o;
}

typedef __bf16 bf16x2_e __attribute__((ext_vector_type(2)));
constexpr int SS_M = 32768;
__device__ __forceinline__ float row_rs(const float* P, int row) {
    const float s = ((P[row] + P[SS_M + row]) + (P[2 * SS_M + row] + P[3 * SS_M + row])) + ((P[4 * SS_M + row] + P[5 * SS_M + row]) + (P[6 * SS_M + row] + P[7 * SS_M + row]));
    return rsqrtf(s * (1.0f / 2048.0f) + 1e-6f);
}
__device__ __forceinline__ void panel_rs(const float* ss, PG8_LAS float* rc, int pm, int t) {
    PG8_LAS int* tag = (PG8_LAS int*)(rc + BM);
    const int have = *tag;
    if (have != pm && t < BM) rc[t] = row_rs(ss, pm * BM + t);
    asm volatile("s_waitcnt lgkmcnt(0)" ::: "memory"); __builtin_amdgcn_s_barrier(); asm volatile("" ::: "memory");
    if (have != pm && t == 0) *tag = pm;
}
struct EpiSwiGLU {
    static constexpr int PID = 0;
    static constexpr bool PERM = true, AFTER_DRAIN = false;
    bf16_t* O; int ldc; const float* ss; PG8_LAS float* rc;
    __device__ __forceinline__ void operator()(const f32x4 (&acc)[2][2][4][2], const Unit& u, int wr, int wc, int fr, int fq) const {
        const int row0 = u.pm * BM + wr * 64 + fr, col0 = u.pn * HALF + wc * 32 + 8 * fq;
        panel_rs(ss, rc, u.pm, (wr * 4 + wc) * 64 + fq * 16 + fr);
#pragma unroll
        for (int ai = 0; ai < 2; ++ai)
#pragma unroll
            for (int m = 0; m < 4; ++m) {
                const int row = row0 + ai * HALF + m * 16;
                const float rs = rc[row - u.pm * BM];
                float o[8];
#pragma unroll
                for (int n = 0; n < 2; ++n)
#pragma unroll
                    for (int j = 0; j < 4; ++j) { const float g = acc[ai][0][m][n][j] * rs, up = acc[ai][1][m][n][j] * rs; o[4 * n + j] = g * __builtin_amdgcn_rcpf(1.0f + __expf(-g)) * up; }
                u32x4 w; w.x = cvt_pk_bf16(o[0], o[1]); w.y = cvt_pk_bf16(o[2], o[3]); w.z = cvt_pk_bf16(o[4], o[5]); w.w = cvt_pk_bf16(o[6], o[7]);
                *(u32x4*)(O + ((size_t)(u.pm * (ldc >> 6) + (col0 >> 6)) * BM + (row - u.pm * BM)) * BK + (col0 & 63)) = w;
                asm volatile("" ::: "memory");
            }
    }
};
struct EpiResid {
    static constexpr int PID = 3;
    static constexpr bool PERM = true, AFTER_DRAIN = false;
    bf16_t* xb; float* ssn; float scale; PG8_LAS float* sp;
    int noop = 0;
    __device__ __forceinline__ void operator()(const f32x4 (&acc)[2][2][4][2], const Unit& u, int wr, int wc, int fr, int fq) const {
        const int row0 = u.pm * BM + wr * 64 + fr, col0 = u.pn * BM + wc * 32 + 8 * fq;
        if (noop) return;
        u32x4 bx[8][2];
#pragma unroll
        for (int gi = 0; gi < 8; ++gi)
#pragma unroll
            for (int bj = 0; bj < 2; ++bj) bx[gi][bj] = *(const u32x4*)(xb + (size_t)(row0 + (gi >> 2) * HALF + (gi & 3) * 16) * 2048 + col0 + bj * HALF);
        asm volatile("" ::: "memory");
#pragma unroll
        for (int gi = 0; gi < 8; ++gi) {
            const int ai = gi >> 2, m = gi & 3;
            const int row = row0 + ai * HALF + m * 16; const size_t off = (size_t)row * 2048 + col0; float s = 0.f;
            u32x4 bc[2]; bc[0] = bx[gi][0]; bc[1] = bx[gi][1];
#pragma unroll
            for (int bj = 0; bj < 2; ++bj) {
                const f32x4 a0 = acc[ai][bj][m][0] * scale, a1 = acc[ai][bj][m][1] * scale; const u32x4 b = bc[bj]; u32x4 w;
                w.x = cvt_pk_bf16(__uint_as_float(b.x << 16) + a0[0], __uint_as_float(b.x & 0xffff0000u) + a0[1]);
                w.y = cvt_pk_bf16(__uint_as_float(b.y << 16) + a0[2], __uint_as_float(b.y & 0xffff0000u) + a0[3]);
                w.z = cvt_pk_bf16(__uint_as_float(b.z << 16) + a1[0], __uint_as_float(b.z & 0xffff0000u) + a1[1]);
                w.w = cvt_pk_bf16(__uint_as_float(b.w << 16) + a1[2], __uint_as_float(b.w & 0xffff0000u) + a1[3]);
                *(u32x4*)(xb + off + bj * HALF) = w;
                const float r0 = __uint_as_float(w.x << 16), r1 = __uint_as_float(w.x & 0xffff0000u), r2 = __uint_as_float(w.y << 16), r3 = __uint_as_float(w.y & 0xffff0000u);
                const float r4 = __uint_as_float(w.z << 16), r5 = __uint_as_float(w.z & 0xffff0000u), r6 = __uint_as_float(w.w << 16), r7 = __uint_as_float(w.w & 0xffff0000u);
                s += ((r0 * r0 + r1 * r1) + (r2 * r2 + r3 * r3)) + ((r4 * r4 + r5 * r5) + (r6 * r6 + r7 * r7));
            }
            s += __shfl_xor(s, 16); s += __shfl_xor(s, 32);
            if (fq == 0) sp[(ai * HALF + wr * 64 + m * 16 + fr) * 4 + wc] = s;
            asm volatile("" ::: "memory");
        }
        asm volatile("s_waitcnt lgkmcnt(0)" ::: "memory"); __builtin_amdgcn_s_barrier(); asm volatile("" ::: "memory");
        const int t = (wr * 4 + wc) * 64 + fq * 16 + fr;
        if (t < BM) { const f32x4 p = *(const PG8_LAS f32x4*)(sp + t * 4); ssn[(size_t)u.pn * SS_M + u.pm * BM + t] = (p[0] + p[1]) + (p[2] + p[3]); }
    }
};
struct EpiZ {
    static constexpr int PID = 1;
    static constexpr bool PERM = true, AFTER_DRAIN = false;
    bf16_t* O; int ldc; const float* ss; const float* bias; PG8_LAS float* rc;
    __device__ __forceinline__ void operator()(const f32x4 (&acc)[2][2][4][2], const Unit& u, int wr, int wc, int fr, int fq) const {
        const int row0 = u.pm * BM + wr * 64 + fr, col0 = u.pn * BM + wc * 32 + 8 * fq;
        panel_rs(ss, rc, u.pm, (wr * 4 + wc) * 64 + fq * 16 + fr);
        const bool hb = u.pn < 6;
        f32x4 bv[2][2];
#pragma unroll
        for (int bj = 0; bj < 2; ++bj)
#pragma unroll
            for (int n = 0; n < 2; ++n) bv[bj][n] = hb ? *(const f32x4*)(bias + col0 + bj * HALF + 4 * n) : (f32x4){0.f, 0.f, 0.f, 0.f};
#pragma unroll
        for (int ai = 0; ai < 2; ++ai)
#pragma unroll
            for (int m = 0; m < 4; ++m) {
                const int row = row0 + ai * HALF + m * 16;
                const float rs = rc[row - u.pm * BM];
                bf16_t* rowp = O + (size_t)row * ldc + col0;
#pragma unroll
                for (int bj = 0; bj < 2; ++bj) {
                    const f32x4 v0 = acc[ai][bj][m][0] * rs + bv[bj][0], v1 = acc[ai][bj][m][1] * rs + bv[bj][1];
                    u32x4 w; w.x = cvt_pk_bf16(v0[0], v0[1]); w.y = cvt_pk_bf16(v0[2], v0[3]); w.z = cvt_pk_bf16(v1[0], v1[1]); w.w = cvt_pk_bf16(v1[2], v1[3]);
                    *(u32x4*)(rowp + bj * HALF) = w;
                }
                asm volatile("" ::: "memory");
            }
    }
};
struct EpiGeluV {
    static constexpr int PID = 2;
    static constexpr bool PERM = true, AFTER_DRAIN = false;
    bf16_t* O; int ldc; const float* ss; float* ssv; PG8_LAS float* sp; PG8_LAS float* rc;
    __device__ __forceinline__ void operator()(const f32x4 (&acc)[2][2][4][2], const Unit& u, int wr, int wc, int fr, int fq) const {
        const int row0 = u.pm * BM + wr * 64 + fr, col0 = u.pn * BM + wc * 32 + 8 * fq;
        panel_rs(ss, rc, u.pm, (wr * 4 + wc) * 64 + fq * 16 + fr);
        const bool isv = u.pn >= 8;
#pragma unroll
        for (int ai = 0; ai < 2; ++ai)
#pragma unroll
            for (int m = 0; m < 4; ++m) {
                const int row = row0 + ai * HALF + m * 16;
                const float rs = rc[row - u.pm * BM];
                bf16_t* rowp = O + (size_t)row * ldc + col0; float s = 0.f;
#pragma unroll
                for (int bj = 0; bj < 2; ++bj) {
                    f32x4 v0 = acc[ai][bj][m][0] * rs, v1 = acc[ai][bj][m][1] * rs;
                    const f32x2 a = gelu_pk((f32x2){v0[0], v0[1]}), b = gelu_pk((f32x2){v0[2], v0[3]}), c = gelu_pk((f32x2){v1[0], v1[1]}), d = gelu_pk((f32x2){v1[2], v1[3]});
                    s += (a.x * a.x + a.y * a.y) + (b.x * b.x + b.y * b.y) + (c.x * c.x + c.y * c.y) + (d.x * d.x + d.y * d.y);
                    u32x4 w; w.x = cvt_pk_bf16(a.x, a.y); w.y = cvt_pk_bf16(b.x, b.y); w.z = cvt_pk_bf16(c.x, c.y); w.w = cvt_pk_bf16(d.x, d.y);
                    *(u32x4*)(rowp + bj * HALF) = w;
                }
                if (isv) { s += __shfl_xor(s, 16); s += __shfl_xor(s, 32); if (fq == 0) sp[(ai * HALF + wr * 64 + m * 16 + fr) * 4 + wc] = s; }
                asm volatile("" ::: "memory");
            }
        if (isv) {
            asm volatile("s_waitcnt lgkmcnt(0)" ::: "memory"); __builtin_amdgcn_s_barrier(); asm volatile("" ::: "memory");
            const int t = (wr * 4 + wc) * 64 + fq * 16 + fr;
            if (t < BM) { const f32x4 p = *(const PG8_LAS f32x4*)(sp + t * 4); ssv[(size_t)(u.pn - 8) * SS_M + u.pm * BM + t] = (p[0] + p[1]) + (p[2] + p[3]); }
        }
    }
};
template <class Epi, class Sched, bool ALIGN_EPI = false, bool SP2 = false>
__device__ __forceinline__ void gemm_phase(PG8_LAS unsigned char* lds, const Gemm g, const Sched& S, const Epi& E) {
    int tid_ = threadIdx.x; asm volatile("" : "+v"(tid_));
    const int tid = tid_, wid = __builtin_amdgcn_readfirstlane(tid >> 6), lane = tid & 63, wr = wid >> 2, wc = wid & 3, fr = lane & 15, fq = lane >> 4;
    const int K = g.K, nt = K / BK;
    unsigned voffA[2], voffB[2];
#pragma unroll
    for (int i = 0; i < 2; ++i) { int R, C; stage_rc(tid * 16 + i * 8192, R, C); const int Rb = Epi::PERM ? ((R & ~31) + perm32(R & 31)) : R;
        voffA[i] = g.amode ? (unsigned)(R * BK + C) * 2u : (unsigned)(R * K + C) * 2u; voffB[i] = (unsigned)(Rb * K + C) * 2u; }
    const size_t kstep = (size_t)(BK * 2);
    const size_t hstep = (size_t)HALF * K * 2;
    const size_t tstep = 2 * hstep;
    const size_t kstepA = g.amode ? (size_t)(BM * BK * 2) : kstep, hstepA = g.amode ? (size_t)(HALF * BK * 2) : hstep, tstepA = g.amode ? (size_t)(K / BK) * (BM * BK * 2) : tstep;
    const unsigned ldsw = (unsigned)wid * 1024u;
    const int aoff = lds_byte(wr * 64 + fr, fq * 8), boff = lds_byte(wc * 32 + fr, fq * 8);
#define PG8_SA(b, h) (((b) * 2 + (h)) * HTB)
#define PG8_SB(b, h) ((4 + (b) * 2 + (h)) * HTB)
#define PG8_STAGE(bufoff, gbase, voff) do { _Pragma("unroll") for (int _i = 0; _i < 2; ++_i) \
        __builtin_amdgcn_global_load_lds((const unsigned*)((const char*)(gbase) + (voff)[_i]), (PG8_LAS unsigned*)(lds + (bufoff) + ldsw + _i * 8192), 16, 0, 0); } while (0)
#define PG8_LDA(dst, b, h) do { _Pragma("unroll") for (int m = 0; m < 4; ++m) _Pragma("unroll") for (int k = 0; k < 2; ++k) dst[m][k] = *(const PG8_LAS bf16x8*)(lds + PG8_SA(b, h) + aoff + m * 2048 + k * 1024); } while (0)
#define PG8_LDB(dst, b, h) do { _Pragma("unroll") for (int n = 0; n < 2; ++n) _Pragma("unroll") for (int k = 0; k < 2; ++k) dst[n][k] = *(const PG8_LAS bf16x8*)(lds + PG8_SB(b, h) + boff + n * 2048 + k * 1024); } while (0)
#define PG8_MMA(ai, bj, At, Bt) do { __builtin_amdgcn_s_setprio(1); _Pragma("unroll") for (int m = 0; m < 4; ++m) _Pragma("unroll") for (int n = 0; n < 2; ++n) _Pragma("unroll") for (int k = 0; k < 2; ++k) \
        acc[ai][bj][m][n] = __builtin_amdgcn_mfma_f32_16x16x32_bf16(Bt[n][k], At[m][k], acc[ai][bj][m][n], 0, 0, 0); __builtin_amdgcn_s_setprio(0); } while (0)
#define PG8_WAIT_V(n) asm volatile("s_waitcnt vmcnt(" #n ")" ::: "memory")
#define PG8_WAIT_L(n) asm volatile("s_waitcnt lgkmcnt(" #n ")" ::: "memory")
#define PG8_BAR __builtin_amdgcn_s_barrier()
#define PG8_SCHED __builtin_amdgcn_sched_barrier(0)
    Unit cur, nxt; int ui = 0;
    if (!S.next(0, cur)) return;
    f32x4 acc[2][2][4][2];
#pragma unroll
    for (int a = 0; a < 2; ++a)
#pragma unroll
        for (int b = 0; b < 2; ++b)
#pragma unroll
            for (int m = 0; m < 4; ++m)
#pragma unroll
                for (int n = 0; n < 2; ++n) acc[a][b][m][n] = (f32x4){0.f, 0.f, 0.f, 0.f};
    bf16x8 At[4][2], B0[2][2], B1[2][2];
    const char* cA = (const char*)g.A + (size_t)cur.pm * tstepA; const char* cB = (const char*)g.Bt + (size_t)cur.pn * tstep;
    S.a_ready(cur);
    if constexpr (SP2) {
        PG8_STAGE(PG8_SB(0, 0), cB, voffB); PG8_STAGE(PG8_SB(0, 1), cB + hstep, voffB); PG8_STAGE(PG8_SA(0, 0), cA, voffA); PG8_STAGE(PG8_SA(0, 1), cA + hstepA, voffA);
        if (wr == 1) PG8_BAR;
        PG8_WAIT_V(2); PG8_BAR;
        PG8_STAGE(PG8_SB(1, 0), cB + kstep, voffB); PG8_STAGE(PG8_SA(1, 0), cA + kstepA, voffA); PG8_STAGE(PG8_SB(1, 1), cB + hstep + kstep, voffB);
        PG8_WAIT_V(6); PG8_BAR;
    } else {
        PG8_STAGE(PG8_SB(0, 0), cB, voffB); PG8_STAGE(PG8_SA(0, 0), cA, voffA); PG8_STAGE(PG8_SB(0, 1), cB + hstep, voffB); PG8_STAGE(PG8_SA(0, 1), cA + hstepA, voffA);
        if (wr == 1) PG8_BAR;
        PG8_WAIT_V(4); PG8_BAR;
        PG8_STAGE(PG8_SB(1, 0), cB + kstep, voffB); PG8_STAGE(PG8_SA(1, 0), cA + kstepA, voffA); PG8_STAGE(PG8_SB(1, 1), cB + hstep + kstep, voffB);
        PG8_WAIT_V(6); PG8_BAR;
    }
    for (;;) {
        const bool has_next = S.next(ui + 1, nxt);
        const char* nA = has_next ? (const char*)g.A + (size_t)nxt.pm * tstepA : cA; const char* nB = has_next ? (const char*)g.Bt + (size_t)nxt.pn * tstep : cB;
        for (int t = 0; t < nt; t += 2) {
            const bool last = (t == nt - 2);
            const char* a1 = cA + (size_t)(t + 1) * kstepA;
            const char* a2 = last ? nA : cA + (size_t)(t + 2) * kstepA; const char* b2 = last ? nB : cB + (size_t)(t + 2) * kstep;
            const char* a3 = a2 + kstepA; const char* b3 = b2 + kstep;
            if (last && has_next) S.a_ready(nxt);
            if constexpr (SP2) {
            PG8_LDB(B0, 0, 0); PG8_LDB(B1, 0, 1); PG8_SCHED; PG8_LDA(At, 0, 0); PG8_STAGE(PG8_SA(1, 1), a1 + hstepA, voffA);
            PG8_WAIT_V(8); PG8_WAIT_L(0); PG8_BAR; PG8_MMA(0, 0, At, B0); PG8_MMA(0, 1, At, B1); PG8_BAR; PG8_SCHED;
            PG8_LDA(At, 0, 1); PG8_STAGE(PG8_SB(0, 0), b2, voffB); PG8_STAGE(PG8_SB(0, 1), b2 + hstep, voffB); PG8_STAGE(PG8_SA(0, 0), a2, voffA);
            PG8_WAIT_V(8); PG8_WAIT_L(0); PG8_BAR; PG8_MMA(1, 0, At, B0); PG8_MMA(1, 1, At, B1); PG8_BAR; PG8_SCHED;
            PG8_LDB(B0, 1, 0); PG8_LDB(B1, 1, 1); PG8_SCHED; PG8_LDA(At, 1, 0); PG8_STAGE(PG8_SA(0, 1), a2 + hstepA, voffA);
            PG8_WAIT_V(8); PG8_WAIT_L(0); PG8_BAR; PG8_MMA(0, 0, At, B0); PG8_MMA(0, 1, At, B1); PG8_BAR; PG8_SCHED;
            PG8_LDA(At, 1, 1); PG8_STAGE(PG8_SB(1, 0), b3, voffB); PG8_STAGE(PG8_SB(1, 1), b3 + hstep, voffB); PG8_STAGE(PG8_SA(1, 0), a3, voffA);
            PG8_WAIT_V(8); PG8_WAIT_L(0); PG8_BAR; PG8_MMA(1, 0, At, B0); PG8_MMA(1, 1, At, B1); PG8_BAR; PG8_SCHED;
            } else {
            PG8_LDB(B0, 0, 0); PG8_SCHED; PG8_LDA(At, 0, 0); PG8_STAGE(PG8_SA(1, 1), a1 + hstepA, voffA);
            PG8_WAIT_L(8); PG8_BAR; PG8_WAIT_L(0); PG8_MMA(0, 0, At, B0); PG8_BAR; PG8_SCHED;
            PG8_LDB(B1, 0, 1); PG8_STAGE(PG8_SB(0, 0), b2, voffB);
            PG8_BAR; PG8_WAIT_L(0); PG8_MMA(0, 1, At, B1); PG8_BAR;
            PG8_LDA(At, 0, 1); PG8_STAGE(PG8_SA(0, 0), a2, voffA);
            PG8_BAR; PG8_WAIT_L(0); PG8_MMA(1, 0, At, B0); PG8_BAR; PG8_SCHED;
            PG8_STAGE(PG8_SB(0, 1), b2 + hstep, voffB);
            PG8_WAIT_V(6); PG8_BAR; PG8_MMA(1, 1, At, B1); PG8_BAR;
            PG8_LDB(B0, 1, 0); PG8_SCHED; PG8_LDA(At, 1, 0); PG8_STAGE(PG8_SA(0, 1), a2 + hstepA, voffA);
            PG8_WAIT_L(8); PG8_BAR; PG8_WAIT_L(0); PG8_MMA(0, 0, At, B0); PG8_BAR; PG8_SCHED;
            PG8_LDB(B1, 1, 1); PG8_STAGE(PG8_SB(1, 0), b3, voffB);
            PG8_BAR; PG8_WAIT_L(0); PG8_MMA(0, 1, At, B1); PG8_BAR;
            PG8_LDA(At, 1, 1); PG8_STAGE(PG8_SA(1, 0), a3, voffA);
            PG8_BAR; PG8_WAIT_L(0); PG8_MMA(1, 0, At, B0); PG8_BAR; PG8_SCHED;
            PG8_STAGE(PG8_SB(1, 1), b3 + hstep, voffB);
            PG8_WAIT_V(6); PG8_BAR; PG8_MMA(1, 1, At, B1); PG8_BAR;
            }
        }
        if constexpr (ALIGN_EPI) { if (wr == 0) PG8_BAR; }
#ifdef PROBE_STAMP
        const unsigned long long pe0_ = __builtin_amdgcn_s_memrealtime();
#endif
        if constexpr (!Epi::AFTER_DRAIN) { E(acc, cur, wr, wc, fr, fq); S.done(cur); }
#ifdef PROBE_STAMP
        if (tid == 0) { PG8_LAS unsigned* pw_ = (PG8_LAS unsigned*)(lds + 147456 - 512) + 24 + Epi::PID; *pw_ += (unsigned)(__builtin_amdgcn_s_memrealtime() - pe0_); }
#endif
        if (!has_next) break;
#pragma unroll
        for (int a = 0; a < 2; ++a)
#pragma unroll
            for (int b = 0; b < 2; ++b)
#pragma unroll
                for (int m = 0; m < 4; ++m)
#pragma unroll
                    for (int n = 0; n < 2; ++n) acc[a][b][m][n] = (f32x4){0.f, 0.f, 0.f, 0.f};
        cur = nxt; cA = nA; cB = nB; ++ui;
        if constexpr (ALIGN_EPI) { if (wr == 1) PG8_BAR; }
    }
    PG8_WAIT_V(0);
    if constexpr (!ALIGN_EPI) { if (wr == 0) PG8_BAR; }
    PG8_BAR;
    if constexpr (Epi::AFTER_DRAIN) { E.fused(acc, cur, wr, wc, fr, fq, lds, wid, lane); S.done(cur); }
#undef PG8_SA
#undef PG8_SB
#undef PG8_STAGE
#undef PG8_LDA
#undef PG8_LDB
#undef PG8_MMA
#undef PG8_WAIT_V
#undef PG8_WAIT_L
#undef PG8_BAR
#undef PG8_SCHED
}
}
#define LAS_BAR __attribute__((address_space(3)))
#define XB_TMO      128
#define XB_XCNT(j)  (256  + 64 * (j))
#define XB_XSUB(j)  (1280 + 64 * (j))
#define XB_XGEN(j)  (2304 + 64 * (j))
#define XB_TOP      3328
#define XB_TOPGEN   3392
#define XCD_BAR_WORDS 3456
#define XB_SPIN_CAP (1u << 22)

__device__ __forceinline__ unsigned xb_ld(unsigned* p)              { return __hip_atomic_load(p, __ATOMIC_RELAXED, __HIP_MEMORY_SCOPE_AGENT); }
__device__ __forceinline__ unsigned xb_add(unsigned* p, unsigned v) { return __hip_atomic_fetch_add(p, v, __ATOMIC_RELAXED, __HIP_MEMORY_SCOPE_AGENT); }
__device__ __forceinline__ unsigned xb_xcc_id() { return (unsigned)__builtin_amdgcn_s_getreg((3 << 11) | 20) & 0xFu; }
#define XB_SPIN(cond, bar) do { unsigned _sp = 0; while (cond) { __builtin_amdgcn_s_sleep(1); \
    if ((++_sp & 255u) == 0u) { if (xb_ld(&(bar)[XB_TMO])) break; if (_sp > XB_SPIN_CAP) { atomicAdd(&(bar)[XB_TMO], 1u); break; } } } } while (0)

struct XcdBarrier {
    unsigned* bar; unsigned x;
    volatile LAS_BAR unsigned* st;
};

__device__ __forceinline__ XcdBarrier xcd_barrier_post(unsigned* bar, volatile LAS_BAR unsigned* st) {
    XcdBarrier b; b.bar = bar; b.x = xb_xcc_id(); b.st = st;
    if (threadIdx.x == 0) (void)xb_add(&bar[XB_XCNT(b.x)], 1u);
    return b;
}
__device__ __forceinline__ void xcd_barrier_complete(unsigned* bar, unsigned x, unsigned& nloc, unsigned& nx) {
    const unsigned G = gridDim.x * gridDim.y * gridDim.z;
    unsigned sum, cnt, mine, sp = 0u;
    for (;;) {
        sum = 0u; cnt = 0u; mine = 0u;
#pragma unroll
        for (unsigned j = 0; j < 16; ++j) { const unsigned c = xb_ld(&bar[XB_XCNT(j)]); sum += c; cnt += (c > 0u) ? 1u : 0u; mine = (j == x) ? c : mine; }
        if (sum == G) break;
        __builtin_amdgcn_s_sleep(1);
        if ((++sp & 255u) == 0u) { if (xb_ld(&bar[XB_TMO])) break; if (sp > XB_SPIN_CAP) { atomicAdd(&bar[XB_TMO], 1u); break; } }
    }
    nloc = mine > 0u ? mine : 1u; nx = cnt > 0u ? cnt : 1u;
}

__device__ __forceinline__ void xcd_barrier(const XcdBarrier& b) {
    asm volatile("s_waitcnt vmcnt(0)" ::: "memory");
    __syncthreads();
    if (threadIdx.x == 0) {
        unsigned* bar = b.bar;
        __builtin_amdgcn_s_waitcnt(0);
#ifdef PROBE_STAMP
        const unsigned long long pt0_ = __builtin_amdgcn_s_memrealtime();
#endif
        unsigned nloc = b.st[0], nx = b.st[1];
        if (nloc == 0u) { xcd_barrier_complete(bar, b.x, nloc, nx); b.st[0] = nloc; b.st[1] = nx; }
        const unsigned old = xb_add(&bar[XB_XSUB(b.x)], 1u);
        const unsigned gen = old / nloc;
        if (old + 1u == (gen + 1u) * nloc) {
            __builtin_amdgcn_fence(__ATOMIC_RELEASE, "agent");
            asm volatile("s_waitcnt vmcnt(0)" ::: "memory");
            const unsigned og = xb_add(&bar[XB_TOP], 1u);
            const unsigned tg = og / nx;
            if (og + 1u == (tg + 1u) * nx) xb_add(&bar[XB_TOPGEN], 1u);
            else XB_SPIN(xb_ld(&bar[XB_TOPGEN]) == tg, bar);
            __builtin_amdgcn_fence(__ATOMIC_ACQUIRE, "agent");
            xb_add(&bar[XB_XGEN(b.x)], 1u);
            asm volatile("s_waitcnt vmcnt(0)" ::: "memory");
        } else {
            XB_SPIN(xb_ld(&bar[XB_XGEN(b.x)]) == gen, bar);
            __builtin_amdgcn_fence(__ATOMIC_ACQUIRE, "agent");
            asm volatile("s_waitcnt vmcnt(0)" ::: "memory");
        }
#ifdef PROBE_STAMP
        { const unsigned cls_ = b.st[4]; const unsigned now_ = (unsigned)__builtin_amdgcn_s_memrealtime(); b.st[8 + cls_] += now_ - (unsigned)pt0_; if (b.st[6]) b.st[16 + cls_] += now_ - b.st[6]; b.st[6] = now_ | 1u; }
#endif
    }
    __syncthreads();
}

constexpr int NWAVES = 8, NTHR = 512;
constexpr int BATCH = 2, T = 16384, D = 2048, FF = 5632, M = BATCH * T;
constexpr int ZN = 5120;
constexpr int ZA = 1536;
constexpr int A_COLS = 3360, E_IN = 4896;
constexpr int ZO = 4096;
constexpr int NSUB = 12;
#ifndef MK_ONE_LAUNCH
#define MK_ONE_LAUNCH 0
#endif

constexpr size_t MiB = 1u << 20;
constexpr size_t WS_CTL = 0, CTL_ZERO_BYTES = 1 * MiB;
constexpr size_t WS_SS = 1 * MiB;
constexpr size_t SS_REC = 8 * (size_t)M;
constexpr size_t WS_WT = 16 * MiB;
constexpr size_t WT_GU1 = WS_WT, WT_D1 = WT_GU1 + 44 * MiB, WT_GU2 = WT_D1 + 22 * MiB, WT_D2 = WT_GU2 + 44 * MiB, WT_IN = WT_D2 + 22 * MiB, WT_OUT = WT_IN + 20 * MiB;
constexpr size_t WS_XB = WT_OUT + 8 * MiB;
constexpr size_t WS_ACT = WS_XB + 128 * MiB;
constexpr size_t WS_SC = WS_ACT + 352 * MiB;
constexpr size_t SC_R = WS_SC, SC_K2 = SC_R + 64 * MiB, SC_KK = SC_K2 + 64 * MiB, SC_BB = SC_KK + 64 * MiB, SC_LW = SC_BB + 64 * MiB, SC_GG = SC_LW + 64 * MiB;
constexpr size_t WS_VF = SC_GG + 64 * MiB;
constexpr size_t WS_V2 = WS_VF + 64 * MiB;
constexpr size_t WS_O = WS_V2 + 64 * MiB;
constexpr size_t WS_SM = WS_O + 128 * MiB;
constexpr size_t SM_W2T = WS_SM, SM_A2T = SM_W2T + 131072, SM_G2T = SM_A2T + 131072, SM_V1T = SM_G2T + 327680, SM_V2T = SM_V1T + 65536, SM_WSB = SM_V2T + 65536;
constexpr size_t WS_U0 = WS_SM + 2 * MiB;
constexpr size_t WS_END = WS_U0 + 64 * MiB;
static_assert(SM_WSB + 524288 <= WS_END, "small-weight map");
static_assert(WT_OUT + 8 * MiB == 176 * MiB && WS_SS + 15 * MiB <= WS_WT, "weight map");
constexpr int CW_TMO = 0, CW_CODE = 1, CW_BAR = 4096;

constexpr int LDS_BYTES = 147456, LDSCTL_OFF = LDS_BYTES - 512;

#define GAS __attribute__((address_space(1)))
#define LAS __attribute__((address_space(3)))
typedef unsigned short bf16;
typedef unsigned v4u __attribute__((ext_vector_type(4)));
typedef unsigned v2u __attribute__((ext_vector_type(2)));
typedef float f32x4 __attribute__((ext_vector_type(4)));
typedef float f32x2 __attribute__((ext_vector_type(2)));
typedef GAS unsigned gu32;
#define RLX_AGENT __ATOMIC_RELAXED, __HIP_MEMORY_SCOPE_AGENT
#define LDS_WAIT() asm volatile("s_waitcnt lgkmcnt(0)" ::: "memory")
typedef __bf16 bf16x2_hw __attribute__((ext_vector_type(2)));
__device__ __forceinline__ unsigned pk2(float lo, float hi) { const bf16x2_hw b = __builtin_convertvector((f32x2){lo, hi}, bf16x2_hw); return __builtin_bit_cast(unsigned, b); }
__device__ __forceinline__ unsigned f2bf(float f) { return pk2(f, f) & 0xffffu; }
__device__ __forceinline__ float bf2f(bf16 b) { return __builtin_bit_cast(float, (unsigned)b << 16); }
__device__ __forceinline__ float bflo(unsigned w) { return __builtin_bit_cast(float, w << 16); }
__device__ __forceinline__ float bfhi(unsigned w) { return __builtin_bit_cast(float, w & 0xffff0000u); }
__device__ __forceinline__ float wave_sum(float v) {
#pragma unroll
    for (int o = 1; o < 64; o <<= 1) v += __shfl_xor(v, o);
    return v;
}
template <int CTRL> __device__ __forceinline__ float dpp_mov(float v) { return __builtin_bit_cast(float, __builtin_amdgcn_update_dpp(0, __builtin_bit_cast(int, v), CTRL, 0xf, 0xf, true)); }
__device__ __forceinline__ float row16_sum(float v) { v += dpp_mov<0xB1>(v); v += dpp_mov<0x4E>(v); v += dpp_mov<0x141>(v); v += dpp_mov<0x140>(v); return v; }
__device__ __forceinline__ float sigmoidf_(float x) { return 1.0f / (1.0f + __expf(-x)); }

__device__ __forceinline__ int opaque(int v) { asm volatile("" : "+v"(v)); return v; }
struct Args { const float* in[29]; float* out; unsigned char* ws; int ph_lo, ph_hi; };
static_assert(sizeof(Args) == 29 * 8 + 8 + 8 + 8, "Args has no padding");
enum { I_X = 0, I_NG, I_WG, I_WU, I_WD, I_EWIN, I_EBQKV, I_EMU, I_EW0, I_EW2, I_EA0, I_EA2, I_EG2, I_EKK, I_EKA, I_ERK, I_EGNG, I_EGNB, I_ESINK, I_EWOUT, I_V0, I_V1, I_V2, I_OWIN, I_OVNG, I_OWS, I_OBS, I_OWOUT, I_FG };

struct TrDesc { const float* W; const float* gk; bf16* WT; int ldw, k0, c0, K, drow0; bool zero; };
__device__ __forceinline__ void tr_load(const TrDesc& d, float (&v)[32], int lane) {
#pragma unroll
    for (int i = 0; i < 32; ++i) { const int kk = 2 * i + (lane >> 5); v[i] = d.zero ? 0.f : d.W[(size_t)(d.k0 + kk) * d.ldw + d.c0 + (lane & 31)]; }
}
__device__ __forceinline__ void tr_store(const TrDesc& d, const float (&v)[32], LAS float* scr, int lane) {
#pragma unroll
    for (int i = 0; i < 32; ++i) { const int kk = 2 * i + (lane >> 5); float x = v[i]; if (d.gk) x *= d.gk[d.k0 + kk]; scr[kk * 33 + (lane & 31)] = x; }
    LDS_WAIT(); asm volatile("" ::: "memory");
    const int c = lane & 7;
#pragma unroll
    for (int j = 0; j < 4; ++j) { const int n = (lane >> 3) + 8 * j; const LAS float* s = scr + (8 * c) * 33 + n;
        v4u o; o.x = pk2(s[0 * 33], s[1 * 33]); o.y = pk2(s[2 * 33], s[3 * 33]); o.z = pk2(s[4 * 33], s[5 * 33]); o.w = pk2(s[6 * 33], s[7 * 33]);
        *(GAS v4u*)(d.WT + (size_t)(d.drow0 + n) * d.K + d.k0 + 8 * c) = o; }
    LDS_WAIT(); asm volatile("" ::: "memory");
}
__device__ __forceinline__ TrDesc tr_desc(const Args& a, int L, int it) {
    unsigned char* ws = a.ws; const bool even = !(L & 1); const int li = L >> 1;
    constexpr int nGU = 32 * 352, nD = 88 * 64; const int nIN = 32 * (even ? 160 : 128);
    TrDesc d; d.zero = false; int r = it;
    if (r < 2 * nGU) { const int f = r / nGU; r -= f * nGU; const int kb = r / 352, rb = r % 352, tj = rb >> 3, sub = rb & 7;
        d.W = (sub < 4 ? a.in[I_WG] : a.in[I_WU]) + (size_t)(L * 2 + f) * D * FF; d.ldw = FF; d.k0 = 64 * kb; d.c0 = 128 * tj + 32 * (sub & 3); d.gk = a.in[I_NG] + (L * 3 + (f ? 2 : 0)) * D;
        d.WT = (bf16*)(ws + (f ? WT_GU2 : WT_GU1)); d.K = D; d.drow0 = 32 * rb; return d; }
    r -= 2 * nGU;
    if (r < 2 * nD) { const int f = r / nD; r -= f * nD; const int kb = r / 64, nb = r % 64;
        d.W = a.in[I_WD] + (size_t)(L * 2 + f) * FF * D; d.ldw = D; d.k0 = 64 * kb; d.c0 = 32 * nb; d.gk = nullptr; d.WT = (bf16*)(ws + (f ? WT_D2 : WT_D1)); d.K = FF; d.drow0 = 32 * nb; return d; }
    r -= 2 * nD;
    if (r < nIN) {
        d.gk = a.in[I_NG] + (L * 3 + 1) * D; d.WT = (bf16*)(ws + WT_IN); d.K = D;
        if (even) { const int kb = r / 160, rb = r % 160, dd = 32 * rb; d.zero = dd >= E_IN; d.W = a.in[I_EWIN] + (size_t)li * D * E_IN; d.ldw = E_IN; d.k0 = 64 * kb; d.c0 = d.zero ? 0 : (dd < ZA ? A_COLS + dd : dd - ZA); d.drow0 = dd; }
        else { const int kb = r / 128, rb = r % 128; d.W = a.in[I_OWIN] + (size_t)li * D * ZO; d.ldw = ZO; d.k0 = 64 * kb; d.c0 = 32 * rb; d.drow0 = 32 * rb; }
        return d; }
    r -= nIN;
    { const int kb = r / 64, nb = r % 64; d.W = (even ? a.in[I_EWOUT] : a.in[I_OWOUT]) + (size_t)li * D * D; d.ldw = D; d.k0 = 64 * kb; d.c0 = 32 * nb; d.gk = nullptr; d.WT = (bf16*)(ws + WT_OUT); d.K = D; d.drow0 = 32 * nb; }
    return d;
}
__device__ __forceinline__ void prep_phase(const Args& a, int L, LAS unsigned char* lds, int vcu, int G, int wave, int lane, int mode) {
    asm volatile("" : "+s"(G));
    LAS float* scr = (LAS float*)(lds + wave * 16384);
    const int gw = vcu * NWAVES + wave, NGW = G * NWAVES;
    unsigned char* ws = a.ws;
    const bool even = !(L & 1); const int li = L >> 1;
    const int nGU = 32 * 352, nD = 88 * 64, nIN = 32 * (even ? 160 : 128), nOUT = 32 * 64;
    const int total = mode == 0 ? 2 * nGU + 2 * nD + nIN + nOUT : mode == 1 ? nGU + nD + nIN : nGU + nD + nOUT;
    const int sh0 = mode == 2 ? nGU : 0, sh1 = mode == 0 ? 0 : mode == 1 ? nGU : nGU + nD, sh2 = mode == 0 ? 0 : mode == 1 ? nGU + nD : nGU + nD + nIN;
#define PREP_IT(i) ((mode == 0) ? (i) : (i) < nGU ? (i) + sh0 : (i) < nGU + nD ? (i) + sh1 : (i) + sh2)
    if (gw < total) {
        TrDesc d0 = tr_desc(a, L, PREP_IT(gw)); float v0[32]; tr_load(d0, v0, lane);
        for (int it = gw; it < total; it += NGW) {
            const int itn = it + NGW; const bool hasn = itn < total; const int itx = hasn ? itn : it;
            TrDesc d1 = tr_desc(a, L, PREP_IT(itx)); float v1[32];
            if (hasn) tr_load(d1, v1, lane);
            tr_store(d0, v0, scr, lane);
            d0 = d1;
#pragma unroll
            for (int i = 0; i < 32; ++i) v0[i] = v1[i];
        }
    }
#undef PREP_IT
    if (mode != 2) {
        const int gt = gw * 64 + lane, NGT = NGW * 64;
        if (even) {
            const float* w2 = a.in[I_EW2] + (size_t)li * 64 * 1024; const float* a2 = a.in[I_EA2] + (size_t)li * 64 * 1024; const float* g2 = a.in[I_EG2] + (size_t)li * 160 * 1024;
            bf16* W2T = (bf16*)(ws + SM_W2T); bf16* A2T = (bf16*)(ws + SM_A2T); bf16* G2T = (bf16*)(ws + SM_G2T);
            for (int e = gt; e < 1024 * 64; e += NGT) { const int k = e >> 10, c = e & 1023; W2T[c * 64 + k] = (bf16)f2bf(w2[e]); A2T[c * 64 + k] = (bf16)f2bf(a2[e]); }
            for (int e = gt; e < 1024 * 160; e += NGT) { const int k = e >> 10, c = e & 1023; G2T[c * 160 + k] = (bf16)f2bf(g2[e]); }
            if (li > 0) { bf16* V1T = (bf16*)(ws + SM_V1T); bf16* V2T = (bf16*)(ws + SM_V2T);
                for (int e = gt; e < 1024 * 32; e += NGT) { const int c = e >> 5, j = e & 31; V1T[j * 1024 + c] = (bf16)f2bf(a.in[I_V1][e]); }
                for (int e = gt; e < 32 * 1024; e += NGT) { const int j = e >> 10, c = e & 1023; V2T[c * 32 + j] = (bf16)f2bf(a.in[I_V2][e]); } }
        } else {
            const float* wsg = a.in[I_OWS] + (size_t)li * 16 * 128 * 128; bf16* WSB = (bf16*)(ws + SM_WSB);
            for (int e = gt; e < 16 * 128 * 128; e += NGT) { const int i = (e >> 7) & 127, j = e & 127; WSB[e] = (bf16)f2bf(j <= i ? wsg[e] : 0.f); }
        }
    }
    if (L == 0) {
        float* ss0 = (float*)(ws + WS_SS); bf16* XB = (bf16*)(ws + WS_XB);
        for (int m = gw; m < M; m += NGW) {
            const GAS f32x4* xr = (const GAS f32x4*)(a.in[I_X] + (size_t)m * D) + lane; GAS v2u* o = (GAS v2u*)(XB + (size_t)m * D) + lane; float s = 0.f;
#pragma unroll
            for (int j = 0; j < 8; ++j) { const f32x4 v = xr[64 * j]; s += (v.x * v.x + v.y * v.y) + (v.z * v.z + v.w * v.w); v2u w; w.x = pk2(v.x, v.y); w.y = pk2(v.z, v.w); o[64 * j] = w; }
            s = wave_sum(s); if (lane < 8) ss0[(size_t)lane * M + m] = lane ? 0.f : s;
        }
    }
}

typedef short bf16x8_t __attribute__((ext_vector_type(8)));
__device__ __forceinline__ float fast_tanh(float x) { const float e = __expf(2.0f * x); return 1.0f - 2.0f / (1.0f + e); }
__device__ __forceinline__ void lerp8(const v4u c, const v4u p, const float* mu, float (&o)[8]) {
    const f32x4 m0 = *(const f32x4*)mu, m1 = *(const f32x4*)(mu + 4);
    const float c0 = bflo(c.x), c1 = bfhi(c.x), c2 = bflo(c.y), c3 = bfhi(c.y), c4 = bflo(c.z), c5 = bfhi(c.z), c6 = bflo(c.w), c7 = bfhi(c.w);
    o[0] = c0 + (bflo(p.x) - c0) * m0.x; o[1] = c1 + (bfhi(p.x) - c1) * m0.y; o[2] = c2 + (bflo(p.y) - c2) * m0.z; o[3] = c3 + (bfhi(p.y) - c3) * m0.w;
    o[4] = c4 + (bflo(p.z) - c4) * m1.x; o[5] = c5 + (bfhi(p.z) - c5) * m1.y; o[6] = c6 + (bflo(p.w) - c6) * m1.z; o[7] = c7 + (bfhi(p.w) - c7) * m1.w;
}
__device__ __forceinline__ void lerp4(const v2u c, const v2u p, const f32x4 m, float (&o)[4]) {
    const float c0 = bflo(c.x), c1 = bfhi(c.x), c2 = bflo(c.y), c3 = bfhi(c.y);
    o[0] = c0 + (bflo(p.x) - c0) * m.x; o[1] = c1 + (bfhi(p.x) - c1) * m.y; o[2] = c2 + (bflo(p.y) - c2) * m.z; o[3] = c3 + (bfhi(p.y) - c3) * m.w;
}
__device__ __forceinline__ v2u pack4(float a, float b, float c, float d) { v2u w; w.x = pk2(a, b); w.y = pk2(c, d); return w; }
constexpr int E1_AW = 0, E1_AA = 9216, E1_AG = 18432, E1_PP = 40960, E1_PB = 106496;
__device__ __forceinline__ void e1_phase(const Args& a, int li, LAS unsigned char* ldsb, int vcu, int G, int tid) {
    unsigned char* ws = a.ws;
    const bf16* Z = (const bf16*)(ws + WS_ACT);
    bf16* R = (bf16*)(ws + SC_R); bf16* K2 = (bf16*)(ws + SC_K2); bf16* KK = (bf16*)(ws + SC_KK); bf16* BB = (bf16*)(ws + SC_BB); bf16* LW = (bf16*)(ws + SC_LW); bf16* GG = (bf16*)(ws + SC_GG);
    bf16* VO = (bf16*)(ws + (li ? WS_V2 : WS_VF)); const bf16* VF = (const bf16*)(ws + WS_VF);
    const bf16* W2T = (const bf16*)(ws + SM_W2T); const bf16* A2T = (const bf16*)(ws + SM_A2T); const bf16* G2T = (const bf16*)(ws + SM_G2T);
    const bf16* V1T = (const bf16*)(ws + SM_V1T); const bf16* V2T = (const bf16*)(ws + SM_V2T);
    const float* mu = a.in[I_EMU] + li * A_COLS;
    const float* w0 = a.in[I_EW0] + li * 1024; const float* a0 = a.in[I_EA0] + li * 1024;
    const float* kkw = a.in[I_EKK] + li * 1024; const float* kaw = a.in[I_EKA] + li * 1024; const float* v0w = a.in[I_V0];
    const int lane = tid & 63, wave = tid >> 6, fr = lane & 15, fq = lane >> 4;
    for (int unit = vcu; unit < M / 64; unit += G) {
        const int m0 = unit * 64;
        for (int e = tid; e < 64 * 36; e += NTHR) { const int r = e / 36, ch = e % 36, j0 = 8 * ch, m = m0 + r; const bool first = (m & (T - 1)) == 0;
            const v4u cur = *(const GAS v4u*)(Z + (size_t)m * ZN + ZA + 3072 + j0); v4u prv = {0u, 0u, 0u, 0u}; if (!first) prv = *(const GAS v4u*)(Z + (size_t)(m - 1) * ZN + ZA + 3072 + j0);
            float x[8]; lerp8(cur, prv, mu + 3072 + j0, x);
            if (j0 < 64) {
#pragma unroll
                for (int i = 0; i < 8; ++i) x[i] = fast_tanh(x[i]);
            } else if (j0 >= 128) {
#pragma unroll
                for (int i = 0; i < 8; ++i) x[i] = sigmoidf_(x[i]);
            }
            v4u o; o.x = pk2(x[0], x[1]); o.y = pk2(x[2], x[3]); o.z = pk2(x[4], x[5]); o.w = pk2(x[6], x[7]);
            LAS unsigned char* dst = j0 < 64 ? ldsb + E1_AW + r * 144 + j0 * 2 : j0 < 128 ? ldsb + E1_AA + r * 144 + (j0 - 64) * 2 : ldsb + E1_AG + r * 336 + (j0 - 128) * 2;
            *(LAS v4u*)dst = o; }
        if (li > 0) {
            f32x4 pacc[4][2];
#pragma unroll
            for (int mt = 0; mt < 4; ++mt) { pacc[mt][0] = (f32x4){0.f, 0.f, 0.f, 0.f}; pacc[mt][1] = pacc[mt][0]; }
            for (int ks = 0; ks < 4; ++ks) { const int c = 128 * wave + 32 * ks + 8 * fq;
                const bf16x8_t w0f = *(const GAS bf16x8_t*)(V1T + (size_t)fr * 1024 + c), w1f = *(const GAS bf16x8_t*)(V1T + (size_t)(16 + fr) * 1024 + c);
#pragma unroll
                for (int mt = 0; mt < 4; ++mt) { const int m = m0 + 16 * mt + fr; const bool first = (m & (T - 1)) == 0;
                    const v4u cur = *(const GAS v4u*)(Z + (size_t)m * ZN + ZA + 2048 + c); v4u prv = {0u, 0u, 0u, 0u}; if (!first) prv = *(const GAS v4u*)(Z + (size_t)(m - 1) * ZN + ZA + 2048 + c);
                    float x[8]; lerp8(cur, prv, mu + 2048 + c, x);
                    v4u o; o.x = pk2(x[0], x[1]); o.y = pk2(x[2], x[3]); o.z = pk2(x[4], x[5]); o.w = pk2(x[6], x[7]);
                    const bf16x8_t af = __builtin_bit_cast(bf16x8_t, o);
                    pacc[mt][0] = __builtin_amdgcn_mfma_f32_16x16x32_bf16(w0f, af, pacc[mt][0], 0, 0, 0); pacc[mt][1] = __builtin_amdgcn_mfma_f32_16x16x32_bf16(w1f, af, pacc[mt][1], 0, 0, 0); } }
#pragma unroll
            for (int mt = 0; mt < 4; ++mt)
#pragma unroll
                for (int nt = 0; nt < 2; ++nt) *(LAS f32x4*)(ldsb + E1_PP + ((wave * 64 + 16 * mt + fr) * 32 + 16 * nt + 4 * fq) * 4) = pacc[mt][nt];
        }
        __syncthreads();
        if (li > 0) {
            for (int e = tid; e < 64 * 32; e += NTHR) { float sum = 0.f;
#pragma unroll
                for (int w = 0; w < 8; ++w) sum += *(const LAS float*)(ldsb + E1_PP + (w * 2048 + e) * 4);
                *(LAS bf16*)(ldsb + E1_PB + (e >> 5) * 80 + (e & 31) * 2) = (bf16)f2bf(sum); }
            __syncthreads();
        }
#define E1_WROW(nt) (cb + 32 * ((nt) >> 1) + 8 * (fr >> 2) + 4 * ((nt) & 1) + (fr & 3))
#pragma unroll 1
        for (int hh = 0; hh < 2; ++hh) {
            const int cb = 128 * wave + 64 * hh;
            {
                bf16x8_t wa[4][2];
#pragma unroll
                for (int nt = 0; nt < 4; ++nt)
#pragma unroll
                    for (int ks = 0; ks < 2; ++ks) wa[nt][ks] = *(const GAS bf16x8_t*)(A2T + (size_t)E1_WROW(nt) * 64 + 32 * ks + 8 * fq);
                v4u ncur[2], nprv[2];
                { const int m = m0 + fr; const bool first = (m & (T - 1)) == 0; const size_t zo = (size_t)m * ZN + ZA + cb + 8 * fq;
#pragma unroll
                  for (int p = 0; p < 2; ++p) { ncur[p] = *(const GAS v4u*)(Z + zo + 1024 + 32 * p); nprv[p] = (v4u){0u, 0u, 0u, 0u}; if (!first) nprv[p] = *(const GAS v4u*)(Z + zo - ZN + 1024 + 32 * p); } }
#pragma unroll 1
                for (int mt = 0; mt < 4; ++mt) {
                    const int m = m0 + 16 * mt + fr;
                    v4u ccur[2], cprv[2];
#pragma unroll
                    for (int p = 0; p < 2; ++p) { ccur[p] = ncur[p]; cprv[p] = nprv[p]; }
                    if (mt < 3) { const size_t zn = (size_t)(m + 16) * ZN + ZA + cb + 8 * fq;
#pragma unroll
                        for (int p = 0; p < 2; ++p) { ncur[p] = *(const GAS v4u*)(Z + zn + 1024 + 32 * p); nprv[p] = *(const GAS v4u*)(Z + zn - ZN + 1024 + 32 * p); } }
                    f32x4 aa[4];
#pragma unroll
                    for (int nt = 0; nt < 4; ++nt) aa[nt] = (f32x4){0.f, 0.f, 0.f, 0.f};
#pragma unroll
                    for (int ks = 0; ks < 2; ++ks) { const bf16x8_t fa = *(const LAS bf16x8_t*)(ldsb + E1_AA + (16 * mt + fr) * 144 + (32 * ks + 8 * fq) * 2);
#pragma unroll
                        for (int nt = 0; nt < 4; ++nt) aa[nt] = __builtin_amdgcn_mfma_f32_16x16x32_bf16(wa[nt][ks], fa, aa[nt], 0, 0, 0); }
                    float k1[2][8], av[2][8], kk0[2][8]; float n2 = 0.f;
#pragma unroll
                    for (int p = 0; p < 2; ++p) { const int c = cb + 32 * p + 8 * fq;
                        lerp8(ccur[p], cprv[p], mu + 1024 + c, k1[p]);
                        const f32x4 a00 = *(const f32x4*)(a0 + c), a01 = *(const f32x4*)(a0 + c + 4), kk00 = *(const f32x4*)(kkw + c), kk01 = *(const f32x4*)(kkw + c + 4);
#pragma unroll
                        for (int j = 0; j < 8; ++j) { const float a0j = j < 4 ? a00[j & 3] : a01[j & 3], kkj = j < 4 ? kk00[j & 3] : kk01[j & 3];
                            av[p][j] = sigmoidf_(a0j + aa[2 * p + (j >> 2)][j & 3]); kk0[p][j] = k1[p][j] * kkj; n2 += kk0[p][j] * kk0[p][j]; } }
                    n2 += __shfl_xor(n2, 16); n2 += __shfl_xor(n2, 32);
                    const float inv = 1.0f / fmaxf(sqrtf(n2), 1e-12f);
#pragma unroll
                    for (int p = 0; p < 2; ++p) { const int c = cb + 32 * p + 8 * fq; const size_t o = (size_t)m * 1024 + c; const f32x4 ka0 = *(const f32x4*)(kaw + c), ka1 = *(const f32x4*)(kaw + c + 4);
                        float kk[8], k2[8], bb[8];
#pragma unroll
                        for (int j = 0; j < 8; ++j) { const float kaj = j < 4 ? ka0[j & 3] : ka1[j & 3]; kk[j] = kk0[p][j] * inv; k2[j] = k1[p][j] * (1.0f + (av[p][j] - 1.0f) * kaj); bb[j] = kk[j] * av[p][j]; }
                        *(GAS v4u*)(KK + o) = (v4u){pk2(kk[0], kk[1]), pk2(kk[2], kk[3]), pk2(kk[4], kk[5]), pk2(kk[6], kk[7])};
                        *(GAS v4u*)(K2 + o) = (v4u){pk2(k2[0], k2[1]), pk2(k2[2], k2[3]), pk2(k2[4], k2[5]), pk2(k2[6], k2[7])};
                        *(GAS v4u*)(BB + o) = (v4u){pk2(bb[0], bb[1]), pk2(bb[2], bb[3]), pk2(bb[4], bb[5]), pk2(bb[6], bb[7])}; }
                }
            }
            {
                bf16x8_t ww[4][2];
#pragma unroll
                for (int nt = 0; nt < 4; ++nt)
#pragma unroll
                    for (int ks = 0; ks < 2; ++ks) ww[nt][ks] = *(const GAS bf16x8_t*)(W2T + (size_t)E1_WROW(nt) * 64 + 32 * ks + 8 * fq);
#pragma unroll 1
                for (int mt = 0; mt < 4; ++mt) {
                    const int m = m0 + 16 * mt + fr;
                    f32x4 aw[4];
#pragma unroll
                    for (int nt = 0; nt < 4; ++nt) aw[nt] = (f32x4){0.f, 0.f, 0.f, 0.f};
#pragma unroll
                    for (int ks = 0; ks < 2; ++ks) { const bf16x8_t fw = *(const LAS bf16x8_t*)(ldsb + E1_AW + (16 * mt + fr) * 144 + (32 * ks + 8 * fq) * 2);
#pragma unroll
                        for (int nt = 0; nt < 4; ++nt) aw[nt] = __builtin_amdgcn_mfma_f32_16x16x32_bf16(ww[nt][ks], fw, aw[nt], 0, 0, 0); }
#pragma unroll
                    for (int p = 0; p < 2; ++p) { const int c = cb + 32 * p + 8 * fq; const f32x4 w00 = *(const f32x4*)(w0 + c), w01 = *(const f32x4*)(w0 + c + 4); float lw[8];
#pragma unroll
                        for (int j = 0; j < 8; ++j) { const float y = -((j < 4 ? w00[j & 3] : w01[j & 3]) + aw[2 * p + (j >> 2)][j & 3]); const float sp = fmaxf(y, 0.f) + __logf(1.0f + __expf(-fabsf(y))); lw[j] = -__expf(-sp - 0.5f); }
                        *(GAS v4u*)(LW + (size_t)m * 1024 + c) = (v4u){pk2(lw[0], lw[1]), pk2(lw[2], lw[3]), pk2(lw[4], lw[5]), pk2(lw[6], lw[7])}; }
                }
            }
            {
                bf16x8_t wg[4][5];
#pragma unroll
                for (int nt = 0; nt < 4; ++nt)
#pragma unroll
                    for (int ks = 0; ks < 5; ++ks) wg[nt][ks] = *(const GAS bf16x8_t*)(G2T + (size_t)E1_WROW(nt) * 160 + 32 * ks + 8 * fq);
#pragma unroll 1
                for (int mt = 0; mt < 4; ++mt) {
                    const int m = m0 + 16 * mt + fr;
                    f32x4 ag[4];
#pragma unroll
                    for (int nt = 0; nt < 4; ++nt) ag[nt] = (f32x4){0.f, 0.f, 0.f, 0.f};
#pragma unroll
                    for (int ks = 0; ks < 5; ++ks) { const bf16x8_t fg = *(const LAS bf16x8_t*)(ldsb + E1_AG + (16 * mt + fr) * 336 + (32 * ks + 8 * fq) * 2);
#pragma unroll
                        for (int nt = 0; nt < 4; ++nt) ag[nt] = __builtin_amdgcn_mfma_f32_16x16x32_bf16(wg[nt][ks], fg, ag[nt], 0, 0, 0); }
#pragma unroll
                    for (int p = 0; p < 2; ++p) *(GAS v4u*)(GG + (size_t)m * 1024 + cb + 32 * p + 8 * fq) = (v4u){pk2(ag[2 * p][0], ag[2 * p][1]), pk2(ag[2 * p][2], ag[2 * p][3]), pk2(ag[2 * p + 1][0], ag[2 * p + 1][1]), pk2(ag[2 * p + 1][2], ag[2 * p + 1][3])};
                }
            }
            {
                v4u nrc[2], nrp[2];
                { const int m = m0 + fr; const bool first = (m & (T - 1)) == 0; const size_t zo = (size_t)m * ZN + ZA + cb + 8 * fq;
#pragma unroll
                  for (int p = 0; p < 2; ++p) { nrc[p] = *(const GAS v4u*)(Z + zo + 32 * p); nrp[p] = (v4u){0u, 0u, 0u, 0u}; if (!first) nrp[p] = *(const GAS v4u*)(Z + zo - ZN + 32 * p); } }
#pragma unroll 1
                for (int mt = 0; mt < 4; ++mt) {
                    const int m = m0 + 16 * mt + fr;
                    v4u crc[2], crp[2];
#pragma unroll
                    for (int p = 0; p < 2; ++p) { crc[p] = nrc[p]; crp[p] = nrp[p]; }
                    if (mt < 3) { const size_t zn = (size_t)(m + 16) * ZN + ZA + cb + 8 * fq;
#pragma unroll
                        for (int p = 0; p < 2; ++p) { nrc[p] = *(const GAS v4u*)(Z + zn + 32 * p); nrp[p] = *(const GAS v4u*)(Z + zn - ZN + 32 * p); } }
#pragma unroll
                    for (int p = 0; p < 2; ++p) { const int c = cb + 32 * p + 8 * fq; float rr[8]; lerp8(crc[p], crp[p], mu + c, rr);
                        *(GAS v4u*)(R + (size_t)m * 1024 + c) = (v4u){pk2(rr[0], rr[1]), pk2(rr[2], rr[3]), pk2(rr[4], rr[5]), pk2(rr[6], rr[7])}; }
                }
            }
            {
                bf16x8_t wv2[4];
#pragma unroll
                for (int nt = 0; nt < 4; ++nt) { wv2[nt] = (bf16x8_t){0, 0, 0, 0, 0, 0, 0, 0}; if (li > 0) wv2[nt] = *(const GAS bf16x8_t*)(V2T + (size_t)E1_WROW(nt) * 32 + 8 * fq); }
                v4u nvc[2], nvp[2];
                { const int m = m0 + fr; const bool first = (m & (T - 1)) == 0; const size_t zo = (size_t)m * ZN + ZA + cb + 8 * fq;
#pragma unroll
                  for (int p = 0; p < 2; ++p) { nvc[p] = *(const GAS v4u*)(Z + zo + 2048 + 32 * p); nvp[p] = (v4u){0u, 0u, 0u, 0u}; if (!first) nvp[p] = *(const GAS v4u*)(Z + zo - ZN + 2048 + 32 * p); } }
#pragma unroll 1
                for (int mt = 0; mt < 4; ++mt) {
                    const int m = m0 + 16 * mt + fr;
                    v4u cvc[2], cvp[2];
#pragma unroll
                    for (int p = 0; p < 2; ++p) { cvc[p] = nvc[p]; cvp[p] = nvp[p]; }
                    if (mt < 3) { const size_t zn = (size_t)(m + 16) * ZN + ZA + cb + 8 * fq;
#pragma unroll
                        for (int p = 0; p < 2; ++p) { nvc[p] = *(const GAS v4u*)(Z + zn + 2048 + 32 * p); nvp[p] = *(const GAS v4u*)(Z + zn - ZN + 2048 + 32 * p); } }
                    f32x4 avr[4];
#pragma unroll
                    for (int nt = 0; nt < 4; ++nt) avr[nt] = (f32x4){0.f, 0.f, 0.f, 0.f};
                    if (li > 0) { const bf16x8_t fp = *(const LAS bf16x8_t*)(ldsb + E1_PB + (16 * mt + fr) * 80 + (8 * fq) * 2);
#pragma unroll
                        for (int nt = 0; nt < 4; ++nt) avr[nt] = __builtin_amdgcn_mfma_f32_16x16x32_bf16(wv2[nt], fp, avr[nt], 0, 0, 0); }
#pragma unroll
                    for (int p = 0; p < 2; ++p) { const int c = cb + 32 * p + 8 * fq; const size_t o = (size_t)m * 1024 + c;
                        float vv[8]; lerp8(cvc[p], cvp[p], mu + 2048 + c, vv);
                        if (li > 0) { const f32x4 v00 = *(const f32x4*)(v0w + c), v01 = *(const f32x4*)(v0w + c + 4); const v4u vf = *(const GAS v4u*)(VF + o);
                            const float f[8] = {bflo(vf.x), bfhi(vf.x), bflo(vf.y), bfhi(vf.y), bflo(vf.z), bfhi(vf.z), bflo(vf.w), bfhi(vf.w)};
#pragma unroll
                            for (int j = 0; j < 8; ++j) vv[j] += (f[j] - vv[j]) * sigmoidf_((j < 4 ? v00[j & 3] : v01[j & 3]) + avr[2 * p + (j >> 2)][j & 3]); }
                        *(GAS v4u*)(VO + o) = (v4u){pk2(vv[0], vv[1]), pk2(vv[2], vv[3]), pk2(vv[4], vv[5]), pk2(vv[6], vv[7])}; }
                }
            }
        }
#undef E1_WROW
        __syncthreads();
    }
}

constexpr size_t CS_AR = WS_ACT, CS_BK = WS_ACT + 128 * MiB, CS_Y0 = WS_ACT + 256 * MiB, CS_GL = WS_ACT + 320 * MiB;
__device__ __forceinline__ int cs_perm(int k) { return (k & 32) + 8 * ((k >> 2) & 3) + 4 * ((k >> 4) & 1) + (k & 3); }
__device__ __forceinline__ f32x4 mm16_ll(const LAS float* A, const LAS float* B, f32x4 c, int fr, int fq) {
    const f32x4 a4 = *(const LAS f32x4*)(A + fr * 16 + 4 * fq);
#pragma unroll
    for (int s = 0; s < 4; ++s) c = __builtin_amdgcn_mfma_f32_16x16x4f32(a4[s], B[(4 * fq + s) * 16 + fr], c, 0, 0, 0);
    return c;
}
__device__ __forceinline__ f32x4 mm16_la(const LAS float* A, const f32x4 b, f32x4 c, int fr, int fq) {
    const f32x4 a4 = *(const LAS f32x4*)(A + fr * 16 + 4 * fq);
#pragma unroll
    for (int s = 0; s < 4; ++s) c = __builtin_amdgcn_mfma_f32_16x16x4f32(a4[s], b[s], c, 0, 0, 0);
    return c;
}
__device__ __forceinline__ void st16(LAS float* Mx, const f32x4 c, int fr, int fq) {
#pragma unroll
    for (int r = 0; r < 4; ++r) Mx[(4 * fq + r) * 16 + fr] = c[r];
}
__device__ __forceinline__ void scanpre_phase(const Args& a, int li, LAS unsigned char* ldsb, int vcu, int G, int tid) {
    unsigned char* ws = a.ws;
    const bf16* Rr = (const bf16*)(ws + SC_R); const bf16* K2 = (const bf16*)(ws + SC_K2); const bf16* KK = (const bf16*)(ws + SC_KK); const bf16* BB = (const bf16*)(ws + SC_BB); const bf16* LW = (const bf16*)(ws + SC_LW);
    const bf16* V = (const bf16*)(ws + (li ? WS_V2 : WS_VF));
    bf16* ARo = (bf16*)(ws + CS_AR); bf16* BKo = (bf16*)(ws + CS_BK); bf16* Y0o = (bf16*)(ws + CS_Y0); float* GLo = (float*)(ws + CS_GL); bf16* U0o = (bf16*)(ws + WS_U0);
    const int lane = tid & 63, wave = tid >> 6, fr = lane & 15, fq = lane >> 4;
    LAS unsigned char* wl = ldsb + wave * 17408;
    LAS bf16* LAR = (LAS bf16*)wl; LAS bf16* LBK = (LAS bf16*)(wl + 4608); LAS float* LM = (LAS float*)(wl + 9216); LAS float* LX = (LAS float*)(wl + 13312);
    const LAS float* Mab = LM, *Mak = LM + 256, *Mrb = LM + 512, *Mrk = LM + 768;
    LAS float* Tm = LX, *Na = LX + 256, *Nb = LX + 512;
    for (int ch = vcu * NWAVES + wave; ch < 32 * 1024; ch += G * NWAVES) {
        const int bh = ch >> 10, ci = ch & 1023, b = bh >> 4, h = bh & 15; const size_t row0 = (size_t)b * T + 16 * ci;
        f32x4 At[4], Rt[4], vv[4]; float glane;
#pragma unroll
        for (int nt = 0; nt < 4; ++nt) { f32x4 lw, kk, bb, k2, rr;
#pragma unroll
            for (int s = 0; s < 4; ++s) { const size_t o = (row0 + 4 * fq + s) * 1024 + h * 64 + 16 * nt + fr;
                lw[s] = bf2f(LW[o]); kk[s] = bf2f(KK[o]); bb[s] = bf2f(BB[o]); k2[s] = bf2f(K2[o]); rr[s] = bf2f(Rr[o]); vv[nt][s] = bf2f(V[o]); }
            f32x4 cum; cum[0] = lw[0]; cum[1] = cum[0] + lw[1]; cum[2] = cum[1] + lw[2]; cum[3] = cum[2] + lw[3];
            float x = cum[3]; { const float y = __shfl_up(x, 16); if (fq >= 1) x += y; } { const float y = __shfl_up(x, 32); if (fq >= 2) x += y; }
            const float excl = x - cum[3]; const float cl = __shfl(x, 48 + fr);
            bf16* bo = BKo + (size_t)ch * 2048 + (16 * nt + fr) * 32 + 8 * fq; f32x4 bh4, kh4;
#pragma unroll
            for (int s = 0; s < 4; ++s) { const float c = excl + cum[s]; const float g = __expf(c), gp = __expf(c - lw[s]), gi = __expf(-c), e = __expf(cl - c);
                At[nt][s] = -kk[s] * gp; Rt[nt][s] = rr[s] * g; bh4[s] = bb[s] * e; kh4[s] = k2[s] * e;
                const int t = 4 * fq + s, cc = 16 * nt + fr;
                LAR[t * 72 + cc] = (bf16)f2bf(At[nt][s]); LAR[(16 + t) * 72 + cc] = (bf16)f2bf(Rt[nt][s]); LBK[t * 72 + cc] = (bf16)f2bf(bb[s] * gi); LBK[(16 + t) * 72 + cc] = (bf16)f2bf(k2[s] * gi); }
            *(GAS v4u*)bo = (v4u){pk2(bh4[0], bh4[1]), pk2(bh4[2], bh4[3]), pk2(kh4[0], kh4[1]), pk2(kh4[2], kh4[3])};
            if (fq == 0) GLo[(size_t)ch * 64 + 16 * nt + fr] = __expf(cl);
            glane = cl; }
        (void)glane;
        LDS_WAIT(); asm volatile("" ::: "memory");
#pragma unroll
        for (int mt = 0; mt < 2; ++mt)
#pragma unroll
            for (int nt = 0; nt < 2; ++nt) { f32x4 m = {0.f, 0.f, 0.f, 0.f};
#pragma unroll
                for (int ks = 0; ks < 2; ++ks) { const bf16x8_t af = *(const LAS bf16x8_t*)(LAR + (16 * mt + fr) * 72 + 32 * ks + 8 * fq), bfr = *(const LAS bf16x8_t*)(LBK + (16 * nt + fr) * 72 + 32 * ks + 8 * fq);
                    m = __builtin_amdgcn_mfma_f32_16x16x32_bf16(af, bfr, m, 0, 0, 0); }
#pragma unroll
                for (int r = 0; r < 4; ++r) { const int t = 4 * fq + r; const bool keep = mt ? (fr <= t) : (fr < t); LM[((mt * 2 + nt) * 16 + t) * 16 + fr] = keep ? m[r] : 0.f; } }
        LDS_WAIT(); asm volatile("" ::: "memory");
        { const f32x4 z = {0.f, 0.f, 0.f, 0.f};
          f32x4 t1;
#pragma unroll
          for (int r = 0; r < 4; ++r) t1[r] = Mab[(4 * fq + r) * 16 + fr] + ((4 * fq + r) == fr ? 1.0f : 0.f);
          st16(Tm, t1, fr, fq);
          f32x4 n2 = mm16_ll(Mab, Mab, z, fr, fq); st16(Na, n2, fr, fq);
          LDS_WAIT(); asm volatile("" ::: "memory");
          f32x4 t2 = mm16_ll(Tm, Na, t1, fr, fq);
          f32x4 n4 = mm16_ll(Na, Na, z, fr, fq);
          LDS_WAIT(); asm volatile("" ::: "memory");
          st16(Tm, t2, fr, fq); st16(Nb, n4, fr, fq);
          LDS_WAIT(); asm volatile("" ::: "memory");
          f32x4 t3 = mm16_ll(Tm, Nb, t2, fr, fq);
          f32x4 n8 = mm16_ll(Nb, Nb, z, fr, fq);
          LDS_WAIT(); asm volatile("" ::: "memory");
          st16(Tm, t3, fr, fq); st16(Na, n8, fr, fq);
          LDS_WAIT(); asm volatile("" ::: "memory");
          f32x4 t4 = mm16_ll(Tm, Na, t3, fr, fq);
          LDS_WAIT(); asm volatile("" ::: "memory");
          st16(Tm, t4, fr, fq);
          LDS_WAIT(); asm volatile("" ::: "memory"); }
#pragma unroll
        for (int nt = 0; nt < 4; ++nt) { const f32x4 z = {0.f, 0.f, 0.f, 0.f};
            const f32x4 w1 = mm16_la(Mak, vv[nt], z, fr, fq);
            const f32x4 u0 = mm16_la(Tm, w1, z, fr, fq);
            const f32x4 ah = mm16_la(Tm, At[nt], z, fr, fq);
            const f32x4 rh = mm16_la(Mrb, ah, Rt[nt], fr, fq);
            f32x4 y0 = mm16_la(Mrb, u0, z, fr, fq); y0 = mm16_la(Mrk, vv[nt], y0, fr, fq);
            const int k = 16 * nt + fr; bf16* arp = ARo + (size_t)ch * 2048 + cs_perm(k);
#pragma unroll
            for (int s = 0; s < 4; ++s) { arp[(4 * fq + s) * 64] = (bf16)f2bf(ah[s]); arp[(16 + 4 * fq + s) * 64] = (bf16)f2bf(rh[s]); }
            *(GAS v2u*)(Y0o + (size_t)ch * 1024 + k * 16 + 4 * fq) = pack4(y0[0], y0[1], y0[2], y0[3]);
            *(GAS v2u*)(U0o + (size_t)ch * 1024 + k * 16 + 4 * fq) = pack4(u0[0], u0[1], u0[2], u0[3]); }
        LDS_WAIT(); asm volatile("" ::: "memory");
    }
}
#ifndef PF_ON
#define PF_ON 0
#endif
constexpr int CQ_NS = 13, CQ_SLOT = 10240, CQ_FULL = CQ_NS * CQ_SLOT, CQ_DONE = CQ_FULL + 64, CQ_NL = 6;
#define CQ_GLDS(src, dst) __builtin_amdgcn_global_load_lds((const unsigned*)(src), (LAS unsigned*)(dst), 16, 0, 0)
typedef unsigned short u16x2_t __attribute__((ext_vector_type(2)));
struct CqOps { bf16x8_t ar[2][2], bk[4]; f32x4 gl[4]; v2u u0, y0; u16x2_t v01, v23; f32x4 u0f, y0f; };
__device__ __forceinline__ void cq_load(CqOps& o, LAS unsigned char* sl, int fr, int fq) {
#pragma unroll
    for (int mt = 0; mt < 2; ++mt)
#pragma unroll
        for (int ks = 0; ks < 2; ++ks) { const int r = 16 * mt + fr; o.ar[mt][ks] = *(const LAS bf16x8_t*)(sl + r * 128 + 16 * ((4 * ks + fq) ^ (r & 7))); }
#pragma unroll
    for (int kt = 0; kt < 4; ++kt) { const int k = 16 * kt + fr; o.bk[kt] = *(const LAS bf16x8_t*)(sl + 4096 + k * 64 + 16 * (fq ^ ((k >> 2) & 3))); o.gl[kt] = *(const LAS f32x4*)(sl + 9728 + (16 * kt + 4 * fq) * 4); }
    o.u0 = *(const LAS v2u*)(sl + 8192 + fr * 32 + 8 * fq); o.y0 = *(const LAS v2u*)(sl + 8704 + fr * 32 + 8 * fq);
    const LAS unsigned short* vp = (const LAS unsigned short*)(sl + 9216 + (4 * fq) * 32 + 2 * fr);
    o.v01.x = vp[0]; o.v01.y = vp[16]; o.v23.x = vp[32]; o.v23.y = vp[48];
}
__device__ __forceinline__ void cq_unpack(CqOps& o) {
    o.u0f = (f32x4){bflo(o.u0.x), bfhi(o.u0.x), bflo(o.u0.y), bfhi(o.u0.y)}; o.y0f = (f32x4){bflo(o.y0.x), bfhi(o.y0.x), bflo(o.y0.y), bfhi(o.y0.y)};
}
__device__ __forceinline__ void cq_step(const CqOps& cur, CqOps& nxt, f32x4 (&St)[4], LAS unsigned char* ldsb, int sn, int cn, volatile LAS unsigned* DONE, unsigned long long ya, unsigned long long yb, unsigned yvoff,
                                        int fr, int fq, bool signal, unsigned& spins) {
    volatile LAS unsigned* fp = (volatile LAS unsigned*)(ldsb + CQ_FULL) + sn; LAS unsigned char* sln = ldsb + sn * CQ_SLOT;
    unsigned fl = *fp;
    v4u w0; w0.x = pk2(St[0][0], St[0][1]); w0.y = pk2(St[0][2], St[0][3]); w0.z = pk2(St[1][0], St[1][1]); w0.w = pk2(St[1][2], St[1][3]); const bf16x8_t sb0 = __builtin_bit_cast(bf16x8_t, w0);
    f32x4 au = __builtin_amdgcn_mfma_f32_16x16x32_bf16(cur.ar[0][0], sb0, cur.u0f, 0, 0, 0);
    v4u w1; w1.x = pk2(St[2][0], St[2][1]); w1.y = pk2(St[2][2], St[2][3]); w1.z = pk2(St[3][0], St[3][1]); w1.w = pk2(St[3][2], St[3][3]); const bf16x8_t sb1 = __builtin_bit_cast(bf16x8_t, w1);
    f32x4 ay = __builtin_amdgcn_mfma_f32_16x16x32_bf16(cur.ar[1][0], sb0, cur.y0f, 0, 0, 0);
#define CQ_DECAY(kt) ({ float g0_ = cur.gl[kt][0], g1_ = cur.gl[kt][1], g2_ = cur.gl[kt][2], g3_ = cur.gl[kt][3]; asm("" : "+v"(g0_)); asm("" : "+v"(g1_)); asm("" : "+v"(g2_)); asm("" : "+v"(g3_)); \
                        (f32x4){St[kt][0] * g0_, St[kt][1] * g1_, St[kt][2] * g2_, St[kt][3] * g3_}; })
    f32x4 Sg[4]; Sg[0] = CQ_DECAY(0); Sg[1] = CQ_DECAY(1);
    au = __builtin_amdgcn_mfma_f32_16x16x32_bf16(cur.ar[0][1], sb1, au, 0, 0, 0);
    Sg[2] = CQ_DECAY(2); Sg[3] = CQ_DECAY(3);
#undef CQ_DECAY
    ay = __builtin_amdgcn_mfma_f32_16x16x32_bf16(cur.ar[1][1], sb1, ay, 0, 0, 0);
    __builtin_amdgcn_sched_barrier(0);
    while (__builtin_amdgcn_ballot_w64(fl != (unsigned)(cn + 1)) != 0ull) { fl = *fp; if (++spins > (1u << 26)) break; }
    __builtin_amdgcn_fence(__ATOMIC_ACQUIRE, "workgroup");
    cq_load(nxt, sln, fr, fq);
    __builtin_amdgcn_sched_barrier(0);
    v4u uw; uw.x = pk2(au[0], au[1]); uw.y = pk2(au[2], au[3]); uw.z = __builtin_bit_cast(unsigned, cur.v01); uw.w = __builtin_bit_cast(unsigned, cur.v23);
    const bf16x8_t uv = __builtin_bit_cast(bf16x8_t, uw);
#pragma unroll
    for (int kt = 0; kt < 4; ++kt) St[kt] = __builtin_amdgcn_mfma_f32_16x16x32_bf16(cur.bk[kt], uv, Sg[kt], 0, 0, 0);
    asm volatile("global_store_dword %0, %1, %2 offset:-4096" :: "v"(yvoff), "v"(ay[0]), "s"(ya) : "memory");
    asm volatile("global_store_dword %0, %1, %2" :: "v"(yvoff), "v"(ay[1]), "s"(ya) : "memory");
    asm volatile("global_store_dword %0, %1, %2 offset:-4096" :: "v"(yvoff), "v"(ay[2]), "s"(yb) : "memory");
    asm volatile("global_store_dword %0, %1, %2" :: "v"(yvoff), "v"(ay[3]), "s"(yb) : "memory");
    __builtin_amdgcn_s_waitcnt(0xC07F);
    cq_unpack(nxt);
    if (signal && fr + fq == 0) DONE[0] = (unsigned)(cn + 1);
}
__device__ __forceinline__ void scanseq_phase(const Args& a, int li, LAS unsigned char* ldsb, int vcu, int tid) {
    volatile LAS unsigned* FULL = (volatile LAS unsigned*)(ldsb + CQ_FULL); volatile LAS unsigned* DONE = (volatile LAS unsigned*)(ldsb + CQ_DONE);
    if (tid < 32) ((LAS unsigned*)(ldsb + CQ_FULL))[tid] = 0u;
    __syncthreads();
    const int wave = __builtin_amdgcn_readfirstlane(tid >> 6), lane = tid & 63;
    if (vcu < 128 && wave <= CQ_NL) {
        unsigned char* ws = a.ws;
        const int bh = vcu >> 2, vb = vcu & 3, b = bh >> 4, h = bh & 15; const size_t row0 = (size_t)b * T; const size_t ch0 = (size_t)bh * 1024;
        if (wave > 0) {
            const unsigned char* ARo = ws + CS_AR; const unsigned char* BKo = ws + CS_BK; const unsigned char* Y0o = ws + CS_Y0; const unsigned char* GLo = ws + CS_GL; const unsigned char* U0o = ws + WS_U0;
            const unsigned char* V = ws + (li ? WS_V2 : WS_VF);
            const unsigned oAR = (unsigned)((lane >> 3) * 128 + 16 * ((lane & 7) ^ ((lane >> 3) & 7)));
            unsigned oBK[4];
#pragma unroll
            for (int i = 0; i < 4; ++i) { const int k = 16 * i + (lane >> 2); oBK[i] = (unsigned)(k * 64 + 16 * ((lane & 3) ^ ((k >> 2) & 3))); }
            const unsigned oUY = (unsigned)((16 * vb + ((lane & 31) >> 1)) * 32 + 16 * (lane & 1));
            const size_t oV = ((size_t)(lane >> 1) * 1024 + h * 64 + 16 * vb) * 2 + 16 * (lane & 1);
            const unsigned oG = (unsigned)(16 * (lane & 15));
            int pub = wave - 1; unsigned spins = 0;
            for (int c = wave - 1; c < 1024; c += CQ_NL) {
                const int s = c % CQ_NS;
                if (c >= CQ_NS) { while ((int)DONE[0] < c - CQ_NS + 1) { __builtin_amdgcn_s_sleep(1); if (++spins > (1u << 24)) break; } }
                LAS unsigned char* sl = ldsb + s * CQ_SLOT; const size_t ch = ch0 + c;
                const unsigned char* ar = ARo + ch * 4096; const unsigned char* bk = BKo + ch * 4096;
#pragma unroll
                for (int i = 0; i < 4; ++i) CQ_GLDS(ar + i * 1024 + oAR, sl + i * 1024);
#pragma unroll
                for (int i = 0; i < 4; ++i) CQ_GLDS(bk + oBK[i], sl + 4096 + i * 1024);
                CQ_GLDS((lane < 32 ? U0o : Y0o) + ch * 2048 + oUY, sl + 8192);
                CQ_GLDS(lane < 32 ? V + (row0 + 16 * (size_t)c) * 2048 + oV : GLo + ch * 256 + oG, sl + 9216);
                asm volatile("s_waitcnt vmcnt(10)" ::: "memory");
                for (; pub <= c - CQ_NL; pub += CQ_NL) FULL[pub % CQ_NS] = (unsigned)(pub + 1);
            }
            asm volatile("s_waitcnt vmcnt(0)" ::: "memory");
            for (; pub < 1024; pub += CQ_NL) FULL[pub % CQ_NS] = (unsigned)(pub + 1);
        } else {
            float* Y = a.out;
            const int fr = lane & 15, fq = lane >> 4; const int colv = h * 64 + 16 * vb + fr;
            f32x4 St[4];
#pragma unroll
            for (int kt = 0; kt < 4; ++kt) St[kt] = (f32x4){0.f, 0.f, 0.f, 0.f};
            unsigned spins = 0;
            CqOps oa, ob;
            while (FULL[0] != 1u) { if (++spins > (1u << 26)) break; }
            __builtin_amdgcn_fence(__ATOMIC_ACQUIRE, "workgroup");
            cq_load(oa, ldsb, fr, fq);
            __builtin_amdgcn_s_waitcnt(0xC07F);
            cq_unpack(oa);
            if (lane == 0) DONE[0] = 1u;
            const unsigned yvoff = (unsigned)((4 * fq * 1024 + colv) * 4);
            unsigned long long yc = (unsigned long long)(size_t)(Y + row0 * 1024);
            int sn = 1;
#ifdef PROBE_STAMP
            const unsigned long long pc0_ = __builtin_readcyclecounter(), pr0_ = __builtin_amdgcn_s_memrealtime();
#endif
            for (int c = 0; c < 1024; c += 2) {
                cq_step(oa, ob, St, ldsb, sn, c + 1, DONE, yc + 4096, yc + 12288, yvoff, fr, fq, false, spins);
                yc += 65536; sn = (sn + 1 == CQ_NS) ? 0 : sn + 1;
                const bool lastc = (c + 2 >= 1024);
                const int sn2 = lastc ? sn - 1 < 0 ? CQ_NS - 1 : sn - 1 : sn, cn2 = lastc ? 1023 : c + 2;
                cq_step(ob, oa, St, ldsb, sn2, cn2, DONE, yc + 4096, yc + 12288, yvoff, fr, fq, true, spins);
                yc += 65536; sn = (sn + 1 == CQ_NS) ? 0 : sn + 1;
            }
#ifdef PROBE_STAMP
            { const unsigned long long pc1_ = __builtin_readcyclecounter(), pr1_ = __builtin_amdgcn_s_memrealtime();
              if (lane == 0 && vcu == 5) *((volatile unsigned*)(ws + WS_CTL) + 24576 + 200 + li) = (unsigned)((pc1_ - pc0_) * 100ull / (pr1_ - pr0_)); }
            if (lane == 0) atomicAdd((unsigned*)(ws + WS_CTL) + 24576 + (vcu & 127), spins);
#endif
        }
    }
    if (PF_ON && vcu >= 128 && vcu < 256) {
        unsigned char* ws = a.ws; const int pv = vcu - 128; const int bh = pv >> 2, vb = pv & 3, b = bh >> 4, h = bh & 15; const size_t row0 = (size_t)b * T; const size_t ch0 = (size_t)bh * 1024;
        const unsigned char* ARo = ws + CS_AR; const unsigned char* BKo = ws + CS_BK; const unsigned char* Y0o = ws + CS_Y0; const unsigned char* GLo = ws + CS_GL; const unsigned char* U0o = ws + WS_U0;
        const unsigned char* V = ws + (li ? WS_V2 : WS_VF);
        unsigned x = 0u;
        for (int c0 = wave * 4; c0 < 1024; c0 += 32) {
            unsigned t[8];
#pragma unroll
            for (int j = 0; j < 4; ++j) { const int c = c0 + j; const size_t ch = ch0 + c;
                const unsigned char* p0 = lane < 32 ? ARo + ch * 4096 + lane * 128 : BKo + ch * 4096 + (lane - 32) * 128;
                const unsigned char* p1 = lane < 4 ? U0o + ch * 2048 + 512 * vb + lane * 128 : lane < 8 ? Y0o + ch * 2048 + 512 * vb + (lane - 4) * 128
                                        : lane < 24 ? V + ((row0 + 16 * (size_t)c + (lane - 8)) * 1024 + h * 64 + 16 * vb) * 2 : GLo + ch * 256 + (lane & 1) * 128;
                t[2 * j] = *(const volatile GAS unsigned*)p0; t[2 * j + 1] = *(const volatile GAS unsigned*)p1; }
#pragma unroll
            for (int j = 0; j < 8; ++j) x ^= t[j];
        }
        if (x == 0x9e3779b9u && li == 77) *(volatile GAS unsigned*)(ws + WS_CTL + 65536) = x;
    }
    __syncthreads();
}

typedef float f32x16 __attribute__((ext_vector_type(16)));
constexpr int AT_K = 0, AT_V = 36864;
__device__ __forceinline__ bf16x8_t tr_frag(unsigned addr) {
    v2u lo, hi; asm volatile("ds_read_b64_tr_b16 %0, %2\n\tds_read_b64_tr_b16 %1, %2 offset:1536\n\ts_waitcnt lgkmcnt(0)" : "=&v"(lo), "=&v"(hi) : "v"(addr) : "memory");
    v4u w; w.x = lo.x; w.y = lo.y; w.z = hi.x; w.w = hi.y; return __builtin_bit_cast(bf16x8_t, w);
}
__device__ __forceinline__ void attn_unit(const Args& a, int li, int au, LAS unsigned char* ldsb, int tid) {
    unsigned char* ws = a.ws; const bf16* Z = (const bf16*)(ws + WS_ACT); bf16* O = (bf16*)(ws + WS_O);
    const int n = au & 127, kvh = (au >> 7) & 3, b = au >> 9;
    const size_t rblk = (size_t)b * T + (size_t)n * 128;
    for (int e = tid; e < 256 * 8 * 2; e += NTHR) { const int which = e >> 11, rem = e & 2047, j = rem >> 3, c8 = rem & 7; const bool valid = (n > 0) || (j >= 128);
        v4u w = {0u, 0u, 0u, 0u}; if (valid) w = *(const GAS v4u*)(Z + (rblk + j - 128) * ZN + 1024 + which * 256 + kvh * 64 + 8 * c8);
        *(LAS v4u*)(ldsb + (which ? AT_V + j * 192 : AT_K + j * 144) + c8 * 16) = w; }
    __syncthreads();
    const int lane = tid & 63, wave = tid >> 6, l31 = lane & 31, h = lane >> 5;
    const unsigned ldsbase = (unsigned)(size_t)ldsb;
#pragma unroll 1
    for (int it = 0; it < 2; ++it) {
        const int tt = 2 * wave + it, g = tt >> 2, qi = tt & 3, hq = kvh * 4 + g; const size_t qrow = rblk + 32 * qi + l31;
        bf16x8_t qf[4];
#pragma unroll
        for (int ks = 0; ks < 4; ++ks) qf[ks] = *(const GAS bf16x8_t*)(Z + qrow * ZN + hq * 64 + 16 * ks + 8 * h);
        f32x16 st[5];
#pragma unroll
        for (int kt = 0; kt < 5; ++kt) {
#pragma unroll
            for (int r = 0; r < 16; ++r) st[kt][r] = 0.f;
#pragma unroll
            for (int ks = 0; ks < 4; ++ks) { const bf16x8_t kf = *(const LAS bf16x8_t*)(ldsb + AT_K + (32 * (qi + kt) + l31) * 144 + (16 * ks + 8 * h) * 2);
                st[kt] = __builtin_amdgcn_mfma_f32_32x32x16_bf16(kf, qf[ks], st[kt], 0, 0, 0); } }
        const float slope = exp2f(-0.5f * (float)(hq + 1)); const float sink = a.in[I_ESINK][li * 16 + hq];
        float mx = sink;
#pragma unroll
        for (int kt = 0; kt < 5; ++kt)
#pragma unroll
            for (int r = 0; r < 16; ++r) { const int j = 32 * (qi + kt) + (r & 3) + 8 * (r >> 2) + 4 * h; const int dist = 32 * qi + l31 + 128 - j;
                const bool ok = (dist >= 0) && (dist < 128) && ((n > 0) || (j >= 128));
                const float s = ok ? st[kt][r] * 0.125f - slope * (float)dist : -INFINITY; st[kt][r] = s; mx = fmaxf(mx, s); }
        mx = fmaxf(mx, __shfl_xor(mx, 32));
        float l = 0.f;
#pragma unroll
        for (int kt = 0; kt < 5; ++kt)
#pragma unroll
            for (int r = 0; r < 16; ++r) { const float p = __expf(st[kt][r] - mx); st[kt][r] = p; l += p; }
        l += __shfl_xor(l, 32); l += __expf(sink - mx);
        f32x16 ot[2];
#pragma unroll
        for (int r = 0; r < 16; ++r) { ot[0][r] = 0.f; ot[1][r] = 0.f; }
#pragma unroll
        for (int kt = 0; kt < 5; ++kt)
#pragma unroll
            for (int s2 = 0; s2 < 2; ++s2) {
                v4u pw; pw.x = pk2(st[kt][8 * s2 + 0], st[kt][8 * s2 + 1]); pw.y = pk2(st[kt][8 * s2 + 2], st[kt][8 * s2 + 3]); pw.z = pk2(st[kt][8 * s2 + 4], st[kt][8 * s2 + 5]); pw.w = pk2(st[kt][8 * s2 + 6], st[kt][8 * s2 + 7]);
                const bf16x8_t pf = __builtin_bit_cast(bf16x8_t, pw);
#pragma unroll
                for (int db = 0; db < 2; ++db) {
                    const unsigned va = ldsbase + AT_V + (unsigned)(32 * (qi + kt) + 16 * s2 + 4 * h + ((lane & 15) >> 2)) * 192u + (unsigned)(32 * db + 16 * ((lane >> 4) & 1) + 4 * (lane & 3)) * 2u;
                    const bf16x8_t vf = tr_frag(va);
                    ot[db] = __builtin_amdgcn_mfma_f32_32x32x16_bf16(vf, pf, ot[db], 0, 0, 0); } }
        const float inv = 1.0f / l;
#pragma unroll
        for (int db = 0; db < 2; ++db)
#pragma unroll
            for (int g4 = 0; g4 < 4; ++g4)
                *(GAS v2u*)(O + qrow * D + 1024 + hq * 64 + 32 * db + 8 * g4 + 4 * h) = pack4(ot[db][4 * g4] * inv, ot[db][4 * g4 + 1] * inv, ot[db][4 * g4 + 2] * inv, ot[db][4 * g4 + 3] * inv);
    }
    __syncthreads();
}

__device__ __forceinline__ void e3_phase(const Args& a, int li, int vcu, int G, int tid) {
    unsigned char* ws = a.ws; const float* Y = a.out;
    const bf16* R = (const bf16*)(ws + SC_R); const bf16* K2 = (const bf16*)(ws + SC_K2); const bf16* GG = (const bf16*)(ws + SC_GG); const bf16* V = (const bf16*)(ws + (li ? WS_V2 : WS_VF));
    bf16* O = (bf16*)(ws + WS_O);
    const float* rk = a.in[I_ERK] + li * 1024; const float* gng = a.in[I_EGNG] + li * 1024; const float* gnb = a.in[I_EGNB] + li * 1024;
    for (size_t e4 = (size_t)vcu * NTHR + tid; e4 < (size_t)M * 256; e4 += (size_t)G * NTHR) {
        const size_t row = e4 >> 8; const int c = (int)(e4 & 255) * 4; const size_t e = row * 1024 + c;
        const f32x4 y = *(const GAS f32x4*)(Y + e);
        const v2u rw = *(const GAS v2u*)(R + e), kw = *(const GAS v2u*)(K2 + e), vw = *(const GAS v2u*)(V + e), gw = *(const GAS v2u*)(GG + e);
        const f32x4 rkv = *(const f32x4*)(rk + c), ggv = *(const f32x4*)(gng + c), gbv = *(const f32x4*)(gnb + c);
        const float mean = row16_sum((y.x + y.y) + (y.z + y.w)) * (1.0f / 64.0f);
        const f32x4 d = y - mean;
        const float var = row16_sum((d.x * d.x + d.y * d.y) + (d.z * d.z + d.w * d.w)) * (1.0f / 64.0f);
        const float rs = rsqrtf(var + 64e-5f);
        const float r0 = bflo(rw.x), r1 = bfhi(rw.x), r2 = bflo(rw.y), r3 = bfhi(rw.y), k0 = bflo(kw.x), k1 = bfhi(kw.x), k2 = bflo(kw.y), k3 = bfhi(kw.y);
        const float bonus = row16_sum((r0 * k0 * rkv.x + r1 * k1 * rkv.y) + (r2 * k2 * rkv.z + r3 * k3 * rkv.w));
        const float o0 = (d.x * rs * ggv.x + gbv.x + bonus * bflo(vw.x)) * bflo(gw.x), o1 = (d.y * rs * ggv.y + gbv.y + bonus * bfhi(vw.x)) * bfhi(gw.x);
        const float o2 = (d.z * rs * ggv.z + gbv.z + bonus * bflo(vw.y)) * bflo(gw.y), o3 = (d.w * rs * ggv.w + gbv.w + bonus * bfhi(vw.y)) * bfhi(gw.y);
        *(GAS v2u*)(O + row * D + c) = pack4(o0, o1, o2, o3);
    }
}

constexpr int SG_W = 0, SG_V = 34816;
__device__ __forceinline__ unsigned sg_off(unsigned row, unsigned ch) { return 256u * row + 16u * (ch ^ (((row & 3u) << 2) | ((row >> 2) & 3u))); }
__device__ __forceinline__ bf16x8_t tr_frag2(unsigned a0, unsigned a1) {
    v2u lo, hi; asm volatile("ds_read_b64_tr_b16 %0, %2\n\tds_read_b64_tr_b16 %1, %3\n\ts_waitcnt lgkmcnt(0)" : "=&v"(lo), "=&v"(hi) : "v"(a0), "v"(a1) : "memory");
    v4u w; w.x = lo.x; w.y = lo.y; w.z = hi.x; w.w = hi.y; return __builtin_bit_cast(bf16x8_t, w);
}
__device__ __forceinline__ void sgu_phase(const Args& a, int li, LAS unsigned char* ldsb, int vcu, int G, int tid) {
    unsigned char* ws = a.ws; const bf16* Z = (const bf16*)(ws + WS_ACT); bf16* O = (bf16*)(ws + WS_O);
    const float* ssv = (const float*)(ws + WS_SS) + (size_t)(13 + li) * SS_REC;
    const bf16* WSB = (const bf16*)(ws + SM_WSB); const float* bs = a.in[I_OBS] + li * 16 * 128; const float* vng = a.in[I_OVNG] + li * D;
    const int lane = tid & 63, wave = tid >> 6, fr = lane & 15, fq = lane >> 4;
    const unsigned ldsbase = (unsigned)(size_t)ldsb;
    int gcur = -1;
    for (int u = vcu; u < 4096; u += G) {
        const int g = u & 15, bn = u >> 4; const size_t m0 = (size_t)bn * 128;
        __syncthreads();
        if (g != gcur) { gcur = g;
            for (int e = tid; e < 128 * 16; e += NTHR) { const int i = e >> 4, ch = e & 15; *(LAS v4u*)(ldsb + SG_W + i * 272 + ch * 16) = *(const GAS v4u*)(WSB + ((size_t)g * 128 + i) * 128 + 8 * ch); } }
        for (int e = tid; e < 128 * 16; e += NTHR) { const int j = e >> 4, ch = e & 15; const float rs = pg8::row_rs(ssv, (int)(m0 + j));
            const v4u w = *(const GAS v4u*)(Z + (m0 + j) * ZO + 2048 + g * 128 + 8 * ch); v4u o;
            o.x = pk2(bflo(w.x) * rs, bfhi(w.x) * rs); o.y = pk2(bflo(w.y) * rs, bfhi(w.y) * rs); o.z = pk2(bflo(w.z) * rs, bfhi(w.z) * rs); o.w = pk2(bflo(w.w) * rs, bfhi(w.w) * rs);
            *(LAS v4u*)(ldsb + SG_V + sg_off((unsigned)j, (unsigned)ch)) = o; }
        __syncthreads();
        bf16x8_t vf[4];
        { const unsigned q = (unsigned)(lane & 15) >> 2, p = (unsigned)lane & 3u;
#pragma unroll
          for (int ks = 0; ks < 4; ++ks) { const unsigned r0 = 32u * ks + 8u * fq + q;
              vf[ks] = tr_frag2(ldsbase + SG_V + sg_off(r0, 2u * wave + (p >> 1)) + 8u * (p & 1u), ldsbase + SG_V + sg_off(r0 + 4u, 2u * wave + (p >> 1)) + 8u * (p & 1u)); } }
        const int cc = g * 128 + 16 * wave + 4 * fq; const f32x4 vg = *(const f32x4*)(vng + cc);
#pragma unroll
        for (int mt = 0; mt < 8; ++mt) {
            f32x4 acc = {0.f, 0.f, 0.f, 0.f};
#pragma unroll
            for (int ks = 0; ks <= (mt >> 1); ++ks) { const bf16x8_t wf = *(const LAS bf16x8_t*)(ldsb + SG_W + (16 * mt + fr) * 272 + (32 * ks + 8 * fq) * 2);
                acc = __builtin_amdgcn_mfma_f32_16x16x32_bf16(vf[ks], wf, acc, 0, 0, 0); }
            const int i = 16 * mt + fr; const float bi = bs[g * 128 + i];
            const v2u uw = *(const GAS v2u*)(Z + (m0 + i) * ZO + cc);
            *(GAS v2u*)(O + (m0 + i) * D + cc) = pack4(bflo(uw.x) * (vg.x * acc[0] + bi), bfhi(uw.x) * (vg.y * acc[1] + bi), bflo(uw.y) * (vg.z * acc[2] + bi), bfhi(uw.y) * (vg.w * acc[3] + bi));
        }
    }
    __syncthreads();
}

__device__ __forceinline__ void final_phase(const Args& a, int vcu, int G, int wave, int lane) {
    const int gw = vcu * NWAVES + wave, NGW = G * NWAVES; const float* ss = (const float*)(a.ws + WS_SS) + (size_t)12 * SS_REC; const float* fg = a.in[I_FG]; const bf16* XBp = (const bf16*)(a.ws + WS_XB);
    for (int m = gw; m < M; m += NGW) { const float rs = pg8::row_rs(ss, m);
        const GAS v4u* xr = (const GAS v4u*)(XBp + (size_t)m * D) + lane; GAS f32x4* orow = (GAS f32x4*)(a.out + (size_t)m * D) + 2 * lane; const GAS f32x4* gr = (const GAS f32x4*)fg + 2 * lane;
#pragma unroll
        for (int j = 0; j < 4; ++j) { const v4u w = xr[64 * j]; const f32x4 g0 = gr[128 * j], g1 = gr[128 * j + 1];
            orow[128 * j] = (f32x4){bflo(w.x) * rs * g0.x, bfhi(w.x) * rs * g0.y, bflo(w.y) * rs * g0.z, bfhi(w.y) * rs * g0.w};
            orow[128 * j + 1] = (f32x4){bflo(w.z) * rs * g1.x, bfhi(w.z) * rs * g1.y, bflo(w.w) * rs * g1.z, bfhi(w.w) * rs * g1.w}; } }
}

__global__ void __launch_bounds__(NTHR, 2) mk_fwd(Args args) {
    extern __shared__ __attribute__((aligned(16))) unsigned char lds_raw[];
    LAS unsigned char* lds = (LAS unsigned char*)lds_raw;
    const int tid = threadIdx.x, lane = tid & 63, wave = __builtin_amdgcn_readfirstlane(tid >> 6);
    const int G = gridDim.x, bx = blockIdx.x; const int vcu = (G % 8 == 0) ? (bx % 8) * (G / 8) + bx / 8 : bx;
    unsigned char* ws = args.ws; gu32* ctl = (gu32*)(ws + WS_CTL);
    for (int u = tid; u < (LDS_BYTES - LDSCTL_OFF) / 4; u += NTHR) ((LAS unsigned*)(lds + LDSCTL_OFF))[u] = 0u;
    __syncthreads();
    const int lo = args.ph_lo, hi = args.ph_hi;
    const bool multi = (hi - lo) > 1;
    XcdBarrier bar; bar.bar = (unsigned*)(ctl + CW_BAR); bar.x = 0; bar.st = nullptr;
    if (multi) bar = xcd_barrier_post((unsigned*)(ctl + CW_BAR), (volatile LAS unsigned*)(lds + LDSCTL_OFF));
#define IN(k) (lo <= (k) && (k) < hi)
#ifdef PROBE_STAMP
#define SEAM(k) do { if ((k) + 1 < hi) { if (tid == 0) bar.st[4] = ((((k) & 7) == 2 && (((k) / 24) & 1)) ? 7u : (unsigned)((k) & 7)); xcd_barrier(bar); } } while (0)
#else
#define SEAM(k) do { if ((k) + 1 < hi) xcd_barrier(bar); } while (0)
#endif
#ifndef DUP_G
#define DUP_G 1
#endif
#ifndef DUP_T
#define DUP_T 1
#endif
#ifndef DUP_GR
#define DUP_GR DUP_G
#endif
#ifndef DUP_G1
#define DUP_G1 DUP_G
#endif
#ifndef DUP_SP
#define DUP_SP DUP_S
#endif
#ifndef DUP_SQ
#define DUP_SQ DUP_S
#endif
#ifndef DUP_PREP
#define DUP_PREP DUP_T
#endif
#ifndef DUP_E1
#define DUP_E1 DUP_T
#endif
#ifndef DUP_SGU
#define DUP_SGU DUP_T
#endif
#ifndef DUP_E3
#define DUP_E3 DUP_T
#endif
#define REPN(n) for (int rep_ = 0; rep_ < (n); ++rep_)
#ifndef DUP_S
#define DUP_S 1
#endif
#define REPG for (int rep_ = 0; rep_ < DUP_G; ++rep_)
#define REPT for (int rep_ = 0; rep_ < DUP_T; ++rep_)
#define REPS for (int rep_ = 0; rep_ < DUP_S; ++rep_)
#define RSEAM(n) do { if (rep_ + 1 < (n)) xcd_barrier(bar); } while (0)
    float* ssb = (float*)(ws + WS_SS);
    bf16* XB = (bf16*)(ws + WS_XB); bf16* ACT = (bf16*)(ws + WS_ACT); bf16* OB = (bf16*)(ws + WS_O);

    for (int s = 0; s < NSUB; ++s) {
        const int pb = s * 8, L = s / 3, kind = s % 3, li = L >> 1; const bool even = !(L & 1);
        #ifndef NO_PREP
        if (kind == 0 && IN(pb + 0)) { REPN(DUP_PREP) { const int t_ = opaque(tid); prep_phase(args, L, lds, vcu, G, __builtin_amdgcn_readfirstlane(t_ >> 6), t_ & 63, (L & 1) ? 2 : 0); RSEAM(DUP_PREP); } SEAM(pb + 0); }
#endif
        if (IN(pb + 1)) {
            const float* ss = ssb + (size_t)s * SS_REC;
            LAS float* RC = (LAS float*)(lds + 135168);
            if (tid == 0) *(LAS int*)(RC + 256) = -1;
            __syncthreads();
            if (kind != 1) {
                pg8::Gemm g{XB, (const bf16*)(ws + (kind == 0 ? WT_GU1 : WT_GU2)), M, 2 * FF, D}; pg8::StaticOrder S; S.init(M, 2 * FF, G, bx);
                pg8::EpiSwiGLU E{ACT, FF, ss, RC};
#ifndef NO_G1
                REPN(DUP_G1) { pg8::gemm_phase<pg8::EpiSwiGLU, pg8::StaticOrder, true, true>(lds, g, S, E); RSEAM(DUP_G1); }
#endif
            } else if (even) {
                pg8::Gemm g{XB, (const bf16*)(ws + WT_IN), M, ZN, D}; pg8::StaticOrder S; S.init(M, ZN, G, bx);
                pg8::EpiZ E{ACT, ZN, ss, args.in[I_EBQKV] + li * 1536, RC};
#ifndef NO_GZ
                REPG { pg8::gemm_phase<pg8::EpiZ, pg8::StaticOrder, true, true>(lds, g, S, E); RSEAM(DUP_G); }
#endif
            } else {
                pg8::Gemm g{XB, (const bf16*)(ws + WT_IN), M, ZO, D}; pg8::StaticOrder S; S.init(M, ZO, G, bx);
                pg8::EpiGeluV E{ACT, ZO, ss, ssb + (size_t)(13 + li) * SS_REC, (LAS float*)(lds + 131072), RC};
#ifndef NO_GG
                REPG { pg8::gemm_phase<pg8::EpiGeluV, pg8::StaticOrder, true, true>(lds, g, S, E); RSEAM(DUP_G); }
#endif
            }
            SEAM(pb + 1);
        }
        if (kind == 1) {
            if (IN(pb + 2)) {
#ifndef NO_E1
                if (even) REPN(DUP_E1) { e1_phase(args, li, lds, vcu, G, opaque(tid)); RSEAM(DUP_E1); }
#endif
#ifndef NO_ATTN
                if (even) for (int au = vcu; au < 1024; au += G) attn_unit(args, li, au, lds, opaque(tid));
#endif
#ifndef NO_SGU
                if (!even) REPN(DUP_SGU) { sgu_phase(args, li, lds, vcu, G, opaque(tid)); RSEAM(DUP_SGU); }
#endif
                SEAM(pb + 2); }
#ifndef NO_SPRE
            if (even && IN(pb + 3)) { REPN(DUP_SP) { scanpre_phase(args, li, lds, vcu, G, opaque(tid)); RSEAM(DUP_SP); } SEAM(pb + 3); }
#endif
#ifndef NO_SSEQ
            if (even && IN(pb + 4)) { const int scu = (G == 256) ? (bx & 7) * 16 + (bx >> 3) + ((bx >> 3) < 16 ? 0 : 128 - 16) : vcu;
                REPN(DUP_SQ) { scanseq_phase(args, li, lds, scu, opaque(tid)); RSEAM(DUP_SQ); }
                if (scu >= 128) { const int t_ = opaque(tid); prep_phase(args, L + 1, lds, scu - 128, G - 128, __builtin_amdgcn_readfirstlane(t_ >> 6), t_ & 63, 1); }
                SEAM(pb + 4); }
#endif
#ifndef NO_E3
            if (even && IN(pb + 5)) { REPN(DUP_E3) { e3_phase(args, li, vcu, G, opaque(tid)); RSEAM(DUP_E3); } SEAM(pb + 5); }
#endif
        }
        if (IN(pb + 6)) {
            const bf16* A = (kind == 1) ? OB : ACT; const int K = (kind == 1) ? D : FF;
            const bf16* Bt = (const bf16*)(ws + (kind == 0 ? WT_D1 : kind == 1 ? WT_OUT : WT_D2));
            pg8::Gemm g{A, Bt, M, D, K, kind == 1 ? 0 : 1}; pg8::StaticOrder S; S.init(M, D, G, bx);
            pg8::EpiResid E{XB, ssb + (size_t)(s + 1) * SS_REC, kind == 1 ? 1.0f : 0.5f, (LAS float*)(lds + 131072)};
#ifndef NO_GR
            REPN(DUP_GR) { if (rep_) { E.scale = 0.f;
#ifdef PROBE_NOEPI
                E.noop = 1;
#endif
                } pg8::gemm_phase<pg8::EpiResid, pg8::StaticOrder, true, true>(lds, g, S, E); RSEAM(DUP_GR); }
#endif
            SEAM(pb + 6);
        }
    }
    if (IN(NSUB * 8)) { const int t_ = opaque(tid); final_phase(args, vcu, G, __builtin_amdgcn_readfirstlane(t_ >> 6), t_ & 63); }
#ifdef PROBE_STAMP
    if (multi) {
        if (tid == 0) { for (int c = 0; c < 8; ++c) __hip_atomic_store((unsigned*)(ctl + 16384 + bx * 8 + c), bar.st[8 + c], __ATOMIC_RELAXED, __HIP_MEMORY_SCOPE_AGENT); __hip_atomic_store((unsigned*)(ctl + 20480 + bx), bar.x, __ATOMIC_RELAXED, __HIP_MEMORY_SCOPE_AGENT); bar.st[4] = 0u; }
        xcd_barrier(bar);
        if (bx == 0 && tid == 0) {
            unsigned long long sum = 0ull; unsigned mn = 0xffffffffu, mx = 0u;
            unsigned ncnt = 0u;
            for (int j = 0; j < G; ++j) { unsigned v = 0u; if (PROBE_SEL && (j >> 3) >= 16) continue; ++ncnt;
                for (int c = 0; c < 8; ++c) if ((PROBE_MASK >> c) & 1) v += __hip_atomic_load((unsigned*)(ctl + 16384 + j * 8 + c), __ATOMIC_RELAXED, __HIP_MEMORY_SCOPE_AGENT);
                sum += v; mn = v < mn ? v : mn; mx = v > mx ? v : mx; }
            unsigned long long stat = PROBE_STAT == 0 ? sum / ncnt : PROBE_STAT == 1 ? mn : mx;
            if (PROBE_STAT == 5) { unsigned long long sp_ = 0ull; for (int j = 0; j < 128; ++j) sp_ += __hip_atomic_load((unsigned*)(ctl + 24576 + j), __ATOMIC_RELAXED, __HIP_MEMORY_SCOPE_AGENT); stat = sp_ / 128ull * 100ull / PROBE_SCALE; }
            else if (PROBE_STAT == 8) { unsigned d_ = 0u; for (int c = 0; c < 4; ++c) if ((PROBE_MASK >> c) & 1) d_ += bar.st[24 + c]; stat = d_; }
            else if (PROBE_STAT == 7) { unsigned d_ = 0u; for (int c = 0; c < 8; ++c) if ((PROBE_MASK >> c) & 1) d_ += bar.st[16 + c]; stat = d_; }
            else if (PROBE_STAT == 6) stat = (unsigned long long)__hip_atomic_load((unsigned*)(ctl + 24576 + 200), __ATOMIC_RELAXED, __HIP_MEMORY_SCOPE_AGENT) * 100ull / PROBE_SCALE;
            else if (PROBE_STAT >= 3) {
                unsigned xmn = 0xffffffffu, xmx = 0u, wsum = 0u, nx_ = 0u;
                for (unsigned x = 0; x < 16; ++x) { unsigned s_ = 0u, n_ = 0u, a_ = 0xffffffffu, b_ = 0u;
                    for (int j = 0; j < G; ++j) { if (__hip_atomic_load((unsigned*)(ctl + 20480 + j), __ATOMIC_RELAXED, __HIP_MEMORY_SCOPE_AGENT) != x) continue; if (PROBE_SEL && (j >> 3) >= 16) continue; unsigned v = 0u;
                        for (int c = 0; c < 8; ++c) if ((PROBE_MASK >> c) & 1) v += __hip_atomic_load((unsigned*)(ctl + 16384 + j * 8 + c), __ATOMIC_RELAXED, __HIP_MEMORY_SCOPE_AGENT);
                        s_ += v; ++n_; a_ = v < a_ ? v : a_; b_ = v > b_ ? v : b_; }
                    if (n_) { const unsigned m_ = s_ / n_; xmn = m_ < xmn ? m_ : xmn; xmx = m_ > xmx ? m_ : xmx; wsum += b_ - a_; ++nx_; } }
                stat = PROBE_STAT == 3 ? (xmx - xmn) : wsum / (nx_ ? nx_ : 1u);
            }
            const unsigned long long ts = __builtin_amdgcn_s_memrealtime();
            while (__builtin_amdgcn_s_memrealtime() - ts < stat * PROBE_SCALE) __builtin_amdgcn_s_sleep(8);
        }
    }
#endif
#undef IN
#undef SEAM
}

extern "C" void kernel_launch(void* const* d_in, const int* in_sizes, int n_in, void* d_out, int out_size, void* d_ws, size_t ws_size, hipStream_t stream) {
    static int grid = 0;
    if (grid == 0) {
        if (n_in != 29 || out_size != M * D || ws_size < WS_END) { fprintf(stderr, "kernel_launch: unexpected shapes (n_in %d, out %d, ws %zu < %zu); nothing launched\n", n_in, out_size, ws_size, (size_t)WS_END); grid = -1; return; }
        int dev = 0, cus = 0;
        if (hipGetDevice(&dev) != hipSuccess || hipDeviceGetAttribute(&cus, hipDeviceAttributeMultiprocessorCount, dev) != hipSuccess) { grid = -1; return; }
        if (hipFuncSetAttribute((const void*)mk_fwd, hipFuncAttributeMaxDynamicSharedMemorySize, LDS_BYTES) != hipSuccess) { fprintf(stderr, "kernel_launch: hipFuncSetAttribute failed\n"); grid = -1; return; }
        int per_cu = 0;
        if (hipOccupancyMaxActiveBlocksPerMultiprocessor(&per_cu, (const void*)mk_fwd, NTHR, LDS_BYTES) != hipSuccess || per_cu < 1) fprintf(stderr, "kernel_launch: occupancy query says %d\n", per_cu);
        (void)hipGetLastError();
        grid = cus;
    }
    if (grid < 0) return;
    (void)hipMemsetAsync((char*)d_ws + WS_CTL, 0, CTL_ZERO_BYTES, stream);
    Args a{};
    for (int i = 0; i < 29; ++i) a.in[i] = (const float*)d_in[i];
    a.out = (float*)d_out; a.ws = (unsigned char*)d_ws;
#if MK_ONE_LAUNCH
    a.ph_lo = 0; a.ph_hi = NSUB * 8 + 1;
    hipLaunchKernelGGL(mk_fwd, dim3(grid), dim3(NTHR), LDS_BYTES, stream, a);
#else
    for (int s = 0; s <= NSUB; ++s) {
        for (int k = 0; k < (s == NSUB ? 1 : 8); ++k) {
            const int L = s / 3, kind = s % 3; const bool even = !(L & 1);
            bool live;
            if (s == NSUB) live = true;
            else if (k == 0) live = (kind == 0);
            else if (k == 1 || k == 6) live = true;
            else if (k == 2) live = (kind == 1);
            else if (k == 3 || k == 4 || k == 5) live = (kind == 1) && even;
            else live = false;
            if (!live) continue;
            a.ph_lo = s * 8 + k; a.ph_hi = a.ph_lo + 1;
            hipLaunchKernelGGL(mk_fwd, dim3(grid), dim3(NTHR), LDS_BYTES, stream, a);
        }
    }
#endif
}
```

```cpp
#include <hip/hip_runtime.h>
#include <cstdio>
#include <cstdint>
#define MK_ONE_LAUNCH 1
namespace pg8 {
#define PG8_LAS __attribute__((address_space(3)))
typedef unsigned short bf16_t;
typedef short bf16x8 __attribute__((ext_vector_type(8)));
typedef float f32x4 __attribute__((ext_vector_type(4)));
typedef unsigned u32x4 __attribute__((ext_vector_type(4)));
constexpr int BM = 256, BK = 64, HALF = 128, HTB = HALF * BK * 2  , STAGE_BYTES = 8 * HTB, NXCD = 8, WGM = 8;

__host__ __device__ __forceinline__ int lds_byte(int r, int c) { const int st = (r >> 4) * 2 + (c >> 5), rr = r & 15, cc = c & 31, ob = rr * 64 + cc * 2; return st * 1024 + (ob ^ (((ob >> 9) & 1) << 5)); }
__host__ __device__ __forceinline__ void stage_rc(int b, int& R, int& C) { const int st = b / 1024, sb = b % 1024, swz = sb ^ (((sb >> 9) & 1) << 5); R = (st >> 1) * 16 + swz / 64; C = (st & 1) * 32 + (swz % 64) / 2; }
__host__ __device__ __forceinline__ int perm32(int rho) { const int n = rho >> 4, i = rho & 15; return 8 * (i >> 2) + 4 * n + (i & 3); }

struct Unit { int pm, pn; };
struct Gemm { const bf16_t* A; const bf16_t* Bt; int M, N, K; int amode = 0; };

struct StaticOrder {
    int nM, nN, nwg, G, c;
    __host__ __device__ void init(int M, int N, int G_, int c_) { nM = M / BM; nN = N / BM; nwg = nM * nN; G = G_; c = c_; }
    __host__ __device__ bool next(int i, Unit& u) const {
        const long L = (long)i * G + c; if (L >= nwg) return false;
        int wgid = (int)L; { const int q = nwg / NXCD, r = nwg % NXCD, xcd = wgid % NXCD, off = wgid / NXCD; wgid = (xcd < r ? xcd * (q + 1) : r * (q + 1) + (xcd - r) * q) + off; }
        const int nig = WGM * nN, gid = wgid / nig, fm = gid * WGM, gsz = (nM - fm) < WGM ? (nM - fm) : WGM;
        u.pm = fm + ((wgid % nig) % gsz); u.pn = (wgid % nig) / gsz; return true;
    }
    __host__ __device__ bool next_from(int i, const Unit& cur, Unit& u) const {
        const int per = G / NXCD;
        if (G % NXCD == 0 && nwg % NXCD == 0 && nM % WGM == 0 && per % WGM == 0 && (nwg / NXCD) % (WGM * nN) == 0) {
            if ((long)i * G + c >= nwg) return false;
            int pn = cur.pn + per / WGM, pm = cur.pm; if (pn >= nN) { pn -= nN; pm += WGM; }
            u.pm = pm; u.pn = pn; return true;
        }
        return next(i, u);
    }
    __device__ __forceinline__ void a_ready(const Unit&) const {}
    __device__ __forceinline__ void done(const Unit&) const {}
};
__device__ __forceinline__ unsigned cvt_pk_bf16(float lo, float hi) { unsigned r; asm volatile("v_cvt_pk_bf16_f32 %0, %1, %2" : "=v"(r) : "v"(lo), "v"(hi)); return r; }
typedef float f32x2 __attribute__((ext_vector_type(2)));
__device__ __forceinline__ f32x2 gelu_pk(f32x2 v) {
    const f32x2 av = __builtin_elementwise_abs(v), d = av * 0.2316418882f + 1.0f;
    f32x2 t; t.x = __builtin_amdgcn_rcpf(d.x); t.y = __builtin_amdgcn_rcpf(d.y);
    f32x2 q = t * 0.5307027145f + (-0.7265760135f); q = q * t + 0.7107068705f; q = q * t + (-0.142248368f); q = q * t + 0.127414796f; q = q * t;
    const f32x2 s = (v * v) * (-0.72134752044f);
    f32x2 e; e.x = __builtin_amdgcn_exp2f(s.x); e.y = __builtin_amdgcn_exp2f(s.y);
    const f32x2 m = v * (q * e), r = v - m;
    f32x2 o; o.x = v.x < 0.f ? m.x : r.x; o.y = v.y < 0.f ? m.y : r.y; return o;
}

typedef __bf16 bf16x2_e __attribute__((ext_vector_type(2)));
constexpr int SS_M = 32768;
__device__ __forceinline__ float row_rs(const float* P, int row) {
    const float s = ((P[row] + P[SS_M + row]) + (P[2 * SS_M + row] + P[3 * SS_M + row])) + ((P[4 * SS_M + row] + P[5 * SS_M + row]) + (P[6 * SS_M + row] + P[7 * SS_M + row]));
    return rsqrtf(s * (1.0f / 2048.0f) + 1e-6f);
}
__device__ __forceinline__ void panel_rs(const float* ss, PG8_LAS float* rc, int pm, int t) {
    PG8_LAS int* tag = (PG8_LAS int*)(rc + BM);
    const int have = *tag;
    if (have != pm && t < BM) rc[t] = row_rs(ss, pm * BM + t);
    asm volatile("s_waitcnt lgkmcnt(0)" ::: "memory"); __builtin_amdgcn_s_barrier(); asm volatile("" ::: "memory");
    if (have != pm && t == 0) *tag = pm;
}
struct EpiSwiGLU {
    static constexpr int PID = 0;
    static constexpr bool PERM = true, AFTER_DRAIN = false;
    bf16_t* O; int ldc; const float* ss; PG8_LAS float* rc;
    __device__ __forceinline__ void operator()(const f32x4 (&acc)[2][2][4][2], const Unit& u, int wr, int wc, int fr, int fq) const {
        const int row0 = u.pm * BM + wr * 64 + fr, col0 = u.pn * HALF + wc * 32 + 8 * fq;
        panel_rs(ss, rc, u.pm, (wr * 4 + wc) * 64 + fq * 16 + fr);
#pragma unroll
        for (int ai = 0; ai < 2; ++ai)
#pragma unroll
            for (int m = 0; m < 4; ++m) {
                const int row = row0 + ai * HALF + m * 16;
                const float rs = rc[row - u.pm * BM], nrl = rs * -1.44269504089f, rs2 = rs * rs;
                float o[8];
#pragma unroll
                for (int n = 0; n < 2; ++n)
#pragma unroll
                    for (int j = 0; j < 4; ++j) { const float ag = acc[ai][0][m][n][j], au = acc[ai][1][m][n][j]; o[4 * n + j] = (ag * au) * (rs2 * __builtin_amdgcn_rcpf(1.0f + __builtin_amdgcn_exp2f(ag * nrl))); }
                u32x4 w; w.x = cvt_pk_bf16(o[0], o[1]); w.y = cvt_pk_bf16(o[2], o[3]); w.z = cvt_pk_bf16(o[4], o[5]); w.w = cvt_pk_bf16(o[6], o[7]);
                *(u32x4*)(O + ((size_t)(u.pm * (ldc >> 6) + (col0 >> 6)) * BM + (row - u.pm * BM)) * BK + (col0 & 63)) = w;
                asm volatile("" ::: "memory");
            }
    }
};
struct EpiResid {
    static constexpr int PID = 3;
    static constexpr bool PERM = true, AFTER_DRAIN = false;
    bf16_t* xb; float* ssn; float scale; PG8_LAS float* sp;
    int noop = 0;
    __device__ __forceinline__ void operator()(const f32x4 (&acc)[2][2][4][2], const Unit& u, int wr, int wc, int fr, int fq) const {
        const int row0 = u.pm * BM + wr * 64 + fr, col0 = u.pn * BM + wc * 32 + 8 * fq;
        if (noop) return;
        u32x4 bx[8][2];
#pragma unroll
        for (int gi = 0; gi < 8; ++gi)
#pragma unroll
            for (int bj = 0; bj < 2; ++bj) bx[gi][bj] = *(const u32x4*)(xb + (size_t)(row0 + (gi >> 2) * HALF + (gi & 3) * 16) * 2048 + col0 + bj * HALF);
        asm volatile("" ::: "memory");
#pragma unroll
        for (int gi = 0; gi < 8; ++gi) {
            const int ai = gi >> 2, m = gi & 3;
            const int row = row0 + ai * HALF + m * 16; const size_t off = (size_t)row * 2048 + col0; float s = 0.f;
            u32x4 bc[2]; bc[0] = bx[gi][0]; bc[1] = bx[gi][1];
#pragma unroll
            for (int bj = 0; bj < 2; ++bj) {
                const f32x4 a0 = acc[ai][bj][m][0] * scale, a1 = acc[ai][bj][m][1] * scale; const u32x4 b = bc[bj]; u32x4 w;
                w.x = cvt_pk_bf16(__uint_as_float(b.x << 16) + a0[0], __uint_as_float(b.x & 0xffff0000u) + a0[1]);
                w.y = cvt_pk_bf16(__uint_as_float(b.y << 16) + a0[2], __uint_as_float(b.y & 0xffff0000u) + a0[3]);
                w.z = cvt_pk_bf16(__uint_as_float(b.z << 16) + a1[0], __uint_as_float(b.z & 0xffff0000u) + a1[1]);
                w.w = cvt_pk_bf16(__uint_as_float(b.w << 16) + a1[2], __uint_as_float(b.w & 0xffff0000u) + a1[3]);
                *(u32x4*)(xb + off + bj * HALF) = w;
                const float r0 = __uint_as_float(w.x << 16), r1 = __uint_as_float(w.x & 0xffff0000u), r2 = __uint_as_float(w.y << 16), r3 = __uint_as_float(w.y & 0xffff0000u);
                const float r4 = __uint_as_float(w.z << 16), r5 = __uint_as_float(w.z & 0xffff0000u), r6 = __uint_as_float(w.w << 16), r7 = __uint_as_float(w.w & 0xffff0000u);
                s += ((r0 * r0 + r1 * r1) + (r2 * r2 + r3 * r3)) + ((r4 * r4 + r5 * r5) + (r6 * r6 + r7 * r7));
            }
            s += __shfl_xor(s, 16); s += __shfl_xor(s, 32);
            if (fq == 0) sp[(ai * HALF + wr * 64 + m * 16 + fr) * 4 + wc] = s;
            asm volatile("" ::: "memory");
        }
        asm volatile("s_waitcnt lgkmcnt(0)" ::: "memory"); __builtin_amdgcn_s_barrier(); asm volatile("" ::: "memory");
        const int t = (wr * 4 + wc) * 64 + fq * 16 + fr;
        if (t < BM) { const f32x4 p = *(const PG8_LAS f32x4*)(sp + t * 4); ssn[(size_t)u.pn * SS_M + u.pm * BM + t] = (p[0] + p[1]) + (p[2] + p[3]); }
    }
};
struct EpiZ {
    static constexpr int PID = 1;
    static constexpr bool PERM = true, AFTER_DRAIN = false;
    bf16_t* O; int ldc; const float* ss; const float* bias; PG8_LAS float* rc;
    __device__ __forceinline__ void operator()(const f32x4 (&acc)[2][2][4][2], const Unit& u, int wr, int wc, int fr, int fq) const {
        const int row0 = u.pm * BM + wr * 64 + fr, col0 = u.pn * BM + wc * 32 + 8 * fq;
        panel_rs(ss, rc, u.pm, (wr * 4 + wc) * 64 + fq * 16 + fr);
        const bool hb = u.pn < 6;
        f32x4 bv[2][2];
#pragma unroll
        for (int bj = 0; bj < 2; ++bj)
#pragma unroll
            for (int n = 0; n < 2; ++n) bv[bj][n] = hb ? *(const f32x4*)(bias + col0 + bj * HALF + 4 * n) : (f32x4){0.f, 0.f, 0.f, 0.f};
#pragma unroll
        for (int ai = 0; ai < 2; ++ai)
#pragma unroll
            for (int m = 0; m < 4; ++m) {
                const int row = row0 + ai * HALF + m * 16;
                const float rs = rc[row - u.pm * BM];
                bf16_t* rowp = O + (size_t)row * ldc + col0;
#pragma unroll
                for (int bj = 0; bj < 2; ++bj) {
                    const f32x4 v0 = acc[ai][bj][m][0] * rs + bv[bj][0], v1 = acc[ai][bj][m][1] * rs + bv[bj][1];
                    u32x4 w; w.x = cvt_pk_bf16(v0[0], v0[1]); w.y = cvt_pk_bf16(v0[2], v0[3]); w.z = cvt_pk_bf16(v1[0], v1[1]); w.w = cvt_pk_bf16(v1[2], v1[3]);
                    *(u32x4*)(rowp + bj * HALF) = w;
                }
                asm volatile("" ::: "memory");
            }
    }
};
struct EpiGeluV {
    static constexpr int PID = 2;
    static constexpr bool PERM = true, AFTER_DRAIN = false;
    bf16_t* O; int ldc; const float* ss; float* ssv; PG8_LAS float* sp; PG8_LAS float* rc;
    __device__ __forceinline__ void operator()(const f32x4 (&acc)[2][2][4][2], const Unit& u, int wr, int wc, int fr, int fq) const {
        const int row0 = u.pm * BM + wr * 64 + fr, col0 = u.pn * BM + wc * 32 + 8 * fq;
        panel_rs(ss, rc, u.pm, (wr * 4 + wc) * 64 + fq * 16 + fr);
        const bool isv = u.pn >= 8;
#pragma unroll
        for (int ai = 0; ai < 2; ++ai)
#pragma unroll
            for (int m = 0; m < 4; ++m) {
                const int row = row0 + ai * HALF + m * 16;
                const float rs = rc[row - u.pm * BM];
                bf16_t* rowp = O + (size_t)row * ldc + col0; float s = 0.f;
#pragma unroll
                for (int bj = 0; bj < 2; ++bj) {
                    f32x4 v0 = acc[ai][bj][m][0] * rs, v1 = acc[ai][bj][m][1] * rs;
                    const f32x2 a = gelu_pk((f32x2){v0[0], v0[1]}), b = gelu_pk((f32x2){v0[2], v0[3]}), c = gelu_pk((f32x2){v1[0], v1[1]}), d = gelu_pk((f32x2){v1[2], v1[3]});
                    s += (a.x * a.x + a.y * a.y) + (b.x * b.x + b.y * b.y) + (c.x * c.x + c.y * c.y) + (d.x * d.x + d.y * d.y);
                    u32x4 w; w.x = cvt_pk_bf16(a.x, a.y); w.y = cvt_pk_bf16(b.x, b.y); w.z = cvt_pk_bf16(c.x, c.y); w.w = cvt_pk_bf16(d.x, d.y);
                    *(u32x4*)(rowp + bj * HALF) = w;
                }
                if (isv) { s += __shfl_xor(s, 16); s += __shfl_xor(s, 32); if (fq == 0) sp[(ai * HALF + wr * 64 + m * 16 + fr) * 4 + wc] = s; }
                asm volatile("" ::: "memory");
            }
        if (isv) {
            asm volatile("s_waitcnt lgkmcnt(0)" ::: "memory"); __builtin_amdgcn_s_barrier(); asm volatile("" ::: "memory");
            const int t = (wr * 4 + wc) * 64 + fq * 16 + fr;
            if (t < BM) { const f32x4 p = *(const PG8_LAS f32x4*)(sp + t * 4); ssv[(size_t)(u.pn - 8) * SS_M + u.pm * BM + t] = (p[0] + p[1]) + (p[2] + p[3]); }
        }
    }
};
template <class Epi, class Sched, bool ALIGN_EPI = false, bool SP2 = false>
__device__ __forceinline__ void gemm_phase(PG8_LAS unsigned char* lds, const Gemm g, const Sched& S, const Epi& E) {
    int tid_ = threadIdx.x; asm volatile("" : "+v"(tid_));
    const int tid = tid_, wid = __builtin_amdgcn_readfirstlane(tid >> 6), lane = tid & 63, wr = wid >> 2, wc = wid & 3, fr = lane & 15, fq = lane >> 4;
    const int K = g.K, nt = K / BK;
    unsigned voffA[2], voffB[2];
#pragma unroll
    for (int i = 0; i < 2; ++i) { int R, C; stage_rc(tid * 16 + i * 8192, R, C); const int Rb = Epi::PERM ? ((R & ~31) + perm32(R & 31)) : R;
        voffA[i] = g.amode ? (unsigned)(R * BK + C) * 2u : (unsigned)(R * K + C) * 2u; voffB[i] = (unsigned)(Rb * K + C) * 2u; }
    const size_t kstep = (size_t)(BK * 2);
    const size_t hstep = (size_t)HALF * K * 2;
    const size_t tstep = 2 * hstep;
    const size_t kstepA = g.amode ? (size_t)(BM * BK * 2) : kstep, hstepA = g.amode ? (size_t)(HALF * BK * 2) : hstep, tstepA = g.amode ? (size_t)(K / BK) * (BM * BK * 2) : tstep;
    const unsigned ldsw = (unsigned)wid * 1024u;
    const int aoff = lds_byte(wr * 64 + fr, fq * 8), boff = lds_byte(wc * 32 + fr, fq * 8);
#define PG8_SA(b, h) (((b) * 2 + (h)) * HTB)
#define PG8_SB(b, h) ((4 + (b) * 2 + (h)) * HTB)
#define PG8_STAGE(bufoff, gbase, voff) do { _Pragma("unroll") for (int _i = 0; _i < 2; ++_i) \
        __builtin_amdgcn_global_load_lds((const unsigned*)((const char*)(gbase) + (voff)[_i]), (PG8_LAS unsigned*)(lds + (bufoff) + ldsw + _i * 8192), 16, 0, 0); } while (0)
#define PG8_LDA(dst, b, h) do { _Pragma("unroll") for (int m = 0; m < 4; ++m) _Pragma("unroll") for (int k = 0; k < 2; ++k) dst[m][k] = *(const PG8_LAS bf16x8*)(lds + PG8_SA(b, h) + aoff + m * 2048 + k * 1024); } while (0)
#define PG8_LDB(dst, b, h) do { _Pragma("unroll") for (int n = 0; n < 2; ++n) _Pragma("unroll") for (int k = 0; k < 2; ++k) dst[n][k] = *(const PG8_LAS bf16x8*)(lds + PG8_SB(b, h) + boff + n * 2048 + k * 1024); } while (0)
#define PG8_MMA(ai, bj, At, Bt) do { __builtin_amdgcn_s_setprio(1); _Pragma("unroll") for (int m = 0; m < 4; ++m) _Pragma("unroll") for (int n = 0; n < 2; ++n) _Pragma("unroll") for (int k = 0; k < 2; ++k) \
        acc[ai][bj][m][n] = __builtin_amdgcn_mfma_f32_16x16x32_bf16(Bt[n][k], At[m][k], acc[ai][bj][m][n], 0, 0, 0); __builtin_amdgcn_s_setprio(0); } while (0)
#define PG8_WAIT_V(n) asm volatile("s_waitcnt vmcnt(" #n ")" ::: "memory")
#define PG8_WAIT_L(n) asm volatile("s_waitcnt lgkmcnt(" #n ")" ::: "memory")
#define PG8_BAR __builtin_amdgcn_s_barrier()
#define PG8_SCHED __builtin_amdgcn_sched_barrier(0)
    Unit cur, nxt; int ui = 0;
    if (!S.next(0, cur)) return;
    f32x4 acc[2][2][4][2];
#pragma unroll
    for (int a = 0; a < 2; ++a)
#pragma unroll
        for (int b = 0; b < 2; ++b)
#pragma unroll
            for (int m = 0; m < 4; ++m)
#pragma unroll
                for (int n = 0; n < 2; ++n) acc[a][b][m][n] = (f32x4){0.f, 0.f, 0.f, 0.f};
    bf16x8 At[4][2], B0[2][2], B1[2][2];
    const char* cA = (const char*)g.A + (size_t)cur.pm * tstepA; const char* cB = (const char*)g.Bt + (size_t)cur.pn * tstep;
    S.a_ready(cur);
    if constexpr (SP2) {
        PG8_STAGE(PG8_SB(0, 0), cB, voffB); PG8_STAGE(PG8_SB(0, 1), cB + hstep, voffB); PG8_STAGE(PG8_SA(0, 0), cA, voffA); PG8_STAGE(PG8_SA(0, 1), cA + hstepA, voffA);
        if (wr == 1) PG8_BAR;
        PG8_WAIT_V(2); PG8_BAR;
        PG8_STAGE(PG8_SB(1, 0), cB + kstep, voffB); PG8_STAGE(PG8_SA(1, 0), cA + kstepA, voffA); PG8_STAGE(PG8_SB(1, 1), cB + hstep + kstep, voffB);
        PG8_WAIT_V(6); PG8_BAR;
    } else {
        PG8_STAGE(PG8_SB(0, 0), cB, voffB); PG8_STAGE(PG8_SA(0, 0), cA, voffA); PG8_STAGE(PG8_SB(0, 1), cB + hstep, voffB); PG8_STAGE(PG8_SA(0, 1), cA + hstepA, voffA);
        if (wr == 1) PG8_BAR;
        PG8_WAIT_V(4); PG8_BAR;
        PG8_STAGE(PG8_SB(1, 0), cB + kstep, voffB); PG8_STAGE(PG8_SA(1, 0), cA + kstepA, voffA); PG8_STAGE(PG8_SB(1, 1), cB + hstep + kstep, voffB);
        PG8_WAIT_V(6); PG8_BAR;
    }
    for (;;) {
        const bool has_next = S.next_from(ui + 1, cur, nxt);
        const char* nA = has_next ? (const char*)g.A + (size_t)nxt.pm * tstepA : cA; const char* nB = has_next ? (const char*)g.Bt + (size_t)nxt.pn * tstep : cB;
        for (int t = 0; t < nt; t += 2) {
            const bool last = (t == nt - 2);
            const char* a1 = cA + (size_t)(t + 1) * kstepA;
            const char* a2 = last ? nA : cA + (size_t)(t + 2) * kstepA; const char* b2 = last ? nB : cB + (size_t)(t + 2) * kstep;
            const char* a3 = a2 + kstepA; const char* b3 = b2 + kstep;
            if (last && has_next) S.a_ready(nxt);
            if constexpr (SP2) {
            PG8_LDB(B0, 0, 0); PG8_LDB(B1, 0, 1); PG8_SCHED; PG8_LDA(At, 0, 0); PG8_STAGE(PG8_SA(1, 1), a1 + hstepA, voffA);
            PG8_WAIT_V(8); PG8_WAIT_L(0); PG8_BAR; PG8_MMA(0, 0, At, B0); PG8_MMA(0, 1, At, B1); PG8_BAR; PG8_SCHED;
            PG8_LDA(At, 0, 1); PG8_STAGE(PG8_SB(0, 0), b2, voffB); PG8_STAGE(PG8_SB(0, 1), b2 + hstep, voffB); PG8_STAGE(PG8_SA(0, 0), a2, voffA);
            PG8_WAIT_V(8); PG8_WAIT_L(0); PG8_BAR; PG8_MMA(1, 0, At, B0); PG8_MMA(1, 1, At, B1); PG8_BAR; PG8_SCHED;
            PG8_LDB(B0, 1, 0); PG8_LDB(B1, 1, 1); PG8_SCHED; PG8_LDA(At, 1, 0); PG8_STAGE(PG8_SA(0, 1), a2 + hstepA, voffA);
            PG8_WAIT_V(8); PG8_WAIT_L(0); PG8_BAR; PG8_MMA(0, 0, At, B0); PG8_MMA(0, 1, At, B1); PG8_BAR; PG8_SCHED;
            PG8_LDA(At, 1, 1); PG8_STAGE(PG8_SB(1, 0), b3, voffB); PG8_STAGE(PG8_SB(1, 1), b3 + hstep, voffB); PG8_STAGE(PG8_SA(1, 0), a3, voffA);
            PG8_WAIT_V(8); PG8_WAIT_L(0); PG8_BAR; PG8_MMA(1, 0, At, B0); PG8_MMA(1, 1, At, B1); PG8_BAR; PG8_SCHED;
            } else {
            PG8_LDB(B0, 0, 0); PG8_SCHED; PG8_LDA(At, 0, 0); PG8_STAGE(PG8_SA(1, 1), a1 + hstepA, voffA);
            PG8_WAIT_L(8); PG8_BAR; PG8_WAIT_L(0); PG8_MMA(0, 0, At, B0); PG8_BAR; PG8_SCHED;
            PG8_LDB(B1, 0, 1); PG8_STAGE(PG8_SB(0, 0), b2, voffB);
            PG8_BAR; PG8_WAIT_L(0); PG8_MMA(0, 1, At, B1); PG8_BAR;
            PG8_LDA(At, 0, 1); PG8_STAGE(PG8_SA(0, 0), a2, voffA);
            PG8_BAR; PG8_WAIT_L(0); PG8_MMA(1, 0, At, B0); PG8_BAR; PG8_SCHED;
            PG8_STAGE(PG8_SB(0, 1), b2 + hstep, voffB);
            PG8_WAIT_V(6); PG8_BAR; PG8_MMA(1, 1, At, B1); PG8_BAR;
            PG8_LDB(B0, 1, 0); PG8_SCHED; PG8_LDA(At, 1, 0); PG8_STAGE(PG8_SA(0, 1), a2 + hstepA, voffA);
            PG8_WAIT_L(8); PG8_BAR; PG8_WAIT_L(0); PG8_MMA(0, 0, At, B0); PG8_BAR; PG8_SCHED;
            PG8_LDB(B1, 1, 1); PG8_STAGE(PG8_SB(1, 0), b3, voffB);
            PG8_BAR; PG8_WAIT_L(0); PG8_MMA(0, 1, At, B1); PG8_BAR;
            PG8_LDA(At, 1, 1); PG8_STAGE(PG8_SA(1, 0), a3, voffA);
            PG8_BAR; PG8_WAIT_L(0); PG8_MMA(1, 0, At, B0); PG8_BAR; PG8_SCHED;
            PG8_STAGE(PG8_SB(1, 1), b3 + hstep, voffB);
            PG8_WAIT_V(6); PG8_BAR; PG8_MMA(1, 1, At, B1); PG8_BAR;
            }
        }
        if constexpr (ALIGN_EPI) { if (wr == 0) PG8_BAR; }
#ifdef PROBE_STAMP
        const unsigned long long pe0_ = __builtin_amdgcn_s_memrealtime();
#endif
        if constexpr (!Epi::AFTER_DRAIN) { E(acc, cur, wr, wc, fr, fq); S.done(cur); }
#ifdef PROBE_STAMP
        if (tid == 0) { PG8_LAS unsigned* pw_ = (PG8_LAS unsigned*)(lds + 147456 - 512) + 24 + Epi::PID; *pw_ += (unsigned)(__builtin_amdgcn_s_memrealtime() - pe0_); }
#endif
        if (!has_next) break;
#pragma unroll
        for (int a = 0; a < 2; ++a)
#pragma unroll
            for (int b = 0; b < 2; ++b)
#pragma unroll
                for (int m = 0; m < 4; ++m)
#pragma unroll
                    for (int n = 0; n < 2; ++n) acc[a][b][m][n] = (f32x4){0.f, 0.f, 0.f, 0.f};
        cur = nxt; cA = nA; cB = nB; ++ui;
        if constexpr (ALIGN_EPI) { if (wr == 1) PG8_BAR; }
    }
    PG8_WAIT_V(0);
    if constexpr (!ALIGN_EPI) { if (wr == 0) PG8_BAR; }
    PG8_BAR;
    if constexpr (Epi::AFTER_DRAIN) { E.fused(acc, cur, wr, wc, fr, fq, lds, wid, lane); S.done(cur); }
#undef PG8_SA
#undef PG8_SB
#undef PG8_STAGE
#undef PG8_LDA
#undef PG8_LDB
#undef PG8_MMA
#undef PG8_WAIT_V
#undef PG8_WAIT_L
#undef PG8_BAR
#undef PG8_SCHED
}
}
#define LAS_BAR __attribute__((address_space(3)))
#define XB_TMO      128
#define XB_XCNT(j)  (256  + 64 * (j))
#define XB_XSUB(j)  (1280 + 64 * (j))
#define XB_XGEN(j)  (2304 + 64 * (j))
#define XB_TOP      3328
#define XB_TOPGEN   3392
#define XCD_BAR_WORDS 3456
#define XB_SPIN_CAP (1u << 22)

__device__ __forceinline__ unsigned xb_ld(unsigned* p)              { return __hip_atomic_load(p, __ATOMIC_RELAXED, __HIP_MEMORY_SCOPE_AGENT); }
__device__ __forceinline__ unsigned xb_add(unsigned* p, unsigned v) { return __hip_atomic_fetch_add(p, v, __ATOMIC_RELAXED, __HIP_MEMORY_SCOPE_AGENT); }
__device__ __forceinline__ unsigned xb_xcc_id() { return (unsigned)__builtin_amdgcn_s_getreg((3 << 11) | 20) & 0xFu; }
#define XB_SPIN(cond, bar) do { unsigned _sp = 0; while (cond) { __builtin_amdgcn_s_sleep(1); \
    if ((++_sp & 255u) == 0u) { if (xb_ld(&(bar)[XB_TMO])) break; if (_sp > XB_SPIN_CAP) { atomicAdd(&(bar)[XB_TMO], 1u); break; } } } } while (0)

struct XcdBarrier {
    unsigned* bar; unsigned x;
    volatile LAS_BAR unsigned* st;
};

__device__ __forceinline__ XcdBarrier xcd_barrier_post(unsigned* bar, volatile LAS_BAR unsigned* st) {
    XcdBarrier b; b.bar = bar; b.x = xb_xcc_id(); b.st = st;
    if (threadIdx.x == 0) (void)xb_add(&bar[XB_XCNT(b.x)], 1u);
    return b;
}
__device__ __forceinline__ void xcd_barrier_complete(unsigned* bar, unsigned x, unsigned& nloc, unsigned& nx) {
    const unsigned G = gridDim.x * gridDim.y * gridDim.z;
    unsigned sum, cnt, mine, sp = 0u;
    for (;;) {
        sum = 0u; cnt = 0u; mine = 0u;
#pragma unroll
        for (unsigned j = 0; j < 16; ++j) { const unsigned c = xb_ld(&bar[XB_XCNT(j)]); sum += c; cnt += (c > 0u) ? 1u : 0u; mine = (j == x) ? c : mine; }
        if (sum == G) break;
        __builtin_amdgcn_s_sleep(1);
        if ((++sp & 255u) == 0u) { if (xb_ld(&bar[XB_TMO])) break; if (sp > XB_SPIN_CAP) { atomicAdd(&bar[XB_TMO], 1u); break; } }
    }
    nloc = mine > 0u ? mine : 1u; nx = cnt > 0u ? cnt : 1u;
}

__device__ __forceinline__ void xcd_barrier(const XcdBarrier& b) {
    asm volatile("s_waitcnt vmcnt(0)" ::: "memory");
    __syncthreads();
    if (threadIdx.x == 0) {
        unsigned* bar = b.bar;
        __builtin_amdgcn_s_waitcnt(0);
#ifdef PROBE_STAMP
        const unsigned long long pt0_ = __builtin_amdgcn_s_memrealtime();
#endif
        unsigned nloc = b.st[0], nx = b.st[1];
        if (nloc == 0u) { xcd_barrier_complete(bar, b.x, nloc, nx); b.st[0] = nloc; b.st[1] = nx; }
        const unsigned old = xb_add(&bar[XB_XSUB(b.x)], 1u);
        const unsigned gen = old / nloc;
        if (old + 1u == (gen + 1u) * nloc) {
            __builtin_amdgcn_fence(__ATOMIC_RELEASE, "agent");
            asm volatile("s_waitcnt vmcnt(0)" ::: "memory");
            const unsigned og = xb_add(&bar[XB_TOP], 1u);
            const unsigned tg = og / nx;
            if (og + 1u == (tg + 1u) * nx) xb_add(&bar[XB_TOPGEN], 1u);
            else XB_SPIN(xb_ld(&bar[XB_TOPGEN]) == tg, bar);
            __builtin_amdgcn_fence(__ATOMIC_ACQUIRE, "agent");
            xb_add(&bar[XB_XGEN(b.x)], 1u);
            asm volatile("s_waitcnt vmcnt(0)" ::: "memory");
        } else {
            XB_SPIN(xb_ld(&bar[XB_XGEN(b.x)]) == gen, bar);
            __builtin_amdgcn_fence(__ATOMIC_ACQUIRE, "agent");
            asm volatile("s_waitcnt vmcnt(0)" ::: "memory");
        }
#ifdef PROBE_STAMP
        { const unsigned cls_ = b.st[4]; const unsigned now_ = (unsigned)__builtin_amdgcn_s_memrealtime(); b.st[8 + cls_] += now_ - (unsigned)pt0_; if (b.st[6]) b.st[16 + cls_] += now_ - b.st[6]; b.st[6] = now_ | 1u; }
#endif
    }
    __syncthreads();
}

constexpr int NWAVES = 8, NTHR = 512;
constexpr int BATCH = 2, T = 16384, D = 2048, FF = 5632, M = BATCH * T;
constexpr int ZN = 5120;
constexpr int ZA = 1536;
constexpr int A_COLS = 3360, E_IN = 4896;
constexpr int ZO = 4096;
constexpr int NSUB = 12;
#ifndef MK_ONE_LAUNCH
#define MK_ONE_LAUNCH 0
#endif

constexpr size_t MiB = 1u << 20;
constexpr size_t WS_CTL = 0, CTL_ZERO_BYTES = 1 * MiB;
constexpr size_t WS_SS = 1 * MiB;
constexpr size_t SS_REC = 8 * (size_t)M;
constexpr size_t WS_WT = 16 * MiB;
constexpr size_t WT_GU1 = WS_WT, WT_D1 = WT_GU1 + 44 * MiB, WT_GU2 = WT_D1 + 22 * MiB, WT_D2 = WT_GU2 + 44 * MiB, WT_IN = WT_D2 + 22 * MiB, WT_OUT = WT_IN + 20 * MiB;
constexpr size_t WS_XB = WT_OUT + 8 * MiB;
constexpr size_t WS_ACT = WS_XB + 128 * MiB;
constexpr size_t WS_SC = WS_ACT + 352 * MiB;
constexpr size_t SC_R = WS_SC, SC_K2 = SC_R + 64 * MiB, SC_KK = SC_K2 + 64 * MiB, SC_BB = SC_KK + 64 * MiB, SC_LW = SC_BB + 64 * MiB, SC_GG = SC_LW + 64 * MiB;
constexpr size_t WS_VF = SC_GG + 64 * MiB;
constexpr size_t WS_V2 = WS_VF + 64 * MiB;
constexpr size_t WS_O = WS_V2 + 64 * MiB;
constexpr size_t WS_SM = WS_O + 128 * MiB;
constexpr size_t SM_W2T = WS_SM, SM_A2T = SM_W2T + 131072, SM_G2T = SM_A2T + 131072, SM_V1T = SM_G2T + 327680, SM_V2T = SM_V1T + 65536, SM_WSB = SM_V2T + 65536;
constexpr size_t WS_U0 = WS_SM + 2 * MiB;
constexpr size_t WS_END = WS_U0 + 64 * MiB;
static_assert(SM_WSB + 524288 <= WS_END, "small-weight map");
constexpr size_t WT2_GU2 = WS_END, WT2_D2 = WT2_GU2 + 44 * MiB, WT2_OUT = WT2_D2 + 22 * MiB, WS_END2 = WT2_OUT + 8 * MiB;
static_assert(WT_OUT + 8 * MiB == 176 * MiB && WS_SS + 15 * MiB <= WS_WT, "weight map");
constexpr int CW_TMO = 0, CW_CODE = 1, CW_BAR = 4096;

constexpr int LDS_BYTES = 147456, LDSCTL_OFF = LDS_BYTES - 512;

#define GAS __attribute__((address_space(1)))
#define LAS __attribute__((address_space(3)))
typedef unsigned short bf16;
typedef unsigned v4u __attribute__((ext_vector_type(4)));
typedef unsigned v2u __attribute__((ext_vector_type(2)));
typedef float f32x4 __attribute__((ext_vector_type(4)));
typedef float f32x2 __attribute__((ext_vector_type(2)));
typedef GAS unsigned gu32;
#define RLX_AGENT __ATOMIC_RELAXED, __HIP_MEMORY_SCOPE_AGENT
#define LDS_WAIT() asm volatile("s_waitcnt lgkmcnt(0)" ::: "memory")
typedef __bf16 bf16x2_hw __attribute__((ext_vector_type(2)));
__device__ __forceinline__ unsigned pk2(float lo, float hi) { const bf16x2_hw b = __builtin_convertvector((f32x2){lo, hi}, bf16x2_hw); return __builtin_bit_cast(unsigned, b); }
__device__ __forceinline__ unsigned f2bf(float f) { return pk2(f, f) & 0xffffu; }
__device__ __forceinline__ float bf2f(bf16 b) { return __builtin_bit_cast(float, (unsigned)b << 16); }
__device__ __forceinline__ float bflo(unsigned w) { return __builtin_bit_cast(float, w << 16); }
__device__ __forceinline__ float bfhi(unsigned w) { return __builtin_bit_cast(float, w & 0xffff0000u); }
__device__ __forceinline__ float wave_sum(float v) {
#pragma unroll
    for (int o = 1; o < 64; o <<= 1) v += __shfl_xor(v, o);
    return v;
}
template <int CTRL> __device__ __forceinline__ float dpp_mov(float v) { return __builtin_bit_cast(float, __builtin_amdgcn_update_dpp(0, __builtin_bit_cast(int, v), CTRL, 0xf, 0xf, true)); }
__device__ __forceinline__ float row16_sum(float v) { v += dpp_mov<0xB1>(v); v += dpp_mov<0x4E>(v); v += dpp_mov<0x141>(v); v += dpp_mov<0x140>(v); return v; }
__device__ __forceinline__ float sigmoidf_(float x) { return 1.0f / (1.0f + __expf(-x)); }

__device__ __forceinline__ int opaque(int v) { asm volatile("" : "+v"(v)); return v; }
struct Args { const float* in[29]; float* out; unsigned char* ws; int ph_lo, ph_hi, dbl, pad_; };
static_assert(sizeof(Args) == 29 * 8 + 8 + 8 + 16, "Args has no padding");
enum { I_X = 0, I_NG, I_WG, I_WU, I_WD, I_EWIN, I_EBQKV, I_EMU, I_EW0, I_EW2, I_EA0, I_EA2, I_EG2, I_EKK, I_EKA, I_ERK, I_EGNG, I_EGNB, I_ESINK, I_EWOUT, I_V0, I_V1, I_V2, I_OWIN, I_OVNG, I_OWS, I_OBS, I_OWOUT, I_FG };

struct TrDesc { const float* W; const float* gk; bf16* WT; int ldw, k0, c0, K, drow0; bool zero; };
__device__ __forceinline__ void tr_load(const TrDesc& d, float (&v)[32], int lane) {
#pragma unroll
    for (int i = 0; i < 32; ++i) { const int kk = 2 * i + (lane >> 5); v[i] = d.zero ? 0.f : d.W[(size_t)(d.k0 + kk) * d.ldw + d.c0 + (lane & 31)]; }
}
__device__ __forceinline__ void tr_store(const TrDesc& d, const float (&v)[32], LAS float* scr, int lane) {
#pragma unroll
    for (int i = 0; i < 32; ++i) { const int kk = 2 * i + (lane >> 5); float x = v[i]; if (d.gk) x *= d.gk[d.k0 + kk]; scr[kk * 33 + (lane & 31)] = x; }
    LDS_WAIT(); asm volatile("" ::: "memory");
    const int c = lane & 7;
#pragma unroll
    for (int j = 0; j < 4; ++j) { const int n = (lane >> 3) + 8 * j; const LAS float* s = scr + (8 * c) * 33 + n;
        v4u o; o.x = pk2(s[0 * 33], s[1 * 33]); o.y = pk2(s[2 * 33], s[3 * 33]); o.z = pk2(s[4 * 33], s[5 * 33]); o.w = pk2(s[6 * 33], s[7 * 33]);
        *(GAS v4u*)(d.WT + (size_t)(d.drow0 + n) * d.K + d.k0 + 8 * c) = o; }
    LDS_WAIT(); asm volatile("" ::: "memory");
}
__device__ __forceinline__ TrDesc tr_desc(const Args& a, int L, int it) {
    unsigned char* ws = a.ws; const bool even = !(L & 1); const int li = L >> 1; const bool odd2 = a.dbl && (L & 1);
    constexpr int nGU = 32 * 352, nD = 88 * 64; const int nIN = 32 * (even ? 160 : 128);
    TrDesc d; d.zero = false; int r = it;
    if (r < 2 * nGU) { const int f = r / nGU; r -= f * nGU; const int kb = r / 352, rb = r % 352, tj = rb >> 3, sub = rb & 7;
        d.W = (sub < 4 ? a.in[I_WG] : a.in[I_WU]) + (size_t)(L * 2 + f) * D * FF; d.ldw = FF; d.k0 = 64 * kb; d.c0 = 128 * tj + 32 * (sub & 3); d.gk = a.in[I_NG] + (L * 3 + (f ? 2 : 0)) * D;
        d.WT = (bf16*)(ws + (f ? (odd2 ? WT2_GU2 : WT_GU2) : WT_GU1)); d.K = D; d.drow0 = 32 * rb; return d; }
    r -= 2 * nGU;
    if (r < 2 * nD) { const int f = r / nD; r -= f * nD; const int kb = r / 64, nb = r % 64;
        d.W = a.in[I_WD] + (size_t)(L * 2 + f) * FF * D; d.ldw = D; d.k0 = 64 * kb; d.c0 = 32 * nb; d.gk = nullptr; d.WT = (bf16*)(ws + (f ? (odd2 ? WT2_D2 : WT_D2) : WT_D1)); d.K = FF; d.drow0 = 32 * nb; return d; }
    r -= 2 * nD;
    if (r < nIN) {
        d.gk = a.in[I_NG] + (L * 3 + 1) * D; d.WT = (bf16*)(ws + WT_IN); d.K = D;
        if (even) { const int kb = r / 160, rb = r % 160, dd = 32 * rb; d.zero = dd >= E_IN; d.W = a.in[I_EWIN] + (size_t)li * D * E_IN; d.ldw = E_IN; d.k0 = 64 * kb; d.c0 = d.zero ? 0 : (dd < ZA ? A_COLS + dd : dd - ZA); d.drow0 = dd; }
        else { const int kb = r / 128, rb = r % 128; d.W = a.in[I_OWIN] + (size_t)li * D * ZO; d.ldw = ZO; d.k0 = 64 * kb; d.c0 = 32 * rb; d.drow0 = 32 * rb; }
        return d; }
    r -= nIN;
    { const int kb = r / 64, nb = r % 64; d.W = (even ? a.in[I_EWOUT] : a.in[I_OWOUT]) + (size_t)li * D * D; d.ldw = D; d.k0 = 64 * kb; d.c0 = 32 * nb; d.gk = nullptr; d.WT = (bf16*)(ws + (odd2 ? WT2_OUT : WT_OUT)); d.K = D; d.drow0 = 32 * nb; }
    return d;
}
__device__ __forceinline__ void prep_phase(const Args& a, int L, LAS unsigned char* lds, int vcu, int G, int wave, int lane, int mode) {
    asm volatile("" : "+s"(G));
    LAS float* scr = (LAS float*)(lds + wave * 16384);
    const int gw = vcu * NWAVES + wave, NGW = G * NWAVES;
    unsigned char* ws = a.ws;
    const bool even = !(L & 1); const int li = L >> 1;
    const int nGU = 32 * 352, nD = 88 * 64, nIN = 32 * (even ? 160 : 128), nOUT = 32 * 64;
    const int total = mode == 0 ? 2 * nGU + 2 * nD + nIN + nOUT : mode == 1 ? nGU + nD + nIN : nGU + nD + nOUT;
    const int sh0 = mode == 2 ? nGU : 0, sh1 = mode == 0 ? 0 : mode == 1 ? nGU : nGU + nD, sh2 = mode == 0 ? 0 : mode == 1 ? nGU + nD : nGU + nD + nIN;
#define PREP_IT(i) ((mode == 0) ? (i) : (i) < nGU ? (i) + sh0 : (i) < nGU + nD ? (i) + sh1 : (i) + sh2)
    if (gw < total) {
        TrDesc d0 = tr_desc(a, L, PREP_IT(gw)); float v0[32]; tr_load(d0, v0, lane);
        for (int it = gw; it < total; it += NGW) {
            const int itn = it + NGW; const bool hasn = itn < total; const int itx = hasn ? itn : it;
            TrDesc d1 = tr_desc(a, L, PREP_IT(itx)); float v1[32];
            if (hasn) tr_load(d1, v1, lane);
            tr_store(d0, v0, scr, lane);
            d0 = d1;
#pragma unroll
            for (int i = 0; i < 32; ++i) v0[i] = v1[i];
        }
    }
#undef PREP_IT
    if (mode != 2) {
        const int gt = gw * 64 + lane, NGT = NGW * 64;
        if (even) {
            const float* w2 = a.in[I_EW2] + (size_t)li * 64 * 1024; const float* a2 = a.in[I_EA2] + (size_t)li * 64 * 1024; const float* g2 = a.in[I_EG2] + (size_t)li * 160 * 1024;
            bf16* W2T = (bf16*)(ws + SM_W2T); bf16* A2T = (bf16*)(ws + SM_A2T); bf16* G2T = (bf16*)(ws + SM_G2T);
            for (int e = gt; e < 1024 * 64; e += NGT) { const int k = e >> 10, c = e & 1023; W2T[c * 64 + k] = (bf16)f2bf(w2[e]); A2T[c * 64 + k] = (bf16)f2bf(a2[e]); }
            for (int e = gt; e < 1024 * 160; e += NGT) { const int k = e >> 10, c = e & 1023; G2T[c * 160 + k] = (bf16)f2bf(g2[e]); }
            if (li > 0) { bf16* V1T = (bf16*)(ws + SM_V1T); bf16* V2T = (bf16*)(ws + SM_V2T);
                for (int e = gt; e < 1024 * 32; e += NGT) { const int c = e >> 5, j = e & 31; V1T[j * 1024 + c] = (bf16)f2bf(a.in[I_V1][e]); }
                for (int e = gt; e < 32 * 1024; e += NGT) { const int j = e >> 10, c = e & 1023; V2T[c * 32 + j] = (bf16)f2bf(a.in[I_V2][e]); } }
        } else {
            const float* wsg = a.in[I_OWS] + (size_t)li * 16 * 128 * 128; bf16* WSB = (bf16*)(ws + SM_WSB);
            for (int e = gt; e < 16 * 128 * 128; e += NGT) { const int i = (e >> 7) & 127, j = e & 127; WSB[e] = (bf16)f2bf(j <= i ? wsg[e] : 0.f); }
        }
    }
    if (L == 0) {
        float* ss0 = (float*)(ws + WS_SS); bf16* XB = (bf16*)(ws + WS_XB);
        for (int m = gw; m < M; m += NGW) {
            const GAS f32x4* xr = (const GAS f32x4*)(a.in[I_X] + (size_t)m * D) + lane; GAS v2u* o = (GAS v2u*)(XB + (size_t)m * D) + lane; float s = 0.f;
#pragma unroll
            for (int j = 0; j < 8; ++j) { const f32x4 v = xr[64 * j]; s += (v.x * v.x + v.y * v.y) + (v.z * v.z + v.w * v.w); v2u w; w.x = pk2(v.x, v.y); w.y = pk2(v.z, v.w); o[64 * j] = w; }
            s = wave_sum(s); if (lane < 8) ss0[(size_t)lane * M + m] = lane ? 0.f : s;
        }
    }
}

typedef short bf16x8_t __attribute__((ext_vector_type(8)));
__device__ __forceinline__ float fast_tanh(float x) { const float e = __expf(2.0f * x); return 1.0f - 2.0f / (1.0f + e); }
__device__ __forceinline__ void lerp8(const v4u c, const v4u p, const float* mu, float (&o)[8]) {
    const f32x4 m0 = *(const f32x4*)mu, m1 = *(const f32x4*)(mu + 4);
    const float c0 = bflo(c.x), c1 = bfhi(c.x), c2 = bflo(c.y), c3 = bfhi(c.y), c4 = bflo(c.z), c5 = bfhi(c.z), c6 = bflo(c.w), c7 = bfhi(c.w);
    o[0] = c0 + (bflo(p.x) - c0) * m0.x; o[1] = c1 + (bfhi(p.x) - c1) * m0.y; o[2] = c2 + (bflo(p.y) - c2) * m0.z; o[3] = c3 + (bfhi(p.y) - c3) * m0.w;
    o[4] = c4 + (bflo(p.z) - c4) * m1.x; o[5] = c5 + (bfhi(p.z) - c5) * m1.y; o[6] = c6 + (bflo(p.w) - c6) * m1.z; o[7] = c7 + (bfhi(p.w) - c7) * m1.w;
}
__device__ __forceinline__ void lerp4(const v2u c, const v2u p, const f32x4 m, float (&o)[4]) {
    const float c0 = bflo(c.x), c1 = bfhi(c.x), c2 = bflo(c.y), c3 = bfhi(c.y);
    o[0] = c0 + (bflo(p.x) - c0) * m.x; o[1] = c1 + (bfhi(p.x) - c1) * m.y; o[2] = c2 + (bflo(p.y) - c2) * m.z; o[3] = c3 + (bfhi(p.y) - c3) * m.w;
}
__device__ __forceinline__ v2u pack4(float a, float b, float c, float d) { v2u w; w.x = pk2(a, b); w.y = pk2(c, d); return w; }
constexpr int E1_AW = 0, E1_AA = 9216, E1_AG = 18432, E1_PP = 40960, E1_PB = 106496;
__device__ __forceinline__ void e1_phase(const Args& a, int li, LAS unsigned char* ldsb, int vcu, int G, int tid) {
    unsigned char* ws = a.ws;
    const bf16* Z = (const bf16*)(ws + WS_ACT);
    bf16* R = (bf16*)(ws + SC_R); bf16* K2 = (bf16*)(ws + SC_K2); bf16* KK = (bf16*)(ws + SC_KK); bf16* BB = (bf16*)(ws + SC_BB); bf16* LW = (bf16*)(ws + SC_LW); bf16* GG = (bf16*)(ws + SC_GG);
    bf16* VO = (bf16*)(ws + (li ? WS_V2 : WS_VF)); const bf16* VF = (const bf16*)(ws + WS_VF);
    const bf16* W2T = (const bf16*)(ws + SM_W2T); const bf16* A2T = (const bf16*)(ws + SM_A2T); const bf16* G2T = (const bf16*)(ws + SM_G2T);
    const bf16* V1T = (const bf16*)(ws + SM_V1T); const bf16* V2T = (const bf16*)(ws + SM_V2T);
    const float* mu = a.in[I_EMU] + li * A_COLS;
    const float* w0 = a.in[I_EW0] + li * 1024; const float* a0 = a.in[I_EA0] + li * 1024;
    const float* kkw = a.in[I_EKK] + li * 1024; const float* kaw = a.in[I_EKA] + li * 1024; const float* v0w = a.in[I_V0];
    const int lane = tid & 63, wave = tid >> 6, fr = lane & 15, fq = lane >> 4;
    for (int unit = vcu; unit < M / 64; unit += G) {
        const int m0 = unit * 64;
        for (int e = tid; e < 64 * 36; e += NTHR) { const int r = e / 36, ch = e % 36, j0 = 8 * ch, m = m0 + r; const bool first = (m & (T - 1)) == 0;
            const v4u cur = *(const GAS v4u*)(Z + (size_t)m * ZN + ZA + 3072 + j0); v4u prv = {0u, 0u, 0u, 0u}; if (!first) prv = *(const GAS v4u*)(Z + (size_t)(m - 1) * ZN + ZA + 3072 + j0);
            float x[8]; lerp8(cur, prv, mu + 3072 + j0, x);
            if (j0 < 64) {
#pragma unroll
                for (int i = 0; i < 8; ++i) x[i] = fast_tanh(x[i]);
            } else if (j0 >= 128) {
#pragma unroll
                for (int i = 0; i < 8; ++i) x[i] = sigmoidf_(x[i]);
            }
            v4u o; o.x = pk2(x[0], x[1]); o.y = pk2(x[2], x[3]); o.z = pk2(x[4], x[5]); o.w = pk2(x[6], x[7]);
            LAS unsigned char* dst = j0 < 64 ? ldsb + E1_AW + r * 144 + j0 * 2 : j0 < 128 ? ldsb + E1_AA + r * 144 + (j0 - 64) * 2 : ldsb + E1_AG + r * 336 + (j0 - 128) * 2;
            *(LAS v4u*)dst = o; }
        if (li > 0) {
            f32x4 pacc[4][2];
#pragma unroll
            for (int mt = 0; mt < 4; ++mt) { pacc[mt][0] = (f32x4){0.f, 0.f, 0.f, 0.f}; pacc[mt][1] = pacc[mt][0]; }
            for (int ks = 0; ks < 4; ++ks) { const int c = 128 * wave + 32 * ks + 8 * fq;
                const bf16x8_t w0f = *(const GAS bf16x8_t*)(V1T + (size_t)fr * 1024 + c), w1f = *(const GAS bf16x8_t*)(V1T + (size_t)(16 + fr) * 1024 + c);
#pragma unroll
                for (int mt = 0; mt < 4; ++mt) { const int m = m0 + 16 * mt + fr; const bool first = (m & (T - 1)) == 0;
                    const v4u cur = *(const GAS v4u*)(Z + (size_t)m * ZN + ZA + 2048 + c); v4u prv = {0u, 0u, 0u, 0u}; if (!first) prv = *(const GAS v4u*)(Z + (size_t)(m - 1) * ZN + ZA + 2048 + c);
                    float x[8]; lerp8(cur, prv, mu + 2048 + c, x);
                    v4u o; o.x = pk2(x[0], x[1]); o.y = pk2(x[2], x[3]); o.z = pk2(x[4], x[5]); o.w = pk2(x[6], x[7]);
                    const bf16x8_t af = __builtin_bit_cast(bf16x8_t, o);
                    pacc[mt][0] = __builtin_amdgcn_mfma_f32_16x16x32_bf16(w0f, af, pacc[mt][0], 0, 0, 0); pacc[mt][1] = __builtin_amdgcn_mfma_f32_16x16x32_bf16(w1f, af, pacc[mt][1], 0, 0, 0); } }
#pragma unroll
            for (int mt = 0; mt < 4; ++mt)
#pragma unroll
                for (int nt = 0; nt < 2; ++nt) *(LAS f32x4*)(ldsb + E1_PP + ((wave * 64 + 16 * mt + fr) * 32 + 16 * nt + 4 * fq) * 4) = pacc[mt][nt];
        }
        __syncthreads();
        if (li > 0) {
            for (int e = tid; e < 64 * 32; e += NTHR) { float sum = 0.f;
#pragma unroll
                for (int w = 0; w < 8; ++w) sum += *(const LAS float*)(ldsb + E1_PP + (w * 2048 + e) * 4);
                *(LAS bf16*)(ldsb + E1_PB + (e >> 5) * 80 + (e & 31) * 2) = (bf16)f2bf(sum); }
            __syncthreads();
        }
#define E1_WROW(nt) (cb + 32 * ((nt) >> 1) + 8 * (fr >> 2) + 4 * ((nt) & 1) + (fr & 3))
#pragma unroll 1
        for (int hh = 0; hh < 2; ++hh) {
            const int cb = 128 * wave + 64 * hh;
            {
                bf16x8_t wa[4][2];
#pragma unroll
                for (int nt = 0; nt < 4; ++nt)
#pragma unroll
                    for (int ks = 0; ks < 2; ++ks) wa[nt][ks] = *(const GAS bf16x8_t*)(A2T + (size_t)E1_WROW(nt) * 64 + 32 * ks + 8 * fq);
                v4u ncur[2], nprv[2];
                { const int m = m0 + fr; const bool first = (m & (T - 1)) == 0; const size_t zo = (size_t)m * ZN + ZA + cb + 8 * fq;
#pragma unroll
                  for (int p = 0; p < 2; ++p) { ncur[p] = *(const GAS v4u*)(Z + zo + 1024 + 32 * p); nprv[p] = (v4u){0u, 0u, 0u, 0u}; if (!first) nprv[p] = *(const GAS v4u*)(Z + zo - ZN + 1024 + 32 * p); } }
#pragma unroll 1
                for (int mt = 0; mt < 4; ++mt) {
                    const int m = m0 + 16 * mt + fr;
                    v4u ccur[2], cprv[2];
#pragma unroll
                    for (int p = 0; p < 2; ++p) { ccur[p] = ncur[p]; cprv[p] = nprv[p]; }
                    if (mt < 3) { const size_t zn = (size_t)(m + 16) * ZN + ZA + cb + 8 * fq;
#pragma unroll
                        for (int p = 0; p < 2; ++p) { ncur[p] = *(const GAS v4u*)(Z + zn + 1024 + 32 * p); nprv[p] = *(const GAS v4u*)(Z + zn - ZN + 1024 + 32 * p); } }
                    f32x4 aa[4];
#pragma unroll
                    for (int nt = 0; nt < 4; ++nt) aa[nt] = (f32x4){0.f, 0.f, 0.f, 0.f};
#pragma unroll
                    for (int ks = 0; ks < 2; ++ks) { const bf16x8_t fa = *(const LAS bf16x8_t*)(ldsb + E1_AA + (16 * mt + fr) * 144 + (32 * ks + 8 * fq) * 2);
#pragma unroll
                        for (int nt = 0; nt < 4; ++nt) aa[nt] = __builtin_amdgcn_mfma_f32_16x16x32_bf16(wa[nt][ks], fa, aa[nt], 0, 0, 0); }
                    float k1[2][8], av[2][8], kk0[2][8]; float n2 = 0.f;
#pragma unroll
                    for (int p = 0; p < 2; ++p) { const int c = cb + 32 * p + 8 * fq;
                        lerp8(ccur[p], cprv[p], mu + 1024 + c, k1[p]);
                        const f32x4 a00 = *(const f32x4*)(a0 + c), a01 = *(const f32x4*)(a0 + c + 4), kk00 = *(const f32x4*)(kkw + c), kk01 = *(const f32x4*)(kkw + c + 4);
#pragma unroll
                        for (int j = 0; j < 8; ++j) { const float a0j = j < 4 ? a00[j & 3] : a01[j & 3], kkj = j < 4 ? kk00[j & 3] : kk01[j & 3];
                            av[p][j] = sigmoidf_(a0j + aa[2 * p + (j >> 2)][j & 3]); kk0[p][j] = k1[p][j] * kkj; n2 += kk0[p][j] * kk0[p][j]; } }
                    n2 += __shfl_xor(n2, 16); n2 += __shfl_xor(n2, 32);
                    const float inv = 1.0f / fmaxf(sqrtf(n2), 1e-12f);
#pragma unroll
                    for (int p = 0; p < 2; ++p) { const int c = cb + 32 * p + 8 * fq; const size_t o = (size_t)m * 1024 + c; const f32x4 ka0 = *(const f32x4*)(kaw + c), ka1 = *(const f32x4*)(kaw + c + 4);
                        float kk[8], k2[8], bb[8];
#pragma unroll
                        for (int j = 0; j < 8; ++j) { const float kaj = j < 4 ? ka0[j & 3] : ka1[j & 3]; kk[j] = kk0[p][j] * inv; k2[j] = k1[p][j] * (1.0f + (av[p][j] - 1.0f) * kaj); bb[j] = kk[j] * av[p][j]; }
                        *(GAS v4u*)(KK + o) = (v4u){pk2(kk[0], kk[1]), pk2(kk[2], kk[3]), pk2(kk[4], kk[5]), pk2(kk[6], kk[7])};
                        *(GAS v4u*)(K2 + o) = (v4u){pk2(k2[0], k2[1]), pk2(k2[2], k2[3]), pk2(k2[4], k2[5]), pk2(k2[6], k2[7])};
                        *(GAS v4u*)(BB + o) = (v4u){pk2(bb[0], bb[1]), pk2(bb[2], bb[3]), pk2(bb[4], bb[5]), pk2(bb[6], bb[7])}; }
                }
            }
            {
                bf16x8_t ww[4][2];
#pragma unroll
                for (int nt = 0; nt < 4; ++nt)
#pragma unroll
                    for (int ks = 0; ks < 2; ++ks) ww[nt][ks] = *(const GAS bf16x8_t*)(W2T + (size_t)E1_WROW(nt) * 64 + 32 * ks + 8 * fq);
#pragma unroll 1
                for (int mt = 0; mt < 4; ++mt) {
                    const int m = m0 + 16 * mt + fr;
                    f32x4 aw[4];
#pragma unroll
                    for (int nt = 0; nt < 4; ++nt) aw[nt] = (f32x4){0.f, 0.f, 0.f, 0.f};
#pragma unroll
                    for (int ks = 0; ks < 2; ++ks) { const bf16x8_t fw = *(const LAS bf16x8_t*)(ldsb + E1_AW + (16 * mt + fr) * 144 + (32 * ks + 8 * fq) * 2);
#pragma unroll
                        for (int nt = 0; nt < 4; ++nt) aw[nt] = __builtin_amdgcn_mfma_f32_16x16x32_bf16(ww[nt][ks], fw, aw[nt], 0, 0, 0); }
#pragma unroll
                    for (int p = 0; p < 2; ++p) { const int c = cb + 32 * p + 8 * fq; const f32x4 w00 = *(const f32x4*)(w0 + c), w01 = *(const f32x4*)(w0 + c + 4); float lw[8];
#pragma unroll
                        for (int j = 0; j < 8; ++j) { const float y = -((j < 4 ? w00[j & 3] : w01[j & 3]) + aw[2 * p + (j >> 2)][j & 3]); const float sp = fmaxf(y, 0.f) + __logf(1.0f + __expf(-fabsf(y))); lw[j] = -__expf(-sp - 0.5f); }
                        *(GAS v4u*)(LW + (size_t)m * 1024 + c) = (v4u){pk2(lw[0], lw[1]), pk2(lw[2], lw[3]), pk2(lw[4], lw[5]), pk2(lw[6], lw[7])}; }
                }
            }
            {
                bf16x8_t wg[4][5];
#pragma unroll
                for (int nt = 0; nt < 4; ++nt)
#pragma unroll
                    for (int ks = 0; ks < 5; ++ks) wg[nt][ks] = *(const GAS bf16x8_t*)(G2T + (size_t)E1_WROW(nt) * 160 + 32 * ks + 8 * fq);
#pragma unroll 1
                for (int mt = 0; mt < 4; ++mt) {
                    const int m = m0 + 16 * mt + fr;
                    f32x4 ag[4];
#pragma unroll
                    for (int nt = 0; nt < 4; ++nt) ag[nt] = (f32x4){0.f, 0.f, 0.f, 0.f};
#pragma unroll
                    for (int ks = 0; ks < 5; ++ks) { const bf16x8_t fg = *(const LAS bf16x8_t*)(ldsb + E1_AG + (16 * mt + fr) * 336 + (32 * ks + 8 * fq) * 2);
#pragma unroll
                        for (int nt = 0; nt < 4; ++nt) ag[nt] = __builtin_amdgcn_mfma_f32_16x16x32_bf16(wg[nt][ks], fg, ag[nt], 0, 0, 0); }
#pragma unroll
                    for (int p = 0; p < 2; ++p) *(GAS v4u*)(GG + (size_t)m * 1024 + cb + 32 * p + 8 * fq) = (v4u){pk2(ag[2 * p][0], ag[2 * p][1]), pk2(ag[2 * p][2], ag[2 * p][3]), pk2(ag[2 * p + 1][0], ag[2 * p + 1][1]), pk2(ag[2 * p + 1][2], ag[2 * p + 1][3])};
                }
            }
            {
                v4u nrc[2], nrp[2];
                { const int m = m0 + fr; const bool first = (m & (T - 1)) == 0; const size_t zo = (size_t)m * ZN + ZA + cb + 8 * fq;
#pragma unroll
                  for (int p = 0; p < 2; ++p) { nrc[p] = *(const GAS v4u*)(Z + zo + 32 * p); nrp[p] = (v4u){0u, 0u, 0u, 0u}; if (!first) nrp[p] = *(const GAS v4u*)(Z + zo - ZN + 32 * p); } }
#pragma unroll 1
                for (int mt = 0; mt < 4; ++mt) {
                    const int m = m0 + 16 * mt + fr;
                    v4u crc[2], crp[2];
#pragma unroll
                    for (int p = 0; p < 2; ++p) { crc[p] = nrc[p]; crp[p] = nrp[p]; }
                    if (mt < 3) { const size_t zn = (size_t)(m + 16) * ZN + ZA + cb + 8 * fq;
#pragma unroll
                        for (int p = 0; p < 2; ++p) { nrc[p] = *(const GAS v4u*)(Z + zn + 32 * p); nrp[p] = *(const GAS v4u*)(Z + zn - ZN + 32 * p); } }
#pragma unroll
                    for (int p = 0; p < 2; ++p) { const int c = cb + 32 * p + 8 * fq; float rr[8]; lerp8(crc[p], crp[p], mu + c, rr);
                        *(GAS v4u*)(R + (size_t)m * 1024 + c) = (v4u){pk2(rr[0], rr[1]), pk2(rr[2], rr[3]), pk2(rr[4], rr[5]), pk2(rr[6], rr[7])}; }
                }
            }
            {
                bf16x8_t wv2[4];
#pragma unroll
                for (int nt = 0; nt < 4; ++nt) { wv2[nt] = (bf16x8_t){0, 0, 0, 0, 0, 0, 0, 0}; if (li > 0) wv2[nt] = *(const GAS bf16x8_t*)(V2T + (size_t)E1_WROW(nt) * 32 + 8 * fq); }
                v4u nvc[2], nvp[2];
                { const int m = m0 + fr; const bool first = (m & (T - 1)) == 0; const size_t zo = (size_t)m * ZN + ZA + cb + 8 * fq;
#pragma unroll
                  for (int p = 0; p < 2; ++p) { nvc[p] = *(const GAS v4u*)(Z + zo + 2048 + 32 * p); nvp[p] = (v4u){0u, 0u, 0u, 0u}; if (!first) nvp[p] = *(const GAS v4u*)(Z + zo - ZN + 2048 + 32 * p); } }
#pragma unroll 1
                for (int mt = 0; mt < 4; ++mt) {
                    const int m = m0 + 16 * mt + fr;
                    v4u cvc[2], cvp[2];
#pragma unroll
                    for (int p = 0; p < 2; ++p) { cvc[p] = nvc[p]; cvp[p] = nvp[p]; }
                    if (mt < 3) { const size_t zn = (size_t)(m + 16) * ZN + ZA + cb + 8 * fq;
#pragma unroll
                        for (int p = 0; p < 2; ++p) { nvc[p] = *(const GAS v4u*)(Z + zn + 2048 + 32 * p); nvp[p] = *(const GAS v4u*)(Z + zn - ZN + 2048 + 32 * p); } }
                    f32x4 avr[4];
#pragma unroll
                    for (int nt = 0; nt < 4; ++nt) avr[nt] = (f32x4){0.f, 0.f, 0.f, 0.f};
                    if (li > 0) { const bf16x8_t fp = *(const LAS bf16x8_t*)(ldsb + E1_PB + (16 * mt + fr) * 80 + (8 * fq) * 2);
#pragma unroll
                        for (int nt = 0; nt < 4; ++nt) avr[nt] = __builtin_amdgcn_mfma_f32_16x16x32_bf16(wv2[nt], fp, avr[nt], 0, 0, 0); }
#pragma unroll
                    for (int p = 0; p < 2; ++p) { const int c = cb + 32 * p + 8 * fq; const size_t o = (size_t)m * 1024 + c;
                        float vv[8]; lerp8(cvc[p], cvp[p], mu + 2048 + c, vv);
                        if (li > 0) { const f32x4 v00 = *(const f32x4*)(v0w + c), v01 = *(const f32x4*)(v0w + c + 4); const v4u vf = *(const GAS v4u*)(VF + o);
                            const float f[8] = {bflo(vf.x), bfhi(vf.x), bflo(vf.y), bfhi(vf.y), bflo(vf.z), bfhi(vf.z), bflo(vf.w), bfhi(vf.w)};
#pragma unroll
                            for (int j = 0; j < 8; ++j) vv[j] += (f[j] - vv[j]) * sigmoidf_((j < 4 ? v00[j & 3] : v01[j & 3]) + avr[2 * p + (j >> 2)][j & 3]); }
                        *(GAS v4u*)(VO + o) = (v4u){pk2(vv[0], vv[1]), pk2(vv[2], vv[3]), pk2(vv[4], vv[5]), pk2(vv[6], vv[7])}; }
                }
            }
        }
#undef E1_WROW
        __syncthreads();
    }
}

constexpr size_t CS_AR = WS_ACT, CS_BK = WS_ACT + 128 * MiB, CS_Y0 = WS_ACT + 256 * MiB, CS_GL = WS_ACT + 320 * MiB;
__device__ __forceinline__ int cs_perm(int k) { return (k & 32) + 8 * ((k >> 2) & 3) + 4 * ((k >> 4) & 1) + (k & 3); }
__device__ __forceinline__ f32x4 mm16_ll(const LAS float* A, const LAS float* B, f32x4 c, int fr, int fq) {
    const f32x4 a4 = *(const LAS f32x4*)(A + fr * 16 + 4 * fq);
#pragma unroll
    for (int s = 0; s < 4; ++s) c = __builtin_amdgcn_mfma_f32_16x16x4f32(a4[s], B[(4 * fq + s) * 16 + fr], c, 0, 0, 0);
    return c;
}
__device__ __forceinline__ f32x4 mm16_la(const LAS float* A, const f32x4 b, f32x4 c, int fr, int fq) {
    const f32x4 a4 = *(const LAS f32x4*)(A + fr * 16 + 4 * fq);
#pragma unroll
    for (int s = 0; s < 4; ++s) c = __builtin_amdgcn_mfma_f32_16x16x4f32(a4[s], b[s], c, 0, 0, 0);
    return c;
}
__device__ __forceinline__ void st16(LAS float* Mx, const f32x4 c, int fr, int fq) {
#pragma unroll
    for (int r = 0; r < 4; ++r) Mx[(4 * fq + r) * 16 + fr] = c[r];
}
__device__ __forceinline__ void scanpre_phase(const Args& a, int li, LAS unsigned char* ldsb, int vcu, int G, int tid) {
    unsigned char* ws = a.ws;
    const bf16* Rr = (const bf16*)(ws + SC_R); const bf16* K2 = (const bf16*)(ws + SC_K2); const bf16* KK = (const bf16*)(ws + SC_KK); const bf16* BB = (const bf16*)(ws + SC_BB); const bf16* LW = (const bf16*)(ws + SC_LW);
    const bf16* V = (const bf16*)(ws + (li ? WS_V2 : WS_VF));
    bf16* ARo = (bf16*)(ws + CS_AR); bf16* BKo = (bf16*)(ws + CS_BK); bf16* Y0o = (bf16*)(ws + CS_Y0); float* GLo = (float*)(ws + CS_GL); bf16* U0o = (bf16*)(ws + WS_U0);
    const int lane = tid & 63, wave = tid >> 6, fr = lane & 15, fq = lane >> 4;
    LAS unsigned char* wl = ldsb + wave * 17408;
    LAS bf16* LAR = (LAS bf16*)wl; LAS bf16* LBK = (LAS bf16*)(wl + 4608); LAS float* LM = (LAS float*)(wl + 9216); LAS float* LX = (LAS float*)(wl + 13312);
    const LAS float* Mab = LM, *Mak = LM + 256, *Mrb = LM + 512, *Mrk = LM + 768;
    LAS float* Tm = LX, *Na = LX + 256, *Nb = LX + 512;
    for (int ch = vcu * NWAVES + wave; ch < 32 * 1024; ch += G * NWAVES) {
        const int bh = ch >> 10, ci = ch & 1023, b = bh >> 4, h = bh & 15; const size_t row0 = (size_t)b * T + 16 * ci;
        f32x4 At[4], Rt[4], vv[4]; float glane;
#pragma unroll
        for (int nt = 0; nt < 4; ++nt) { f32x4 lw, kk, bb, k2, rr;
#pragma unroll
            for (int s = 0; s < 4; ++s) { const size_t o = (row0 + 4 * fq + s) * 1024 + h * 64 + 16 * nt + fr;
                lw[s] = bf2f(LW[o]); kk[s] = bf2f(KK[o]); bb[s] = bf2f(BB[o]); k2[s] = bf2f(K2[o]); rr[s] = bf2f(Rr[o]); vv[nt][s] = bf2f(V[o]); }
            f32x4 cum; cum[0] = lw[0]; cum[1] = cum[0] + lw[1]; cum[2] = cum[1] + lw[2]; cum[3] = cum[2] + lw[3];
            float x = cum[3]; { const float y = __shfl_up(x, 16); if (fq >= 1) x += y; } { const float y = __shfl_up(x, 32); if (fq >= 2) x += y; }
            const float excl = x - cum[3]; const float cl = __shfl(x, 48 + fr);
            bf16* bo = BKo + (size_t)ch * 2048 + (16 * nt + fr) * 32 + 8 * fq; f32x4 bh4, kh4;
#pragma unroll
            for (int s = 0; s < 4; ++s) { const float c = excl + cum[s]; const float g = __expf(c), gp = __expf(c - lw[s]), gi = __expf(-c), e = __expf(cl - c);
                At[nt][s] = -kk[s] * gp; Rt[nt][s] = rr[s] * g; bh4[s] = bb[s] * e; kh4[s] = k2[s] * e;
                const int t = 4 * fq + s, cc = 16 * nt + fr;
                LAR[t * 72 + cc] = (bf16)f2bf(At[nt][s]); LAR[(16 + t) * 72 + cc] = (bf16)f2bf(Rt[nt][s]); LBK[t * 72 + cc] = (bf16)f2bf(bb[s] * gi); LBK[(16 + t) * 72 + cc] = (bf16)f2bf(k2[s] * gi); }
            *(GAS v4u*)bo = (v4u){pk2(bh4[0], bh4[1]), pk2(bh4[2], bh4[3]), pk2(kh4[0], kh4[1]), pk2(kh4[2], kh4[3])};
            if (fq == 0) GLo[(size_t)ch * 64 + 16 * nt + fr] = __expf(cl);
            glane = cl; }
        (void)glane;
        LDS_WAIT(); asm volatile("" ::: "memory");
#pragma unroll
        for (int mt = 0; mt < 2; ++mt)
#pragma unroll
            for (int nt = 0; nt < 2; ++nt) { f32x4 m = {0.f, 0.f, 0.f, 0.f};
#pragma unroll
                for (int ks = 0; ks < 2; ++ks) { const bf16x8_t af = *(const LAS bf16x8_t*)(LAR + (16 * mt + fr) * 72 + 32 * ks + 8 * fq), bfr = *(const LAS bf16x8_t*)(LBK + (16 * nt + fr) * 72 + 32 * ks + 8 * fq);
                    m = __builtin_amdgcn_mfma_f32_16x16x32_bf16(af, bfr, m, 0, 0, 0); }
#pragma unroll
                for (int r = 0; r < 4; ++r) { const int t = 4 * fq + r; const bool keep = mt ? (fr <= t) : (fr < t); LM[((mt * 2 + nt) * 16 + t) * 16 + fr] = keep ? m[r] : 0.f; } }
        LDS_WAIT(); asm volatile("" ::: "memory");
        { const f32x4 z = {0.f, 0.f, 0.f, 0.f};
          f32x4 t1;
#pragma unroll
          for (int r = 0; r < 4; ++r) t1[r] = Mab[(4 * fq + r) * 16 + fr] + ((4 * fq + r) == fr ? 1.0f : 0.f);
          st16(Tm, t1, fr, fq);
          f32x4 n2 = mm16_ll(Mab, Mab, z, fr, fq); st16(Na, n2, fr, fq);
          LDS_WAIT(); asm volatile("" ::: "memory");
          f32x4 t2 = mm16_ll(Tm, Na, t1, fr, fq);
          f32x4 n4 = mm16_ll(Na, Na, z, fr, fq);
          LDS_WAIT(); asm volatile("" ::: "memory");
          st16(Tm, t2, fr, fq); st16(Nb, n4, fr, fq);
          LDS_WAIT(); asm volatile("" ::: "memory");
          f32x4 t3 = mm16_ll(Tm, Nb, t2, fr, fq);
          f32x4 n8 = mm16_ll(Nb, Nb, z, fr, fq);
          LDS_WAIT(); asm volatile("" ::: "memory");
          st16(Tm, t3, fr, fq); st16(Na, n8, fr, fq);
          LDS_WAIT(); asm volatile("" ::: "memory");
          f32x4 t4 = mm16_ll(Tm, Na, t3, fr, fq);
          LDS_WAIT(); asm volatile("" ::: "memory");
          st16(Tm, t4, fr, fq);
          LDS_WAIT(); asm volatile("" ::: "memory"); }
#pragma unroll
        for (int nt = 0; nt < 4; ++nt) { const f32x4 z = {0.f, 0.f, 0.f, 0.f};
            const f32x4 w1 = mm16_la(Mak, vv[nt], z, fr, fq);
            const f32x4 u0 = mm16_la(Tm, w1, z, fr, fq);
            const f32x4 ah = mm16_la(Tm, At[nt], z, fr, fq);
            const f32x4 rh = mm16_la(Mrb, ah, Rt[nt], fr, fq);
            f32x4 y0 = mm16_la(Mrb, u0, z, fr, fq); y0 = mm16_la(Mrk, vv[nt], y0, fr, fq);
            const int k = 16 * nt + fr; bf16* arp = ARo + (size_t)ch * 2048 + cs_perm(k);
#pragma unroll
            for (int s = 0; s < 4; ++s) { arp[(4 * fq + s) * 64] = (bf16)f2bf(ah[s]); arp[(16 + 4 * fq + s) * 64] = (bf16)f2bf(rh[s]); }
            *(GAS v2u*)(Y0o + (size_t)ch * 1024 + k * 16 + 4 * fq) = pack4(y0[0], y0[1], y0[2], y0[3]);
            *(GAS v2u*)(U0o + (size_t)ch * 1024 + k * 16 + 4 * fq) = pack4(u0[0], u0[1], u0[2], u0[3]); }
        LDS_WAIT(); asm volatile("" ::: "memory");
    }
}
#ifndef PF_ON
#define PF_ON 0
#endif
constexpr int CQ_NS = 13, CQ_SLOT = 10240, CQ_FULL = CQ_NS * CQ_SLOT, CQ_DONE = CQ_FULL + 64, CQ_NL = 6;
#define CQ_GLDS(src, dst) __builtin_amdgcn_global_load_lds((const unsigned*)(src), (LAS unsigned*)(dst), 16, 0, 0)
typedef unsigned short u16x2_t __attribute__((ext_vector_type(2)));
struct CqOps { bf16x8_t ar[2][2], bk[4]; f32x4 gl[4]; v2u u0, y0; u16x2_t v01, v23; f32x4 u0f, y0f; };
__device__ __forceinline__ void cq_load(CqOps& o, LAS unsigned char* sl, int fr, int fq) {
#pragma unroll
    for (int mt = 0; mt < 2; ++mt)
#pragma unroll
        for (int ks = 0; ks < 2; ++ks) { const int r = 16 * mt + fr; o.ar[mt][ks] = *(const LAS bf16x8_t*)(sl + r * 128 + 16 * ((4 * ks + fq) ^ (r & 7))); }
#pragma unroll
    for (int kt = 0; kt < 4; ++kt) { const int k = 16 * kt + fr; o.bk[kt] = *(const LAS bf16x8_t*)(sl + 4096 + k * 64 + 16 * (fq ^ ((k >> 2) & 3))); o.gl[kt] = *(const LAS f32x4*)(sl + 9728 + (16 * kt + 4 * fq) * 4); }
    o.u0 = *(const LAS v2u*)(sl + 8192 + fr * 32 + 8 * fq); o.y0 = *(const LAS v2u*)(sl + 8704 + fr * 32 + 8 * fq);
    const LAS unsigned short* vp = (const LAS unsigned short*)(sl + 9216 + (4 * fq) * 32 + 2 * fr);
    o.v01.x = vp[0]; o.v01.y = vp[16]; o.v23.x = vp[32]; o.v23.y = vp[48];
}
__device__ __forceinline__ void cq_unpack(CqOps& o) {
    o.u0f = (f32x4){bflo(o.u0.x), bfhi(o.u0.x), bflo(o.u0.y), bfhi(o.u0.y)}; o.y0f = (f32x4){bflo(o.y0.x), bfhi(o.y0.x), bflo(o.y0.y), bfhi(o.y0.y)};
}
__device__ __forceinline__ void cq_step(const CqOps& cur, CqOps& nxt, f32x4 (&St)[4], LAS unsigned char* ldsb, int sn, int cn, volatile LAS unsigned* DONE, unsigned long long ya, unsigned long long yb, unsigned yvoff,
                                        int fr, int fq, bool signal, unsigned& spins) {
    volatile LAS unsigned* fp = (volatile LAS unsigned*)(ldsb + CQ_FULL) + sn; LAS unsigned char* sln = ldsb + sn * CQ_SLOT;
    unsigned fl = *fp;
    v4u w0; w0.x = pk2(St[0][0], St[0][1]); w0.y = pk2(St[0][2], St[0][3]); w0.z = pk2(St[1][0], St[1][1]); w0.w = pk2(St[1][2], St[1][3]); const bf16x8_t sb0 = __builtin_bit_cast(bf16x8_t, w0);
    f32x4 au = __builtin_amdgcn_mfma_f32_16x16x32_bf16(cur.ar[0][0], sb0, cur.u0f, 0, 0, 0);
    v4u w1; w1.x = pk2(St[2][0], St[2][1]); w1.y = pk2(St[2][2], St[2][3]); w1.z = pk2(St[3][0], St[3][1]); w1.w = pk2(St[3][2], St[3][3]); const bf16x8_t sb1 = __builtin_bit_cast(bf16x8_t, w1);
    f32x4 ay = __builtin_amdgcn_mfma_f32_16x16x32_bf16(cur.ar[1][0], sb0, cur.y0f, 0, 0, 0);
#define CQ_DECAY(kt) ({ float g0_ = cur.gl[kt][0], g1_ = cur.gl[kt][1], g2_ = cur.gl[kt][2], g3_ = cur.gl[kt][3]; asm("" : "+v"(g0_)); asm("" : "+v"(g1_)); asm("" : "+v"(g2_)); asm("" : "+v"(g3_)); \
                        (f32x4){St[kt][0] * g0_, St[kt][1] * g1_, St[kt][2] * g2_, St[kt][3] * g3_}; })
    f32x4 Sg[4]; Sg[0] = CQ_DECAY(0); Sg[1] = CQ_DECAY(1);
    au = __builtin_amdgcn_mfma_f32_16x16x32_bf16(cur.ar[0][1], sb1, au, 0, 0, 0);
    Sg[2] = CQ_DECAY(2); Sg[3] = CQ_DECAY(3);
#undef CQ_DECAY
    ay = __builtin_amdgcn_mfma_f32_16x16x32_bf16(cur.ar[1][1], sb1, ay, 0, 0, 0);
    __builtin_amdgcn_sched_barrier(0);
    while (__builtin_amdgcn_ballot_w64(fl != (unsigned)(cn + 1)) != 0ull) { fl = *fp; if (++spins > (1u << 26)) break; }
    __builtin_amdgcn_fence(__ATOMIC_ACQUIRE, "workgroup");
    cq_load(nxt, sln, fr, fq);
    __builtin_amdgcn_sched_barrier(0);
    v4u uw; uw.x = pk2(au[0], au[1]); uw.y = pk2(au[2], au[3]); uw.z = __builtin_bit_cast(unsigned, cur.v01); uw.w = __builtin_bit_cast(unsigned, cur.v23);
    const bf16x8_t uv = __builtin_bit_cast(bf16x8_t, uw);
#pragma unroll
    for (int kt = 0; kt < 4; ++kt) St[kt] = __builtin_amdgcn_mfma_f32_16x16x32_bf16(cur.bk[kt], uv, Sg[kt], 0, 0, 0);
    asm volatile("global_store_dword %0, %1, %2 offset:-4096" :: "v"(yvoff), "v"(ay[0]), "s"(ya) : "memory");
    asm volatile("global_store_dword %0, %1, %2" :: "v"(yvoff), "v"(ay[1]), "s"(ya) : "memory");
    asm volatile("global_store_dword %0, %1, %2 offset:-4096" :: "v"(yvoff), "v"(ay[2]), "s"(yb) : "memory");
    asm volatile("global_store_dword %0, %1, %2" :: "v"(yvoff), "v"(ay[3]), "s"(yb) : "memory");
    __builtin_amdgcn_s_waitcnt(0xC07F);
    cq_unpack(nxt);
    if (signal && fr + fq == 0) DONE[0] = (unsigned)(cn + 1);
}
__device__ __forceinline__ void scanseq_phase(const Args& a, int li, LAS unsigned char* ldsb, int vcu, int tid) {
    volatile LAS unsigned* FULL = (volatile LAS unsigned*)(ldsb + CQ_FULL); volatile LAS unsigned* DONE = (volatile LAS unsigned*)(ldsb + CQ_DONE);
    if (tid < 32) ((LAS unsigned*)(ldsb + CQ_FULL))[tid] = 0u;
    __syncthreads();
    const int wave = __builtin_amdgcn_readfirstlane(tid >> 6), lane = tid & 63;
    if (vcu < 128 && wave <= CQ_NL) {
        unsigned char* ws = a.ws;
        const int bh = vcu >> 2, vb = vcu & 3, b = bh >> 4, h = bh & 15; const size_t row0 = (size_t)b * T; const size_t ch0 = (size_t)bh * 1024;
        if (wave > 0) {
            const unsigned char* ARo = ws + CS_AR; const unsigned char* BKo = ws + CS_BK; const unsigned char* Y0o = ws + CS_Y0; const unsigned char* GLo = ws + CS_GL; const unsigned char* U0o = ws + WS_U0;
            const unsigned char* V = ws + (li ? WS_V2 : WS_VF);
            const unsigned oAR = (unsigned)((lane >> 3) * 128 + 16 * ((lane & 7) ^ ((lane >> 3) & 7)));
            unsigned oBK[4];
#pragma unroll
            for (int i = 0; i < 4; ++i) { const int k = 16 * i + (lane >> 2); oBK[i] = (unsigned)(k * 64 + 16 * ((lane & 3) ^ ((k >> 2) & 3))); }
            const unsigned oUY = (unsigned)((16 * vb + ((lane & 31) >> 1)) * 32 + 16 * (lane & 1));
            const size_t oV = ((size_t)(lane >> 1) * 1024 + h * 64 + 16 * vb) * 2 + 16 * (lane & 1);
            const unsigned oG = (unsigned)(16 * (lane & 15));
            int pub = wave - 1; unsigned spins = 0;
            for (int c = wave - 1; c < 1024; c += CQ_NL) {
                const int s = c % CQ_NS;
                if (c >= CQ_NS) { while ((int)DONE[0] < c - CQ_NS + 1) { __builtin_amdgcn_s_sleep(1); if (++spins > (1u << 24)) break; } }
                LAS unsigned char* sl = ldsb + s * CQ_SLOT; const size_t ch = ch0 + c;
                const unsigned char* ar = ARo + ch * 4096; const unsigned char* bk = BKo + ch * 4096;
#pragma unroll
                for (int i = 0; i < 4; ++i) CQ_GLDS(ar + i * 1024 + oAR, sl + i * 1024);
#pragma unroll
                for (int i = 0; i < 4; ++i) CQ_GLDS(bk + oBK[i], sl + 4096 + i * 1024);
                CQ_GLDS((lane < 32 ? U0o : Y0o) + ch * 2048 + oUY, sl + 8192);
                CQ_GLDS(lane < 32 ? V + (row0 + 16 * (size_t)c) * 2048 + oV : GLo + ch * 256 + oG, sl + 9216);
                asm volatile("s_waitcnt vmcnt(10)" ::: "memory");
                for (; pub <= c - CQ_NL; pub += CQ_NL) FULL[pub % CQ_NS] = (unsigned)(pub + 1);
            }
            asm volatile("s_waitcnt vmcnt(0)" ::: "memory");
            for (; pub < 1024; pub += CQ_NL) FULL[pub % CQ_NS] = (unsigned)(pub + 1);
        } else {
            float* Y = a.out;
            const int fr = lane & 15, fq = lane >> 4; const int colv = h * 64 + 16 * vb + fr;
            f32x4 St[4];
#pragma unroll
            for (int kt = 0; kt < 4; ++kt) St[kt] = (f32x4){0.f, 0.f, 0.f, 0.f};
            unsigned spins = 0;
            CqOps oa, ob;
            while (FULL[0] != 1u) { if (++spins > (1u << 26)) break; }
            __builtin_amdgcn_fence(__ATOMIC_ACQUIRE, "workgroup");
            cq_load(oa, ldsb, fr, fq);
            __builtin_amdgcn_s_waitcnt(0xC07F);
            cq_unpack(oa);
            if (lane == 0) DONE[0] = 1u;
            const unsigned yvoff = (unsigned)((4 * fq * 1024 + colv) * 4);
            unsigned long long yc = (unsigned long long)(size_t)(Y + row0 * 1024);
            int sn = 1;
#ifdef PROBE_STAMP
            const unsigned long long pc0_ = __builtin_readcyclecounter(), pr0_ = __builtin_amdgcn_s_memrealtime();
#endif
            for (int c = 0; c < 1024; c += 2) {
                cq_step(oa, ob, St, ldsb, sn, c + 1, DONE, yc + 4096, yc + 12288, yvoff, fr, fq, false, spins);
                yc += 65536; sn = (sn + 1 == CQ_NS) ? 0 : sn + 1;
                const bool lastc = (c + 2 >= 1024);
                const int sn2 = lastc ? sn - 1 < 0 ? CQ_NS - 1 : sn - 1 : sn, cn2 = lastc ? 1023 : c + 2;
                cq_step(ob, oa, St, ldsb, sn2, cn2, DONE, yc + 4096, yc + 12288, yvoff, fr, fq, true, spins);
                yc += 65536; sn = (sn + 1 == CQ_NS) ? 0 : sn + 1;
            }
#ifdef PROBE_STAMP
            { const unsigned long long pc1_ = __builtin_readcyclecounter(), pr1_ = __builtin_amdgcn_s_memrealtime();
              if (lane == 0 && vcu == 5) *((volatile unsigned*)(ws + WS_CTL) + 24576 + 200 + li) = (unsigned)((pc1_ - pc0_) * 100ull / (pr1_ - pr0_)); }
            if (lane == 0) atomicAdd((unsigned*)(ws + WS_CTL) + 24576 + (vcu & 127), spins);
#endif
        }
    }
    if (PF_ON && vcu >= 128 && vcu < 256) {
        unsigned char* ws = a.ws; const int pv = vcu - 128; const int bh = pv >> 2, vb = pv & 3, b = bh >> 4, h = bh & 15; const size_t row0 = (size_t)b * T; const size_t ch0 = (size_t)bh * 1024;
        const unsigned char* ARo = ws + CS_AR; const unsigned char* BKo = ws + CS_BK; const unsigned char* Y0o = ws + CS_Y0; const unsigned char* GLo = ws + CS_GL; const unsigned char* U0o = ws + WS_U0;
        const unsigned char* V = ws + (li ? WS_V2 : WS_VF);
        unsigned x = 0u;
        for (int c0 = wave * 4; c0 < 1024; c0 += 32) {
            unsigned t[8];
#pragma unroll
            for (int j = 0; j < 4; ++j) { const int c = c0 + j; const size_t ch = ch0 + c;
                const unsigned char* p0 = lane < 32 ? ARo + ch * 4096 + lane * 128 : BKo + ch * 4096 + (lane - 32) * 128;
                const unsigned char* p1 = lane < 4 ? U0o + ch * 2048 + 512 * vb + lane * 128 : lane < 8 ? Y0o + ch * 2048 + 512 * vb + (lane - 4) * 128
                                        : lane < 24 ? V + ((row0 + 16 * (size_t)c + (lane - 8)) * 1024 + h * 64 + 16 * vb) * 2 : GLo + ch * 256 + (lane & 1) * 128;
                t[2 * j] = *(const volatile GAS unsigned*)p0; t[2 * j + 1] = *(const volatile GAS unsigned*)p1; }
#pragma unroll
            for (int j = 0; j < 8; ++j) x ^= t[j];
        }
        if (x == 0x9e3779b9u && li == 77) *(volatile GAS unsigned*)(ws + WS_CTL + 65536) = x;
    }
    __syncthreads();
}

typedef float f32x16 __attribute__((ext_vector_type(16)));
constexpr int AT_K = 0, AT_V = 36864;
__device__ __forceinline__ bf16x8_t tr_frag(unsigned addr) {
    v2u lo, hi; asm volatile("ds_read_b64_tr_b16 %0, %2\n\tds_read_b64_tr_b16 %1, %2 offset:1536\n\ts_waitcnt lgkmcnt(0)" : "=&v"(lo), "=&v"(hi) : "v"(addr) : "memory");
    v4u w; w.x = lo.x; w.y = lo.y; w.z = hi.x; w.w = hi.y; return __builtin_bit_cast(bf16x8_t, w);
}
__device__ __forceinline__ void attn_unit(const Args& a, int li, int au, LAS unsigned char* ldsb, int tid) {
    unsigned char* ws = a.ws; const bf16* Z = (const bf16*)(ws + WS_ACT); bf16* O = (bf16*)(ws + WS_O);
    const int n = au & 127, kvh = (au >> 7) & 3, b = au >> 9;
    const size_t rblk = (size_t)b * T + (size_t)n * 128;
    for (int e = tid; e < 256 * 8 * 2; e += NTHR) { const int which = e >> 11, rem = e & 2047, j = rem >> 3, c8 = rem & 7; const bool valid = (n > 0) || (j >= 128);
        v4u w = {0u, 0u, 0u, 0u}; if (valid) w = *(const GAS v4u*)(Z + (rblk + j - 128) * ZN + 1024 + which * 256 + kvh * 64 + 8 * c8);
        *(LAS v4u*)(ldsb + (which ? AT_V + j * 192 : AT_K + j * 144) + c8 * 16) = w; }
    __syncthreads();
    const int lane = tid & 63, wave = tid >> 6, l31 = lane & 31, h = lane >> 5;
    const unsigned ldsbase = (unsigned)(size_t)ldsb;
#pragma unroll 1
    for (int it = 0; it < 2; ++it) {
        const int tt = 2 * wave + it, g = tt >> 2, qi = tt & 3, hq = kvh * 4 + g; const size_t qrow = rblk + 32 * qi + l31;
        bf16x8_t qf[4];
#pragma unroll
        for (int ks = 0; ks < 4; ++ks) qf[ks] = *(const GAS bf16x8_t*)(Z + qrow * ZN + hq * 64 + 16 * ks + 8 * h);
        f32x16 st[5];
#pragma unroll
        for (int kt = 0; kt < 5; ++kt) {
#pragma unroll
            for (int r = 0; r < 16; ++r) st[kt][r] = 0.f;
#pragma unroll
            for (int ks = 0; ks < 4; ++ks) { const bf16x8_t kf = *(const LAS bf16x8_t*)(ldsb + AT_K + (32 * (qi + kt) + l31) * 144 + (16 * ks + 8 * h) * 2);
                st[kt] = __builtin_amdgcn_mfma_f32_32x32x16_bf16(kf, qf[ks], st[kt], 0, 0, 0); } }
        const float slope = exp2f(-0.5f * (float)(hq + 1)); const float sink = a.in[I_ESINK][li * 16 + hq];
        float mx = sink;
#pragma unroll
        for (int kt = 0; kt < 5; ++kt)
#pragma unroll
            for (int r = 0; r < 16; ++r) { const int j = 32 * (qi + kt) + (r & 3) + 8 * (r >> 2) + 4 * h; const int dist = 32 * qi + l31 + 128 - j;
                const bool ok = (dist >= 0) && (dist < 128) && ((n > 0) || (j >= 128));
                const float s = ok ? st[kt][r] * 0.125f - slope * (float)dist : -INFINITY; st[kt][r] = s; mx = fmaxf(mx, s); }
        mx = fmaxf(mx, __shfl_xor(mx, 32));
        float l = 0.f;
#pragma unroll
        for (int kt = 0; kt < 5; ++kt)
#pragma unroll
            for (int r = 0; r < 16; ++r) { const float p = __expf(st[kt][r] - mx); st[kt][r] = p; l += p; }
        l += __shfl_xor(l, 32); l += __expf(sink - mx);
        f32x16 ot[2];
#pragma unroll
        for (int r = 0; r < 16; ++r) { ot[0][r] = 0.f; ot[1][r] = 0.f; }
#pragma unroll
        for (int kt = 0; kt < 5; ++kt)
#pragma unroll
            for (int s2 = 0; s2 < 2; ++s2) {
                v4u pw; pw.x = pk2(st[kt][8 * s2 + 0], st[kt][8 * s2 + 1]); pw.y = pk2(st[kt][8 * s2 + 2], st[kt][8 * s2 + 3]); pw.z = pk2(st[kt][8 * s2 + 4], st[kt][8 * s2 + 5]); pw.w = pk2(st[kt][8 * s2 + 6], st[kt][8 * s2 + 7]);
                const bf16x8_t pf = __builtin_bit_cast(bf16x8_t, pw);
#pragma unroll
                for (int db = 0; db < 2; ++db) {
                    const unsigned va = ldsbase + AT_V + (unsigned)(32 * (qi + kt) + 16 * s2 + 4 * h + ((lane & 15) >> 2)) * 192u + (unsigned)(32 * db + 16 * ((lane >> 4) & 1) + 4 * (lane & 3)) * 2u;
                    const bf16x8_t vf = tr_frag(va);
                    ot[db] = __builtin_amdgcn_mfma_f32_32x32x16_bf16(vf, pf, ot[db], 0, 0, 0); } }
        const float inv = 1.0f / l;
#pragma unroll
        for (int db = 0; db < 2; ++db)
#pragma unroll
            for (int g4 = 0; g4 < 4; ++g4)
                *(GAS v2u*)(O + qrow * D + 1024 + hq * 64 + 32 * db + 8 * g4 + 4 * h) = pack4(ot[db][4 * g4] * inv, ot[db][4 * g4 + 1] * inv, ot[db][4 * g4 + 2] * inv, ot[db][4 * g4 + 3] * inv);
    }
    __syncthreads();
}

__device__ __forceinline__ void e3_phase(const Args& a, int li, int vcu, int G, int tid) {
    unsigned char* ws = a.ws; const float* Y = a.out;
    const bf16* R = (const bf16*)(ws + SC_R); const bf16* K2 = (const bf16*)(ws + SC_K2); const bf16* GG = (const bf16*)(ws + SC_GG); const bf16* V = (const bf16*)(ws + (li ? WS_V2 : WS_VF));
    bf16* O = (bf16*)(ws + WS_O);
    const float* rk = a.in[I_ERK] + li * 1024; const float* gng = a.in[I_EGNG] + li * 1024; const float* gnb = a.in[I_EGNB] + li * 1024;
    for (size_t e4 = (size_t)vcu * NTHR + tid; e4 < (size_t)M * 256; e4 += (size_t)G * NTHR) {
        const size_t row = e4 >> 8; const int c = (int)(e4 & 255) * 4; const size_t e = row * 1024 + c;
        const f32x4 y = *(const GAS f32x4*)(Y + e);
        const v2u rw = *(const GAS v2u*)(R + e), kw = *(const GAS v2u*)(K2 + e), vw = *(const GAS v2u*)(V + e), gw = *(const GAS v2u*)(GG + e);
        const f32x4 rkv = *(const f32x4*)(rk + c), ggv = *(const f32x4*)(gng + c), gbv = *(const f32x4*)(gnb + c);
        const float mean = row16_sum((y.x + y.y) + (y.z + y.w)) * (1.0f / 64.0f);
        const f32x4 d = y - mean;
        const float var = row16_sum((d.x * d.x + d.y * d.y) + (d.z * d.z + d.w * d.w)) * (1.0f / 64.0f);
        const float rs = rsqrtf(var + 64e-5f);
        const float r0 = bflo(rw.x), r1 = bfhi(rw.x), r2 = bflo(rw.y), r3 = bfhi(rw.y), k0 = bflo(kw.x), k1 = bfhi(kw.x), k2 = bflo(kw.y), k3 = bfhi(kw.y);
        const float bonus = row16_sum((r0 * k0 * rkv.x + r1 * k1 * rkv.y) + (r2 * k2 * rkv.z + r3 * k3 * rkv.w));
        const float o0 = (d.x * rs * ggv.x + gbv.x + bonus * bflo(vw.x)) * bflo(gw.x), o1 = (d.y * rs * ggv.y + gbv.y + bonus * bfhi(vw.x)) * bfhi(gw.x);
        const float o2 = (d.z * rs * ggv.z + gbv.z + bonus * bflo(vw.y)) * bflo(gw.y), o3 = (d.w * rs * ggv.w + gbv.w + bonus * bfhi(vw.y)) * bfhi(gw.y);
        *(GAS v2u*)(O + row * D + c) = pack4(o0, o1, o2, o3);
    }
}

constexpr int SG_W = 0, SG_V = 34816;
__device__ __forceinline__ unsigned sg_off(unsigned row, unsigned ch) { return 256u * row + 16u * (ch ^ (((row & 3u) << 2) | ((row >> 2) & 3u))); }
__device__ __forceinline__ bf16x8_t tr_frag2(unsigned a0, unsigned a1) {
    v2u lo, hi; asm volatile("ds_read_b64_tr_b16 %0, %2\n\tds_read_b64_tr_b16 %1, %3\n\ts_waitcnt lgkmcnt(0)" : "=&v"(lo), "=&v"(hi) : "v"(a0), "v"(a1) : "memory");
    v4u w; w.x = lo.x; w.y = lo.y; w.z = hi.x; w.w = hi.y; return __builtin_bit_cast(bf16x8_t, w);
}
__device__ __forceinline__ void sgu_phase(const Args& a, int li, LAS unsigned char* ldsb, int vcu, int G, int tid) {
    unsigned char* ws = a.ws; const bf16* Z = (const bf16*)(ws + WS_ACT); bf16* O = (bf16*)(ws + WS_O);
    const float* ssv = (const float*)(ws + WS_SS) + (size_t)(13 + li) * SS_REC;
    const bf16* WSB = (const bf16*)(ws + SM_WSB); const float* bs = a.in[I_OBS] + li * 16 * 128; const float* vng = a.in[I_OVNG] + li * D;
    const int lane = tid & 63, wave = tid >> 6, fr = lane & 15, fq = lane >> 4;
    const unsigned ldsbase = (unsigned)(size_t)ldsb;
    int gcur = -1;
    for (int u = vcu; u < 4096; u += G) {
        const int g = u & 15, bn = u >> 4; const size_t m0 = (size_t)bn * 128;
        __syncthreads();
        if (g != gcur) { gcur = g;
            for (int e = tid; e < 128 * 16; e += NTHR) { const int i = e >> 4, ch = e & 15; *(LAS v4u*)(ldsb + SG_W + i * 272 + ch * 16) = *(const GAS v4u*)(WSB + ((size_t)g * 128 + i) * 128 + 8 * ch); } }
        for (int e = tid; e < 128 * 16; e += NTHR) { const int j = e >> 4, ch = e & 15; const float rs = pg8::row_rs(ssv, (int)(m0 + j));
            const v4u w = *(const GAS v4u*)(Z + (m0 + j) * ZO + 2048 + g * 128 + 8 * ch); v4u o;
            o.x = pk2(bflo(w.x) * rs, bfhi(w.x) * rs); o.y = pk2(bflo(w.y) * rs, bfhi(w.y) * rs); o.z = pk2(bflo(w.z) * rs, bfhi(w.z) * rs); o.w = pk2(bflo(w.w) * rs, bfhi(w.w) * rs);
            *(LAS v4u*)(ldsb + SG_V + sg_off((unsigned)j, (unsigned)ch)) = o; }
        __syncthreads();
        bf16x8_t vf[4];
        { const unsigned q = (unsigned)(lane & 15) >> 2, p = (unsigned)lane & 3u;
#pragma unroll
          for (int ks = 0; ks < 4; ++ks) { const unsigned r0 = 32u * ks + 8u * fq + q;
              vf[ks] = tr_frag2(ldsbase + SG_V + sg_off(r0, 2u * wave + (p >> 1)) + 8u * (p & 1u), ldsbase + SG_V + sg_off(r0 + 4u, 2u * wave + (p >> 1)) + 8u * (p & 1u)); } }
        const int cc = g * 128 + 16 * wave + 4 * fq; const f32x4 vg = *(const f32x4*)(vng + cc);
#pragma unroll
        for (int mt = 0; mt < 8; ++mt) {
            f32x4 acc = {0.f, 0.f, 0.f, 0.f};
#pragma unroll
            for (int ks = 0; ks <= (mt >> 1); ++ks) { const bf16x8_t wf = *(const LAS bf16x8_t*)(ldsb + SG_W + (16 * mt + fr) * 272 + (32 * ks + 8 * fq) * 2);
                acc = __builtin_amdgcn_mfma_f32_16x16x32_bf16(vf[ks], wf, acc, 0, 0, 0); }
            const int i = 16 * mt + fr; const float bi = bs[g * 128 + i];
            const v2u uw = *(const GAS v2u*)(Z + (m0 + i) * ZO + cc);
            *(GAS v2u*)(O + (m0 + i) * D + cc) = pack4(bflo(uw.x) * (vg.x * acc[0] + bi), bfhi(uw.x) * (vg.y * acc[1] + bi), bflo(uw.y) * (vg.z * acc[2] + bi), bfhi(uw.y) * (vg.w * acc[3] + bi));
        }
    }
    __syncthreads();
}

__device__ __forceinline__ void final_phase(const Args& a, int vcu, int G, int wave, int lane) {
    const int gw = vcu * NWAVES + wave, NGW = G * NWAVES; const float* ss = (const float*)(a.ws + WS_SS) + (size_t)12 * SS_REC; const float* fg = a.in[I_FG]; const bf16* XBp = (const bf16*)(a.ws + WS_XB);
    for (int m = gw; m < M; m += NGW) { const float rs = pg8::row_rs(ss, m);
        const GAS v4u* xr = (const GAS v4u*)(XBp + (size_t)m * D) + lane; GAS f32x4* orow = (GAS f32x4*)(a.out + (size_t)m * D) + 2 * lane; const GAS f32x4* gr = (const GAS f32x4*)fg + 2 * lane;
#pragma unroll
        for (int j = 0; j < 4; ++j) { const v4u w = xr[64 * j]; const f32x4 g0 = gr[128 * j], g1 = gr[128 * j + 1];
            orow[128 * j] = (f32x4){bflo(w.x) * rs * g0.x, bfhi(w.x) * rs * g0.y, bflo(w.y) * rs * g0.z, bfhi(w.y) * rs * g0.w};
            orow[128 * j + 1] = (f32x4){bflo(w.z) * rs * g1.x, bfhi(w.z) * rs * g1.y, bflo(w.w) * rs * g1.z, bfhi(w.w) * rs * g1.w}; } }
}

__global__ void __launch_bounds__(NTHR, 2) mk_fwd(Args args) {
    extern __shared__ __attribute__((aligned(16))) unsigned char lds_raw[];
    LAS unsigned char* lds = (LAS unsigned char*)lds_raw;
    const int tid = threadIdx.x, lane = tid & 63, wave = __builtin_amdgcn_readfirstlane(tid >> 6);
    const int G = gridDim.x, bx = blockIdx.x; const int vcu = (G % 8 == 0) ? (bx % 8) * (G / 8) + bx / 8 : bx;
    unsigned char* ws = args.ws; gu32* ctl = (gu32*)(ws + WS_CTL);
    for (int u = tid; u < (LDS_BYTES - LDSCTL_OFF) / 4; u += NTHR) ((LAS unsigned*)(lds + LDSCTL_OFF))[u] = 0u;
    __syncthreads();
    const int lo = args.ph_lo, hi = args.ph_hi;
    const bool multi = (hi - lo) > 1;
    XcdBarrier bar; bar.bar = (unsigned*)(ctl + CW_BAR); bar.x = 0; bar.st = nullptr;
    if (multi) bar = xcd_barrier_post((unsigned*)(ctl + CW_BAR), (volatile LAS unsigned*)(lds + LDSCTL_OFF));
#define IN(k) (lo <= (k) && (k) < hi)
#ifdef PROBE_STAMP
#define SEAM(k) do { if ((k) + 1 < hi) { if (tid == 0) bar.st[4] = ((((k) & 7) == 2 && (((k) / 24) & 1)) ? 7u : (unsigned)((k) & 7)); xcd_barrier(bar); } } while (0)
#else
#define SEAM(k) do { if ((k) + 1 < hi) xcd_barrier(bar); } while (0)
#endif
#ifndef DUP_G
#define DUP_G 1
#endif
#ifndef DUP_T
#define DUP_T 1
#endif
#ifndef DUP_GR
#define DUP_GR DUP_G
#endif
#ifndef DUP_G1
#define DUP_G1 DUP_G
#endif
#ifndef DUP_SP
#define DUP_SP DUP_S
#endif
#ifndef DUP_SQ
#define DUP_SQ DUP_S
#endif
#ifndef DUP_PREP
#define DUP_PREP DUP_T
#endif
#ifndef DUP_E1
#define DUP_E1 DUP_T
#endif
#ifndef DUP_SGU
#define DUP_SGU DUP_T
#endif
#ifndef DUP_E3
#define DUP_E3 DUP_T
#endif
#define REPN(n) for (int rep_ = 0; rep_ < (n); ++rep_)
#ifndef DUP_S
#define DUP_S 1
#endif
#define REPG for (int rep_ = 0; rep_ < DUP_G; ++rep_)
#define REPT for (int rep_ = 0; rep_ < DUP_T; ++rep_)
#define REPS for (int rep_ = 0; rep_ < DUP_S; ++rep_)
#define RSEAM(n) do { if (rep_ + 1 < (n)) xcd_barrier(bar); } while (0)
    float* ssb = (float*)(ws + WS_SS);
    bf16* XB = (bf16*)(ws + WS_XB); bf16* ACT = (bf16*)(ws + WS_ACT); bf16* OB = (bf16*)(ws + WS_O);

    for (int s = 0; s < NSUB; ++s) {
        const int pb = s * 8, L = s / 3, kind = s % 3, li = L >> 1; const bool even = !(L & 1);
        #ifndef NO_PREP
        if (kind == 0 && IN(pb + 0) && !(args.dbl && (L & 1))) { REPN(DUP_PREP) { const int t_ = opaque(tid); prep_phase(args, L, lds, vcu, G, __builtin_amdgcn_readfirstlane(t_ >> 6), t_ & 63, (L & 1) ? 2 : 0); RSEAM(DUP_PREP); } SEAM(pb + 0); }
#endif
        if (IN(pb + 1)) {
            const float* ss = ssb + (size_t)s * SS_REC;
            LAS float* RC = (LAS float*)(lds + 135168);
            if (tid == 0) *(LAS int*)(RC + 256) = -1;
            __syncthreads();
            if (kind != 1) {
                pg8::Gemm g{XB, (const bf16*)(ws + (kind == 0 ? WT_GU1 : (args.dbl && (L & 1)) ? WT2_GU2 : WT_GU2)), M, 2 * FF, D}; pg8::StaticOrder S; S.init(M, 2 * FF, G, bx);
                pg8::EpiSwiGLU E{ACT, FF, ss, RC};
#ifndef NO_G1
                REPN(DUP_G1) { pg8::gemm_phase<pg8::EpiSwiGLU, pg8::StaticOrder, true, true>(lds, g, S, E); RSEAM(DUP_G1); }
#endif
            } else if (even) {
                pg8::Gemm g{XB, (const bf16*)(ws + WT_IN), M, ZN, D}; pg8::StaticOrder S; S.init(M, ZN, G, bx);
                pg8::EpiZ E{ACT, ZN, ss, args.in[I_EBQKV] + li * 1536, RC};
#ifndef NO_GZ
                REPG { pg8::gemm_phase<pg8::EpiZ, pg8::StaticOrder, true, true>(lds, g, S, E); RSEAM(DUP_G); }
#endif
            } else {
                pg8::Gemm g{XB, (const bf16*)(ws + WT_IN), M, ZO, D}; pg8::StaticOrder S; S.init(M, ZO, G, bx);
                pg8::EpiGeluV E{ACT, ZO, ss, ssb + (size_t)(13 + li) * SS_REC, (LAS float*)(lds + 131072), RC};
#ifndef NO_GG
                REPG { pg8::gemm_phase<pg8::EpiGeluV, pg8::StaticOrder, true, true>(lds, g, S, E); RSEAM(DUP_G); }
#endif
            }
            SEAM(pb + 1);
        }
        if (kind == 1) {
            if (IN(pb + 2)) {
#ifndef NO_E1
                if (even) REPN(DUP_E1) { e1_phase(args, li, lds, vcu, G, opaque(tid)); RSEAM(DUP_E1); }
#endif
#ifndef NO_ATTN
                if (even) for (int au = vcu; au < 1024; au += G) attn_unit(args, li, au, lds, opaque(tid));
#endif
#ifndef NO_SGU
                if (!even) REPN(DUP_SGU) { sgu_phase(args, li, lds, vcu, G, opaque(tid)); RSEAM(DUP_SGU); }
#endif
                SEAM(pb + 2); }
#ifndef NO_SPRE
            if (even && IN(pb + 3)) { REPN(DUP_SP) { scanpre_phase(args, li, lds, vcu, G, opaque(tid)); RSEAM(DUP_SP); } SEAM(pb + 3); }
#endif
#ifndef NO_SSEQ
            if (even && IN(pb + 4)) { const int scu = (G == 256) ? (bx & 7) * 16 + (bx >> 3) + ((bx >> 3) < 16 ? 0 : 128 - 16) : vcu;
                REPN(DUP_SQ) { scanseq_phase(args, li, lds, scu, opaque(tid)); RSEAM(DUP_SQ); }
                if (scu >= 128) { const int t_ = opaque(tid); prep_phase(args, L + 1, lds, scu - 128, G - 128, __builtin_amdgcn_readfirstlane(t_ >> 6), t_ & 63, args.dbl ? 0 : 1); }
                SEAM(pb + 4); }
#endif
#ifndef NO_E3
            if (even && IN(pb + 5)) { REPN(DUP_E3) { e3_phase(args, li, vcu, G, opaque(tid)); RSEAM(DUP_E3); } SEAM(pb + 5); }
#endif
        }
        if (IN(pb + 6)) {
            const bf16* A = (kind == 1) ? OB : ACT; const int K = (kind == 1) ? D : FF;
            const bool odd2 = args.dbl && (L & 1); const bf16* Bt = (const bf16*)(ws + (kind == 0 ? WT_D1 : kind == 1 ? (odd2 ? WT2_OUT : WT_OUT) : (odd2 ? WT2_D2 : WT_D2)));
            pg8::Gemm g{A, Bt, M, D, K, kind == 1 ? 0 : 1}; pg8::StaticOrder S; S.init(M, D, G, bx);
            pg8::EpiResid E{XB, ssb + (size_t)(s + 1) * SS_REC, kind == 1 ? 1.0f : 0.5f, (LAS float*)(lds + 131072)};
#ifndef NO_GR
            REPN(DUP_GR) { if (rep_) { E.scale = 0.f;
#ifdef PROBE_NOEPI
                E.noop = 1;
#endif
                } pg8::gemm_phase<pg8::EpiResid, pg8::StaticOrder, true, true>(lds, g, S, E); RSEAM(DUP_GR); }
#endif
            SEAM(pb + 6);
        }
    }
    if (IN(NSUB * 8)) { const int t_ = opaque(tid); final_phase(args, vcu, G, __builtin_amdgcn_readfirstlane(t_ >> 6), t_ & 63); }
#ifdef PROBE_STAMP
    if (multi) {
        if (tid == 0) { for (int c = 0; c < 8; ++c) __hip_atomic_store((unsigned*)(ctl + 16384 + bx * 8 + c), bar.st[8 + c], __ATOMIC_RELAXED, __HIP_MEMORY_SCOPE_AGENT); __hip_atomic_store((unsigned*)(ctl + 20480 + bx), bar.x, __ATOMIC_RELAXED, __HIP_MEMORY_SCOPE_AGENT); bar.st[4] = 0u; }
        xcd_barrier(bar);
        if (bx == 0 && tid == 0) {
            unsigned long long sum = 0ull; unsigned mn = 0xffffffffu, mx = 0u;
            unsigned ncnt = 0u;
            for (int j = 0; j < G; ++j) { unsigned v = 0u; if (PROBE_SEL && (j >> 3) >= 16) continue; ++ncnt;
                for (int c = 0; c < 8; ++c) if ((PROBE_MASK >> c) & 1) v += __hip_atomic_load((unsigned*)(ctl + 16384 + j * 8 + c), __ATOMIC_RELAXED, __HIP_MEMORY_SCOPE_AGENT);
                sum += v; mn = v < mn ? v : mn; mx = v > mx ? v : mx; }
            unsigned long long stat = PROBE_STAT == 0 ? sum / ncnt : PROBE_STAT == 1 ? mn : mx;
            if (PROBE_STAT == 5) { unsigned long long sp_ = 0ull; for (int j = 0; j < 128; ++j) sp_ += __hip_atomic_load((unsigned*)(ctl + 24576 + j), __ATOMIC_RELAXED, __HIP_MEMORY_SCOPE_AGENT); stat = sp_ / 128ull * 100ull / PROBE_SCALE; }
            else if (PROBE_STAT == 8) { unsigned d_ = 0u; for (int c = 0; c < 4; ++c) if ((PROBE_MASK >> c) & 1) d_ += bar.st[24 + c]; stat = d_; }
            else if (PROBE_STAT == 7) { unsigned d_ = 0u; for (int c = 0; c < 8; ++c) if ((PROBE_MASK >> c) & 1) d_ += bar.st[16 + c]; stat = d_; }
            else if (PROBE_STAT == 6) stat = (unsigned long long)__hip_atomic_load((unsigned*)(ctl + 24576 + 200), __ATOMIC_RELAXED, __HIP_MEMORY_SCOPE_AGENT) * 100ull / PROBE_SCALE;
            else if (PROBE_STAT >= 3) {
                unsigned xmn = 0xffffffffu, xmx = 0u, wsum = 0u, nx_ = 0u;
                for (unsigned x = 0; x < 16; ++x) { unsigned s_ = 0u, n_ = 0u, a_ = 0xffffffffu, b_ = 0u;
                    for (int j = 0; j < G; ++j) { if (__hip_atomic_load((unsigned*)(ctl + 20480 + j), __ATOMIC_RELAXED, __HIP_MEMORY_SCOPE_AGENT) != x) continue; if (PROBE_SEL && (j >> 3) >= 16) continue; unsigned v = 0u;
                        for (int c = 0; c < 8; ++c) if ((PROBE_MASK >> c) & 1) v += __hip_atomic_load((unsigned*)(ctl + 16384 + j * 8 + c), __ATOMIC_RELAXED, __HIP_MEMORY_SCOPE_AGENT);
                        s_ += v; ++n_; a_ = v < a_ ? v : a_; b_ = v > b_ ? v : b_; }
                    if (n_) { const unsigned m_ = s_ / n_; xmn = m_ < xmn ? m_ : xmn; xmx = m_ > xmx ? m_ : xmx; wsum += b_ - a_; ++nx_; } }
                stat = PROBE_STAT == 3 ? (xmx - xmn) : wsum / (nx_ ? nx_ : 1u);
            }
            const unsigned long long ts = __builtin_amdgcn_s_memrealtime();
            while (__builtin_amdgcn_s_memrealtime() - ts < stat * PROBE_SCALE) __builtin_amdgcn_s_sleep(8);
        }
    }
#endif
#undef IN
#undef SEAM
}

extern "C" void kernel_launch(void* const* d_in, const int* in_sizes, int n_in, void* d_out, int out_size, void* d_ws, size_t ws_size, hipStream_t stream) {
    static int grid = 0;
    if (grid == 0) {
        if (n_in != 29 || out_size != M * D || ws_size < WS_END) { fprintf(stderr, "kernel_launch: unexpected shapes (n_in %d, out %d, ws %zu < %zu); nothing launched\n", n_in, out_size, ws_size, (size_t)WS_END); grid = -1; return; }
        int dev = 0, cus = 0;
        if (hipGetDevice(&dev) != hipSuccess || hipDeviceGetAttribute(&cus, hipDeviceAttributeMultiprocessorCount, dev) != hipSuccess) { grid = -1; return; }
        if (hipFuncSetAttribute((const void*)mk_fwd, hipFuncAttributeMaxDynamicSharedMemorySize, LDS_BYTES) != hipSuccess) { fprintf(stderr, "kernel_launch: hipFuncSetAttribute failed\n"); grid = -1; return; }
        int per_cu = 0;
        if (hipOccupancyMaxActiveBlocksPerMultiprocessor(&per_cu, (const void*)mk_fwd, NTHR, LDS_BYTES) != hipSuccess || per_cu < 1) fprintf(stderr, "kernel_launch: occupancy query says %d\n", per_cu);
        (void)hipGetLastError();
        grid = cus;
    }
    if (grid < 0) return;
    (void)hipMemsetAsync((char*)d_ws + WS_CTL, 0, CTL_ZERO_BYTES, stream);
    Args a{};
    for (int i = 0; i < 29; ++i) a.in[i] = (const float*)d_in[i];
    a.out = (float*)d_out; a.ws = (unsigned char*)d_ws; a.dbl = (ws_size >= WS_END2) ? 1 : 0; a.pad_ = 0;
#if MK_ONE_LAUNCH
    a.ph_lo = 0; a.ph_hi = NSUB * 8 + 1;
    hipLaunchKernelGGL(mk_fwd, dim3(grid), dim3(NTHR), LDS_BYTES, stream, a);
#else
    for (int s = 0; s <= NSUB; ++s) {
        for (int k = 0; k < (s == NSUB ? 1 : 8); ++k) {
            const int L = s / 3, kind = s % 3; const bool even = !(L & 1);
            bool live;
            if (s == NSUB) live = true;
            else if (k == 0) live = (kind == 0);
            else if (k == 1 || k == 6) live = true;
            else if (k == 2) live = (kind == 1);
            else if (k == 3 || k == 4 || k == 5) live = (kind == 1) && even;
            else live = false;
            if (!live) continue;
            a.ph_lo = s * 8 + k; a.ph_hi = a.ph_lo + 1;
            hipLaunchKernelGGL(mk_fwd, dim3(grid), dim3(NTHR), LDS_BYTES, stream, a);
        }
    }
#endif
}
```

```cpp
#include <hip/hip_runtime.h>
#include <cstdio>
#include <cstdint>
#define MK_ONE_LAUNCH 1
namespace pg8 {
#define PG8_LAS __attribute__((address_space(3)))
typedef unsigned short bf16_t;
typedef short bf16x8 __attribute__((ext_vector_type(8)));
typedef float f32x4 __attribute__((ext_vector_type(4)));
typedef unsigned u32x4 __attribute__((ext_vector_type(4)));
constexpr int BM = 256, BK = 64, HALF = 128, HTB = HALF * BK * 2  , STAGE_BYTES = 8 * HTB, NXCD = 8, WGM = 8;

__host__ __device__ __forceinline__ int lds_byte(int r, int c) { const int st = (r >> 4) * 2 + (c >> 5), rr = r & 15, cc = c & 31, ob = rr * 64 + cc * 2; return st * 1024 + (ob ^ (((ob >> 9) & 1) << 5)); }
__host__ __device__ __forceinline__ void stage_rc(int b, int& R, int& C) { const int st = b / 1024, sb = b % 1024, swz = sb ^ (((sb >> 9) & 1) << 5); R = (st >> 1) * 16 + swz / 64; C = (st & 1) * 32 + (swz % 64) / 2; }
__host__ __device__ __forceinline__ int perm32(int rho) { const int n = rho >> 4, i = rho & 15; return 8 * (i >> 2) + 4 * n + (i & 3); }

struct Unit { int pm, pn; };
struct Gemm { const bf16_t* A; const bf16_t* Bt; int M, N, K; int amode = 0; };

struct StaticOrder {
    int nM, nN, nwg, G, c;
    __host__ __device__ void init(int M, int N, int G_, int c_) { nM = M / BM; nN = N / BM; nwg = nM * nN; G = G_; c = c_; }
    __host__ __device__ bool next(int i, Unit& u) const {
        const long L = (long)i * G + c; if (L >= nwg) return false;
        int wgid = (int)L; { const int q = nwg / NXCD, r = nwg % NXCD, xcd = wgid % NXCD, off = wgid / NXCD; wgid = (xcd < r ? xcd * (q + 1) : r * (q + 1) + (xcd - r) * q) + off; }
        const int nig = WGM * nN, gid = wgid / nig, fm = gid * WGM, gsz = (nM - fm) < WGM ? (nM - fm) : WGM;
        u.pm = fm + ((wgid % nig) % gsz); u.pn = (wgid % nig) / gsz; return true;
    }
    __device__ __forceinline__ void a_ready(const Unit&) const {}
    __device__ __forceinline__ void done(const Unit&) const {}
};
__device__ __forceinline__ unsigned cvt_pk_bf16(float lo, float hi) { unsigned r; asm volatile("v_cvt_pk_bf16_f32 %0, %1, %2" : "=v"(r) : "v"(lo), "v"(hi)); return r; }
typedef float f32x2 __attribute__((ext_vector_type(2)));
__device__ __forceinline__ f32x2 gelu_pk(f32x2 v) {
    const f32x2 av = __builtin_elementwise_abs(v), d = av * 0.2316418882f + 1.0f;
    f32x2 t; t.x = __builtin_amdgcn_rcpf(d.x); t.y = __builtin_amdgcn_rcpf(d.y);
    f32x2 q = t * 0.5307027145f + (-0.7265760135f); q = q * t + 0.7107068705f; q = q * t + (-0.142248368f); q = q * t + 0.127414796f; q = q * t;
    const f32x2 s = (v * v) * (-0.72134752044f);
    f32x2 e; e.x = __builtin_amdgcn_exp2f(s.x); e.y = __builtin_amdgcn_exp2f(s.y);
    const f32x2 m = v * (q * e), r = v - m;
    f32x2 o; o.x = v.x < 0.f ? m.x : r.x; o.y = v.y < 0.f ? m.y : r.y; return o;
}

typedef __bf16 bf16x2_e __attribute__((ext_vector_type(2)));
constexpr int SS_M = 32768;
__device__ __forceinline__ float row_rs(const float* P, int row) {
    const float s = ((P[row] + P[SS_M + row]) + (P[2 * SS_M + row] + P[3 * SS_M + row])) + ((P[4 * SS_M + row] + P[5 * SS_M + row]) + (P[6 * SS_M + row] + P[7 * SS_M + row]));
    return rsqrtf(s * (1.0f / 2048.0f) + 1e-6f);
}
__device__ __forceinline__ void panel_rs(const float* ss, PG8_LAS float* rc, int pm, int t) {
    PG8_LAS int* tag = (PG8_LAS int*)(rc + BM);
    const int have = *tag;
    if (have != pm && t < BM) rc[t] = row_rs(ss, pm * BM + t);
    asm volatile("s_waitcnt lgkmcnt(0)" ::: "memory"); __builtin_amdgcn_s_barrier(); asm volatile("" ::: "memory");
    if (have != pm && t == 0) *tag = pm;
}
struct EpiSwiGLU {
    static constexpr int PID = 0;
    static constexpr bool PERM = true, AFTER_DRAIN = false;
    bf16_t* O; int ldc; const float* ss; PG8_LAS float* rc;
    __device__ __forceinline__ void operator()(const f32x4 (&acc)[2][2][4][2], const Unit& u, int wr, int wc, int fr, int fq) const {
        const int row0 = u.pm * BM + wr * 64 + fr, col0 = u.pn * HALF + wc * 32 + 8 * fq;
        panel_rs(ss, rc, u.pm, (wr * 4 + wc) * 64 + fq * 16 + fr);
#pragma unroll
        for (int ai = 0; ai < 2; ++ai)
#pragma unroll
            for (int m = 0; m < 4; ++m) {
                const int row = row0 + ai * HALF + m * 16;
                const float rs = rc[row - u.pm * BM], nrl = rs * -1.44269504089f, rs2 = rs * rs;
                float o[8];
#pragma unroll
                for (int n = 0; n < 2; ++n)
#pragma unroll
                    for (int j = 0; j < 4; ++j) { const float ag = acc[ai][0][m][n][j], au = acc[ai][1][m][n][j]; o[4 * n + j] = (ag * au) * (rs2 * __builtin_amdgcn_rcpf(1.0f + __builtin_amdgcn_exp2f(ag * nrl))); }
                u32x4 w; w.x = cvt_pk_bf16(o[0], o[1]); w.y = cvt_pk_bf16(o[2], o[3]); w.z = cvt_pk_bf16(o[4], o[5]); w.w = cvt_pk_bf16(o[6], o[7]);
                *(u32x4*)(O + ((size_t)(u.pm * (ldc >> 6) + (col0 >> 6)) * BM + (row - u.pm * BM)) * BK + (col0 & 63)) = w;
                asm volatile("" ::: "memory");
            }
    }
};
struct EpiResid {
    static constexpr int PID = 3;
    static constexpr bool PERM = true, AFTER_DRAIN = false;
    bf16_t* xb; float* ssn; float scale; PG8_LAS float* sp;
    int noop = 0;
    __device__ __forceinline__ void operator()(const f32x4 (&acc)[2][2][4][2], const Unit& u, int wr, int wc, int fr, int fq) const {
        const int row0 = u.pm * BM + wr * 64 + fr, col0 = u.pn * BM + wc * 32 + 8 * fq;
        if (noop) return;
        u32x4 bx[8][2];
#pragma unroll
        for (int gi = 0; gi < 8; ++gi)
#pragma unroll
            for (int bj = 0; bj < 2; ++bj) bx[gi][bj] = *(const u32x4*)(xb + (size_t)(row0 + (gi >> 2) * HALF + (gi & 3) * 16) * 2048 + col0 + bj * HALF);
        asm volatile("" ::: "memory");
#pragma unroll
        for (int gi = 0; gi < 8; ++gi) {
            const int ai = gi >> 2, m = gi & 3;
            const int row = row0 + ai * HALF + m * 16; const size_t off = (size_t)row * 2048 + col0; float s = 0.f;
            u32x4 bc[2]; bc[0] = bx[gi][0]; bc[1] = bx[gi][1];
#pragma unroll
            for (int bj = 0; bj < 2; ++bj) {
                const f32x4 a0 = acc[ai][bj][m][0] * scale, a1 = acc[ai][bj][m][1] * scale; const u32x4 b = bc[bj]; u32x4 w;
                w.x = cvt_pk_bf16(__uint_as_float(b.x << 16) + a0[0], __uint_as_float(b.x & 0xffff0000u) + a0[1]);
                w.y = cvt_pk_bf16(__uint_as_float(b.y << 16) + a0[2], __uint_as_float(b.y & 0xffff0000u) + a0[3]);
                w.z = cvt_pk_bf16(__uint_as_float(b.z << 16) + a1[0], __uint_as_float(b.z & 0xffff0000u) + a1[1]);
                w.w = cvt_pk_bf16(__uint_as_float(b.w << 16) + a1[2], __uint_as_float(b.w & 0xffff0000u) + a1[3]);
                *(u32x4*)(xb + off + bj * HALF) = w;
                const float r0 = __uint_as_float(w.x << 16), r1 = __uint_as_float(w.x & 0xffff0000u), r2 = __uint_as_float(w.y << 16), r3 = __uint_as_float(w.y & 0xffff0000u);
                const float r4 = __uint_as_float(w.z << 16), r5 = __uint_as_float(w.z & 0xffff0000u), r6 = __uint_as_float(w.w << 16), r7 = __uint_as_float(w.w & 0xffff0000u);
                s += ((r0 * r0 + r1 * r1) + (r2 * r2 + r3 * r3)) + ((r4 * r4 + r5 * r5) + (r6 * r6 + r7 * r7));
            }
            s += __shfl_xor(s, 16); s += __shfl_xor(s, 32);
            if (fq == 0) sp[(ai * HALF + wr * 64 + m * 16 + fr) * 4 + wc] = s;
            asm volatile("" ::: "memory");
        }
        asm volatile("s_waitcnt lgkmcnt(0)" ::: "memory"); __builtin_amdgcn_s_barrier(); asm volatile("" ::: "memory");
        const int t = (wr * 4 + wc) * 64 + fq * 16 + fr;
        if (t < BM) { const f32x4 p = *(const PG8_LAS f32x4*)(sp + t * 4); ssn[(size_t)u.pn * SS_M + u.pm * BM + t] = (p[0] + p[1]) + (p[2] + p[3]); }
    }
};
struct EpiZ {
    static constexpr int PID = 1;
    static constexpr bool PERM = true, AFTER_DRAIN = false;
    bf16_t* O; int ldc; const float* ss; const float* bias; PG8_LAS float* rc;
    __device__ __forceinline__ void operator()(const f32x4 (&acc)[2][2][4][2], const Unit& u, int wr, int wc, int fr, int fq) const {
        const int row0 = u.pm * BM + wr * 64 + fr, col0 = u.pn * BM + wc * 32 + 8 * fq;
        panel_rs(ss, rc, u.pm, (wr * 4 + wc) * 64 + fq * 16 + fr);
        const bool hb = u.pn < 6;
        f32x4 bv[2][2];
#pragma unroll
        for (int bj = 0; bj < 2; ++bj)
#pragma unroll
            for (int n = 0; n < 2; ++n) bv[bj][n] = hb ? *(const f32x4*)(bias + col0 + bj * HALF + 4 * n) : (f32x4){0.f, 0.f, 0.f, 0.f};
#pragma unroll
        for (int ai = 0; ai < 2; ++ai)
#pragma unroll
            for (int m = 0; m < 4; ++m) {
                const int row = row0 + ai * HALF + m * 16;
                const float rs = rc[row - u.pm * BM];
                bf16_t* rowp = O + (size_t)row * ldc + col0;
#pragma unroll
                for (int bj = 0; bj < 2; ++bj) {
                    const f32x4 v0 = acc[ai][bj][m][0] * rs + bv[bj][0], v1 = acc[ai][bj][m][1] * rs + bv[bj][1];
                    u32x4 w; w.x = cvt_pk_bf16(v0[0], v0[1]); w.y = cvt_pk_bf16(v0[2], v0[3]); w.z = cvt_pk_bf16(v1[0], v1[1]); w.w = cvt_pk_bf16(v1[2], v1[3]);
                    *(u32x4*)(rowp + bj * HALF) = w;
                }
                asm volatile("" ::: "memory");
            }
    }
};
struct EpiGeluV {
    static constexpr int PID = 2;
    static constexpr bool PERM = true, AFTER_DRAIN = false;
    bf16_t* O; int ldc; const float* ss; float* ssv; PG8_LAS float* sp; PG8_LAS float* rc;
    __device__ __forceinline__ void operator()(const f32x4 (&acc)[2][2][4][2], const Unit& u, int wr, int wc, int fr, int fq) const {
        const int row0 = u.pm * BM + wr * 64 + fr, col0 = u.pn * BM + wc * 32 + 8 * fq;
        panel_rs(ss, rc, u.pm, (wr * 4 + wc) * 64 + fq * 16 + fr);
        const bool isv = u.pn >= 8;
#pragma unroll
        for (int ai = 0; ai < 2; ++ai)
#pragma unroll
            for (int m = 0; m < 4; ++m) {
                const int row = row0 + ai * HALF + m * 16;
                const float rs = rc[row - u.pm * BM];
                bf16_t* rowp = O + (size_t)row * ldc + col0; float s = 0.f;
#pragma unroll
                for (int bj = 0; bj < 2; ++bj) {
                    f32x4 v0 = acc[ai][bj][m][0] * rs, v1 = acc[ai][bj][m][1] * rs;
                    const f32x2 a = gelu_pk((f32x2){v0[0], v0[1]}), b = gelu_pk((f32x2){v0[2], v0[3]}), c = gelu_pk((f32x2){v1[0], v1[1]}), d = gelu_pk((f32x2){v1[2], v1[3]});
                    s += (a.x * a.x + a.y * a.y) + (b.x * b.x + b.y * b.y) + (c.x * c.x + c.y * c.y) + (d.x * d.x + d.y * d.y);
                    u32x4 w; w.x = cvt_pk_bf16(a.x, a.y); w.y = cvt_pk_bf16(b.x, b.y); w.z = cvt_pk_bf16(c.x, c.y); w.w = cvt_pk_bf16(d.x, d.y);
                    *(u32x4*)(rowp + bj * HALF) = w;
                }
                if (isv) { s += __shfl_xor(s, 16); s += __shfl_xor(s, 32); if (fq == 0) sp[(ai * HALF + wr * 64 + m * 16 + fr) * 4 + wc] = s; }
                asm volatile("" ::: "memory");
            }
        if (isv) {
            asm volatile("s_waitcnt lgkmcnt(0)" ::: "memory"); __builtin_amdgcn_s_barrier(); asm volatile("" ::: "memory");
            const int t = (wr * 4 + wc) * 64 + fq * 16 + fr;
            if (t < BM) { const f32x4 p = *(const PG8_LAS f32x4*)(sp + t * 4); ssv[(size_t)(u.pn - 8) * SS_M + u.pm * BM + t] = (p[0] + p[1]) + (p[2] + p[3]); }
        }
    }
};
template <class Epi, class Sched, bool ALIGN_EPI = false, bool SP2 = false>
__device__ __forceinline__ void gemm_phase(PG8_LAS unsigned char* lds, const Gemm g, const Sched& S, const Epi& E) {
    int tid_ = threadIdx.x; asm volatile("" : "+v"(tid_));
    const int tid = tid_, wid = __builtin_amdgcn_readfirstlane(tid >> 6), lane = tid & 63, wr = wid >> 2, wc = wid & 3, fr = lane & 15, fq = lane >> 4;
    const int K = g.K, nt = K / BK;
    unsigned voffA[2], voffB[2];
#pragma unroll
    for (int i = 0; i < 2; ++i) { int R, C; stage_rc(tid * 16 + i * 8192, R, C); const int Rb = Epi::PERM ? ((R & ~31) + perm32(R & 31)) : R;
        voffA[i] = g.amode ? (unsigned)(R * BK + C) * 2u : (unsigned)(R * K + C) * 2u; voffB[i] = (unsigned)(Rb * K + C) * 2u; }
    const size_t kstep = (size_t)(BK * 2);
    const size_t hstep = (size_t)HALF * K * 2;
    const size_t tstep = 2 * hstep;
    const size_t kstepA = g.amode ? (size_t)(BM * BK * 2) : kstep, hstepA = g.amode ? (size_t)(HALF * BK * 2) : hstep, tstepA = g.amode ? (size_t)(K / BK) * (BM * BK * 2) : tstep;
    const unsigned ldsw = (unsigned)wid * 1024u;
    const int aoff = lds_byte(wr * 64 + fr, fq * 8), boff = lds_byte(wc * 32 + fr, fq * 8);
#define PG8_SA(b, h) (((b) * 2 + (h)) * HTB)
#define PG8_SB(b, h) ((4 + (b) * 2 + (h)) * HTB)
#define PG8_STAGE(bufoff, gbase, voff) do { _Pragma("unroll") for (int _i = 0; _i < 2; ++_i) \
        __builtin_amdgcn_global_load_lds((const unsigned*)((const char*)(gbase) + (voff)[_i]), (PG8_LAS unsigned*)(lds + (bufoff) + ldsw + _i * 8192), 16, 0, 0); } while (0)
#define PG8_LDA(dst, b, h) do { _Pragma("unroll") for (int m = 0; m < 4; ++m) _Pragma("unroll") for (int k = 0; k < 2; ++k) dst[m][k] = *(const PG8_LAS bf16x8*)(lds + PG8_SA(b, h) + aoff + m * 2048 + k * 1024); } while (0)
#define PG8_LDB(dst, b, h) do { _Pragma("unroll") for (int n = 0; n < 2; ++n) _Pragma("unroll") for (int k = 0; k < 2; ++k) dst[n][k] = *(const PG8_LAS bf16x8*)(lds + PG8_SB(b, h) + boff + n * 2048 + k * 1024); } while (0)
#define PG8_MMA(ai, bj, At, Bt) do { __builtin_amdgcn_s_setprio(1); _Pragma("unroll") for (int m = 0; m < 4; ++m) _Pragma("unroll") for (int n = 0; n < 2; ++n) _Pragma("unroll") for (int k = 0; k < 2; ++k) \
        acc[ai][bj][m][n] = __builtin_amdgcn_mfma_f32_16x16x32_bf16(Bt[n][k], At[m][k], acc[ai][bj][m][n], 0, 0, 0); __builtin_amdgcn_s_setprio(0); } while (0)
#define PG8_WAIT_V(n) asm volatile("s_waitcnt vmcnt(" #n ")" ::: "memory")
#define PG8_WAIT_L(n) asm volatile("s_waitcnt lgkmcnt(" #n ")" ::: "memory")
#define PG8_BAR __builtin_amdgcn_s_barrier()
#define PG8_SCHED __builtin_amdgcn_sched_barrier(0)
    Unit cur, nxt; int ui = 0;
    if (!S.next(0, cur)) return;
    f32x4 acc[2][2][4][2];
#pragma unroll
    for (int a = 0; a < 2; ++a)
#pragma unroll
        for (int b = 0; b < 2; ++b)
#pragma unroll
            for (int m = 0; m < 4; ++m)
#pragma unroll
                for (int n = 0; n < 2; ++n) acc[a][b][m][n] = (f32x4){0.f, 0.f, 0.f, 0.f};
    bf16x8 At[4][2], B0[2][2], B1[2][2];
    const char* cA = (const char*)g.A + (size_t)cur.pm * tstepA; const char* cB = (const char*)g.Bt + (size_t)cur.pn * tstep;
    S.a_ready(cur);
    if constexpr (SP2) {
        PG8_STAGE(PG8_SB(0, 0), cB, voffB); PG8_STAGE(PG8_SB(0, 1), cB + hstep, voffB); PG8_STAGE(PG8_SA(0, 0), cA, voffA); PG8_STAGE(PG8_SA(0, 1), cA + hstepA, voffA);
        if (wr == 1) PG8_BAR;
        PG8_WAIT_V(2); PG8_BAR;
        PG8_STAGE(PG8_SB(1, 0), cB + kstep, voffB); PG8_STAGE(PG8_SA(1, 0), cA + kstepA, voffA); PG8_STAGE(PG8_SB(1, 1), cB + hstep + kstep, voffB);
        PG8_WAIT_V(6); PG8_BAR;
    } else {
        PG8_STAGE(PG8_SB(0, 0), cB, voffB); PG8_STAGE(PG8_SA(0, 0), cA, voffA); PG8_STAGE(PG8_SB(0, 1), cB + hstep, voffB); PG8_STAGE(PG8_SA(0, 1), cA + hstepA, voffA);
        if (wr == 1) PG8_BAR;
        PG8_WAIT_V(4); PG8_BAR;
        PG8_STAGE(PG8_SB(1, 0), cB + kstep, voffB); PG8_STAGE(PG8_SA(1, 0), cA + kstepA, voffA); PG8_STAGE(PG8_SB(1, 1), cB + hstep + kstep, voffB);
        PG8_WAIT_V(6); PG8_BAR;
    }
    for (;;) {
        const bool has_next = S.next(ui + 1, nxt);
        const char* nA = has_next ? (const char*)g.A + (size_t)nxt.pm * tstepA : cA; const char* nB = has_next ? (const char*)g.Bt + (size_t)nxt.pn * tstep : cB;
        for (int t = 0; t < nt; t += 2) {
            const bool last = (t == nt - 2);
            const char* a1 = cA + (size_t)(t + 1) * kstepA;
            const char* a2 = last ? nA : cA + (size_t)(t + 2) * kstepA; const char* b2 = last ? nB : cB + (size_t)(t + 2) * kstep;
            const char* a3 = a2 + kstepA; const char* b3 = b2 + kstep;
            if (last && has_next) S.a_ready(nxt);
            if constexpr (SP2) {
            PG8_LDB(B0, 0, 0); PG8_LDB(B1, 0, 1); PG8_SCHED; PG8_LDA(At, 0, 0); PG8_STAGE(PG8_SA(1, 1), a1 + hstepA, voffA);
            PG8_WAIT_V(8); PG8_WAIT_L(0); PG8_BAR; PG8_MMA(0, 0, At, B0); PG8_MMA(0, 1, At, B1); PG8_BAR; PG8_SCHED;
            PG8_LDA(At, 0, 1); PG8_STAGE(PG8_SB(0, 0), b2, voffB); PG8_STAGE(PG8_SB(0, 1), b2 + hstep, voffB); PG8_STAGE(PG8_SA(0, 0), a2, voffA);
            PG8_WAIT_V(8); PG8_WAIT_L(0); PG8_BAR; PG8_MMA(1, 0, At, B0); PG8_MMA(1, 1, At, B1); PG8_BAR; PG8_SCHED;
            PG8_LDB(B0, 1, 0); PG8_LDB(B1, 1, 1); PG8_SCHED; PG8_LDA(At, 1, 0); PG8_STAGE(PG8_SA(0, 1), a2 + hstepA, voffA);
            PG8_WAIT_V(8); PG8_WAIT_L(0); PG8_BAR; PG8_MMA(0, 0, At, B0); PG8_MMA(0, 1, At, B1); PG8_BAR; PG8_SCHED;
            PG8_LDA(At, 1, 1); PG8_STAGE(PG8_SB(1, 0), b3, voffB); PG8_STAGE(PG8_SB(1, 1), b3 + hstep, voffB); PG8_STAGE(PG8_SA(1, 0), a3, voffA);
            PG8_WAIT_V(8); PG8_WAIT_L(0); PG8_BAR; PG8_MMA(1, 0, At, B0); PG8_MMA(1, 1, At, B1); PG8_BAR; PG8_SCHED;
            } else {
            PG8_LDB(B0, 0, 0); PG8_SCHED; PG8_LDA(At, 0, 0); PG8_STAGE(PG8_SA(1, 1), a1 + hstepA, voffA);
            PG8_WAIT_L(8); PG8_BAR; PG8_WAIT_L(0); PG8_MMA(0, 0, At, B0); PG8_BAR; PG8_SCHED;
            PG8_LDB(B1, 0, 1); PG8_STAGE(PG8_SB(0, 0), b2, voffB);
            PG8_BAR; PG8_WAIT_L(0); PG8_MMA(0, 1, At, B1); PG8_BAR;
            PG8_LDA(At, 0, 1); PG8_STAGE(PG8_SA(0, 0), a2, voffA);
            PG8_BAR; PG8_WAIT_L(0); PG8_MMA(1, 0, At, B0); PG8_BAR; PG8_SCHED;
            PG8_STAGE(PG8_SB(0, 1), b2 + hstep, voffB);
            PG8_WAIT_V(6); PG8_BAR; PG8_MMA(1, 1, At, B1); PG8_BAR;
            PG8_LDB(B0, 1, 0); PG8_SCHED; PG8_LDA(At, 1, 0); PG8_STAGE(PG8_SA(0, 1), a2 + hstepA, voffA);
            PG8_WAIT_L(8); PG8_BAR; PG8_WAIT_L(0); PG8_MMA(0, 0, At, B0); PG8_BAR; PG8_SCHED;
            PG8_LDB(B1, 1, 1); PG8_STAGE(PG8_SB(1, 0), b3, voffB);
            PG8_BAR; PG8_WAIT_L(0); PG8_MMA(0, 1, At, B1); PG8_BAR;
            PG8_LDA(At, 1, 1); PG8_STAGE(PG8_SA(1, 0), a3, voffA);
            PG8_BAR; PG8_WAIT_L(0); PG8_MMA(1, 0, At, B0); PG8_BAR; PG8_SCHED;
            PG8_STAGE(PG8_SB(1, 1), b3 + hstep, voffB);
            PG8_WAIT_V(6); PG8_BAR; PG8_MMA(1, 1, At, B1); PG8_BAR;
            }
        }
        if constexpr (ALIGN_EPI) { if (wr == 0) PG8_BAR; }
#ifdef PROBE_STAMP
        const unsigned long long pe0_ = __builtin_amdgcn_s_memrealtime();
#endif
        if constexpr (!Epi::AFTER_DRAIN) { E(acc, cur, wr, wc, fr, fq); S.done(cur); }
#ifdef PROBE_STAMP
        if (tid == 0) { PG8_LAS unsigned* pw_ = (PG8_LAS unsigned*)(lds + 147456 - 512) + 24 + Epi::PID; *pw_ += (unsigned)(__builtin_amdgcn_s_memrealtime() - pe0_); }
#endif
        if (!has_next) break;
#pragma unroll
        for (int a = 0; a < 2; ++a)
#pragma unroll
            for (int b = 0; b < 2; ++b)
#pragma unroll
                for (int m = 0; m < 4; ++m)
#pragma unroll
                    for (int n = 0; n < 2; ++n) acc[a][b][m][n] = (f32x4){0.f, 0.f, 0.f, 0.f};
        cur = nxt; cA = nA; cB = nB; ++ui;
        if constexpr (ALIGN_EPI) { if (wr == 1) PG8_BAR; }
    }
    PG8_WAIT_V(0);
    if constexpr (!ALIGN_EPI) { if (wr == 0) PG8_BAR; }
    PG8_BAR;
    if constexpr (Epi::AFTER_DRAIN) { E.fused(acc, cur, wr, wc, fr, fq, lds, wid, lane); S.done(cur); }
#undef PG8_SA
#undef PG8_SB
#undef PG8_STAGE
#undef PG8_LDA
#undef PG8_LDB
#undef PG8_MMA
#undef PG8_WAIT_V
#undef PG8_WAIT_L
#undef PG8_BAR
#undef PG8_SCHED
}
}
#define LAS_BAR __attribute__((address_space(3)))
#define XB_TMO      128
#define XB_XCNT(j)  (256  + 64 * (j))
#define XB_XSUB(j)  (1280 + 64 * (j))
#define XB_XGEN(j)  (2304 + 64 * (j))
#define XB_TOP      3328
#define XB_TOPGEN   3392
#define XCD_BAR_WORDS 3456
#define XB_SPIN_CAP (1u << 22)

__device__ __forceinline__ unsigned xb_ld(unsigned* p)              { return __hip_atomic_load(p, __ATOMIC_RELAXED, __HIP_MEMORY_SCOPE_AGENT); }
__device__ __forceinline__ unsigned xb_add(unsigned* p, unsigned v) { return __hip_atomic_fetch_add(p, v, __ATOMIC_RELAXED, __HIP_MEMORY_SCOPE_AGENT); }
__device__ __forceinline__ unsigned xb_xcc_id() { return (unsigned)__builtin_amdgcn_s_getreg((3 << 11) | 20) & 0xFu; }
#define XB_SPIN(cond, bar) do { unsigned _sp = 0; while (cond) { __builtin_amdgcn_s_sleep(1); \
    if ((++_sp & 255u) == 0u) { if (xb_ld(&(bar)[XB_TMO])) break; if (_sp > XB_SPIN_CAP) { atomicAdd(&(bar)[XB_TMO], 1u); break; } } } } while (0)

struct XcdBarrier {
    unsigned* bar; unsigned x;
    volatile LAS_BAR unsigned* st;
};

__device__ __forceinline__ XcdBarrier xcd_barrier_post(unsigned* bar, volatile LAS_BAR unsigned* st) {
    XcdBarrier b; b.bar = bar; b.x = xb_xcc_id(); b.st = st;
    if (threadIdx.x == 0) (void)xb_add(&bar[XB_XCNT(b.x)], 1u);
    return b;
}
__device__ __forceinline__ void xcd_barrier_complete(unsigned* bar, unsigned x, unsigned& nloc, unsigned& nx) {
    const unsigned G = gridDim.x * gridDim.y * gridDim.z;
    unsigned sum, cnt, mine, sp = 0u;
    for (;;) {
        sum = 0u; cnt = 0u; mine = 0u;
#pragma unroll
        for (unsigned j = 0; j < 16; ++j) { const unsigned c = xb_ld(&bar[XB_XCNT(j)]); sum += c; cnt += (c > 0u) ? 1u : 0u; mine = (j == x) ? c : mine; }
        if (sum == G) break;
        __builtin_amdgcn_s_sleep(1);
        if ((++sp & 255u) == 0u) { if (xb_ld(&bar[XB_TMO])) break; if (sp > XB_SPIN_CAP) { atomicAdd(&bar[XB_TMO], 1u); break; } }
    }
    nloc = mine > 0u ? mine : 1u; nx = cnt > 0u ? cnt : 1u;
}

__device__ __forceinline__ void xcd_barrier(const XcdBarrier& b) {
    asm volatile("s_waitcnt vmcnt(0)" ::: "memory");
    __syncthreads();
    if (threadIdx.x == 0) {
        unsigned* bar = b.bar;
        __builtin_amdgcn_s_waitcnt(0);
#ifdef PROBE_STAMP
        const unsigned long long pt0_ = __builtin_amdgcn_s_memrealtime();
#endif
        unsigned nloc = b.st[0], nx = b.st[1];
        if (nloc == 0u) { xcd_barrier_complete(bar, b.x, nloc, nx); b.st[0] = nloc; b.st[1] = nx; }
        const unsigned old = xb_add(&bar[XB_XSUB(b.x)], 1u);
        const unsigned gen = old / nloc;
        if (old + 1u == (gen + 1u) * nloc) {
            __builtin_amdgcn_fence(__ATOMIC_RELEASE, "agent");
            asm volatile("s_waitcnt vmcnt(0)" ::: "memory");
            const unsigned og = xb_add(&bar[XB_TOP], 1u);
            const unsigned tg = og / nx;
            if (og + 1u == (tg + 1u) * nx) xb_add(&bar[XB_TOPGEN], 1u);
            else XB_SPIN(xb_ld(&bar[XB_TOPGEN]) == tg, bar);
            __builtin_amdgcn_fence(__ATOMIC_ACQUIRE, "agent");
            xb_add(&bar[XB_XGEN(b.x)], 1u);
            asm volatile("s_waitcnt vmcnt(0)" ::: "memory");
        } else {
            XB_SPIN(xb_ld(&bar[XB_XGEN(b.x)]) == gen, bar);
            __builtin_amdgcn_fence(__ATOMIC_ACQUIRE, "agent");
            asm volatile("s_waitcnt vmcnt(0)" ::: "memory");
        }
#ifdef PROBE_STAMP
        { const unsigned cls_ = b.st[4]; const unsigned now_ = (unsigned)__builtin_amdgcn_s_memrealtime(); b.st[8 + cls_] += now_ - (unsigned)pt0_; if (b.st[6]) b.st[16 + cls_] += now_ - b.st[6]; b.st[6] = now_ | 1u; }
#endif
    }
    __syncthreads();
}

constexpr int NWAVES = 8, NTHR = 512;
constexpr int BATCH = 2, T = 16384, D = 2048, FF = 5632, M = BATCH * T;
constexpr int ZN = 5120;
constexpr int ZA = 1536;
constexpr int A_COLS = 3360, E_IN = 4896;
constexpr int ZO = 4096;
constexpr int NSUB = 12;
#ifndef MK_ONE_LAUNCH
#define MK_ONE_LAUNCH 0
#endif

constexpr size_t MiB = 1u << 20;
constexpr size_t WS_CTL = 0, CTL_ZERO_BYTES = 1 * MiB;
constexpr size_t WS_SS = 1 * MiB;
constexpr size_t SS_REC = 8 * (size_t)M;
constexpr size_t WS_WT = 16 * MiB;
constexpr size_t WT_GU1 = WS_WT, WT_D1 = WT_GU1 + 44 * MiB, WT_GU2 = WT_D1 + 22 * MiB, WT_D2 = WT_GU2 + 44 * MiB, WT_IN = WT_D2 + 22 * MiB, WT_OUT = WT_IN + 20 * MiB;
constexpr size_t WS_XB = WT_OUT + 8 * MiB;
constexpr size_t WS_ACT = WS_XB + 128 * MiB;
constexpr size_t WS_SC = WS_ACT + 352 * MiB;
constexpr size_t SC_R = WS_SC, SC_K2 = SC_R + 64 * MiB, SC_KK = SC_K2 + 64 * MiB, SC_BB = SC_KK + 64 * MiB, SC_LW = SC_BB + 64 * MiB, SC_GG = SC_LW + 64 * MiB;
constexpr size_t WS_VF = SC_GG + 64 * MiB;
constexpr size_t WS_V2 = WS_VF + 64 * MiB;
constexpr size_t WS_O = WS_V2 + 64 * MiB;
constexpr size_t WS_SM = WS_O + 128 * MiB;
constexpr size_t SM_W2T = WS_SM, SM_A2T = SM_W2T + 131072, SM_G2T = SM_A2T + 131072, SM_V1T = SM_G2T + 327680, SM_V2T = SM_V1T + 65536, SM_WSB = SM_V2T + 65536;
constexpr size_t WS_U0 = WS_SM + 2 * MiB;
constexpr size_t WS_END = WS_U0 + 64 * MiB;
static_assert(SM_WSB + 524288 <= WS_END, "small-weight map");
constexpr size_t WT2_GU2 = WS_END, WT2_D2 = WT2_GU2 + 44 * MiB, WT2_OUT = WT2_D2 + 22 * MiB, WS_END2 = WT2_OUT + 8 * MiB;
static_assert(WT_OUT + 8 * MiB == 176 * MiB && WS_SS + 15 * MiB <= WS_WT, "weight map");
constexpr int CW_TMO = 0, CW_CODE = 1, CW_BAR = 4096;

constexpr int LDS_BYTES = 147456, LDSCTL_OFF = LDS_BYTES - 512;

#define GAS __attribute__((address_space(1)))
#define LAS __attribute__((address_space(3)))
typedef unsigned short bf16;
typedef unsigned v4u __attribute__((ext_vector_type(4)));
typedef unsigned v2u __attribute__((ext_vector_type(2)));
typedef float f32x4 __attribute__((ext_vector_type(4)));
typedef float f32x2 __attribute__((ext_vector_type(2)));
typedef GAS unsigned gu32;
#define RLX_AGENT __ATOMIC_RELAXED, __HIP_MEMORY_SCOPE_AGENT
#define LDS_WAIT() asm volatile("s_waitcnt lgkmcnt(0)" ::: "memory")
typedef __bf16 bf16x2_hw __attribute__((ext_vector_type(2)));
__device__ __forceinline__ unsigned pk2(float lo, float hi) { const bf16x2_hw b = __builtin_convertvector((f32x2){lo, hi}, bf16x2_hw); return __builtin_bit_cast(unsigned, b); }
__device__ __forceinline__ unsigned f2bf(float f) { return pk2(f, f) & 0xffffu; }
__device__ __forceinline__ float bf2f(bf16 b) { return __builtin_bit_cast(float, (unsigned)b << 16); }
__device__ __forceinline__ float bflo(unsigned w) { return __builtin_bit_cast(float, w << 16); }
__device__ __forceinline__ float bfhi(unsigned w) { return __builtin_bit_cast(float, w & 0xffff0000u); }
__device__ __forceinline__ float wave_sum(float v) {
#pragma unroll
    for (int o = 1; o < 64; o <<= 1) v += __shfl_xor(v, o);
    return v;
}
template <int CTRL> __device__ __forceinline__ float dpp_mov(float v) { return __builtin_bit_cast(float, __builtin_amdgcn_update_dpp(0, __builtin_bit_cast(int, v), CTRL, 0xf, 0xf, true)); }
__device__ __forceinline__ float row16_sum(float v) { v += dpp_mov<0xB1>(v); v += dpp_mov<0x4E>(v); v += dpp_mov<0x141>(v); v += dpp_mov<0x140>(v); return v; }
__device__ __forceinline__ float sigmoidf_(float x) { return 1.0f / (1.0f + __expf(-x)); }

__device__ __forceinline__ int opaque(int v) { asm volatile("" : "+v"(v)); return v; }
struct Args { const float* in[29]; float* out; unsigned char* ws; int ph_lo, ph_hi, dbl, pad_; };
static_assert(sizeof(Args) == 29 * 8 + 8 + 8 + 16, "Args has no padding");
enum { I_X = 0, I_NG, I_WG, I_WU, I_WD, I_EWIN, I_EBQKV, I_EMU, I_EW0, I_EW2, I_EA0, I_EA2, I_EG2, I_EKK, I_EKA, I_ERK, I_EGNG, I_EGNB, I_ESINK, I_EWOUT, I_V0, I_V1, I_V2, I_OWIN, I_OVNG, I_OWS, I_OBS, I_OWOUT, I_FG };

struct TrDesc { const float* W; const float* gk; bf16* WT; int ldw, k0, c0, K, drow0; bool zero; };
__device__ __forceinline__ void tr_load(const TrDesc& d, float (&v)[32], int lane) {
#pragma unroll
    for (int i = 0; i < 32; ++i) { const int kk = 2 * i + (lane >> 5); v[i] = d.zero ? 0.f : d.W[(size_t)(d.k0 + kk) * d.ldw + d.c0 + (lane & 31)]; }
}
__device__ __forceinline__ void tr_store(const TrDesc& d, const float (&v)[32], LAS float* scr, int lane) {
#pragma unroll
    for (int i = 0; i < 32; ++i) { const int kk = 2 * i + (lane >> 5); float x = v[i]; if (d.gk) x *= d.gk[d.k0 + kk]; scr[kk * 33 + (lane & 31)] = x; }
    LDS_WAIT(); asm volatile("" ::: "memory");
    const int c = lane & 7;
#pragma unroll
    for (int j = 0; j < 4; ++j) { const int n = (lane >> 3) + 8 * j; const LAS float* s = scr + (8 * c) * 33 + n;
        v4u o; o.x = pk2(s[0 * 33], s[1 * 33]); o.y = pk2(s[2 * 33], s[3 * 33]); o.z = pk2(s[4 * 33], s[5 * 33]); o.w = pk2(s[6 * 33], s[7 * 33]);
        *(GAS v4u*)(d.WT + (size_t)(d.drow0 + n) * d.K + d.k0 + 8 * c) = o; }
    LDS_WAIT(); asm volatile("" ::: "memory");
}
__device__ __forceinline__ TrDesc tr_desc(const Args& a, int L, int it) {
    unsigned char* ws = a.ws; const bool even = !(L & 1); const int li = L >> 1; const bool odd2 = a.dbl && (L & 1);
    constexpr int nGU = 32 * 352, nD = 88 * 64; const int nIN = 32 * (even ? 160 : 128);
    TrDesc d; d.zero = false; int r = it;
    if (r < 2 * nGU) { const int f = r / nGU; r -= f * nGU; const int kb = r / 352, rb = r % 352, tj = rb >> 3, sub = rb & 7;
        d.W = (sub < 4 ? a.in[I_WG] : a.in[I_WU]) + (size_t)(L * 2 + f) * D * FF; d.ldw = FF; d.k0 = 64 * kb; d.c0 = 128 * tj + 32 * (sub & 3); d.gk = a.in[I_NG] + (L * 3 + (f ? 2 : 0)) * D;
        d.WT = (bf16*)(ws + (f ? (odd2 ? WT2_GU2 : WT_GU2) : WT_GU1)); d.K = D; d.drow0 = 32 * rb; return d; }
    r -= 2 * nGU;
    if (r < 2 * nD) { const int f = r / nD; r -= f * nD; const int kb = r / 64, nb = r % 64;
        d.W = a.in[I_WD] + (size_t)(L * 2 + f) * FF * D; d.ldw = D; d.k0 = 64 * kb; d.c0 = 32 * nb; d.gk = nullptr; d.WT = (bf16*)(ws + (f ? (odd2 ? WT2_D2 : WT_D2) : WT_D1)); d.K = FF; d.drow0 = 32 * nb; return d; }
    r -= 2 * nD;
    if (r < nIN) {
        d.gk = a.in[I_NG] + (L * 3 + 1) * D; d.WT = (bf16*)(ws + WT_IN); d.K = D;
        if (even) { const int kb = r / 160, rb = r % 160, dd = 32 * rb; d.zero = dd >= E_IN; d.W = a.in[I_EWIN] + (size_t)li * D * E_IN; d.ldw = E_IN; d.k0 = 64 * kb; d.c0 = d.zero ? 0 : (dd < ZA ? A_COLS + dd : dd - ZA); d.drow0 = dd; }
        else { const int kb = r / 128, rb = r % 128; d.W = a.in[I_OWIN] + (size_t)li * D * ZO; d.ldw = ZO; d.k0 = 64 * kb; d.c0 = 32 * rb; d.drow0 = 32 * rb; }
        return d; }
    r -= nIN;
    { const int kb = r / 64, nb = r % 64; d.W = (even ? a.in[I_EWOUT] : a.in[I_OWOUT]) + (size_t)li * D * D; d.ldw = D; d.k0 = 64 * kb; d.c0 = 32 * nb; d.gk = nullptr; d.WT = (bf16*)(ws + (odd2 ? WT2_OUT : WT_OUT)); d.K = D; d.drow0 = 32 * nb; }
    return d;
}
__device__ __forceinline__ void prep_phase(const Args& a, int L, LAS unsigned char* lds, int vcu, int G, int wave, int lane, int mode) {
    asm volatile("" : "+s"(G));
    LAS float* scr = (LAS float*)(lds + wave * 16384);
    const int gw = vcu * NWAVES + wave, NGW = G * NWAVES;
    unsigned char* ws = a.ws;
    const bool even = !(L & 1); const int li = L >> 1;
    const int nGU = 32 * 352, nD = 88 * 64, nIN = 32 * (even ? 160 : 128), nOUT = 32 * 64;
    const int total = mode == 0 ? 2 * nGU + 2 * nD + nIN + nOUT : mode == 1 ? nGU + nD + nIN : nGU + nD + nOUT;
    const int sh0 = mode == 2 ? nGU : 0, sh1 = mode == 0 ? 0 : mode == 1 ? nGU : nGU + nD, sh2 = mode == 0 ? 0 : mode == 1 ? nGU + nD : nGU + nD + nIN;
#define PREP_IT(i) ((mode == 0) ? (i) : (i) < nGU ? (i) + sh0 : (i) < nGU + nD ? (i) + sh1 : (i) + sh2)
    if (gw < total) {
        TrDesc d0 = tr_desc(a, L, PREP_IT(gw)); float v0[32]; tr_load(d0, v0, lane);
        for (int it = gw; it < total; it += NGW) {
            const int itn = it + NGW; const bool hasn = itn < total; const int itx = hasn ? itn : it;
            TrDesc d1 = tr_desc(a, L, PREP_IT(itx)); float v1[32];
            if (hasn) tr_load(d1, v1, lane);
            tr_store(d0, v0, scr, lane);
            d0 = d1;
#pragma unroll
            for (int i = 0; i < 32; ++i) v0[i] = v1[i];
        }
    }
#undef PREP_IT
    if (mode != 2) {
        const int gt = gw * 64 + lane, NGT = NGW * 64;
        if (even) {
            const float* w2 = a.in[I_EW2] + (size_t)li * 64 * 1024; const float* a2 = a.in[I_EA2] + (size_t)li * 64 * 1024; const float* g2 = a.in[I_EG2] + (size_t)li * 160 * 1024;
            bf16* W2T = (bf16*)(ws + SM_W2T); bf16* A2T = (bf16*)(ws + SM_A2T); bf16* G2T = (bf16*)(ws + SM_G2T);
            for (int e = gt; e < 1024 * 64; e += NGT) { const int k = e >> 10, c = e & 1023; W2T[c * 64 + k] = (bf16)f2bf(w2[e]); A2T[c * 64 + k] = (bf16)f2bf(a2[e]); }
            for (int e = gt; e < 1024 * 160; e += NGT) { const int k = e >> 10, c = e & 1023; G2T[c * 160 + k] = (bf16)f2bf(g2[e]); }
            if (li > 0) { bf16* V1T = (bf16*)(ws + SM_V1T); bf16* V2T = (bf16*)(ws + SM_V2T);
                for (int e = gt; e < 1024 * 32; e += NGT) { const int c = e >> 5, j = e & 31; V1T[j * 1024 + c] = (bf16)f2bf(a.in[I_V1][e]); }
                for (int e = gt; e < 32 * 1024; e += NGT) { const int j = e >> 10, c = e & 1023; V2T[c * 32 + j] = (bf16)f2bf(a.in[I_V2][e]); } }
        } else {
            const float* wsg = a.in[I_OWS] + (size_t)li * 16 * 128 * 128; bf16* WSB = (bf16*)(ws + SM_WSB);
            for (int e = gt; e < 16 * 128 * 128; e += NGT) { const int i = (e >> 7) & 127, j = e & 127; WSB[e] = (bf16)f2bf(j <= i ? wsg[e] : 0.f); }
        }
    }
    if (L == 0) {
        float* ss0 = (float*)(ws + WS_SS); bf16* XB = (bf16*)(ws + WS_XB);
        for (int m = gw; m < M; m += NGW) {
            const GAS f32x4* xr = (const GAS f32x4*)(a.in[I_X] + (size_t)m * D) + lane; GAS v2u* o = (GAS v2u*)(XB + (size_t)m * D) + lane; float s = 0.f;
#pragma unroll
            for (int j = 0; j < 8; ++j) { const f32x4 v = xr[64 * j]; s += (v.x * v.x + v.y * v.y) + (v.z * v.z + v.w * v.w); v2u w; w.x = pk2(v.x, v.y); w.y = pk2(v.z, v.w); o[64 * j] = w; }
            s = wave_sum(s); if (lane < 8) ss0[(size_t)lane * M + m] = lane ? 0.f : s;
        }
    }
}

typedef short bf16x8_t __attribute__((ext_vector_type(8)));
__device__ __forceinline__ float fast_tanh(float x) { const float e = __expf(2.0f * x); return 1.0f - 2.0f / (1.0f + e); }
__device__ __forceinline__ void lerp8(const v4u c, const v4u p, const float* mu, float (&o)[8]) {
    const f32x4 m0 = *(const f32x4*)mu, m1 = *(const f32x4*)(mu + 4);
    const float c0 = bflo(c.x), c1 = bfhi(c.x), c2 = bflo(c.y), c3 = bfhi(c.y), c4 = bflo(c.z), c5 = bfhi(c.z), c6 = bflo(c.w), c7 = bfhi(c.w);
    o[0] = c0 + (bflo(p.x) - c0) * m0.x; o[1] = c1 + (bfhi(p.x) - c1) * m0.y; o[2] = c2 + (bflo(p.y) - c2) * m0.z; o[3] = c3 + (bfhi(p.y) - c3) * m0.w;
    o[4] = c4 + (bflo(p.z) - c4) * m1.x; o[5] = c5 + (bfhi(p.z) - c5) * m1.y; o[6] = c6 + (bflo(p.w) - c6) * m1.z; o[7] = c7 + (bfhi(p.w) - c7) * m1.w;
}
__device__ __forceinline__ void lerp4(const v2u c, const v2u p, const f32x4 m, float (&o)[4]) {
    const float c0 = bflo(c.x), c1 = bfhi(c.x), c2 = bflo(c.y), c3 = bfhi(c.y);
    o[0] = c0 + (bflo(p.x) - c0) * m.x; o[1] = c1 + (bfhi(p.x) - c1) * m.y; o[2] = c2 + (bflo(p.y) - c2) * m.z; o[3] = c3 + (bfhi(p.y) - c3) * m.w;
}
__device__ __forceinline__ v2u pack4(float a, float b, float c, float d) { v2u w; w.x = pk2(a, b); w.y = pk2(c, d); return w; }
constexpr int E1_AW = 0, E1_AA = 9216, E1_AG = 18432, E1_PP = 40960, E1_PB = 106496;
__device__ __forceinline__ void e1_phase(const Args& a, int li, LAS unsigned char* ldsb, int vcu, int G, int tid) {
    unsigned char* ws = a.ws;
    const bf16* Z = (const bf16*)(ws + WS_ACT);
    bf16* R = (bf16*)(ws + SC_R); bf16* K2 = (bf16*)(ws + SC_K2); bf16* KK = (bf16*)(ws + SC_KK); bf16* BB = (bf16*)(ws + SC_BB); bf16* LW = (bf16*)(ws + SC_LW); bf16* GG = (bf16*)(ws + SC_GG);
    bf16* VO = (bf16*)(ws + (li ? WS_V2 : WS_VF)); const bf16* VF = (const bf16*)(ws + WS_VF);
    const bf16* W2T = (const bf16*)(ws + SM_W2T); const bf16* A2T = (const bf16*)(ws + SM_A2T); const bf16* G2T = (const bf16*)(ws + SM_G2T);
    const bf16* V1T = (const bf16*)(ws + SM_V1T); const bf16* V2T = (const bf16*)(ws + SM_V2T);
    const float* mu = a.in[I_EMU] + li * A_COLS;
    const float* w0 = a.in[I_EW0] + li * 1024; const float* a0 = a.in[I_EA0] + li * 1024;
    const float* kkw = a.in[I_EKK] + li * 1024; const float* kaw = a.in[I_EKA] + li * 1024; const float* v0w = a.in[I_V0];
    const int lane = tid & 63, wave = tid >> 6, fr = lane & 15, fq = lane >> 4;
    for (int unit = vcu; unit < M / 64; unit += G) {
        const int m0 = unit * 64;
        for (int e = tid; e < 64 * 36; e += NTHR) { const int r = e / 36, ch = e % 36, j0 = 8 * ch, m = m0 + r; const bool first = (m & (T - 1)) == 0;
            const v4u cur = *(const GAS v4u*)(Z + (size_t)m * ZN + ZA + 3072 + j0); v4u prv = {0u, 0u, 0u, 0u}; if (!first) prv = *(const GAS v4u*)(Z + (size_t)(m - 1) * ZN + ZA + 3072 + j0);
            float x[8]; lerp8(cur, prv, mu + 3072 + j0, x);
            if (j0 < 64) {
#pragma unroll
                for (int i = 0; i < 8; ++i) x[i] = fast_tanh(x[i]);
            } else if (j0 >= 128) {
#pragma unroll
                for (int i = 0; i < 8; ++i) x[i] = sigmoidf_(x[i]);
            }
            v4u o; o.x = pk2(x[0], x[1]); o.y = pk2(x[2], x[3]); o.z = pk2(x[4], x[5]); o.w = pk2(x[6], x[7]);
            LAS unsigned char* dst = j0 < 64 ? ldsb + E1_AW + r * 144 + j0 * 2 : j0 < 128 ? ldsb + E1_AA + r * 144 + (j0 - 64) * 2 : ldsb + E1_AG + r * 336 + (j0 - 128) * 2;
            *(LAS v4u*)dst = o; }
        if (li > 0) {
            f32x4 pacc[4][2];
#pragma unroll
            for (int mt = 0; mt < 4; ++mt) { pacc[mt][0] = (f32x4){0.f, 0.f, 0.f, 0.f}; pacc[mt][1] = pacc[mt][0]; }
            for (int ks = 0; ks < 4; ++ks) { const int c = 128 * wave + 32 * ks + 8 * fq;
                const bf16x8_t w0f = *(const GAS bf16x8_t*)(V1T + (size_t)fr * 1024 + c), w1f = *(const GAS bf16x8_t*)(V1T + (size_t)(16 + fr) * 1024 + c);
#pragma unroll
                for (int mt = 0; mt < 4; ++mt) { const int m = m0 + 16 * mt + fr; const bool first = (m & (T - 1)) == 0;
                    const v4u cur = *(const GAS v4u*)(Z + (size_t)m * ZN + ZA + 2048 + c); v4u prv = {0u, 0u, 0u, 0u}; if (!first) prv = *(const GAS v4u*)(Z + (size_t)(m - 1) * ZN + ZA + 2048 + c);
                    float x[8]; lerp8(cur, prv, mu + 2048 + c, x);
                    v4u o; o.x = pk2(x[0], x[1]); o.y = pk2(x[2], x[3]); o.z = pk2(x[4], x[5]); o.w = pk2(x[6], x[7]);
                    const bf16x8_t af = __builtin_bit_cast(bf16x8_t, o);
                    pacc[mt][0] = __builtin_amdgcn_mfma_f32_16x16x32_bf16(w0f, af, pacc[mt][0], 0, 0, 0); pacc[mt][1] = __builtin_amdgcn_mfma_f32_16x16x32_bf16(w1f, af, pacc[mt][1], 0, 0, 0); } }
#pragma unroll
            for (int mt = 0; mt < 4; ++mt)
#pragma unroll
                for (int nt = 0; nt < 2; ++nt) *(LAS f32x4*)(ldsb + E1_PP + ((wave * 64 + 16 * mt + fr) * 32 + 16 * nt + 4 * fq) * 4) = pacc[mt][nt];
        }
        __syncthreads();
        if (li > 0) {
            for (int e = tid; e < 64 * 32; e += NTHR) { float sum = 0.f;
#pragma unroll
                for (int w = 0; w < 8; ++w) sum += *(const LAS float*)(ldsb + E1_PP + (w * 2048 + e) * 4);
                *(LAS bf16*)(ldsb + E1_PB + (e >> 5) * 80 + (e & 31) * 2) = (bf16)f2bf(sum); }
            __syncthreads();
        }
#define E1_WROW(nt) (cb + 32 * ((nt) >> 1) + 8 * (fr >> 2) + 4 * ((nt) & 1) + (fr & 3))
#pragma unroll 1
        for (int hh = 0; hh < 2; ++hh) {
            const int cb = 128 * wave + 64 * hh;
            {
                bf16x8_t wa[4][2];
#pragma unroll
                for (int nt = 0; nt < 4; ++nt)
#pragma unroll
                    for (int ks = 0; ks < 2; ++ks) wa[nt][ks] = *(const GAS bf16x8_t*)(A2T + (size_t)E1_WROW(nt) * 64 + 32 * ks + 8 * fq);
                v4u ncur[2], nprv[2];
                { const int m = m0 + fr; const bool first = (m & (T - 1)) == 0; const size_t zo = (size_t)m * ZN + ZA + cb + 8 * fq;
#pragma unroll
                  for (int p = 0; p < 2; ++p) { ncur[p] = *(const GAS v4u*)(Z + zo + 1024 + 32 * p); nprv[p] = (v4u){0u, 0u, 0u, 0u}; if (!first) nprv[p] = *(const GAS v4u*)(Z + zo - ZN + 1024 + 32 * p); } }
#pragma unroll 1
                for (int mt = 0; mt < 4; ++mt) {
                    const int m = m0 + 16 * mt + fr;
                    v4u ccur[2], cprv[2];
#pragma unroll
                    for (int p = 0; p < 2; ++p) { ccur[p] = ncur[p]; cprv[p] = nprv[p]; }
                    if (mt < 3) { const size_t zn = (size_t)(m + 16) * ZN + ZA + cb + 8 * fq;
#pragma unroll
                        for (int p = 0; p < 2; ++p) { ncur[p] = *(const GAS v4u*)(Z + zn + 1024 + 32 * p); nprv[p] = *(const GAS v4u*)(Z + zn - ZN + 1024 + 32 * p); } }
                    f32x4 aa[4];
#pragma unroll
                    for (int nt = 0; nt < 4; ++nt) aa[nt] = (f32x4){0.f, 0.f, 0.f, 0.f};
#pragma unroll
                    for (int ks = 0; ks < 2; ++ks) { const bf16x8_t fa = *(const LAS bf16x8_t*)(ldsb + E1_AA + (16 * mt + fr) * 144 + (32 * ks + 8 * fq) * 2);
#pragma unroll
                        for (int nt = 0; nt < 4; ++nt) aa[nt] = __builtin_amdgcn_mfma_f32_16x16x32_bf16(wa[nt][ks], fa, aa[nt], 0, 0, 0); }
                    float k1[2][8], av[2][8], kk0[2][8]; float n2 = 0.f;
#pragma unroll
                    for (int p = 0; p < 2; ++p) { const int c = cb + 32 * p + 8 * fq;
                        lerp8(ccur[p], cprv[p], mu + 1024 + c, k1[p]);
                        const f32x4 a00 = *(const f32x4*)(a0 + c), a01 = *(const f32x4*)(a0 + c + 4), kk00 = *(const f32x4*)(kkw + c), kk01 = *(const f32x4*)(kkw + c + 4);
#pragma unroll
                        for (int j = 0; j < 8; ++j) { const float a0j = j < 4 ? a00[j & 3] : a01[j & 3], kkj = j < 4 ? kk00[j & 3] : kk01[j & 3];
                            av[p][j] = sigmoidf_(a0j + aa[2 * p + (j >> 2)][j & 3]); kk0[p][j] = k1[p][j] * kkj; n2 += kk0[p][j] * kk0[p][j]; } }
                    n2 += __shfl_xor(n2, 16); n2 += __shfl_xor(n2, 32);
                    const float inv = 1.0f / fmaxf(sqrtf(n2), 1e-12f);
#pragma unroll
                    for (int p = 0; p < 2; ++p) { const int c = cb + 32 * p + 8 * fq; const size_t o = (size_t)m * 1024 + c; const f32x4 ka0 = *(const f32x4*)(kaw + c), ka1 = *(const f32x4*)(kaw + c + 4);
                        float kk[8], k2[8], bb[8];
#pragma unroll
                        for (int j = 0; j < 8; ++j) { const float kaj = j < 4 ? ka0[j & 3] : ka1[j & 3]; kk[j] = kk0[p][j] * inv; k2[j] = k1[p][j] * (1.0f + (av[p][j] - 1.0f) * kaj); bb[j] = kk[j] * av[p][j]; }
                        *(GAS v4u*)(KK + o) = (v4u){pk2(kk[0], kk[1]), pk2(kk[2], kk[3]), pk2(kk[4], kk[5]), pk2(kk[6], kk[7])};
                        *(GAS v4u*)(K2 + o) = (v4u){pk2(k2[0], k2[1]), pk2(k2[2], k2[3]), pk2(k2[4], k2[5]), pk2(k2[6], k2[7])};
                        *(GAS v4u*)(BB + o) = (v4u){pk2(bb[0], bb[1]), pk2(bb[2], bb[3]), pk2(bb[4], bb[5]), pk2(bb[6], bb[7])}; }
                }
            }
            {
                bf16x8_t ww[4][2];
#pragma unroll
                for (int nt = 0; nt < 4; ++nt)
#pragma unroll
                    for (int ks = 0; ks < 2; ++ks) ww[nt][ks] = *(const GAS bf16x8_t*)(W2T + (size_t)E1_WROW(nt) * 64 + 32 * ks + 8 * fq);
#pragma unroll 1
                for (int mt = 0; mt < 4; ++mt) {
                    const int m = m0 + 16 * mt + fr;
                    f32x4 aw[4];
#pragma unroll
                    for (int nt = 0; nt < 4; ++nt) aw[nt] = (f32x4){0.f, 0.f, 0.f, 0.f};
#pragma unroll
                    for (int ks = 0; ks < 2; ++ks) { const bf16x8_t fw = *(const LAS bf16x8_t*)(ldsb + E1_AW + (16 * mt + fr) * 144 + (32 * ks + 8 * fq) * 2);
#pragma unroll
                        for (int nt = 0; nt < 4; ++nt) aw[nt] = __builtin_amdgcn_mfma_f32_16x16x32_bf16(ww[nt][ks], fw, aw[nt], 0, 0, 0); }
#pragma unroll
                    for (int p = 0; p < 2; ++p) { const int c = cb + 32 * p + 8 * fq; const f32x4 w00 = *(const f32x4*)(w0 + c), w01 = *(const f32x4*)(w0 + c + 4); float lw[8];
#pragma unroll
                        for (int j = 0; j < 8; ++j) { const float y = -((j < 4 ? w00[j & 3] : w01[j & 3]) + aw[2 * p + (j >> 2)][j & 3]); const float sp = fmaxf(y, 0.f) + __logf(1.0f + __expf(-fabsf(y))); lw[j] = -__expf(-sp - 0.5f); }
                        *(GAS v4u*)(LW + (size_t)m * 1024 + c) = (v4u){pk2(lw[0], lw[1]), pk2(lw[2], lw[3]), pk2(lw[4], lw[5]), pk2(lw[6], lw[7])}; }
                }
            }
            {
                bf16x8_t wg[4][5];
#pragma unroll
                for (int nt = 0; nt < 4; ++nt)
#pragma unroll
                    for (int ks = 0; ks < 5; ++ks) wg[nt][ks] = *(const GAS bf16x8_t*)(G2T + (size_t)E1_WROW(nt) * 160 + 32 * ks + 8 * fq);
#pragma unroll 1
                for (int mt = 0; mt < 4; ++mt) {
                    const int m = m0 + 16 * mt + fr;
                    f32x4 ag[4];
#pragma unroll
                    for (int nt = 0; nt < 4; ++nt) ag[nt] = (f32x4){0.f, 0.f, 0.f, 0.f};
#pragma unroll
                    for (int ks = 0; ks < 5; ++ks) { const bf16x8_t fg = *(const LAS bf16x8_t*)(ldsb + E1_AG + (16 * mt + fr) * 336 + (32 * ks + 8 * fq) * 2);
#pragma unroll
                        for (int nt = 0; nt < 4; ++nt) ag[nt] = __builtin_amdgcn_mfma_f32_16x16x32_bf16(wg[nt][ks], fg, ag[nt], 0, 0, 0); }
#pragma unroll
                    for (int p = 0; p < 2; ++p) *(GAS v4u*)(GG + (size_t)m * 1024 + cb + 32 * p + 8 * fq) = (v4u){pk2(ag[2 * p][0], ag[2 * p][1]), pk2(ag[2 * p][2], ag[2 * p][3]), pk2(ag[2 * p + 1][0], ag[2 * p + 1][1]), pk2(ag[2 * p + 1][2], ag[2 * p + 1][3])};
                }
            }
            {
                v4u nrc[2], nrp[2];
                { const int m = m0 + fr; const bool first = (m & (T - 1)) == 0; const size_t zo = (size_t)m * ZN + ZA + cb + 8 * fq;
#pragma unroll
                  for (int p = 0; p < 2; ++p) { nrc[p] = *(const GAS v4u*)(Z + zo + 32 * p); nrp[p] = (v4u){0u, 0u, 0u, 0u}; if (!first) nrp[p] = *(const GAS v4u*)(Z + zo - ZN + 32 * p); } }
#pragma unroll 1
                for (int mt = 0; mt < 4; ++mt) {
                    const int m = m0 + 16 * mt + fr;
                    v4u crc[2], crp[2];
#pragma unroll
                    for (int p = 0; p < 2; ++p) { crc[p] = nrc[p]; crp[p] = nrp[p]; }
                    if (mt < 3) { const size_t zn = (size_t)(m + 16) * ZN + ZA + cb + 8 * fq;
#pragma unroll
                        for (int p = 0; p < 2; ++p) { nrc[p] = *(const GAS v4u*)(Z + zn + 32 * p); nrp[p] = *(const GAS v4u*)(Z + zn - ZN + 32 * p); } }
#pragma unroll
                    for (int p = 0; p < 2; ++p) { const int c = cb + 32 * p + 8 * fq; float rr[8]; lerp8(crc[p], crp[p], mu + c, rr);
                        *(GAS v4u*)(R + (size_t)m * 1024 + c) = (v4u){pk2(rr[0], rr[1]), pk2(rr[2], rr[3]), pk2(rr[4], rr[5]), pk2(rr[6], rr[7])}; }
                }
            }
            {
                bf16x8_t wv2[4];
#pragma unroll
                for (int nt = 0; nt < 4; ++nt) { wv2[nt] = (bf16x8_t){0, 0, 0, 0, 0, 0, 0, 0}; if (li > 0) wv2[nt] = *(const GAS bf16x8_t*)(V2T + (size_t)E1_WROW(nt) * 32 + 8 * fq); }
                v4u nvc[2], nvp[2];
                { const int m = m0 + fr; const bool first = (m & (T - 1)) == 0; const size_t zo = (size_t)m * ZN + ZA + cb + 8 * fq;
#pragma unroll
                  for (int p = 0; p < 2; ++p) { nvc[p] = *(const GAS v4u*)(Z + zo + 2048 + 32 * p); nvp[p] = (v4u){0u, 0u, 0u, 0u}; if (!first) nvp[p] = *(const GAS v4u*)(Z + zo - ZN + 2048 + 32 * p); } }
#pragma unroll 1
                for (int mt = 0; mt < 4; ++mt) {
                    const int m = m0 + 16 * mt + fr;
                    v4u cvc[2], cvp[2];
#pragma unroll
                    for (int p = 0; p < 2; ++p) { cvc[p] = nvc[p]; cvp[p] = nvp[p]; }
                    if (mt < 3) { const size_t zn = (size_t)(m + 16) * ZN + ZA + cb + 8 * fq;
#pragma unroll
                        for (int p = 0; p < 2; ++p) { nvc[p] = *(const GAS v4u*)(Z + zn + 2048 + 32 * p); nvp[p] = *(const GAS v4u*)(Z + zn - ZN + 2048 + 32 * p); } }
                    f32x4 avr[4];
#pragma unroll
                    for (int nt = 0; nt < 4; ++nt) avr[nt] = (f32x4){0.f, 0.f, 0.f, 0.f};
                    if (li > 0) { const bf16x8_t fp = *(const LAS bf16x8_t*)(ldsb + E1_PB + (16 * mt + fr) * 80 + (8 * fq) * 2);
#pragma unroll
                        for (int nt = 0; nt < 4; ++nt) avr[nt] = __builtin_amdgcn_mfma_f32_16x16x32_bf16(wv2[nt], fp, avr[nt], 0, 0, 0); }
#pragma unroll
                    for (int p = 0; p < 2; ++p) { const int c = cb + 32 * p + 8 * fq; const size_t o = (size_t)m * 1024 + c;
                        float vv[8]; lerp8(cvc[p], cvp[p], mu + 2048 + c, vv);
                        if (li > 0) { const f32x4 v00 = *(const f32x4*)(v0w + c), v01 = *(const f32x4*)(v0w + c + 4); const v4u vf = *(const GAS v4u*)(VF + o);
                            const float f[8] = {bflo(vf.x), bfhi(vf.x), bflo(vf.y), bfhi(vf.y), bflo(vf.z), bfhi(vf.z), bflo(vf.w), bfhi(vf.w)};
#pragma unroll
                            for (int j = 0; j < 8; ++j) vv[j] += (f[j] - vv[j]) * sigmoidf_((j < 4 ? v00[j & 3] : v01[j & 3]) + avr[2 * p + (j >> 2)][j & 3]); }
                        *(GAS v4u*)(VO + o) = (v4u){pk2(vv[0], vv[1]), pk2(vv[2], vv[3]), pk2(vv[4], vv[5]), pk2(vv[6], vv[7])}; }
                }
            }
        }
#undef E1_WROW
        __syncthreads();
    }
}

constexpr size_t CS_AR = WS_ACT, CS_BK = WS_ACT + 128 * MiB, CS_Y0 = WS_ACT + 256 * MiB, CS_GL = WS_ACT + 320 * MiB;
__device__ __forceinline__ int cs_perm(int k) { return (k & 32) + 8 * ((k >> 2) & 3) + 4 * ((k >> 4) & 1) + (k & 3); }
__device__ __forceinline__ f32x4 mm16_ll(const LAS float* A, const LAS float* B, f32x4 c, int fr, int fq) {
    const f32x4 a4 = *(const LAS f32x4*)(A + fr * 16 + 4 * fq);
#pragma unroll
    for (int s = 0; s < 4; ++s) c = __builtin_amdgcn_mfma_f32_16x16x4f32(a4[s], B[(4 * fq + s) * 16 + fr], c, 0, 0, 0);
    return c;
}
__device__ __forceinline__ f32x4 mm16_la(const LAS float* A, const f32x4 b, f32x4 c, int fr, int fq) {
    const f32x4 a4 = *(const LAS f32x4*)(A + fr * 16 + 4 * fq);
#pragma unroll
    for (int s = 0; s < 4; ++s) c = __builtin_amdgcn_mfma_f32_16x16x4f32(a4[s], b[s], c, 0, 0, 0);
    return c;
}
__device__ __forceinline__ void st16(LAS float* Mx, const f32x4 c, int fr, int fq) {
#pragma unroll
    for (int r = 0; r < 4; ++r) Mx[(4 * fq + r) * 16 + fr] = c[r];
}
__device__ __forceinline__ void scanpre_phase(const Args& a, int li, LAS unsigned char* ldsb, int vcu, int G, int tid) {
    unsigned char* ws = a.ws;
    const bf16* Rr = (const bf16*)(ws + SC_R); const bf16* K2 = (const bf16*)(ws + SC_K2); const bf16* KK = (const bf16*)(ws + SC_KK); const bf16* BB = (const bf16*)(ws + SC_BB); const bf16* LW = (const bf16*)(ws + SC_LW);
    const bf16* V = (const bf16*)(ws + (li ? WS_V2 : WS_VF));
    bf16* ARo = (bf16*)(ws + CS_AR); bf16* BKo = (bf16*)(ws + CS_BK); bf16* Y0o = (bf16*)(ws + CS_Y0); float* GLo = (float*)(ws + CS_GL); bf16* U0o = (bf16*)(ws + WS_U0);
    const int lane = tid & 63, wave = tid >> 6, fr = lane & 15, fq = lane >> 4;
    LAS unsigned char* wl = ldsb + wave * 17408;
    LAS bf16* LAR = (LAS bf16*)wl; LAS bf16* LBK = (LAS bf16*)(wl + 4608); LAS float* LM = (LAS float*)(wl + 9216); LAS float* LX = (LAS float*)(wl + 13312);
    const LAS float* Mab = LM, *Mak = LM + 256, *Mrb = LM + 512, *Mrk = LM + 768;
    LAS float* Tm = LX, *Na = LX + 256, *Nb = LX + 512;
    for (int ch = vcu * NWAVES + wave; ch < 32 * 1024; ch += G * NWAVES) {
        const int bh = ch >> 10, ci = ch & 1023, b = bh >> 4, h = bh & 15; const size_t row0 = (size_t)b * T + 16 * ci;
        f32x4 At[4], Rt[4], vv[4]; float glane;
#pragma unroll
        for (int nt = 0; nt < 4; ++nt) { f32x4 lw, kk, bb, k2, rr;
#pragma unroll
            for (int s = 0; s < 4; ++s) { const size_t o = (row0 + 4 * fq + s) * 1024 + h * 64 + 16 * nt + fr;
                lw[s] = bf2f(LW[o]); kk[s] = bf2f(KK[o]); bb[s] = bf2f(BB[o]); k2[s] = bf2f(K2[o]); rr[s] = bf2f(Rr[o]); vv[nt][s] = bf2f(V[o]); }
            f32x4 cum; cum[0] = lw[0]; cum[1] = cum[0] + lw[1]; cum[2] = cum[1] + lw[2]; cum[3] = cum[2] + lw[3];
            float x = cum[3]; { const float y = __shfl_up(x, 16); if (fq >= 1) x += y; } { const float y = __shfl_up(x, 32); if (fq >= 2) x += y; }
            const float excl = x - cum[3]; const float cl = __shfl(x, 48 + fr);
            bf16* bo = BKo + (size_t)ch * 2048 + (16 * nt + fr) * 32 + 8 * fq; f32x4 bh4, kh4;
#pragma unroll
            for (int s = 0; s < 4; ++s) { const float c = excl + cum[s]; const float g = __expf(c), gp = __expf(c - lw[s]), gi = __expf(-c), e = __expf(cl - c);
                At[nt][s] = -kk[s] * gp; Rt[nt][s] = rr[s] * g; bh4[s] = bb[s] * e; kh4[s] = k2[s] * e;
                const int t = 4 * fq + s, cc = 16 * nt + fr;
                LAR[t * 72 + cc] = (bf16)f2bf(At[nt][s]); LAR[(16 + t) * 72 + cc] = (bf16)f2bf(Rt[nt][s]); LBK[t * 72 + cc] = (bf16)f2bf(bb[s] * gi); LBK[(16 + t) * 72 + cc] = (bf16)f2bf(k2[s] * gi); }
            *(GAS v4u*)bo = (v4u){pk2(bh4[0], bh4[1]), pk2(bh4[2], bh4[3]), pk2(kh4[0], kh4[1]), pk2(kh4[2], kh4[3])};
            if (fq == 0) GLo[(size_t)ch * 64 + 16 * nt + fr] = __expf(cl);
            glane = cl; }
        (void)glane;
        LDS_WAIT(); asm volatile("" ::: "memory");
#pragma unroll
        for (int mt = 0; mt < 2; ++mt)
#pragma unroll
            for (int nt = 0; nt < 2; ++nt) { f32x4 m = {0.f, 0.f, 0.f, 0.f};
#pragma unroll
                for (int ks = 0; ks < 2; ++ks) { const bf16x8_t af = *(const LAS bf16x8_t*)(LAR + (16 * mt + fr) * 72 + 32 * ks + 8 * fq), bfr = *(const LAS bf16x8_t*)(LBK + (16 * nt + fr) * 72 + 32 * ks + 8 * fq);
                    m = __builtin_amdgcn_mfma_f32_16x16x32_bf16(af, bfr, m, 0, 0, 0); }
#pragma unroll
                for (int r = 0; r < 4; ++r) { const int t = 4 * fq + r; const bool keep = mt ? (fr <= t) : (fr < t); LM[((mt * 2 + nt) * 16 + t) * 16 + fr] = keep ? m[r] : 0.f; } }
        LDS_WAIT(); asm volatile("" ::: "memory");
        { const f32x4 z = {0.f, 0.f, 0.f, 0.f};
          f32x4 t1;
#pragma unroll
          for (int r = 0; r < 4; ++r) t1[r] = Mab[(4 * fq + r) * 16 + fr] + ((4 * fq + r) == fr ? 1.0f : 0.f);
          st16(Tm, t1, fr, fq);
          f32x4 n2 = mm16_ll(Mab, Mab, z, fr, fq); st16(Na, n2, fr, fq);
          LDS_WAIT(); asm volatile("" ::: "memory");
          f32x4 t2 = mm16_ll(Tm, Na, t1, fr, fq);
          f32x4 n4 = mm16_ll(Na, Na, z, fr, fq);
          LDS_WAIT(); asm volatile("" ::: "memory");
          st16(Tm, t2, fr, fq); st16(Nb, n4, fr, fq);
          LDS_WAIT(); asm volatile("" ::: "memory");
          f32x4 t3 = mm16_ll(Tm, Nb, t2, fr, fq);
          f32x4 n8 = mm16_ll(Nb, Nb, z, fr, fq);
          LDS_WAIT(); asm volatile("" ::: "memory");
          st16(Tm, t3, fr, fq); st16(Na, n8, fr, fq);
          LDS_WAIT(); asm volatile("" ::: "memory");
          f32x4 t4 = mm16_ll(Tm, Na, t3, fr, fq);
          LDS_WAIT(); asm volatile("" ::: "memory");
          st16(Tm, t4, fr, fq);
          LDS_WAIT(); asm volatile("" ::: "memory"); }
#pragma unroll
        for (int nt = 0; nt < 4; ++nt) { const f32x4 z = {0.f, 0.f, 0.f, 0.f};
            const f32x4 w1 = mm16_la(Mak, vv[nt], z, fr, fq);
            const f32x4 u0 = mm16_la(Tm, w1, z, fr, fq);
            const f32x4 ah = mm16_la(Tm, At[nt], z, fr, fq);
            const f32x4 rh = mm16_la(Mrb, ah, Rt[nt], fr, fq);
            f32x4 y0 = mm16_la(Mrb, u0, z, fr, fq); y0 = mm16_la(Mrk, vv[nt], y0, fr, fq);
            const int k = 16 * nt + fr; bf16* arp = ARo + (size_t)ch * 2048 + cs_perm(k);
#pragma unroll
            for (int s = 0; s < 4; ++s) { arp[(4 * fq + s) * 64] = (bf16)f2bf(ah[s]); arp[(16 + 4 * fq + s) * 64] = (bf16)f2bf(rh[s]); }
            *(GAS v2u*)(Y0o + (size_t)ch * 1024 + k * 16 + 4 * fq) = pack4(y0[0], y0[1], y0[2], y0[3]);
            *(GAS v2u*)(U0o + (size_t)ch * 1024 + k * 16 + 4 * fq) = pack4(u0[0], u0[1], u0[2], u0[3]); }
        LDS_WAIT(); asm volatile("" ::: "memory");
    }
}
#ifndef PF_ON
#define PF_ON 0
#endif
constexpr int CQ_NS = 13, CQ_SLOT = 10240, CQ_FULL = CQ_NS * CQ_SLOT, CQ_DONE = CQ_FULL + 64, CQ_NL = 6;
#define CQ_GLDS(src, dst) __builtin_amdgcn_global_load_lds((const unsigned*)(src), (LAS unsigned*)(dst), 16, 0, 0)
typedef unsigned short u16x2_t __attribute__((ext_vector_type(2)));
struct CqOps { bf16x8_t ar[2][2], bk[4]; f32x4 gl[4]; v2u u0, y0; u16x2_t v01, v23; f32x4 u0f, y0f; };
__device__ __forceinline__ void cq_load(CqOps& o, LAS unsigned char* sl, int fr, int fq) {
#pragma unroll
    for (int mt = 0; mt < 2; ++mt)
#pragma unroll
        for (int ks = 0; ks < 2; ++ks) { const int r = 16 * mt + fr; o.ar[mt][ks] = *(const LAS bf16x8_t*)(sl + r * 128 + 16 * ((4 * ks + fq) ^ (r & 7))); }
#pragma unroll
    for (int kt = 0; kt < 4; ++kt) { const int k = 16 * kt + fr; o.bk[kt] = *(const LAS bf16x8_t*)(sl + 4096 + k * 64 + 16 * (fq ^ ((k >> 2) & 3))); o.gl[kt] = *(const LAS f32x4*)(sl + 9728 + (16 * kt + 4 * fq) * 4); }
    o.u0 = *(const LAS v2u*)(sl + 8192 + fr * 32 + 8 * fq); o.y0 = *(const LAS v2u*)(sl + 8704 + fr * 32 + 8 * fq);
    const LAS unsigned short* vp = (const LAS unsigned short*)(sl + 9216 + (4 * fq) * 32 + 2 * fr);
    o.v01.x = vp[0]; o.v01.y = vp[16]; o.v23.x = vp[32]; o.v23.y = vp[48];
}
__device__ __forceinline__ void cq_unpack(CqOps& o) {
    o.u0f = (f32x4){bflo(o.u0.x), bfhi(o.u0.x), bflo(o.u0.y), bfhi(o.u0.y)}; o.y0f = (f32x4){bflo(o.y0.x), bfhi(o.y0.x), bflo(o.y0.y), bfhi(o.y0.y)};
}
__device__ __forceinline__ void cq_step(const CqOps& cur, CqOps& nxt, f32x4 (&St)[4], LAS unsigned char* ldsb, int sn, int cn, volatile LAS unsigned* DONE, unsigned long long ya, unsigned long long yb, unsigned yvoff,
                                        int fr, int fq, bool signal, unsigned& spins) {
    volatile LAS unsigned* fp = (volatile LAS unsigned*)(ldsb + CQ_FULL) + sn; LAS unsigned char* sln = ldsb + sn * CQ_SLOT;
    unsigned fl = *fp;
    v4u w0; w0.x = pk2(St[0][0], St[0][1]); w0.y = pk2(St[0][2], St[0][3]); w0.z = pk2(St[1][0], St[1][1]); w0.w = pk2(St[1][2], St[1][3]); const bf16x8_t sb0 = __builtin_bit_cast(bf16x8_t, w0);
    f32x4 au = __builtin_amdgcn_mfma_f32_16x16x32_bf16(cur.ar[0][0], sb0, cur.u0f, 0, 0, 0);
    v4u w1; w1.x = pk2(St[2][0], St[2][1]); w1.y = pk2(St[2][2], St[2][3]); w1.z = pk2(St[3][0], St[3][1]); w1.w = pk2(St[3][2], St[3][3]); const bf16x8_t sb1 = __builtin_bit_cast(bf16x8_t, w1);
    f32x4 ay = __builtin_amdgcn_mfma_f32_16x16x32_bf16(cur.ar[1][0], sb0, cur.y0f, 0, 0, 0);
#define CQ_DECAY(kt) ({ float g0_ = cur.gl[kt][0], g1_ = cur.gl[kt][1], g2_ = cur.gl[kt][2], g3_ = cur.gl[kt][3]; asm("" : "+v"(g0_)); asm("" : "+v"(g1_)); asm("" : "+v"(g2_)); asm("" : "+v"(g3_)); \
                        (f32x4){St[kt][0] * g0_, St[kt][1] * g1_, St[kt][2] * g2_, St[kt][3] * g3_}; })
    f32x4 Sg[4]; Sg[0] = CQ_DECAY(0); Sg[1] = CQ_DECAY(1);
    au = __builtin_amdgcn_mfma_f32_16x16x32_bf16(cur.ar[0][1], sb1, au, 0, 0, 0);
    Sg[2] = CQ_DECAY(2); Sg[3] = CQ_DECAY(3);
#undef CQ_DECAY
    ay = __builtin_amdgcn_mfma_f32_16x16x32_bf16(cur.ar[1][1], sb1, ay, 0, 0, 0);
    __builtin_amdgcn_sched_barrier(0);
    while (__builtin_amdgcn_ballot_w64(fl != (unsigned)(cn + 1)) != 0ull) { fl = *fp; if (++spins > (1u << 26)) break; }
    __builtin_amdgcn_fence(__ATOMIC_ACQUIRE, "workgroup");
    cq_load(nxt, sln, fr, fq);
    __builtin_amdgcn_sched_barrier(0);
    v4u uw; uw.x = pk2(au[0], au[1]); uw.y = pk2(au[2], au[3]); uw.z = __builtin_bit_cast(unsigned, cur.v01); uw.w = __builtin_bit_cast(unsigned, cur.v23);
    const bf16x8_t uv = __builtin_bit_cast(bf16x8_t, uw);
#pragma unroll
    for (int kt = 0; kt < 4; ++kt) St[kt] = __builtin_amdgcn_mfma_f32_16x16x32_bf16(cur.bk[kt], uv, Sg[kt], 0, 0, 0);
    asm volatile("global_store_dword %0, %1, %2 offset:-4096" :: "v"(yvoff), "v"(ay[0]), "s"(ya) : "memory");
    asm volatile("global_store_dword %0, %1, %2" :: "v"(yvoff), "v"(ay[1]), "s"(ya) : "memory");
    asm volatile("global_store_dword %0, %1, %2 offset:-4096" :: "v"(yvoff), "v"(ay[2]), "s"(yb) : "memory");
    asm volatile("global_store_dword %0, %1, %2" :: "v"(yvoff), "v"(ay[3]), "s"(yb) : "memory");
    __builtin_amdgcn_s_waitcnt(0xC07F);
    cq_unpack(nxt);
    if (signal && fr + fq == 0) DONE[0] = (unsigned)(cn + 1);
}
__device__ __forceinline__ void scanseq_phase(const Args& a, int li, LAS unsigned char* ldsb, int vcu, int tid) {
    volatile LAS unsigned* FULL = (volatile LAS unsigned*)(ldsb + CQ_FULL); volatile LAS unsigned* DONE = (volatile LAS unsigned*)(ldsb + CQ_DONE);
    if (tid < 32) ((LAS unsigned*)(ldsb + CQ_FULL))[tid] = 0u;
    __syncthreads();
    const int wave = __builtin_amdgcn_readfirstlane(tid >> 6), lane = tid & 63;
    if (vcu < 128 && wave <= CQ_NL) {
        unsigned char* ws = a.ws;
        const int bh = vcu >> 2, vb = vcu & 3, b = bh >> 4, h = bh & 15; const size_t row0 = (size_t)b * T; const size_t ch0 = (size_t)bh * 1024;
        if (wave > 0) {
            const unsigned char* ARo = ws + CS_AR; const unsigned char* BKo = ws + CS_BK; const unsigned char* Y0o = ws + CS_Y0; const unsigned char* GLo = ws + CS_GL; const unsigned char* U0o = ws + WS_U0;
            const unsigned char* V = ws + (li ? WS_V2 : WS_VF);
            const unsigned oAR = (unsigned)((lane >> 3) * 128 + 16 * ((lane & 7) ^ ((lane >> 3) & 7)));
            unsigned oBK[4];
#pragma unroll
            for (int i = 0; i < 4; ++i) { const int k = 16 * i + (lane >> 2); oBK[i] = (unsigned)(k * 64 + 16 * ((lane & 3) ^ ((k >> 2) & 3))); }
            const unsigned oUY = (unsigned)((16 * vb + ((lane & 31) >> 1)) * 32 + 16 * (lane & 1));
            const size_t oV = ((size_t)(lane >> 1) * 1024 + h * 64 + 16 * vb) * 2 + 16 * (lane & 1);
            const unsigned oG = (unsigned)(16 * (lane & 15));
            int pub = wave - 1; unsigned spins = 0;
            for (int c = wave - 1; c < 1024; c += CQ_NL) {
                const int s = c % CQ_NS;
                if (c >= CQ_NS) { while ((int)DONE[0] < c - CQ_NS + 1) { __builtin_amdgcn_s_sleep(1); if (++spins > (1u << 24)) break; } }
                LAS unsigned char* sl = ldsb + s * CQ_SLOT; const size_t ch = ch0 + c;
                const unsigned char* ar = ARo + ch * 4096; const unsigned char* bk = BKo + ch * 4096;
#pragma unroll
                for (int i = 0; i < 4; ++i) CQ_GLDS(ar + i * 1024 + oAR, sl + i * 1024);
#pragma unroll
                for (int i = 0; i < 4; ++i) CQ_GLDS(bk + oBK[i], sl + 4096 + i * 1024);
                CQ_GLDS((lane < 32 ? U0o : Y0o) + ch * 2048 + oUY, sl + 8192);
                CQ_GLDS(lane < 32 ? V + (row0 + 16 * (size_t)c) * 2048 + oV : GLo + ch * 256 + oG, sl + 9216);
                asm volatile("s_waitcnt vmcnt(10)" ::: "memory");
                for (; pub <= c - CQ_NL; pub += CQ_NL) FULL[pub % CQ_NS] = (unsigned)(pub + 1);
            }
            asm volatile("s_waitcnt vmcnt(0)" ::: "memory");
            for (; pub < 1024; pub += CQ_NL) FULL[pub % CQ_NS] = (unsigned)(pub + 1);
        } else {
            float* Y = a.out;
            const int fr = lane & 15, fq = lane >> 4; const int colv = h * 64 + 16 * vb + fr;
            f32x4 St[4];
#pragma unroll
            for (int kt = 0; kt < 4; ++kt) St[kt] = (f32x4){0.f, 0.f, 0.f, 0.f};
            unsigned spins = 0;
            CqOps oa, ob;
            while (FULL[0] != 1u) { if (++spins > (1u << 26)) break; }
            __builtin_amdgcn_fence(__ATOMIC_ACQUIRE, "workgroup");
            cq_load(oa, ldsb, fr, fq);
            __builtin_amdgcn_s_waitcnt(0xC07F);
            cq_unpack(oa);
            if (lane == 0) DONE[0] = 1u;
            const unsigned yvoff = (unsigned)((4 * fq * 1024 + colv) * 4);
            unsigned long long yc = (unsigned long long)(size_t)(Y + row0 * 1024);
            int sn = 1;
#ifdef PROBE_STAMP
            const unsigned long long pc0_ = __builtin_readcyclecounter(), pr0_ = __builtin_amdgcn_s_memrealtime();
#endif
            for (int c = 0; c < 1024; c += 2) {
                cq_step(oa, ob, St, ldsb, sn, c + 1, DONE, yc + 4096, yc + 12288, yvoff, fr, fq, false, spins);
                yc += 65536; sn = (sn + 1 == CQ_NS) ? 0 : sn + 1;
                const bool lastc = (c + 2 >= 1024);
                const int sn2 = lastc ? sn - 1 < 0 ? CQ_NS - 1 : sn - 1 : sn, cn2 = lastc ? 1023 : c + 2;
                cq_step(ob, oa, St, ldsb, sn2, cn2, DONE, yc + 4096, yc + 12288, yvoff, fr, fq, true, spins);
                yc += 65536; sn = (sn + 1 == CQ_NS) ? 0 : sn + 1;
            }
#ifdef PROBE_STAMP
            { const unsigned long long pc1_ = __builtin_readcyclecounter(), pr1_ = __builtin_amdgcn_s_memrealtime();
              if (lane == 0 && vcu == 5) *((volatile unsigned*)(ws + WS_CTL) + 24576 + 200 + li) = (unsigned)((pc1_ - pc0_) * 100ull / (pr1_ - pr0_)); }
            if (lane == 0) atomicAdd((unsigned*)(ws + WS_CTL) + 24576 + (vcu & 127), spins);
#endif
        }
    }
    if (PF_ON && vcu >= 128 && vcu < 256) {
        unsigned char* ws = a.ws; const int pv = vcu - 128; const int bh = pv >> 2, vb = pv & 3, b = bh >> 4, h = bh & 15; const size_t row0 = (size_t)b * T; const size_t ch0 = (size_t)bh * 1024;
        const unsigned char* ARo = ws + CS_AR; const unsigned char* BKo = ws + CS_BK; const unsigned char* Y0o = ws + CS_Y0; const unsigned char* GLo = ws + CS_GL; const unsigned char* U0o = ws + WS_U0;
        const unsigned char* V = ws + (li ? WS_V2 : WS_VF);
        unsigned x = 0u;
        for (int c0 = wave * 4; c0 < 1024; c0 += 32) {
            unsigned t[8];
#pragma unroll
            for (int j = 0; j < 4; ++j) { const int c = c0 + j; const size_t ch = ch0 + c;
                const unsigned char* p0 = lane < 32 ? ARo + ch * 4096 + lane * 128 : BKo + ch * 4096 + (lane - 32) * 128;
                const unsigned char* p1 = lane < 4 ? U0o + ch * 2048 + 512 * vb + lane * 128 : lane < 8 ? Y0o + ch * 2048 + 512 * vb + (lane - 4) * 128
                                        : lane < 24 ? V + ((row0 + 16 * (size_t)c + (lane - 8)) * 1024 + h * 64 + 16 * vb) * 2 : GLo + ch * 256 + (lane & 1) * 128;
                t[2 * j] = *(const volatile GAS unsigned*)p0; t[2 * j + 1] = *(const volatile GAS unsigned*)p1; }
#pragma unroll
            for (int j = 0; j < 8; ++j) x ^= t[j];
        }
        if (x == 0x9e3779b9u && li == 77) *(volatile GAS unsigned*)(ws + WS_CTL + 65536) = x;
    }
    __syncthreads();
}

typedef float f32x16 __attribute__((ext_vector_type(16)));
constexpr int AT_K = 0, AT_V = 36864;
__device__ __forceinline__ bf16x8_t tr_frag(unsigned addr) {
    v2u lo, hi; asm volatile("ds_read_b64_tr_b16 %0, %2\n\tds_read_b64_tr_b16 %1, %2 offset:1536\n\ts_waitcnt lgkmcnt(0)" : "=&v"(lo), "=&v"(hi) : "v"(addr) : "memory");
    v4u w; w.x = lo.x; w.y = lo.y; w.z = hi.x; w.w = hi.y; return __builtin_bit_cast(bf16x8_t, w);
}
__device__ __forceinline__ void attn_unit(const Args& a, int li, int au, LAS unsigned char* ldsb, int tid) {
    unsigned char* ws = a.ws; const bf16* Z = (const bf16*)(ws + WS_ACT); bf16* O = (bf16*)(ws + WS_O);
    const int n = au & 127, kvh = (au >> 7) & 3, b = au >> 9;
    const size_t rblk = (size_t)b * T + (size_t)n * 128;
    for (int e = tid; e < 256 * 8 * 2; e += NTHR) { const int which = e >> 11, rem = e & 2047, j = rem >> 3, c8 = rem & 7; const bool valid = (n > 0) || (j >= 128);
        v4u w = {0u, 0u, 0u, 0u}; if (valid) w = *(const GAS v4u*)(Z + (rblk + j - 128) * ZN + 1024 + which * 256 + kvh * 64 + 8 * c8);
        *(LAS v4u*)(ldsb + (which ? AT_V + j * 192 : AT_K + j * 144) + c8 * 16) = w; }
    __syncthreads();
    const int lane = tid & 63, wave = tid >> 6, l31 = lane & 31, h = lane >> 5;
    const unsigned ldsbase = (unsigned)(size_t)ldsb;
#pragma unroll 1
    for (int it = 0; it < 2; ++it) {
        const int tt = 2 * wave + it, g = tt >> 2, qi = tt & 3, hq = kvh * 4 + g; const size_t qrow = rblk + 32 * qi + l31;
        bf16x8_t qf[4];
#pragma unroll
        for (int ks = 0; ks < 4; ++ks) qf[ks] = *(const GAS bf16x8_t*)(Z + qrow * ZN + hq * 64 + 16 * ks + 8 * h);
        f32x16 st[5];
#pragma unroll
        for (int kt = 0; kt < 5; ++kt) {
#pragma unroll
            for (int r = 0; r < 16; ++r) st[kt][r] = 0.f;
#pragma unroll
            for (int ks = 0; ks < 4; ++ks) { const bf16x8_t kf = *(const LAS bf16x8_t*)(ldsb + AT_K + (32 * (qi + kt) + l31) * 144 + (16 * ks + 8 * h) * 2);
                st[kt] = __builtin_amdgcn_mfma_f32_32x32x16_bf16(kf, qf[ks], st[kt], 0, 0, 0); } }
        const float slope = exp2f(-0.5f * (float)(hq + 1)); const float sink = a.in[I_ESINK][li * 16 + hq];
        float mx = sink;
#pragma unroll
        for (int kt = 0; kt < 5; ++kt)
#pragma unroll
            for (int r = 0; r < 16; ++r) { const int j = 32 * (qi + kt) + (r & 3) + 8 * (r >> 2) + 4 * h; const int dist = 32 * qi + l31 + 128 - j;
                const bool ok = (dist >= 0) && (dist < 128) && ((n > 0) || (j >= 128));
                const float s = ok ? st[kt][r] * 0.125f - slope * (float)dist : -INFINITY; st[kt][r] = s; mx = fmaxf(mx, s); }
        mx = fmaxf(mx, __shfl_xor(mx, 32));
        float l = 0.f;
#pragma unroll
        for (int kt = 0; kt < 5; ++kt)
#pragma unroll
            for (int r = 0; r < 16; ++r) { const float p = __expf(st[kt][r] - mx); st[kt][r] = p; l += p; }
        l += __shfl_xor(l, 32); l += __expf(sink - mx);
        f32x16 ot[2];
#pragma unroll
        for (int r = 0; r < 16; ++r) { ot[0][r] = 0.f; ot[1][r] = 0.f; }
#pragma unroll
        for (int kt = 0; kt < 5; ++kt)
#pragma unroll
            for (int s2 = 0; s2 < 2; ++s2) {
                v4u pw; pw.x = pk2(st[kt][8 * s2 + 0], st[kt][8 * s2 + 1]); pw.y = pk2(st[kt][8 * s2 + 2], st[kt][8 * s2 + 3]); pw.z = pk2(st[kt][8 * s2 + 4], st[kt][8 * s2 + 5]); pw.w = pk2(st[kt][8 * s2 + 6], st[kt][8 * s2 + 7]);
                const bf16x8_t pf = __builtin_bit_cast(bf16x8_t, pw);
#pragma unroll
                for (int db = 0; db < 2; ++db) {
                    const unsigned va = ldsbase + AT_V + (unsigned)(32 * (qi + kt) + 16 * s2 + 4 * h + ((lane & 15) >> 2)) * 192u + (unsigned)(32 * db + 16 * ((lane >> 4) & 1) + 4 * (lane & 3)) * 2u;
                    const bf16x8_t vf = tr_frag(va);
                    ot[db] = __builtin_amdgcn_mfma_f32_32x32x16_bf16(vf, pf, ot[db], 0, 0, 0); } }
        const float inv = 1.0f / l;
#pragma unroll
        for (int db = 0; db < 2; ++db)
#pragma unroll
            for (int g4 = 0; g4 < 4; ++g4)
                *(GAS v2u*)(O + qrow * D + 1024 + hq * 64 + 32 * db + 8 * g4 + 4 * h) = pack4(ot[db][4 * g4] * inv, ot[db][4 * g4 + 1] * inv, ot[db][4 * g4 + 2] * inv, ot[db][4 * g4 + 3] * inv);
    }
    __syncthreads();
}

__device__ __forceinline__ void e3_phase(const Args& a, int li, int vcu, int G, int tid) {
    unsigned char* ws = a.ws; const float* Y = a.out;
    const bf16* R = (const bf16*)(ws + SC_R); const bf16* K2 = (const bf16*)(ws + SC_K2); const bf16* GG = (const bf16*)(ws + SC_GG); const bf16* V = (const bf16*)(ws + (li ? WS_V2 : WS_VF));
    bf16* O = (bf16*)(ws + WS_O);
    const float* rk = a.in[I_ERK] + li * 1024; const float* gng = a.in[I_EGNG] + li * 1024; const float* gnb = a.in[I_EGNB] + li * 1024;
    for (size_t e4 = (size_t)vcu * NTHR + tid; e4 < (size_t)M * 256; e4 += (size_t)G * NTHR) {
        const size_t row = e4 >> 8; const int c = (int)(e4 & 255) * 4; const size_t e = row * 1024 + c;
        const f32x4 y = *(const GAS f32x4*)(Y + e);
        const v2u rw = *(const GAS v2u*)(R + e), kw = *(const GAS v2u*)(K2 + e), vw = *(const GAS v2u*)(V + e), gw = *(const GAS v2u*)(GG + e);
        const f32x4 rkv = *(const f32x4*)(rk + c), ggv = *(const f32x4*)(gng + c), gbv = *(const f32x4*)(gnb + c);
        const float mean = row16_sum((y.x + y.y) + (y.z + y.w)) * (1.0f / 64.0f);
        const f32x4 d = y - mean;
        const float var = row16_sum((d.x * d.x + d.y * d.y) + (d.z * d.z + d.w * d.w)) * (1.0f / 64.0f);
        const float rs = rsqrtf(var + 64e-5f);
        const float r0 = bflo(rw.x), r1 = bfhi(rw.x), r2 = bflo(rw.y), r3 = bfhi(rw.y), k0 = bflo(kw.x), k1 = bfhi(kw.x), k2 = bflo(kw.y), k3 = bfhi(kw.y);
        const float bonus = row16_sum((r0 * k0 * rkv.x + r1 * k1 * rkv.y) + (r2 * k2 * rkv.z + r3 * k3 * rkv.w));
        const float o0 = (d.x * rs * ggv.x + gbv.x + bonus * bflo(vw.x)) * bflo(gw.x), o1 = (d.y * rs * ggv.y + gbv.y + bonus * bfhi(vw.x)) * bfhi(gw.x);
        const float o2 = (d.z * rs * ggv.z + gbv.z + bonus * bflo(vw.y)) * bflo(gw.y), o3 = (d.w * rs * ggv.w + gbv.w + bonus * bfhi(vw.y)) * bfhi(gw.y);
        *(GAS v2u*)(O + row * D + c) = pack4(o0, o1, o2, o3);
    }
}

constexpr int SG_W = 0, SG_V = 34816, SG_RS = 34816 + 32768;
__device__ __forceinline__ unsigned sg_off(unsigned row, unsigned ch) { return 256u * row + 16u * (ch ^ (((row & 3u) << 2) | ((row >> 2) & 3u))); }
__device__ __forceinline__ bf16x8_t tr_frag2(unsigned a0, unsigned a1) {
    v2u lo, hi; asm volatile("ds_read_b64_tr_b16 %0, %2\n\tds_read_b64_tr_b16 %1, %3\n\ts_waitcnt lgkmcnt(0)" : "=&v"(lo), "=&v"(hi) : "v"(a0), "v"(a1) : "memory");
    v4u w; w.x = lo.x; w.y = lo.y; w.z = hi.x; w.w = hi.y; return __builtin_bit_cast(bf16x8_t, w);
}
__device__ __forceinline__ void sgu_phase(const Args& a, int li, LAS unsigned char* ldsb, int vcu, int G, int tid) {
    unsigned char* ws = a.ws; const bf16* Z = (const bf16*)(ws + WS_ACT); bf16* O = (bf16*)(ws + WS_O);
    const float* ssv = (const float*)(ws + WS_SS) + (size_t)(13 + li) * SS_REC;
    const bf16* WSB = (const bf16*)(ws + SM_WSB); const float* bs = a.in[I_OBS] + li * 16 * 128; const float* vng = a.in[I_OVNG] + li * D;
    const int lane = tid & 63, wave = tid >> 6, fr = lane & 15, fq = lane >> 4;
    const unsigned ldsbase = (unsigned)(size_t)ldsb;
    int gcur = -1;
    for (int u = vcu; u < 4096; u += G) {
        const int g = u & 15, bn = u >> 4; const size_t m0 = (size_t)bn * 128;
        __syncthreads();
        if (g != gcur) { gcur = g;
            for (int e = tid; e < 128 * 16; e += NTHR) { const int i = e >> 4, ch = e & 15; *(LAS v4u*)(ldsb + SG_W + i * 272 + ch * 16) = *(const GAS v4u*)(WSB + ((size_t)g * 128 + i) * 128 + 8 * ch); } }
        v4u wv[4];
#pragma unroll
        for (int it = 0; it < 4; ++it) { const int e = tid + it * NTHR, j = e >> 4, ch = e & 15; wv[it] = *(const GAS v4u*)(Z + (m0 + j) * ZO + 2048 + g * 128 + 8 * ch); }
        if (tid < 128) *(LAS float*)(ldsb + SG_RS + tid * 4) = pg8::row_rs(ssv, (int)(m0 + tid));
        __syncthreads();
#pragma unroll
        for (int it = 0; it < 4; ++it) { const int e = tid + it * NTHR, j = e >> 4, ch = e & 15; const float rs = *(const LAS float*)(ldsb + SG_RS + j * 4);
            const v4u w = wv[it]; v4u o;
            o.x = pk2(bflo(w.x) * rs, bfhi(w.x) * rs); o.y = pk2(bflo(w.y) * rs, bfhi(w.y) * rs); o.z = pk2(bflo(w.z) * rs, bfhi(w.z) * rs); o.w = pk2(bflo(w.w) * rs, bfhi(w.w) * rs);
            *(LAS v4u*)(ldsb + SG_V + sg_off((unsigned)j, (unsigned)ch)) = o; }
        __syncthreads();
        bf16x8_t vf[4];
        { const unsigned q = (unsigned)(lane & 15) >> 2, p = (unsigned)lane & 3u;
#pragma unroll
          for (int ks = 0; ks < 4; ++ks) { const unsigned r0 = 32u * ks + 8u * fq + q;
              vf[ks] = tr_frag2(ldsbase + SG_V + sg_off(r0, 2u * wave + (p >> 1)) + 8u * (p & 1u), ldsbase + SG_V + sg_off(r0 + 4u, 2u * wave + (p >> 1)) + 8u * (p & 1u)); } }
        const int cc = g * 128 + 16 * wave + 4 * fq; const f32x4 vg = *(const f32x4*)(vng + cc);
#pragma unroll
        for (int mt = 0; mt < 8; ++mt) {
            f32x4 acc = {0.f, 0.f, 0.f, 0.f};
#pragma unroll
            for (int ks = 0; ks <= (mt >> 1); ++ks) { const bf16x8_t wf = *(const LAS bf16x8_t*)(ldsb + SG_W + (16 * mt + fr) * 272 + (32 * ks + 8 * fq) * 2);
                acc = __builtin_amdgcn_mfma_f32_16x16x32_bf16(vf[ks], wf, acc, 0, 0, 0); }
            const int i = 16 * mt + fr; const float bi = bs[g * 128 + i];
            const v2u uw = *(const GAS v2u*)(Z + (m0 + i) * ZO + cc);
            *(GAS v2u*)(O + (m0 + i) * D + cc) = pack4(bflo(uw.x) * (vg.x * acc[0] + bi), bfhi(uw.x) * (vg.y * acc[1] + bi), bflo(uw.y) * (vg.z * acc[2] + bi), bfhi(uw.y) * (vg.w * acc[3] + bi));
        }
    }
    __syncthreads();
}

__device__ __forceinline__ void final_phase(const Args& a, int vcu, int G, int wave, int lane) {
    const int gw = vcu * NWAVES + wave, NGW = G * NWAVES; const float* ss = (const float*)(a.ws + WS_SS) + (size_t)12 * SS_REC; const float* fg = a.in[I_FG]; const bf16* XBp = (const bf16*)(a.ws + WS_XB);
    for (int m = gw; m < M; m += NGW) { const float rs = pg8::row_rs(ss, m);
        const GAS v4u* xr = (const GAS v4u*)(XBp + (size_t)m * D) + lane; GAS f32x4* orow = (GAS f32x4*)(a.out + (size_t)m * D) + 2 * lane; const GAS f32x4* gr = (const GAS f32x4*)fg + 2 * lane;
#pragma unroll
        for (int j = 0; j < 4; ++j) { const v4u w = xr[64 * j]; const f32x4 g0 = gr[128 * j], g1 = gr[128 * j + 1];
            orow[128 * j] = (f32x4){bflo(w.x) * rs * g0.x, bfhi(w.x) * rs * g0.y, bflo(w.y) * rs * g0.z, bfhi(w.y) * rs * g0.w};
            orow[128 * j + 1] = (f32x4){bflo(w.z) * rs * g1.x, bfhi(w.z) * rs * g1.y, bflo(w.w) * rs * g1.z, bfhi(w.w) * rs * g1.w}; } }
}

__global__ void __launch_bounds__(NTHR, 2) mk_fwd(Args args) {
    extern __shared__ __attribute__((aligned(16))) unsigned char lds_raw[];
    LAS unsigned char* lds = (LAS unsigned char*)lds_raw;
    const int tid = threadIdx.x, lane = tid & 63, wave = __builtin_amdgcn_readfirstlane(tid >> 6);
    const int G = gridDim.x, bx = blockIdx.x; const int vcu = (G % 8 == 0) ? (bx % 8) * (G / 8) + bx / 8 : bx;
    unsigned char* ws = args.ws; gu32* ctl = (gu32*)(ws + WS_CTL);
    for (int u = tid; u < (LDS_BYTES - LDSCTL_OFF) / 4; u += NTHR) ((LAS unsigned*)(lds + LDSCTL_OFF))[u] = 0u;
    __syncthreads();
    const int lo = args.ph_lo, hi = args.ph_hi;
    const bool multi = (hi - lo) > 1;
    XcdBarrier bar; bar.bar = (unsigned*)(ctl + CW_BAR); bar.x = 0; bar.st = nullptr;
    if (multi) bar = xcd_barrier_post((unsigned*)(ctl + CW_BAR), (volatile LAS unsigned*)(lds + LDSCTL_OFF));
#define IN(k) (lo <= (k) && (k) < hi)
#ifdef PROBE_STAMP
#define SEAM(k) do { if ((k) + 1 < hi) { if (tid == 0) bar.st[4] = ((((k) & 7) == 2 && (((k) / 24) & 1)) ? 7u : (unsigned)((k) & 7)); xcd_barrier(bar); } } while (0)
#else
#define SEAM(k) do { if ((k) + 1 < hi) xcd_barrier(bar); } while (0)
#endif
#ifndef DUP_G
#define DUP_G 1
#endif
#ifndef DUP_T
#define DUP_T 1
#endif
#ifndef DUP_GR
#define DUP_GR DUP_G
#endif
#ifndef DUP_G1
#define DUP_G1 DUP_G
#endif
#ifndef DUP_SP
#define DUP_SP DUP_S
#endif
#ifndef DUP_SQ
#define DUP_SQ DUP_S
#endif
#ifndef DUP_PREP
#define DUP_PREP DUP_T
#endif
#ifndef DUP_E1
#define DUP_E1 DUP_T
#endif
#ifndef DUP_SGU
#define DUP_SGU DUP_T
#endif
#ifndef DUP_E3
#define DUP_E3 DUP_T
#endif
#define REPN(n) for (int rep_ = 0; rep_ < (n); ++rep_)
#ifndef DUP_S
#define DUP_S 1
#endif
#define REPG for (int rep_ = 0; rep_ < DUP_G; ++rep_)
#define REPT for (int rep_ = 0; rep_ < DUP_T; ++rep_)
#define REPS for (int rep_ = 0; rep_ < DUP_S; ++rep_)
#define RSEAM(n) do { if (rep_ + 1 < (n)) xcd_barrier(bar); } while (0)
    float* ssb = (float*)(ws + WS_SS);
    bf16* XB = (bf16*)(ws + WS_XB); bf16* ACT = (bf16*)(ws + WS_ACT); bf16* OB = (bf16*)(ws + WS_O);

    for (int s = 0; s < NSUB; ++s) {
        const int pb = s * 8, L = s / 3, kind = s % 3, li = L >> 1; const bool even = !(L & 1);
        #ifndef NO_PREP
        if (kind == 0 && IN(pb + 0) && !(args.dbl && (L & 1))) { REPN(DUP_PREP) { const int t_ = opaque(tid); prep_phase(args, L, lds, vcu, G, __builtin_amdgcn_readfirstlane(t_ >> 6), t_ & 63, (L & 1) ? 2 : 0); RSEAM(DUP_PREP); } SEAM(pb + 0); }
#endif
        if (IN(pb + 1)) {
            const float* ss = ssb + (size_t)s * SS_REC;
            LAS float* RC = (LAS float*)(lds + 135168);
            if (tid == 0) *(LAS int*)(RC + 256) = -1;
            __syncthreads();
            if (kind != 1) {
                pg8::Gemm g{XB, (const bf16*)(ws + (kind == 0 ? WT_GU1 : (args.dbl && (L & 1)) ? WT2_GU2 : WT_GU2)), M, 2 * FF, D}; pg8::StaticOrder S; S.init(M, 2 * FF, G, bx);
                pg8::EpiSwiGLU E{ACT, FF, ss, RC};
#ifndef NO_G1
                REPN(DUP_G1) { pg8::gemm_phase<pg8::EpiSwiGLU, pg8::StaticOrder, true, true>(lds, g, S, E); RSEAM(DUP_G1); }
#endif
            } else if (even) {
                pg8::Gemm g{XB, (const bf16*)(ws + WT_IN), M, ZN, D}; pg8::StaticOrder S; S.init(M, ZN, G, bx);
                pg8::EpiZ E{ACT, ZN, ss, args.in[I_EBQKV] + li * 1536, RC};
#ifndef NO_GZ
                REPG { pg8::gemm_phase<pg8::EpiZ, pg8::StaticOrder, true, true>(lds, g, S, E); RSEAM(DUP_G); }
#endif
            } else {
                pg8::Gemm g{XB, (const bf16*)(ws + WT_IN), M, ZO, D}; pg8::StaticOrder S; S.init(M, ZO, G, bx);
                pg8::EpiGeluV E{ACT, ZO, ss, ssb + (size_t)(13 + li) * SS_REC, (LAS float*)(lds + 131072), RC};
#ifndef NO_GG
                REPG { pg8::gemm_phase<pg8::EpiGeluV, pg8::StaticOrder, true, true>(lds, g, S, E); RSEAM(DUP_G); }
#endif
            }
            SEAM(pb + 1);
        }
        if (kind == 1) {
            if (IN(pb + 2)) {
#ifndef NO_E1
                if (even) REPN(DUP_E1) { e1_phase(args, li, lds, vcu, G, opaque(tid)); RSEAM(DUP_E1); }
#endif
#ifndef NO_ATTN
                if (even) for (int au = vcu; au < 1024; au += G) attn_unit(args, li, au, lds, opaque(tid));
#endif
#ifndef NO_SGU
                if (!even) REPN(DUP_SGU) { sgu_phase(args, li, lds, vcu, G, opaque(tid)); RSEAM(DUP_SGU); }
#endif
                SEAM(pb + 2); }
#ifndef NO_SPRE
            if (even && IN(pb + 3)) { REPN(DUP_SP) { scanpre_phase(args, li, lds, vcu, G, opaque(tid)); RSEAM(DUP_SP); } SEAM(pb + 3); }
#endif
#ifndef NO_SSEQ
            if (even && IN(pb + 4)) { const int scu = (G == 256) ? (bx & 7) * 16 + (bx >> 3) + ((bx >> 3) < 16 ? 0 : 128 - 16) : vcu;
                REPN(DUP_SQ) { scanseq_phase(args, li, lds, scu, opaque(tid)); RSEAM(DUP_SQ); }
                if (scu >= 128) { const int t_ = opaque(tid); prep_phase(args, L + 1, lds, scu - 128, G - 128, __builtin_amdgcn_readfirstlane(t_ >> 6), t_ & 63, args.dbl ? 0 : 1); }
                SEAM(pb + 4); }
#endif
#ifndef NO_E3
            if (even && IN(pb + 5)) { REPN(DUP_E3) { e3_phase(args, li, vcu, G, opaque(tid)); RSEAM(DUP_E3); } SEAM(pb + 5); }
#endif
        }
        if (IN(pb + 6)) {
            const bf16* A = (kind == 1) ? OB : ACT; const int K = (kind == 1) ? D : FF;
            const bool odd2 = args.dbl && (L & 1); const bf16* Bt = (const bf16*)(ws + (kind == 0 ? WT_D1 : kind == 1 ? (odd2 ? WT2_OUT : WT_OUT) : (odd2 ? WT2_D2 : WT_D2)));
            pg8::Gemm g{A, Bt, M, D, K, kind == 1 ? 0 : 1}; pg8::StaticOrder S; S.init(M, D, G, bx);
            pg8::EpiResid E{XB, ssb + (size_t)(s + 1) * SS_REC, kind == 1 ? 1.0f : 0.5f, (LAS float*)(lds + 131072)};
#ifndef NO_GR
            REPN(DUP_GR) { if (rep_) { E.scale = 0.f;
#ifdef PROBE_NOEPI
                E.noop = 1;
#endif
                } pg8::gemm_phase<pg8::EpiResid, pg8::StaticOrder, true, true>(lds, g, S, E); RSEAM(DUP_GR); }
#endif
            SEAM(pb + 6);
        }
    }
    if (IN(NSUB * 8)) { const int t_ = opaque(tid); final_phase(args, vcu, G, __builtin_amdgcn_readfirstlane(t_ >> 6), t_ & 63); }
#ifdef PROBE_STAMP
    if (multi) {
        if (tid == 0) { for (int c = 0; c < 8; ++c) __hip_atomic_store((unsigned*)(ctl + 16384 + bx * 8 + c), bar.st[8 + c], __ATOMIC_RELAXED, __HIP_MEMORY_SCOPE_AGENT); __hip_atomic_store((unsigned*)(ctl + 20480 + bx), bar.x, __ATOMIC_RELAXED, __HIP_MEMORY_SCOPE_AGENT); bar.st[4] = 0u; }
        xcd_barrier(bar);
        if (bx == 0 && tid == 0) {
            unsigned long long sum = 0ull; unsigned mn = 0xffffffffu, mx = 0u;
            unsigned ncnt = 0u;
            for (int j = 0; j < G; ++j) { unsigned v = 0u; if (PROBE_SEL && (j >> 3) >= 16) continue; ++ncnt;
                for (int c = 0; c < 8; ++c) if ((PROBE_MASK >> c) & 1) v += __hip_atomic_load((unsigned*)(ctl + 16384 + j * 8 + c), __ATOMIC_RELAXED, __HIP_MEMORY_SCOPE_AGENT);
                sum += v; mn = v < mn ? v : mn; mx = v > mx ? v : mx; }
            unsigned long long stat = PROBE_STAT == 0 ? sum / ncnt : PROBE_STAT == 1 ? mn : mx;
            if (PROBE_STAT == 5) { unsigned long long sp_ = 0ull; for (int j = 0; j < 128; ++j) sp_ += __hip_atomic_load((unsigned*)(ctl + 24576 + j), __ATOMIC_RELAXED, __HIP_MEMORY_SCOPE_AGENT); stat = sp_ / 128ull * 100ull / PROBE_SCALE; }
            else if (PROBE_STAT == 8) { unsigned d_ = 0u; for (int c = 0; c < 4; ++c) if ((PROBE_MASK >> c) & 1) d_ += bar.st[24 + c]; stat = d_; }
            else if (PROBE_STAT == 7) { unsigned d_ = 0u; for (int c = 0; c < 8; ++c) if ((PROBE_MASK >> c) & 1) d_ += bar.st[16 + c]; stat = d_; }
            else if (PROBE_STAT == 6) stat = (unsigned long long)__hip_atomic_load((unsigned*)(ctl + 24576 + 200), __ATOMIC_RELAXED, __HIP_MEMORY_SCOPE_AGENT) * 100ull / PROBE_SCALE;
            else if (PROBE_STAT >= 3) {
                unsigned xmn = 0xffffffffu, xmx = 0u, wsum = 0u, nx_ = 0u;
                for (unsigned x = 0; x < 16; ++x) { unsigned s_ = 0u, n_ = 0u, a_ = 0xffffffffu, b_ = 0u;
                    for (int j = 0; j < G; ++j) { if (__hip_atomic_load((unsigned*)(ctl + 20480 + j), __ATOMIC_RELAXED, __HIP_MEMORY_SCOPE_AGENT) != x) continue; if (PROBE_SEL && (j >> 3) >= 16) continue; unsigned v = 0u;
                        for (int c = 0; c < 8; ++c) if ((PROBE_MASK >> c) & 1) v += __hip_atomic_load((unsigned*)(ctl + 16384 + j * 8 + c), __ATOMIC_RELAXED, __HIP_MEMORY_SCOPE_AGENT);
                        s_ += v; ++n_; a_ = v < a_ ? v : a_; b_ = v > b_ ? v : b_; }
                    if (n_) { const unsigned m_ = s_ / n_; xmn = m_ < xmn ? m_ : xmn; xmx = m_ > xmx ? m_ : xmx; wsum += b_ - a_; ++nx_; } }
                stat = PROBE_STAT == 3 ? (xmx - xmn) : wsum / (nx_ ? nx_ : 1u);
            }
            const unsigned long long ts = __builtin_amdgcn_s_memrealtime();
            while (__builtin_amdgcn_s_memrealtime() - ts < stat * PROBE_SCALE) __builtin_amdgcn_s_sleep(8);
        }
    }
#endif
#undef IN
#undef SEAM
}

extern "C" void kernel_launch(void* const* d_in, const int* in_sizes, int n_in, void* d_out, int out_size, void* d_ws, size_t ws_size, hipStream_t stream) {
    static int grid = 0;
    if (grid == 0) {
        if (n_in != 29 || out_size != M * D || ws_size < WS_END) { fprintf(stderr, "kernel_launch: unexpected shapes (n_in %d, out %d, ws %zu < %zu); nothing launched\n", n_in, out_size, ws_size, (size_t)WS_END); grid = -1; return; }
        int dev = 0, cus = 0;
        if (hipGetDevice(&dev) != hipSuccess || hipDeviceGetAttribute(&cus, hipDeviceAttributeMultiprocessorCount, dev) != hipSuccess) { grid = -1; return; }
        if (hipFuncSetAttribute((const void*)mk_fwd, hipFuncAttributeMaxDynamicSharedMemorySize, LDS_BYTES) != hipSuccess) { fprintf(stderr, "kernel_launch: hipFuncSetAttribute failed\n"); grid = -1; return; }
        int per_cu = 0;
        if (hipOccupancyMaxActiveBlocksPerMultiprocessor(&per_cu, (const void*)mk_fwd, NTHR, LDS_BYTES) != hipSuccess || per_cu < 1) fprintf(stderr, "kernel_launch: occupancy query says %d\n", per_cu);
        (void)hipGetLastError();
        grid = cus;
    }
    if (grid < 0) return;
    (void)hipMemsetAsync((char*)d_ws + WS_CTL, 0, CTL_ZERO_BYTES, stream);
    Args a{};
    for (int i = 0; i < 29; ++i) a.in[i] = (const float*)d_in[i];
    a.out = (float*)d_out; a.ws = (unsigned char*)d_ws; a.dbl = (ws_size >= WS_END2) ? 1 : 0; a.pad_ = 0;
#if MK_ONE_LAUNCH
    a.ph_lo = 0; a.ph_hi = NSUB * 8 + 1;
    hipLaunchKernelGGL(mk_fwd, dim3(grid), dim3(NTHR), LDS_BYTES, stream, a);
#else
    for (int s = 0; s <= NSUB; ++s) {
        for (int k = 0; k < (s == NSUB ? 1 : 8); ++k) {
            const int L = s / 3, kind = s % 3; const bool even = !(L & 1);
            bool live;
            if (s == NSUB) live = true;
            else if (k == 0) live = (kind == 0);
            else if (k == 1 || k == 6) live = true;
            else if (k == 2) live = (kind == 1);
            else if (k == 3 || k == 4 || k == 5) live = (kind == 1) && even;
            else live = false;
            if (!live) continue;
            a.ph_lo = s * 8 + k; a.ph_hi = a.ph_lo + 1;
            hipLaunchKernelGGL(mk_fwd, dim3(grid), dim3(NTHR), LDS_BYTES, stream, a);
        }
    }
#endif
}
```
